# Optimizing an MI355X kernel written in HIP

```python
import jax
import jax.numpy as jnp
from jax import lax
import numpy as np

D_MODEL = 1024
BATCH = 16
SEQ = 256
DEPTH = 4
DEC_BATCH = 4
DEC_SEQ = 1024
PAST_LEN = 512

GRID_W = 64
N_EVEN = (DEPTH + 1) // 2
N_ODD = DEPTH // 2
N_MOD = 6
D_FF = 4 * D_MODEL
EPS = 1e-6

SSD_HEADS = 16
SSD_HEADDIM = 64
D_SSD = SSD_HEADS * SSD_HEADDIM
SSD_GROUPS = 4
D_STATE = 128
SSD_CONV_CH = D_SSD + 2 * SSD_GROUPS * D_STATE
IN_SSD = D_SSD + SSD_CONV_CH + 2 * SSD_HEADS
SSD_CHUNK = 64

RWKV_HEADS = 16
RWKV_HEAD = 64
D_RWKV = RWKV_HEADS * RWKV_HEAD
DECAY_LORA = 64
AAA_LORA = 64
GATE_LORA = 128
IN_RWKV = 3 * D_RWKV + 2 * DECAY_LORA + 2 * AAA_LORA + GATE_LORA
RWKV_LN_EPS = 64e-5

GLA_HEADS = 4
GLA_DK = 128
GLA_DV = 256
GLA_GATE_RANK = 16
GLA_TAU = 16.0
GLA_CHUNK = 16
IN_GLA = 2 * GLA_HEADS * GLA_DK + 2 * GLA_HEADS * GLA_DV + 2 * GLA_GATE_RANK

ML_HEADS = 4
ML_DK = 128
ML_DV = 256
ML_CHUNK = 64
IN_ML = 2 * ML_HEADS * ML_DK + 2 * ML_HEADS * ML_DV + 4 * ML_HEADS

IN_AB = IN_SSD + IN_RWKV
IN_CD = IN_GLA + IN_ML
D_MIX_AB = D_SSD + D_RWKV
D_MIX_CD = GLA_HEADS * GLA_DV + ML_HEADS * ML_DV

kernel_name = 'hybrid_diffusion_ssd_rwkv_gla_mlstm_step'


def rmsnorm(x, g):
    xf = x.astype(jnp.float32)
    y = xf * lax.rsqrt(jnp.mean(xf * xf, axis=-1, keepdims=True) + EPS)
    return y.astype(x.dtype) * g


def head_rmsnorm(x, g, n_heads):
    shp = x.shape
    y = rmsnorm(x.reshape(shp[:-1] + (n_heads, shp[-1] // n_heads)), g.reshape(n_heads, -1))
    return y.reshape(shp)


def head_layernorm(x, w, b, n_heads):
    shp = x.shape
    xf = x.reshape(shp[:-1] + (n_heads, shp[-1] // n_heads)).astype(jnp.float32)
    mu = jnp.mean(xf, axis=-1, keepdims=True)
    var = jnp.mean(jnp.square(xf - mu), axis=-1, keepdims=True)
    y = ((xf - mu) * lax.rsqrt(var + RWKV_LN_EPS)).reshape(shp).astype(x.dtype)
    return y * w + b


def short_conv(x, w, b, grid_rows):
    bsz, t, ch = x.shape
    w = w.astype(x.dtype)
    if grid_rows is None:
        y = lax.conv_general_dilated(x, w[1][:, None, :], (1,), 'SAME',
                                     dimension_numbers=('NWC', 'WIO', 'NWC'), feature_group_count=ch)
    else:
        y = lax.conv_general_dilated(x.reshape(bsz, grid_rows, GRID_W, ch), w[:, :, None, :], (1, 1), 'SAME',
                                     dimension_numbers=('NHWC', 'HWIO', 'NHWC'), feature_group_count=ch)
        y = y.reshape(bsz, t, ch)
    return y + b


def token_shift(x):
    xp = jnp.pad(x, ((0, 0), (1, 1), (0, 0)))
    return 0.5 * (xp[:, :-2] + xp[:, 2:])


def chunked_linear_scan(q, k, v, log_a, s0, chunk):
    out_dtype = v.dtype
    f32 = jnp.float32
    bsz, nh, t, _ = q.shape
    dv = v.shape[-1]
    nc = t // chunk
    q, k, v, la = (u.astype(f32).reshape(bsz, nh, nc, chunk, -1) for u in (q, k, v, log_a))
    b = jnp.cumsum(la, axis=3)
    b_last = b[:, :, :, -1:]
    causal = jnp.tril(jnp.ones((chunk, chunk), dtype=bool))
    if la.shape[-1] == 1:
        b0 = b[..., 0]
        seg = b0[..., :, None] - b0[..., None, :]
        dec = jnp.where(causal, jnp.exp(jnp.where(causal, seg, 0.0)), 0.0)
        scores = jnp.einsum('bhntk,bhnsk->bhnts', q, k) * dec
    else:
        cm = causal[:, :, None]
        seg = b[:, :, :, :, None, :] - b[:, :, :, None, :, :]
        dec = jnp.where(cm, jnp.exp(jnp.where(cm, seg, 0.0)), 0.0)
        scores = jnp.einsum('bhntk,bhnsk,bhntsk->bhnts', q, k, dec)
    o_intra = jnp.einsum('bhnts,bhnsv->bhntv', scores, v)
    ds = jnp.einsum('bhnsk,bhnsv->bhnkv', k * jnp.exp(b_last - b), v)
    g = jnp.exp(b_last[:, :, :, 0])

    def step(s, inp):
        g_c, ds_c = inp
        return g_c[..., None] * s + ds_c, s

    s_fin, s_start = lax.scan(step, s0.astype(f32), (jnp.moveaxis(g, 2, 0), jnp.moveaxis(ds, 2, 0)))
    s_start = jnp.moveaxis(s_start, 0, 2)
    o_inter = jnp.einsum('bhntk,bhnkv->bhntv', q * jnp.exp(b), s_start)
    o = (o_intra + o_inter).reshape(bsz, nh, t, dv)
    return o.astype(out_dtype), s_fin.astype(out_dtype)


def chunked_mlstm(q, k, v, i_pre, log_f, c0, n0, m0, chunk):
    out_dtype = v.dtype
    f32 = jnp.float32
    bsz, nh, t, _ = q.shape
    dv = v.shape[-1]
    nc = t // chunk
    q, k, v = (u.astype(f32).reshape(bsz, nh, nc, chunk, -1) for u in (q, k, v))
    ig, lf = (u.astype(f32).reshape(bsz, nh, nc, chunk) for u in (i_pre, log_f))
    b = jnp.cumsum(lf, axis=-1)
    causal = jnp.tril(jnp.ones((chunk, chunk), dtype=bool))
    dmat = jnp.where(causal, b[..., :, None] - b[..., None, :] + ig[..., None, :], -jnp.inf)
    lw_tail = b[..., -1:] - b + ig
    m_loc = jnp.max(lw_tail, axis=-1)
    w_tail = jnp.exp(lw_tail - m_loc[..., None])
    dc = jnp.einsum('bhns,bhnsk,bhnsv->bhnkv', w_tail, k, v)
    dn = jnp.einsum('bhns,bhnsk->bhnk', w_tail, k)
    g = b[..., -1]

    def step(carry, inp):
        c_s, n_s, m_s = carry
        g_c, ml_c, dc_c, dn_c = inp
        m_new = jnp.maximum(g_c + m_s, ml_c)
        a_old = jnp.exp(g_c + m_s - m_new)
        a_new = jnp.exp(ml_c - m_new)
        c_n = a_old[..., None, None] * c_s + a_new[..., None, None] * dc_c
        n_n = a_old[..., None] * n_s + a_new[..., None] * dn_c
        return (c_n, n_n, m_new), (c_s, n_s, m_s)

    xs = tuple(jnp.moveaxis(u, 2, 0) for u in (g, m_loc, dc, dn))
    (c_f, n_f, m_f), (c_st, n_st, m_st) = lax.scan(step, (c0.astype(f32), n0.astype(f32), m0.astype(f32)), xs)
    c_st, n_st, m_st = (jnp.moveaxis(u, 0, 2) for u in (c_st, n_st, m_st))
    m_inter = b + m_st[..., None]
    m_t = jnp.maximum(m_inter, jnp.max(dmat, axis=-1))
    w_inter = jnp.exp(m_inter - m_t)
    s_qk = jnp.einsum('bhntk,bhnsk->bhnts', q, k) * jnp.exp(dmat - m_t[..., None])
    num = jnp.einsum('bhnts,bhnsv->bhntv', s_qk, v) + w_inter[..., None] * jnp.einsum('bhntk,bhnkv->bhntv', q, c_st)
    den = jnp.sum(s_qk, axis=-1) + w_inter * jnp.einsum('bhntk,bhnk->bhnt', q, n_st)
    h = num / jnp.maximum(jnp.abs(den), jnp.exp(-m_t))[..., None]
    return h.reshape(bsz, nh, t, dv).astype(out_dtype), (c_f.astype(out_dtype), n_f.astype(out_dtype), m_f.astype(out_dtype))


def rwkv7_scan(r, log_w, k, v, kk, a, s0):
    out_dtype = v.dtype
    xs = tuple(jnp.moveaxis(u.astype(jnp.float32), 1, 0) for u in (r, log_w, k, v, kk, a))

    def step(s, inp):
        r_t, lw_t, k_t, v_t, kk_t, a_t = inp
        s_kk = jnp.einsum('bhvk,bhk->bhv', s, kk_t)
        s = (s * jnp.exp(lw_t)[:, :, None, :] - s_kk[..., None] * (kk_t * a_t)[:, :, None, :]
             + v_t[..., None] * k_t[:, :, None, :])
        return s, jnp.einsum('bhvk,bhk->bhv', s, r_t)

    s_fin, ys = lax.scan(step, s0.astype(jnp.float32), xs)
    return jnp.moveaxis(ys, 0, 1).astype(out_dtype), s_fin.astype(out_dtype)


def mixer_ab(h, s_ssd, s_rwkv, grid_rows, p):
    bsz, t, _ = h.shape
    proj = h @ p['w_in']
    ssd_in, rw_in = proj[..., :IN_SSD], proj[..., IN_SSD:]

    z = ssd_in[..., :D_SSD]
    xbc = jax.nn.silu(short_conv(ssd_in[..., D_SSD:D_SSD + SSD_CONV_CH], p['ssd_conv_w'], p['ssd_conv_b'], grid_rows))
    dt_raw = ssd_in[..., D_SSD + SSD_CONV_CH:].reshape(bsz, t, 2, SSD_HEADS)
    xs = xbc[..., :D_SSD].reshape(bsz, t, SSD_HEADS, SSD_HEADDIM)
    bc = xbc[..., D_SSD:].reshape(bsz, t, 2, SSD_GROUPS, D_STATE)
    rep = SSD_HEADS // SSD_GROUPS
    b_h = jnp.repeat(bc[:, :, 0], rep, axis=2)
    c_h = jnp.repeat(bc[:, :, 1], rep, axis=2)
    dt = jax.nn.softplus(dt_raw.astype(jnp.float32) + p['ssd_dt_bias'])
    log_a = dt * -jnp.exp(p['ssd_a_log'].astype(jnp.float32))
    q = c_h.transpose(0, 2, 1, 3)
    v = xs.transpose(0, 2, 1, 3)
    ys, ss = [], []
    for d in range(2):
        k = (b_h * dt[:, :, d, :, None]).transpose(0, 2, 1, 3)
        la = log_a[:, :, d].transpose(0, 2, 1)[..., None]
        args = (q, k, v, la) if d == 0 else tuple(jnp.flip(u, 2) for u in (q, k, v, la))
        y, s = chunked_linear_scan(*args, s_ssd[:, d], SSD_CHUNK)
        ys.append(y if d == 0 else jnp.flip(y, 2))
        ss.append(s)
    y_ssd = (ys[0] + ys[1]).transpose(0, 2, 1, 3) + xs * p['ssd_d'][:, None]
    y_ssd = rmsnorm(y_ssd.reshape(bsz, t, D_SSD) * jax.nn.silu(z), p['ssd_norm'])

    rw = rw_in + p['rwkv_mu'] * (token_shift(rw_in) - rw_in)
    o4 = 3 * D_RWKV + 2 * DECAY_LORA
    o5 = o4 + 2 * AAA_LORA
    r, k, v, wd, ad, gd = jnp.split(rw, [D_RWKV, 2 * D_RWKV, 3 * D_RWKV, o4, o5], axis=-1)
    wd = wd.reshape(bsz, t, 2, DECAY_LORA)
    ad = ad.reshape(bsz, t, 2, AAA_LORA)
    w_pre = (p['rwkv_w0'] + jnp.einsum('btdr,drc->btdc', jnp.tanh(wd), p['rwkv_w2'])).astype(jnp.float32)
    log_w = -jnp.exp(-jax.nn.softplus(-w_pre) - 0.5)
    a = jax.nn.sigmoid(p['rwkv_a0'] + jnp.einsum('btdr,drc->btdc', ad, p['rwkv_a2']))
    g = jax.nn.sigmoid(gd) @ p['rwkv_g2']

    def hsplit(u):
        return u.reshape(u.shape[:-1] + (RWKV_HEADS, RWKV_HEAD))

    rh, kh, vh = hsplit(r), hsplit(k), hsplit(v)
    kk = hsplit(k * p['rwkv_k_k']).astype(jnp.float32)
    kk = kk * lax.rsqrt(jnp.sum(kk * kk, axis=-1, keepdims=True) + 1e-12)
    lw_h, a_h = hsplit(log_w), hsplit(a)
    k_a = hsplit(p['rwkv_k_a'])
    ys_rw, ss_rw = [], []
    for d in range(2):
        kd = kh * (1 + (a_h[:, :, d] - 1) * k_a)
        args = (rh, lw_h[:, :, d], kd, vh, kk, a_h[:, :, d])
        if d == 1:
            args = tuple(jnp.flip(u, 1) for u in args)
        y, s = rwkv7_scan(*args, s_rwkv[:, d])
        ys_rw.append(y if d == 0 else jnp.flip(y, 1))
        ss_rw.append(s)
    y_rw = head_layernorm((ys_rw[0] + ys_rw[1]).reshape(bsz, t, D_RWKV), p['rwkv_ln_w'], p['rwkv_ln_b'], RWKV_HEADS)
    bonus = jnp.sum(rh * kh * p['rwkv_r_k'], axis=-1, keepdims=True) * vh
    y_rw = (y_rw + bonus.reshape(bsz, t, D_RWKV)) * g

    out = jnp.concatenate([y_ssd, y_rw], axis=-1) @ p['w_out']
    return out, (jnp.stack(ss, axis=1), jnp.stack(ss_rw, axis=1))


def mixer_cd(h, s_gla, s_mc, s_mn, s_mm, grid_rows, p):
    bsz, t, _ = h.shape
    proj = h @ p['w_in']
    gla_in, ml_in = proj[..., :IN_GLA], proj[..., IN_GLA:]

    def heads(u, n_heads):
        return u.reshape(bsz, t, n_heads, -1).transpose(0, 2, 1, 3)

    dkg, dvg = GLA_HEADS * GLA_DK, GLA_HEADS * GLA_DV
    gq, gk, gv, gg, gd = jnp.split(gla_in, [dkg, 2 * dkg, 2 * dkg + dvg, 2 * dkg + 2 * dvg], axis=-1)
    gd = gd.reshape(bsz, t, 2, GLA_GATE_RANK)
    gate_pre = jnp.einsum('btdr,drc->btdc', gd, p['gla_gate_w']) + p['gla_gate_b']
    log_alpha = jax.nn.log_sigmoid(gate_pre.astype(jnp.float32)) / GLA_TAU
    q, k, v = heads(gq, GLA_HEADS) * GLA_DK ** -0.5, heads(gk, GLA_HEADS), heads(gv, GLA_HEADS)
    os_g, ss_g = [], []
    for d in range(2):
        la = heads(log_alpha[:, :, d], GLA_HEADS)
        args = (q, k, v, la) if d == 0 else tuple(jnp.flip(u, 2) for u in (q, k, v, la))
        o, s = chunked_linear_scan(*args, s_gla[:, d], GLA_CHUNK)
        os_g.append(o if d == 0 else jnp.flip(o, 2))
        ss_g.append(s)
    o_g = (os_g[0] + os_g[1]).transpose(0, 2, 1, 3).reshape(bsz, t, dvg)
    y_gla = head_rmsnorm(o_g, p['gla_norm'], GLA_HEADS) * jax.nn.silu(gg)

    dkm, dvm = ML_HEADS * ML_DK, ML_HEADS * ML_DV
    mqk, mv, mo, mif = jnp.split(ml_in, [2 * dkm, 2 * dkm + dvm, 2 * dkm + 2 * dvm], axis=-1)
    mqk = jax.nn.silu(short_conv(mqk, p['ml_conv_w'], p['ml_conv_b'], grid_rows))
    q = heads(mqk[..., :dkm], ML_HEADS)
    k = heads(mqk[..., dkm:], ML_HEADS) * ML_DK ** -0.5
    v = heads(mv, ML_HEADS)
    mif = mif.reshape(bsz, t, 2, 2, ML_HEADS).astype(jnp.float32)
    i_pre = mif[:, :, 0] + p['ml_i_b']
    log_f = jax.nn.log_sigmoid(mif[:, :, 1] + p['ml_f_b'])
    hs, cs, ns, ms = [], [], [], []
    for d in range(2):
        ig = i_pre[:, :, d].transpose(0, 2, 1)
        lf = log_f[:, :, d].transpose(0, 2, 1)
        args = (q, k, v, ig, lf) if d == 0 else tuple(jnp.flip(u, 2) for u in (q, k, v, ig, lf))
        hh, (sc, sn, sm) = chunked_mlstm(*args, s_mc[:, d], s_mn[:, d], s_mm[:, d], ML_CHUNK)
        hs.append(hh if d == 0 else jnp.flip(hh, 2))
        cs.append(sc)
        ns.append(sn)
        ms.append(sm)
    h_m = (hs[0] + hs[1]).transpose(0, 2, 1, 3).reshape(bsz, t, dvm)
    y_ml = jax.nn.sigmoid(mo) * head_rmsnorm(h_m, p['ml_norm'], ML_HEADS)

    out = jnp.concatenate([y_gla, y_ml], axis=-1) @ p['w_out']
    return out, (jnp.stack(ss_g, axis=1), jnp.stack(cs, axis=1), jnp.stack(ns, axis=1), jnp.stack(ms, axis=1))


def sandwich_block(x, mod, mix_fn, g, w_up, w_down):
    shift1, scale1, gate1, shift2, scale2, gate2 = jnp.split(mod, N_MOD, axis=-1)
    m, st = mix_fn(rmsnorm(x, g[0]) * (1 + scale1) + shift1)
    x = x + gate1 * rmsnorm(m, g[1])
    f = jnp.square(jax.nn.relu((rmsnorm(x, g[2]) * (1 + scale2) + shift2) @ w_up)) @ w_down
    x = x + gate2 * rmsnorm(f, g[3])
    return x, st


def setup_inputs(seed: int = 0) -> dict:
    key = jax.random.key(seed)
    ks = iter(jax.random.split(key, 64))

    def nrm(shape, scale=1.0):
        return scale * jax.random.normal(next(ks), shape, jnp.float32)

    def unif(shape, lo, hi):
        return jax.random.uniform(next(ks), shape, jnp.float32, lo, hi)

    dt0 = jnp.exp(unif((N_EVEN, 2, SSD_HEADS), float(np.log(1e-3)), float(np.log(1e-1))))
    return {
        'x_prompt': nrm((BATCH, SEQ, D_MODEL)),
        'x_sample': nrm((DEC_BATCH, DEC_SEQ, D_MODEL)),
        'state_ssd': nrm((DEC_BATCH, N_EVEN, 2, SSD_HEADS, D_STATE, SSD_HEADDIM), 0.3),
        'state_rwkv': nrm((DEC_BATCH, N_EVEN, 2, RWKV_HEADS, RWKV_HEAD, RWKV_HEAD), 0.3),
        'state_gla': nrm((DEC_BATCH, N_ODD, 2, GLA_HEADS, GLA_DK, GLA_DV), 0.3),
        'state_mlstm_c': nrm((DEC_BATCH, N_ODD, 2, ML_HEADS, ML_DK, ML_DV), 0.3),
        'state_mlstm_n': nrm((DEC_BATCH, N_ODD, 2, ML_HEADS, ML_DK), 0.3),
        'state_mlstm_m': nrm((DEC_BATCH, N_ODD, 2, ML_HEADS)),
        'c': nrm((DEC_BATCH, D_MODEL)),
        'c_ctx': nrm((D_MODEL,)),
        'w_mod': nrm((DEPTH, D_MODEL, N_MOD * D_MODEL), 0.5 * D_MODEL ** -0.5),
        'b_mod': nrm((DEPTH, N_MOD * D_MODEL), 0.02),
        'norm_g': 1.0 + nrm((DEPTH, 4, D_MODEL), 0.05),
        'w_mlp_up': nrm((DEPTH, D_MODEL, D_FF), D_MODEL ** -0.5),
        'w_mlp_down': nrm((DEPTH, D_FF, D_MODEL), D_FF ** -0.5),
        'w_in_ab': nrm((N_EVEN, D_MODEL, IN_AB), D_MODEL ** -0.5),
        'ssd_conv_w': nrm((N_EVEN, 3, 3, SSD_CONV_CH), 1.0 / 3.0),
        'ssd_conv_b': nrm((N_EVEN, SSD_CONV_CH), 0.02),
        'ssd_dt_bias': dt0 + jnp.log(-jnp.expm1(-dt0)),
        'ssd_a_log': jnp.log(unif((N_EVEN, 2, SSD_HEADS), 1.0, 16.0)),
        'ssd_d': 1.0 + nrm((N_EVEN, SSD_HEADS), 0.1),
        'ssd_norm': 1.0 + nrm((N_EVEN, D_SSD), 0.05),
        'rwkv_mu': unif((N_EVEN, IN_RWKV), 0.0, 1.0),
        'rwkv_w0': unif((N_EVEN, 2, D_RWKV), -6.0, -1.0),
        'rwkv_w2': nrm((N_EVEN, 2, DECAY_LORA, D_RWKV), 0.5 * DECAY_LORA ** -0.5),
        'rwkv_a0': nrm((N_EVEN, 2, D_RWKV), 0.5),
        'rwkv_a2': nrm((N_EVEN, 2, AAA_LORA, D_RWKV), 0.5 * AAA_LORA ** -0.5),
        'rwkv_g2': nrm((N_EVEN, GATE_LORA, D_RWKV), GATE_LORA ** -0.5),
        'rwkv_k_k': 0.85 + nrm((N_EVEN, D_RWKV), 0.05),
        'rwkv_k_a': 1.0 + nrm((N_EVEN, D_RWKV), 0.05),
        'rwkv_r_k': nrm((N_EVEN, RWKV_HEADS, RWKV_HEAD), 0.1),
        'rwkv_ln_w': 1.0 + nrm((N_EVEN, D_RWKV), 0.05),
        'rwkv_ln_b': nrm((N_EVEN, D_RWKV), 0.02),
        'w_out_ab': nrm((N_EVEN, D_MIX_AB, D_MODEL), D_MIX_AB ** -0.5),
        'w_in_cd': nrm((N_ODD, D_MODEL, IN_CD), D_MODEL ** -0.5),
        'gla_gate_w': nrm((N_ODD, 2, GLA_GATE_RANK, GLA_HEADS * GLA_DK), GLA_GATE_RANK ** -0.5),
        'gla_gate_b': nrm((N_ODD, 2, GLA_HEADS * GLA_DK), 0.5),
        'gla_norm': 1.0 + nrm((N_ODD, GLA_HEADS * GLA_DV), 0.05),
        'mlstm_conv_w': nrm((N_ODD, 3, 3, 2 * ML_HEADS * ML_DK), 1.0 / 3.0),
        'mlstm_conv_b': nrm((N_ODD, 2 * ML_HEADS * ML_DK), 0.02),
        'mlstm_i_b': nrm((N_ODD, 2, ML_HEADS), 0.1),
        'mlstm_f_b': unif((N_ODD, 2, ML_HEADS), 3.0, 6.0),
        'mlstm_norm': 1.0 + nrm((N_ODD, ML_HEADS * ML_DV), 0.05),
        'w_out_cd': nrm((N_ODD, D_MIX_CD, D_MODEL), D_MIX_CD ** -0.5),
    }


def reference(x_prompt, x_sample, state_ssd, state_rwkv, state_gla, state_mlstm_c, state_mlstm_n, state_mlstm_m, c,
              c_ctx, w_mod, b_mod, norm_g, w_mlp_up, w_mlp_down,
              w_in_ab, ssd_conv_w, ssd_conv_b, ssd_dt_bias, ssd_a_log, ssd_d, ssd_norm,
              rwkv_mu, rwkv_w0, rwkv_w2, rwkv_a0, rwkv_a2, rwkv_g2, rwkv_k_k, rwkv_k_a, rwkv_r_k, rwkv_ln_w, rwkv_ln_b,
              w_out_ab, w_in_cd, gla_gate_w, gla_gate_b, gla_norm, mlstm_conv_w, mlstm_conv_b, mlstm_i_b, mlstm_f_b,
              mlstm_norm, w_out_cd):
    bp = x_prompt.shape[0]
    rows = x_sample.shape[1] // GRID_W
    dtp = x_prompt.dtype
    zero_ssd = jnp.zeros((bp, 2, SSD_HEADS, D_STATE, SSD_HEADDIM), dtp)
    zero_rwkv = jnp.zeros((bp, 2, RWKV_HEADS, RWKV_HEAD, RWKV_HEAD), dtp)
    zero_gla = jnp.zeros((bp, 2, GLA_HEADS, GLA_DK, GLA_DV), dtp)
    zero_mc = jnp.zeros((bp, 2, ML_HEADS, ML_DK, ML_DV), dtp)
    zero_mn = jnp.zeros((bp, 2, ML_HEADS, ML_DK), dtp)
    zero_mm = jnp.zeros((bp, 2, ML_HEADS), dtp)
    cond_ctx = jax.nn.silu(c_ctx)[None, :]
    cond_lat = jax.nn.silu(c)
    y_prompt, y_sample = x_prompt, x_sample
    new_ssd, new_rwkv, new_gla, new_mc, new_mn, new_mm = [], [], [], [], [], []
    for l in range(DEPTH):
        j = l // 2
        mod_ctx = (cond_ctx @ w_mod[l] + b_mod[l])[:, None, :]
        mod_lat = (cond_lat @ w_mod[l] + b_mod[l])[:, None, :]
        if l % 2 == 0:
            p = {'w_in': w_in_ab[j], 'ssd_conv_w': ssd_conv_w[j], 'ssd_conv_b': ssd_conv_b[j],
                 'ssd_dt_bias': ssd_dt_bias[j], 'ssd_a_log': ssd_a_log[j], 'ssd_d': ssd_d[j], 'ssd_norm': ssd_norm[j],
                 'rwkv_mu': rwkv_mu[j], 'rwkv_w0': rwkv_w0[j], 'rwkv_w2': rwkv_w2[j], 'rwkv_a0': rwkv_a0[j],
                 'rwkv_a2': rwkv_a2[j], 'rwkv_g2': rwkv_g2[j], 'rwkv_k_k': rwkv_k_k[j], 'rwkv_k_a': rwkv_k_a[j],
                 'rwkv_r_k': rwkv_r_k[j], 'rwkv_ln_w': rwkv_ln_w[j], 'rwkv_ln_b': rwkv_ln_b[j], 'w_out': w_out_ab[j]}
            y_prompt, (s_ssd, s_rw) = sandwich_block(
                y_prompt, mod_ctx, lambda h: mixer_ab(h, zero_ssd, zero_rwkv, None, p),
                norm_g[l], w_mlp_up[l], w_mlp_down[l])
            y_sample, _ = sandwich_block(
                y_sample, mod_lat, lambda h: mixer_ab(h, state_ssd[:, j], state_rwkv[:, j], rows, p),
                norm_g[l], w_mlp_up[l], w_mlp_down[l])
            new_ssd.append(s_ssd)
            new_rwkv.append(s_rw)
        else:
            p = {'w_in': w_in_cd[j], 'gla_gate_w': gla_gate_w[j], 'gla_gate_b': gla_gate_b[j], 'gla_norm': gla_norm[j],
                 'ml_conv_w': mlstm_conv_w[j], 'ml_conv_b': mlstm_conv_b[j], 'ml_i_b': mlstm_i_b[j],
                 'ml_f_b': mlstm_f_b[j], 'ml_norm': mlstm_norm[j], 'w_out': w_out_cd[j]}
            y_prompt, (s_gla, s_mc, s_mn, s_mm) = sandwich_block(
                y_prompt, mod_ctx, lambda h: mixer_cd(h, zero_gla, zero_mc, zero_mn, zero_mm, None, p),
                norm_g[l], w_mlp_up[l], w_mlp_down[l])
            y_sample, _ = sandwich_block(
                y_sample, mod_lat,
                lambda h: mixer_cd(h, state_gla[:, j], state_mlstm_c[:, j], state_mlstm_n[:, j], state_mlstm_m[:, j], rows, p),
                norm_g[l], w_mlp_up[l], w_mlp_down[l])
            new_gla.append(s_gla)
            new_mc.append(s_mc)
            new_mn.append(s_mn)
            new_mm.append(s_mm)
    return (y_prompt, y_sample, jnp.stack(new_ssd, axis=1), jnp.stack(new_rwkv, axis=1), jnp.stack(new_gla, axis=1),
            jnp.stack(new_mc, axis=1), jnp.stack(new_mn, axis=1), jnp.stack(new_mm, axis=1))
```

```cpp
#include <hip/hip_runtime.h>
#include <hip/hip_cooperative_groups.h>
#include <cstdio>
#include <cstdint>
namespace cg = cooperative_groups;

#define LAS __attribute__((address_space(3)))
typedef unsigned short bf16_t;
typedef short bf16x8 __attribute__((ext_vector_type(8)));
typedef float f32x4 __attribute__((ext_vector_type(4)));
typedef float f32x2 __attribute__((ext_vector_type(2)));
typedef unsigned u32x4 __attribute__((ext_vector_type(4)));
typedef unsigned u32x2 __attribute__((ext_vector_type(2)));

constexpr int MTOK = 8192, DM = 1024, DFF = 4096;
constexpr int N_AB = 6560, N_AB_P = 6656, N_CD = 6192, N_CD_P = 6400;
constexpr int PROJ_LD_AB = N_AB_P, PROJ_LD_CD = N_CD_P;
constexpr int PREP_LD = 7168, LOUT_LD = 5120, LORA_K = 384, YLD = 2048;
constexpr int IN_SSD = 3104, IN_GLA = 3104;
constexpr size_t MiB = 1u << 20;
constexpr size_t WS_MOD = 0, WS_DT = 1 * MiB, WS_DA = 3 * MiB, WS_WIN = 5 * MiB, WS_WOUT = 19 * MiB, WS_WUP = 23 * MiB, WS_WDN = 31 * MiB,
                 WS_WLORA = 39 * MiB, WS_H = 41 * MiB, WS_PROJ = 57 * MiB, WS_PREP = 161 * MiB, WS_MIX = 273 * MiB, WS_MP = 305 * MiB,
                 WS_LORAA = 369 * MiB, WS_END = 375 * MiB;
constexpr size_t O_X = 0, O_SSD = 8388608, O_RWKV = 16777216, O_GLA = 20971520, O_MC = 29360128, O_MN = 37748736, O_MM = 37781504;

struct Params { const float* in[44]; float* out; unsigned char* ws; };
enum { I_XP = 0, I_XS, I_SSSD, I_SRWKV, I_SGLA, I_SMC, I_SMN, I_SMM, I_C, I_CCTX, I_WMOD, I_BMOD, I_NORMG, I_WUP, I_WDN, I_WINAB, I_SCONVW, I_SCONVB,
       I_DTB, I_ALOG, I_SSDD, I_SSDN, I_MU, I_W0, I_W2, I_A0, I_A2, I_G2, I_KK, I_KA, I_RK, I_LNW, I_LNB, I_WOUTAB, I_WINCD, I_GGW, I_GGB, I_GLAN,
       I_MCONVW, I_MCONVB, I_MIB, I_MFB, I_MLN, I_WOUTCD };

__device__ __forceinline__ float bf2f(unsigned b) { return __uint_as_float(b << 16); }
__device__ __forceinline__ unsigned f2bf(float f) { unsigned u = __float_as_uint(f); return (u + 0x7fffu + ((u >> 16) & 1u)) >> 16; }
__device__ __forceinline__ unsigned pk2(float lo, float hi) { return f2bf(lo) | (f2bf(hi) << 16); }
__device__ __forceinline__ float lo16(unsigned w) { return __uint_as_float(w << 16); }
__device__ __forceinline__ float hi16(unsigned w) { return __uint_as_float(w & 0xffff0000u); }
__device__ __forceinline__ void unpack8(u32x4 w, float* o) { o[0] = lo16(w.x); o[1] = hi16(w.x); o[2] = lo16(w.y); o[3] = hi16(w.y); o[4] = lo16(w.z); o[5] = hi16(w.z); o[6] = lo16(w.w); o[7] = hi16(w.w); }
__device__ __forceinline__ f32x4 unpack4(u32x2 w) { return (f32x4){lo16(w.x), hi16(w.x), lo16(w.y), hi16(w.y)}; }
__device__ __forceinline__ u32x4 pack8(const float* o) { u32x4 w; w.x = pk2(o[0], o[1]); w.y = pk2(o[2], o[3]); w.z = pk2(o[4], o[5]); w.w = pk2(o[6], o[7]); return w; }
__device__ __forceinline__ float sigmoidf_(float x) { return 1.f / (1.f + __expf(-x)); }
__device__ __forceinline__ float siluf_(float x) { return x / (1.f + __expf(-x)); }
__device__ __forceinline__ float softplusf_(float x) { return fmaxf(x, 0.f) + __logf(1.f + __expf(-fabsf(x))); }
__device__ __forceinline__ float logsigmoidf_(float x) { return fminf(x, 0.f) - __logf(1.f + __expf(-fabsf(x))); }
__device__ __forceinline__ float tanhf_(float x) { const float e = __expf(-2.f * fabsf(x)); const float r = (1.f - e) / (1.f + e); return x < 0.f ? -r : r; }
__device__ __forceinline__ float wave_sum(float v) {
#pragma unroll
    for (int o = 1; o < 64; o <<= 1) v += __shfl_xor(v, o);
    return v;
}
__device__ __forceinline__ float quad_sum(float x) {
    x += __int_as_float(__builtin_amdgcn_update_dpp(0, __float_as_int(x), 0xB1, 0xF, 0xF, true));
    x += __int_as_float(__builtin_amdgcn_update_dpp(0, __float_as_int(x), 0x4E, 0xF, 0xF, true));
    return x;
}

namespace pg8 {
constexpr int BM = 256, BK = 64, HALF = 128, HTB = HALF * BK * 2, STAGE_BYTES = 8 * HTB, NXCD = 8, WGM = 8;
__host__ __device__ __forceinline__ int lds_byte(int r, int c) { const int st = (r >> 4) * 2 + (c >> 5), rr = r & 15, cc = c & 31, ob = rr * 64 + cc * 2; return st * 1024 + (ob ^ (((ob >> 9) & 1) << 5)); }
__host__ __device__ __forceinline__ void stage_rc(int b, int& R, int& C) { const int st = b / 1024, sb = b % 1024, swz = sb ^ (((sb >> 9) & 1) << 5); R = (st >> 1) * 16 + swz / 64; C = (st & 1) * 32 + (swz % 64) / 2; }
__host__ __device__ __forceinline__ int perm32(int rho) { const int n = rho >> 4, i = rho & 15; return 8 * (i >> 2) + 4 * n + (i & 3); }

struct Unit { int pm, pn, ks; };
struct Gemm { const bf16_t* A; const bf16_t* Bt; int lda, ldb, K; };
template <int mode> struct Sched {
    int nM, nN, nNv, nwg, G, c, K;
    __device__ void init(int M, int N, int nK, int K_, int G_, int c_) { nM = M / BM; nN = N / BM; nNv = nN * nK; nwg = nM * nNv; G = G_; c = c_; K = K_; }
    __device__ bool next(int i, Unit& u) const {
        const long L = (long)i * G + c; if (L >= nwg) return false;
        int wgid = (int)L; { const int q = nwg / NXCD, r = nwg % NXCD, xcd = wgid % NXCD, off = wgid / NXCD; wgid = (xcd < r ? xcd * (q + 1) : r * (q + 1) + (xcd - r) * q) + off; }
        const int nig = WGM * nNv, gid = wgid / nig, fm = gid * WGM, gsz = (nM - fm) < WGM ? (nM - fm) : WGM;
        u.pm = fm + ((wgid % nig) % gsz); const int pnv = (wgid % nig) / gsz; u.pn = pnv % nN; u.ks = pnv / nN; return true;
    }
    __device__ __forceinline__ size_t aoff(const Unit& u) const { if (mode == 1) { const int g = u.pn >> 2; return (size_t)(g < 2 ? 0 : (g < 4 ? 128 : 256)) * 2; } return (size_t)u.ks * K * 2; }
    __device__ __forceinline__ size_t boff(const Unit& u) const { return mode == 1 ? 0 : (size_t)u.ks * K * 2; }
};

__device__ __forceinline__ unsigned cvt_pk_bf16(float lo, float hi) { unsigned r; asm volatile("v_cvt_pk_bf16_f32 %0, %1, %2" : "=v"(r) : "v"(lo), "v"(hi)); return r; }

template <int ACT> struct EpiBf16 {
    static constexpr bool PERM = true;
    bf16_t* O; int ldc;
    __device__ __forceinline__ void operator()(const f32x4 (&acc)[2][2][4][2], const Unit& u, int wr, int wc, int fr, int fq) const {
        const int row0 = u.pm * BM + wr * 64 + fr; const int col0 = u.pn * BM + wc * 32 + 8 * fq;
#pragma unroll
        for (int ai = 0; ai < 2; ++ai)
#pragma unroll
            for (int m = 0; m < 4; ++m) { bf16_t* rowp = O + (size_t)(row0 + ai * HALF + m * 16) * ldc + col0;
#pragma unroll
                for (int bj = 0; bj < 2; ++bj) { f32x4 v0 = acc[ai][bj][m][0], v1 = acc[ai][bj][m][1];
                    if (ACT == 2) {
#pragma unroll
                        for (int e = 0; e < 4; ++e) { const float a = fmaxf(v0[e], 0.f), b = fmaxf(v1[e], 0.f); v0[e] = a * a; v1[e] = b * b; } }
                    u32x4 w; w.x = cvt_pk_bf16(v0[0], v0[1]); w.y = cvt_pk_bf16(v0[2], v0[3]); w.z = cvt_pk_bf16(v1[0], v1[1]); w.w = cvt_pk_bf16(v1[2], v1[3]);
                    *(u32x4*)(rowp + bj * HALF) = w; } }
    }
};
struct EpiF32 {
    static constexpr bool PERM = false;
    float* O; int ldc; size_t pstride;
    __device__ __forceinline__ void operator()(const f32x4 (&acc)[2][2][4][2], const Unit& u, int wr, int wc, int fr, int fq) const {
        float* base = O + (size_t)u.ks * pstride; const int col0 = u.pn * BM + wc * 32 + 4 * fq;
#pragma unroll
        for (int ai = 0; ai < 2; ++ai)
#pragma unroll
            for (int m = 0; m < 4; ++m) { float* rowp = base + (size_t)(u.pm * BM + ai * HALF + wr * 64 + m * 16 + fr) * ldc + col0;
#pragma unroll
                for (int bj = 0; bj < 2; ++bj)
#pragma unroll
                    for (int n = 0; n < 2; ++n) *(f32x4*)(rowp + bj * HALF + n * 16) = acc[ai][bj][m][n]; }
    }
};

template <class Epi, class SchedT>
__device__ __forceinline__ void gemm_phase(LAS unsigned char* lds, const Gemm g, const SchedT& S, const Epi& E) {
    int tid_ = threadIdx.x; asm volatile("" : "+v"(tid_));
    const int tid = tid_, wid = __builtin_amdgcn_readfirstlane(tid >> 6), lane = tid & 63, wr = wid >> 2, wc = wid & 3, fr = lane & 15, fq = lane >> 4;
    int K_ = g.K; asm volatile("" : "+s"(K_));
    const int K = K_, nt = K / BK;
    unsigned voffA[2], voffB[2];
#pragma unroll
    for (int i = 0; i < 2; ++i) { int R, C; stage_rc(tid * 16 + i * 8192, R, C); const int Rb = Epi::PERM ? ((R & ~31) + perm32(R & 31)) : R;
        voffA[i] = (unsigned)(R * g.lda + C) * 2u; voffB[i] = (unsigned)(Rb * g.ldb + C) * 2u; }
    const size_t kstep = (size_t)(BK * 2);
    const size_t hstepA = (size_t)HALF * g.lda * 2, hstepB = (size_t)HALF * g.ldb * 2;
    const size_t tstepA = 2 * hstepA, tstepB = 2 * hstepB;
    const unsigned ldsw = (unsigned)wid * 1024u;
    const int aoff = lds_byte(wr * 64 + fr, fq * 8), boff = lds_byte(wc * 32 + fr, fq * 8);
#define PG8_SA(b, h) (((b) * 2 + (h)) * HTB)
#define PG8_SB(b, h) ((4 + (b) * 2 + (h)) * HTB)
#define PG8_STAGE(bufoff, gbase, voff) do { _Pragma("unroll") for (int _i = 0; _i < 2; ++_i) \
        __builtin_amdgcn_global_load_lds((const unsigned*)((const char*)(gbase) + (voff)[_i]), (LAS unsigned*)(lds + (bufoff) + ldsw + _i * 8192), 16, 0, 0); } while (0)
#define PG8_LDA(dst, b, h) do { _Pragma("unroll") for (int m = 0; m < 4; ++m) _Pragma("unroll") for (int k = 0; k < 2; ++k) dst[m][k] = *(const LAS bf16x8*)(lds + PG8_SA(b, h) + aoff + m * 2048 + k * 1024); } while (0)
#define PG8_LDB(dst, b, h) do { _Pragma("unroll") for (int n = 0; n < 2; ++n) _Pragma("unroll") for (int k = 0; k < 2; ++k) dst[n][k] = *(const LAS bf16x8*)(lds + PG8_SB(b, h) + boff + n * 2048 + k * 1024); } while (0)
#define PG8_MMA(ai, bj, At, Bt) do { __builtin_amdgcn_s_setprio(1); _Pragma("unroll") for (int m = 0; m < 4; ++m) _Pragma("unroll") for (int n = 0; n < 2; ++n) _Pragma("unroll") for (int k = 0; k < 2; ++k) \
        acc[ai][bj][m][n] = __builtin_amdgcn_mfma_f32_16x16x32_bf16(Bt[n][k], At[m][k], acc[ai][bj][m][n], 0, 0, 0); __builtin_amdgcn_s_setprio(0); } while (0)
#define PG8_WAIT_V(n) asm volatile("s_waitcnt vmcnt(" #n ")" ::: "memory")
#define PG8_WAIT_L(n) asm volatile("s_waitcnt lgkmcnt(" #n ")" ::: "memory")
#define PG8_BAR __builtin_amdgcn_s_barrier()
#define PG8_SCHED __builtin_amdgcn_sched_barrier(0)
    Unit cur, nxt; int ui = 0;
    if (!S.next(0, cur)) return;
    f32x4 acc[2][2][4][2];
#pragma unroll
    for (int a = 0; a < 2; ++a)
#pragma unroll
        for (int b = 0; b < 2; ++b)
#pragma unroll
            for (int m = 0; m < 4; ++m)
#pragma unroll
                for (int n = 0; n < 2; ++n) acc[a][b][m][n] = (f32x4){0.f, 0.f, 0.f, 0.f};
    bf16x8 At[4][2], B0[2][2], B1[2][2];
    const char* cA = (const char*)g.A + (size_t)cur.pm * tstepA + S.aoff(cur); const char* cB = (const char*)g.Bt + (size_t)cur.pn * tstepB + S.boff(cur);
    PG8_STAGE(PG8_SB(0, 0), cB, voffB); PG8_STAGE(PG8_SB(0, 1), cB + hstepB, voffB); PG8_STAGE(PG8_SA(0, 0), cA, voffA); PG8_STAGE(PG8_SA(0, 1), cA + hstepA, voffA);
    if (wr == 1) PG8_BAR;
    PG8_WAIT_V(2); PG8_BAR;
    PG8_STAGE(PG8_SB(1, 0), cB + kstep, voffB); PG8_STAGE(PG8_SA(1, 0), cA + kstep, voffA); PG8_STAGE(PG8_SB(1, 1), cB + hstepB + kstep, voffB);
    PG8_WAIT_V(6); PG8_BAR;
    for (;;) {
        const bool has_next = S.next(ui + 1, nxt);
        const char* nA = has_next ? (const char*)g.A + (size_t)nxt.pm * tstepA + S.aoff(nxt) : cA; const char* nB = has_next ? (const char*)g.Bt + (size_t)nxt.pn * tstepB + S.boff(nxt) : cB;
        for (int t = 0; t < nt; t += 2) {
            const bool last = (t == nt - 2);
            const char* a1 = cA + (size_t)(t + 1) * kstep;
            const char* a2 = last ? nA : cA + (size_t)(t + 2) * kstep; const char* b2 = last ? nB : cB + (size_t)(t + 2) * kstep;
            const char* a3 = a2 + kstep; const char* b3 = b2 + kstep;
            PG8_LDB(B0, 0, 0); PG8_LDB(B1, 0, 1); PG8_SCHED; PG8_LDA(At, 0, 0); PG8_STAGE(PG8_SA(1, 1), a1 + hstepA, voffA);
            PG8_WAIT_V(8); PG8_WAIT_L(0); PG8_BAR; PG8_MMA(0, 0, At, B0); PG8_MMA(0, 1, At, B1); PG8_BAR; PG8_SCHED;
            PG8_LDA(At, 0, 1); PG8_STAGE(PG8_SB(0, 0), b2, voffB); PG8_STAGE(PG8_SB(0, 1), b2 + hstepB, voffB); PG8_STAGE(PG8_SA(0, 0), a2, voffA);
            PG8_WAIT_V(8); PG8_WAIT_L(0); PG8_BAR; PG8_MMA(1, 0, At, B0); PG8_MMA(1, 1, At, B1); PG8_BAR; PG8_SCHED;
            PG8_LDB(B0, 1, 0); PG8_LDB(B1, 1, 1); PG8_SCHED; PG8_LDA(At, 1, 0); PG8_STAGE(PG8_SA(0, 1), a2 + hstepA, voffA);
            PG8_WAIT_V(8); PG8_WAIT_L(0); PG8_BAR; PG8_MMA(0, 0, At, B0); PG8_MMA(0, 1, At, B1); PG8_BAR; PG8_SCHED;
            PG8_LDA(At, 1, 1); PG8_STAGE(PG8_SB(1, 0), b3, voffB); PG8_STAGE(PG8_SB(1, 1), b3 + hstepB, voffB); PG8_STAGE(PG8_SA(1, 0), a3, voffA);
            PG8_WAIT_V(8); PG8_WAIT_L(0); PG8_BAR; PG8_MMA(1, 0, At, B0); PG8_MMA(1, 1, At, B1); PG8_BAR; PG8_SCHED;
        }
        if (wr == 0) PG8_BAR;
        E(acc, cur, wr, wc, fr, fq);
        if (!has_next) break;
#pragma unroll
        for (int a = 0; a < 2; ++a)
#pragma unroll
            for (int b = 0; b < 2; ++b)
#pragma unroll
                for (int m = 0; m < 4; ++m)
#pragma unroll
                    for (int n = 0; n < 2; ++n) acc[a][b][m][n] = (f32x4){0.f, 0.f, 0.f, 0.f};
        cur = nxt; cA = nA; cB = nB; ++ui;
        if (wr == 1) PG8_BAR;
    }
    PG8_WAIT_V(0);
    PG8_BAR;
#undef PG8_SA
#undef PG8_SB
#undef PG8_STAGE
#undef PG8_LDA
#undef PG8_LDB
#undef PG8_MMA
#undef PG8_WAIT_V
#undef PG8_WAIT_L
#undef PG8_BAR
#undef PG8_SCHED
}
}

constexpr int LDS_BYTES = 147456;
#ifndef PH
#define PH 0xFFFF
#endif
struct Ctx { LAS unsigned char* lds; int tid, lane, wave, G, bid; };
__device__ __forceinline__ Ctx fresh_ctx(LAS unsigned char* lds) { Ctx C; int t = threadIdx.x; asm volatile("" : "+v"(t)); C.lds = lds; C.tid = t; C.lane = t & 63; C.wave = __builtin_amdgcn_readfirstlane(t >> 6); C.G = gridDim.x; C.bid = blockIdx.x; return C; }

__device__ __forceinline__ void phase_mod(const Params& P, const Ctx& C) {
    LAS float* sc = (LAS float*)C.lds; LAS float* red = sc + 5120;
    for (int i = C.tid; i < 5120; i += 512) { const int r = i >> 10, k = i & 1023; const float x = r == 0 ? P.in[I_CCTX][k] : P.in[I_C][(r - 1) * 1024 + k]; sc[i] = siluf_(x); }
    __syncthreads();
    float* MOD = (float*)(P.ws + WS_MOD);
    const int kg = C.tid >> 6, c = C.tid & 63;
    for (int tile = C.bid; tile < 384; tile += C.G) {
        const int l = tile / 96, col = (tile % 96) * 64 + c;
        const float* w = P.in[I_WMOD] + (size_t)l * 1024 * 6144 + col;
        float a0 = 0.f, a1 = 0.f, a2 = 0.f, a3 = 0.f, a4 = 0.f;
#pragma unroll 8
        for (int k = kg * 128; k < kg * 128 + 128; ++k) { const float wv = w[(size_t)k * 6144]; a0 += sc[k] * wv; a1 += sc[1024 + k] * wv; a2 += sc[2048 + k] * wv; a3 += sc[3072 + k] * wv; a4 += sc[4096 + k] * wv; }
        red[(kg * 5 + 0) * 64 + c] = a0; red[(kg * 5 + 1) * 64 + c] = a1; red[(kg * 5 + 2) * 64 + c] = a2; red[(kg * 5 + 3) * 64 + c] = a3; red[(kg * 5 + 4) * 64 + c] = a4;
        __syncthreads();
        if (C.tid < 320) { const int r = C.tid >> 6; float s = 0.f;
#pragma unroll
            for (int q = 0; q < 8; ++q) s += red[(q * 5 + r) * 64 + c];
            MOD[(size_t)(l * 5 + r) * 6144 + col] = s + P.in[I_BMOD][l * 6144 + col]; }
        __syncthreads();
    }
}

__device__ __forceinline__ void transpose_item(const float* W, int K, int N, bf16_t* WT, LAS float* scr, int item, int nblk, int lane) {
    const int kb = item / nblk, nb = item % nblk, k0 = 64 * kb, n0 = 32 * nb;
    const bool nok = (n0 + (lane & 31)) < N;
#pragma unroll 8
    for (int i = 0; i < 32; ++i) { const int kk = 2 * i + (lane >> 5); scr[kk * 33 + (lane & 31)] = nok ? W[(size_t)(k0 + kk) * N + n0 + (lane & 31)] : 0.f; }
    asm volatile("s_waitcnt lgkmcnt(0)" ::: "memory");
    const int c = lane & 7;
#pragma unroll
    for (int j = 0; j < 4; ++j) { const int n = (lane >> 3) + 8 * j; const LAS float* s = scr + (8 * c) * 33 + n;
        u32x4 o; o.x = pk2(s[0 * 33], s[1 * 33]); o.y = pk2(s[2 * 33], s[3 * 33]); o.z = pk2(s[4 * 33], s[5 * 33]); o.w = pk2(s[6 * 33], s[7 * 33]);
        *(u32x4*)(WT + (size_t)(n0 + n) * K + k0 + 8 * c) = o; }
    asm volatile("s_waitcnt lgkmcnt(0)" ::: "memory");
}
__device__ __forceinline__ void phase_convert(const Params& P, const Ctx& C, int l) {
    LAS float* scr = (LAS float*)(C.lds + 32768 + C.wave * 8704);
    const int gw = C.bid * 8 + C.wave, NGW = C.G * 8; const int j = l >> 1; const bool ev = (l & 1) == 0;
    const float* win = ev ? P.in[I_WINAB] + (size_t)j * 1024 * N_AB : P.in[I_WINCD] + (size_t)j * 1024 * N_CD;
    const float* wout = (ev ? P.in[I_WOUTAB] : P.in[I_WOUTCD]) + (size_t)j * 2048 * 1024;
    const float* wup = P.in[I_WUP] + (size_t)l * 1024 * 4096; const float* wdn = P.in[I_WDN] + (size_t)l * 4096 * 1024;
    const int N_in = ev ? N_AB : N_CD, Np = ev ? N_AB_P : N_CD_P;
    const int I0 = 16 * (Np / 32), I1 = 32 * 32, I2 = 16 * 128, I3 = 64 * 32;
    for (int it = gw; it < I0 + I1 + I2 + I3; it += NGW) {
        int r = it;
        if (r < I0) { transpose_item(win, 1024, N_in, (bf16_t*)(P.ws + WS_WIN), scr, r, Np / 32, C.lane); continue; } r -= I0;
        if (r < I1) { transpose_item(wout, 2048, 1024, (bf16_t*)(P.ws + WS_WOUT), scr, r, 32, C.lane); continue; } r -= I1;
        if (r < I2) { transpose_item(wup, 1024, 4096, (bf16_t*)(P.ws + WS_WUP), scr, r, 128, C.lane); continue; } r -= I2;
        transpose_item(wdn, 4096, 1024, (bf16_t*)(P.ws + WS_WDN), scr, r, 32, C.lane);
    }
    if (ev) {
        bf16_t* WL = (bf16_t*)(P.ws + WS_WLORA);
        for (int idx = C.bid * 512 + C.tid; idx < 5120 * 16; idx += C.G * 512) {
            const int n = idx % 5120, k8 = idx / 5120, g = n >> 10, cc = n & 1023; float o[8];
#pragma unroll
            for (int e = 0; e < 8; ++e) { const int k = k8 * 8 + e; float v = 0.f;
                if (g == 0) { if (k < 64) v = P.in[I_W2][((size_t)(j * 2 + 0) * 64 + k) * 1024 + cc]; }
                else if (g == 1) { if (k >= 64) v = P.in[I_W2][((size_t)(j * 2 + 1) * 64 + (k - 64)) * 1024 + cc]; }
                else if (g == 2) { if (k < 64) v = P.in[I_A2][((size_t)(j * 2 + 0) * 64 + k) * 1024 + cc]; }
                else if (g == 3) { if (k >= 64) v = P.in[I_A2][((size_t)(j * 2 + 1) * 64 + (k - 64)) * 1024 + cc]; }
                else v = P.in[I_G2][((size_t)j * 128 + k) * 1024 + cc];
                o[e] = v; }
            *(u32x4*)(WL + (size_t)n * 128 + k8 * 8) = pack8(o);
        }
    }
}

__device__ __forceinline__ void phase_rows(const Params& P, const Ctx& C, int mode, const float* gpost, const float* gate_mod  ,
                                           bool next, const float* gpre, const float* mod_next  ) {
    float* X = P.out + O_X; const float* MP0 = (const float*)(P.ws + WS_MP); const float* MP1 = MP0 + (size_t)MTOK * DM; bf16_t* H = (bf16_t*)(P.ws + WS_H);
    const int gw = C.bid * 8 + C.wave, NGW = C.G * 8;
    for (int m = gw; m < MTOK; m += NGW) {
        const int mr = m < 4096 ? 0 : 1 + ((m - 4096) >> 10);
        f32x4 x[4];
        if (mode == 0) { const f32x4* src = (const f32x4*)(m < 4096 ? P.in[I_XP] + (size_t)m * DM : P.in[I_XS] + (size_t)(m - 4096) * DM) + C.lane;
#pragma unroll
            for (int j = 0; j < 4; ++j) x[j] = src[64 * j];
        } else {
            const f32x4* xs = (const f32x4*)(X + (size_t)m * DM) + C.lane; const f32x4* p0 = (const f32x4*)(MP0 + (size_t)m * DM) + C.lane; const f32x4* p1 = (const f32x4*)(MP1 + (size_t)m * DM) + C.lane;
            f32x4 f[4]; float ss = 0.f;
#pragma unroll
            for (int j = 0; j < 4; ++j) { x[j] = xs[64 * j]; f[j] = p0[64 * j] + p1[64 * j]; ss += (f[j].x * f[j].x + f[j].y * f[j].y) + (f[j].z * f[j].z + f[j].w * f[j].w); }
            const float rs = rsqrtf(wave_sum(ss) * (1.f / DM) + 1e-6f);
            const f32x4* gp = (const f32x4*)gpost + C.lane; const f32x4* gt = (const f32x4*)(gate_mod + (size_t)mr * 6144) + C.lane;
#pragma unroll
            for (int j = 0; j < 4; ++j) x[j] = x[j] + gt[64 * j] * (f[j] * rs * gp[64 * j]);
        }
        f32x4* xo = (f32x4*)(X + (size_t)m * DM) + C.lane;
#pragma unroll
        for (int j = 0; j < 4; ++j) xo[64 * j] = x[j];
        if (next) {
            float ss = 0.f;
#pragma unroll
            for (int j = 0; j < 4; ++j) ss += (x[j].x * x[j].x + x[j].y * x[j].y) + (x[j].z * x[j].z + x[j].w * x[j].w);
            const float rs = rsqrtf(wave_sum(ss) * (1.f / DM) + 1e-6f);
            const f32x4* gp = (const f32x4*)gpre + C.lane; const f32x4* sh = (const f32x4*)(mod_next + (size_t)mr * 6144) + C.lane; const f32x4* sl = (const f32x4*)(mod_next + (size_t)mr * 6144 + 1024) + C.lane;
            u32x2* ho = (u32x2*)(H + (size_t)m * DM) + C.lane;
#pragma unroll
            for (int j = 0; j < 4; ++j) { const f32x4 h = (x[j] * rs * gp[64 * j]) * (sl[64 * j] + 1.f) + sh[64 * j]; u32x2 w; w.x = pk2(h.x, h.y); w.y = pk2(h.z, h.w); ho[64 * j] = w; }
        }
    }
}

__device__ __forceinline__ void conv8(const bf16_t* src, int ld, int col0, int base, int t, bool samp, const float* w, const float* b, int NC, int ch, float* acc) {
    { const f32x4 b0 = *(const f32x4*)(b + ch), b1 = *(const f32x4*)(b + ch + 4); acc[0] = b0.x; acc[1] = b0.y; acc[2] = b0.z; acc[3] = b0.w; acc[4] = b1.x; acc[5] = b1.y; acc[6] = b1.z; acc[7] = b1.w; }
    if (!samp) {
#pragma unroll
        for (int d = 0; d < 3; ++d) { const int tt = t + d - 1; if (tt < 0 || tt >= 256) continue;
            float xv[8]; unpack8(*(const u32x4*)(src + (size_t)(base + tt) * ld + col0 + ch), xv);
            const f32x4 w0 = *(const f32x4*)(w + (3 + d) * NC + ch), w1 = *(const f32x4*)(w + (3 + d) * NC + ch + 4);
            acc[0] += w0.x * xv[0]; acc[1] += w0.y * xv[1]; acc[2] += w0.z * xv[2]; acc[3] += w0.w * xv[3]; acc[4] += w1.x * xv[4]; acc[5] += w1.y * xv[5]; acc[6] += w1.z * xv[6]; acc[7] += w1.w * xv[7]; }
    } else {
        const int r = t >> 6, c = t & 63;
#pragma unroll
        for (int i = 0; i < 3; ++i)
#pragma unroll
            for (int d = 0; d < 3; ++d) { const int rr = r + i - 1, cc = c + d - 1; if (rr < 0 || rr >= 16 || cc < 0 || cc >= 64) continue;
                float xv[8]; unpack8(*(const u32x4*)(src + (size_t)(base + rr * 64 + cc) * ld + col0 + ch), xv);
                const f32x4 w0 = *(const f32x4*)(w + (i * 3 + d) * NC + ch), w1 = *(const f32x4*)(w + (i * 3 + d) * NC + ch + 4);
                acc[0] += w0.x * xv[0]; acc[1] += w0.y * xv[1]; acc[2] += w0.z * xv[2]; acc[3] += w0.w * xv[3]; acc[4] += w1.x * xv[4]; acc[5] += w1.y * xv[5]; acc[6] += w1.z * xv[6]; acc[7] += w1.w * xv[7]; }
    }
}

__device__ __forceinline__ void phase_prep_even(const Params& P, const Ctx& C, int j) {
    const bf16_t* PROJ = (const bf16_t*)(P.ws + WS_PROJ); bf16_t* PREP = (bf16_t*)(P.ws + WS_PREP); bf16_t* LA = (bf16_t*)(P.ws + WS_LORAA);
    float* DT = (float*)(P.ws + WS_DT); float* DA = (float*)(P.ws + WS_DA);
    const float* cw = P.in[I_SCONVW] + (size_t)j * 9 * 2048; const float* cb = P.in[I_SCONVB] + j * 2048;
    const float* mu = P.in[I_MU] + j * 3456; const float* kkw = P.in[I_KK] + j * 1024;
    const int gw = C.bid * 8 + C.wave, NGW = C.G * 8, lane = C.lane;
    for (int m = gw; m < MTOK; m += NGW) {
        const bool samp = m >= 4096; const int T = samp ? 1024 : 256; const int t = samp ? ((m - 4096) & 1023) : (m & 255); const int base = m - t;
        const bf16_t* prow = PROJ + (size_t)m * PROJ_LD_AB; bf16_t* orow = PREP + (size_t)m * PREP_LD;
#pragma unroll 1
        for (int it = 0; it < 4; ++it) { const int ch = it * 512 + lane * 8; float acc[8];
            conv8(PROJ, PROJ_LD_AB, 1024, base, t, samp, cw, cb, 2048, ch, acc);
#pragma unroll
            for (int e = 0; e < 8; ++e) acc[e] = siluf_(acc[e]);
            *(u32x4*)(orow + ch) = pack8(acc); }
#pragma unroll
        for (int it = 0; it < 2; ++it) { const int ch = it * 512 + lane * 8; float z[8]; unpack8(*(const u32x4*)(prow + ch), z);
#pragma unroll
            for (int e = 0; e < 8; ++e) z[e] = siluf_(z[e]);
            *(u32x4*)(orow + 2048 + ch) = pack8(z); }
        if (lane < 32) { const float raw = bf2f(prow[3072 + lane]); const float dt = softplusf_(raw + P.in[I_DTB][j * 32 + lane]);
            DT[(size_t)m * 32 + lane] = dt; DA[(size_t)m * 32 + lane] = __expf(-dt * __expf(P.in[I_ALOG][j * 32 + lane])); }
        const bool hp = t > 0, hn = t < T - 1;
#pragma unroll 1
        for (int it = 0; it < 7; ++it) { const int c = it * 512 + lane * 8; if (c >= 3456) break;
            float x[8], xp[8], xn[8];
            unpack8(*(const u32x4*)(prow + IN_SSD + c), x);
            if (hp) unpack8(*(const u32x4*)(prow - PROJ_LD_AB + IN_SSD + c), xp); else {
#pragma unroll
                for (int e = 0; e < 8; ++e) xp[e] = 0.f; }
            if (hn) unpack8(*(const u32x4*)(prow + PROJ_LD_AB + IN_SSD + c), xn); else {
#pragma unroll
                for (int e = 0; e < 8; ++e) xn[e] = 0.f; }
            const f32x4 m0 = *(const f32x4*)(mu + c), m1 = *(const f32x4*)(mu + c + 4);
            const float mv[8] = {m0.x, m0.y, m0.z, m0.w, m1.x, m1.y, m1.z, m1.w};
#pragma unroll
            for (int e = 0; e < 8; ++e) x[e] = x[e] + mv[e] * (0.5f * (xp[e] + xn[e]) - x[e]);
            if (it < 2) { *(u32x4*)(orow + 3072 + c) = pack8(x); }
            else if (it < 4) { *(u32x4*)(orow + 4096 + (c - 1024)) = pack8(x);
                const f32x4 k0 = *(const f32x4*)(kkw + c - 1024), k1 = *(const f32x4*)(kkw + c - 1024 + 4);
                const float kv[8] = {k0.x, k0.y, k0.z, k0.w, k1.x, k1.y, k1.z, k1.w}; float ss = 0.f;
#pragma unroll
                for (int e = 0; e < 8; ++e) { x[e] *= kv[e]; ss += x[e] * x[e]; }
                ss += __shfl_xor(ss, 1); ss += __shfl_xor(ss, 2); ss += __shfl_xor(ss, 4);
                const float rn = rsqrtf(ss + 1e-12f);
#pragma unroll
                for (int e = 0; e < 8; ++e) x[e] *= rn;
                *(u32x4*)(orow + 6144 + (c - 1024)) = pack8(x); }
            else if (it < 6) { *(u32x4*)(orow + 5120 + (c - 2048)) = pack8(x); }
            else { const int cc = c - 3072;
#pragma unroll
                for (int e = 0; e < 8; ++e) x[e] = cc < 128 ? tanhf_(x[e]) : (cc < 256 ? x[e] : sigmoidf_(x[e]));
                *(u32x4*)(LA + (size_t)m * LORA_K + cc) = pack8(x); }
        }
    }
}
__device__ __forceinline__ void phase_prep_odd(const Params& P, const Ctx& C, int j) {
    const bf16_t* PROJ = (const bf16_t*)(P.ws + WS_PROJ); bf16_t* PREP = (bf16_t*)(P.ws + WS_PREP);
    const float* cw = P.in[I_MCONVW] + (size_t)j * 9 * 1024; const float* cb = P.in[I_MCONVB] + j * 1024;
    const int gw = C.bid * 8 + C.wave, NGW = C.G * 8, lane = C.lane;
    for (int m = gw; m < MTOK; m += NGW) {
        const bool samp = m >= 4096; const int t = samp ? ((m - 4096) & 1023) : (m & 255); const int base = m - t;
#pragma unroll 1
        for (int it = 0; it < 2; ++it) { const int ch = it * 512 + lane * 8; float acc[8];
            conv8(PROJ, PROJ_LD_CD, IN_GLA, base, t, samp, cw, cb, 1024, ch, acc);
#pragma unroll
            for (int e = 0; e < 8; ++e) acc[e] = siluf_(acc[e]);
            *(u32x4*)(PREP + (size_t)m * PREP_LD + ch) = pack8(acc); }
    }
}

template <int MODE>
__device__ __forceinline__ void diag_scan(const Params& P, const Ctx& C, int j, int s, int h, int dir_in, int vh) {
    const int tid = C.tid;
    const int dir = MODE == 0 ? (tid >> 8) : dir_in;
    const int tl = MODE == 0 ? (tid & 255) : tid;
    const int vl = tl >> 2, ks = tl & 3;
    const int T = s < 16 ? 256 : 1024, base = s < 16 ? s * 256 : 4096 + (s - 16) * 1024, nch = T >> 4;
    const bf16_t* PROJ = (const bf16_t*)(P.ws + WS_PROJ); const bf16_t* PREP = (const bf16_t*)(P.ws + WS_PREP);
    bf16_t* Y = (bf16_t*)(P.ws + WS_MP) + (size_t)dir * MTOK * YLD;
    constexpr int QO = 0, KO = 2048, AO = 4096;
    constexpr int VO = MODE == 1 ? 6144 : 4096;
    constexpr int SO = MODE == 0 ? 5120 : (MODE == 1 ? 8192 : 6144);
    constexpr int BUFSZ = MODE == 0 ? 5184 : (MODE == 1 ? 8192 : 6208);
    LAS float* L0 = (LAS float*)C.lds + (MODE == 0 ? (tid >> 8) * 2 * BUFSZ : 0);
    LAS float* GW = (LAS float*)C.lds + 2 * 8192;
    const int stt = MODE == 0 ? (tl >> 4) : (tl >> 5);
    const int sc8 = (tl & 15) * 8, sc4 = MODE == 0 ? (tl & 15) * 4 : (tl & 31) * 4;
    if (MODE == 1) {
        const float* gwp = P.in[I_GGW] + (size_t)(j * 2 + dir) * 16 * 512 + h * 128;
        for (int i = tid; i < 16 * 128; i += 512) GW[i] = gwp[(i >> 7) * 512 + (i & 127)];
        if (tid < 128) GW[2048 + tid] = P.in[I_GGB][(j * 2 + dir) * 512 + h * 128 + tid];
    }
    float S[32]; float N[MODE == 2 ? 32 : 1]; float mst = 0.f;
    {
        const float* s0 = nullptr; int vstride = 1, kstride = 64;
        if (s >= 16) { const int b = s - 16;
            if (MODE == 0) { s0 = P.in[I_SSSD] + ((size_t)((b * 2 + j) * 2 + dir) * 16 + h) * 8192 + vl; kstride = 64; }
            if (MODE == 1) { s0 = P.in[I_SGLA] + ((size_t)((b * 2 + j) * 2 + dir) * 4 + h) * 32768 + vh * 128 + vl; kstride = 256; }
            if (MODE == 2) { s0 = P.in[I_SMC] + ((size_t)((b * 2 + j) * 2 + dir) * 4 + h) * 32768 + vh * 128 + vl; kstride = 256; } }
        (void)vstride;
#pragma unroll
        for (int i = 0; i < 32; ++i) { const int k = 16 * (i >> 2) + 4 * ks + (i & 3); S[i] = s0 ? s0[(size_t)k * kstride] : 0.f; }
        if (MODE == 2) {
#pragma unroll
            for (int i = 0; i < 32; ++i) { const int k = 16 * (i >> 2) + 4 * ks + (i & 3); N[i] = s >= 16 ? P.in[I_SMN][((size_t)(((s - 16) * 2 + j) * 2 + dir) * 4 + h) * 128 + k] : 0.f; }
            mst = s >= 16 ? P.in[I_SMM][(((s - 16) * 2 + j) * 2 + dir) * 4 + h] : 0.f;
        }
    }
    u32x4 rq8, rk8; u32x2 rq4, rk4, rv4; u32x4 rg0, rg1; float rs0 = 0.f, rs1 = 0.f;
    auto load_raw = [&](int c) {
        const int step = c * 16 + stt; const int m = base + (dir ? (T - 1 - step) : step);
        if (MODE == 0) { const int g = h >> 2; const bf16_t* pr = PREP + (size_t)m * PREP_LD;
            rq8 = *(const u32x4*)(pr + 1536 + g * 128 + sc8); rk8 = *(const u32x4*)(pr + 1024 + g * 128 + sc8); rv4 = *(const u32x2*)(pr + h * 64 + sc4);
            rs0 = ((const float*)(P.ws + WS_DT))[(size_t)m * 32 + dir * 16 + h]; rs1 = ((const float*)(P.ws + WS_DA))[(size_t)m * 32 + dir * 16 + h]; }
        if (MODE == 1) { const bf16_t* pr = PROJ + (size_t)m * PROJ_LD_CD;
            rq4 = *(const u32x2*)(pr + h * 128 + sc4); rk4 = *(const u32x2*)(pr + 512 + h * 128 + sc4); rv4 = *(const u32x2*)(pr + 1024 + h * 256 + vh * 128 + sc4);
            rg0 = *(const u32x4*)(pr + 3072 + dir * 16); rg1 = *(const u32x4*)(pr + 3072 + dir * 16 + 8); }
        if (MODE == 2) { const bf16_t* pr = PROJ + (size_t)m * PROJ_LD_CD; const bf16_t* pp = PREP + (size_t)m * PREP_LD;
            rq4 = *(const u32x2*)(pp + h * 128 + sc4); rk4 = *(const u32x2*)(pp + 512 + h * 128 + sc4); rv4 = *(const u32x2*)(pr + IN_GLA + 1024 + h * 256 + vh * 128 + sc4);
            rs0 = bf2f(pr[IN_GLA + 3072 + dir * 4 + h]); rs1 = bf2f(pr[IN_GLA + 3072 + 8 + dir * 4 + h]); }
    };
    auto write_lds = [&](LAS float* B) {
        if (MODE == 0) { float q[8], k[8]; unpack8(rq8, q); unpack8(rk8, k);
            *(LAS f32x4*)(B + QO + stt * 128 + sc8) = (f32x4){q[0], q[1], q[2], q[3]}; *(LAS f32x4*)(B + QO + stt * 128 + sc8 + 4) = (f32x4){q[4], q[5], q[6], q[7]};
            *(LAS f32x4*)(B + KO + stt * 128 + sc8) = (f32x4){k[0], k[1], k[2], k[3]}; *(LAS f32x4*)(B + KO + stt * 128 + sc8 + 4) = (f32x4){k[4], k[5], k[6], k[7]};
            *(LAS f32x4*)(B + VO + stt * 64 + sc4) = unpack4(rv4) * rs0;
            if ((tl & 15) == 0) B[SO + stt] = rs1; }
        if (MODE == 1) {
            *(LAS f32x4*)(B + QO + stt * 128 + sc4) = unpack4(rq4) * 0.08838834764831845f; *(LAS f32x4*)(B + KO + stt * 128 + sc4) = unpack4(rk4);
            *(LAS f32x4*)(B + VO + stt * 128 + sc4) = unpack4(rv4);
            float gd[16]; unpack8(rg0, gd); unpack8(rg1, gd + 8);
            f32x4 gp = *(LAS f32x4*)(GW + 2048 + sc4);
#pragma unroll
            for (int r = 0; r < 16; ++r) gp = gp + *(LAS f32x4*)(GW + r * 128 + sc4) * gd[r];
            f32x4 a;
#pragma unroll
            for (int e = 0; e < 4; ++e) a[e] = __expf(logsigmoidf_(gp[e]) * 0.0625f);
            *(LAS f32x4*)(B + AO + stt * 128 + sc4) = a; }
        if (MODE == 2) {
            *(LAS f32x4*)(B + QO + stt * 128 + sc4) = unpack4(rq4); *(LAS f32x4*)(B + KO + stt * 128 + sc4) = unpack4(rk4) * 0.08838834764831845f;
            *(LAS f32x4*)(B + VO + stt * 128 + sc4) = unpack4(rv4);
            if ((tl & 31) == 0) { B[SO + stt * 2] = rs0 + P.in[I_MIB][(j * 2 + dir) * 4 + h]; B[SO + stt * 2 + 1] = logsigmoidf_(rs1 + P.in[I_MFB][(j * 2 + dir) * 4 + h]); } }
    };
    __syncthreads();
    load_raw(0); write_lds(L0);
    __syncthreads();
    const int ycol = MODE == 0 ? h * 64 + vl : (MODE == 1 ? h * 256 + vh * 128 + vl : 1024 + h * 256 + vh * 128 + vl);
    constexpr int VW = MODE == 0 ? 64 : 128;
    for (int c = 0; c < nch; ++c) {
        LAS float* B = L0 + (c & 1) * BUFSZ;
        if (c + 1 < nch) load_raw(c + 1);
#pragma unroll 2
        for (int tt = 0; tt < 16; ++tt) {
            const int step = c * 16 + tt; const int m = base + (dir ? (T - 1 - step) : step);
            float vv = B[VO + tt * VW + vl];
            float dec = 1.f, rden = 1.f, acc0 = 0.f, acc1 = 0.f, den = 0.f;
            if (MODE == 0) dec = B[SO + tt];
            if (MODE == 2) { const float ig = B[SO + tt * 2], lf = B[SO + tt * 2 + 1]; const float mn = fmaxf(lf + mst, ig); dec = __expf(lf + mst - mn); const float an = __expf(ig - mn); vv *= an; rden = an; mst = mn; }
#pragma unroll
            for (int i4 = 0; i4 < 8; ++i4) {
                const f32x4 q4 = *(LAS f32x4*)(B + QO + tt * 128 + 16 * i4 + 4 * ks), k4 = *(LAS f32x4*)(B + KO + tt * 128 + 16 * i4 + 4 * ks);
                f32x4 a4 = (f32x4){dec, dec, dec, dec}; if (MODE == 1) a4 = *(LAS f32x4*)(B + AO + tt * 128 + 16 * i4 + 4 * ks);
#pragma unroll
                for (int e = 0; e < 4; ++e) { const int i = i4 * 4 + e;
                    S[i] = S[i] * a4[e] + k4[e] * vv;
                    if (e & 1) acc1 += S[i] * q4[e]; else acc0 += S[i] * q4[e];
                    if (MODE == 2) { N[i] = N[i] * dec + k4[e] * rden; den += N[i] * q4[e]; } }
            }
            float o = quad_sum(acc0 + acc1);
            if (MODE == 2) { den = quad_sum(den); o = o / fmaxf(fabsf(den), __expf(-mst)); }
            if (ks == 0) Y[(size_t)m * YLD + ycol] = (bf16_t)f2bf(o);
        }
        if (c + 1 < nch) write_lds(L0 + ((c + 1) & 1) * BUFSZ);
        __syncthreads();
    }
    if (s < 16) {
        if (MODE == 0) { float* o = P.out + O_SSD + ((size_t)((s * 2 + j) * 2 + dir) * 16 + h) * 8192 + vl;
#pragma unroll
            for (int i = 0; i < 32; ++i) { const int k = 16 * (i >> 2) + 4 * ks + (i & 3); o[(size_t)k * 64] = S[i]; } }
        else { float* o = P.out + (MODE == 1 ? O_GLA : O_MC) + ((size_t)((s * 2 + j) * 2 + dir) * 4 + h) * 32768 + vh * 128 + vl;
#pragma unroll
            for (int i = 0; i < 32; ++i) { const int k = 16 * (i >> 2) + 4 * ks + (i & 3); o[(size_t)k * 256] = S[i]; }
            if (MODE == 2 && vh == 0 && vl == 0) {
#pragma unroll
                for (int i = 0; i < 32; ++i) { const int k = 16 * (i >> 2) + 4 * ks + (i & 3); P.out[O_MN + ((size_t)((s * 2 + j) * 2 + dir) * 4 + h) * 128 + k] = N[i]; }
                if (ks == 0) P.out[O_MM + ((s * 2 + j) * 2 + dir) * 4 + h] = mst; } }
    }
}

__device__ __forceinline__ void rwkv_scan(const Params& P, const Ctx& C, int j, int s, int h) {
    const int tid = C.tid, dir = tid >> 8, tl = tid & 255, vl = tl >> 2, ks = tl & 3;
    const int T = s < 16 ? 256 : 1024, base = s < 16 ? s * 256 : 4096 + (s - 16) * 1024, nch = T >> 4;
    const bf16_t* PREP = (const bf16_t*)(P.ws + WS_PREP); const bf16_t* LOUT = (const bf16_t*)(P.ws + WS_PROJ);
    bf16_t* Y = (bf16_t*)(P.ws + WS_MP) + (size_t)dir * MTOK * YLD;
    constexpr int BUFSZ = 6 * 1024;
    LAS float* L0 = (LAS float*)C.lds + dir * 2 * BUFSZ;
    const int stt = tl >> 4, sc4 = (tl & 15) * 4;
    const f32x4 w0 = *(const f32x4*)(P.in[I_W0] + (j * 2 + dir) * 1024 + h * 64 + sc4), a0 = *(const f32x4*)(P.in[I_A0] + (j * 2 + dir) * 1024 + h * 64 + sc4), ka = *(const f32x4*)(P.in[I_KA] + j * 1024 + h * 64 + sc4);
    float S[16];
    { const float* s0 = s >= 16 ? P.in[I_SRWKV] + (((size_t)(((s - 16) * 2 + j) * 2 + dir) * 16 + h) * 64 + vl) * 64 : nullptr;
#pragma unroll
        for (int i4 = 0; i4 < 4; ++i4) { const f32x4 v = s0 ? *(const f32x4*)(s0 + 16 * i4 + 4 * ks) : (f32x4){0.f, 0.f, 0.f, 0.f}; S[i4 * 4] = v.x; S[i4 * 4 + 1] = v.y; S[i4 * 4 + 2] = v.z; S[i4 * 4 + 3] = v.w; } }
    u32x2 rr, rk, rv, rkk, rwl, ral;
    auto load_raw = [&](int c) {
        const int step = c * 16 + stt; const int m = base + (dir ? (T - 1 - step) : step);
        const bf16_t* pp = PREP + (size_t)m * PREP_LD + h * 64 + sc4; const bf16_t* lo = LOUT + (size_t)m * LOUT_LD + dir * 1024 + h * 64 + sc4;
        rr = *(const u32x2*)(pp + 3072); rk = *(const u32x2*)(pp + 4096); rv = *(const u32x2*)(pp + 5120); rkk = *(const u32x2*)(pp + 6144);
        rwl = *(const u32x2*)lo; ral = *(const u32x2*)(lo + 2048);
    };
    auto write_lds = [&](LAS float* B) {
        const f32x4 r = unpack4(rr), k = unpack4(rk), v = unpack4(rv), kk = unpack4(rkk), wl = unpack4(rwl), al = unpack4(ral);
        f32x4 w, kd, kka;
#pragma unroll
        for (int e = 0; e < 4; ++e) { const float wp = w0[e] + wl[e]; const float lw = -__expf(-softplusf_(-wp) - 0.5f); w[e] = __expf(lw);
            const float a = sigmoidf_(a0[e] + al[e]); kd[e] = k[e] * (1.f + (a - 1.f) * ka[e]); kka[e] = kk[e] * a; }
        LAS float* p = B + stt * 64 + sc4;
        *(LAS f32x4*)(p) = r; *(LAS f32x4*)(p + 1024) = w; *(LAS f32x4*)(p + 2048) = kd; *(LAS f32x4*)(p + 3072) = v; *(LAS f32x4*)(p + 4096) = kk; *(LAS f32x4*)(p + 5120) = kka;
    };
    __syncthreads();
    load_raw(0); write_lds(L0);
    __syncthreads();
    const int ycol = 1024 + h * 64 + vl;
    for (int c = 0; c < nch; ++c) {
        LAS float* B = L0 + (c & 1) * BUFSZ;
        if (c + 1 < nch) load_raw(c + 1);
#pragma unroll 2
        for (int tt = 0; tt < 16; ++tt) {
            const int step = c * 16 + tt; const int m = base + (dir ? (T - 1 - step) : step);
            LAS float* p = B + tt * 64 + 4 * ks;
            const float vv = B[3072 + tt * 64 + vl];
            f32x4 kk4[4]; float d0 = 0.f, d1 = 0.f;
#pragma unroll
            for (int i4 = 0; i4 < 4; ++i4) { kk4[i4] = *(LAS f32x4*)(p + 4096 + 16 * i4); d0 += S[i4 * 4] * kk4[i4].x + S[i4 * 4 + 2] * kk4[i4].z; d1 += S[i4 * 4 + 1] * kk4[i4].y + S[i4 * 4 + 3] * kk4[i4].w; }
            const float sk = quad_sum(d0 + d1);
            float y0 = 0.f, y1 = 0.f;
#pragma unroll
            for (int i4 = 0; i4 < 4; ++i4) { const f32x4 w4 = *(LAS f32x4*)(p + 1024 + 16 * i4), kd4 = *(LAS f32x4*)(p + 2048 + 16 * i4), ka4 = *(LAS f32x4*)(p + 5120 + 16 * i4), r4 = *(LAS f32x4*)(p + 16 * i4);
#pragma unroll
                for (int e = 0; e < 4; ++e) { const int i = i4 * 4 + e; S[i] = S[i] * w4[e] - sk * ka4[e] + vv * kd4[e]; if (e & 1) y1 += S[i] * r4[e]; else y0 += S[i] * r4[e]; } }
            const float y = quad_sum(y0 + y1);
            if (ks == 0) Y[(size_t)m * YLD + ycol] = (bf16_t)f2bf(y);
        }
        if (c + 1 < nch) write_lds(L0 + ((c + 1) & 1) * BUFSZ);
        __syncthreads();
    }
    if (s < 16) { float* o = P.out + O_RWKV + (((size_t)((s * 2 + j) * 2 + dir) * 16 + h) * 64 + vl) * 64;
#pragma unroll
        for (int i4 = 0; i4 < 4; ++i4) *(f32x4*)(o + 16 * i4 + 4 * ks) = (f32x4){S[i4 * 4], S[i4 * 4 + 1], S[i4 * 4 + 2], S[i4 * 4 + 3]}; }
}

__device__ __forceinline__ void phase_scan(const Params& P, const Ctx& C, int l) {
    const int j = l >> 1; const bool ev = (l & 1) == 0;
    for (int round = 0; round < 8; ++round) {
        int q;
        if (C.G == 256) { if (C.bid < 128) { if (round > 0) break; q = C.bid; } else { if (round > 3) break; q = 128 + (C.bid - 128) * 4 + round; } }
        else { q = C.bid + round * C.G; if (q >= 640) break; }
        int type, idx, s;
        if (q < 128) { type = q >> 6; idx = q & 63; s = 16 + (idx >> 4); idx &= 15; }
        else { const int r = q - 128; type = r >> 8; idx = r & 255; s = idx >> 4; idx &= 15; }
        if (ev) { if (type == 0) diag_scan<0>(P, C, j, s, idx, 0, 0); else rwkv_scan(P, C, j, s, idx); }
        else { const int dir = idx >> 3, h = (idx >> 1) & 3, vh = idx & 1; if (type == 0) diag_scan<1>(P, C, j, s, h, dir, vh); else diag_scan<2>(P, C, j, s, h, dir, vh); }
    }
}

__device__ __forceinline__ void ld16(const bf16_t* p, float* o) { unpack8(*(const u32x4*)p, o); unpack8(*(const u32x4*)(p + 8), o + 8); }
__device__ __forceinline__ void ld16f(const float* p, float* o) {
#pragma unroll
    for (int q = 0; q < 4; ++q) { const f32x4 v = *(const f32x4*)(p + 4 * q); o[4 * q] = v.x; o[4 * q + 1] = v.y; o[4 * q + 2] = v.z; o[4 * q + 3] = v.w; } }
__device__ __forceinline__ void st16(bf16_t* p, const float* o) { *(u32x4*)p = pack8(o); *(u32x4*)(p + 8) = pack8(o + 8); }
__device__ __forceinline__ void phase_post(const Params& P, const Ctx& C, int l) {
    const int j = l >> 1; const bool ev = (l & 1) == 0;
    const bf16_t* PROJ = (const bf16_t*)(P.ws + WS_PROJ); const bf16_t* PREP = (const bf16_t*)(P.ws + WS_PREP);
    const bf16_t* Y0 = (const bf16_t*)(P.ws + WS_MP); const bf16_t* Y1 = Y0 + (size_t)MTOK * YLD; bf16_t* MIX = (bf16_t*)(P.ws + WS_MIX);
    const int gw = C.bid * 8 + C.wave, NGW = C.G * 8, lane = C.lane, c0 = lane * 16;
    for (int m = gw; m < MTOK; m += NGW) {
        float ya[16], yb[16], t0[16], t1[16], o[16];
        if (ev) {
            const bf16_t* pp = PREP + (size_t)m * PREP_LD;
            ld16(Y0 + (size_t)m * YLD + c0, ya); ld16(Y1 + (size_t)m * YLD + c0, yb); ld16(pp + c0, t0); ld16(pp + 2048 + c0, t1);
            const float dsk = P.in[I_SSDD][j * 16 + (lane >> 2)]; float ss = 0.f;
#pragma unroll
            for (int e = 0; e < 16; ++e) { o[e] = (ya[e] + yb[e] + t0[e] * dsk) * t1[e]; ss += o[e] * o[e]; }
            const float rs = rsqrtf(wave_sum(ss) * (1.f / 1024.f) + 1e-6f);
            ld16f(P.in[I_SSDN] + j * 1024 + c0, t0);
#pragma unroll
            for (int e = 0; e < 16; ++e) o[e] = o[e] * rs * t0[e];
            st16(MIX + (size_t)m * 2048 + c0, o);
            ld16(Y0 + (size_t)m * YLD + 1024 + c0, ya); ld16(Y1 + (size_t)m * YLD + 1024 + c0, yb);
            float mu = 0.f;
#pragma unroll
            for (int e = 0; e < 16; ++e) { ya[e] += yb[e]; mu += ya[e]; }
            mu += __shfl_xor(mu, 1); mu += __shfl_xor(mu, 2); mu *= (1.f / 64.f);
            float var = 0.f;
#pragma unroll
            for (int e = 0; e < 16; ++e) { ya[e] -= mu; var += ya[e] * ya[e]; }
            var += __shfl_xor(var, 1); var += __shfl_xor(var, 2); var *= (1.f / 64.f);
            const float rstd = rsqrtf(var + 64e-5f);
            ld16f(P.in[I_LNW] + j * 1024 + c0, t0); ld16f(P.in[I_LNB] + j * 1024 + c0, t1);
#pragma unroll
            for (int e = 0; e < 16; ++e) o[e] = ya[e] * rstd * t0[e] + t1[e];
            ld16(pp + 3072 + c0, ya); ld16(pp + 4096 + c0, yb); ld16f(P.in[I_RK] + j * 1024 + c0, t0);
            float bs = 0.f;
#pragma unroll
            for (int e = 0; e < 16; ++e) bs += ya[e] * yb[e] * t0[e];
            bs += __shfl_xor(bs, 1); bs += __shfl_xor(bs, 2);
            ld16(pp + 5120 + c0, ya); ld16(PROJ + (size_t)m * LOUT_LD + 4096 + c0, yb);
#pragma unroll
            for (int e = 0; e < 16; ++e) o[e] = (o[e] + bs * ya[e]) * yb[e];
            st16(MIX + (size_t)m * 2048 + 1024 + c0, o);
        } else {
            const bf16_t* pr = PROJ + (size_t)m * PROJ_LD_CD;
#pragma unroll
            for (int g = 0; g < 2; ++g) {
                ld16(Y0 + (size_t)m * YLD + g * 1024 + c0, ya); ld16(Y1 + (size_t)m * YLD + g * 1024 + c0, yb);
                float ss = 0.f;
#pragma unroll
                for (int e = 0; e < 16; ++e) { ya[e] += yb[e]; ss += ya[e] * ya[e]; }
                ss += __shfl_xor(ss, 1); ss += __shfl_xor(ss, 2); ss += __shfl_xor(ss, 4); ss += __shfl_xor(ss, 8);
                const float rs = rsqrtf(ss * (1.f / 256.f) + 1e-6f);
                ld16f((g == 0 ? P.in[I_GLAN] : P.in[I_MLN]) + j * 1024 + c0, t0);
                ld16(pr + (g == 0 ? 2048 : IN_GLA + 2048) + c0, t1);
#pragma unroll
                for (int e = 0; e < 16; ++e) o[e] = ya[e] * rs * t0[e] * (g == 0 ? siluf_(t1[e]) : sigmoidf_(t1[e]));
                st16(MIX + (size_t)m * 2048 + g * 1024 + c0, o);
            }
        }
    }
}

__global__ void __launch_bounds__(512, 2) hybrid_fwd(Params P) {
    extern __shared__ __attribute__((aligned(16))) unsigned char lds_raw[];
    cg::grid_group grid = cg::this_grid();
    Ctx C; C.lds = (LAS unsigned char*)lds_raw; C.tid = threadIdx.x; C.lane = C.tid & 63; C.wave = __builtin_amdgcn_readfirstlane(C.tid >> 6); C.G = gridDim.x; C.bid = blockIdx.x;
    const float* MOD = (const float*)(P.ws + WS_MOD);
    const bf16_t* H = (const bf16_t*)(P.ws + WS_H);
    if (PH & 1) phase_mod(P, fresh_ctx(C.lds));
    if (PH & 2) phase_convert(P, fresh_ctx(C.lds), 0);
    grid.sync();
    if (PH & 4) phase_rows(P, fresh_ctx(C.lds), 0, nullptr, nullptr, true, P.in[I_NORMG] + 0, MOD + 0);
    grid.sync();
#pragma unroll 1
    for (int l = 0; l < 4; ++l) {
        const bool ev = (l & 1) == 0; const float* modl = MOD + (size_t)l * 5 * 6144; const float* ng = P.in[I_NORMG] + l * 4 * 1024;
        if (PH & 8) { pg8::Gemm g{H, (const bf16_t*)(P.ws + WS_WIN), 1024, 1024, 1024}; pg8::Sched<0> S; S.init(MTOK, ev ? N_AB_P : N_CD_P, 1, 1024, C.G, C.bid);
          pg8::EpiBf16<0> E{(bf16_t*)(P.ws + WS_PROJ), ev ? PROJ_LD_AB : PROJ_LD_CD}; pg8::gemm_phase(C.lds, g, S, E); }
        grid.sync();
        if (PH & 16) { if (ev) phase_prep_even(P, fresh_ctx(C.lds), l >> 1); else phase_prep_odd(P, fresh_ctx(C.lds), l >> 1); }
        grid.sync();
        if (ev && (PH & 32)) {
            pg8::Gemm g{(const bf16_t*)(P.ws + WS_LORAA), (const bf16_t*)(P.ws + WS_WLORA), LORA_K, 128, 128}; pg8::Sched<1> S; S.init(MTOK, LOUT_LD, 1, 128, C.G, C.bid);
            pg8::EpiBf16<0> E{(bf16_t*)(P.ws + WS_PROJ), LOUT_LD}; pg8::gemm_phase(C.lds, g, S, E);
            grid.sync();
        }
        if (PH & 64) phase_scan(P, fresh_ctx(C.lds), l);
        grid.sync();
        if (PH & 128) phase_post(P, fresh_ctx(C.lds), l);
        grid.sync();
        if (PH & 256) { pg8::Gemm g{(const bf16_t*)(P.ws + WS_MIX), (const bf16_t*)(P.ws + WS_WOUT), 2048, 2048, 1024}; pg8::Sched<0> S; S.init(MTOK, 1024, 2, 1024, C.G, C.bid);
          pg8::EpiF32 E{(float*)(P.ws + WS_MP), 1024, (size_t)MTOK * 1024}; pg8::gemm_phase(C.lds, g, S, E); }
        grid.sync();
        if (PH & 512) phase_rows(P, fresh_ctx(C.lds), 1, ng + 1024, modl + 2048, true, ng + 2048, modl + 3072);
        grid.sync();
        if (PH & 1024) { pg8::Gemm g{H, (const bf16_t*)(P.ws + WS_WUP), 1024, 1024, 1024}; pg8::Sched<0> S; S.init(MTOK, 4096, 1, 1024, C.G, C.bid);
          pg8::EpiBf16<2> E{(bf16_t*)(P.ws + WS_PROJ), 4096}; pg8::gemm_phase(C.lds, g, S, E); }
        grid.sync();
        if (PH & 2048) { pg8::Gemm g{(const bf16_t*)(P.ws + WS_PROJ), (const bf16_t*)(P.ws + WS_WDN), 4096, 4096, 2048}; pg8::Sched<0> S; S.init(MTOK, 1024, 2, 2048, C.G, C.bid);
          pg8::EpiF32 E{(float*)(P.ws + WS_MP), 1024, (size_t)MTOK * 1024}; pg8::gemm_phase(C.lds, g, S, E); }
        grid.sync();
        if (PH & 4096) { if (l < 3) { phase_rows(P, fresh_ctx(C.lds), 1, ng + 3072, modl + 5120, true, ng + 4096, modl + 5 * 6144); phase_convert(P, fresh_ctx(C.lds), l + 1); }
        else phase_rows(P, fresh_ctx(C.lds), 1, ng + 3072, modl + 5120, false, nullptr, nullptr); }
        if (l < 3) grid.sync();
    }
}

extern "C" void kernel_launch(void* const* d_in, const int* in_sizes, int n_in, void* d_out, int out_size, void* d_ws, size_t ws_size, hipStream_t stream) {
    static int grid = 0;
    if (grid == 0) {
        if (n_in != 44 || ws_size < WS_END) { fprintf(stderr, "kernel_launch: unexpected n_in %d / ws %zu\n", n_in, ws_size); grid = -1; return; }
        int dev = 0, cus = 0, per_cu = 0;
        hipGetDevice(&dev); hipDeviceGetAttribute(&cus, hipDeviceAttributeMultiprocessorCount, dev);
        if (hipFuncSetAttribute((const void*)hybrid_fwd, hipFuncAttributeMaxDynamicSharedMemorySize, LDS_BYTES) != hipSuccess) { fprintf(stderr, "hipFuncSetAttribute failed\n"); grid = -1; return; }
        hipOccupancyMaxActiveBlocksPerMultiprocessor(&per_cu, (const void*)hybrid_fwd, 512, LDS_BYTES);
        (void)hipGetLastError();
        if (per_cu < 1) per_cu = 1;
        grid = cus * 1;
    }
    if (grid < 0) return;
    Params p{};
    for (int i = 0; i < 44; ++i) p.in[i] = (const float*)d_in[i];
    p.out = (float*)d_out; p.ws = (unsigned char*)d_ws;
    void* args[] = {&p};
    hipError_t e = hipLaunchCooperativeKernel((const void*)hybrid_fwd, dim3(grid), dim3(512), args, LDS_BYTES, stream);
    if (e != hipSuccess) fprintf(stderr, "cooperative launch failed: %s (grid %d)\n", hipGetErrorString(e), grid);
}
```

```cpp
#include <hip/hip_runtime.h>
#include <hip/hip_cooperative_groups.h>
#include <cstdio>
#include <cstdint>
namespace cg = cooperative_groups;

#define LAS __attribute__((address_space(3)))
typedef unsigned short bf16_t;
typedef short bf16x8 __attribute__((ext_vector_type(8)));
typedef float f32x4 __attribute__((ext_vector_type(4)));
typedef float f32x2 __attribute__((ext_vector_type(2)));
typedef unsigned u32x4 __attribute__((ext_vector_type(4)));
typedef unsigned u32x2 __attribute__((ext_vector_type(2)));

constexpr int MTOK = 8192, DM = 1024, DFF = 4096;
constexpr int N_AB = 6560, N_AB_P = 6656, N_CD = 6192, N_CD_P = 6400;
constexpr int PROJ_LD_AB = N_AB_P, PROJ_LD_CD = N_CD_P;
constexpr int PREP_LD = 7168, LOUT_LD = 5120, LORA_K = 384, YLD = 2048;
constexpr int IN_SSD = 3104, IN_GLA = 3104;
constexpr size_t MiB = 1u << 20;
constexpr size_t WS_MOD = 0, WS_CTL = 512 * 1024, CTL_BYTES = 16384, WS_DT = 1 * MiB, WS_DA = 3 * MiB, WS_WIN = 5 * MiB, WS_WOUT = 19 * MiB, WS_WUP = 23 * MiB, WS_WDN = 31 * MiB,
                 WS_WLORA = 39 * MiB, WS_H = 41 * MiB, WS_PROJ = 57 * MiB, WS_PREP = 161 * MiB, WS_MIX = 273 * MiB, WS_MP = 305 * MiB,
                 WS_LORAA = 369 * MiB, WS_END = 375 * MiB;
constexpr size_t O_X = 0, O_SSD = 8388608, O_RWKV = 16777216, O_GLA = 20971520, O_MC = 29360128, O_MN = 37748736, O_MM = 37781504;

struct Params { const float* in[44]; float* out; unsigned char* ws; };
enum { I_XP = 0, I_XS, I_SSSD, I_SRWKV, I_SGLA, I_SMC, I_SMN, I_SMM, I_C, I_CCTX, I_WMOD, I_BMOD, I_NORMG, I_WUP, I_WDN, I_WINAB, I_SCONVW, I_SCONVB,
       I_DTB, I_ALOG, I_SSDD, I_SSDN, I_MU, I_W0, I_W2, I_A0, I_A2, I_G2, I_KK, I_KA, I_RK, I_LNW, I_LNB, I_WOUTAB, I_WINCD, I_GGW, I_GGB, I_GLAN,
       I_MCONVW, I_MCONVB, I_MIB, I_MFB, I_MLN, I_WOUTCD };

__device__ __forceinline__ float bf2f(unsigned b) { return __uint_as_float(b << 16); }
__device__ __forceinline__ unsigned f2bf(float f) { unsigned u = __float_as_uint(f); return (u + 0x7fffu + ((u >> 16) & 1u)) >> 16; }
__device__ __forceinline__ unsigned pk2(float lo, float hi) { return f2bf(lo) | (f2bf(hi) << 16); }
__device__ __forceinline__ float lo16(unsigned w) { return __uint_as_float(w << 16); }
__device__ __forceinline__ float hi16(unsigned w) { return __uint_as_float(w & 0xffff0000u); }
__device__ __forceinline__ void unpack8(u32x4 w, float* o) { o[0] = lo16(w.x); o[1] = hi16(w.x); o[2] = lo16(w.y); o[3] = hi16(w.y); o[4] = lo16(w.z); o[5] = hi16(w.z); o[6] = lo16(w.w); o[7] = hi16(w.w); }
__device__ __forceinline__ f32x4 unpack4(u32x2 w) { return (f32x4){lo16(w.x), hi16(w.x), lo16(w.y), hi16(w.y)}; }
__device__ __forceinline__ u32x4 pack8(const float* o) { u32x4 w; w.x = pk2(o[0], o[1]); w.y = pk2(o[2], o[3]); w.z = pk2(o[4], o[5]); w.w = pk2(o[6], o[7]); return w; }
__device__ __forceinline__ float sigmoidf_(float x) { return 1.f / (1.f + __expf(-x)); }
__device__ __forceinline__ float siluf_(float x) { return x / (1.f + __expf(-x)); }
__device__ __forceinline__ float softplusf_(float x) { return fmaxf(x, 0.f) + __logf(1.f + __expf(-fabsf(x))); }
__device__ __forceinline__ float logsigmoidf_(float x) { return fminf(x, 0.f) - __logf(1.f + __expf(-fabsf(x))); }
__device__ __forceinline__ float tanhf_(float x) { const float e = __expf(-2.f * fabsf(x)); const float r = (1.f - e) / (1.f + e); return x < 0.f ? -r : r; }
__device__ __forceinline__ float wave_sum(float v) {
#pragma unroll
    for (int o = 1; o < 64; o <<= 1) v += __shfl_xor(v, o);
    return v;
}
__device__ __forceinline__ float quad_sum(float x) {
    x += __int_as_float(__builtin_amdgcn_update_dpp(0, __float_as_int(x), 0xB1, 0xF, 0xF, true));
    x += __int_as_float(__builtin_amdgcn_update_dpp(0, __float_as_int(x), 0x4E, 0xF, 0xF, true));
    return x;
}

#define DPP_ADD(x, ctrl) ((x) + __int_as_float(__builtin_amdgcn_update_dpp(0, __float_as_int(x), (ctrl), 0xF, 0xF, true)))
__device__ __forceinline__ float row_sum8(float x) { x = DPP_ADD(x, 0xB1); x = DPP_ADD(x, 0x4E); x = DPP_ADD(x, 0x141); return x; }
__device__ __forceinline__ float row_sum16(float x) { x = row_sum8(x); x = DPP_ADD(x, 0x140); return x; }
namespace pg8 {
constexpr int BM = 256, BK = 64, HALF = 128, HTB = HALF * BK * 2, STAGE_BYTES = 8 * HTB, NXCD = 8, WGM = 8;
__host__ __device__ __forceinline__ int lds_byte(int r, int c) { const int st = (r >> 4) * 2 + (c >> 5), rr = r & 15, cc = c & 31, ob = rr * 64 + cc * 2; return st * 1024 + (ob ^ (((ob >> 9) & 1) << 5)); }
__host__ __device__ __forceinline__ void stage_rc(int b, int& R, int& C) { const int st = b / 1024, sb = b % 1024, swz = sb ^ (((sb >> 9) & 1) << 5); R = (st >> 1) * 16 + swz / 64; C = (st & 1) * 32 + (swz % 64) / 2; }
__host__ __device__ __forceinline__ int perm32(int rho) { const int n = rho >> 4, i = rho & 15; return 8 * (i >> 2) + 4 * n + (i & 3); }

struct Unit { int pm, pn, ks; };
struct Gemm { const bf16_t* A; const bf16_t* Bt; int lda, ldb, K; };
template <int mode> struct Sched {
    int nM, nN, nNv, nwg, G, c, K;
    __device__ void init(int M, int N, int nK, int K_, int G_, int c_) { nM = M / BM; nN = N / BM; nNv = nN * nK; nwg = nM * nNv; G = G_; c = c_; K = K_; }
    __device__ bool next(int i, Unit& u) const {
        const long L = (long)i * G + c; if (L >= nwg) return false;
        int wgid = (int)L; { const int q = nwg / NXCD, r = nwg % NXCD, xcd = wgid % NXCD, off = wgid / NXCD; wgid = (xcd < r ? xcd * (q + 1) : r * (q + 1) + (xcd - r) * q) + off; }
        const int nig = WGM * nNv, gid = wgid / nig, fm = gid * WGM, gsz = (nM - fm) < WGM ? (nM - fm) : WGM;
        u.pm = fm + ((wgid % nig) % gsz); const int pnv = (wgid % nig) / gsz; u.pn = pnv % nN; u.ks = pnv / nN; return true;
    }
    __device__ __forceinline__ size_t aoff(const Unit& u) const { if (mode == 1) { const int g = u.pn >> 2; return (size_t)(g < 2 ? 0 : (g < 4 ? 128 : 256)) * 2; } return (size_t)u.ks * K * 2; }
    __device__ __forceinline__ size_t boff(const Unit& u) const { return mode == 1 ? 0 : (size_t)u.ks * K * 2; }
};

__device__ __forceinline__ unsigned cvt_pk_bf16(float lo, float hi) { unsigned r; asm volatile("v_cvt_pk_bf16_f32 %0, %1, %2" : "=v"(r) : "v"(lo), "v"(hi)); return r; }

template <int ACT> struct EpiBf16 {
    static constexpr bool PERM = true;
    bf16_t* O; int ldc;
    __device__ __forceinline__ void operator()(const f32x4 (&acc)[2][2][4][2], const Unit& u, int wr, int wc, int fr, int fq) const {
        const int row0 = u.pm * BM + wr * 64 + fr; const int col0 = u.pn * BM + wc * 32 + 8 * fq;
#pragma unroll
        for (int ai = 0; ai < 2; ++ai)
#pragma unroll
            for (int m = 0; m < 4; ++m) { bf16_t* rowp = O + (size_t)(row0 + ai * HALF + m * 16) * ldc + col0;
#pragma unroll
                for (int bj = 0; bj < 2; ++bj) { f32x4 v0 = acc[ai][bj][m][0], v1 = acc[ai][bj][m][1];
                    if (ACT == 2) {
#pragma unroll
                        for (int e = 0; e < 4; ++e) { const float a = fmaxf(v0[e], 0.f), b = fmaxf(v1[e], 0.f); v0[e] = a * a; v1[e] = b * b; } }
                    u32x4 w; w.x = cvt_pk_bf16(v0[0], v0[1]); w.y = cvt_pk_bf16(v0[2], v0[3]); w.z = cvt_pk_bf16(v1[0], v1[1]); w.w = cvt_pk_bf16(v1[2], v1[3]);
                    *(u32x4*)(rowp + bj * HALF) = w; } }
    }
};
struct EpiF32 {
    static constexpr bool PERM = false;
    float* O; int ldc; size_t pstride;
    __device__ __forceinline__ void operator()(const f32x4 (&acc)[2][2][4][2], const Unit& u, int wr, int wc, int fr, int fq) const {
        float* base = O + (size_t)u.ks * pstride; const int col0 = u.pn * BM + wc * 32 + 4 * fq;
#pragma unroll
        for (int ai = 0; ai < 2; ++ai)
#pragma unroll
            for (int m = 0; m < 4; ++m) { float* rowp = base + (size_t)(u.pm * BM + ai * HALF + wr * 64 + m * 16 + fr) * ldc + col0;
#pragma unroll
                for (int bj = 0; bj < 2; ++bj)
#pragma unroll
                    for (int n = 0; n < 2; ++n) *(f32x4*)(rowp + bj * HALF + n * 16) = acc[ai][bj][m][n]; }
    }
};

template <class Epi, class SchedT>
__device__ __forceinline__ void gemm_phase(LAS unsigned char* lds, const Gemm g, const SchedT& S, const Epi& E) {
    int tid_ = threadIdx.x; asm volatile("" : "+v"(tid_));
    const int tid = tid_, wid = __builtin_amdgcn_readfirstlane(tid >> 6), lane = tid & 63, wr = wid >> 2, wc = wid & 3, fr = lane & 15, fq = lane >> 4;
    int K_ = g.K; asm volatile("" : "+s"(K_));
    const int K = K_, nt = K / BK;
    unsigned voffA[2], voffB[2];
#pragma unroll
    for (int i = 0; i < 2; ++i) { int R, C; stage_rc(tid * 16 + i * 8192, R, C); const int Rb = Epi::PERM ? ((R & ~31) + perm32(R & 31)) : R;
        voffA[i] = (unsigned)(R * g.lda + C) * 2u; voffB[i] = (unsigned)(Rb * g.ldb + C) * 2u; }
    const size_t kstep = (size_t)(BK * 2);
    const size_t hstepA = (size_t)HALF * g.lda * 2, hstepB = (size_t)HALF * g.ldb * 2;
    const size_t tstepA = 2 * hstepA, tstepB = 2 * hstepB;
    const unsigned ldsw = (unsigned)wid * 1024u;
    const int aoff = lds_byte(wr * 64 + fr, fq * 8), boff = lds_byte(wc * 32 + fr, fq * 8);
#define PG8_SA(b, h) (((b) * 2 + (h)) * HTB)
#define PG8_SB(b, h) ((4 + (b) * 2 + (h)) * HTB)
#define PG8_STAGE(bufoff, gbase, voff) do { _Pragma("unroll") for (int _i = 0; _i < 2; ++_i) \
        __builtin_amdgcn_global_load_lds((const unsigned*)((const char*)(gbase) + (voff)[_i]), (LAS unsigned*)(lds + (bufoff) + ldsw + _i * 8192), 16, 0, 0); } while (0)
#define PG8_LDA(dst, b, h) do { _Pragma("unroll") for (int m = 0; m < 4; ++m) _Pragma("unroll") for (int k = 0; k < 2; ++k) dst[m][k] = *(const LAS bf16x8*)(lds + PG8_SA(b, h) + aoff + m * 2048 + k * 1024); } while (0)
#define PG8_LDB(dst, b, h) do { _Pragma("unroll") for (int n = 0; n < 2; ++n) _Pragma("unroll") for (int k = 0; k < 2; ++k) dst[n][k] = *(const LAS bf16x8*)(lds + PG8_SB(b, h) + boff + n * 2048 + k * 1024); } while (0)
#define PG8_MMA(ai, bj, At, Bt) do { __builtin_amdgcn_s_setprio(1); _Pragma("unroll") for (int m = 0; m < 4; ++m) _Pragma("unroll") for (int n = 0; n < 2; ++n) _Pragma("unroll") for (int k = 0; k < 2; ++k) \
        acc[ai][bj][m][n] = __builtin_amdgcn_mfma_f32_16x16x32_bf16(Bt[n][k], At[m][k], acc[ai][bj][m][n], 0, 0, 0); __builtin_amdgcn_s_setprio(0); } while (0)
#define PG8_WAIT_V(n) asm volatile("s_waitcnt vmcnt(" #n ")" ::: "memory")
#define PG8_WAIT_L(n) asm volatile("s_waitcnt lgkmcnt(" #n ")" ::: "memory")
#define PG8_BAR __builtin_amdgcn_s_barrier()
#define PG8_SCHED __builtin_amdgcn_sched_barrier(0)
    Unit cur, nxt; int ui = 0;
    if (!S.next(0, cur)) return;
    f32x4 acc[2][2][4][2];
#pragma unroll
    for (int a = 0; a < 2; ++a)
#pragma unroll
        for (int b = 0; b < 2; ++b)
#pragma unroll
            for (int m = 0; m < 4; ++m)
#pragma unroll
                for (int n = 0; n < 2; ++n) acc[a][b][m][n] = (f32x4){0.f, 0.f, 0.f, 0.f};
    bf16x8 At[4][2], B0[2][2], B1[2][2];
    const char* cA = (const char*)g.A + (size_t)cur.pm * tstepA + S.aoff(cur); const char* cB = (const char*)g.Bt + (size_t)cur.pn * tstepB + S.boff(cur);
    PG8_STAGE(PG8_SB(0, 0), cB, voffB); PG8_STAGE(PG8_SB(0, 1), cB + hstepB, voffB); PG8_STAGE(PG8_SA(0, 0), cA, voffA); PG8_STAGE(PG8_SA(0, 1), cA + hstepA, voffA);
    if (wr == 1) PG8_BAR;
    PG8_WAIT_V(2); PG8_BAR;
    PG8_STAGE(PG8_SB(1, 0), cB + kstep, voffB); PG8_STAGE(PG8_SA(1, 0), cA + kstep, voffA); PG8_STAGE(PG8_SB(1, 1), cB + hstepB + kstep, voffB);
    PG8_WAIT_V(6); PG8_BAR;
    for (;;) {
        const bool has_next = S.next(ui + 1, nxt);
        const char* nA = has_next ? (const char*)g.A + (size_t)nxt.pm * tstepA + S.aoff(nxt) : cA; const char* nB = has_next ? (const char*)g.Bt + (size_t)nxt.pn * tstepB + S.boff(nxt) : cB;
        for (int t = 0; t < nt; t += 2) {
            const bool last = (t == nt - 2);
            const char* a1 = cA + (size_t)(t + 1) * kstep;
            const char* a2 = last ? nA : cA + (size_t)(t + 2) * kstep; const char* b2 = last ? nB : cB + (size_t)(t + 2) * kstep;
            const char* a3 = a2 + kstep; const char* b3 = b2 + kstep;
            PG8_LDB(B0, 0, 0); PG8_LDB(B1, 0, 1); PG8_SCHED; PG8_LDA(At, 0, 0); PG8_STAGE(PG8_SA(1, 1), a1 + hstepA, voffA);
            PG8_WAIT_V(8); PG8_WAIT_L(0); PG8_BAR; PG8_MMA(0, 0, At, B0); PG8_MMA(0, 1, At, B1); PG8_BAR; PG8_SCHED;
            PG8_LDA(At, 0, 1); PG8_STAGE(PG8_SB(0, 0), b2, voffB); PG8_STAGE(PG8_SB(0, 1), b2 + hstepB, voffB); PG8_STAGE(PG8_SA(0, 0), a2, voffA);
            PG8_WAIT_V(8); PG8_WAIT_L(0); PG8_BAR; PG8_MMA(1, 0, At, B0); PG8_MMA(1, 1, At, B1); PG8_BAR; PG8_SCHED;
            PG8_LDB(B0, 1, 0); PG8_LDB(B1, 1, 1); PG8_SCHED; PG8_LDA(At, 1, 0); PG8_STAGE(PG8_SA(0, 1), a2 + hstepA, voffA);
            PG8_WAIT_V(8); PG8_WAIT_L(0); PG8_BAR; PG8_MMA(0, 0, At, B0); PG8_MMA(0, 1, At, B1); PG8_BAR; PG8_SCHED;
            PG8_LDA(At, 1, 1); PG8_STAGE(PG8_SB(1, 0), b3, voffB); PG8_STAGE(PG8_SB(1, 1), b3 + hstepB, voffB); PG8_STAGE(PG8_SA(1, 0), a3, voffA);
            PG8_WAIT_V(8); PG8_WAIT_L(0); PG8_BAR; PG8_MMA(1, 0, At, B0); PG8_MMA(1, 1, At, B1); PG8_BAR; PG8_SCHED;
        }
        if (wr == 0) PG8_BAR;
        E(acc, cur, wr, wc, fr, fq);
        if (!has_next) break;
#pragma unroll
        for (int a = 0; a < 2; ++a)
#pragma unroll
            for (int b = 0; b < 2; ++b)
#pragma unroll
                for (int m = 0; m < 4; ++m)
#pragma unroll
                    for (int n = 0; n < 2; ++n) acc[a][b][m][n] = (f32x4){0.f, 0.f, 0.f, 0.f};
        cur = nxt; cA = nA; cB = nB; ++ui;
        if (wr == 1) PG8_BAR;
    }
    PG8_WAIT_V(0);
    PG8_BAR;
#undef PG8_SA
#undef PG8_SB
#undef PG8_STAGE
#undef PG8_LDA
#undef PG8_LDB
#undef PG8_MMA
#undef PG8_WAIT_V
#undef PG8_WAIT_L
#undef PG8_BAR
#undef PG8_SCHED
}
}

#define XB_TMO      128
#define XB_XCNT(j)  (256  + 64 * (j))
#define XB_XSUB(j)  (1280 + 64 * (j))
#define XB_XGEN(j)  (2304 + 64 * (j))
#define XB_TOP      3328
#define XB_TOPGEN   3392
#define XCD_BAR_WORDS 3456
#define XB_SPIN_CAP (1u << 18)
__device__ __forceinline__ unsigned xb_ld(unsigned* p)              { return __hip_atomic_load(p, __ATOMIC_RELAXED, __HIP_MEMORY_SCOPE_AGENT); }
__device__ __forceinline__ unsigned xb_add(unsigned* p, unsigned v) { return __hip_atomic_fetch_add(p, v, __ATOMIC_RELAXED, __HIP_MEMORY_SCOPE_AGENT); }
__device__ __forceinline__ unsigned xb_xcc_id() { return (unsigned)__builtin_amdgcn_s_getreg((3 << 11) | 20) & 0xFu; }
#define XB_SPIN(cond, bar) do { unsigned _sp = 0; while (cond) { __builtin_amdgcn_s_sleep(1); \
    if ((++_sp & 255u) == 0u) { if (xb_ld(&(bar)[XB_TMO])) break; if (_sp > XB_SPIN_CAP) { atomicAdd(&(bar)[XB_TMO], 1u); break; } } } } while (0)
struct XcdBarrier { unsigned* bar; unsigned x; volatile LAS unsigned* st; };
__device__ __forceinline__ XcdBarrier xcd_barrier_post(unsigned* bar, volatile LAS unsigned* st) {
    XcdBarrier b; b.bar = bar; b.x = xb_xcc_id(); b.st = st;
    if (threadIdx.x == 0) (void)xb_add(&bar[XB_XCNT(b.x)], 1u);
    return b;
}
__device__ __forceinline__ void xcd_barrier_complete(unsigned* bar, unsigned x, unsigned& nloc, unsigned& nx) {
    const unsigned G = gridDim.x * gridDim.y * gridDim.z;
    unsigned sum, cnt, mine, sp = 0u;
    for (;;) {
        sum = 0u; cnt = 0u; mine = 0u;
#pragma unroll
        for (unsigned j = 0; j < 16; ++j) { const unsigned c = xb_ld(&bar[XB_XCNT(j)]); sum += c; cnt += (c > 0u) ? 1u : 0u; mine = (j == x) ? c : mine; }
        if (sum == G) break;
        __builtin_amdgcn_s_sleep(1);
        if ((++sp & 255u) == 0u) { if (xb_ld(&bar[XB_TMO])) break; if (sp > XB_SPIN_CAP) { atomicAdd(&bar[XB_TMO], 1u); break; } }
    }
    nloc = mine > 0u ? mine : 1u; nx = cnt > 0u ? cnt : 1u;
}
__device__ __forceinline__ void xcd_barrier(const XcdBarrier& b) {
    asm volatile("s_waitcnt vmcnt(0)" ::: "memory");
    __syncthreads();
    if (threadIdx.x == 0) {
        unsigned* bar = b.bar;
        __builtin_amdgcn_s_waitcnt(0);
        unsigned nloc = b.st[0], nx = b.st[1];
        if (nloc == 0u) { xcd_barrier_complete(bar, b.x, nloc, nx); b.st[0] = nloc; b.st[1] = nx; }
        const unsigned old = xb_add(&bar[XB_XSUB(b.x)], 1u);
        const unsigned gen = old / nloc;
        if (old + 1u == (gen + 1u) * nloc) {
            __builtin_amdgcn_fence(__ATOMIC_RELEASE, "agent");
            asm volatile("s_waitcnt vmcnt(0)" ::: "memory");
            const unsigned og = xb_add(&bar[XB_TOP], 1u);
            const unsigned tg = og / nx;
            if (og + 1u == (tg + 1u) * nx) xb_add(&bar[XB_TOPGEN], 1u);
            else XB_SPIN(xb_ld(&bar[XB_TOPGEN]) == tg, bar);
            __builtin_amdgcn_fence(__ATOMIC_ACQUIRE, "agent");
            xb_add(&bar[XB_XGEN(b.x)], 1u);
            asm volatile("s_waitcnt vmcnt(0)" ::: "memory");
        } else {
            XB_SPIN(xb_ld(&bar[XB_XGEN(b.x)]) == gen, bar);
            __builtin_amdgcn_fence(__ATOMIC_ACQUIRE, "agent");
            asm volatile("s_waitcnt vmcnt(0)" ::: "memory");
        }
    }
    __syncthreads();
}

constexpr int LDS_BYTES = 147456;
#ifndef PH
#define PH 0xFFFF
#endif
#ifndef DUP
#define DUP 0
#endif
#define GSYNC() xcd_barrier(xb)
#define REP(bit) for (int rep_ = 0; rep_ < ((DUP & (bit)) ? 2 : 1); ++rep_)
struct Ctx { LAS unsigned char* lds; int tid, lane, wave, G, bid; };
__device__ __forceinline__ Ctx fresh_ctx(LAS unsigned char* lds) { Ctx C; int t = threadIdx.x; asm volatile("" : "+v"(t)); C.lds = lds; C.tid = t; C.lane = t & 63; C.wave = __builtin_amdgcn_readfirstlane(t >> 6); C.G = gridDim.x; C.bid = blockIdx.x; return C; }

__device__ __forceinline__ void phase_mod(const Params& P, const Ctx& C) {
    LAS float* sc = (LAS float*)C.lds; LAS float* red = sc + 5120;
    for (int i = C.tid; i < 5120; i += 512) { const int r = i >> 10, k = i & 1023; const float x = r == 0 ? P.in[I_CCTX][k] : P.in[I_C][(r - 1) * 1024 + k]; sc[i] = siluf_(x); }
    __syncthreads();
    float* MOD = (float*)(P.ws + WS_MOD);
    const int kg = C.tid >> 6, c = C.tid & 63;
    for (int tile = C.bid; tile < 384; tile += C.G) {
        const int l = tile / 96, col = (tile % 96) * 64 + c;
        const float* w = P.in[I_WMOD] + (size_t)l * 1024 * 6144 + col;
        float a0 = 0.f, a1 = 0.f, a2 = 0.f, a3 = 0.f, a4 = 0.f;
#pragma unroll 8
        for (int k = kg * 128; k < kg * 128 + 128; ++k) { const float wv = w[(size_t)k * 6144]; a0 += sc[k] * wv; a1 += sc[1024 + k] * wv; a2 += sc[2048 + k] * wv; a3 += sc[3072 + k] * wv; a4 += sc[4096 + k] * wv; }
        red[(kg * 5 + 0) * 64 + c] = a0; red[(kg * 5 + 1) * 64 + c] = a1; red[(kg * 5 + 2) * 64 + c] = a2; red[(kg * 5 + 3) * 64 + c] = a3; red[(kg * 5 + 4) * 64 + c] = a4;
        __syncthreads();
        if (C.tid < 320) { const int r = C.tid >> 6; float s = 0.f;
#pragma unroll
            for (int q = 0; q < 8; ++q) s += red[(q * 5 + r) * 64 + c];
            MOD[(size_t)(l * 5 + r) * 6144 + col] = s + P.in[I_BMOD][l * 6144 + col]; }
        __syncthreads();
    }
}

__device__ __forceinline__ void transpose_item(const float* W, int K, int N, bf16_t* WT, LAS float* scr, int item, int nblk, int lane) {
    const int kb = item / nblk, nb = item % nblk, k0 = 64 * kb, n0 = 32 * nb;
    const bool nok = (n0 + (lane & 31)) < N;
#pragma unroll 8
    for (int i = 0; i < 32; ++i) { const int kk = 2 * i + (lane >> 5); scr[kk * 33 + (lane & 31)] = nok ? W[(size_t)(k0 + kk) * N + n0 + (lane & 31)] : 0.f; }
    asm volatile("s_waitcnt lgkmcnt(0)" ::: "memory");
    const int c = lane & 7;
#pragma unroll
    for (int j = 0; j < 4; ++j) { const int n = (lane >> 3) + 8 * j; const LAS float* s = scr + (8 * c) * 33 + n;
        u32x4 o; o.x = pk2(s[0 * 33], s[1 * 33]); o.y = pk2(s[2 * 33], s[3 * 33]); o.z = pk2(s[4 * 33], s[5 * 33]); o.w = pk2(s[6 * 33], s[7 * 33]);
        *(u32x4*)(WT + (size_t)(n0 + n) * K + k0 + 8 * c) = o; }
    asm volatile("s_waitcnt lgkmcnt(0)" ::: "memory");
}
__device__ __forceinline__ void phase_convert(const Params& P, const Ctx& C, int l) {
    LAS float* scr = (LAS float*)(C.lds + 32768 + C.wave * 8704);
    const int gw = C.bid * 8 + C.wave, NGW = C.G * 8; const int j = l >> 1; const bool ev = (l & 1) == 0;
    const float* win = ev ? P.in[I_WINAB] + (size_t)j * 1024 * N_AB : P.in[I_WINCD] + (size_t)j * 1024 * N_CD;
    const float* wout = (ev ? P.in[I_WOUTAB] : P.in[I_WOUTCD]) + (size_t)j * 2048 * 1024;
    const float* wup = P.in[I_WUP] + (size_t)l * 1024 * 4096; const float* wdn = P.in[I_WDN] + (size_t)l * 4096 * 1024;
    const int N_in = ev ? N_AB : N_CD, Np = ev ? N_AB_P : N_CD_P;
    const int I0 = 16 * (Np / 32), I1 = 32 * 32, I2 = 16 * 128, I3 = 64 * 32;
    for (int it = gw; it < I0 + I1 + I2 + I3; it += NGW) {
        int r = it;
        if (r < I0) { transpose_item(win, 1024, N_in, (bf16_t*)(P.ws + WS_WIN), scr, r, Np / 32, C.lane); continue; } r -= I0;
        if (r < I1) { transpose_item(wout, 2048, 1024, (bf16_t*)(P.ws + WS_WOUT), scr, r, 32, C.lane); continue; } r -= I1;
        if (r < I2) { transpose_item(wup, 1024, 4096, (bf16_t*)(P.ws + WS_WUP), scr, r, 128, C.lane); continue; } r -= I2;
        transpose_item(wdn, 4096, 1024, (bf16_t*)(P.ws + WS_WDN), scr, r, 32, C.lane);
    }
    if (ev) {
        bf16_t* WL = (bf16_t*)(P.ws + WS_WLORA);
        for (int idx = C.bid * 512 + C.tid; idx < 5120 * 16; idx += C.G * 512) {
            const int n = idx % 5120, k8 = idx / 5120, g = n >> 10, cc = n & 1023; float o[8];
#pragma unroll
            for (int e = 0; e < 8; ++e) { const int k = k8 * 8 + e; float v = 0.f;
                if (g == 0) { if (k < 64) v = P.in[I_W2][((size_t)(j * 2 + 0) * 64 + k) * 1024 + cc]; }
                else if (g == 1) { if (k >= 64) v = P.in[I_W2][((size_t)(j * 2 + 1) * 64 + (k - 64)) * 1024 + cc]; }
                else if (g == 2) { if (k < 64) v = P.in[I_A2][((size_t)(j * 2 + 0) * 64 + k) * 1024 + cc]; }
                else if (g == 3) { if (k >= 64) v = P.in[I_A2][((size_t)(j * 2 + 1) * 64 + (k - 64)) * 1024 + cc]; }
                else v = P.in[I_G2][((size_t)j * 128 + k) * 1024 + cc];
                o[e] = v; }
            *(u32x4*)(WL + (size_t)n * 128 + k8 * 8) = pack8(o);
        }
    }
}

__device__ __forceinline__ void phase_rows(const Params& P, const Ctx& C, int mode, const float* gpost, const float* gate_mod  ,
                                           bool next, const float* gpre, const float* mod_next  ) {
    float* X = P.out + O_X; const float* MP0 = (const float*)(P.ws + WS_MP); const float* MP1 = MP0 + (size_t)MTOK * DM; bf16_t* H = (bf16_t*)(P.ws + WS_H);
    const int gw = C.bid * 8 + C.wave, NGW = C.G * 8;
    for (int m = gw; m < MTOK; m += NGW) {
        const int mr = m < 4096 ? 0 : 1 + ((m - 4096) >> 10);
        f32x4 x[4];
        if (mode == 0) { const f32x4* src = (const f32x4*)(m < 4096 ? P.in[I_XP] + (size_t)m * DM : P.in[I_XS] + (size_t)(m - 4096) * DM) + C.lane;
#pragma unroll
            for (int j = 0; j < 4; ++j) x[j] = src[64 * j];
        } else {
            const f32x4* xs = (const f32x4*)(X + (size_t)m * DM) + C.lane; const f32x4* p0 = (const f32x4*)(MP0 + (size_t)m * DM) + C.lane; const f32x4* p1 = (const f32x4*)(MP1 + (size_t)m * DM) + C.lane;
            f32x4 f[4]; float ss = 0.f;
#pragma unroll
            for (int j = 0; j < 4; ++j) { x[j] = xs[64 * j]; f[j] = p0[64 * j] + p1[64 * j]; ss += (f[j].x * f[j].x + f[j].y * f[j].y) + (f[j].z * f[j].z + f[j].w * f[j].w); }
            const float rs = rsqrtf(wave_sum(ss) * (1.f / DM) + 1e-6f);
            const f32x4* gp = (const f32x4*)gpost + C.lane; const f32x4* gt = (const f32x4*)(gate_mod + (size_t)mr * 6144) + C.lane;
#pragma unroll
            for (int j = 0; j < 4; ++j) x[j] = x[j] + gt[64 * j] * (f[j] * rs * gp[64 * j]);
        }
        f32x4* xo = (f32x4*)(X + (size_t)m * DM) + C.lane;
#pragma unroll
        for (int j = 0; j < 4; ++j) xo[64 * j] = x[j];
        if (next) {
            float ss = 0.f;
#pragma unroll
            for (int j = 0; j < 4; ++j) ss += (x[j].x * x[j].x + x[j].y * x[j].y) + (x[j].z * x[j].z + x[j].w * x[j].w);
            const float rs = rsqrtf(wave_sum(ss) * (1.f / DM) + 1e-6f);
            const f32x4* gp = (const f32x4*)gpre + C.lane; const f32x4* sh = (const f32x4*)(mod_next + (size_t)mr * 6144) + C.lane; const f32x4* sl = (const f32x4*)(mod_next + (size_t)mr * 6144 + 1024) + C.lane;
            u32x2* ho = (u32x2*)(H + (size_t)m * DM) + C.lane;
#pragma unroll
            for (int j = 0; j < 4; ++j) { const f32x4 h = (x[j] * rs * gp[64 * j]) * (sl[64 * j] + 1.f) + sh[64 * j]; u32x2 w; w.x = pk2(h.x, h.y); w.y = pk2(h.z, h.w); ho[64 * j] = w; }
        }
    }
}

__device__ __forceinline__ void conv8(const bf16_t* src, int ld, int col0, int base, int t, bool samp, const float* w, const float* b, int NC, int ch, float* acc) {
    { const f32x4 b0 = *(const f32x4*)(b + ch), b1 = *(const f32x4*)(b + ch + 4); acc[0] = b0.x; acc[1] = b0.y; acc[2] = b0.z; acc[3] = b0.w; acc[4] = b1.x; acc[5] = b1.y; acc[6] = b1.z; acc[7] = b1.w; }
    if (!samp) {
#pragma unroll
        for (int d = 0; d < 3; ++d) { const int tt = t + d - 1; if (tt < 0 || tt >= 256) continue;
            float xv[8]; unpack8(*(const u32x4*)(src + (size_t)(base + tt) * ld + col0 + ch), xv);
            const f32x4 w0 = *(const f32x4*)(w + (3 + d) * NC + ch), w1 = *(const f32x4*)(w + (3 + d) * NC + ch + 4);
            acc[0] += w0.x * xv[0]; acc[1] += w0.y * xv[1]; acc[2] += w0.z * xv[2]; acc[3] += w0.w * xv[3]; acc[4] += w1.x * xv[4]; acc[5] += w1.y * xv[5]; acc[6] += w1.z * xv[6]; acc[7] += w1.w * xv[7]; }
    } else {
        const int r = t >> 6, c = t & 63;
#pragma unroll
        for (int i = 0; i < 3; ++i)
#pragma unroll
            for (int d = 0; d < 3; ++d) { const int rr = r + i - 1, cc = c + d - 1; if (rr < 0 || rr >= 16 || cc < 0 || cc >= 64) continue;
                float xv[8]; unpack8(*(const u32x4*)(src + (size_t)(base + rr * 64 + cc) * ld + col0 + ch), xv);
                const f32x4 w0 = *(const f32x4*)(w + (i * 3 + d) * NC + ch), w1 = *(const f32x4*)(w + (i * 3 + d) * NC + ch + 4);
                acc[0] += w0.x * xv[0]; acc[1] += w0.y * xv[1]; acc[2] += w0.z * xv[2]; acc[3] += w0.w * xv[3]; acc[4] += w1.x * xv[4]; acc[5] += w1.y * xv[5]; acc[6] += w1.z * xv[6]; acc[7] += w1.w * xv[7]; }
    }
}

__device__ __forceinline__ void phase_prep_even(const Params& P, const Ctx& C, int j) {
    const bf16_t* PROJ = (const bf16_t*)(P.ws + WS_PROJ); bf16_t* PREP = (bf16_t*)(P.ws + WS_PREP); bf16_t* LA = (bf16_t*)(P.ws + WS_LORAA);
    float* DT = (float*)(P.ws + WS_DT); float* DA = (float*)(P.ws + WS_DA);
    const float* cw = P.in[I_SCONVW] + (size_t)j * 9 * 2048; const float* cb = P.in[I_SCONVB] + j * 2048;
    const float* mu = P.in[I_MU] + j * 3456; const float* kkw = P.in[I_KK] + j * 1024;
    const int gw = C.bid * 8 + C.wave, NGW = C.G * 8, lane = C.lane;
    for (int m = gw; m < MTOK; m += NGW) {
        const bool samp = m >= 4096; const int T = samp ? 1024 : 256; const int t = samp ? ((m - 4096) & 1023) : (m & 255); const int base = m - t;
        const bf16_t* prow = PROJ + (size_t)m * PROJ_LD_AB; bf16_t* orow = PREP + (size_t)m * PREP_LD;
#pragma unroll 1
        for (int it = 0; it < 4; ++it) { const int ch = it * 512 + lane * 8; float acc[8];
            conv8(PROJ, PROJ_LD_AB, 1024, base, t, samp, cw, cb, 2048, ch, acc);
#pragma unroll
            for (int e = 0; e < 8; ++e) acc[e] = siluf_(acc[e]);
            *(u32x4*)(orow + ch) = pack8(acc); }
#pragma unroll
        for (int it = 0; it < 2; ++it) { const int ch = it * 512 + lane * 8; float z[8]; unpack8(*(const u32x4*)(prow + ch), z);
#pragma unroll
            for (int e = 0; e < 8; ++e) z[e] = siluf_(z[e]);
            *(u32x4*)(orow + 2048 + ch) = pack8(z); }
        if (lane < 32) { const float raw = bf2f(prow[3072 + lane]); const float dt = softplusf_(raw + P.in[I_DTB][j * 32 + lane]);
            DT[(size_t)m * 32 + lane] = dt; DA[(size_t)m * 32 + lane] = __expf(-dt * __expf(P.in[I_ALOG][j * 32 + lane])); }
        const bool hp = t > 0, hn = t < T - 1;
#pragma unroll 1
        for (int it = 0; it < 7; ++it) { const int c = it * 512 + lane * 8; if (c >= 3456) break;
            float x[8], xp[8], xn[8];
            unpack8(*(const u32x4*)(prow + IN_SSD + c), x);
            if (hp) unpack8(*(const u32x4*)(prow - PROJ_LD_AB + IN_SSD + c), xp); else {
#pragma unroll
                for (int e = 0; e < 8; ++e) xp[e] = 0.f; }
            if (hn) unpack8(*(const u32x4*)(prow + PROJ_LD_AB + IN_SSD + c), xn); else {
#pragma unroll
                for (int e = 0; e < 8; ++e) xn[e] = 0.f; }
            const f32x4 m0 = *(const f32x4*)(mu + c), m1 = *(const f32x4*)(mu + c + 4);
            const float mv[8] = {m0.x, m0.y, m0.z, m0.w, m1.x, m1.y, m1.z, m1.w};
#pragma unroll
            for (int e = 0; e < 8; ++e) x[e] = x[e] + mv[e] * (0.5f * (xp[e] + xn[e]) - x[e]);
            if (it < 2) { *(u32x4*)(orow + 3072 + c) = pack8(x); }
            else if (it < 4) { *(u32x4*)(orow + 4096 + (c - 1024)) = pack8(x);
                const f32x4 k0 = *(const f32x4*)(kkw + c - 1024), k1 = *(const f32x4*)(kkw + c - 1024 + 4);
                const float kv[8] = {k0.x, k0.y, k0.z, k0.w, k1.x, k1.y, k1.z, k1.w}; float ss = 0.f;
#pragma unroll
                for (int e = 0; e < 8; ++e) { x[e] *= kv[e]; ss += x[e] * x[e]; }
                ss += __shfl_xor(ss, 1); ss += __shfl_xor(ss, 2); ss += __shfl_xor(ss, 4);
                const float rn = rsqrtf(ss + 1e-12f);
#pragma unroll
                for (int e = 0; e < 8; ++e) x[e] *= rn;
                *(u32x4*)(orow + 6144 + (c - 1024)) = pack8(x); }
            else if (it < 6) { *(u32x4*)(orow + 5120 + (c - 2048)) = pack8(x); }
            else { const int cc = c - 3072;
#pragma unroll
                for (int e = 0; e < 8; ++e) x[e] = cc < 128 ? tanhf_(x[e]) : (cc < 256 ? x[e] : sigmoidf_(x[e]));
                *(u32x4*)(LA + (size_t)m * LORA_K + cc) = pack8(x); }
        }
    }
}
__device__ __forceinline__ void phase_prep_odd(const Params& P, const Ctx& C, int j) {
    const bf16_t* PROJ = (const bf16_t*)(P.ws + WS_PROJ); bf16_t* PREP = (bf16_t*)(P.ws + WS_PREP);
    const float* cw = P.in[I_MCONVW] + (size_t)j * 9 * 1024; const float* cb = P.in[I_MCONVB] + j * 1024;
    const int gw = C.bid * 8 + C.wave, NGW = C.G * 8, lane = C.lane;
    for (int m = gw; m < MTOK; m += NGW) {
        const bool samp = m >= 4096; const int t = samp ? ((m - 4096) & 1023) : (m & 255); const int base = m - t;
#pragma unroll 1
        for (int it = 0; it < 2; ++it) { const int ch = it * 512 + lane * 8; float acc[8];
            conv8(PROJ, PROJ_LD_CD, IN_GLA, base, t, samp, cw, cb, 1024, ch, acc);
#pragma unroll
            for (int e = 0; e < 8; ++e) acc[e] = siluf_(acc[e]);
            *(u32x4*)(PREP + (size_t)m * PREP_LD + ch) = pack8(acc); }
    }
}

template <int MODE>
__device__ __forceinline__ void diag_scan(const Params& P, const Ctx& C, int j, int s, int h, int dir_in, int vh) {
    const int tid = C.tid;
    const int dir = MODE == 0 ? (tid >> 8) : dir_in;
    const int tl = MODE == 0 ? (tid & 255) : tid;
    const int kg = tl & 15, vg = tl >> 4;
    const int T = s < 16 ? 256 : 1024, base = s < 16 ? s * 256 : 4096 + (s - 16) * 1024, nch = T >> 4;
    const bf16_t* PROJ = (const bf16_t*)(P.ws + WS_PROJ); const bf16_t* PREP = (const bf16_t*)(P.ws + WS_PREP);
    bf16_t* Y = (bf16_t*)(P.ws + WS_MP) + (size_t)dir * MTOK * YLD;
    constexpr int QO = 0, KO = 2048, AO = 4096;
    constexpr int VO = MODE == 1 ? 6144 : 4096;
    constexpr int SO = MODE == 0 ? 5120 : (MODE == 1 ? 8192 : 6144);
    constexpr int BUFSZ = MODE == 0 ? 5184 : (MODE == 1 ? 8192 : 6208);
    LAS float* L0 = (LAS float*)C.lds + (MODE == 0 ? (tid >> 8) * 2 * BUFSZ : 0);
    LAS float* GW = (LAS float*)C.lds + 2 * 8192;
    const int stt = MODE == 0 ? (tl >> 4) : (tl >> 5);
    const int sc8 = (tl & 15) * 8, sc4 = MODE == 0 ? (tl & 15) * 4 : (tl & 31) * 4;
    if (MODE == 1) {
        const float* gwp = P.in[I_GGW] + (size_t)(j * 2 + dir) * 16 * 512 + h * 128;
        for (int i = tid; i < 16 * 128; i += 512) GW[i] = gwp[(i >> 7) * 512 + (i & 127)];
        if (tid < 128) GW[2048 + tid] = P.in[I_GGB][(j * 2 + dir) * 512 + h * 128 + tid];
    }
    f32x2 S01[8], S23[8]; f32x2 N2[MODE == 2 ? 4 : 1]; float mst = 0.f;
    {
        const float* s0 = nullptr; int kstride = 64;
        if (s >= 16) { const int b = s - 16;
            if (MODE == 0) { s0 = P.in[I_SSSD] + ((size_t)((b * 2 + j) * 2 + dir) * 16 + h) * 8192 + 4 * vg; kstride = 64; }
            if (MODE == 1) { s0 = P.in[I_SGLA] + ((size_t)((b * 2 + j) * 2 + dir) * 4 + h) * 32768 + vh * 128 + 4 * vg; kstride = 256; }
            if (MODE == 2) { s0 = P.in[I_SMC] + ((size_t)((b * 2 + j) * 2 + dir) * 4 + h) * 32768 + vh * 128 + 4 * vg; kstride = 256; } }
#pragma unroll
        for (int i = 0; i < 8; ++i) { const int k = 64 * (i >> 2) + 4 * kg + (i & 3); const f32x4 v = s0 ? *(const f32x4*)(s0 + (size_t)k * kstride) : (f32x4){0.f, 0.f, 0.f, 0.f}; S01[i] = (f32x2){v.x, v.y}; S23[i] = (f32x2){v.z, v.w}; }
        if (MODE == 2) {
            const float* n0 = s >= 16 ? P.in[I_SMN] + ((size_t)(((s - 16) * 2 + j) * 2 + dir) * 4 + h) * 128 : nullptr;
#pragma unroll
            for (int hh = 0; hh < 2; ++hh) { const f32x4 v = n0 ? *(const f32x4*)(n0 + 64 * hh + 4 * kg) : (f32x4){0.f, 0.f, 0.f, 0.f}; N2[hh * 2] = (f32x2){v.x, v.y}; N2[hh * 2 + 1] = (f32x2){v.z, v.w}; }
            mst = s >= 16 ? P.in[I_SMM][(((s - 16) * 2 + j) * 2 + dir) * 4 + h] : 0.f;
        }
    }
    u32x4 rq8, rk8; u32x2 rq4, rk4, rv4; u32x4 rg0, rg1; float rs0 = 0.f, rs1 = 0.f;
    auto load_raw = [&](int c) {
        const int step = c * 16 + stt; const int m = base + (dir ? (T - 1 - step) : step);
        if (MODE == 0) { const int g = h >> 2; const bf16_t* pr = PREP + (size_t)m * PREP_LD;
            rq8 = *(const u32x4*)(pr + 1536 + g * 128 + sc8); rk8 = *(const u32x4*)(pr + 1024 + g * 128 + sc8); rv4 = *(const u32x2*)(pr + h * 64 + sc4);
            rs0 = ((const float*)(P.ws + WS_DT))[(size_t)m * 32 + dir * 16 + h]; rs1 = ((const float*)(P.ws + WS_DA))[(size_t)m * 32 + dir * 16 + h]; }
        if (MODE == 1) { const bf16_t* pr = PROJ + (size_t)m * PROJ_LD_CD;
            rq4 = *(const u32x2*)(pr + h * 128 + sc4); rk4 = *(const u32x2*)(pr + 512 + h * 128 + sc4); rv4 = *(const u32x2*)(pr + 1024 + h * 256 + vh * 128 + sc4);
            rg0 = *(const u32x4*)(pr + 3072 + dir * 16); rg1 = *(const u32x4*)(pr + 3072 + dir * 16 + 8); }
        if (MODE == 2) { const bf16_t* pr = PROJ + (size_t)m * PROJ_LD_CD; const bf16_t* pp = PREP + (size_t)m * PREP_LD;
            rq4 = *(const u32x2*)(pp + h * 128 + sc4); rk4 = *(const u32x2*)(pp + 512 + h * 128 + sc4); rv4 = *(const u32x2*)(pr + IN_GLA + 1024 + h * 256 + vh * 128 + sc4);
            rs0 = bf2f(pr[IN_GLA + 3072 + dir * 4 + h]); rs1 = bf2f(pr[IN_GLA + 3072 + 8 + dir * 4 + h]); }
    };
    auto write_lds = [&](LAS float* B) {
        if (MODE == 0) { float q[8], k[8]; unpack8(rq8, q); unpack8(rk8, k);
            *(LAS f32x4*)(B + QO + stt * 128 + sc8) = (f32x4){q[0], q[1], q[2], q[3]}; *(LAS f32x4*)(B + QO + stt * 128 + sc8 + 4) = (f32x4){q[4], q[5], q[6], q[7]};
            *(LAS f32x4*)(B + KO + stt * 128 + sc8) = (f32x4){k[0], k[1], k[2], k[3]}; *(LAS f32x4*)(B + KO + stt * 128 + sc8 + 4) = (f32x4){k[4], k[5], k[6], k[7]};
            *(LAS f32x4*)(B + VO + stt * 64 + sc4) = unpack4(rv4) * rs0;
            if ((tl & 15) == 0) B[SO + stt] = rs1; }
        if (MODE == 1) {
            *(LAS f32x4*)(B + QO + stt * 128 + sc4) = unpack4(rq4) * 0.08838834764831845f; *(LAS f32x4*)(B + KO + stt * 128 + sc4) = unpack4(rk4);
            *(LAS f32x4*)(B + VO + stt * 128 + sc4) = unpack4(rv4);
            float gd[16]; unpack8(rg0, gd); unpack8(rg1, gd + 8);
            f32x4 gp = *(LAS f32x4*)(GW + 2048 + sc4);
#pragma unroll
            for (int r = 0; r < 16; ++r) gp = gp + *(LAS f32x4*)(GW + r * 128 + sc4) * gd[r];
            f32x4 a;
#pragma unroll
            for (int e = 0; e < 4; ++e) a[e] = __expf(logsigmoidf_(gp[e]) * 0.0625f);
            *(LAS f32x4*)(B + AO + stt * 128 + sc4) = a; }
        if (MODE == 2) {
            *(LAS f32x4*)(B + QO + stt * 128 + sc4) = unpack4(rq4); *(LAS f32x4*)(B + KO + stt * 128 + sc4) = unpack4(rk4) * 0.08838834764831845f;
            *(LAS f32x4*)(B + VO + stt * 128 + sc4) = unpack4(rv4);
            if ((tl & 31) == 0) { B[SO + stt * 2] = rs0 + P.in[I_MIB][(j * 2 + dir) * 4 + h]; B[SO + stt * 2 + 1] = logsigmoidf_(rs1 + P.in[I_MFB][(j * 2 + dir) * 4 + h]); } }
    };
    __syncthreads();
    load_raw(0); write_lds(L0);
    __syncthreads();
    const int ycol = (MODE == 0 ? h * 64 : (MODE == 1 ? h * 256 + vh * 128 : 1024 + h * 256 + vh * 128)) + 4 * vg;
    constexpr int VW = MODE == 0 ? 64 : 128;
    for (int c = 0; c < nch; ++c) {
        LAS float* B = L0 + (c & 1) * BUFSZ;
        if (c + 1 < nch) load_raw(c + 1);
#pragma unroll 2
        for (int tt = 0; tt < 16; ++tt) {
            const int step = c * 16 + tt; const int m = base + (dir ? (T - 1 - step) : step);
            f32x4 vv4 = *(LAS f32x4*)(B + VO + tt * VW + 4 * vg);
            float dec = 1.f, an = 1.f;
            if (MODE == 0) dec = B[SO + tt];
            if (MODE == 2) { const float ig = B[SO + tt * 2], lf = B[SO + tt * 2 + 1]; const float mn = fmaxf(lf + mst, ig); dec = __expf(lf + mst - mn); an = __expf(ig - mn); vv4 = vv4 * an; mst = mn; }
            const f32x2 v01 = (f32x2){vv4.x, vv4.y}, v23 = (f32x2){vv4.z, vv4.w};
            f32x2 acc01 = (f32x2){0.f, 0.f}, acc23 = (f32x2){0.f, 0.f}, den2 = (f32x2){0.f, 0.f};
#pragma unroll
            for (int hh = 0; hh < 2; ++hh) {
                const f32x4 q4 = *(LAS f32x4*)(B + QO + tt * 128 + 64 * hh + 4 * kg), k4 = *(LAS f32x4*)(B + KO + tt * 128 + 64 * hh + 4 * kg);
                f32x4 a4 = (f32x4){dec, dec, dec, dec}; if (MODE == 1) a4 = *(LAS f32x4*)(B + AO + tt * 128 + 64 * hh + 4 * kg);
#pragma unroll
                for (int e = 0; e < 4; ++e) { const int i = hh * 4 + e; const f32x2 as = (f32x2){a4[e], a4[e]}, ks2 = (f32x2){k4[e], k4[e]}, qs = (f32x2){q4[e], q4[e]};
                    S01[i] = S01[i] * as + ks2 * v01; S23[i] = S23[i] * as + ks2 * v23;
                    acc01 = acc01 + S01[i] * qs; acc23 = acc23 + S23[i] * qs; }
                if (MODE == 2) { const f32x2 d2 = (f32x2){dec, dec}, an2 = (f32x2){an, an};
                    N2[hh * 2] = N2[hh * 2] * d2 + (f32x2){k4.x, k4.y} * an2; N2[hh * 2 + 1] = N2[hh * 2 + 1] * d2 + (f32x2){k4.z, k4.w} * an2;
                    den2 = den2 + N2[hh * 2] * (f32x2){q4.x, q4.y} + N2[hh * 2 + 1] * (f32x2){q4.z, q4.w}; }
            }
            float o0 = row_sum16(acc01.x), o1 = row_sum16(acc01.y), o2 = row_sum16(acc23.x), o3 = row_sum16(acc23.y);
            if (MODE == 2) { const float den = row_sum16(den2.x + den2.y); const float r = 1.f / fmaxf(fabsf(den), __expf(-mst)); o0 *= r; o1 *= r; o2 *= r; o3 *= r; }
            if (kg == 0) { u32x2 w; w.x = pk2(o0, o1); w.y = pk2(o2, o3); *(u32x2*)(Y + (size_t)m * YLD + ycol) = w; }
        }
        if (c + 1 < nch) write_lds(L0 + ((c + 1) & 1) * BUFSZ);
        __syncthreads();
    }
    if (s < 16) {
        float* o; int kstride;
        if (MODE == 0) { o = P.out + O_SSD + ((size_t)((s * 2 + j) * 2 + dir) * 16 + h) * 8192 + 4 * vg; kstride = 64; }
        else { o = P.out + (MODE == 1 ? O_GLA : O_MC) + ((size_t)((s * 2 + j) * 2 + dir) * 4 + h) * 32768 + vh * 128 + 4 * vg; kstride = 256; }
#pragma unroll
        for (int i = 0; i < 8; ++i) { const int k = 64 * (i >> 2) + 4 * kg + (i & 3); *(f32x4*)(o + (size_t)k * kstride) = (f32x4){S01[i].x, S01[i].y, S23[i].x, S23[i].y}; }
        if (MODE == 2 && vh == 0 && vg == 0) { float* no = P.out + O_MN + ((size_t)((s * 2 + j) * 2 + dir) * 4 + h) * 128;
#pragma unroll
            for (int hh = 0; hh < 2; ++hh) *(f32x4*)(no + 64 * hh + 4 * kg) = (f32x4){N2[hh * 2].x, N2[hh * 2].y, N2[hh * 2 + 1].x, N2[hh * 2 + 1].y};
            if (kg == 0) P.out[O_MM + ((s * 2 + j) * 2 + dir) * 4 + h] = mst; }
    }
}

__device__ __forceinline__ void rwkv_scan(const Params& P, const Ctx& C, int j, int s, int h) {
    const int tid = C.tid, dir = tid >> 8, tl = tid & 255, kg = tl & 7, vg = tl >> 3;
    const int T = s < 16 ? 256 : 1024, base = s < 16 ? s * 256 : 4096 + (s - 16) * 1024, nch = T >> 4;
    const bf16_t* PREP = (const bf16_t*)(P.ws + WS_PREP); const bf16_t* LOUT = (const bf16_t*)(P.ws + WS_PROJ);
    bf16_t* Y = (bf16_t*)(P.ws + WS_MP) + (size_t)dir * MTOK * YLD;
    constexpr int BUFSZ = 6 * 1024;
    LAS float* L0 = (LAS float*)C.lds + dir * 2 * BUFSZ;
    const int stt = tl >> 4, sc4 = (tl & 15) * 4;
    const f32x4 w0 = *(const f32x4*)(P.in[I_W0] + (j * 2 + dir) * 1024 + h * 64 + sc4), a0 = *(const f32x4*)(P.in[I_A0] + (j * 2 + dir) * 1024 + h * 64 + sc4), ka = *(const f32x4*)(P.in[I_KA] + j * 1024 + h * 64 + sc4);
    f32x2 S2[8];
    { const float* s0 = s >= 16 ? P.in[I_SRWKV] + (((size_t)(((s - 16) * 2 + j) * 2 + dir) * 16 + h) * 64 + 2 * vg) * 64 : nullptr;
#pragma unroll
        for (int hh = 0; hh < 2; ++hh) { const f32x4 u0 = s0 ? *(const f32x4*)(s0 + 32 * hh + 4 * kg) : (f32x4){0.f, 0.f, 0.f, 0.f}, u1 = s0 ? *(const f32x4*)(s0 + 64 + 32 * hh + 4 * kg) : (f32x4){0.f, 0.f, 0.f, 0.f};
#pragma unroll
            for (int e = 0; e < 4; ++e) S2[hh * 4 + e] = (f32x2){u0[e], u1[e]}; } }
    u32x2 rr, rk, rv, rkk, rwl, ral;
    auto load_raw = [&](int c) {
        const int step = c * 16 + stt; const int m = base + (dir ? (T - 1 - step) : step);
        const bf16_t* pp = PREP + (size_t)m * PREP_LD + h * 64 + sc4; const bf16_t* lo = LOUT + (size_t)m * LOUT_LD + dir * 1024 + h * 64 + sc4;
        rr = *(const u32x2*)(pp + 3072); rk = *(const u32x2*)(pp + 4096); rv = *(const u32x2*)(pp + 5120); rkk = *(const u32x2*)(pp + 6144);
        rwl = *(const u32x2*)lo; ral = *(const u32x2*)(lo + 2048);
    };
    auto write_lds = [&](LAS float* B) {
        const f32x4 r = unpack4(rr), k = unpack4(rk), v = unpack4(rv), kk = unpack4(rkk), wl = unpack4(rwl), al = unpack4(ral);
        f32x4 w, kd, kka;
#pragma unroll
        for (int e = 0; e < 4; ++e) { const float wp = w0[e] + wl[e]; const float lw = -__expf(-softplusf_(-wp) - 0.5f); w[e] = __expf(lw);
            const float a = sigmoidf_(a0[e] + al[e]); kd[e] = k[e] * (1.f + (a - 1.f) * ka[e]); kka[e] = kk[e] * a; }
        LAS float* p = B + stt * 64 + sc4;
        *(LAS f32x4*)(p) = r; *(LAS f32x4*)(p + 1024) = w; *(LAS f32x4*)(p + 2048) = kd; *(LAS f32x4*)(p + 3072) = v; *(LAS f32x4*)(p + 4096) = kk; *(LAS f32x4*)(p + 5120) = kka;
    };
    __syncthreads();
    load_raw(0); write_lds(L0);
    __syncthreads();
    const int ycol = 1024 + h * 64 + 2 * vg;
    for (int c = 0; c < nch; ++c) {
        LAS float* B = L0 + (c & 1) * BUFSZ;
        if (c + 1 < nch) load_raw(c + 1);
#pragma unroll 2
        for (int tt = 0; tt < 16; ++tt) {
            const int step = c * 16 + tt; const int m = base + (dir ? (T - 1 - step) : step);
            LAS float* p = B + tt * 64 + 4 * kg;
            const f32x2 vv2 = *(LAS f32x2*)(B + 3072 + tt * 64 + 2 * vg);
            f32x2 d2 = (f32x2){0.f, 0.f};
#pragma unroll
            for (int hh = 0; hh < 2; ++hh) { const f32x4 kk4 = *(LAS f32x4*)(p + 4096 + 32 * hh);
#pragma unroll
                for (int e = 0; e < 4; ++e) d2 = d2 + S2[hh * 4 + e] * (f32x2){kk4[e], kk4[e]}; }
            f32x2 sk2; sk2.x = row_sum8(d2.x); sk2.y = row_sum8(d2.y);
            f32x2 y2 = (f32x2){0.f, 0.f};
#pragma unroll
            for (int hh = 0; hh < 2; ++hh) { const f32x4 w4 = *(LAS f32x4*)(p + 1024 + 32 * hh), kd4 = *(LAS f32x4*)(p + 2048 + 32 * hh), ka4 = *(LAS f32x4*)(p + 5120 + 32 * hh), r4 = *(LAS f32x4*)(p + 32 * hh);
#pragma unroll
                for (int e = 0; e < 4; ++e) { const int i = hh * 4 + e;
                    S2[i] = S2[i] * (f32x2){w4[e], w4[e]} - sk2 * (f32x2){ka4[e], ka4[e]} + vv2 * (f32x2){kd4[e], kd4[e]};
                    y2 = y2 + S2[i] * (f32x2){r4[e], r4[e]}; } }
            const float ya = row_sum8(y2.x), yb = row_sum8(y2.y);
            if (kg == 0) *(unsigned*)(Y + (size_t)m * YLD + ycol) = pk2(ya, yb);
        }
        if (c + 1 < nch) write_lds(L0 + ((c + 1) & 1) * BUFSZ);
        __syncthreads();
    }
    if (s < 16) { float* o = P.out + O_RWKV + (((size_t)((s * 2 + j) * 2 + dir) * 16 + h) * 64 + 2 * vg) * 64;
#pragma unroll
        for (int hh = 0; hh < 2; ++hh) { *(f32x4*)(o + 32 * hh + 4 * kg) = (f32x4){S2[hh * 4].x, S2[hh * 4 + 1].x, S2[hh * 4 + 2].x, S2[hh * 4 + 3].x};
            *(f32x4*)(o + 64 + 32 * hh + 4 * kg) = (f32x4){S2[hh * 4].y, S2[hh * 4 + 1].y, S2[hh * 4 + 2].y, S2[hh * 4 + 3].y}; } }
}

__device__ __forceinline__ void phase_scan(const Params& P, const Ctx& C, int l) {
    const int j = l >> 1; const bool ev = (l & 1) == 0;
    for (int round = 0; round < 8; ++round) {
        int q;
        if (C.G == 256) { if (C.bid < 128) { if (round > 0) break; q = C.bid; } else { if (round > 3) break; q = 128 + (C.bid - 128) * 4 + round; } }
        else { q = C.bid + round * C.G; if (q >= 640) break; }
        int type, idx, s;
        if (q < 128) { type = q >> 6; idx = q & 63; s = 16 + (idx >> 4); idx &= 15; }
        else { const int r = q - 128; type = r >> 8; idx = r & 255; s = idx >> 4; idx &= 15; }
        if (ev) { if (type == 0) diag_scan<0>(P, C, j, s, idx, 0, 0); else rwkv_scan(P, C, j, s, idx); }
        else { const int dir = idx >> 3, h = (idx >> 1) & 3, vh = idx & 1; if (type == 0) diag_scan<1>(P, C, j, s, h, dir, vh); else diag_scan<2>(P, C, j, s, h, dir, vh); }
    }
}

__device__ __forceinline__ void ld16(const bf16_t* p, float* o) { unpack8(*(const u32x4*)p, o); unpack8(*(const u32x4*)(p + 8), o + 8); }
__device__ __forceinline__ void ld16f(const float* p, float* o) {
#pragma unroll
    for (int q = 0; q < 4; ++q) { const f32x4 v = *(const f32x4*)(p + 4 * q); o[4 * q] = v.x; o[4 * q + 1] = v.y; o[4 * q + 2] = v.z; o[4 * q + 3] = v.w; } }
__device__ __forceinline__ void st16(bf16_t* p, const float* o) { *(u32x4*)p = pack8(o); *(u32x4*)(p + 8) = pack8(o + 8); }
__device__ __forceinline__ void phase_post(const Params& P, const Ctx& C, int l) {
    const int j = l >> 1; const bool ev = (l & 1) == 0;
    const bf16_t* PROJ = (const bf16_t*)(P.ws + WS_PROJ); const bf16_t* PREP = (const bf16_t*)(P.ws + WS_PREP);
    const bf16_t* Y0 = (const bf16_t*)(P.ws + WS_MP); const bf16_t* Y1 = Y0 + (size_t)MTOK * YLD; bf16_t* MIX = (bf16_t*)(P.ws + WS_MIX);
    const int gw = C.bid * 8 + C.wave, NGW = C.G * 8, lane = C.lane, c0 = lane * 16;
    for (int m = gw; m < MTOK; m += NGW) {
        float ya[16], yb[16], t0[16], t1[16], o[16];
        if (ev) {
            const bf16_t* pp = PREP + (size_t)m * PREP_LD;
            ld16(Y0 + (size_t)m * YLD + c0, ya); ld16(Y1 + (size_t)m * YLD + c0, yb); ld16(pp + c0, t0); ld16(pp + 2048 + c0, t1);
            const float dsk = P.in[I_SSDD][j * 16 + (lane >> 2)]; float ss = 0.f;
#pragma unroll
            for (int e = 0; e < 16; ++e) { o[e] = (ya[e] + yb[e] + t0[e] * dsk) * t1[e]; ss += o[e] * o[e]; }
            const float rs = rsqrtf(wave_sum(ss) * (1.f / 1024.f) + 1e-6f);
            ld16f(P.in[I_SSDN] + j * 1024 + c0, t0);
#pragma unroll
            for (int e = 0; e < 16; ++e) o[e] = o[e] * rs * t0[e];
            st16(MIX + (size_t)m * 2048 + c0, o);
            ld16(Y0 + (size_t)m * YLD + 1024 + c0, ya); ld16(Y1 + (size_t)m * YLD + 1024 + c0, yb);
            float mu = 0.f;
#pragma unroll
            for (int e = 0; e < 16; ++e) { ya[e] += yb[e]; mu += ya[e]; }
            mu += __shfl_xor(mu, 1); mu += __shfl_xor(mu, 2); mu *= (1.f / 64.f);
            float var = 0.f;
#pragma unroll
            for (int e = 0; e < 16; ++e) { ya[e] -= mu; var += ya[e] * ya[e]; }
            var += __shfl_xor(var, 1); var += __shfl_xor(var, 2); var *= (1.f / 64.f);
            const float rstd = rsqrtf(var + 64e-5f);
            ld16f(P.in[I_LNW] + j * 1024 + c0, t0); ld16f(P.in[I_LNB] + j * 1024 + c0, t1);
#pragma unroll
            for (int e = 0; e < 16; ++e) o[e] = ya[e] * rstd * t0[e] + t1[e];
            ld16(pp + 3072 + c0, ya); ld16(pp + 4096 + c0, yb); ld16f(P.in[I_RK] + j * 1024 + c0, t0);
            float bs = 0.f;
#pragma unroll
            for (int e = 0; e < 16; ++e) bs += ya[e] * yb[e] * t0[e];
            bs += __shfl_xor(bs, 1); bs += __shfl_xor(bs, 2);
            ld16(pp + 5120 + c0, ya); ld16(PROJ + (size_t)m * LOUT_LD + 4096 + c0, yb);
#pragma unroll
            for (int e = 0; e < 16; ++e) o[e] = (o[e] + bs * ya[e]) * yb[e];
            st16(MIX + (size_t)m * 2048 + 1024 + c0, o);
        } else {
            const bf16_t* pr = PROJ + (size_t)m * PROJ_LD_CD;
#pragma unroll
            for (int g = 0; g < 2; ++g) {
                ld16(Y0 + (size_t)m * YLD + g * 1024 + c0, ya); ld16(Y1 + (size_t)m * YLD + g * 1024 + c0, yb);
                float ss = 0.f;
#pragma unroll
                for (int e = 0; e < 16; ++e) { ya[e] += yb[e]; ss += ya[e] * ya[e]; }
                ss += __shfl_xor(ss, 1); ss += __shfl_xor(ss, 2); ss += __shfl_xor(ss, 4); ss += __shfl_xor(ss, 8);
                const float rs = rsqrtf(ss * (1.f / 256.f) + 1e-6f);
                ld16f((g == 0 ? P.in[I_GLAN] : P.in[I_MLN]) + j * 1024 + c0, t0);
                ld16(pr + (g == 0 ? 2048 : IN_GLA + 2048) + c0, t1);
#pragma unroll
                for (int e = 0; e < 16; ++e) o[e] = ya[e] * rs * t0[e] * (g == 0 ? siluf_(t1[e]) : sigmoidf_(t1[e]));
                st16(MIX + (size_t)m * 2048 + g * 1024 + c0, o);
            }
        }
    }
}

__global__ void __launch_bounds__(512, 2) hybrid_fwd(Params P) {
    extern __shared__ __attribute__((aligned(16))) unsigned char lds_raw[];
    cg::grid_group grid = cg::this_grid();
    Ctx C; C.lds = (LAS unsigned char*)lds_raw; C.tid = threadIdx.x; C.lane = C.tid & 63; C.wave = __builtin_amdgcn_readfirstlane(C.tid >> 6); C.G = gridDim.x; C.bid = blockIdx.x;
    const float* MOD = (const float*)(P.ws + WS_MOD);
    const bf16_t* H = (const bf16_t*)(P.ws + WS_H);
    if (C.tid < 4) ((volatile LAS unsigned*)(C.lds + LDS_BYTES - 16))[C.tid] = 0u;
    __syncthreads();
    const XcdBarrier xb = xcd_barrier_post((unsigned*)(P.ws + WS_CTL), (volatile LAS unsigned*)(C.lds + LDS_BYTES - 16));
    REP(1) if (PH & 1) phase_mod(P, fresh_ctx(C.lds));
    REP(2) if (PH & 2) phase_convert(P, fresh_ctx(C.lds), 0);
    grid.sync();
    if (PH & 4) phase_rows(P, fresh_ctx(C.lds), 0, nullptr, nullptr, true, P.in[I_NORMG] + 0, MOD + 0);
    GSYNC();
#pragma unroll 1
    for (int l = 0; l < 4; ++l) {
        const bool ev = (l & 1) == 0; const float* modl = MOD + (size_t)l * 5 * 6144; const float* ng = P.in[I_NORMG] + l * 4 * 1024;
        REP(8) if (PH & 8) { pg8::Gemm g{H, (const bf16_t*)(P.ws + WS_WIN), 1024, 1024, 1024}; pg8::Sched<0> S; S.init(MTOK, ev ? N_AB_P : N_CD_P, 1, 1024, C.G, C.bid);
          pg8::EpiBf16<0> E{(bf16_t*)(P.ws + WS_PROJ), ev ? PROJ_LD_AB : PROJ_LD_CD}; pg8::gemm_phase(C.lds, g, S, E); }
        GSYNC();
        REP(16) if (PH & 16) { if (ev) phase_prep_even(P, fresh_ctx(C.lds), l >> 1); else phase_prep_odd(P, fresh_ctx(C.lds), l >> 1); }
        GSYNC();
        if (ev && (PH & 32)) {
            REP(32) {
            pg8::Gemm g{(const bf16_t*)(P.ws + WS_LORAA), (const bf16_t*)(P.ws + WS_WLORA), LORA_K, 128, 128}; pg8::Sched<1> S; S.init(MTOK, LOUT_LD, 1, 128, C.G, C.bid);
            pg8::EpiBf16<0> E{(bf16_t*)(P.ws + WS_PROJ), LOUT_LD}; pg8::gemm_phase(C.lds, g, S, E); }
            GSYNC();
        }
        REP(64) if (PH & 64) phase_scan(P, fresh_ctx(C.lds), l);
        GSYNC();
        REP(128) if (PH & 128) phase_post(P, fresh_ctx(C.lds), l);
        GSYNC();
        REP(256) if (PH & 256) { pg8::Gemm g{(const bf16_t*)(P.ws + WS_MIX), (const bf16_t*)(P.ws + WS_WOUT), 2048, 2048, 1024}; pg8::Sched<0> S; S.init(MTOK, 1024, 2, 1024, C.G, C.bid);
          pg8::EpiF32 E{(float*)(P.ws + WS_MP), 1024, (size_t)MTOK * 1024}; pg8::gemm_phase(C.lds, g, S, E); }
        GSYNC();
        if (PH & 512) phase_rows(P, fresh_ctx(C.lds), 1, ng + 1024, modl + 2048, true, ng + 2048, modl + 3072);
        GSYNC();
        REP(1024) if (PH & 1024) { pg8::Gemm g{H, (const bf16_t*)(P.ws + WS_WUP), 1024, 1024, 1024}; pg8::Sched<0> S; S.init(MTOK, 4096, 1, 1024, C.G, C.bid);
          pg8::EpiBf16<2> E{(bf16_t*)(P.ws + WS_PROJ), 4096}; pg8::gemm_phase(C.lds, g, S, E); }
        GSYNC();
        REP(2048) if (PH & 2048) { pg8::Gemm g{(const bf16_t*)(P.ws + WS_PROJ), (const bf16_t*)(P.ws + WS_WDN), 4096, 4096, 2048}; pg8::Sched<0> S; S.init(MTOK, 1024, 2, 2048, C.G, C.bid);
          pg8::EpiF32 E{(float*)(P.ws + WS_MP), 1024, (size_t)MTOK * 1024}; pg8::gemm_phase(C.lds, g, S, E); }
        GSYNC();
        if (PH & 4096) { if (l < 3) { phase_rows(P, fresh_ctx(C.lds), 1, ng + 3072, modl + 5120, true, ng + 4096, modl + 5 * 6144); phase_convert(P, fresh_ctx(C.lds), l + 1); }
        else phase_rows(P, fresh_ctx(C.lds), 1, ng + 3072, modl + 5120, false, nullptr, nullptr); }
        if (l < 3) GSYNC();
    }
}

extern "C" void kernel_launch(void* const* d_in, const int* in_sizes, int n_in, void* d_out, int out_size, void* d_ws, size_t ws_size, hipStream_t stream) {
    static int grid = 0;
    if (grid == 0) {
        if (n_in != 44 || ws_size < WS_END) { fprintf(stderr, "kernel_launch: unexpected n_in %d / ws %zu\n", n_in, ws_size); grid = -1; return; }
        int dev = 0, cus = 0, per_cu = 0;
        hipGetDevice(&dev); hipDeviceGetAttribute(&cus, hipDeviceAttributeMultiprocessorCount, dev);
        if (hipFuncSetAttribute((const void*)hybrid_fwd, hipFuncAttributeMaxDynamicSharedMemorySize, LDS_BYTES) != hipSuccess) { fprintf(stderr, "hipFuncSetAttribute failed\n"); grid = -1; return; }
        hipOccupancyMaxActiveBlocksPerMultiprocessor(&per_cu, (const void*)hybrid_fwd, 512, LDS_BYTES);
        (void)hipGetLastError();
        if (per_cu < 1) per_cu = 1;
        grid = cus * 1;
    }
    if (grid < 0) return;
    if (hipMemsetAsync((char*)d_ws + WS_CTL, 0, CTL_BYTES, stream) != hipSuccess) { fprintf(stderr, "memset failed\n"); return; }
    Params p{};
    for (int i = 0; i < 44; ++i) p.in[i] = (const float*)d_in[i];
    p.out = (float*)d_out; p.ws = (unsigned char*)d_ws;
    void* args[] = {&p};
    hipError_t e = hipLaunchCooperativeKernel((const void*)hybrid_fwd, dim3(grid), dim3(512), args, LDS_BYTES, stream);
    if (e != hipSuccess) fprintf(stderr, "cooperative launch failed: %s (grid %d)\n", hipGetErrorString(e), grid);
}
```

```cpp
#include <hip/hip_runtime.h>
#include <hip/hip_cooperative_groups.h>
#include <cstdio>
#include <cstdint>
namespace cg = cooperative_groups;

#define LAS __attribute__((address_space(3)))
typedef unsigned short bf16_t;
typedef short bf16x8 __attribute__((ext_vector_type(8)));
typedef float f32x4 __attribute__((ext_vector_type(4)));
typedef float f32x2 __attribute__((ext_vector_type(2)));
typedef unsigned u32x4 __attribute__((ext_vector_type(4)));
typedef unsigned u32x2 __attribute__((ext_vector_type(2)));

constexpr int MTOK = 8192, DM = 1024, DFF = 4096;
constexpr int N_AB = 6560, N_AB_P = 6656, N_CD = 6192, N_CD_P = 6400;
constexpr int PROJ_LD_AB = N_AB_P, PROJ_LD_CD = N_CD_P;
constexpr int PREP_LD = 7168, LOUT_LD = 5120, LORA_K = 384, YLD = 2048;
constexpr int IN_SSD = 3104, IN_GLA = 3104;
constexpr size_t MiB = 1u << 20;
constexpr size_t WS_MOD = 0, WS_CTL = 512 * 1024, CTL_BYTES = 16384, WS_DT = 1 * MiB, WS_DA = 3 * MiB, WS_WIN = 5 * MiB, WS_WOUT = 19 * MiB, WS_WUP = 23 * MiB, WS_WDN = 31 * MiB,
                 WS_WLORA = 39 * MiB, WS_H = 41 * MiB, WS_PROJ = 57 * MiB, WS_PREP = 161 * MiB, WS_MIX = 273 * MiB, WS_MP = 305 * MiB,
                 WS_LORAA = 369 * MiB, WS_END = 375 * MiB;
constexpr size_t O_X = 0, O_SSD = 8388608, O_RWKV = 16777216, O_GLA = 20971520, O_MC = 29360128, O_MN = 37748736, O_MM = 37781504;

struct Params { const float* in[44]; float* out; unsigned char* ws; };
enum { I_XP = 0, I_XS, I_SSSD, I_SRWKV, I_SGLA, I_SMC, I_SMN, I_SMM, I_C, I_CCTX, I_WMOD, I_BMOD, I_NORMG, I_WUP, I_WDN, I_WINAB, I_SCONVW, I_SCONVB,
       I_DTB, I_ALOG, I_SSDD, I_SSDN, I_MU, I_W0, I_W2, I_A0, I_A2, I_G2, I_KK, I_KA, I_RK, I_LNW, I_LNB, I_WOUTAB, I_WINCD, I_GGW, I_GGB, I_GLAN,
       I_MCONVW, I_MCONVB, I_MIB, I_MFB, I_MLN, I_WOUTCD };

__device__ __forceinline__ float bf2f(unsigned b) { return __uint_as_float(b << 16); }
__device__ __forceinline__ unsigned f2bf(float f) { unsigned u = __float_as_uint(f); return (u + 0x7fffu + ((u >> 16) & 1u)) >> 16; }
__device__ __forceinline__ unsigned pk2(float lo, float hi) { return f2bf(lo) | (f2bf(hi) << 16); }
__device__ __forceinline__ float lo16(unsigned w) { return __uint_as_float(w << 16); }
__device__ __forceinline__ float hi16(unsigned w) { return __uint_as_float(w & 0xffff0000u); }
__device__ __forceinline__ void unpack8(u32x4 w, float* o) { o[0] = lo16(w.x); o[1] = hi16(w.x); o[2] = lo16(w.y); o[3] = hi16(w.y); o[4] = lo16(w.z); o[5] = hi16(w.z); o[6] = lo16(w.w); o[7] = hi16(w.w); }
__device__ __forceinline__ f32x4 unpack4(u32x2 w) { return (f32x4){lo16(w.x), hi16(w.x), lo16(w.y), hi16(w.y)}; }
__device__ __forceinline__ u32x4 pack8(const float* o) { u32x4 w; w.x = pk2(o[0], o[1]); w.y = pk2(o[2], o[3]); w.z = pk2(o[4], o[5]); w.w = pk2(o[6], o[7]); return w; }
__device__ __forceinline__ float sigmoidf_(float x) { return 1.f / (1.f + __expf(-x)); }
__device__ __forceinline__ float siluf_(float x) { return x / (1.f + __expf(-x)); }
__device__ __forceinline__ float softplusf_(float x) { return fmaxf(x, 0.f) + __logf(1.f + __expf(-fabsf(x))); }
__device__ __forceinline__ float logsigmoidf_(float x) { return fminf(x, 0.f) - __logf(1.f + __expf(-fabsf(x))); }
__device__ __forceinline__ float tanhf_(float x) { const float e = __expf(-2.f * fabsf(x)); const float r = (1.f - e) / (1.f + e); return x < 0.f ? -r : r; }
__device__ __forceinline__ float wave_sum(float v) {
#pragma unroll
    for (int o = 1; o < 64; o <<= 1) v += __shfl_xor(v, o);
    return v;
}
__device__ __forceinline__ float quad_sum(float x) {
    x += __int_as_float(__builtin_amdgcn_update_dpp(0, __float_as_int(x), 0xB1, 0xF, 0xF, true));
    x += __int_as_float(__builtin_amdgcn_update_dpp(0, __float_as_int(x), 0x4E, 0xF, 0xF, true));
    return x;
}

#define DPP_ADD(x, ctrl) ((x) + __int_as_float(__builtin_amdgcn_update_dpp(0, __float_as_int(x), (ctrl), 0xF, 0xF, true)))
__device__ __forceinline__ float row_sum8(float x) { x = DPP_ADD(x, 0xB1); x = DPP_ADD(x, 0x4E); x = DPP_ADD(x, 0x141); return x; }
__device__ __forceinline__ float row_sum16(float x) { x = row_sum8(x); x = DPP_ADD(x, 0x140); return x; }
namespace pg8 {
constexpr int BM = 256, BK = 64, HALF = 128, HTB = HALF * BK * 2, STAGE_BYTES = 8 * HTB, NXCD = 8, WGM = 8;
__host__ __device__ __forceinline__ int lds_byte(int r, int c) { const int st = (r >> 4) * 2 + (c >> 5), rr = r & 15, cc = c & 31, ob = rr * 64 + cc * 2; return st * 1024 + (ob ^ (((ob >> 9) & 1) << 5)); }
__host__ __device__ __forceinline__ void stage_rc(int b, int& R, int& C) { const int st = b / 1024, sb = b % 1024, swz = sb ^ (((sb >> 9) & 1) << 5); R = (st >> 1) * 16 + swz / 64; C = (st & 1) * 32 + (swz % 64) / 2; }
__host__ __device__ __forceinline__ int perm32(int rho) { const int n = rho >> 4, i = rho & 15; return 8 * (i >> 2) + 4 * n + (i & 3); }

struct Unit { int pm, pn, ks; };
struct Gemm { const bf16_t* A; const bf16_t* Bt; int lda, ldb, K; };
template <int mode> struct Sched {
    int nM, nN, nNv, nwg, G, c, K;
    __device__ void init(int M, int N, int nK, int K_, int G_, int c_) { nM = M / BM; nN = N / BM; nNv = nN * nK; nwg = nM * nNv; G = G_; c = c_; K = K_; }
    __device__ bool next(int i, Unit& u) const {
        const long L = (long)i * G + c; if (L >= nwg) return false;
        int wgid = (int)L; { const int q = nwg / NXCD, r = nwg % NXCD, xcd = wgid % NXCD, off = wgid / NXCD; wgid = (xcd < r ? xcd * (q + 1) : r * (q + 1) + (xcd - r) * q) + off; }
        const int nig = WGM * nNv, gid = wgid / nig, fm = gid * WGM, gsz = (nM - fm) < WGM ? (nM - fm) : WGM;
        u.pm = fm + ((wgid % nig) % gsz); const int pnv = (wgid % nig) / gsz; u.pn = pnv % nN; u.ks = pnv / nN; return true;
    }
    __device__ __forceinline__ size_t aoff(const Unit& u) const { if (mode == 1) { const int g = u.pn >> 2; return (size_t)(g < 2 ? 0 : (g < 4 ? 128 : 256)) * 2; } return (size_t)u.ks * K * 2; }
    __device__ __forceinline__ size_t boff(const Unit& u) const { return mode == 1 ? 0 : (size_t)u.ks * K * 2; }
};

__device__ __forceinline__ unsigned cvt_pk_bf16(float lo, float hi) { unsigned r; asm volatile("v_cvt_pk_bf16_f32 %0, %1, %2" : "=v"(r) : "v"(lo), "v"(hi)); return r; }

template <int ACT> struct EpiBf16 {
    static constexpr bool PERM = true;
    bf16_t* O; int ldc;
    __device__ __forceinline__ void operator()(const f32x4 (&acc)[2][2][4][2], const Unit& u, int wr, int wc, int fr, int fq) const {
        const int row0 = u.pm * BM + wr * 64 + fr; const int col0 = u.pn * BM + wc * 32 + 8 * fq;
#pragma unroll
        for (int ai = 0; ai < 2; ++ai)
#pragma unroll
            for (int m = 0; m < 4; ++m) { bf16_t* rowp = O + (size_t)(row0 + ai * HALF + m * 16) * ldc + col0;
#pragma unroll
                for (int bj = 0; bj < 2; ++bj) { f32x4 v0 = acc[ai][bj][m][0], v1 = acc[ai][bj][m][1];
                    if (ACT == 2) {
#pragma unroll
                        for (int e = 0; e < 4; ++e) { const float a = fmaxf(v0[e], 0.f), b = fmaxf(v1[e], 0.f); v0[e] = a * a; v1[e] = b * b; } }
                    u32x4 w; w.x = cvt_pk_bf16(v0[0], v0[1]); w.y = cvt_pk_bf16(v0[2], v0[3]); w.z = cvt_pk_bf16(v1[0], v1[1]); w.w = cvt_pk_bf16(v1[2], v1[3]);
                    *(u32x4*)(rowp + bj * HALF) = w; } }
    }
};
struct EpiF32 {
    static constexpr bool PERM = false;
    float* O; int ldc; size_t pstride;
    __device__ __forceinline__ void operator()(const f32x4 (&acc)[2][2][4][2], const Unit& u, int wr, int wc, int fr, int fq) const {
        float* base = O + (size_t)u.ks * pstride; const int col0 = u.pn * BM + wc * 32 + 4 * fq;
#pragma unroll
        for (int ai = 0; ai < 2; ++ai)
#pragma unroll
            for (int m = 0; m < 4; ++m) { float* rowp = base + (size_t)(u.pm * BM + ai * HALF + wr * 64 + m * 16 + fr) * ldc + col0;
#pragma unroll
                for (int bj = 0; bj < 2; ++bj)
#pragma unroll
                    for (int n = 0; n < 2; ++n) *(f32x4*)(rowp + bj * HALF + n * 16) = acc[ai][bj][m][n]; }
    }
};

template <class Epi, class SchedT>
__device__ __forceinline__ void gemm_phase(LAS unsigned char* lds, const Gemm g, const SchedT& S, const Epi& E) {
    int tid_ = threadIdx.x; asm volatile("" : "+v"(tid_));
    const int tid = tid_, wid = __builtin_amdgcn_readfirstlane(tid >> 6), lane = tid & 63, wr = wid >> 2, wc = wid & 3, fr = lane & 15, fq = lane >> 4;
    int K_ = g.K; asm volatile("" : "+s"(K_));
    const int K = K_, nt = K / BK;
    unsigned voffA[2], voffB[2];
#pragma unroll
    for (int i = 0; i < 2; ++i) { int R, C; stage_rc(tid * 16 + i * 8192, R, C); const int Rb = Epi::PERM ? ((R & ~31) + perm32(R & 31)) : R;
        voffA[i] = (unsigned)(R * g.lda + C) * 2u; voffB[i] = (unsigned)(Rb * g.ldb + C) * 2u; }
    const size_t kstep = (size_t)(BK * 2);
    const size_t hstepA = (size_t)HALF * g.lda * 2, hstepB = (size_t)HALF * g.ldb * 2;
    const size_t tstepA = 2 * hstepA, tstepB = 2 * hstepB;
    const unsigned ldsw = (unsigned)wid * 1024u;
    const int aoff = lds_byte(wr * 64 + fr, fq * 8), boff = lds_byte(wc * 32 + fr, fq * 8);
#define PG8_SA(b, h) (((b) * 2 + (h)) * HTB)
#define PG8_SB(b, h) ((4 + (b) * 2 + (h)) * HTB)
#define PG8_STAGE(bufoff, gbase, voff) do { _Pragma("unroll") for (int _i = 0; _i < 2; ++_i) \
        __builtin_amdgcn_global_load_lds((const unsigned*)((const char*)(gbase) + (voff)[_i]), (LAS unsigned*)(lds + (bufoff) + ldsw + _i * 8192), 16, 0, 0); } while (0)
#define PG8_LDA(dst, b, h) do { _Pragma("unroll") for (int m = 0; m < 4; ++m) _Pragma("unroll") for (int k = 0; k < 2; ++k) dst[m][k] = *(const LAS bf16x8*)(lds + PG8_SA(b, h) + aoff + m * 2048 + k * 1024); } while (0)
#define PG8_LDB(dst, b, h) do { _Pragma("unroll") for (int n = 0; n < 2; ++n) _Pragma("unroll") for (int k = 0; k < 2; ++k) dst[n][k] = *(const LAS bf16x8*)(lds + PG8_SB(b, h) + boff + n * 2048 + k * 1024); } while (0)
#define PG8_MMA(ai, bj, At, Bt) do { __builtin_amdgcn_s_setprio(1); _Pragma("unroll") for (int m = 0; m < 4; ++m) _Pragma("unroll") for (int n = 0; n < 2; ++n) _Pragma("unroll") for (int k = 0; k < 2; ++k) \
        acc[ai][bj][m][n] = __builtin_amdgcn_mfma_f32_16x16x32_bf16(Bt[n][k], At[m][k], acc[ai][bj][m][n], 0, 0, 0); __builtin_amdgcn_s_setprio(0); } while (0)
#define PG8_WAIT_V(n) asm volatile("s_waitcnt vmcnt(" #n ")" ::: "memory")
#define PG8_WAIT_L(n) asm volatile("s_waitcnt lgkmcnt(" #n ")" ::: "memory")
#define PG8_BAR __builtin_amdgcn_s_barrier()
#define PG8_SCHED __builtin_amdgcn_sched_barrier(0)
    Unit cur, nxt; int ui = 0;
    if (!S.next(0, cur)) return;
    f32x4 acc[2][2][4][2];
#pragma unroll
    for (int a = 0; a < 2; ++a)
#pragma unroll
        for (int b = 0; b < 2; ++b)
#pragma unroll
            for (int m = 0; m < 4; ++m)
#pragma unroll
                for (int n = 0; n < 2; ++n) acc[a][b][m][n] = (f32x4){0.f, 0.f, 0.f, 0.f};
    bf16x8 At[4][2], B0[2][2], B1[2][2];
    const char* cA = (const char*)g.A + (size_t)cur.pm * tstepA + S.aoff(cur); const char* cB = (const char*)g.Bt + (size_t)cur.pn * tstepB + S.boff(cur);
    PG8_STAGE(PG8_SB(0, 0), cB, voffB); PG8_STAGE(PG8_SB(0, 1), cB + hstepB, voffB); PG8_STAGE(PG8_SA(0, 0), cA, voffA); PG8_STAGE(PG8_SA(0, 1), cA + hstepA, voffA);
    if (wr == 1) PG8_BAR;
    PG8_WAIT_V(2); PG8_BAR;
    PG8_STAGE(PG8_SB(1, 0), cB + kstep, voffB); PG8_STAGE(PG8_SA(1, 0), cA + kstep, voffA); PG8_STAGE(PG8_SB(1, 1), cB + hstepB + kstep, voffB);
    PG8_WAIT_V(6); PG8_BAR;
    for (;;) {
        const bool has_next = S.next(ui + 1, nxt);
        const char* nA = has_next ? (const char*)g.A + (size_t)nxt.pm * tstepA + S.aoff(nxt) : cA; const char* nB = has_next ? (const char*)g.Bt + (size_t)nxt.pn * tstepB + S.boff(nxt) : cB;
        for (int t = 0; t < nt; t += 2) {
            const bool last = (t == nt - 2);
            const char* a1 = cA + (size_t)(t + 1) * kstep;
            const char* a2 = last ? nA : cA + (size_t)(t + 2) * kstep; const char* b2 = last ? nB : cB + (size_t)(t + 2) * kstep;
            const char* a3 = a2 + kstep; const char* b3 = b2 + kstep;
            PG8_LDB(B0, 0, 0); PG8_LDB(B1, 0, 1); PG8_SCHED; PG8_LDA(At, 0, 0); PG8_STAGE(PG8_SA(1, 1), a1 + hstepA, voffA);
            PG8_WAIT_V(8); PG8_WAIT_L(0); PG8_BAR; PG8_MMA(0, 0, At, B0); PG8_MMA(0, 1, At, B1); PG8_BAR; PG8_SCHED;
            PG8_LDA(At, 0, 1); PG8_STAGE(PG8_SB(0, 0), b2, voffB); PG8_STAGE(PG8_SB(0, 1), b2 + hstepB, voffB); PG8_STAGE(PG8_SA(0, 0), a2, voffA);
            PG8_WAIT_V(8); PG8_WAIT_L(0); PG8_BAR; PG8_MMA(1, 0, At, B0); PG8_MMA(1, 1, At, B1); PG8_BAR; PG8_SCHED;
            PG8_LDB(B0, 1, 0); PG8_LDB(B1, 1, 1); PG8_SCHED; PG8_LDA(At, 1, 0); PG8_STAGE(PG8_SA(0, 1), a2 + hstepA, voffA);
            PG8_WAIT_V(8); PG8_WAIT_L(0); PG8_BAR; PG8_MMA(0, 0, At, B0); PG8_MMA(0, 1, At, B1); PG8_BAR; PG8_SCHED;
            PG8_LDA(At, 1, 1); PG8_STAGE(PG8_SB(1, 0), b3, voffB); PG8_STAGE(PG8_SB(1, 1), b3 + hstepB, voffB); PG8_STAGE(PG8_SA(1, 0), a3, voffA);
            PG8_WAIT_V(8); PG8_WAIT_L(0); PG8_BAR; PG8_MMA(1, 0, At, B0); PG8_MMA(1, 1, At, B1); PG8_BAR; PG8_SCHED;
        }
        if (wr == 0) PG8_BAR;
        E(acc, cur, wr, wc, fr, fq);
        if (!has_next) break;
#pragma unroll
        for (int a = 0; a < 2; ++a)
#pragma unroll
            for (int b = 0; b < 2; ++b)
#pragma unroll
                for (int m = 0; m < 4; ++m)
#pragma unroll
                    for (int n = 0; n < 2; ++n) acc[a][b][m][n] = (f32x4){0.f, 0.f, 0.f, 0.f};
        cur = nxt; cA = nA; cB = nB; ++ui;
        if (wr == 1) PG8_BAR;
    }
    PG8_WAIT_V(0);
    PG8_BAR;
#undef PG8_SA
#undef PG8_SB
#undef PG8_STAGE
#undef PG8_LDA
#undef PG8_LDB
#undef PG8_MMA
#undef PG8_WAIT_V
#undef PG8_WAIT_L
#undef PG8_BAR
#undef PG8_SCHED
}
}

#define XB_TMO      128
#define XB_XCNT(j)  (256  + 64 * (j))
#define XB_XSUB(j)  (1280 + 64 * (j))
#define XB_XGEN(j)  (2304 + 64 * (j))
#define XB_TOP      3328
#define XB_TOPGEN   3392
#define XCD_BAR_WORDS 3456
#define XB_SPIN_CAP (1u << 18)
__device__ __forceinline__ unsigned xb_ld(unsigned* p)              { return __hip_atomic_load(p, __ATOMIC_RELAXED, __HIP_MEMORY_SCOPE_AGENT); }
__device__ __forceinline__ unsigned xb_add(unsigned* p, unsigned v) { return __hip_atomic_fetch_add(p, v, __ATOMIC_RELAXED, __HIP_MEMORY_SCOPE_AGENT); }
__device__ __forceinline__ unsigned xb_xcc_id() { return (unsigned)__builtin_amdgcn_s_getreg((3 << 11) | 20) & 0xFu; }
#define XB_SPIN(cond, bar) do { unsigned _sp = 0; while (cond) { __builtin_amdgcn_s_sleep(1); \
    if ((++_sp & 255u) == 0u) { if (xb_ld(&(bar)[XB_TMO])) break; if (_sp > XB_SPIN_CAP) { atomicAdd(&(bar)[XB_TMO], 1u); break; } } } } while (0)
struct XcdBarrier { unsigned* bar; unsigned x; volatile LAS unsigned* st; };
__device__ __forceinline__ XcdBarrier xcd_barrier_post(unsigned* bar, volatile LAS unsigned* st) {
    XcdBarrier b; b.bar = bar; b.x = xb_xcc_id(); b.st = st;
    if (threadIdx.x == 0) (void)xb_add(&bar[XB_XCNT(b.x)], 1u);
    return b;
}
__device__ __forceinline__ void xcd_barrier_complete(unsigned* bar, unsigned x, unsigned& nloc, unsigned& nx) {
    const unsigned G = gridDim.x * gridDim.y * gridDim.z;
    unsigned sum, cnt, mine, sp = 0u;
    for (;;) {
        sum = 0u; cnt = 0u; mine = 0u;
#pragma unroll
        for (unsigned j = 0; j < 16; ++j) { const unsigned c = xb_ld(&bar[XB_XCNT(j)]); sum += c; cnt += (c > 0u) ? 1u : 0u; mine = (j == x) ? c : mine; }
        if (sum == G) break;
        __builtin_amdgcn_s_sleep(1);
        if ((++sp & 255u) == 0u) { if (xb_ld(&bar[XB_TMO])) break; if (sp > XB_SPIN_CAP) { atomicAdd(&bar[XB_TMO], 1u); break; } }
    }
    nloc = mine > 0u ? mine : 1u; nx = cnt > 0u ? cnt : 1u;
}
__device__ __forceinline__ void xcd_barrier(const XcdBarrier& b) {
    asm volatile("s_waitcnt vmcnt(0)" ::: "memory");
    __syncthreads();
    if (threadIdx.x == 0) {
        unsigned* bar = b.bar;
        __builtin_amdgcn_s_waitcnt(0);
        unsigned nloc = b.st[0], nx = b.st[1];
        if (nloc == 0u) { xcd_barrier_complete(bar, b.x, nloc, nx); b.st[0] = nloc; b.st[1] = nx; }
        const unsigned old = xb_add(&bar[XB_XSUB(b.x)], 1u);
        const unsigned gen = old / nloc;
        if (old + 1u == (gen + 1u) * nloc) {
            __builtin_amdgcn_fence(__ATOMIC_RELEASE, "agent");
            asm volatile("s_waitcnt vmcnt(0)" ::: "memory");
            const unsigned og = xb_add(&bar[XB_TOP], 1u);
            const unsigned tg = og / nx;
            if (og + 1u == (tg + 1u) * nx) xb_add(&bar[XB_TOPGEN], 1u);
            else XB_SPIN(xb_ld(&bar[XB_TOPGEN]) == tg, bar);
            __builtin_amdgcn_fence(__ATOMIC_ACQUIRE, "agent");
            xb_add(&bar[XB_XGEN(b.x)], 1u);
            asm volatile("s_waitcnt vmcnt(0)" ::: "memory");
        } else {
            XB_SPIN(xb_ld(&bar[XB_XGEN(b.x)]) == gen, bar);
            __builtin_amdgcn_fence(__ATOMIC_ACQUIRE, "agent");
            asm volatile("s_waitcnt vmcnt(0)" ::: "memory");
        }
    }
    __syncthreads();
}

constexpr int LDS_BYTES = 147456;
#ifndef PH
#define PH 0xFFFF
#endif
#ifndef DUP
#define DUP 0
#endif
#define GSYNC() xcd_barrier(xb)
#define REP(bit) for (int rep_ = 0; rep_ < ((DUP & (bit)) ? 2 : 1); ++rep_)
struct Ctx { LAS unsigned char* lds; int tid, lane, wave, G, bid; };
__device__ __forceinline__ Ctx fresh_ctx(LAS unsigned char* lds) { Ctx C; int t = threadIdx.x; asm volatile("" : "+v"(t)); C.lds = lds; C.tid = t; C.lane = t & 63; C.wave = __builtin_amdgcn_readfirstlane(t >> 6); C.G = gridDim.x; C.bid = blockIdx.x; return C; }

__device__ __forceinline__ void phase_mod(const Params& P, const Ctx& C) {
    LAS float* sc = (LAS float*)C.lds; LAS float* red = sc + 5120;
    for (int i = C.tid; i < 5120; i += 512) { const int r = i >> 10, k = i & 1023; const float x = r == 0 ? P.in[I_CCTX][k] : P.in[I_C][(r - 1) * 1024 + k]; sc[i] = siluf_(x); }
    __syncthreads();
    float* MOD = (float*)(P.ws + WS_MOD);
    const int kg = C.tid >> 6, c = C.tid & 63;
    for (int tile = C.bid; tile < 384; tile += C.G) {
        const int l = tile / 96, col = (tile % 96) * 64 + c;
        const float* w = P.in[I_WMOD] + (size_t)l * 1024 * 6144 + col;
        float a0 = 0.f, a1 = 0.f, a2 = 0.f, a3 = 0.f, a4 = 0.f;
#pragma unroll 8
        for (int k = kg * 128; k < kg * 128 + 128; ++k) { const float wv = w[(size_t)k * 6144]; a0 += sc[k] * wv; a1 += sc[1024 + k] * wv; a2 += sc[2048 + k] * wv; a3 += sc[3072 + k] * wv; a4 += sc[4096 + k] * wv; }
        red[(kg * 5 + 0) * 64 + c] = a0; red[(kg * 5 + 1) * 64 + c] = a1; red[(kg * 5 + 2) * 64 + c] = a2; red[(kg * 5 + 3) * 64 + c] = a3; red[(kg * 5 + 4) * 64 + c] = a4;
        __syncthreads();
        if (C.tid < 320) { const int r = C.tid >> 6; float s = 0.f;
#pragma unroll
            for (int q = 0; q < 8; ++q) s += red[(q * 5 + r) * 64 + c];
            MOD[(size_t)(l * 5 + r) * 6144 + col] = s + P.in[I_BMOD][l * 6144 + col]; }
        __syncthreads();
    }
}

__device__ __forceinline__ void transpose_item(const float* W, int K, int N, bf16_t* WT, LAS float* scr, int item, int nblk, int lane) {
    const int kb = item / nblk, nb = item % nblk, k0 = 64 * kb, n0 = 32 * nb;
    const bool nok = (n0 + (lane & 31)) < N;
#pragma unroll 8
    for (int i = 0; i < 32; ++i) { const int kk = 2 * i + (lane >> 5); scr[kk * 33 + (lane & 31)] = nok ? W[(size_t)(k0 + kk) * N + n0 + (lane & 31)] : 0.f; }
    asm volatile("s_waitcnt lgkmcnt(0)" ::: "memory");
    const int c = lane & 7;
#pragma unroll
    for (int j = 0; j < 4; ++j) { const int n = (lane >> 3) + 8 * j; const LAS float* s = scr + (8 * c) * 33 + n;
        u32x4 o; o.x = pk2(s[0 * 33], s[1 * 33]); o.y = pk2(s[2 * 33], s[3 * 33]); o.z = pk2(s[4 * 33], s[5 * 33]); o.w = pk2(s[6 * 33], s[7 * 33]);
        *(u32x4*)(WT + (size_t)(n0 + n) * K + k0 + 8 * c) = o; }
    asm volatile("s_waitcnt lgkmcnt(0)" ::: "memory");
}
__device__ __forceinline__ void phase_convert(const Params& P, const Ctx& C, int l) {
    LAS float* scr = (LAS float*)(C.lds + 32768 + C.wave * 8704);
    const int gw = C.bid * 8 + C.wave, NGW = C.G * 8; const int j = l >> 1; const bool ev = (l & 1) == 0;
    const float* win = ev ? P.in[I_WINAB] + (size_t)j * 1024 * N_AB : P.in[I_WINCD] + (size_t)j * 1024 * N_CD;
    const float* wout = (ev ? P.in[I_WOUTAB] : P.in[I_WOUTCD]) + (size_t)j * 2048 * 1024;
    const float* wup = P.in[I_WUP] + (size_t)l * 1024 * 4096; const float* wdn = P.in[I_WDN] + (size_t)l * 4096 * 1024;
    const int N_in = ev ? N_AB : N_CD, Np = ev ? N_AB_P : N_CD_P;
    const int I0 = 16 * (Np / 32), I1 = 32 * 32, I2 = 16 * 128, I3 = 64 * 32;
    for (int it = gw; it < I0 + I1 + I2 + I3; it += NGW) {
        int r = it;
        if (r < I0) { transpose_item(win, 1024, N_in, (bf16_t*)(P.ws + WS_WIN), scr, r, Np / 32, C.lane); continue; } r -= I0;
        if (r < I1) { transpose_item(wout, 2048, 1024, (bf16_t*)(P.ws + WS_WOUT), scr, r, 32, C.lane); continue; } r -= I1;
        if (r < I2) { transpose_item(wup, 1024, 4096, (bf16_t*)(P.ws + WS_WUP), scr, r, 128, C.lane); continue; } r -= I2;
        transpose_item(wdn, 4096, 1024, (bf16_t*)(P.ws + WS_WDN), scr, r, 32, C.lane);
    }
    if (ev) {
        bf16_t* WL = (bf16_t*)(P.ws + WS_WLORA);
        for (int idx = C.bid * 512 + C.tid; idx < 5120 * 16; idx += C.G * 512) {
            const int n = idx % 5120, k8 = idx / 5120, g = n >> 10, cc = n & 1023; float o[8];
#pragma unroll
            for (int e = 0; e < 8; ++e) { const int k = k8 * 8 + e; float v = 0.f;
                if (g == 0) { if (k < 64) v = P.in[I_W2][((size_t)(j * 2 + 0) * 64 + k) * 1024 + cc]; }
                else if (g == 1) { if (k >= 64) v = P.in[I_W2][((size_t)(j * 2 + 1) * 64 + (k - 64)) * 1024 + cc]; }
                else if (g == 2) { if (k < 64) v = P.in[I_A2][((size_t)(j * 2 + 0) * 64 + k) * 1024 + cc]; }
                else if (g == 3) { if (k >= 64) v = P.in[I_A2][((size_t)(j * 2 + 1) * 64 + (k - 64)) * 1024 + cc]; }
                else v = P.in[I_G2][((size_t)j * 128 + k) * 1024 + cc];
                o[e] = v; }
            *(u32x4*)(WL + (size_t)n * 128 + k8 * 8) = pack8(o);
        }
    }
}

__device__ __forceinline__ void phase_rows(const Params& P, const Ctx& C, int mode, const float* gpost, const float* gate_mod  ,
                                           bool next, const float* gpre, const float* mod_next  ) {
    float* X = P.out + O_X; const float* MP0 = (const float*)(P.ws + WS_MP); const float* MP1 = MP0 + (size_t)MTOK * DM; bf16_t* H = (bf16_t*)(P.ws + WS_H);
    const int gw = C.bid * 8 + C.wave, NGW = C.G * 8;
    for (int m = gw; m < MTOK; m += NGW) {
        const int mr = m < 4096 ? 0 : 1 + ((m - 4096) >> 10);
        f32x4 x[4];
        if (mode == 0) { const f32x4* src = (const f32x4*)(m < 4096 ? P.in[I_XP] + (size_t)m * DM : P.in[I_XS] + (size_t)(m - 4096) * DM) + C.lane;
#pragma unroll
            for (int j = 0; j < 4; ++j) x[j] = src[64 * j];
        } else {
            const f32x4* xs = (const f32x4*)(X + (size_t)m * DM) + C.lane; const f32x4* p0 = (const f32x4*)(MP0 + (size_t)m * DM) + C.lane; const f32x4* p1 = (const f32x4*)(MP1 + (size_t)m * DM) + C.lane;
            f32x4 f[4]; float ss = 0.f;
#pragma unroll
            for (int j = 0; j < 4; ++j) { x[j] = xs[64 * j]; f[j] = p0[64 * j] + p1[64 * j]; ss += (f[j].x * f[j].x + f[j].y * f[j].y) + (f[j].z * f[j].z + f[j].w * f[j].w); }
            const float rs = rsqrtf(wave_sum(ss) * (1.f / DM) + 1e-6f);
            const f32x4* gp = (const f32x4*)gpost + C.lane; const f32x4* gt = (const f32x4*)(gate_mod + (size_t)mr * 6144) + C.lane;
#pragma unroll
            for (int j = 0; j < 4; ++j) x[j] = x[j] + gt[64 * j] * (f[j] * rs * gp[64 * j]);
        }
        f32x4* xo = (f32x4*)(X + (size_t)m * DM) + C.lane;
#pragma unroll
        for (int j = 0; j < 4; ++j) xo[64 * j] = x[j];
        if (next) {
            float ss = 0.f;
#pragma unroll
            for (int j = 0; j < 4; ++j) ss += (x[j].x * x[j].x + x[j].y * x[j].y) + (x[j].z * x[j].z + x[j].w * x[j].w);
            const float rs = rsqrtf(wave_sum(ss) * (1.f / DM) + 1e-6f);
            const f32x4* gp = (const f32x4*)gpre + C.lane; const f32x4* sh = (const f32x4*)(mod_next + (size_t)mr * 6144) + C.lane; const f32x4* sl = (const f32x4*)(mod_next + (size_t)mr * 6144 + 1024) + C.lane;
            u32x2* ho = (u32x2*)(H + (size_t)m * DM) + C.lane;
#pragma unroll
            for (int j = 0; j < 4; ++j) { const f32x4 h = (x[j] * rs * gp[64 * j]) * (sl[64 * j] + 1.f) + sh[64 * j]; u32x2 w; w.x = pk2(h.x, h.y); w.y = pk2(h.z, h.w); ho[64 * j] = w; }
        }
    }
}

__device__ __forceinline__ void conv8(const bf16_t* src, int ld, int col0, int base, int t, bool samp, const float* w, const float* b, int NC, int ch, float* acc) {
    { const f32x4 b0 = *(const f32x4*)(b + ch), b1 = *(const f32x4*)(b + ch + 4); acc[0] = b0.x; acc[1] = b0.y; acc[2] = b0.z; acc[3] = b0.w; acc[4] = b1.x; acc[5] = b1.y; acc[6] = b1.z; acc[7] = b1.w; }
    if (!samp) {
#pragma unroll
        for (int d = 0; d < 3; ++d) { const int tt = t + d - 1; if (tt < 0 || tt >= 256) continue;
            float xv[8]; unpack8(*(const u32x4*)(src + (size_t)(base + tt) * ld + col0 + ch), xv);
            const f32x4 w0 = *(const f32x4*)(w + (3 + d) * NC + ch), w1 = *(const f32x4*)(w + (3 + d) * NC + ch + 4);
            acc[0] += w0.x * xv[0]; acc[1] += w0.y * xv[1]; acc[2] += w0.z * xv[2]; acc[3] += w0.w * xv[3]; acc[4] += w1.x * xv[4]; acc[5] += w1.y * xv[5]; acc[6] += w1.z * xv[6]; acc[7] += w1.w * xv[7]; }
    } else {
        const int r = t >> 6, c = t & 63;
#pragma unroll
        for (int i = 0; i < 3; ++i)
#pragma unroll
            for (int d = 0; d < 3; ++d) { const int rr = r + i - 1, cc = c + d - 1; if (rr < 0 || rr >= 16 || cc < 0 || cc >= 64) continue;
                float xv[8]; unpack8(*(const u32x4*)(src + (size_t)(base + rr * 64 + cc) * ld + col0 + ch), xv);
                const f32x4 w0 = *(const f32x4*)(w + (i * 3 + d) * NC + ch), w1 = *(const f32x4*)(w + (i * 3 + d) * NC + ch + 4);
                acc[0] += w0.x * xv[0]; acc[1] += w0.y * xv[1]; acc[2] += w0.z * xv[2]; acc[3] += w0.w * xv[3]; acc[4] += w1.x * xv[4]; acc[5] += w1.y * xv[5]; acc[6] += w1.z * xv[6]; acc[7] += w1.w * xv[7]; }
    }
}

__device__ __forceinline__ void phase_prep_even(const Params& P, const Ctx& C, int j) {
    const bf16_t* PROJ = (const bf16_t*)(P.ws + WS_PROJ); bf16_t* PREP = (bf16_t*)(P.ws + WS_PREP); bf16_t* LA = (bf16_t*)(P.ws + WS_LORAA);
    float* DT = (float*)(P.ws + WS_DT); float* DA = (float*)(P.ws + WS_DA);
    const float* cw = P.in[I_SCONVW] + (size_t)j * 9 * 2048; const float* cb = P.in[I_SCONVB] + j * 2048;
    const float* mu = P.in[I_MU] + j * 3456; const float* kkw = P.in[I_KK] + j * 1024;
    const int gw = C.bid * 8 + C.wave, NGW = C.G * 8, lane = C.lane;
    for (int m = gw; m < MTOK; m += NGW) {
        const bool samp = m >= 4096; const int T = samp ? 1024 : 256; const int t = samp ? ((m - 4096) & 1023) : (m & 255); const int base = m - t;
        const bf16_t* prow = PROJ + (size_t)m * PROJ_LD_AB; bf16_t* orow = PREP + (size_t)m * PREP_LD;
#pragma unroll 1
        for (int it = 0; it < 4; ++it) { const int ch = it * 512 + lane * 8; float acc[8];
            conv8(PROJ, PROJ_LD_AB, 1024, base, t, samp, cw, cb, 2048, ch, acc);
#pragma unroll
            for (int e = 0; e < 8; ++e) acc[e] = siluf_(acc[e]);
            *(u32x4*)(orow + ch) = pack8(acc); }
#pragma unroll
        for (int it = 0; it < 2; ++it) { const int ch = it * 512 + lane * 8; float z[8]; unpack8(*(const u32x4*)(prow + ch), z);
#pragma unroll
            for (int e = 0; e < 8; ++e) z[e] = siluf_(z[e]);
            *(u32x4*)(orow + 2048 + ch) = pack8(z); }
        if (lane < 32) { const float raw = bf2f(prow[3072 + lane]); const float dt = softplusf_(raw + P.in[I_DTB][j * 32 + lane]);
            DT[(size_t)m * 32 + lane] = dt; DA[(size_t)m * 32 + lane] = -dt * __expf(P.in[I_ALOG][j * 32 + lane]); }
        const bool hp = t > 0, hn = t < T - 1;
#pragma unroll 1
        for (int it = 0; it < 7; ++it) { const int c = it * 512 + lane * 8; if (c >= 3456) break;
            float x[8], xp[8], xn[8];
            unpack8(*(const u32x4*)(prow + IN_SSD + c), x);
            if (hp) unpack8(*(const u32x4*)(prow - PROJ_LD_AB + IN_SSD + c), xp); else {
#pragma unroll
                for (int e = 0; e < 8; ++e) xp[e] = 0.f; }
            if (hn) unpack8(*(const u32x4*)(prow + PROJ_LD_AB + IN_SSD + c), xn); else {
#pragma unroll
                for (int e = 0; e < 8; ++e) xn[e] = 0.f; }
            const f32x4 m0 = *(const f32x4*)(mu + c), m1 = *(const f32x4*)(mu + c + 4);
            const float mv[8] = {m0.x, m0.y, m0.z, m0.w, m1.x, m1.y, m1.z, m1.w};
#pragma unroll
            for (int e = 0; e < 8; ++e) x[e] = x[e] + mv[e] * (0.5f * (xp[e] + xn[e]) - x[e]);
            if (it < 2) { *(u32x4*)(orow + 3072 + c) = pack8(x); }
            else if (it < 4) { *(u32x4*)(orow + 4096 + (c - 1024)) = pack8(x);
                const f32x4 k0 = *(const f32x4*)(kkw + c - 1024), k1 = *(const f32x4*)(kkw + c - 1024 + 4);
                const float kv[8] = {k0.x, k0.y, k0.z, k0.w, k1.x, k1.y, k1.z, k1.w}; float ss = 0.f;
#pragma unroll
                for (int e = 0; e < 8; ++e) { x[e] *= kv[e]; ss += x[e] * x[e]; }
                ss += __shfl_xor(ss, 1); ss += __shfl_xor(ss, 2); ss += __shfl_xor(ss, 4);
                const float rn = rsqrtf(ss + 1e-12f);
#pragma unroll
                for (int e = 0; e < 8; ++e) x[e] *= rn;
                *(u32x4*)(orow + 6144 + (c - 1024)) = pack8(x); }
            else if (it < 6) { *(u32x4*)(orow + 5120 + (c - 2048)) = pack8(x); }
            else { const int cc = c - 3072;
#pragma unroll
                for (int e = 0; e < 8; ++e) x[e] = cc < 128 ? tanhf_(x[e]) : (cc < 256 ? x[e] : sigmoidf_(x[e]));
                *(u32x4*)(LA + (size_t)m * LORA_K + cc) = pack8(x); }
        }
    }
}
__device__ __forceinline__ void phase_prep_odd(const Params& P, const Ctx& C, int j) {
    const bf16_t* PROJ = (const bf16_t*)(P.ws + WS_PROJ); bf16_t* PREP = (bf16_t*)(P.ws + WS_PREP);
    const float* cw = P.in[I_MCONVW] + (size_t)j * 9 * 1024; const float* cb = P.in[I_MCONVB] + j * 1024;
    const int gw = C.bid * 8 + C.wave, NGW = C.G * 8, lane = C.lane;
    for (int m = gw; m < MTOK; m += NGW) {
        const bool samp = m >= 4096; const int t = samp ? ((m - 4096) & 1023) : (m & 255); const int base = m - t;
#pragma unroll 1
        for (int it = 0; it < 2; ++it) { const int ch = it * 512 + lane * 8; float acc[8];
            conv8(PROJ, PROJ_LD_CD, IN_GLA, base, t, samp, cw, cb, 1024, ch, acc);
#pragma unroll
            for (int e = 0; e < 8; ++e) acc[e] = siluf_(acc[e]);
            *(u32x4*)(PREP + (size_t)m * PREP_LD + ch) = pack8(acc); }
    }
}

constexpr int CS_QLD = 136, CS_SLD = 72;
constexpr int CS_QS = 0, CS_KS = 17408, CS_KT = 34816, CS_VT = 53248, CS_PS = 64768, CS_ST = 73984, CS_LA = 95744, CS_TOT = 128512, CS_BV = 131072, CS_IG = 131328, CS_GW = 131584, CS_MS = 140288;
__device__ __forceinline__ bf16x8 lds_frag(const LAS bf16_t* p) { return *(const LAS bf16x8*)p; }
template <int MODE>
__device__ __forceinline__ void chunk_scan(const Params& P, const Ctx& C, int j, int s, int dir, int h, int vs) {
    const int tid = C.tid, lane = C.lane, w = C.wave, fr = lane & 15, fq = lane >> 4;
    const int T = s < 16 ? 256 : 1024, base = s < 16 ? s * 256 : 4096 + (s - 16) * 1024, nch = T >> 6;
    const bf16_t* PROJ = (const bf16_t*)(P.ws + WS_PROJ); const bf16_t* PREP = (const bf16_t*)(P.ws + WS_PREP);
    bf16_t* Y = (bf16_t*)(P.ws + WS_MP) + (size_t)dir * MTOK * YLD;
    LAS bf16_t* Qs = (LAS bf16_t*)(C.lds + CS_QS); LAS bf16_t* Ks = (LAS bf16_t*)(C.lds + CS_KS); LAS bf16_t* Kt = (LAS bf16_t*)(C.lds + CS_KT); LAS bf16_t* Vt = (LAS bf16_t*)(C.lds + CS_VT);
    LAS bf16_t* Ps = (LAS bf16_t*)(C.lds + CS_PS); LAS bf16_t* St = (LAS bf16_t*)(C.lds + CS_ST);
    LAS float* LA = (LAS float*)(C.lds + CS_LA); LAS float* TOT = (LAS float*)(C.lds + CS_TOT); LAS float* BV = (LAS float*)(C.lds + CS_BV); LAS float* IG = (LAS float*)(C.lds + CS_IG);
    LAS float* GW = (LAS float*)(C.lds + CS_GW); LAS float* MS = (LAS float*)(C.lds + CS_MS);
    constexpr int NVT = MODE == 2 ? 5 : 4;
    const int si = tid >> 3, kq = tid & 7;
    __syncthreads();
    if (MODE == 1) {
        const float* gwp = P.in[I_GGW] + (size_t)(j * 2 + dir) * 16 * 512 + h * 128;
        for (int i = tid; i < 16 * 128; i += 512) GW[i] = gwp[(i >> 7) * 512 + (i & 127)];
        if (tid < 128) GW[2048 + tid] = P.in[I_GGB][(j * 2 + dir) * 512 + h * 128 + tid];
    }
    f32x4 Sacc[NVT];
    {
        const float* s0 = nullptr; int kstride = 64; float em0 = 1.f;
        if (s >= 16) { const int b = s - 16;
            if (MODE == 0) { s0 = P.in[I_SSSD] + ((size_t)((b * 2 + j) * 2 + dir) * 16 + h) * 8192; kstride = 64; }
            if (MODE == 1) { s0 = P.in[I_SGLA] + ((size_t)((b * 2 + j) * 2 + dir) * 4 + h) * 32768 + vs * 64; kstride = 256; }
            if (MODE == 2) { s0 = P.in[I_SMC] + ((size_t)((b * 2 + j) * 2 + dir) * 4 + h) * 32768 + vs * 64; kstride = 256; em0 = __expf(P.in[I_SMM][((b * 2 + j) * 2 + dir) * 4 + h]); } }
#pragma unroll
        for (int vt = 0; vt < 4; ++vt)
#pragma unroll
            for (int e = 0; e < 4; ++e) Sacc[vt][e] = s0 ? s0[(size_t)(16 * w + 4 * fq + e) * kstride + 16 * vt + fr] * em0 : 0.f;
        if (MODE == 2) {
            const float* n0 = s >= 16 ? P.in[I_SMN] + ((size_t)(((s - 16) * 2 + j) * 2 + dir) * 4 + h) * 128 : nullptr;
#pragma unroll
            for (int e = 0; e < 4; ++e) Sacc[NVT - 1][e] = (n0 && fr == 0) ? n0[16 * w + 4 * fq + e] * em0 : 0.f;
            if (tid == 0) MS[0] = s >= 16 ? P.in[I_SMM][(((s - 16) * 2 + j) * 2 + dir) * 4 + h] : 0.f;
            for (int i = tid; i < 16 * CS_SLD; i += 512) Vt[64 * CS_SLD + i] = (bf16_t)((i < CS_SLD) ? 0x3F80 : 0);
        }
#pragma unroll
        for (int vt = 0; vt < NVT; ++vt) { u32x2 wv; wv.x = pk2(Sacc[vt][0], Sacc[vt][1]); wv.y = pk2(Sacc[vt][2], Sacc[vt][3]); *(LAS u32x2*)(St + (16 * vt + fr) * CS_QLD + 16 * w + 4 * fq) = wv; }
    }
    u32x4 rq0, rq1, rk0, rk1, rv, rg0, rg1; float rs0 = 0.f, rla = 0.f, rig = 0.f;
    auto load_raw = [&](int c) {
        const int st0 = c * 64 + si; const int m = base + (dir ? (T - 1 - st0) : st0);
        const int st1 = c * 64 + (tid & 63); const int m1 = base + (dir ? (T - 1 - st1) : st1);
        if (MODE == 0) { const int g = h >> 2; const bf16_t* pr = PREP + (size_t)m * PREP_LD;
            rq0 = *(const u32x4*)(pr + 1536 + g * 128 + 16 * kq); rq1 = *(const u32x4*)(pr + 1536 + g * 128 + 16 * kq + 8);
            rk0 = *(const u32x4*)(pr + 1024 + g * 128 + 16 * kq); rk1 = *(const u32x4*)(pr + 1024 + g * 128 + 16 * kq + 8);
            rv = *(const u32x4*)(pr + h * 64 + 8 * kq);
            rs0 = ((const float*)(P.ws + WS_DT))[(size_t)m * 32 + dir * 16 + h];
            if (tid < 64) rla = ((const float*)(P.ws + WS_DA))[(size_t)m1 * 32 + dir * 16 + h]; }
        if (MODE == 1) { const bf16_t* pr = PROJ + (size_t)m * PROJ_LD_CD;
            rq0 = *(const u32x4*)(pr + h * 128 + 16 * kq); rq1 = *(const u32x4*)(pr + h * 128 + 16 * kq + 8);
            rk0 = *(const u32x4*)(pr + 512 + h * 128 + 16 * kq); rk1 = *(const u32x4*)(pr + 512 + h * 128 + 16 * kq + 8);
            rv = *(const u32x4*)(pr + 1024 + h * 256 + vs * 64 + 8 * kq);
            rg0 = *(const u32x4*)(pr + 3072 + dir * 16); rg1 = *(const u32x4*)(pr + 3072 + dir * 16 + 8); }
        if (MODE == 2) { const bf16_t* pr = PROJ + (size_t)m * PROJ_LD_CD; const bf16_t* pp = PREP + (size_t)m * PREP_LD;
            rq0 = *(const u32x4*)(pp + h * 128 + 16 * kq); rq1 = *(const u32x4*)(pp + h * 128 + 16 * kq + 8);
            rk0 = *(const u32x4*)(pp + 512 + h * 128 + 16 * kq); rk1 = *(const u32x4*)(pp + 512 + h * 128 + 16 * kq + 8);
            rv = *(const u32x4*)(pr + IN_GLA + 1024 + h * 256 + vs * 64 + 8 * kq);
            if (tid < 64) { const bf16_t* p1 = PROJ + (size_t)m1 * PROJ_LD_CD + IN_GLA + 3072; rig = bf2f(p1[dir * 4 + h]); rla = bf2f(p1[8 + dir * 4 + h]); } }
    };
    load_raw(0);
    __syncthreads();
    const int ycol0 = (MODE == 0 ? h * 64 : (MODE == 1 ? h * 256 + vs * 64 : 1024 + h * 256 + vs * 64));
    for (int c = 0; c < nch; ++c) {
        if (MODE == 1) {
            float gd[16]; unpack8(rg0, gd); unpack8(rg1, gd + 8);
#pragma unroll
            for (int q4 = 0; q4 < 4; ++q4) { f32x4 gp = *(LAS f32x4*)(GW + 2048 + 16 * kq + 4 * q4);
#pragma unroll
                for (int r = 0; r < 16; ++r) gp = gp + *(LAS f32x4*)(GW + r * 128 + 16 * kq + 4 * q4) * gd[r];
                f32x4 la;
#pragma unroll
                for (int e = 0; e < 4; ++e) la[e] = logsigmoidf_(gp[e]) * 0.0625f;
                *(LAS f32x4*)(LA + si * 128 + 16 * kq + 4 * q4) = la; }
        } else if (tid < 64) {
            float ig = 0.f, la = rla;
            if (MODE == 2) { ig = rig + P.in[I_MIB][(j * 2 + dir) * 4 + h]; la = logsigmoidf_(rla + P.in[I_MFB][(j * 2 + dir) * 4 + h]); }
            float x = la;
#pragma unroll
            for (int o = 1; o < 64; o <<= 1) { const float y = __shfl_up(x, o); if (lane >= o) x += y; }
            BV[tid] = x;
            if (MODE == 2) { IG[tid] = ig; const float bl = __shfl(x, 63); float ml = bl - x + ig;
#pragma unroll
                for (int o = 1; o < 64; o <<= 1) ml = fmaxf(ml, __shfl_xor(ml, o));
                if (tid == 0) MS[0] = fmaxf(bl + MS[0], ml); }
        }
        __syncthreads();
        if (MODE == 1) {
            const int k = tid & 127, qd = tid >> 7; float run = 0.f;
#pragma unroll
            for (int jj = 0; jj < 16; ++jj) { run += LA[(16 * qd + jj) * 128 + k]; LA[(16 * qd + jj) * 128 + k] = run; }
            TOT[qd * 128 + k] = run;
            __syncthreads();
            if (tid < 128) TOT[4 * 128 + tid] = __expf(TOT[tid] + TOT[128 + tid] + TOT[256 + tid] + TOT[384 + tid]);
        }
        {
            float q[16], k[16], v[8]; unpack8(rq0, q); unpack8(rq1, q + 8); unpack8(rk0, k); unpack8(rk1, k + 8); unpack8(rv, v);
            float qs[16], ks[16], kt[16];
            if (MODE == 1) { const int qd = si >> 4;
#pragma unroll
                for (int e = 0; e < 16; ++e) { const int kk = 16 * kq + e; float b = LA[si * 128 + kk]; const float t0 = TOT[kk], t1 = TOT[128 + kk], t2 = TOT[256 + kk], t3 = TOT[384 + kk];
                    b += (qd > 0 ? t0 : 0.f) + (qd > 1 ? t1 : 0.f) + (qd > 2 ? t2 : 0.f); const float bl = (t0 + t1) + (t2 + t3);
                    qs[e] = q[e] * 0.08838834764831845f * __expf(b); ks[e] = k[e] * __expf(fminf(-b, 80.f)); kt[e] = k[e] * __expf(bl - b); }
            } else { const float bi = BV[si], bl = BV[63]; const float dk = __expf(bl - bi); const float kg = MODE == 2 ? 0.08838834764831845f * __expf(IG[si]) : 1.f;
#pragma unroll
                for (int e = 0; e < 16; ++e) { qs[e] = q[e]; ks[e] = k[e] * kg; kt[e] = ks[e] * dk; } }
            *(LAS u32x4*)(Qs + si * CS_QLD + 16 * kq) = pack8(qs); *(LAS u32x4*)(Qs + si * CS_QLD + 16 * kq + 8) = pack8(qs + 8);
            *(LAS u32x4*)(Ks + si * CS_QLD + 16 * kq) = pack8(ks); *(LAS u32x4*)(Ks + si * CS_QLD + 16 * kq + 8) = pack8(ks + 8);
#pragma unroll
            for (int e = 0; e < 16; ++e) Kt[(16 * kq + e) * CS_SLD + si] = (bf16_t)f2bf(kt[e]);
            const float vsc = MODE == 0 ? rs0 : 1.f;
#pragma unroll
            for (int e = 0; e < 8; ++e) Vt[(8 * kq + e) * CS_SLD + si] = (bf16_t)f2bf(v[e] * vsc);
        }
        __syncthreads();
        if (c + 1 < nch) load_raw(c + 1);
        const int tt = w >> 1;
#pragma unroll
        for (int sj = 0; sj < 2; ++sj) { const int st = 2 * (w & 1) + sj; u32x2 wv; wv.x = 0u; wv.y = 0u;
            if (st <= tt) { f32x4 acc = (f32x4){0.f, 0.f, 0.f, 0.f};
#pragma unroll
                for (int kk = 0; kk < 4; ++kk) acc = __builtin_amdgcn_mfma_f32_16x16x32_bf16(lds_frag(Ks + (16 * st + fr) * CS_QLD + 32 * kk + 8 * fq), lds_frag(Qs + (16 * tt + fr) * CS_QLD + 32 * kk + 8 * fq), acc, 0, 0, 0);
                const int tg = 16 * tt + fr, sg = 16 * st + 4 * fq;
                if (MODE != 1) { const float bt = BV[tg]; const f32x4 bs = *(LAS f32x4*)(BV + sg);
#pragma unroll
                    for (int e = 0; e < 4; ++e) acc[e] *= __expf(fminf(bt - bs[e], 0.f)); }
#pragma unroll
                for (int e = 0; e < 4; ++e) acc[e] = (sg + e <= tg) ? acc[e] : 0.f;
                wv.x = pk2(acc[0], acc[1]); wv.y = pk2(acc[2], acc[3]); }
            *(LAS u32x2*)(Ps + (16 * tt + fr) * CS_SLD + 16 * st + 4 * fq) = wv; }
        __syncthreads();
        {
            const int tg = 16 * tt + fr; const int stp = c * 64 + tg; const int m = base + (dir ? (T - 1 - stp) : stp);
            const float ebt = MODE == 1 ? 1.f : __expf(BV[tg]);
            bf16x8 pf[2], qf[4];
#pragma unroll
            for (int ks2 = 0; ks2 < 2; ++ks2) pf[ks2] = lds_frag(Ps + tg * CS_SLD + 32 * ks2 + 8 * fq);
#pragma unroll
            for (int kk = 0; kk < 4; ++kk) qf[kk] = lds_frag(Qs + tg * CS_QLD + 32 * kk + 8 * fq);
            float rden = 1.f;
            if (MODE == 2) { f32x4 ai = (f32x4){0.f, 0.f, 0.f, 0.f}, ao = (f32x4){0.f, 0.f, 0.f, 0.f};
#pragma unroll
                for (int ks2 = 0; ks2 < 2; ++ks2) ai = __builtin_amdgcn_mfma_f32_16x16x32_bf16(lds_frag(Vt + (64 + fr) * CS_SLD + 32 * ks2 + 8 * fq), pf[ks2], ai, 0, 0, 0);
#pragma unroll
                for (int kk = 0; kk < 4; ++kk) ao = __builtin_amdgcn_mfma_f32_16x16x32_bf16(lds_frag(St + (64 + fr) * CS_QLD + 32 * kk + 8 * fq), qf[kk], ao, 0, 0, 0);
                const float den = __shfl(ai[0] + ao[0] * ebt, fr); rden = 1.f / fmaxf(fabsf(den), 1.f); }
#pragma unroll
            for (int vj = 0; vj < 2; ++vj) { const int vt = 2 * (w & 1) + vj; f32x4 ai = (f32x4){0.f, 0.f, 0.f, 0.f}, ao = (f32x4){0.f, 0.f, 0.f, 0.f};
#pragma unroll
                for (int ks2 = 0; ks2 < 2; ++ks2) ai = __builtin_amdgcn_mfma_f32_16x16x32_bf16(lds_frag(Vt + (16 * vt + fr) * CS_SLD + 32 * ks2 + 8 * fq), pf[ks2], ai, 0, 0, 0);
#pragma unroll
                for (int kk = 0; kk < 4; ++kk) ao = __builtin_amdgcn_mfma_f32_16x16x32_bf16(lds_frag(St + (16 * vt + fr) * CS_QLD + 32 * kk + 8 * fq), qf[kk], ao, 0, 0, 0);
                u32x2 wv; wv.x = pk2((ai[0] + ao[0] * ebt) * rden, (ai[1] + ao[1] * ebt) * rden); wv.y = pk2((ai[2] + ao[2] * ebt) * rden, (ai[3] + ao[3] * ebt) * rden);
                *(u32x2*)(Y + (size_t)m * YLD + ycol0 + 16 * vt + 4 * fq) = wv; }
        }
        {
            f32x4 dec; if (MODE == 1) dec = *(LAS f32x4*)(TOT + 4 * 128 + 16 * w + 4 * fq); else { const float d = __expf(BV[63]); dec = (f32x4){d, d, d, d}; }
            bf16x8 kf[2];
#pragma unroll
            for (int ks2 = 0; ks2 < 2; ++ks2) kf[ks2] = lds_frag(Kt + (16 * w + fr) * CS_SLD + 32 * ks2 + 8 * fq);
#pragma unroll
            for (int vt = 0; vt < NVT; ++vt) { Sacc[vt] = Sacc[vt] * dec;
#pragma unroll
                for (int ks2 = 0; ks2 < 2; ++ks2) Sacc[vt] = __builtin_amdgcn_mfma_f32_16x16x32_bf16(kf[ks2], lds_frag(Vt + (16 * vt + fr) * CS_SLD + 32 * ks2 + 8 * fq), Sacc[vt], 0, 0, 0); }
        }
        __syncthreads();
#pragma unroll
        for (int vt = 0; vt < NVT; ++vt) { u32x2 wv; wv.x = pk2(Sacc[vt][0], Sacc[vt][1]); wv.y = pk2(Sacc[vt][2], Sacc[vt][3]); *(LAS u32x2*)(St + (16 * vt + fr) * CS_QLD + 16 * w + 4 * fq) = wv; }
    }
    if (s < 16) {
        float* o; int kstride; float sc = 1.f;
        if (MODE == 0) { o = P.out + O_SSD + ((size_t)((s * 2 + j) * 2 + dir) * 16 + h) * 8192; kstride = 64; }
        else { o = P.out + (MODE == 1 ? O_GLA : O_MC) + ((size_t)((s * 2 + j) * 2 + dir) * 4 + h) * 32768 + vs * 64; kstride = 256; }
        if (MODE == 2) { __syncthreads(); sc = __expf(-MS[0]); }
#pragma unroll
        for (int vt = 0; vt < 4; ++vt)
#pragma unroll
            for (int e = 0; e < 4; ++e) o[(size_t)(16 * w + 4 * fq + e) * kstride + 16 * vt + fr] = Sacc[vt][e] * sc;
        if (MODE == 2 && vs == 0) {
            if (fr == 0) {
#pragma unroll
                for (int e = 0; e < 4; ++e) P.out[O_MN + ((size_t)((s * 2 + j) * 2 + dir) * 4 + h) * 128 + 16 * w + 4 * fq + e] = Sacc[NVT - 1][e] * sc; }
            if (tid == 0) P.out[O_MM + ((s * 2 + j) * 2 + dir) * 4 + h] = MS[0]; }
    }
}

__device__ __forceinline__ void rwkv_scan(const Params& P, const Ctx& C, int j, int s, int dir, int h) {
    const int tid = C.tid, tl = tid & 255, kg = tl & 7, vg = tl >> 3; const bool act = tid < 256;
    const int T = s < 16 ? 256 : 1024, base = s < 16 ? s * 256 : 4096 + (s - 16) * 1024, nch = T >> 4;
    const bf16_t* PREP = (const bf16_t*)(P.ws + WS_PREP); const bf16_t* LOUT = (const bf16_t*)(P.ws + WS_PROJ);
    bf16_t* Y = (bf16_t*)(P.ws + WS_MP) + (size_t)dir * MTOK * YLD;
    constexpr int BUFSZ = 6 * 1024;
    LAS float* L0 = (LAS float*)C.lds;
    const int stt = tl >> 4, sc4 = (tl & 15) * 4;
    const f32x4 w0 = *(const f32x4*)(P.in[I_W0] + (j * 2 + dir) * 1024 + h * 64 + sc4), a0 = *(const f32x4*)(P.in[I_A0] + (j * 2 + dir) * 1024 + h * 64 + sc4), ka = *(const f32x4*)(P.in[I_KA] + j * 1024 + h * 64 + sc4);
    f32x2 S2[8];
    { const float* s0 = s >= 16 ? P.in[I_SRWKV] + (((size_t)(((s - 16) * 2 + j) * 2 + dir) * 16 + h) * 64 + 2 * vg) * 64 : nullptr;
#pragma unroll
        for (int hh = 0; hh < 2; ++hh) { const f32x4 u0 = s0 ? *(const f32x4*)(s0 + 32 * hh + 4 * kg) : (f32x4){0.f, 0.f, 0.f, 0.f}, u1 = s0 ? *(const f32x4*)(s0 + 64 + 32 * hh + 4 * kg) : (f32x4){0.f, 0.f, 0.f, 0.f};
#pragma unroll
            for (int e = 0; e < 4; ++e) S2[hh * 4 + e] = (f32x2){u0[e], u1[e]}; } }
    u32x2 rr, rk, rv, rkk, rwl, ral;
    auto load_raw = [&](int c) {
        const int step = c * 16 + stt; const int m = base + (dir ? (T - 1 - step) : step);
        const bf16_t* pp = PREP + (size_t)m * PREP_LD + h * 64 + sc4; const bf16_t* lo = LOUT + (size_t)m * LOUT_LD + dir * 1024 + h * 64 + sc4;
        rr = *(const u32x2*)(pp + 3072); rk = *(const u32x2*)(pp + 4096); rv = *(const u32x2*)(pp + 5120); rkk = *(const u32x2*)(pp + 6144);
        rwl = *(const u32x2*)lo; ral = *(const u32x2*)(lo + 2048);
    };
    auto write_lds = [&](LAS float* B) {
        const f32x4 r = unpack4(rr), k = unpack4(rk), v = unpack4(rv), kk = unpack4(rkk), wl = unpack4(rwl), al = unpack4(ral);
        f32x4 w, kd, kka;
#pragma unroll
        for (int e = 0; e < 4; ++e) { const float wp = w0[e] + wl[e]; const float lw = -__expf(-softplusf_(-wp) - 0.5f); w[e] = __expf(lw);
            const float a = sigmoidf_(a0[e] + al[e]); kd[e] = k[e] * (1.f + (a - 1.f) * ka[e]); kka[e] = kk[e] * a; }
        LAS float* p = B + stt * 64 + sc4;
        *(LAS f32x4*)(p) = r; *(LAS f32x4*)(p + 1024) = w; *(LAS f32x4*)(p + 2048) = kd; *(LAS f32x4*)(p + 3072) = v; *(LAS f32x4*)(p + 4096) = kk; *(LAS f32x4*)(p + 5120) = kka;
    };
    __syncthreads();
    if (act) { load_raw(0); write_lds(L0); }
    __syncthreads();
    const int ycol = 1024 + h * 64 + 2 * vg;
    for (int c = 0; c < nch; ++c) {
        LAS float* B = L0 + (c & 1) * BUFSZ;
        if (act) {
        if (c + 1 < nch) load_raw(c + 1);
#pragma unroll 2
        for (int tt = 0; tt < 16; ++tt) {
            const int step = c * 16 + tt; const int m = base + (dir ? (T - 1 - step) : step);
            LAS float* p = B + tt * 64 + 4 * kg;
            const f32x2 vv2 = *(LAS f32x2*)(B + 3072 + tt * 64 + 2 * vg);
            f32x2 d2 = (f32x2){0.f, 0.f};
#pragma unroll
            for (int hh = 0; hh < 2; ++hh) { const f32x4 kk4 = *(LAS f32x4*)(p + 4096 + 32 * hh);
#pragma unroll
                for (int e = 0; e < 4; ++e) d2 = d2 + S2[hh * 4 + e] * (f32x2){kk4[e], kk4[e]}; }
            f32x2 sk2; sk2.x = row_sum8(d2.x); sk2.y = row_sum8(d2.y);
            f32x2 y2 = (f32x2){0.f, 0.f};
#pragma unroll
            for (int hh = 0; hh < 2; ++hh) { const f32x4 w4 = *(LAS f32x4*)(p + 1024 + 32 * hh), kd4 = *(LAS f32x4*)(p + 2048 + 32 * hh), ka4 = *(LAS f32x4*)(p + 5120 + 32 * hh), r4 = *(LAS f32x4*)(p + 32 * hh);
#pragma unroll
                for (int e = 0; e < 4; ++e) { const int i = hh * 4 + e;
                    S2[i] = S2[i] * (f32x2){w4[e], w4[e]} - sk2 * (f32x2){ka4[e], ka4[e]} + vv2 * (f32x2){kd4[e], kd4[e]};
                    y2 = y2 + S2[i] * (f32x2){r4[e], r4[e]}; } }
            const float ya = row_sum8(y2.x), yb = row_sum8(y2.y);
            if (kg == 0) *(unsigned*)(Y + (size_t)m * YLD + ycol) = pk2(ya, yb);
        }
        if (c + 1 < nch) write_lds(L0 + ((c + 1) & 1) * BUFSZ);
        }
        __syncthreads();
    }
    if (act && s < 16) { float* o = P.out + O_RWKV + (((size_t)((s * 2 + j) * 2 + dir) * 16 + h) * 64 + 2 * vg) * 64;
#pragma unroll
        for (int hh = 0; hh < 2; ++hh) { *(f32x4*)(o + 32 * hh + 4 * kg) = (f32x4){S2[hh * 4].x, S2[hh * 4 + 1].x, S2[hh * 4 + 2].x, S2[hh * 4 + 3].x};
            *(f32x4*)(o + 64 + 32 * hh + 4 * kg) = (f32x4){S2[hh * 4].y, S2[hh * 4 + 1].y, S2[hh * 4 + 2].y, S2[hh * 4 + 3].y}; } }
}

__device__ __forceinline__ void scan_unit(const Params& P, const Ctx& C, int l, int type, int q) {
    const int j = l >> 1; const bool ev = (l & 1) == 0;
    int s, idx;
    if (q < 128) { s = 16 + (q >> 5); idx = q & 31; } else { const int r = q - 128; s = r >> 5; idx = r & 31; }
    if (ev) { const int dir = idx >> 4, h = idx & 15; if (type == 0) chunk_scan<0>(P, C, j, s, dir, h, 0); else rwkv_scan(P, C, j, s, dir, h); }
    else { const int dir = idx >> 4, h = (idx >> 2) & 3, vs = idx & 3; if (type == 0) chunk_scan<1>(P, C, j, s, dir, h, vs); else chunk_scan<2>(P, C, j, s, dir, h, vs); }
}
__device__ __forceinline__ void phase_scan(const Params& P, const Ctx& C0, int l) {
    const int G = C0.G, bid = C0.bid;
#pragma unroll 1
    for (int it = 0; it < 1280; ++it) {
        int type, q;
        if (G == 256) { if (bid < 128) { if (it >= 2) break; type = 1 - it; q = bid; } else { if (it >= 8) break; type = 1 - (it >> 2); q = 128 + (bid - 128) * 4 + (it & 3); } }
        else { const int x = bid + it * G; if (x >= 1280) break; type = 1 - x / 640; q = x % 640; }
        const Ctx C = fresh_ctx(C0.lds);
        scan_unit(P, C, l, type, q);
    }
}

__device__ __forceinline__ void ld16(const bf16_t* p, float* o) { unpack8(*(const u32x4*)p, o); unpack8(*(const u32x4*)(p + 8), o + 8); }
__device__ __forceinline__ void ld16f(const float* p, float* o) {
#pragma unroll
    for (int q = 0; q < 4; ++q) { const f32x4 v = *(const f32x4*)(p + 4 * q); o[4 * q] = v.x; o[4 * q + 1] = v.y; o[4 * q + 2] = v.z; o[4 * q + 3] = v.w; } }
__device__ __forceinline__ void st16(bf16_t* p, const float* o) { *(u32x4*)p = pack8(o); *(u32x4*)(p + 8) = pack8(o + 8); }
__device__ __forceinline__ void phase_post(const Params& P, const Ctx& C, int l) {
    const int j = l >> 1; const bool ev = (l & 1) == 0;
    const bf16_t* PROJ = (const bf16_t*)(P.ws + WS_PROJ); const bf16_t* PREP = (const bf16_t*)(P.ws + WS_PREP);
    const bf16_t* Y0 = (const bf16_t*)(P.ws + WS_MP); const bf16_t* Y1 = Y0 + (size_t)MTOK * YLD; bf16_t* MIX = (bf16_t*)(P.ws + WS_MIX);
    const int gw = C.bid * 8 + C.wave, NGW = C.G * 8, lane = C.lane, c0 = lane * 16;
    for (int m = gw; m < MTOK; m += NGW) {
        float ya[16], yb[16], t0[16], t1[16], o[16];
        if (ev) {
            const bf16_t* pp = PREP + (size_t)m * PREP_LD;
            ld16(Y0 + (size_t)m * YLD + c0, ya); ld16(Y1 + (size_t)m * YLD + c0, yb); ld16(pp + c0, t0); ld16(pp + 2048 + c0, t1);
            const float dsk = P.in[I_SSDD][j * 16 + (lane >> 2)]; float ss = 0.f;
#pragma unroll
            for (int e = 0; e < 16; ++e) { o[e] = (ya[e] + yb[e] + t0[e] * dsk) * t1[e]; ss += o[e] * o[e]; }
            const float rs = rsqrtf(wave_sum(ss) * (1.f / 1024.f) + 1e-6f);
            ld16f(P.in[I_SSDN] + j * 1024 + c0, t0);
#pragma unroll
            for (int e = 0; e < 16; ++e) o[e] = o[e] * rs * t0[e];
            st16(MIX + (size_t)m * 2048 + c0, o);
            ld16(Y0 + (size_t)m * YLD + 1024 + c0, ya); ld16(Y1 + (size_t)m * YLD + 1024 + c0, yb);
            float mu = 0.f;
#pragma unroll
            for (int e = 0; e < 16; ++e) { ya[e] += yb[e]; mu += ya[e]; }
            mu += __shfl_xor(mu, 1); mu += __shfl_xor(mu, 2); mu *= (1.f / 64.f);
            float var = 0.f;
#pragma unroll
            for (int e = 0; e < 16; ++e) { ya[e] -= mu; var += ya[e] * ya[e]; }
            var += __shfl_xor(var, 1); var += __shfl_xor(var, 2); var *= (1.f / 64.f);
            const float rstd = rsqrtf(var + 64e-5f);
            ld16f(P.in[I_LNW] + j * 1024 + c0, t0); ld16f(P.in[I_LNB] + j * 1024 + c0, t1);
#pragma unroll
            for (int e = 0; e < 16; ++e) o[e] = ya[e] * rstd * t0[e] + t1[e];
            ld16(pp + 3072 + c0, ya); ld16(pp + 4096 + c0, yb); ld16f(P.in[I_RK] + j * 1024 + c0, t0);
            float bs = 0.f;
#pragma unroll
            for (int e = 0; e < 16; ++e) bs += ya[e] * yb[e] * t0[e];
            bs += __shfl_xor(bs, 1); bs += __shfl_xor(bs, 2);
            ld16(pp + 5120 + c0, ya); ld16(PROJ + (size_t)m * LOUT_LD + 4096 + c0, yb);
#pragma unroll
            for (int e = 0; e < 16; ++e) o[e] = (o[e] + bs * ya[e]) * yb[e];
            st16(MIX + (size_t)m * 2048 + 1024 + c0, o);
        } else {
            const bf16_t* pr = PROJ + (size_t)m * PROJ_LD_CD;
#pragma unroll
            for (int g = 0; g < 2; ++g) {
                ld16(Y0 + (size_t)m * YLD + g * 1024 + c0, ya); ld16(Y1 + (size_t)m * YLD + g * 1024 + c0, yb);
                float ss = 0.f;
#pragma unroll
                for (int e = 0; e < 16; ++e) { ya[e] += yb[e]; ss += ya[e] * ya[e]; }
                ss += __shfl_xor(ss, 1); ss += __shfl_xor(ss, 2); ss += __shfl_xor(ss, 4); ss += __shfl_xor(ss, 8);
                const float rs = rsqrtf(ss * (1.f / 256.f) + 1e-6f);
                ld16f((g == 0 ? P.in[I_GLAN] : P.in[I_MLN]) + j * 1024 + c0, t0);
                ld16(pr + (g == 0 ? 2048 : IN_GLA + 2048) + c0, t1);
#pragma unroll
                for (int e = 0; e < 16; ++e) o[e] = ya[e] * rs * t0[e] * (g == 0 ? siluf_(t1[e]) : sigmoidf_(t1[e]));
                st16(MIX + (size_t)m * 2048 + g * 1024 + c0, o);
            }
        }
    }
}

__global__ void __launch_bounds__(512, 2) hybrid_fwd(Params P) {
    extern __shared__ __attribute__((aligned(16))) unsigned char lds_raw[];
    cg::grid_group grid = cg::this_grid();
    Ctx C; C.lds = (LAS unsigned char*)lds_raw; C.tid = threadIdx.x; C.lane = C.tid & 63; C.wave = __builtin_amdgcn_readfirstlane(C.tid >> 6); C.G = gridDim.x; C.bid = blockIdx.x;
    const float* MOD = (const float*)(P.ws + WS_MOD);
    const bf16_t* H = (const bf16_t*)(P.ws + WS_H);
    if (C.tid < 4) ((volatile LAS unsigned*)(C.lds + LDS_BYTES - 16))[C.tid] = 0u;
    __syncthreads();
    const XcdBarrier xb = xcd_barrier_post((unsigned*)(P.ws + WS_CTL), (volatile LAS unsigned*)(C.lds + LDS_BYTES - 16));
    REP(1) if (PH & 1) phase_mod(P, fresh_ctx(C.lds));
    REP(2) if (PH & 2) phase_convert(P, fresh_ctx(C.lds), 0);
    grid.sync();
    if (PH & 4) phase_rows(P, fresh_ctx(C.lds), 0, nullptr, nullptr, true, P.in[I_NORMG] + 0, MOD + 0);
    GSYNC();
#pragma unroll 1
    for (int l = 0; l < 4; ++l) {
        const bool ev = (l & 1) == 0; const float* modl = MOD + (size_t)l * 5 * 6144; const float* ng = P.in[I_NORMG] + l * 4 * 1024;
        REP(8) if (PH & 8) { pg8::Gemm g{H, (const bf16_t*)(P.ws + WS_WIN), 1024, 1024, 1024}; pg8::Sched<0> S; S.init(MTOK, ev ? N_AB_P : N_CD_P, 1, 1024, C.G, C.bid);
          pg8::EpiBf16<0> E{(bf16_t*)(P.ws + WS_PROJ), ev ? PROJ_LD_AB : PROJ_LD_CD}; pg8::gemm_phase(C.lds, g, S, E); }
        GSYNC();
        REP(16) if (PH & 16) { if (ev) phase_prep_even(P, fresh_ctx(C.lds), l >> 1); else phase_prep_odd(P, fresh_ctx(C.lds), l >> 1); }
        GSYNC();
        if (ev && (PH & 32)) {
            REP(32) {
            pg8::Gemm g{(const bf16_t*)(P.ws + WS_LORAA), (const bf16_t*)(P.ws + WS_WLORA), LORA_K, 128, 128}; pg8::Sched<1> S; S.init(MTOK, LOUT_LD, 1, 128, C.G, C.bid);
            pg8::EpiBf16<0> E{(bf16_t*)(P.ws + WS_PROJ), LOUT_LD}; pg8::gemm_phase(C.lds, g, S, E); }
            GSYNC();
        }
        REP(64) if (PH & 64) phase_scan(P, fresh_ctx(C.lds), l);
        GSYNC();
        REP(128) if (PH & 128) phase_post(P, fresh_ctx(C.lds), l);
        GSYNC();
        REP(256) if (PH & 256) { pg8::Gemm g{(const bf16_t*)(P.ws + WS_MIX), (const bf16_t*)(P.ws + WS_WOUT), 2048, 2048, 1024}; pg8::Sched<0> S; S.init(MTOK, 1024, 2, 1024, C.G, C.bid);
          pg8::EpiF32 E{(float*)(P.ws + WS_MP), 1024, (size_t)MTOK * 1024}; pg8::gemm_phase(C.lds, g, S, E); }
        GSYNC();
        if (PH & 512) phase_rows(P, fresh_ctx(C.lds), 1, ng + 1024, modl + 2048, true, ng + 2048, modl + 3072);
        GSYNC();
        REP(1024) if (PH & 1024) { pg8::Gemm g{H, (const bf16_t*)(P.ws + WS_WUP), 1024, 1024, 1024}; pg8::Sched<0> S; S.init(MTOK, 4096, 1, 1024, C.G, C.bid);
          pg8::EpiBf16<2> E{(bf16_t*)(P.ws + WS_PROJ), 4096}; pg8::gemm_phase(C.lds, g, S, E); }
        GSYNC();
        REP(2048) if (PH & 2048) { pg8::Gemm g{(const bf16_t*)(P.ws + WS_PROJ), (const bf16_t*)(P.ws + WS_WDN), 4096, 4096, 2048}; pg8::Sched<0> S; S.init(MTOK, 1024, 2, 2048, C.G, C.bid);
          pg8::EpiF32 E{(float*)(P.ws + WS_MP), 1024, (size_t)MTOK * 1024}; pg8::gemm_phase(C.lds, g, S, E); }
        GSYNC();
        if (PH & 4096) { if (l < 3) { phase_rows(P, fresh_ctx(C.lds), 1, ng + 3072, modl + 5120, true, ng + 4096, modl + 5 * 6144); phase_convert(P, fresh_ctx(C.lds), l + 1); }
        else phase_rows(P, fresh_ctx(C.lds), 1, ng + 3072, modl + 5120, false, nullptr, nullptr); }
        if (l < 3) GSYNC();
    }
}

extern "C" void kernel_launch(void* const* d_in, const int* in_sizes, int n_in, void* d_out, int out_size, void* d_ws, size_t ws_size, hipStream_t stream) {
    static int grid = 0;
    if (grid == 0) {
        if (n_in != 44 || ws_size < WS_END) { fprintf(stderr, "kernel_launch: unexpected n_in %d / ws %zu\n", n_in, ws_size); grid = -1; return; }
        int dev = 0, cus = 0, per_cu = 0;
        hipGetDevice(&dev); hipDeviceGetAttribute(&cus, hipDeviceAttributeMultiprocessorCount, dev);
        if (hipFuncSetAttribute((const void*)hybrid_fwd, hipFuncAttributeMaxDynamicSharedMemorySize, LDS_BYTES) != hipSuccess) { fprintf(stderr, "hipFuncSetAttribute failed\n"); grid = -1; return; }
        hipOccupancyMaxActiveBlocksPerMultiprocessor(&per_cu, (const void*)hybrid_fwd, 512, LDS_BYTES);
        (void)hipGetLastError();
        if (per_cu < 1) per_cu = 1;
        grid = cus * 1;
    }
    if (grid < 0) return;
    if (hipMemsetAsync((char*)d_ws + WS_CTL, 0, CTL_BYTES, stream) != hipSuccess) { fprintf(stderr, "memset failed\n"); return; }
    Params p{};
    for (int i = 0; i < 44; ++i) p.in[i] = (const float*)d_in[i];
    p.out = (float*)d_out; p.ws = (unsigned char*)d_ws;
    void* args[] = {&p};
    hipError_t e = hipLaunchCooperativeKernel((const void*)hybrid_fwd, dim3(grid), dim3(512), args, LDS_BYTES, stream);
    if (e != hipSuccess) fprintf(stderr, "cooperative launch failed: %s (grid %d)\n", hipGetErrorString(e), grid);
}
```

```cpp
#include <hip/hip_runtime.h>
#include <hip/hip_cooperative_groups.h>
#include <cstdio>
#include <cstdint>
namespace cg = cooperative_groups;

#define LAS __attribute__((address_space(3)))
typedef unsigned short bf16_t;
typedef short bf16x8 __attribute__((ext_vector_type(8)));
typedef float f32x4 __attribute__((ext_vector_type(4)));
typedef float f32x2 __attribute__((ext_vector_type(2)));
typedef unsigned u32x4 __attribute__((ext_vector_type(4)));
typedef unsigned u32x2 __attribute__((ext_vector_type(2)));

constexpr int MTOK = 8192, DM = 1024, DFF = 4096;
constexpr int N_AB = 6560, N_AB_P = 6656, N_CD = 6192, N_CD_P = 6400;
constexpr int PROJ_LD_AB = N_AB_P, PROJ_LD_CD = N_CD_P;
constexpr int PREP_LD = 7168, LOUT_LD = 5120, LORA_K = 384, YLD = 2048;
constexpr int IN_SSD = 3104, IN_GLA = 3104;
constexpr size_t MiB = 1u << 20;
constexpr size_t WS_MOD = 0, WS_CTL = 512 * 1024, CTL_BYTES = 16384, WS_DT = 1 * MiB, WS_DA = 3 * MiB, WS_WIN = 5 * MiB, WS_WOUT = 19 * MiB, WS_WUP = 23 * MiB, WS_WDN = 31 * MiB,
                 WS_WLORA = 39 * MiB, WS_H = 41 * MiB, WS_PROJ = 57 * MiB, WS_PREP = 161 * MiB, WS_MIX = 273 * MiB, WS_MP = 305 * MiB,
                 WS_LORAA = 369 * MiB, WS_END = 375 * MiB;
constexpr size_t O_X = 0, O_SSD = 8388608, O_RWKV = 16777216, O_GLA = 20971520, O_MC = 29360128, O_MN = 37748736, O_MM = 37781504;

struct Params { const float* in[44]; float* out; unsigned char* ws; };
enum { I_XP = 0, I_XS, I_SSSD, I_SRWKV, I_SGLA, I_SMC, I_SMN, I_SMM, I_C, I_CCTX, I_WMOD, I_BMOD, I_NORMG, I_WUP, I_WDN, I_WINAB, I_SCONVW, I_SCONVB,
       I_DTB, I_ALOG, I_SSDD, I_SSDN, I_MU, I_W0, I_W2, I_A0, I_A2, I_G2, I_KK, I_KA, I_RK, I_LNW, I_LNB, I_WOUTAB, I_WINCD, I_GGW, I_GGB, I_GLAN,
       I_MCONVW, I_MCONVB, I_MIB, I_MFB, I_MLN, I_WOUTCD };

__device__ __forceinline__ float bf2f(unsigned b) { return __uint_as_float(b << 16); }
__device__ __forceinline__ unsigned f2bf(float f) { unsigned u = __float_as_uint(f); return (u + 0x7fffu + ((u >> 16) & 1u)) >> 16; }
typedef __bf16 bf16x2_hw __attribute__((ext_vector_type(2)));
__device__ __forceinline__ unsigned pk2(float lo, float hi) { const f32x2 v = {lo, hi}; const bf16x2_hw b = __builtin_convertvector(v, bf16x2_hw); return __builtin_bit_cast(unsigned, b); }
__device__ __forceinline__ float lo16(unsigned w) { return __uint_as_float(w << 16); }
__device__ __forceinline__ float hi16(unsigned w) { return __uint_as_float(w & 0xffff0000u); }
__device__ __forceinline__ void unpack8(u32x4 w, float* o) { o[0] = lo16(w.x); o[1] = hi16(w.x); o[2] = lo16(w.y); o[3] = hi16(w.y); o[4] = lo16(w.z); o[5] = hi16(w.z); o[6] = lo16(w.w); o[7] = hi16(w.w); }
__device__ __forceinline__ f32x4 unpack4(u32x2 w) { return (f32x4){lo16(w.x), hi16(w.x), lo16(w.y), hi16(w.y)}; }
__device__ __forceinline__ u32x4 pack8(const float* o) { u32x4 w; w.x = pk2(o[0], o[1]); w.y = pk2(o[2], o[3]); w.z = pk2(o[4], o[5]); w.w = pk2(o[6], o[7]); return w; }
__device__ __forceinline__ float sigmoidf_(float x) { return 1.f / (1.f + __expf(-x)); }
__device__ __forceinline__ float siluf_(float x) { return x / (1.f + __expf(-x)); }
__device__ __forceinline__ float softplusf_(float x) { return fmaxf(x, 0.f) + __logf(1.f + __expf(-fabsf(x))); }
__device__ __forceinline__ float logsigmoidf_(float x) { return fminf(x, 0.f) - __logf(1.f + __expf(-fabsf(x))); }
__device__ __forceinline__ float tanhf_(float x) { const float e = __expf(-2.f * fabsf(x)); const float r = (1.f - e) / (1.f + e); return x < 0.f ? -r : r; }
__device__ __forceinline__ float wave_sum(float v) {
#pragma unroll
    for (int o = 1; o < 64; o <<= 1) v += __shfl_xor(v, o);
    return v;
}
__device__ __forceinline__ float quad_sum(float x) {
    x += __int_as_float(__builtin_amdgcn_update_dpp(0, __float_as_int(x), 0xB1, 0xF, 0xF, true));
    x += __int_as_float(__builtin_amdgcn_update_dpp(0, __float_as_int(x), 0x4E, 0xF, 0xF, true));
    return x;
}

#define DPP_ADD(x, ctrl) ((x) + __int_as_float(__builtin_amdgcn_update_dpp(0, __float_as_int(x), (ctrl), 0xF, 0xF, true)))
__device__ __forceinline__ float row_sum8(float x) { x = DPP_ADD(x, 0xB1); x = DPP_ADD(x, 0x4E); x = DPP_ADD(x, 0x141); return x; }
__device__ __forceinline__ float row_sum16(float x) { x = row_sum8(x); x = DPP_ADD(x, 0x140); return x; }
namespace pg8 {
constexpr int BM = 256, BK = 64, HALF = 128, HTB = HALF * BK * 2, STAGE_BYTES = 8 * HTB, NXCD = 8, WGM = 8;
__host__ __device__ __forceinline__ int lds_byte(int r, int c) { const int st = (r >> 4) * 2 + (c >> 5), rr = r & 15, cc = c & 31, ob = rr * 64 + cc * 2; return st * 1024 + (ob ^ (((ob >> 9) & 1) << 5)); }
__host__ __device__ __forceinline__ void stage_rc(int b, int& R, int& C) { const int st = b / 1024, sb = b % 1024, swz = sb ^ (((sb >> 9) & 1) << 5); R = (st >> 1) * 16 + swz / 64; C = (st & 1) * 32 + (swz % 64) / 2; }
__host__ __device__ __forceinline__ int perm32(int rho) { const int n = rho >> 4, i = rho & 15; return 8 * (i >> 2) + 4 * n + (i & 3); }

struct Unit { int pm, pn, ks; };
struct Gemm { const bf16_t* A; const bf16_t* Bt; int lda, ldb, K; };
template <int mode> struct Sched {
    int nM, nN, nNv, nwg, G, c, K;
    __device__ void init(int M, int N, int nK, int K_, int G_, int c_) { nM = M / BM; nN = N / BM; nNv = nN * nK; nwg = nM * nNv; G = G_; c = c_; K = K_; }
    __device__ bool next(int i, Unit& u) const {
        const long L = (long)i * G + c; if (L >= nwg) return false;
        int wgid = (int)L; { const int q = nwg / NXCD, r = nwg % NXCD, xcd = wgid % NXCD, off = wgid / NXCD; wgid = (xcd < r ? xcd * (q + 1) : r * (q + 1) + (xcd - r) * q) + off; }
        const int nig = WGM * nNv, gid = wgid / nig, fm = gid * WGM, gsz = (nM - fm) < WGM ? (nM - fm) : WGM;
        u.pm = fm + ((wgid % nig) % gsz); const int pnv = (wgid % nig) / gsz; u.pn = pnv % nN; u.ks = pnv / nN; return true;
    }
    __device__ __forceinline__ size_t aoff(const Unit& u) const { if (mode == 1) { const int g = u.pn >> 2; return (size_t)(g < 2 ? 0 : (g < 4 ? 128 : 256)) * 2; } return (size_t)u.ks * K * 2; }
    __device__ __forceinline__ size_t boff(const Unit& u) const { return mode == 1 ? 0 : (size_t)u.ks * K * 2; }
};

__device__ __forceinline__ unsigned cvt_pk_bf16(float lo, float hi) { unsigned r; asm volatile("v_cvt_pk_bf16_f32 %0, %1, %2" : "=v"(r) : "v"(lo), "v"(hi)); return r; }

template <int ACT> struct EpiBf16 {
    static constexpr bool PERM = true;
    bf16_t* O; int ldc;
    __device__ __forceinline__ void operator()(const f32x4 (&acc)[2][2][4][2], const Unit& u, int wr, int wc, int fr, int fq) const {
        const int row0 = u.pm * BM + wr * 64 + fr; const int col0 = u.pn * BM + wc * 32 + 8 * fq;
#pragma unroll
        for (int ai = 0; ai < 2; ++ai)
#pragma unroll
            for (int m = 0; m < 4; ++m) { bf16_t* rowp = O + (size_t)(row0 + ai * HALF + m * 16) * ldc + col0;
#pragma unroll
                for (int bj = 0; bj < 2; ++bj) { f32x4 v0 = acc[ai][bj][m][0], v1 = acc[ai][bj][m][1];
                    if (ACT == 2) {
#pragma unroll
                        for (int e = 0; e < 4; ++e) { const float a = fmaxf(v0[e], 0.f), b = fmaxf(v1[e], 0.f); v0[e] = a * a; v1[e] = b * b; } }
                    u32x4 w; w.x = cvt_pk_bf16(v0[0], v0[1]); w.y = cvt_pk_bf16(v0[2], v0[3]); w.z = cvt_pk_bf16(v1[0], v1[1]); w.w = cvt_pk_bf16(v1[2], v1[3]);
                    *(u32x4*)(rowp + bj * HALF) = w; } }
    }
};
struct EpiF32 {
    static constexpr bool PERM = false;
    float* O; int ldc; size_t pstride;
    __device__ __forceinline__ void operator()(const f32x4 (&acc)[2][2][4][2], const Unit& u, int wr, int wc, int fr, int fq) const {
        float* base = O + (size_t)u.ks * pstride; const int col0 = u.pn * BM + wc * 32 + 4 * fq;
#pragma unroll
        for (int ai = 0; ai < 2; ++ai)
#pragma unroll
            for (int m = 0; m < 4; ++m) { float* rowp = base + (size_t)(u.pm * BM + ai * HALF + wr * 64 + m * 16 + fr) * ldc + col0;
#pragma unroll
                for (int bj = 0; bj < 2; ++bj)
#pragma unroll
                    for (int n = 0; n < 2; ++n) *(f32x4*)(rowp + bj * HALF + n * 16) = acc[ai][bj][m][n]; }
    }
};

template <class Epi, class SchedT>
__device__ __forceinline__ void gemm_phase(LAS unsigned char* lds, const Gemm g, const SchedT& S, const Epi& E) {
    int tid_ = threadIdx.x; asm volatile("" : "+v"(tid_));
    const int tid = tid_, wid = __builtin_amdgcn_readfirstlane(tid >> 6), lane = tid & 63, wr = wid >> 2, wc = wid & 3, fr = lane & 15, fq = lane >> 4;
    int K_ = g.K; asm volatile("" : "+s"(K_));
    const int K = K_, nt = K / BK;
    unsigned voffA[2], voffB[2];
#pragma unroll
    for (int i = 0; i < 2; ++i) { int R, C; stage_rc(tid * 16 + i * 8192, R, C); const int Rb = Epi::PERM ? ((R & ~31) + perm32(R & 31)) : R;
        voffA[i] = (unsigned)(R * g.lda + C) * 2u; voffB[i] = (unsigned)(Rb * g.ldb + C) * 2u; }
    const size_t kstep = (size_t)(BK * 2);
    const size_t hstepA = (size_t)HALF * g.lda * 2, hstepB = (size_t)HALF * g.ldb * 2;
    const size_t tstepA = 2 * hstepA, tstepB = 2 * hstepB;
    const unsigned ldsw = (unsigned)wid * 1024u;
    const int aoff = lds_byte(wr * 64 + fr, fq * 8), boff = lds_byte(wc * 32 + fr, fq * 8);
#define PG8_SA(b, h) (((b) * 2 + (h)) * HTB)
#define PG8_SB(b, h) ((4 + (b) * 2 + (h)) * HTB)
#define PG8_STAGE(bufoff, gbase, voff) do { _Pragma("unroll") for (int _i = 0; _i < 2; ++_i) \
        __builtin_amdgcn_global_load_lds((const unsigned*)((const char*)(gbase) + (voff)[_i]), (LAS unsigned*)(lds + (bufoff) + ldsw + _i * 8192), 16, 0, 0); } while (0)
#define PG8_LDA(dst, b, h) do { _Pragma("unroll") for (int m = 0; m < 4; ++m) _Pragma("unroll") for (int k = 0; k < 2; ++k) dst[m][k] = *(const LAS bf16x8*)(lds + PG8_SA(b, h) + aoff + m * 2048 + k * 1024); } while (0)
#define PG8_LDB(dst, b, h) do { _Pragma("unroll") for (int n = 0; n < 2; ++n) _Pragma("unroll") for (int k = 0; k < 2; ++k) dst[n][k] = *(const LAS bf16x8*)(lds + PG8_SB(b, h) + boff + n * 2048 + k * 1024); } while (0)
#define PG8_MMA(ai, bj, At, Bt) do { __builtin_amdgcn_s_setprio(1); _Pragma("unroll") for (int m = 0; m < 4; ++m) _Pragma("unroll") for (int n = 0; n < 2; ++n) _Pragma("unroll") for (int k = 0; k < 2; ++k) \
        acc[ai][bj][m][n] = __builtin_amdgcn_mfma_f32_16x16x32_bf16(Bt[n][k], At[m][k], acc[ai][bj][m][n], 0, 0, 0); __builtin_amdgcn_s_setprio(0); } while (0)
#define PG8_WAIT_V(n) asm volatile("s_waitcnt vmcnt(" #n ")" ::: "memory")
#define PG8_WAIT_L(n) asm volatile("s_waitcnt lgkmcnt(" #n ")" ::: "memory")
#define PG8_BAR __builtin_amdgcn_s_barrier()
#define PG8_SCHED __builtin_amdgcn_sched_barrier(0)
    Unit cur, nxt; int ui = 0;
    if (!S.next(0, cur)) return;
    f32x4 acc[2][2][4][2];
#pragma unroll
    for (int a = 0; a < 2; ++a)
#pragma unroll
        for (int b = 0; b < 2; ++b)
#pragma unroll
            for (int m = 0; m < 4; ++m)
#pragma unroll
                for (int n = 0; n < 2; ++n) acc[a][b][m][n] = (f32x4){0.f, 0.f, 0.f, 0.f};
    bf16x8 At[4][2], B0[2][2], B1[2][2];
    const char* cA = (const char*)g.A + (size_t)cur.pm * tstepA + S.aoff(cur); const char* cB = (const char*)g.Bt + (size_t)cur.pn * tstepB + S.boff(cur);
    PG8_STAGE(PG8_SB(0, 0), cB, voffB); PG8_STAGE(PG8_SB(0, 1), cB + hstepB, voffB); PG8_STAGE(PG8_SA(0, 0), cA, voffA); PG8_STAGE(PG8_SA(0, 1), cA + hstepA, voffA);
    if (wr == 1) PG8_BAR;
    PG8_WAIT_V(2); PG8_BAR;
    PG8_STAGE(PG8_SB(1, 0), cB + kstep, voffB); PG8_STAGE(PG8_SA(1, 0), cA + kstep, voffA); PG8_STAGE(PG8_SB(1, 1), cB + hstepB + kstep, voffB);
    PG8_WAIT_V(6); PG8_BAR;
    for (;;) {
        const bool has_next = S.next(ui + 1, nxt);
        const char* nA = has_next ? (const char*)g.A + (size_t)nxt.pm * tstepA + S.aoff(nxt) : cA; const char* nB = has_next ? (const char*)g.Bt + (size_t)nxt.pn * tstepB + S.boff(nxt) : cB;
        for (int t = 0; t < nt; t += 2) {
            const bool last = (t == nt - 2);
            const char* a1 = cA + (size_t)(t + 1) * kstep;
            const char* a2 = last ? nA : cA + (size_t)(t + 2) * kstep; const char* b2 = last ? nB : cB + (size_t)(t + 2) * kstep;
            const char* a3 = a2 + kstep; const char* b3 = b2 + kstep;
            PG8_LDB(B0, 0, 0); PG8_LDB(B1, 0, 1); PG8_SCHED; PG8_LDA(At, 0, 0); PG8_STAGE(PG8_SA(1, 1), a1 + hstepA, voffA);
            PG8_WAIT_V(8); PG8_WAIT_L(0); PG8_BAR; PG8_MMA(0, 0, At, B0); PG8_MMA(0, 1, At, B1); PG8_BAR; PG8_SCHED;
            PG8_LDA(At, 0, 1); PG8_STAGE(PG8_SB(0, 0), b2, voffB); PG8_STAGE(PG8_SB(0, 1), b2 + hstepB, voffB); PG8_STAGE(PG8_SA(0, 0), a2, voffA);
            PG8_WAIT_V(8); PG8_WAIT_L(0); PG8_BAR; PG8_MMA(1, 0, At, B0); PG8_MMA(1, 1, At, B1); PG8_BAR; PG8_SCHED;
            PG8_LDB(B0, 1, 0); PG8_LDB(B1, 1, 1); PG8_SCHED; PG8_LDA(At, 1, 0); PG8_STAGE(PG8_SA(0, 1), a2 + hstepA, voffA);
            PG8_WAIT_V(8); PG8_WAIT_L(0); PG8_BAR; PG8_MMA(0, 0, At, B0); PG8_MMA(0, 1, At, B1); PG8_BAR; PG8_SCHED;
            PG8_LDA(At, 1, 1); PG8_STAGE(PG8_SB(1, 0), b3, voffB); PG8_STAGE(PG8_SB(1, 1), b3 + hstepB, voffB); PG8_STAGE(PG8_SA(1, 0), a3, voffA);
            PG8_WAIT_V(8); PG8_WAIT_L(0); PG8_BAR; PG8_MMA(1, 0, At, B0); PG8_MMA(1, 1, At, B1); PG8_BAR; PG8_SCHED;
        }
        if (wr == 0) PG8_BAR;
        E(acc, cur, wr, wc, fr, fq);
        if (!has_next) break;
#pragma unroll
        for (int a = 0; a < 2; ++a)
#pragma unroll
            for (int b = 0; b < 2; ++b)
#pragma unroll
                for (int m = 0; m < 4; ++m)
#pragma unroll
                    for (int n = 0; n < 2; ++n) acc[a][b][m][n] = (f32x4){0.f, 0.f, 0.f, 0.f};
        cur = nxt; cA = nA; cB = nB; ++ui;
        if (wr == 1) PG8_BAR;
    }
    PG8_WAIT_V(0);
    PG8_BAR;
#undef PG8_SA
#undef PG8_SB
#undef PG8_STAGE
#undef PG8_LDA
#undef PG8_LDB
#undef PG8_MMA
#undef PG8_WAIT_V
#undef PG8_WAIT_L
#undef PG8_BAR
#undef PG8_SCHED
}
}

#define XB_TMO      128
#define XB_XCNT(j)  (256  + 64 * (j))
#define XB_XSUB(j)  (1280 + 64 * (j))
#define XB_XGEN(j)  (2304 + 64 * (j))
#define XB_TOP      3328
#define XB_TOPGEN   3392
#define XCD_BAR_WORDS 3456
#define XB_SPIN_CAP (1u << 18)
__device__ __forceinline__ unsigned xb_ld(unsigned* p)              { return __hip_atomic_load(p, __ATOMIC_RELAXED, __HIP_MEMORY_SCOPE_AGENT); }
__device__ __forceinline__ unsigned xb_add(unsigned* p, unsigned v) { return __hip_atomic_fetch_add(p, v, __ATOMIC_RELAXED, __HIP_MEMORY_SCOPE_AGENT); }
__device__ __forceinline__ unsigned xb_xcc_id() { return (unsigned)__builtin_amdgcn_s_getreg((3 << 11) | 20) & 0xFu; }
#define XB_SPIN(cond, bar) do { unsigned _sp = 0; while (cond) { __builtin_amdgcn_s_sleep(1); \
    if ((++_sp & 255u) == 0u) { if (xb_ld(&(bar)[XB_TMO])) break; if (_sp > XB_SPIN_CAP) { atomicAdd(&(bar)[XB_TMO], 1u); break; } } } } while (0)
struct XcdBarrier { unsigned* bar; unsigned x; volatile LAS unsigned* st; };
__device__ __forceinline__ XcdBarrier xcd_barrier_post(unsigned* bar, volatile LAS unsigned* st) {
    XcdBarrier b; b.bar = bar; b.x = xb_xcc_id(); b.st = st;
    if (threadIdx.x == 0) (void)xb_add(&bar[XB_XCNT(b.x)], 1u);
    return b;
}
__device__ __forceinline__ void xcd_barrier_complete(unsigned* bar, unsigned x, unsigned& nloc, unsigned& nx) {
    const unsigned G = gridDim.x * gridDim.y * gridDim.z;
    unsigned sum, cnt, mine, sp = 0u;
    for (;;) {
        sum = 0u; cnt = 0u; mine = 0u;
#pragma unroll
        for (unsigned j = 0; j < 16; ++j) { const unsigned c = xb_ld(&bar[XB_XCNT(j)]); sum += c; cnt += (c > 0u) ? 1u : 0u; mine = (j == x) ? c : mine; }
        if (sum == G) break;
        __builtin_amdgcn_s_sleep(1);
        if ((++sp & 255u) == 0u) { if (xb_ld(&bar[XB_TMO])) break; if (sp > XB_SPIN_CAP) { atomicAdd(&bar[XB_TMO], 1u); break; } }
    }
    nloc = mine > 0u ? mine : 1u; nx = cnt > 0u ? cnt : 1u;
}
__device__ __forceinline__ void xcd_barrier(const XcdBarrier& b) {
    asm volatile("s_waitcnt vmcnt(0)" ::: "memory");
    __syncthreads();
    if (threadIdx.x == 0) {
        unsigned* bar = b.bar;
        __builtin_amdgcn_s_waitcnt(0);
        unsigned nloc = b.st[0], nx = b.st[1];
        if (nloc == 0u) { xcd_barrier_complete(bar, b.x, nloc, nx); b.st[0] = nloc; b.st[1] = nx; }
        const unsigned old = xb_add(&bar[XB_XSUB(b.x)], 1u);
        const unsigned gen = old / nloc;
        if (old + 1u == (gen + 1u) * nloc) {
            __builtin_amdgcn_fence(__ATOMIC_RELEASE, "agent");
            asm volatile("s_waitcnt vmcnt(0)" ::: "memory");
            const unsigned og = xb_add(&bar[XB_TOP], 1u);
            const unsigned tg = og / nx;
            if (og + 1u == (tg + 1u) * nx) xb_add(&bar[XB_TOPGEN], 1u);
            else XB_SPIN(xb_ld(&bar[XB_TOPGEN]) == tg, bar);
            __builtin_amdgcn_fence(__ATOMIC_ACQUIRE, "agent");
            xb_add(&bar[XB_XGEN(b.x)], 1u);
            asm volatile("s_waitcnt vmcnt(0)" ::: "memory");
        } else {
            XB_SPIN(xb_ld(&bar[XB_XGEN(b.x)]) == gen, bar);
            __builtin_amdgcn_fence(__ATOMIC_ACQUIRE, "agent");
            asm volatile("s_waitcnt vmcnt(0)" ::: "memory");
        }
    }
    __syncthreads();
}

constexpr int LDS_BYTES = 147456;
#ifndef PH
#define PH 0xFFFF
#endif
#ifndef DUP
#define DUP 0
#endif
#define GSYNC() do { xcd_barrier(xb); if (DUP & 0x8000) { xcd_barrier(xb); xcd_barrier(xb); } } while (0)
#define REP(bit) for (int rep_ = 0; rep_ < ((DUP & (bit)) ? 2 : 1); ++rep_)
struct Ctx { LAS unsigned char* lds; int tid, lane, wave, G, bid; };
__device__ __forceinline__ Ctx fresh_ctx(LAS unsigned char* lds) { Ctx C; int t = threadIdx.x; asm volatile("" : "+v"(t)); C.lds = lds; C.tid = t; C.lane = t & 63; C.wave = __builtin_amdgcn_readfirstlane(t >> 6); C.G = gridDim.x; C.bid = blockIdx.x; return C; }

__device__ __forceinline__ void phase_mod(const Params& P, const Ctx& C) {
    LAS float* sc = (LAS float*)C.lds; LAS float* red = sc + 5120;
    for (int i = C.tid; i < 5120; i += 512) { const int r = i >> 10, k = i & 1023; const float x = r == 0 ? P.in[I_CCTX][k] : P.in[I_C][(r - 1) * 1024 + k]; sc[i] = siluf_(x); }
    __syncthreads();
    float* MOD = (float*)(P.ws + WS_MOD);
    const int kg = C.tid >> 6, c = C.tid & 63;
    for (int tile = C.bid; tile < 384; tile += C.G) {
        const int l = tile / 96, col = (tile % 96) * 64 + c;
        const float* w = P.in[I_WMOD] + (size_t)l * 1024 * 6144 + col;
        float a0 = 0.f, a1 = 0.f, a2 = 0.f, a3 = 0.f, a4 = 0.f;
#pragma unroll 8
        for (int k = kg * 128; k < kg * 128 + 128; ++k) { const float wv = w[(size_t)k * 6144]; a0 += sc[k] * wv; a1 += sc[1024 + k] * wv; a2 += sc[2048 + k] * wv; a3 += sc[3072 + k] * wv; a4 += sc[4096 + k] * wv; }
        red[(kg * 5 + 0) * 64 + c] = a0; red[(kg * 5 + 1) * 64 + c] = a1; red[(kg * 5 + 2) * 64 + c] = a2; red[(kg * 5 + 3) * 64 + c] = a3; red[(kg * 5 + 4) * 64 + c] = a4;
        __syncthreads();
        if (C.tid < 320) { const int r = C.tid >> 6; float s = 0.f;
#pragma unroll
            for (int q = 0; q < 8; ++q) s += red[(q * 5 + r) * 64 + c];
            MOD[(size_t)(l * 5 + r) * 6144 + col] = s + P.in[I_BMOD][l * 6144 + col]; }
        __syncthreads();
    }
}

__device__ __forceinline__ void transpose_item(const float* W, int K, int N, bf16_t* WT, LAS float* scr, int item, int nblk, int lane) {
    const int kb = item / nblk, nb = item % nblk, k0 = 64 * kb, n0 = 32 * nb;
    const bool nok = (n0 + (lane & 31)) < N;
#pragma unroll 8
    for (int i = 0; i < 32; ++i) { const int kk = 2 * i + (lane >> 5); scr[kk * 33 + (lane & 31)] = nok ? W[(size_t)(k0 + kk) * N + n0 + (lane & 31)] : 0.f; }
    asm volatile("s_waitcnt lgkmcnt(0)" ::: "memory");
    const int c = lane & 7;
#pragma unroll
    for (int j = 0; j < 4; ++j) { const int n = (lane >> 3) + 8 * j; const LAS float* s = scr + (8 * c) * 33 + n;
        u32x4 o; o.x = pk2(s[0 * 33], s[1 * 33]); o.y = pk2(s[2 * 33], s[3 * 33]); o.z = pk2(s[4 * 33], s[5 * 33]); o.w = pk2(s[6 * 33], s[7 * 33]);
        *(u32x4*)(WT + (size_t)(n0 + n) * K + k0 + 8 * c) = o; }
    asm volatile("s_waitcnt lgkmcnt(0)" ::: "memory");
}
__device__ __forceinline__ void phase_convert(const Params& P, const Ctx& C, int l) {
    LAS float* scr = (LAS float*)(C.lds + 32768 + C.wave * 8704);
    const int gw = C.bid * 8 + C.wave, NGW = C.G * 8; const int j = l >> 1; const bool ev = (l & 1) == 0;
    const float* win = ev ? P.in[I_WINAB] + (size_t)j * 1024 * N_AB : P.in[I_WINCD] + (size_t)j * 1024 * N_CD;
    const float* wout = (ev ? P.in[I_WOUTAB] : P.in[I_WOUTCD]) + (size_t)j * 2048 * 1024;
    const float* wup = P.in[I_WUP] + (size_t)l * 1024 * 4096; const float* wdn = P.in[I_WDN] + (size_t)l * 4096 * 1024;
    const int N_in = ev ? N_AB : N_CD, Np = ev ? N_AB_P : N_CD_P;
    const int I0 = 16 * (Np / 32), I1 = 32 * 32, I2 = 16 * 128, I3 = 64 * 32;
    for (int it = gw; it < I0 + I1 + I2 + I3; it += NGW) {
        int r = it;
        if (r < I0) { transpose_item(win, 1024, N_in, (bf16_t*)(P.ws + WS_WIN), scr, r, Np / 32, C.lane); continue; } r -= I0;
        if (r < I1) { transpose_item(wout, 2048, 1024, (bf16_t*)(P.ws + WS_WOUT), scr, r, 32, C.lane); continue; } r -= I1;
        if (r < I2) { transpose_item(wup, 1024, 4096, (bf16_t*)(P.ws + WS_WUP), scr, r, 128, C.lane); continue; } r -= I2;
        transpose_item(wdn, 4096, 1024, (bf16_t*)(P.ws + WS_WDN), scr, r, 32, C.lane);
    }
    if (ev) {
        bf16_t* WL = (bf16_t*)(P.ws + WS_WLORA);
        for (int idx = C.bid * 512 + C.tid; idx < 5120 * 16; idx += C.G * 512) {
            const int n = idx % 5120, k8 = idx / 5120, g = n >> 10, cc = n & 1023; float o[8];
#pragma unroll
            for (int e = 0; e < 8; ++e) { const int k = k8 * 8 + e; float v = 0.f;
                if (g == 0) { if (k < 64) v = P.in[I_W2][((size_t)(j * 2 + 0) * 64 + k) * 1024 + cc]; }
                else if (g == 1) { if (k >= 64) v = P.in[I_W2][((size_t)(j * 2 + 1) * 64 + (k - 64)) * 1024 + cc]; }
                else if (g == 2) { if (k < 64) v = P.in[I_A2][((size_t)(j * 2 + 0) * 64 + k) * 1024 + cc]; }
                else if (g == 3) { if (k >= 64) v = P.in[I_A2][((size_t)(j * 2 + 1) * 64 + (k - 64)) * 1024 + cc]; }
                else v = P.in[I_G2][((size_t)j * 128 + k) * 1024 + cc];
                o[e] = v; }
            *(u32x4*)(WL + (size_t)n * 128 + k8 * 8) = pack8(o);
        }
    }
}

__device__ __forceinline__ void phase_rows(const Params& P, const Ctx& C, int mode, const float* gpost, const float* gate_mod  ,
                                           bool next, const float* gpre, const float* mod_next  , bool dummy = false) {
    float* X = P.out + O_X; const float* MP0 = (const float*)(P.ws + WS_MP); const float* MP1 = MP0 + (size_t)MTOK * DM; bf16_t* H = (bf16_t*)(P.ws + WS_H);
    const int gw = C.bid * 8 + C.wave, NGW = C.G * 8;
    for (int m = gw; m < MTOK; m += NGW) {
        const int mr = m < 4096 ? 0 : 1 + ((m - 4096) >> 10);
        f32x4 x[4];
        if (mode == 0) { const f32x4* src = (const f32x4*)(m < 4096 ? P.in[I_XP] + (size_t)m * DM : P.in[I_XS] + (size_t)(m - 4096) * DM) + C.lane;
#pragma unroll
            for (int j = 0; j < 4; ++j) x[j] = src[64 * j];
        } else {
            const f32x4* xs = (const f32x4*)(X + (size_t)m * DM) + C.lane; const f32x4* p0 = (const f32x4*)(MP0 + (size_t)m * DM) + C.lane; const f32x4* p1 = (const f32x4*)(MP1 + (size_t)m * DM) + C.lane;
            f32x4 f[4]; float ss = 0.f;
#pragma unroll
            for (int j = 0; j < 4; ++j) { x[j] = xs[64 * j]; f[j] = p0[64 * j] + p1[64 * j]; ss += (f[j].x * f[j].x + f[j].y * f[j].y) + (f[j].z * f[j].z + f[j].w * f[j].w); }
            const float rs = rsqrtf(wave_sum(ss) * (1.f / DM) + 1e-6f);
            const f32x4* gp = (const f32x4*)gpost + C.lane; const f32x4* gt = (const f32x4*)(gate_mod + (size_t)mr * 6144) + C.lane;
#pragma unroll
            for (int j = 0; j < 4; ++j) x[j] = x[j] + gt[64 * j] * (f[j] * rs * gp[64 * j]);
        }
        f32x4* xo = (f32x4*)((dummy ? (float*)(P.ws + WS_PREP) : X) + (size_t)m * DM) + C.lane;
#pragma unroll
        for (int j = 0; j < 4; ++j) xo[64 * j] = x[j];
        if (next) {
            float ss = 0.f;
#pragma unroll
            for (int j = 0; j < 4; ++j) ss += (x[j].x * x[j].x + x[j].y * x[j].y) + (x[j].z * x[j].z + x[j].w * x[j].w);
            const float rs = rsqrtf(wave_sum(ss) * (1.f / DM) + 1e-6f);
            const f32x4* gp = (const f32x4*)gpre + C.lane; const f32x4* sh = (const f32x4*)(mod_next + (size_t)mr * 6144) + C.lane; const f32x4* sl = (const f32x4*)(mod_next + (size_t)mr * 6144 + 1024) + C.lane;
            u32x2* ho = (u32x2*)((dummy ? (bf16_t*)(P.ws + WS_PREP + 40 * MiB) : H) + (size_t)m * DM) + C.lane;
#pragma unroll
            for (int j = 0; j < 4; ++j) { const f32x4 h = (x[j] * rs * gp[64 * j]) * (sl[64 * j] + 1.f) + sh[64 * j]; u32x2 w; w.x = pk2(h.x, h.y); w.y = pk2(h.z, h.w); ho[64 * j] = w; }
        }
    }
}

__device__ __forceinline__ void conv8(const bf16_t* src, int ld, int col0, int base, int t, bool samp, const float* w, const float* b, int NC, int ch, float* acc) {
    { const f32x4 b0 = *(const f32x4*)(b + ch), b1 = *(const f32x4*)(b + ch + 4); acc[0] = b0.x; acc[1] = b0.y; acc[2] = b0.z; acc[3] = b0.w; acc[4] = b1.x; acc[5] = b1.y; acc[6] = b1.z; acc[7] = b1.w; }
    if (!samp) {
#pragma unroll
        for (int d = 0; d < 3; ++d) { const int tt = t + d - 1; if (tt < 0 || tt >= 256) continue;
            float xv[8]; unpack8(*(const u32x4*)(src + (size_t)(base + tt) * ld + col0 + ch), xv);
            const f32x4 w0 = *(const f32x4*)(w + (3 + d) * NC + ch), w1 = *(const f32x4*)(w + (3 + d) * NC + ch + 4);
            acc[0] += w0.x * xv[0]; acc[1] += w0.y * xv[1]; acc[2] += w0.z * xv[2]; acc[3] += w0.w * xv[3]; acc[4] += w1.x * xv[4]; acc[5] += w1.y * xv[5]; acc[6] += w1.z * xv[6]; acc[7] += w1.w * xv[7]; }
    } else {
        const int r = t >> 6, c = t & 63;
#pragma unroll
        for (int i = 0; i < 3; ++i)
#pragma unroll
            for (int d = 0; d < 3; ++d) { const int rr = r + i - 1, cc = c + d - 1; if (rr < 0 || rr >= 16 || cc < 0 || cc >= 64) continue;
                float xv[8]; unpack8(*(const u32x4*)(src + (size_t)(base + rr * 64 + cc) * ld + col0 + ch), xv);
                const f32x4 w0 = *(const f32x4*)(w + (i * 3 + d) * NC + ch), w1 = *(const f32x4*)(w + (i * 3 + d) * NC + ch + 4);
                acc[0] += w0.x * xv[0]; acc[1] += w0.y * xv[1]; acc[2] += w0.z * xv[2]; acc[3] += w0.w * xv[3]; acc[4] += w1.x * xv[4]; acc[5] += w1.y * xv[5]; acc[6] += w1.z * xv[6]; acc[7] += w1.w * xv[7]; }
    }
}

__device__ __forceinline__ void phase_prep_even(const Params& P, const Ctx& C, int j) {
    const bf16_t* PROJ = (const bf16_t*)(P.ws + WS_PROJ); bf16_t* PREP = (bf16_t*)(P.ws + WS_PREP); bf16_t* LA = (bf16_t*)(P.ws + WS_LORAA);
    float* DT = (float*)(P.ws + WS_DT); float* DA = (float*)(P.ws + WS_DA);
    const float* cw = P.in[I_SCONVW] + (size_t)j * 9 * 2048; const float* cb = P.in[I_SCONVB] + j * 2048;
    const float* mu = P.in[I_MU] + j * 3456; const float* kkw = P.in[I_KK] + j * 1024;
    const int gw = C.bid * 8 + C.wave, NGW = C.G * 8, lane = C.lane;
    for (int m = gw; m < MTOK; m += NGW) {
        const bool samp = m >= 4096; const int T = samp ? 1024 : 256; const int t = samp ? ((m - 4096) & 1023) : (m & 255); const int base = m - t;
        const bf16_t* prow = PROJ + (size_t)m * PROJ_LD_AB; bf16_t* orow = PREP + (size_t)m * PREP_LD;
#pragma unroll 1
        for (int it = 0; it < 4; ++it) { const int ch = it * 512 + lane * 8; float acc[8];
            conv8(PROJ, PROJ_LD_AB, 1024, base, t, samp, cw, cb, 2048, ch, acc);
#pragma unroll
            for (int e = 0; e < 8; ++e) acc[e] = siluf_(acc[e]);
            *(u32x4*)(orow + ch) = pack8(acc); }
#pragma unroll
        for (int it = 0; it < 2; ++it) { const int ch = it * 512 + lane * 8; float z[8]; unpack8(*(const u32x4*)(prow + ch), z);
#pragma unroll
            for (int e = 0; e < 8; ++e) z[e] = siluf_(z[e]);
            *(u32x4*)(orow + 2048 + ch) = pack8(z); }
        if (lane < 32) { const float raw = bf2f(prow[3072 + lane]); const float dt = softplusf_(raw + P.in[I_DTB][j * 32 + lane]);
            DT[(size_t)m * 32 + lane] = dt; DA[(size_t)m * 32 + lane] = -dt * __expf(P.in[I_ALOG][j * 32 + lane]); }
        const bool hp = t > 0, hn = t < T - 1;
#pragma unroll 1
        for (int it = 0; it < 7; ++it) { const int c = it * 512 + lane * 8; if (c >= 3456) break;
            float x[8], xp[8], xn[8];
            unpack8(*(const u32x4*)(prow + IN_SSD + c), x);
            if (hp) unpack8(*(const u32x4*)(prow - PROJ_LD_AB + IN_SSD + c), xp); else {
#pragma unroll
                for (int e = 0; e < 8; ++e) xp[e] = 0.f; }
            if (hn) unpack8(*(const u32x4*)(prow + PROJ_LD_AB + IN_SSD + c), xn); else {
#pragma unroll
                for (int e = 0; e < 8; ++e) xn[e] = 0.f; }
            const f32x4 m0 = *(const f32x4*)(mu + c), m1 = *(const f32x4*)(mu + c + 4);
            const float mv[8] = {m0.x, m0.y, m0.z, m0.w, m1.x, m1.y, m1.z, m1.w};
#pragma unroll
            for (int e = 0; e < 8; ++e) x[e] = x[e] + mv[e] * (0.5f * (xp[e] + xn[e]) - x[e]);
            if (it < 2) { *(u32x4*)(orow + 3072 + c) = pack8(x); }
            else if (it < 4) { *(u32x4*)(orow + 4096 + (c - 1024)) = pack8(x);
                const f32x4 k0 = *(const f32x4*)(kkw + c - 1024), k1 = *(const f32x4*)(kkw + c - 1024 + 4);
                const float kv[8] = {k0.x, k0.y, k0.z, k0.w, k1.x, k1.y, k1.z, k1.w}; float ss = 0.f;
#pragma unroll
                for (int e = 0; e < 8; ++e) { x[e] *= kv[e]; ss += x[e] * x[e]; }
                ss += __shfl_xor(ss, 1); ss += __shfl_xor(ss, 2); ss += __shfl_xor(ss, 4);
                const float rn = rsqrtf(ss + 1e-12f);
#pragma unroll
                for (int e = 0; e < 8; ++e) x[e] *= rn;
                *(u32x4*)(orow + 6144 + (c - 1024)) = pack8(x); }
            else if (it < 6) { *(u32x4*)(orow + 5120 + (c - 2048)) = pack8(x); }
            else { const int cc = c - 3072;
#pragma unroll
                for (int e = 0; e < 8; ++e) x[e] = cc < 128 ? tanhf_(x[e]) : (cc < 256 ? x[e] : sigmoidf_(x[e]));
                *(u32x4*)(LA + (size_t)m * LORA_K + cc) = pack8(x); }
        }
    }
}
__device__ __forceinline__ void phase_prep_odd(const Params& P, const Ctx& C, int j) {
    const bf16_t* PROJ = (const bf16_t*)(P.ws + WS_PROJ); bf16_t* PREP = (bf16_t*)(P.ws + WS_PREP);
    const float* cw = P.in[I_MCONVW] + (size_t)j * 9 * 1024; const float* cb = P.in[I_MCONVB] + j * 1024;
    const int gw = C.bid * 8 + C.wave, NGW = C.G * 8, lane = C.lane;
    for (int m = gw; m < MTOK; m += NGW) {
        const bool samp = m >= 4096; const int t = samp ? ((m - 4096) & 1023) : (m & 255); const int base = m - t;
#pragma unroll 1
        for (int it = 0; it < 2; ++it) { const int ch = it * 512 + lane * 8; float acc[8];
            conv8(PROJ, PROJ_LD_CD, IN_GLA, base, t, samp, cw, cb, 1024, ch, acc);
#pragma unroll
            for (int e = 0; e < 8; ++e) acc[e] = siluf_(acc[e]);
            *(u32x4*)(PREP + (size_t)m * PREP_LD + ch) = pack8(acc); }
    }
}

constexpr int CS_QLD = 136, CS_SLD = 72;
constexpr int CS_QS = 0, CS_KS = 17408, CS_KT = 34816, CS_VT = 53248, CS_PS = 64768, CS_ST = 73984, CS_LA = 95744, CS_TOT = 128512, CS_BV = 131072, CS_IG = 131328, CS_GW = 131584, CS_MS = 140288, CS_FV = 140352, CS_DTV = 140608;
__device__ __forceinline__ bf16x8 lds_frag(const LAS bf16_t* p) { return *(const LAS bf16x8*)p; }
template <int MODE>
__device__ __forceinline__ void chunk_scan(const Params& P, const Ctx& C, int j, int s, int dir, int h, int vs) {
    const int tid = C.tid, lane = C.lane, w = C.wave, fr = lane & 15, fq = lane >> 4;
    const int T = s < 16 ? 256 : 1024, base = s < 16 ? s * 256 : 4096 + (s - 16) * 1024, nch = T >> 6;
    const bf16_t* PROJ = (const bf16_t*)(P.ws + WS_PROJ); const bf16_t* PREP = (const bf16_t*)(P.ws + WS_PREP);
    bf16_t* Y = (bf16_t*)(P.ws + WS_MP) + (size_t)dir * MTOK * YLD;
    LAS bf16_t* Qs = (LAS bf16_t*)(C.lds + CS_QS); LAS bf16_t* Ks = (LAS bf16_t*)(C.lds + CS_KS); LAS bf16_t* Kt = (LAS bf16_t*)(C.lds + CS_KT); LAS bf16_t* Vt = (LAS bf16_t*)(C.lds + CS_VT);
    LAS bf16_t* Ps = (LAS bf16_t*)(C.lds + CS_PS); LAS bf16_t* St = (LAS bf16_t*)(C.lds + CS_ST);
    LAS float* LA = (LAS float*)(C.lds + CS_LA); LAS float* TOT = (LAS float*)(C.lds + CS_TOT); LAS float* BV = (LAS float*)(C.lds + CS_BV); LAS float* IG = (LAS float*)(C.lds + CS_IG);
    LAS float* GW = (LAS float*)(C.lds + CS_GW); LAS float* MS = (LAS float*)(C.lds + CS_MS); LAS float* FV = (LAS float*)(C.lds + CS_FV); LAS float* DTV = (LAS float*)(C.lds + CS_DTV);
    constexpr int NVT = MODE == 2 ? 5 : 4;
    const int si = tid >> 3, kq = tid & 7;
    __syncthreads();
    if (MODE == 1) {
        const float* gwp = P.in[I_GGW] + (size_t)(j * 2 + dir) * 16 * 512 + h * 128;
        for (int i = tid; i < 16 * 128; i += 512) GW[i] = gwp[(i >> 7) * 512 + (i & 127)];
        if (tid < 128) GW[2048 + tid] = P.in[I_GGB][(j * 2 + dir) * 512 + h * 128 + tid];
    }
    f32x4 Sacc[NVT];
    {
        const float* s0 = nullptr; int kstride = 64; float em0 = 1.f;
        if (s >= 16) { const int b = s - 16;
            if (MODE == 0) { s0 = P.in[I_SSSD] + ((size_t)((b * 2 + j) * 2 + dir) * 16 + h) * 8192; kstride = 64; }
            if (MODE == 1) { s0 = P.in[I_SGLA] + ((size_t)((b * 2 + j) * 2 + dir) * 4 + h) * 32768 + vs * 64; kstride = 256; }
            if (MODE == 2) { s0 = P.in[I_SMC] + ((size_t)((b * 2 + j) * 2 + dir) * 4 + h) * 32768 + vs * 64; kstride = 256; em0 = __expf(P.in[I_SMM][((b * 2 + j) * 2 + dir) * 4 + h]); } }
#pragma unroll
        for (int vt = 0; vt < 4; ++vt)
#pragma unroll
            for (int e = 0; e < 4; ++e) Sacc[vt][e] = s0 ? s0[(size_t)(16 * w + 4 * fq + e) * kstride + 16 * vt + fr] * em0 : 0.f;
        if (MODE == 2) {
            const float* n0 = s >= 16 ? P.in[I_SMN] + ((size_t)(((s - 16) * 2 + j) * 2 + dir) * 4 + h) * 128 : nullptr;
#pragma unroll
            for (int e = 0; e < 4; ++e) Sacc[NVT - 1][e] = (n0 && fr == 0) ? n0[16 * w + 4 * fq + e] * em0 : 0.f;
            if (tid == 0) MS[0] = s >= 16 ? P.in[I_SMM][(((s - 16) * 2 + j) * 2 + dir) * 4 + h] : 0.f;
            for (int i = tid; i < 16 * CS_SLD; i += 512) Vt[64 * CS_SLD + i] = (bf16_t)((i < CS_SLD) ? 0x3F80 : 0);
        }
#pragma unroll
        for (int vt = 0; vt < NVT; ++vt) { u32x2 wv; wv.x = pk2(Sacc[vt][0], Sacc[vt][1]); wv.y = pk2(Sacc[vt][2], Sacc[vt][3]); *(LAS u32x2*)(St + (16 * vt + fr) * CS_QLD + 16 * w + 4 * fq) = wv; }
    }
    u32x4 rq0, rq1, rk0, rk1, rg0, rg1; float rla = 0.f, rig = 0.f, rdt = 0.f;
    unsigned short rkt[16], rvt[8];
    const int kx = tid & 127, tgk = tid >> 7, vx = tid & 63, tgv = tid >> 6;
    auto tok = [&](int c, int i) { const int st0 = c * 64 + i; return base + (dir ? (T - 1 - st0) : st0); };
    auto load_raw = [&](int c) {
        const int m = tok(c, si); const int m1 = tok(c, tid & 63);
        const bf16_t* krow; const bf16_t* vrow; int kld, vld;
        if (MODE == 0) { const int g = h >> 2; const bf16_t* pr = PREP + (size_t)m * PREP_LD;
            rq0 = *(const u32x4*)(pr + 1536 + g * 128 + 16 * kq); rq1 = *(const u32x4*)(pr + 1536 + g * 128 + 16 * kq + 8);
            rk0 = *(const u32x4*)(pr + 1024 + g * 128 + 16 * kq); rk1 = *(const u32x4*)(pr + 1024 + g * 128 + 16 * kq + 8);
            if (tid < 64) { rla = ((const float*)(P.ws + WS_DA))[(size_t)m1 * 32 + dir * 16 + h]; rdt = ((const float*)(P.ws + WS_DT))[(size_t)m1 * 32 + dir * 16 + h]; }
            krow = PREP + 1024 + g * 128 + kx; kld = PREP_LD; vrow = PREP + h * 64 + vx; vld = PREP_LD; }
        if (MODE == 1) { const bf16_t* pr = PROJ + (size_t)m * PROJ_LD_CD;
            rq0 = *(const u32x4*)(pr + h * 128 + 16 * kq); rq1 = *(const u32x4*)(pr + h * 128 + 16 * kq + 8);
            rk0 = *(const u32x4*)(pr + 512 + h * 128 + 16 * kq); rk1 = *(const u32x4*)(pr + 512 + h * 128 + 16 * kq + 8);
            rg0 = *(const u32x4*)(pr + 3072 + dir * 16); rg1 = *(const u32x4*)(pr + 3072 + dir * 16 + 8);
            krow = PROJ + 512 + h * 128 + kx; kld = PROJ_LD_CD; vrow = PROJ + 1024 + h * 256 + vs * 64 + vx; vld = PROJ_LD_CD; }
        if (MODE == 2) { const bf16_t* pp = PREP + (size_t)m * PREP_LD;
            rq0 = *(const u32x4*)(pp + h * 128 + 16 * kq); rq1 = *(const u32x4*)(pp + h * 128 + 16 * kq + 8);
            rk0 = *(const u32x4*)(pp + 512 + h * 128 + 16 * kq); rk1 = *(const u32x4*)(pp + 512 + h * 128 + 16 * kq + 8);
            if (tid < 64) { const bf16_t* p1 = PROJ + (size_t)m1 * PROJ_LD_CD + IN_GLA + 3072; rig = bf2f(p1[dir * 4 + h]); rla = bf2f(p1[8 + dir * 4 + h]); }
            krow = PREP + 512 + h * 128 + kx; kld = PREP_LD; vrow = PROJ + IN_GLA + 1024 + h * 256 + vs * 64 + vx; vld = PROJ_LD_CD; }
#pragma unroll
        for (int jj = 0; jj < 16; ++jj) rkt[jj] = krow[(size_t)tok(c, 16 * tgk + jj) * kld];
#pragma unroll
        for (int jj = 0; jj < 8; ++jj) rvt[jj] = vrow[(size_t)tok(c, 8 * tgv + jj) * vld];
    };
    load_raw(0);
    __syncthreads();
    const int ycol0 = (MODE == 0 ? h * 64 : (MODE == 1 ? h * 256 + vs * 64 : 1024 + h * 256 + vs * 64));
    for (int c = 0; c < nch; ++c) {
        if (MODE == 1) {
            float gd[16]; unpack8(rg0, gd); unpack8(rg1, gd + 8);
#pragma unroll
            for (int q4 = 0; q4 < 4; ++q4) { f32x4 gp = *(LAS f32x4*)(GW + 2048 + 16 * kq + 4 * q4);
#pragma unroll
                for (int r = 0; r < 16; ++r) gp = gp + *(LAS f32x4*)(GW + r * 128 + 16 * kq + 4 * q4) * gd[r];
                f32x4 la;
#pragma unroll
                for (int e = 0; e < 4; ++e) la[e] = logsigmoidf_(gp[e]) * 0.0625f;
                *(LAS f32x4*)(LA + si * 128 + 16 * kq + 4 * q4) = la; }
        } else if (tid < 64) {
            float ig = 0.f, la = rla;
            if (MODE == 2) { ig = rig + P.in[I_MIB][(j * 2 + dir) * 4 + h]; la = logsigmoidf_(rla + P.in[I_MFB][(j * 2 + dir) * 4 + h]); }
            float x = la;
#pragma unroll
            for (int o = 1; o < 64; o <<= 1) { const float y = __shfl_up(x, o); if (lane >= o) x += y; }
            const float bl = __shfl(x, 63);
            const float kgn = MODE == 2 ? 0.08838834764831845f * __expf(ig) : 1.f;
            BV[tid] = x; IG[tid] = kgn; FV[tid] = kgn * __expf(bl - x); DTV[tid] = MODE == 0 ? rdt : 1.f;
            if (MODE == 2) { float ml = bl - x + ig;
#pragma unroll
                for (int o = 1; o < 64; o <<= 1) ml = fmaxf(ml, __shfl_xor(ml, o));
                if (tid == 0) MS[0] = fmaxf(bl + MS[0], ml); }
        }
        __syncthreads();
        if (MODE == 1) {
            const int k = tid & 127, qd = tid >> 7; float run = 0.f;
#pragma unroll
            for (int jj = 0; jj < 16; ++jj) { run += LA[(16 * qd + jj) * 128 + k]; LA[(16 * qd + jj) * 128 + k] = run; }
            TOT[qd * 128 + k] = run;
            __syncthreads();
            if (tid < 128) TOT[4 * 128 + tid] = __expf(TOT[tid] + TOT[128 + tid] + TOT[256 + tid] + TOT[384 + tid]);
        }
        {
            float q[16], k[16]; unpack8(rq0, q); unpack8(rq1, q + 8); unpack8(rk0, k); unpack8(rk1, k + 8);
            float qs[16], ks[16];
            if (MODE == 1) { const int qd = si >> 4;
#pragma unroll
                for (int e4 = 0; e4 < 4; ++e4) { const int kk = 16 * kq + 4 * e4; const f32x4 bb = *(LAS f32x4*)(LA + si * 128 + kk), t0 = *(LAS f32x4*)(TOT + kk), t1 = *(LAS f32x4*)(TOT + 128 + kk), t2 = *(LAS f32x4*)(TOT + 256 + kk);
#pragma unroll
                    for (int e = 0; e < 4; ++e) { const float b = bb[e] + (qd > 0 ? t0[e] : 0.f) + (qd > 1 ? t1[e] : 0.f) + (qd > 2 ? t2[e] : 0.f);
                        qs[4 * e4 + e] = q[4 * e4 + e] * 0.08838834764831845f * __expf(b); ks[4 * e4 + e] = k[4 * e4 + e] * __expf(fminf(-b, 80.f)); } }
            } else { const float kgn = IG[si];
#pragma unroll
                for (int e = 0; e < 16; ++e) { qs[e] = q[e]; ks[e] = k[e] * kgn; } }
            *(LAS u32x4*)(Qs + si * CS_QLD + 16 * kq) = pack8(qs); *(LAS u32x4*)(Qs + si * CS_QLD + 16 * kq + 8) = pack8(qs + 8);
            *(LAS u32x4*)(Ks + si * CS_QLD + 16 * kq) = pack8(ks); *(LAS u32x4*)(Ks + si * CS_QLD + 16 * kq + 8) = pack8(ks + 8);
        }
        {
            float kt[16];
            if (MODE == 1) { float off = 0.f; const float t0 = TOT[kx], t1 = TOT[128 + kx], t2 = TOT[256 + kx], t3 = TOT[384 + kx];
                off = (tgk > 0 ? t0 : 0.f) + (tgk > 1 ? t1 : 0.f) + (tgk > 2 ? t2 : 0.f); const float bl = (t0 + t1) + (t2 + t3);
#pragma unroll
                for (int jj = 0; jj < 16; ++jj) kt[jj] = bf2f(rkt[jj]) * __expf(bl - (LA[(16 * tgk + jj) * 128 + kx] + off));
            } else {
#pragma unroll
                for (int jj = 0; jj < 16; ++jj) kt[jj] = bf2f(rkt[jj]) * FV[16 * tgk + jj]; }
            *(LAS u32x4*)(Kt + kx * CS_SLD + 16 * tgk) = pack8(kt); *(LAS u32x4*)(Kt + kx * CS_SLD + 16 * tgk + 8) = pack8(kt + 8);
            float vt8[8];
#pragma unroll
            for (int jj = 0; jj < 8; ++jj) vt8[jj] = bf2f(rvt[jj]) * (MODE == 0 ? DTV[8 * tgv + jj] : 1.f);
            *(LAS u32x4*)(Vt + vx * CS_SLD + 8 * tgv) = pack8(vt8);
        }
        __syncthreads();
        if (c + 1 < nch) load_raw(c + 1);
        const int tt = w >> 1;
#pragma unroll
        for (int sj = 0; sj < 2; ++sj) { const int st = 2 * (w & 1) + sj; u32x2 wv; wv.x = 0u; wv.y = 0u;
            if (st <= tt) { f32x4 acc = (f32x4){0.f, 0.f, 0.f, 0.f};
#pragma unroll
                for (int kk = 0; kk < 4; ++kk) acc = __builtin_amdgcn_mfma_f32_16x16x32_bf16(lds_frag(Ks + (16 * st + fr) * CS_QLD + 32 * kk + 8 * fq), lds_frag(Qs + (16 * tt + fr) * CS_QLD + 32 * kk + 8 * fq), acc, 0, 0, 0);
                const int tg = 16 * tt + fr, sg = 16 * st + 4 * fq;
                if (MODE != 1) { const float bt = BV[tg]; const f32x4 bs = *(LAS f32x4*)(BV + sg);
#pragma unroll
                    for (int e = 0; e < 4; ++e) acc[e] *= __expf(fminf(bt - bs[e], 0.f)); }
#pragma unroll
                for (int e = 0; e < 4; ++e) acc[e] = (sg + e <= tg) ? acc[e] : 0.f;
                wv.x = pk2(acc[0], acc[1]); wv.y = pk2(acc[2], acc[3]); }
            *(LAS u32x2*)(Ps + (16 * tt + fr) * CS_SLD + 16 * st + 4 * fq) = wv; }
        __syncthreads();
        {
            const int tg = 16 * tt + fr; const int stp = c * 64 + tg; const int m = base + (dir ? (T - 1 - stp) : stp);
            const float ebt = MODE == 1 ? 1.f : __expf(BV[tg]);
            bf16x8 pf[2], qf[4];
#pragma unroll
            for (int ks2 = 0; ks2 < 2; ++ks2) pf[ks2] = lds_frag(Ps + tg * CS_SLD + 32 * ks2 + 8 * fq);
#pragma unroll
            for (int kk = 0; kk < 4; ++kk) qf[kk] = lds_frag(Qs + tg * CS_QLD + 32 * kk + 8 * fq);
            float rden = 1.f;
            if (MODE == 2) { f32x4 ai = (f32x4){0.f, 0.f, 0.f, 0.f}, ao = (f32x4){0.f, 0.f, 0.f, 0.f};
#pragma unroll
                for (int ks2 = 0; ks2 < 2; ++ks2) ai = __builtin_amdgcn_mfma_f32_16x16x32_bf16(lds_frag(Vt + (64 + fr) * CS_SLD + 32 * ks2 + 8 * fq), pf[ks2], ai, 0, 0, 0);
#pragma unroll
                for (int kk = 0; kk < 4; ++kk) ao = __builtin_amdgcn_mfma_f32_16x16x32_bf16(lds_frag(St + (64 + fr) * CS_QLD + 32 * kk + 8 * fq), qf[kk], ao, 0, 0, 0);
                const float den = __shfl(ai[0] + ao[0] * ebt, fr); rden = 1.f / fmaxf(fabsf(den), 1.f); }
#pragma unroll
            for (int vj = 0; vj < 2; ++vj) { const int vt = 2 * (w & 1) + vj; f32x4 ai = (f32x4){0.f, 0.f, 0.f, 0.f}, ao = (f32x4){0.f, 0.f, 0.f, 0.f};
#pragma unroll
                for (int ks2 = 0; ks2 < 2; ++ks2) ai = __builtin_amdgcn_mfma_f32_16x16x32_bf16(lds_frag(Vt + (16 * vt + fr) * CS_SLD + 32 * ks2 + 8 * fq), pf[ks2], ai, 0, 0, 0);
#pragma unroll
                for (int kk = 0; kk < 4; ++kk) ao = __builtin_amdgcn_mfma_f32_16x16x32_bf16(lds_frag(St + (16 * vt + fr) * CS_QLD + 32 * kk + 8 * fq), qf[kk], ao, 0, 0, 0);
                u32x2 wv; wv.x = pk2((ai[0] + ao[0] * ebt) * rden, (ai[1] + ao[1] * ebt) * rden); wv.y = pk2((ai[2] + ao[2] * ebt) * rden, (ai[3] + ao[3] * ebt) * rden);
                *(u32x2*)(Y + (size_t)m * YLD + ycol0 + 16 * vt + 4 * fq) = wv; }
        }
        {
            f32x4 dec; if (MODE == 1) dec = *(LAS f32x4*)(TOT + 4 * 128 + 16 * w + 4 * fq); else { const float d = __expf(BV[63]); dec = (f32x4){d, d, d, d}; }
            bf16x8 kf[2];
#pragma unroll
            for (int ks2 = 0; ks2 < 2; ++ks2) kf[ks2] = lds_frag(Kt + (16 * w + fr) * CS_SLD + 32 * ks2 + 8 * fq);
#pragma unroll
            for (int vt = 0; vt < NVT; ++vt) { Sacc[vt] = Sacc[vt] * dec;
#pragma unroll
                for (int ks2 = 0; ks2 < 2; ++ks2) Sacc[vt] = __builtin_amdgcn_mfma_f32_16x16x32_bf16(kf[ks2], lds_frag(Vt + (16 * vt + fr) * CS_SLD + 32 * ks2 + 8 * fq), Sacc[vt], 0, 0, 0); }
        }
        __syncthreads();
#pragma unroll
        for (int vt = 0; vt < NVT; ++vt) { u32x2 wv; wv.x = pk2(Sacc[vt][0], Sacc[vt][1]); wv.y = pk2(Sacc[vt][2], Sacc[vt][3]); *(LAS u32x2*)(St + (16 * vt + fr) * CS_QLD + 16 * w + 4 * fq) = wv; }
    }
    if (s < 16) {
        float* o; int kstride; float sc = 1.f;
        if (MODE == 0) { o = P.out + O_SSD + ((size_t)((s * 2 + j) * 2 + dir) * 16 + h) * 8192; kstride = 64; }
        else { o = P.out + (MODE == 1 ? O_GLA : O_MC) + ((size_t)((s * 2 + j) * 2 + dir) * 4 + h) * 32768 + vs * 64; kstride = 256; }
        if (MODE == 2) { __syncthreads(); sc = __expf(-MS[0]); }
#pragma unroll
        for (int vt = 0; vt < 4; ++vt)
#pragma unroll
            for (int e = 0; e < 4; ++e) o[(size_t)(16 * w + 4 * fq + e) * kstride + 16 * vt + fr] = Sacc[vt][e] * sc;
        if (MODE == 2 && vs == 0) {
            if (fr == 0) {
#pragma unroll
                for (int e = 0; e < 4; ++e) P.out[O_MN + ((size_t)((s * 2 + j) * 2 + dir) * 4 + h) * 128 + 16 * w + 4 * fq + e] = Sacc[NVT - 1][e] * sc; }
            if (tid == 0) P.out[O_MM + ((s * 2 + j) * 2 + dir) * 4 + h] = MS[0]; }
    }
}

struct RwOps { f32x4 kk0, kk1, w0, w1, kd0, kd1, ka0, ka1, r0, r1; f32x2 vv; };
__device__ __forceinline__ RwOps rw_ops(const LAS float* B, int tt, int kg, int vg) {
    const LAS float* p = B + tt * 64 + 4 * kg; RwOps o;
    o.kk0 = *(const LAS f32x4*)(p + 4096); o.kk1 = *(const LAS f32x4*)(p + 4096 + 32); o.w0 = *(const LAS f32x4*)(p + 1024); o.w1 = *(const LAS f32x4*)(p + 1024 + 32);
    o.kd0 = *(const LAS f32x4*)(p + 2048); o.kd1 = *(const LAS f32x4*)(p + 2048 + 32); o.ka0 = *(const LAS f32x4*)(p + 5120); o.ka1 = *(const LAS f32x4*)(p + 5120 + 32);
    o.r0 = *(const LAS f32x4*)(p); o.r1 = *(const LAS f32x4*)(p + 32); o.vv = *(const LAS f32x2*)(B + 3072 + tt * 64 + 2 * vg); return o;
}
__device__ __forceinline__ void rwkv_pair(const Params& P, const Ctx& C, int j, int bq, bool lng) {
    const int niter = lng ? 64 : 32; const bool act = !lng || C.tid < 256;
    const int tid = C.tid, half = tid >> 8, tl = tid & 255, kg = tl & 7, vg = tl >> 3;
    const bf16_t* PREP = (const bf16_t*)(P.ws + WS_PREP); const bf16_t* LOUT = (const bf16_t*)(P.ws + WS_PROJ);
    constexpr int BUFSZ = 6 * 1024;
    LAS float* L0 = (LAS float*)C.lds + half * 2 * BUFSZ;
    const int stt = tl >> 4, sc4 = (tl & 15) * 4;
    auto unit_of = [&](int cc, int& s, int& dir, int& h, int& lc) {
        if (lng) { s = 16 + (bq >> 5); dir = (bq >> 4) & 1; h = bq & 15; lc = cc; }
        else { const int q = 4 * bq + 2 * half + (cc >> 4); s = q >> 5; dir = (q >> 4) & 1; h = q & 15; lc = cc & 15; } };
    f32x2 S2[8];
    auto init_state = [&](int s, int dir, int h) {
        const float* s0 = s >= 16 ? P.in[I_SRWKV] + (((size_t)(((s - 16) * 2 + j) * 2 + dir) * 16 + h) * 64 + 2 * vg) * 64 : nullptr;
#pragma unroll
        for (int hh = 0; hh < 2; ++hh) { const f32x4 u0 = s0 ? *(const f32x4*)(s0 + 32 * hh + 4 * kg) : (f32x4){0.f, 0.f, 0.f, 0.f}, u1 = s0 ? *(const f32x4*)(s0 + 64 + 32 * hh + 4 * kg) : (f32x4){0.f, 0.f, 0.f, 0.f};
#pragma unroll
            for (int e = 0; e < 4; ++e) S2[hh * 4 + e] = (f32x2){u0[e], u1[e]}; } };
    u32x2 rr, rk, rv, rkk, rwl, ral; f32x4 cw0, ca0, cka;
    auto load_raw = [&](int cc) {
        int s, dir, h, lc; unit_of(cc, s, dir, h, lc);
        const int T = s < 16 ? 256 : 1024, base = s < 16 ? s * 256 : 4096 + (s - 16) * 1024;
        const int step = lc * 16 + stt; const int m = base + (dir ? (T - 1 - step) : step);
        const bf16_t* pp = PREP + (size_t)m * PREP_LD + h * 64 + sc4; const bf16_t* lo = LOUT + (size_t)m * LOUT_LD + dir * 1024 + h * 64 + sc4;
        rr = *(const u32x2*)(pp + 3072); rk = *(const u32x2*)(pp + 4096); rv = *(const u32x2*)(pp + 5120); rkk = *(const u32x2*)(pp + 6144);
        rwl = *(const u32x2*)lo; ral = *(const u32x2*)(lo + 2048);
        cw0 = *(const f32x4*)(P.in[I_W0] + (j * 2 + dir) * 1024 + h * 64 + sc4); ca0 = *(const f32x4*)(P.in[I_A0] + (j * 2 + dir) * 1024 + h * 64 + sc4); cka = *(const f32x4*)(P.in[I_KA] + j * 1024 + h * 64 + sc4);
    };
    auto write_lds = [&](LAS float* B) {
        const f32x4 r = unpack4(rr), k = unpack4(rk), v = unpack4(rv), kk = unpack4(rkk), wl = unpack4(rwl), al = unpack4(ral);
        f32x4 w, kd, kka;
#pragma unroll
        for (int e = 0; e < 4; ++e) { const float wp = cw0[e] + wl[e]; const float lw = -__expf(-softplusf_(-wp) - 0.5f); w[e] = __expf(lw);
            const float a = sigmoidf_(ca0[e] + al[e]); kd[e] = k[e] * (1.f + (a - 1.f) * cka[e]); kka[e] = kk[e] * a; }
        LAS float* p = B + stt * 64 + sc4;
        *(LAS f32x4*)(p) = r; *(LAS f32x4*)(p + 1024) = w; *(LAS f32x4*)(p + 2048) = kd; *(LAS f32x4*)(p + 3072) = v; *(LAS f32x4*)(p + 4096) = kk; *(LAS f32x4*)(p + 5120) = kka;
    };
    __syncthreads();
    if (act) { load_raw(0); write_lds(L0);
    { int s, dir, h, lc; unit_of(0, s, dir, h, lc); init_state(s, dir, h); } }
    __syncthreads();
#pragma unroll 1
    for (int cc = 0; cc < niter; ++cc) {
        if (act) {
        LAS float* B = L0 + (cc & 1) * BUFSZ;
        int s, dir, h, lc; unit_of(cc, s, dir, h, lc);
        const int T = s < 16 ? 256 : 1024, base = s < 16 ? s * 256 : 4096 + (s - 16) * 1024;
        if (cc + 1 < niter) load_raw(cc + 1);
        bf16_t* Y = (bf16_t*)(P.ws + WS_MP) + (size_t)dir * MTOK * YLD + 1024 + h * 64 + 2 * vg;
        RwOps cur = rw_ops(B, 0, kg, vg);
#pragma unroll 2
        for (int tt = 0; tt < 16; ++tt) {
            const RwOps nx = rw_ops(B, (tt + 1) & 15, kg, vg);
            const int step = lc * 16 + tt; const int m = base + (dir ? (T - 1 - step) : step);
            f32x2 da = (f32x2){0.f, 0.f}, db = (f32x2){0.f, 0.f};
#pragma unroll
            for (int e = 0; e < 4; ++e) { da = da + S2[e] * (f32x2){cur.kk0[e], cur.kk0[e]}; db = db + S2[4 + e] * (f32x2){cur.kk1[e], cur.kk1[e]}; }
            const f32x2 d2 = da + db;
            f32x2 sk2; sk2.x = row_sum8(d2.x); sk2.y = row_sum8(d2.y);
            f32x2 ya = (f32x2){0.f, 0.f}, yb = (f32x2){0.f, 0.f};
#pragma unroll
            for (int e = 0; e < 4; ++e) {
                S2[e] = S2[e] * (f32x2){cur.w0[e], cur.w0[e]} - sk2 * (f32x2){cur.ka0[e], cur.ka0[e]} + cur.vv * (f32x2){cur.kd0[e], cur.kd0[e]};
                S2[4 + e] = S2[4 + e] * (f32x2){cur.w1[e], cur.w1[e]} - sk2 * (f32x2){cur.ka1[e], cur.ka1[e]} + cur.vv * (f32x2){cur.kd1[e], cur.kd1[e]};
                ya = ya + S2[e] * (f32x2){cur.r0[e], cur.r0[e]}; yb = yb + S2[4 + e] * (f32x2){cur.r1[e], cur.r1[e]}; }
            const f32x2 y2 = ya + yb;
            const float y0 = row_sum8(y2.x), y1 = row_sum8(y2.y);
            if (kg == 0) *(unsigned*)(Y + (size_t)m * YLD) = pg8::cvt_pk_bf16(y0, y1);
            cur = nx;
        }
        const int nchU = lng ? 64 : 16;
        if (lc == nchU - 1 && s < 16) { float* o = P.out + O_RWKV + (((size_t)((s * 2 + j) * 2 + dir) * 16 + h) * 64 + 2 * vg) * 64;
#pragma unroll
            for (int hh = 0; hh < 2; ++hh) { *(f32x4*)(o + 32 * hh + 4 * kg) = (f32x4){S2[hh * 4].x, S2[hh * 4 + 1].x, S2[hh * 4 + 2].x, S2[hh * 4 + 3].x};
                *(f32x4*)(o + 64 + 32 * hh + 4 * kg) = (f32x4){S2[hh * 4].y, S2[hh * 4 + 1].y, S2[hh * 4 + 2].y, S2[hh * 4 + 3].y}; } }
        if (cc + 1 < niter) { write_lds(L0 + ((cc + 1) & 1) * BUFSZ);
            if (lc == nchU - 1) { int s2, d2_, h2, lc2; unit_of(cc + 1, s2, d2_, h2, lc2); init_state(s2, d2_, h2); } }
        }
        __syncthreads();
    }
}

__device__ __forceinline__ void scan_unit(const Params& P, const Ctx& C, int l, int type, int q) {
    const int j = l >> 1; const bool ev = (l & 1) == 0;
    int s, idx;
    if (q < 128) { s = 16 + (q >> 5); idx = q & 31; } else { const int r = q - 128; s = r >> 5; idx = r & 31; }
    if (ev) { const int dir = idx >> 4, h = idx & 15; chunk_scan<0>(P, C, j, s, dir, h, 0); }
    else { const int dir = idx >> 4, h = (idx >> 2) & 3, vs = idx & 3; if (type == 0) chunk_scan<1>(P, C, j, s, dir, h, vs); else chunk_scan<2>(P, C, j, s, dir, h, vs); }
}
__device__ __forceinline__ void phase_scan(const Params& P, const Ctx& C0, int l) {
    const int G = C0.G, bid = C0.bid; const bool ev = (l & 1) == 0;
    if (ev) {
        if (G == 256) {
            rwkv_pair(P, fresh_ctx(C0.lds), l >> 1, bid < 128 ? bid : bid - 128, bid < 128);
#pragma unroll 1
            for (int it = 0; it < 4; ++it) { if (bid < 128 && it > 0) break; const int q = bid < 128 ? bid : 128 + (bid - 128) * 4 + it; scan_unit(P, fresh_ctx(C0.lds), l, 0, q); }
        } else {
#pragma unroll 1
            for (int x = bid; x < 256 + 640; x += G) { if (x < 256) rwkv_pair(P, fresh_ctx(C0.lds), l >> 1, x < 128 ? x : x - 128, x < 128); else scan_unit(P, fresh_ctx(C0.lds), l, 0, x - 256); }
        }
        return;
    }
#pragma unroll 1
    for (int it = 0; it < 1280; ++it) {
        int type, q;
        if (G == 256) { if (bid < 128) { if (it >= 2) break; type = 1 - it; q = bid; } else { if (it >= 8) break; type = 1 - (it >> 2); q = 128 + (bid - 128) * 4 + (it & 3); } }
        else { const int x = bid + it * G; if (x >= 1280) break; type = 1 - x / 640; q = x % 640; }
        scan_unit(P, fresh_ctx(C0.lds), l, type, q);
    }
}

__device__ __forceinline__ void ld16(const bf16_t* p, float* o) { unpack8(*(const u32x4*)p, o); unpack8(*(const u32x4*)(p + 8), o + 8); }
__device__ __forceinline__ void ld16f(const float* p, float* o) {
#pragma unroll
    for (int q = 0; q < 4; ++q) { const f32x4 v = *(const f32x4*)(p + 4 * q); o[4 * q] = v.x; o[4 * q + 1] = v.y; o[4 * q + 2] = v.z; o[4 * q + 3] = v.w; } }
__device__ __forceinline__ void st16(bf16_t* p, const float* o) { *(u32x4*)p = pack8(o); *(u32x4*)(p + 8) = pack8(o + 8); }
__device__ __forceinline__ void phase_post(const Params& P, const Ctx& C, int l) {
    const int j = l >> 1; const bool ev = (l & 1) == 0;
    const bf16_t* PROJ = (const bf16_t*)(P.ws + WS_PROJ); const bf16_t* PREP = (const bf16_t*)(P.ws + WS_PREP);
    const bf16_t* Y0 = (const bf16_t*)(P.ws + WS_MP); const bf16_t* Y1 = Y0 + (size_t)MTOK * YLD; bf16_t* MIX = (bf16_t*)(P.ws + WS_MIX);
    const int gw = C.bid * 8 + C.wave, NGW = C.G * 8, lane = C.lane, c0 = lane * 16;
    for (int m = gw; m < MTOK; m += NGW) {
        float ya[16], yb[16], t0[16], t1[16], o[16];
        if (ev) {
            const bf16_t* pp = PREP + (size_t)m * PREP_LD;
            ld16(Y0 + (size_t)m * YLD + c0, ya); ld16(Y1 + (size_t)m * YLD + c0, yb); ld16(pp + c0, t0); ld16(pp + 2048 + c0, t1);
            const float dsk = P.in[I_SSDD][j * 16 + (lane >> 2)]; float ss = 0.f;
#pragma unroll
            for (int e = 0; e < 16; ++e) { o[e] = (ya[e] + yb[e] + t0[e] * dsk) * t1[e]; ss += o[e] * o[e]; }
            const float rs = rsqrtf(wave_sum(ss) * (1.f / 1024.f) + 1e-6f);
            ld16f(P.in[I_SSDN] + j * 1024 + c0, t0);
#pragma unroll
            for (int e = 0; e < 16; ++e) o[e] = o[e] * rs * t0[e];
            st16(MIX + (size_t)m * 2048 + c0, o);
            ld16(Y0 + (size_t)m * YLD + 1024 + c0, ya); ld16(Y1 + (size_t)m * YLD + 1024 + c0, yb);
            float mu = 0.f;
#pragma unroll
            for (int e = 0; e < 16; ++e) { ya[e] += yb[e]; mu += ya[e]; }
            mu += __shfl_xor(mu, 1); mu += __shfl_xor(mu, 2); mu *= (1.f / 64.f);
            float var = 0.f;
#pragma unroll
            for (int e = 0; e < 16; ++e) { ya[e] -= mu; var += ya[e] * ya[e]; }
            var += __shfl_xor(var, 1); var += __shfl_xor(var, 2); var *= (1.f / 64.f);
            const float rstd = rsqrtf(var + 64e-5f);
            ld16f(P.in[I_LNW] + j * 1024 + c0, t0); ld16f(P.in[I_LNB] + j * 1024 + c0, t1);
#pragma unroll
            for (int e = 0; e < 16; ++e) o[e] = ya[e] * rstd * t0[e] + t1[e];
            ld16(pp + 3072 + c0, ya); ld16(pp + 4096 + c0, yb); ld16f(P.in[I_RK] + j * 1024 + c0, t0);
            float bs = 0.f;
#pragma unroll
            for (int e = 0; e < 16; ++e) bs += ya[e] * yb[e] * t0[e];
            bs += __shfl_xor(bs, 1); bs += __shfl_xor(bs, 2);
            ld16(pp + 5120 + c0, ya); ld16(PROJ + (size_t)m * LOUT_LD + 4096 + c0, yb);
#pragma unroll
            for (int e = 0; e < 16; ++e) o[e] = (o[e] + bs * ya[e]) * yb[e];
            st16(MIX + (size_t)m * 2048 + 1024 + c0, o);
        } else {
            const bf16_t* pr = PROJ + (size_t)m * PROJ_LD_CD;
#pragma unroll
            for (int g = 0; g < 2; ++g) {
                ld16(Y0 + (size_t)m * YLD + g * 1024 + c0, ya); ld16(Y1 + (size_t)m * YLD + g * 1024 + c0, yb);
                float ss = 0.f;
#pragma unroll
                for (int e = 0; e < 16; ++e) { ya[e] += yb[e]; ss += ya[e] * ya[e]; }
                ss += __shfl_xor(ss, 1); ss += __shfl_xor(ss, 2); ss += __shfl_xor(ss, 4); ss += __shfl_xor(ss, 8);
                const float rs = rsqrtf(ss * (1.f / 256.f) + 1e-6f);
                ld16f((g == 0 ? P.in[I_GLAN] : P.in[I_MLN]) + j * 1024 + c0, t0);
                ld16(pr + (g == 0 ? 2048 : IN_GLA + 2048) + c0, t1);
#pragma unroll
                for (int e = 0; e < 16; ++e) o[e] = ya[e] * rs * t0[e] * (g == 0 ? siluf_(t1[e]) : sigmoidf_(t1[e]));
                st16(MIX + (size_t)m * 2048 + g * 1024 + c0, o);
            }
        }
    }
}

__global__ void __launch_bounds__(512, 2) hybrid_fwd(Params P) {
    extern __shared__ __attribute__((aligned(16))) unsigned char lds_raw[];
    cg::grid_group grid = cg::this_grid();
    Ctx C; C.lds = (LAS unsigned char*)lds_raw; C.tid = threadIdx.x; C.lane = C.tid & 63; C.wave = __builtin_amdgcn_readfirstlane(C.tid >> 6); C.G = gridDim.x; C.bid = blockIdx.x;
    const float* MOD = (const float*)(P.ws + WS_MOD);
    const bf16_t* H = (const bf16_t*)(P.ws + WS_H);
    if (C.tid < 4) ((volatile LAS unsigned*)(C.lds + LDS_BYTES - 16))[C.tid] = 0u;
    __syncthreads();
    const XcdBarrier xb = xcd_barrier_post((unsigned*)(P.ws + WS_CTL), (volatile LAS unsigned*)(C.lds + LDS_BYTES - 16));
    REP(1) if (PH & 1) phase_mod(P, fresh_ctx(C.lds));
    REP(2) if (PH & 2) phase_convert(P, fresh_ctx(C.lds), 0);
    grid.sync();
    if (PH & 4) phase_rows(P, fresh_ctx(C.lds), 0, nullptr, nullptr, true, P.in[I_NORMG] + 0, MOD + 0);
    GSYNC();
#pragma unroll 1
    for (int l = 0; l < 4; ++l) {
        const bool ev = (l & 1) == 0; const float* modl = MOD + (size_t)l * 5 * 6144; const float* ng = P.in[I_NORMG] + l * 4 * 1024;
        REP(8) if (PH & 8) { pg8::Gemm g{H, (const bf16_t*)(P.ws + WS_WIN), 1024, 1024, 1024}; pg8::Sched<0> S; S.init(MTOK, ev ? N_AB_P : N_CD_P, 1, 1024, C.G, C.bid);
          pg8::EpiBf16<0> E{(bf16_t*)(P.ws + WS_PROJ), ev ? PROJ_LD_AB : PROJ_LD_CD}; pg8::gemm_phase(C.lds, g, S, E); }
        GSYNC();
        REP(16) if (PH & 16) { if (ev) phase_prep_even(P, fresh_ctx(C.lds), l >> 1); else phase_prep_odd(P, fresh_ctx(C.lds), l >> 1); }
        GSYNC();
        if (ev && (PH & 32)) {
            REP(32) {
            pg8::Gemm g{(const bf16_t*)(P.ws + WS_LORAA), (const bf16_t*)(P.ws + WS_WLORA), LORA_K, 128, 128}; pg8::Sched<1> S; S.init(MTOK, LOUT_LD, 1, 128, C.G, C.bid);
            pg8::EpiBf16<0> E{(bf16_t*)(P.ws + WS_PROJ), LOUT_LD}; pg8::gemm_phase(C.lds, g, S, E); }
            GSYNC();
        }
        for (int rep_ = 0; rep_ < (((DUP & 64) && ev) || ((DUP & 0x4000) && !ev) ? 2 : 1); ++rep_) if (PH & 64) phase_scan(P, fresh_ctx(C.lds), l);
        GSYNC();
        REP(128) if (PH & 128) phase_post(P, fresh_ctx(C.lds), l);
        GSYNC();
        REP(256) if (PH & 256) { pg8::Gemm g{(const bf16_t*)(P.ws + WS_MIX), (const bf16_t*)(P.ws + WS_WOUT), 2048, 2048, 1024}; pg8::Sched<0> S; S.init(MTOK, 1024, 2, 1024, C.G, C.bid);
          pg8::EpiF32 E{(float*)(P.ws + WS_MP), 1024, (size_t)MTOK * 1024}; pg8::gemm_phase(C.lds, g, S, E); }
        GSYNC();
        if (DUP & 512) phase_rows(P, fresh_ctx(C.lds), 1, ng + 1024, modl + 2048, true, ng + 2048, modl + 3072, true);
        if (PH & 512) phase_rows(P, fresh_ctx(C.lds), 1, ng + 1024, modl + 2048, true, ng + 2048, modl + 3072);
        GSYNC();
        REP(1024) if (PH & 1024) { pg8::Gemm g{H, (const bf16_t*)(P.ws + WS_WUP), 1024, 1024, 1024}; pg8::Sched<0> S; S.init(MTOK, 4096, 1, 1024, C.G, C.bid);
          pg8::EpiBf16<2> E{(bf16_t*)(P.ws + WS_PROJ), 4096}; pg8::gemm_phase(C.lds, g, S, E); }
        GSYNC();
        REP(2048) if (PH & 2048) { pg8::Gemm g{(const bf16_t*)(P.ws + WS_PROJ), (const bf16_t*)(P.ws + WS_WDN), 4096, 4096, 2048}; pg8::Sched<0> S; S.init(MTOK, 1024, 2, 2048, C.G, C.bid);
          pg8::EpiF32 E{(float*)(P.ws + WS_MP), 1024, (size_t)MTOK * 1024}; pg8::gemm_phase(C.lds, g, S, E); }
        GSYNC();
        if (DUP & 4096) phase_rows(P, fresh_ctx(C.lds), 1, ng + 3072, modl + 5120, true, ng + 2048, modl + 3072, true);
        if (PH & 4096) { if (l < 3) { phase_rows(P, fresh_ctx(C.lds), 1, ng + 3072, modl + 5120, true, ng + 4096, modl + 5 * 6144); phase_convert(P, fresh_ctx(C.lds), l + 1); }
        else phase_rows(P, fresh_ctx(C.lds), 1, ng + 3072, modl + 5120, false, nullptr, nullptr); }
        if (l < 3) GSYNC();
    }
}

extern "C" void kernel_launch(void* const* d_in, const int* in_sizes, int n_in, void* d_out, int out_size, void* d_ws, size_t ws_size, hipStream_t stream) {
    static int grid = 0;
    if (grid == 0) {
        if (n_in != 44 || ws_size < WS_END) { fprintf(stderr, "kernel_launch: unexpected n_in %d / ws %zu\n", n_in, ws_size); grid = -1; return; }
        int dev = 0, cus = 0, per_cu = 0;
        hipGetDevice(&dev); hipDeviceGetAttribute(&cus, hipDeviceAttributeMultiprocessorCount, dev);
        if (hipFuncSetAttribute((const void*)hybrid_fwd, hipFuncAttributeMaxDynamicSharedMemorySize, LDS_BYTES) != hipSuccess) { fprintf(stderr, "hipFuncSetAttribute failed\n"); grid = -1; return; }
        hipOccupancyMaxActiveBlocksPerMultiprocessor(&per_cu, (const void*)hybrid_fwd, 512, LDS_BYTES);
        (void)hipGetLastError();
        if (per_cu < 1) per_cu = 1;
        grid = cus * 1;
    }
    if (grid < 0) return;
    if (hipMemsetAsync((char*)d_ws + WS_CTL, 0, CTL_BYTES, stream) != hipSuccess) { fprintf(stderr, "memset failed\n"); return; }
    Params p{};
    for (int i = 0; i < 44; ++i) p.in[i] = (const float*)d_in[i];
    p.out = (float*)d_out; p.ws = (unsigned char*)d_ws;
    void* args[] = {&p};
    hipError_t e = hipLaunchCooperativeKernel((const void*)hybrid_fwd, dim3(grid), dim3(512), args, LDS_BYTES, stream);
    if (e != hipSuccess) fprintf(stderr, "cooperative launch failed: %s (grid %d)\n", hipGetErrorString(e), grid);
}
```

```cpp
#include <hip/hip_runtime.h>
#include <hip/hip_cooperative_groups.h>
#include <cstdio>
#include <cstdint>
namespace cg = cooperative_groups;

#define LAS __attribute__((address_space(3)))
typedef unsigned short bf16_t;
typedef short bf16x8 __attribute__((ext_vector_type(8)));
typedef float f32x4 __attribute__((ext_vector_type(4)));
typedef float f32x2 __attribute__((ext_vector_type(2)));
typedef unsigned u32x4 __attribute__((ext_vector_type(4)));
typedef unsigned u32x2 __attribute__((ext_vector_type(2)));

constexpr int MTOK = 8192, DM = 1024, DFF = 4096;
constexpr int N_AB = 6560, N_AB_P = 6656, N_CD = 6192, N_CD_P = 6400;
constexpr int PROJ_LD_AB = N_AB_P, PROJ_LD_CD = N_CD_P;
constexpr int PREP_LD = 7168, LOUT_LD = 5120, LORA_K = 384, YLD = 2048;
constexpr int IN_SSD = 3104, IN_GLA = 3104;
constexpr size_t MiB = 1u << 20;
constexpr size_t WS_MOD = 0, WS_CTL = 512 * 1024, CTL_BYTES = 16384, WS_DT = 1 * MiB, WS_DA = 3 * MiB, WS_WIN = 5 * MiB, WS_WOUT = 19 * MiB, WS_WUP = 23 * MiB, WS_WDN = 31 * MiB,
                 WS_WLORA = 39 * MiB, WS_H = 41 * MiB, WS_PROJ = 57 * MiB, WS_PREP = 161 * MiB, WS_MIX = 273 * MiB, WS_MP = 305 * MiB,
                 WS_LORAA = 369 * MiB, WS_END = 375 * MiB;
constexpr size_t O_X = 0, O_SSD = 8388608, O_RWKV = 16777216, O_GLA = 20971520, O_MC = 29360128, O_MN = 37748736, O_MM = 37781504;

struct Params { const float* in[44]; float* out; unsigned char* ws; };
enum { I_XP = 0, I_XS, I_SSSD, I_SRWKV, I_SGLA, I_SMC, I_SMN, I_SMM, I_C, I_CCTX, I_WMOD, I_BMOD, I_NORMG, I_WUP, I_WDN, I_WINAB, I_SCONVW, I_SCONVB,
       I_DTB, I_ALOG, I_SSDD, I_SSDN, I_MU, I_W0, I_W2, I_A0, I_A2, I_G2, I_KK, I_KA, I_RK, I_LNW, I_LNB, I_WOUTAB, I_WINCD, I_GGW, I_GGB, I_GLAN,
       I_MCONVW, I_MCONVB, I_MIB, I_MFB, I_MLN, I_WOUTCD };

__device__ __forceinline__ float bf2f(unsigned b) { return __uint_as_float(b << 16); }
__device__ __forceinline__ unsigned f2bf(float f) { unsigned u = __float_as_uint(f); return (u + 0x7fffu + ((u >> 16) & 1u)) >> 16; }
typedef __bf16 bf16x2_hw __attribute__((ext_vector_type(2)));
__device__ __forceinline__ unsigned pk2(float lo, float hi) { const f32x2 v = {lo, hi}; const bf16x2_hw b = __builtin_convertvector(v, bf16x2_hw); return __builtin_bit_cast(unsigned, b); }
__device__ __forceinline__ float lo16(unsigned w) { return __uint_as_float(w << 16); }
__device__ __forceinline__ float hi16(unsigned w) { return __uint_as_float(w & 0xffff0000u); }
__device__ __forceinline__ void unpack8(u32x4 w, float* o) { o[0] = lo16(w.x); o[1] = hi16(w.x); o[2] = lo16(w.y); o[3] = hi16(w.y); o[4] = lo16(w.z); o[5] = hi16(w.z); o[6] = lo16(w.w); o[7] = hi16(w.w); }
__device__ __forceinline__ f32x4 unpack4(u32x2 w) { return (f32x4){lo16(w.x), hi16(w.x), lo16(w.y), hi16(w.y)}; }
__device__ __forceinline__ u32x4 pack8(const float* o) { u32x4 w; w.x = pk2(o[0], o[1]); w.y = pk2(o[2], o[3]); w.z = pk2(o[4], o[5]); w.w = pk2(o[6], o[7]); return w; }
__device__ __forceinline__ float sigmoidf_(float x) { return 1.f / (1.f + __expf(-x)); }
__device__ __forceinline__ float siluf_(float x) { return x / (1.f + __expf(-x)); }
__device__ __forceinline__ float softplusf_(float x) { return fmaxf(x, 0.f) + __logf(1.f + __expf(-fabsf(x))); }
__device__ __forceinline__ float logsigmoidf_(float x) { return fminf(x, 0.f) - __logf(1.f + __expf(-fabsf(x))); }
__device__ __forceinline__ float tanhf_(float x) { const float e = __expf(-2.f * fabsf(x)); const float r = (1.f - e) / (1.f + e); return x < 0.f ? -r : r; }
__device__ __forceinline__ float wave_sum(float v) {
#pragma unroll
    for (int o = 1; o < 64; o <<= 1) v += __shfl_xor(v, o);
    return v;
}
__device__ __forceinline__ float quad_sum(float x) {
    x += __int_as_float(__builtin_amdgcn_update_dpp(0, __float_as_int(x), 0xB1, 0xF, 0xF, true));
    x += __int_as_float(__builtin_amdgcn_update_dpp(0, __float_as_int(x), 0x4E, 0xF, 0xF, true));
    return x;
}

#define DPP_ADD(x, ctrl) ((x) + __int_as_float(__builtin_amdgcn_update_dpp(0, __float_as_int(x), (ctrl), 0xF, 0xF, true)))
__device__ __forceinline__ float row_sum8(float x) { x = DPP_ADD(x, 0xB1); x = DPP_ADD(x, 0x4E); x = DPP_ADD(x, 0x141); return x; }
__device__ __forceinline__ float row_sum16(float x) { x = row_sum8(x); x = DPP_ADD(x, 0x140); return x; }
namespace pg8 {
constexpr int BM = 256, BK = 64, HALF = 128, HTB = HALF * BK * 2, STAGE_BYTES = 8 * HTB, NXCD = 8, WGM = 8;
__host__ __device__ __forceinline__ int lds_byte(int r, int c) { const int st = (r >> 4) * 2 + (c >> 5), rr = r & 15, cc = c & 31, ob = rr * 64 + cc * 2; return st * 1024 + (ob ^ (((ob >> 9) & 1) << 5)); }
__host__ __device__ __forceinline__ void stage_rc(int b, int& R, int& C) { const int st = b / 1024, sb = b % 1024, swz = sb ^ (((sb >> 9) & 1) << 5); R = (st >> 1) * 16 + swz / 64; C = (st & 1) * 32 + (swz % 64) / 2; }
__host__ __device__ __forceinline__ int perm32(int rho) { const int n = rho >> 4, i = rho & 15; return 8 * (i >> 2) + 4 * n + (i & 3); }

struct Unit { int pm, pn, ks; };
struct Gemm { const bf16_t* A; const bf16_t* Bt; int lda, ldb, K; };
template <int mode> struct Sched {
    int nM, nN, nNv, nwg, G, c, K;
    __device__ void init(int M, int N, int nK, int K_, int G_, int c_) { nM = M / BM; nN = N / BM; nNv = nN * nK; nwg = nM * nNv; G = G_; c = c_; K = K_; }
    __device__ bool next(int i, Unit& u) const {
        const long L = (long)i * G + c; if (L >= nwg) return false;
        int wgid = (int)L; { const int q = nwg / NXCD, r = nwg % NXCD, xcd = wgid % NXCD, off = wgid / NXCD; wgid = (xcd < r ? xcd * (q + 1) : r * (q + 1) + (xcd - r) * q) + off; }
        const int nig = WGM * nNv, gid = wgid / nig, fm = gid * WGM, gsz = (nM - fm) < WGM ? (nM - fm) : WGM;
        u.pm = fm + ((wgid % nig) % gsz); const int pnv = (wgid % nig) / gsz; u.pn = pnv % nN; u.ks = pnv / nN; return true;
    }
    __device__ __forceinline__ size_t aoff(const Unit& u) const { if (mode == 1) { const int g = u.pn >> 2; return (size_t)(g < 2 ? 0 : (g < 4 ? 128 : 256)) * 2; } return (size_t)u.ks * K * 2; }
    __device__ __forceinline__ size_t boff(const Unit& u) const { return mode == 1 ? 0 : (size_t)u.ks * K * 2; }
};

__device__ __forceinline__ unsigned cvt_pk_bf16(float lo, float hi) { unsigned r; asm volatile("v_cvt_pk_bf16_f32 %0, %1, %2" : "=v"(r) : "v"(lo), "v"(hi)); return r; }

template <int ACT> struct EpiBf16 {
    static constexpr bool PERM = true;
    bf16_t* O; int ldc; size_t pstride;
    __device__ __forceinline__ void operator()(const f32x4 (&acc)[2][2][4][2], const Unit& u, int wr, int wc, int fr, int fq) const {
        const int row0 = u.pm * BM + wr * 64 + fr; const int col0 = u.pn * BM + wc * 32 + 8 * fq; bf16_t* Ob = O + (size_t)u.ks * pstride;
#pragma unroll
        for (int ai = 0; ai < 2; ++ai)
#pragma unroll
            for (int m = 0; m < 4; ++m) { bf16_t* rowp = Ob + (size_t)(row0 + ai * HALF + m * 16) * ldc + col0;
#pragma unroll
                for (int bj = 0; bj < 2; ++bj) { f32x4 v0 = acc[ai][bj][m][0], v1 = acc[ai][bj][m][1];
                    if (ACT == 2) {
#pragma unroll
                        for (int e = 0; e < 4; ++e) { const float a = fmaxf(v0[e], 0.f), b = fmaxf(v1[e], 0.f); v0[e] = a * a; v1[e] = b * b; } }
                    u32x4 w; w.x = cvt_pk_bf16(v0[0], v0[1]); w.y = cvt_pk_bf16(v0[2], v0[3]); w.z = cvt_pk_bf16(v1[0], v1[1]); w.w = cvt_pk_bf16(v1[2], v1[3]);
                    *(u32x4*)(rowp + bj * HALF) = w; } }
    }
};
struct EpiF32 {
    static constexpr bool PERM = false;
    float* O; int ldc; size_t pstride;
    __device__ __forceinline__ void operator()(const f32x4 (&acc)[2][2][4][2], const Unit& u, int wr, int wc, int fr, int fq) const {
        float* base = O + (size_t)u.ks * pstride; const int col0 = u.pn * BM + wc * 32 + 4 * fq;
#pragma unroll
        for (int ai = 0; ai < 2; ++ai)
#pragma unroll
            for (int m = 0; m < 4; ++m) { float* rowp = base + (size_t)(u.pm * BM + ai * HALF + wr * 64 + m * 16 + fr) * ldc + col0;
#pragma unroll
                for (int bj = 0; bj < 2; ++bj)
#pragma unroll
                    for (int n = 0; n < 2; ++n) *(f32x4*)(rowp + bj * HALF + n * 16) = acc[ai][bj][m][n]; }
    }
};

template <class Epi, class SchedT>
__device__ __forceinline__ void gemm_phase(LAS unsigned char* lds, const Gemm g, const SchedT& S, const Epi& E) {
    int tid_ = threadIdx.x; asm volatile("" : "+v"(tid_));
    const int tid = tid_, wid = __builtin_amdgcn_readfirstlane(tid >> 6), lane = tid & 63, wr = wid >> 2, wc = wid & 3, fr = lane & 15, fq = lane >> 4;
    int K_ = g.K; asm volatile("" : "+s"(K_));
    const int K = K_, nt = K / BK;
    unsigned voffA[2], voffB[2];
#pragma unroll
    for (int i = 0; i < 2; ++i) { int R, C; stage_rc(tid * 16 + i * 8192, R, C); const int Rb = Epi::PERM ? ((R & ~31) + perm32(R & 31)) : R;
        voffA[i] = (unsigned)(R * g.lda + C) * 2u; voffB[i] = (unsigned)(Rb * g.ldb + C) * 2u; }
    const size_t kstep = (size_t)(BK * 2);
    const size_t hstepA = (size_t)HALF * g.lda * 2, hstepB = (size_t)HALF * g.ldb * 2;
    const size_t tstepA = 2 * hstepA, tstepB = 2 * hstepB;
    const unsigned ldsw = (unsigned)wid * 1024u;
    const int aoff = lds_byte(wr * 64 + fr, fq * 8), boff = lds_byte(wc * 32 + fr, fq * 8);
#define PG8_SA(b, h) (((b) * 2 + (h)) * HTB)
#define PG8_SB(b, h) ((4 + (b) * 2 + (h)) * HTB)
#define PG8_STAGE(bufoff, gbase, voff) do { _Pragma("unroll") for (int _i = 0; _i < 2; ++_i) \
        __builtin_amdgcn_global_load_lds((const unsigned*)((const char*)(gbase) + (voff)[_i]), (LAS unsigned*)(lds + (bufoff) + ldsw + _i * 8192), 16, 0, 0); } while (0)
#define PG8_LDA(dst, b, h) do { _Pragma("unroll") for (int m = 0; m < 4; ++m) _Pragma("unroll") for (int k = 0; k < 2; ++k) dst[m][k] = *(const LAS bf16x8*)(lds + PG8_SA(b, h) + aoff + m * 2048 + k * 1024); } while (0)
#define PG8_LDB(dst, b, h) do { _Pragma("unroll") for (int n = 0; n < 2; ++n) _Pragma("unroll") for (int k = 0; k < 2; ++k) dst[n][k] = *(const LAS bf16x8*)(lds + PG8_SB(b, h) + boff + n * 2048 + k * 1024); } while (0)
#define PG8_MMA(ai, bj, At, Bt) do { __builtin_amdgcn_s_setprio(1); _Pragma("unroll") for (int m = 0; m < 4; ++m) _Pragma("unroll") for (int n = 0; n < 2; ++n) _Pragma("unroll") for (int k = 0; k < 2; ++k) \
        acc[ai][bj][m][n] = __builtin_amdgcn_mfma_f32_16x16x32_bf16(Bt[n][k], At[m][k], acc[ai][bj][m][n], 0, 0, 0); __builtin_amdgcn_s_setprio(0); } while (0)
#define PG8_WAIT_V(n) asm volatile("s_waitcnt vmcnt(" #n ")" ::: "memory")
#define PG8_WAIT_L(n) asm volatile("s_waitcnt lgkmcnt(" #n ")" ::: "memory")
#define PG8_BAR __builtin_amdgcn_s_barrier()
#define PG8_SCHED __builtin_amdgcn_sched_barrier(0)
    Unit cur, nxt; int ui = 0;
    if (!S.next(0, cur)) return;
    f32x4 acc[2][2][4][2];
#pragma unroll
    for (int a = 0; a < 2; ++a)
#pragma unroll
        for (int b = 0; b < 2; ++b)
#pragma unroll
            for (int m = 0; m < 4; ++m)
#pragma unroll
                for (int n = 0; n < 2; ++n) acc[a][b][m][n] = (f32x4){0.f, 0.f, 0.f, 0.f};
    bf16x8 At[4][2], B0[2][2], B1[2][2];
    const char* cA = (const char*)g.A + (size_t)cur.pm * tstepA + S.aoff(cur); const char* cB = (const char*)g.Bt + (size_t)cur.pn * tstepB + S.boff(cur);
    PG8_STAGE(PG8_SB(0, 0), cB, voffB); PG8_STAGE(PG8_SB(0, 1), cB + hstepB, voffB); PG8_STAGE(PG8_SA(0, 0), cA, voffA); PG8_STAGE(PG8_SA(0, 1), cA + hstepA, voffA);
    if (wr == 1) PG8_BAR;
    PG8_WAIT_V(2); PG8_BAR;
    PG8_STAGE(PG8_SB(1, 0), cB + kstep, voffB); PG8_STAGE(PG8_SA(1, 0), cA + kstep, voffA); PG8_STAGE(PG8_SB(1, 1), cB + hstepB + kstep, voffB);
    PG8_WAIT_V(6); PG8_BAR;
    for (;;) {
        const bool has_next = S.next(ui + 1, nxt);
        const char* nA = has_next ? (const char*)g.A + (size_t)nxt.pm * tstepA + S.aoff(nxt) : cA; const char* nB = has_next ? (const char*)g.Bt + (size_t)nxt.pn * tstepB + S.boff(nxt) : cB;
        for (int t = 0; t < nt; t += 2) {
            const bool last = (t == nt - 2);
            const char* a1 = cA + (size_t)(t + 1) * kstep;
            const char* a2 = last ? nA : cA + (size_t)(t + 2) * kstep; const char* b2 = last ? nB : cB + (size_t)(t + 2) * kstep;
            const char* a3 = a2 + kstep; const char* b3 = b2 + kstep;
            PG8_LDB(B0, 0, 0); PG8_LDB(B1, 0, 1); PG8_SCHED; PG8_LDA(At, 0, 0); PG8_STAGE(PG8_SA(1, 1), a1 + hstepA, voffA);
            PG8_WAIT_V(8); PG8_WAIT_L(0); PG8_BAR; PG8_MMA(0, 0, At, B0); PG8_MMA(0, 1, At, B1); PG8_BAR; PG8_SCHED;
            PG8_LDA(At, 0, 1); PG8_STAGE(PG8_SB(0, 0), b2, voffB); PG8_STAGE(PG8_SB(0, 1), b2 + hstepB, voffB); PG8_STAGE(PG8_SA(0, 0), a2, voffA);
            PG8_WAIT_V(8); PG8_WAIT_L(0); PG8_BAR; PG8_MMA(1, 0, At, B0); PG8_MMA(1, 1, At, B1); PG8_BAR; PG8_SCHED;
            PG8_LDB(B0, 1, 0); PG8_LDB(B1, 1, 1); PG8_SCHED; PG8_LDA(At, 1, 0); PG8_STAGE(PG8_SA(0, 1), a2 + hstepA, voffA);
            PG8_WAIT_V(8); PG8_WAIT_L(0); PG8_BAR; PG8_MMA(0, 0, At, B0); PG8_MMA(0, 1, At, B1); PG8_BAR; PG8_SCHED;
            PG8_LDA(At, 1, 1); PG8_STAGE(PG8_SB(1, 0), b3, voffB); PG8_STAGE(PG8_SB(1, 1), b3 + hstepB, voffB); PG8_STAGE(PG8_SA(1, 0), a3, voffA);
            PG8_WAIT_V(8); PG8_WAIT_L(0); PG8_BAR; PG8_MMA(1, 0, At, B0); PG8_MMA(1, 1, At, B1); PG8_BAR; PG8_SCHED;
        }
        if (wr == 0) PG8_BAR;
        E(acc, cur, wr, wc, fr, fq);
        if (!has_next) break;
#pragma unroll
        for (int a = 0; a < 2; ++a)
#pragma unroll
            for (int b = 0; b < 2; ++b)
#pragma unroll
                for (int m = 0; m < 4; ++m)
#pragma unroll
                    for (int n = 0; n < 2; ++n) acc[a][b][m][n] = (f32x4){0.f, 0.f, 0.f, 0.f};
        cur = nxt; cA = nA; cB = nB; ++ui;
        if (wr == 1) PG8_BAR;
    }
    PG8_WAIT_V(0);
    PG8_BAR;
#undef PG8_SA
#undef PG8_SB
#undef PG8_STAGE
#undef PG8_LDA
#undef PG8_LDB
#undef PG8_MMA
#undef PG8_WAIT_V
#undef PG8_WAIT_L
#undef PG8_BAR
#undef PG8_SCHED
}
}

#define XB_TMO      128
#define XB_XCNT(j)  (256  + 64 * (j))
#define XB_XSUB(j)  (1280 + 64 * (j))
#define XB_XGEN(j)  (2304 + 64 * (j))
#define XB_TOP      3328
#define XB_TOPGEN   3392
#define XCD_BAR_WORDS 3456
#define XB_SPIN_CAP (1u << 18)
__device__ __forceinline__ unsigned xb_ld(unsigned* p)              { return __hip_atomic_load(p, __ATOMIC_RELAXED, __HIP_MEMORY_SCOPE_AGENT); }
__device__ __forceinline__ unsigned xb_add(unsigned* p, unsigned v) { return __hip_atomic_fetch_add(p, v, __ATOMIC_RELAXED, __HIP_MEMORY_SCOPE_AGENT); }
__device__ __forceinline__ unsigned xb_xcc_id() { return (unsigned)__builtin_amdgcn_s_getreg((3 << 11) | 20) & 0xFu; }
#define XB_SPIN(cond, bar) do { unsigned _sp = 0; while (cond) { __builtin_amdgcn_s_sleep(1); \
    if ((++_sp & 255u) == 0u) { if (xb_ld(&(bar)[XB_TMO])) break; if (_sp > XB_SPIN_CAP) { atomicAdd(&(bar)[XB_TMO], 1u); break; } } } } while (0)
struct XcdBarrier { unsigned* bar; unsigned x; volatile LAS unsigned* st; };
__device__ __forceinline__ XcdBarrier xcd_barrier_post(unsigned* bar, volatile LAS unsigned* st) {
    XcdBarrier b; b.bar = bar; b.x = xb_xcc_id(); b.st = st;
    if (threadIdx.x == 0) (void)xb_add(&bar[XB_XCNT(b.x)], 1u);
    return b;
}
__device__ __forceinline__ void xcd_barrier_complete(unsigned* bar, unsigned x, unsigned& nloc, unsigned& nx) {
    const unsigned G = gridDim.x * gridDim.y * gridDim.z;
    unsigned sum, cnt, mine, sp = 0u;
    for (;;) {
        sum = 0u; cnt = 0u; mine = 0u;
#pragma unroll
        for (unsigned j = 0; j < 16; ++j) { const unsigned c = xb_ld(&bar[XB_XCNT(j)]); sum += c; cnt += (c > 0u) ? 1u : 0u; mine = (j == x) ? c : mine; }
        if (sum == G) break;
        __builtin_amdgcn_s_sleep(1);
        if ((++sp & 255u) == 0u) { if (xb_ld(&bar[XB_TMO])) break; if (sp > XB_SPIN_CAP) { atomicAdd(&bar[XB_TMO], 1u); break; } }
    }
    nloc = mine > 0u ? mine : 1u; nx = cnt > 0u ? cnt : 1u;
}
__device__ __forceinline__ void xcd_barrier(const XcdBarrier& b) {
    asm volatile("s_waitcnt vmcnt(0)" ::: "memory");
    __syncthreads();
    if (threadIdx.x == 0) {
        unsigned* bar = b.bar;
        __builtin_amdgcn_s_waitcnt(0);
        unsigned nloc = b.st[0], nx = b.st[1];
        if (nloc == 0u) { xcd_barrier_complete(bar, b.x, nloc, nx); b.st[0] = nloc; b.st[1] = nx; }
        const unsigned old = xb_add(&bar[XB_XSUB(b.x)], 1u);
        const unsigned gen = old / nloc;
        if (old + 1u == (gen + 1u) * nloc) {
            __builtin_amdgcn_fence(__ATOMIC_RELEASE, "agent");
            asm volatile("s_waitcnt vmcnt(0)" ::: "memory");
            const unsigned og = xb_add(&bar[XB_TOP], 1u);
            const unsigned tg = og / nx;
            if (og + 1u == (tg + 1u) * nx) xb_add(&bar[XB_TOPGEN], 1u);
            else XB_SPIN(xb_ld(&bar[XB_TOPGEN]) == tg, bar);
            __builtin_amdgcn_fence(__ATOMIC_ACQUIRE, "agent");
            xb_add(&bar[XB_XGEN(b.x)], 1u);
            asm volatile("s_waitcnt vmcnt(0)" ::: "memory");
        } else {
            XB_SPIN(xb_ld(&bar[XB_XGEN(b.x)]) == gen, bar);
            __builtin_amdgcn_fence(__ATOMIC_ACQUIRE, "agent");
            asm volatile("s_waitcnt vmcnt(0)" ::: "memory");
        }
    }
    __syncthreads();
}

constexpr int LDS_BYTES = 147456;
#ifndef PH
#define PH 0xFFFF
#endif
#ifndef DUP
#define DUP 0
#endif
#define GSYNC() do { xcd_barrier(xb); if (DUP & 0x8000) { xcd_barrier(xb); xcd_barrier(xb); } } while (0)
#define REP(bit) for (int rep_ = 0; rep_ < ((DUP & (bit)) ? 2 : 1); ++rep_)
struct Ctx { LAS unsigned char* lds; int tid, lane, wave, G, bid; };
__device__ __forceinline__ Ctx fresh_ctx(LAS unsigned char* lds) { Ctx C; int t = threadIdx.x; asm volatile("" : "+v"(t)); C.lds = lds; C.tid = t; C.lane = t & 63; C.wave = __builtin_amdgcn_readfirstlane(t >> 6); C.G = gridDim.x; C.bid = blockIdx.x; return C; }

__device__ __forceinline__ void phase_mod(const Params& P, const Ctx& C) {
    LAS float* sc = (LAS float*)C.lds; LAS float* red = sc + 5120;
    for (int i = C.tid; i < 5120; i += 512) { const int r = i >> 10, k = i & 1023; const float x = r == 0 ? P.in[I_CCTX][k] : P.in[I_C][(r - 1) * 1024 + k]; sc[i] = siluf_(x); }
    __syncthreads();
    float* MOD = (float*)(P.ws + WS_MOD);
    const int kg = C.tid >> 6, c = C.tid & 63;
    for (int tile = C.bid; tile < 384; tile += C.G) {
        const int l = tile / 96, col = (tile % 96) * 64 + c;
        const float* w = P.in[I_WMOD] + (size_t)l * 1024 * 6144 + col;
        float a0 = 0.f, a1 = 0.f, a2 = 0.f, a3 = 0.f, a4 = 0.f;
#pragma unroll 8
        for (int k = kg * 128; k < kg * 128 + 128; ++k) { const float wv = w[(size_t)k * 6144]; a0 += sc[k] * wv; a1 += sc[1024 + k] * wv; a2 += sc[2048 + k] * wv; a3 += sc[3072 + k] * wv; a4 += sc[4096 + k] * wv; }
        red[(kg * 5 + 0) * 64 + c] = a0; red[(kg * 5 + 1) * 64 + c] = a1; red[(kg * 5 + 2) * 64 + c] = a2; red[(kg * 5 + 3) * 64 + c] = a3; red[(kg * 5 + 4) * 64 + c] = a4;
        __syncthreads();
        if (C.tid < 320) { const int r = C.tid >> 6; float s = 0.f;
#pragma unroll
            for (int q = 0; q < 8; ++q) s += red[(q * 5 + r) * 64 + c];
            MOD[(size_t)(l * 5 + r) * 6144 + col] = s + P.in[I_BMOD][l * 6144 + col]; }
        __syncthreads();
    }
}

__device__ __forceinline__ void transpose_item(const float* W, int K, int N, bf16_t* WT, LAS float* scr, int item, int nblk, int lane) {
    const int kb = item / nblk, nb = item % nblk, k0 = 64 * kb, n0 = 32 * nb;
    const bool nok = (n0 + (lane & 31)) < N;
#pragma unroll 8
    for (int i = 0; i < 32; ++i) { const int kk = 2 * i + (lane >> 5); scr[kk * 33 + (lane & 31)] = nok ? W[(size_t)(k0 + kk) * N + n0 + (lane & 31)] : 0.f; }
    asm volatile("s_waitcnt lgkmcnt(0)" ::: "memory");
    const int c = lane & 7;
#pragma unroll
    for (int j = 0; j < 4; ++j) { const int n = (lane >> 3) + 8 * j; const LAS float* s = scr + (8 * c) * 33 + n;
        u32x4 o; o.x = pk2(s[0 * 33], s[1 * 33]); o.y = pk2(s[2 * 33], s[3 * 33]); o.z = pk2(s[4 * 33], s[5 * 33]); o.w = pk2(s[6 * 33], s[7 * 33]);
        *(u32x4*)(WT + (size_t)(n0 + n) * K + k0 + 8 * c) = o; }
    asm volatile("s_waitcnt lgkmcnt(0)" ::: "memory");
}
__device__ __forceinline__ void phase_convert(const Params& P, const Ctx& C, int l) {
    LAS float* scr = (LAS float*)(C.lds + 32768 + C.wave * 8704);
    const int gw = C.bid * 8 + C.wave, NGW = C.G * 8; const int j = l >> 1; const bool ev = (l & 1) == 0;
    const float* win = ev ? P.in[I_WINAB] + (size_t)j * 1024 * N_AB : P.in[I_WINCD] + (size_t)j * 1024 * N_CD;
    const float* wout = (ev ? P.in[I_WOUTAB] : P.in[I_WOUTCD]) + (size_t)j * 2048 * 1024;
    const float* wup = P.in[I_WUP] + (size_t)l * 1024 * 4096; const float* wdn = P.in[I_WDN] + (size_t)l * 4096 * 1024;
    const int N_in = ev ? N_AB : N_CD, Np = ev ? N_AB_P : N_CD_P;
    const int I0 = 16 * (Np / 32), I1 = 32 * 32, I2 = 16 * 128, I3 = 64 * 32;
    for (int it = gw; it < I0 + I1 + I2 + I3; it += NGW) {
        int r = it;
        if (r < I0) { transpose_item(win, 1024, N_in, (bf16_t*)(P.ws + WS_WIN), scr, r, Np / 32, C.lane); continue; } r -= I0;
        if (r < I1) { transpose_item(wout, 2048, 1024, (bf16_t*)(P.ws + WS_WOUT), scr, r, 32, C.lane); continue; } r -= I1;
        if (r < I2) { transpose_item(wup, 1024, 4096, (bf16_t*)(P.ws + WS_WUP), scr, r, 128, C.lane); continue; } r -= I2;
        transpose_item(wdn, 4096, 1024, (bf16_t*)(P.ws + WS_WDN), scr, r, 32, C.lane);
    }
    if (ev) {
        bf16_t* WL = (bf16_t*)(P.ws + WS_WLORA);
        for (int idx = C.bid * 512 + C.tid; idx < 5120 * 16; idx += C.G * 512) {
            const int n = idx % 5120, k8 = idx / 5120, g = n >> 10, cc = n & 1023; float o[8];
#pragma unroll
            for (int e = 0; e < 8; ++e) { const int k = k8 * 8 + e; float v = 0.f;
                if (g == 0) { if (k < 64) v = P.in[I_W2][((size_t)(j * 2 + 0) * 64 + k) * 1024 + cc]; }
                else if (g == 1) { if (k >= 64) v = P.in[I_W2][((size_t)(j * 2 + 1) * 64 + (k - 64)) * 1024 + cc]; }
                else if (g == 2) { if (k < 64) v = P.in[I_A2][((size_t)(j * 2 + 0) * 64 + k) * 1024 + cc]; }
                else if (g == 3) { if (k >= 64) v = P.in[I_A2][((size_t)(j * 2 + 1) * 64 + (k - 64)) * 1024 + cc]; }
                else v = P.in[I_G2][((size_t)j * 128 + k) * 1024 + cc];
                o[e] = v; }
            *(u32x4*)(WL + (size_t)n * 128 + k8 * 8) = pack8(o);
        }
    }
}

__device__ __forceinline__ void phase_rows(const Params& P, const Ctx& C, int mode, const float* gpost, const float* gate_mod  ,
                                           bool next, const float* gpre, const float* mod_next  , bool dummy = false) {
    float* X = P.out + O_X; const bf16_t* MP0 = (const bf16_t*)(P.ws + WS_MP); const bf16_t* MP1 = MP0 + (size_t)MTOK * DM; bf16_t* H = (bf16_t*)(P.ws + WS_H);
    const int gw = C.bid * 8 + C.wave, NGW = C.G * 8;
    for (int m = gw; m < MTOK; m += NGW) {
        const int mr = m < 4096 ? 0 : 1 + ((m - 4096) >> 10);
        f32x4 x[4];
        if (mode == 0) { const f32x4* src = (const f32x4*)(m < 4096 ? P.in[I_XP] + (size_t)m * DM : P.in[I_XS] + (size_t)(m - 4096) * DM) + C.lane;
#pragma unroll
            for (int j = 0; j < 4; ++j) x[j] = src[64 * j];
        } else {
            const f32x4* xs = (const f32x4*)(X + (size_t)m * DM) + C.lane; const u32x2* p0 = (const u32x2*)(MP0 + (size_t)m * DM) + C.lane; const u32x2* p1 = (const u32x2*)(MP1 + (size_t)m * DM) + C.lane;
            f32x4 f[4]; float ss = 0.f;
#pragma unroll
            for (int j = 0; j < 4; ++j) { x[j] = xs[64 * j]; f[j] = unpack4(p0[64 * j]) + unpack4(p1[64 * j]); ss += (f[j].x * f[j].x + f[j].y * f[j].y) + (f[j].z * f[j].z + f[j].w * f[j].w); }
            const float rs = rsqrtf(wave_sum(ss) * (1.f / DM) + 1e-6f);
            const f32x4* gp = (const f32x4*)gpost + C.lane; const f32x4* gt = (const f32x4*)(gate_mod + (size_t)mr * 6144) + C.lane;
#pragma unroll
            for (int j = 0; j < 4; ++j) x[j] = x[j] + gt[64 * j] * (f[j] * rs * gp[64 * j]);
        }
        f32x4* xo = (f32x4*)((dummy ? (float*)(P.ws + WS_PREP) : X) + (size_t)m * DM) + C.lane;
#pragma unroll
        for (int j = 0; j < 4; ++j) xo[64 * j] = x[j];
        if (next) {
            float ss = 0.f;
#pragma unroll
            for (int j = 0; j < 4; ++j) ss += (x[j].x * x[j].x + x[j].y * x[j].y) + (x[j].z * x[j].z + x[j].w * x[j].w);
            const float rs = rsqrtf(wave_sum(ss) * (1.f / DM) + 1e-6f);
            const f32x4* gp = (const f32x4*)gpre + C.lane; const f32x4* sh = (const f32x4*)(mod_next + (size_t)mr * 6144) + C.lane; const f32x4* sl = (const f32x4*)(mod_next + (size_t)mr * 6144 + 1024) + C.lane;
            u32x2* ho = (u32x2*)((dummy ? (bf16_t*)(P.ws + WS_PREP + 40 * MiB) : H) + (size_t)m * DM) + C.lane;
#pragma unroll
            for (int j = 0; j < 4; ++j) { const f32x4 h = (x[j] * rs * gp[64 * j]) * (sl[64 * j] + 1.f) + sh[64 * j]; u32x2 w; w.x = pk2(h.x, h.y); w.y = pk2(h.z, h.w); ho[64 * j] = w; }
        }
    }
}

__device__ __forceinline__ void conv8(const bf16_t* src, int ld, int col0, int base, int t, bool samp, const float* w, const float* b, int NC, int ch, float* acc) {
    { const f32x4 b0 = *(const f32x4*)(b + ch), b1 = *(const f32x4*)(b + ch + 4); acc[0] = b0.x; acc[1] = b0.y; acc[2] = b0.z; acc[3] = b0.w; acc[4] = b1.x; acc[5] = b1.y; acc[6] = b1.z; acc[7] = b1.w; }
    if (!samp) {
#pragma unroll
        for (int d = 0; d < 3; ++d) { const int tt = t + d - 1; if (tt < 0 || tt >= 256) continue;
            float xv[8]; unpack8(*(const u32x4*)(src + (size_t)(base + tt) * ld + col0 + ch), xv);
            const f32x4 w0 = *(const f32x4*)(w + (3 + d) * NC + ch), w1 = *(const f32x4*)(w + (3 + d) * NC + ch + 4);
            acc[0] += w0.x * xv[0]; acc[1] += w0.y * xv[1]; acc[2] += w0.z * xv[2]; acc[3] += w0.w * xv[3]; acc[4] += w1.x * xv[4]; acc[5] += w1.y * xv[5]; acc[6] += w1.z * xv[6]; acc[7] += w1.w * xv[7]; }
    } else {
        const int r = t >> 6, c = t & 63;
#pragma unroll
        for (int i = 0; i < 3; ++i)
#pragma unroll
            for (int d = 0; d < 3; ++d) { const int rr = r + i - 1, cc = c + d - 1; if (rr < 0 || rr >= 16 || cc < 0 || cc >= 64) continue;
                float xv[8]; unpack8(*(const u32x4*)(src + (size_t)(base + rr * 64 + cc) * ld + col0 + ch), xv);
                const f32x4 w0 = *(const f32x4*)(w + (i * 3 + d) * NC + ch), w1 = *(const f32x4*)(w + (i * 3 + d) * NC + ch + 4);
                acc[0] += w0.x * xv[0]; acc[1] += w0.y * xv[1]; acc[2] += w0.z * xv[2]; acc[3] += w0.w * xv[3]; acc[4] += w1.x * xv[4]; acc[5] += w1.y * xv[5]; acc[6] += w1.z * xv[6]; acc[7] += w1.w * xv[7]; }
    }
}

__device__ __forceinline__ void phase_prep_even(const Params& P, const Ctx& C, int j) {
    const bf16_t* PROJ = (const bf16_t*)(P.ws + WS_PROJ); bf16_t* PREP = (bf16_t*)(P.ws + WS_PREP); bf16_t* LA = (bf16_t*)(P.ws + WS_LORAA);
    float* DT = (float*)(P.ws + WS_DT); float* DA = (float*)(P.ws + WS_DA);
    const float* cw = P.in[I_SCONVW] + (size_t)j * 9 * 2048; const float* cb = P.in[I_SCONVB] + j * 2048;
    const float* mu = P.in[I_MU] + j * 3456; const float* kkw = P.in[I_KK] + j * 1024;
    const int gw = C.bid * 8 + C.wave, NGW = C.G * 8, lane = C.lane;
    for (int m = gw; m < MTOK; m += NGW) {
        const bool samp = m >= 4096; const int T = samp ? 1024 : 256; const int t = samp ? ((m - 4096) & 1023) : (m & 255); const int base = m - t;
        const bf16_t* prow = PROJ + (size_t)m * PROJ_LD_AB; bf16_t* orow = PREP + (size_t)m * PREP_LD;
#pragma unroll 1
        for (int it = 0; it < 4; ++it) { const int ch = it * 512 + lane * 8; float acc[8];
            conv8(PROJ, PROJ_LD_AB, 1024, base, t, samp, cw, cb, 2048, ch, acc);
#pragma unroll
            for (int e = 0; e < 8; ++e) acc[e] = siluf_(acc[e]);
            *(u32x4*)(orow + ch) = pack8(acc); }
#pragma unroll
        for (int it = 0; it < 2; ++it) { const int ch = it * 512 + lane * 8; float z[8]; unpack8(*(const u32x4*)(prow + ch), z);
#pragma unroll
            for (int e = 0; e < 8; ++e) z[e] = siluf_(z[e]);
            *(u32x4*)(orow + 2048 + ch) = pack8(z); }
        if (lane < 32) { const float raw = bf2f(prow[3072 + lane]); const float dt = softplusf_(raw + P.in[I_DTB][j * 32 + lane]);
            DT[(size_t)m * 32 + lane] = dt; DA[(size_t)m * 32 + lane] = -dt * __expf(P.in[I_ALOG][j * 32 + lane]); }
        const bool hp = t > 0, hn = t < T - 1;
#pragma unroll 1
        for (int it = 0; it < 7; ++it) { const int c = it * 512 + lane * 8; if (c >= 3456) break;
            float x[8], xp[8], xn[8];
            unpack8(*(const u32x4*)(prow + IN_SSD + c), x);
            if (hp) unpack8(*(const u32x4*)(prow - PROJ_LD_AB + IN_SSD + c), xp); else {
#pragma unroll
                for (int e = 0; e < 8; ++e) xp[e] = 0.f; }
            if (hn) unpack8(*(const u32x4*)(prow + PROJ_LD_AB + IN_SSD + c), xn); else {
#pragma unroll
                for (int e = 0; e < 8; ++e) xn[e] = 0.f; }
            const f32x4 m0 = *(const f32x4*)(mu + c), m1 = *(const f32x4*)(mu + c + 4);
            const float mv[8] = {m0.x, m0.y, m0.z, m0.w, m1.x, m1.y, m1.z, m1.w};
#pragma unroll
            for (int e = 0; e < 8; ++e) x[e] = x[e] + mv[e] * (0.5f * (xp[e] + xn[e]) - x[e]);
            if (it < 2) { *(u32x4*)(orow + 3072 + c) = pack8(x); }
            else if (it < 4) { *(u32x4*)(orow + 4096 + (c - 1024)) = pack8(x);
                const f32x4 k0 = *(const f32x4*)(kkw + c - 1024), k1 = *(const f32x4*)(kkw + c - 1024 + 4);
                const float kv[8] = {k0.x, k0.y, k0.z, k0.w, k1.x, k1.y, k1.z, k1.w}; float ss = 0.f;
#pragma unroll
                for (int e = 0; e < 8; ++e) { x[e] *= kv[e]; ss += x[e] * x[e]; }
                ss += __shfl_xor(ss, 1); ss += __shfl_xor(ss, 2); ss += __shfl_xor(ss, 4);
                const float rn = rsqrtf(ss + 1e-12f);
#pragma unroll
                for (int e = 0; e < 8; ++e) x[e] *= rn;
                *(u32x4*)(orow + 6144 + (c - 1024)) = pack8(x); }
            else if (it < 6) { *(u32x4*)(orow + 5120 + (c - 2048)) = pack8(x); }
            else { const int cc = c - 3072;
#pragma unroll
                for (int e = 0; e < 8; ++e) x[e] = cc < 128 ? tanhf_(x[e]) : (cc < 256 ? x[e] : sigmoidf_(x[e]));
                *(u32x4*)(LA + (size_t)m * LORA_K + cc) = pack8(x); }
        }
    }
}
__device__ __forceinline__ void phase_prep_odd(const Params& P, const Ctx& C, int j) {
    const bf16_t* PROJ = (const bf16_t*)(P.ws + WS_PROJ); bf16_t* PREP = (bf16_t*)(P.ws + WS_PREP);
    const float* cw = P.in[I_MCONVW] + (size_t)j * 9 * 1024; const float* cb = P.in[I_MCONVB] + j * 1024;
    const int gw = C.bid * 8 + C.wave, NGW = C.G * 8, lane = C.lane;
    for (int m = gw; m < MTOK; m += NGW) {
        const bool samp = m >= 4096; const int t = samp ? ((m - 4096) & 1023) : (m & 255); const int base = m - t;
#pragma unroll 1
        for (int it = 0; it < 2; ++it) { const int ch = it * 512 + lane * 8; float acc[8];
            conv8(PROJ, PROJ_LD_CD, IN_GLA, base, t, samp, cw, cb, 1024, ch, acc);
#pragma unroll
            for (int e = 0; e < 8; ++e) acc[e] = siluf_(acc[e]);
            *(u32x4*)(PREP + (size_t)m * PREP_LD + ch) = pack8(acc); }
    }
}

constexpr int CS_QLD = 136, CS_SLD = 72;
constexpr int CS_QS = 0, CS_KS = 17408, CS_KT = 34816, CS_VT = 53248, CS_PS = 64768, CS_ST = 73984, CS_LA = 95744, CS_TOT = 128512, CS_BV = 131072, CS_IG = 131328, CS_GW = 131584, CS_MS = 140288, CS_FV = 140352, CS_DTV = 140608;
__device__ __forceinline__ bf16x8 lds_frag(const LAS bf16_t* p) { return *(const LAS bf16x8*)p; }
template <int MODE>
__device__ __forceinline__ void chunk_scan(const Params& P, const Ctx& C, int j, int s, int dir, int h, int vs) {
    const int tid = C.tid, lane = C.lane, w = C.wave, fr = lane & 15, fq = lane >> 4;
    const int T = s < 16 ? 256 : 1024, base = s < 16 ? s * 256 : 4096 + (s - 16) * 1024, nch = T >> 6;
    const bf16_t* PROJ = (const bf16_t*)(P.ws + WS_PROJ); const bf16_t* PREP = (const bf16_t*)(P.ws + WS_PREP);
    bf16_t* Y = (bf16_t*)(P.ws + WS_MP) + (size_t)dir * MTOK * YLD;
    LAS bf16_t* Qs = (LAS bf16_t*)(C.lds + CS_QS); LAS bf16_t* Ks = (LAS bf16_t*)(C.lds + CS_KS); LAS bf16_t* Kt = (LAS bf16_t*)(C.lds + CS_KT); LAS bf16_t* Vt = (LAS bf16_t*)(C.lds + CS_VT);
    LAS bf16_t* Ps = (LAS bf16_t*)(C.lds + CS_PS); LAS bf16_t* St = (LAS bf16_t*)(C.lds + CS_ST);
    LAS float* LA = (LAS float*)(C.lds + CS_LA); LAS float* TOT = (LAS float*)(C.lds + CS_TOT); LAS float* BV = (LAS float*)(C.lds + CS_BV); LAS float* IG = (LAS float*)(C.lds + CS_IG);
    LAS float* GW = (LAS float*)(C.lds + CS_GW); LAS float* MS = (LAS float*)(C.lds + CS_MS); LAS float* FV = (LAS float*)(C.lds + CS_FV); LAS float* DTV = (LAS float*)(C.lds + CS_DTV);
    constexpr int NVT = MODE == 2 ? 5 : 4;
    const int si = tid >> 3, kq = tid & 7;
    __syncthreads();
    if (MODE == 1) {
        const float* gwp = P.in[I_GGW] + (size_t)(j * 2 + dir) * 16 * 512 + h * 128;
        for (int i = tid; i < 16 * 128; i += 512) GW[i] = gwp[(i >> 7) * 512 + (i & 127)];
        if (tid < 128) GW[2048 + tid] = P.in[I_GGB][(j * 2 + dir) * 512 + h * 128 + tid];
    }
    f32x4 Sacc[NVT];
    {
        const float* s0 = nullptr; int kstride = 64; float em0 = 1.f;
        if (s >= 16) { const int b = s - 16;
            if (MODE == 0) { s0 = P.in[I_SSSD] + ((size_t)((b * 2 + j) * 2 + dir) * 16 + h) * 8192; kstride = 64; }
            if (MODE == 1) { s0 = P.in[I_SGLA] + ((size_t)((b * 2 + j) * 2 + dir) * 4 + h) * 32768 + vs * 64; kstride = 256; }
            if (MODE == 2) { s0 = P.in[I_SMC] + ((size_t)((b * 2 + j) * 2 + dir) * 4 + h) * 32768 + vs * 64; kstride = 256; em0 = __expf(P.in[I_SMM][((b * 2 + j) * 2 + dir) * 4 + h]); } }
#pragma unroll
        for (int vt = 0; vt < 4; ++vt)
#pragma unroll
            for (int e = 0; e < 4; ++e) Sacc[vt][e] = s0 ? s0[(size_t)(16 * w + 4 * fq + e) * kstride + 16 * vt + fr] * em0 : 0.f;
        if (MODE == 2) {
            const float* n0 = s >= 16 ? P.in[I_SMN] + ((size_t)(((s - 16) * 2 + j) * 2 + dir) * 4 + h) * 128 : nullptr;
#pragma unroll
            for (int e = 0; e < 4; ++e) Sacc[NVT - 1][e] = (n0 && fr == 0) ? n0[16 * w + 4 * fq + e] * em0 : 0.f;
            if (tid == 0) MS[0] = s >= 16 ? P.in[I_SMM][(((s - 16) * 2 + j) * 2 + dir) * 4 + h] : 0.f;
            for (int i = tid; i < 16 * CS_SLD; i += 512) Vt[64 * CS_SLD + i] = (bf16_t)((i < CS_SLD) ? 0x3F80 : 0);
        }
#pragma unroll
        for (int vt = 0; vt < NVT; ++vt) { u32x2 wv; wv.x = pk2(Sacc[vt][0], Sacc[vt][1]); wv.y = pk2(Sacc[vt][2], Sacc[vt][3]); *(LAS u32x2*)(St + (16 * vt + fr) * CS_QLD + 16 * w + 4 * fq) = wv; }
    }
    u32x4 rq0, rq1, rk0, rk1, rg0, rg1; float rla = 0.f, rig = 0.f, rdt = 0.f;
    unsigned short rkt[16], rvt[8];
    const int kx = tid & 127, tgk = tid >> 7, vx = tid & 63, tgv = tid >> 6;
    auto tok = [&](int c, int i) { const int st0 = c * 64 + i; return base + (dir ? (T - 1 - st0) : st0); };
    auto load_raw = [&](int c) {
        const int m = tok(c, si); const int m1 = tok(c, tid & 63);
        const bf16_t* krow; const bf16_t* vrow; int kld, vld;
        if (MODE == 0) { const int g = h >> 2; const bf16_t* pr = PREP + (size_t)m * PREP_LD;
            rq0 = *(const u32x4*)(pr + 1536 + g * 128 + 16 * kq); rq1 = *(const u32x4*)(pr + 1536 + g * 128 + 16 * kq + 8);
            rk0 = *(const u32x4*)(pr + 1024 + g * 128 + 16 * kq); rk1 = *(const u32x4*)(pr + 1024 + g * 128 + 16 * kq + 8);
            if (tid < 64) { rla = ((const float*)(P.ws + WS_DA))[(size_t)m1 * 32 + dir * 16 + h]; rdt = ((const float*)(P.ws + WS_DT))[(size_t)m1 * 32 + dir * 16 + h]; }
            krow = PREP + 1024 + g * 128 + kx; kld = PREP_LD; vrow = PREP + h * 64 + vx; vld = PREP_LD; }
        if (MODE == 1) { const bf16_t* pr = PROJ + (size_t)m * PROJ_LD_CD;
            rq0 = *(const u32x4*)(pr + h * 128 + 16 * kq); rq1 = *(const u32x4*)(pr + h * 128 + 16 * kq + 8);
            rk0 = *(const u32x4*)(pr + 512 + h * 128 + 16 * kq); rk1 = *(const u32x4*)(pr + 512 + h * 128 + 16 * kq + 8);
            rg0 = *(const u32x4*)(pr + 3072 + dir * 16); rg1 = *(const u32x4*)(pr + 3072 + dir * 16 + 8);
            krow = PROJ + 512 + h * 128 + kx; kld = PROJ_LD_CD; vrow = PROJ + 1024 + h * 256 + vs * 64 + vx; vld = PROJ_LD_CD; }
        if (MODE == 2) { const bf16_t* pp = PREP + (size_t)m * PREP_LD;
            rq0 = *(const u32x4*)(pp + h * 128 + 16 * kq); rq1 = *(const u32x4*)(pp + h * 128 + 16 * kq + 8);
            rk0 = *(const u32x4*)(pp + 512 + h * 128 + 16 * kq); rk1 = *(const u32x4*)(pp + 512 + h * 128 + 16 * kq + 8);
            if (tid < 64) { const bf16_t* p1 = PROJ + (size_t)m1 * PROJ_LD_CD + IN_GLA + 3072; rig = bf2f(p1[dir * 4 + h]); rla = bf2f(p1[8 + dir * 4 + h]); }
            krow = PREP + 512 + h * 128 + kx; kld = PREP_LD; vrow = PROJ + IN_GLA + 1024 + h * 256 + vs * 64 + vx; vld = PROJ_LD_CD; }
#pragma unroll
        for (int jj = 0; jj < 16; ++jj) rkt[jj] = krow[(size_t)tok(c, 16 * tgk + jj) * kld];
#pragma unroll
        for (int jj = 0; jj < 8; ++jj) rvt[jj] = vrow[(size_t)tok(c, 8 * tgv + jj) * vld];
    };
    load_raw(0);
    __syncthreads();
    const int ycol0 = (MODE == 0 ? h * 64 : (MODE == 1 ? h * 256 + vs * 64 : 1024 + h * 256 + vs * 64));
    for (int c = 0; c < nch; ++c) {
        if (MODE == 1) {
            float gd[16]; unpack8(rg0, gd); unpack8(rg1, gd + 8);
#pragma unroll
            for (int q4 = 0; q4 < 4; ++q4) { f32x4 gp = *(LAS f32x4*)(GW + 2048 + 16 * kq + 4 * q4);
#pragma unroll
                for (int r = 0; r < 16; ++r) gp = gp + *(LAS f32x4*)(GW + r * 128 + 16 * kq + 4 * q4) * gd[r];
                f32x4 la;
#pragma unroll
                for (int e = 0; e < 4; ++e) la[e] = logsigmoidf_(gp[e]) * 0.0625f;
                *(LAS f32x4*)(LA + si * 128 + 16 * kq + 4 * q4) = la; }
        } else if (tid < 64) {
            float ig = 0.f, la = rla;
            if (MODE == 2) { ig = rig + P.in[I_MIB][(j * 2 + dir) * 4 + h]; la = logsigmoidf_(rla + P.in[I_MFB][(j * 2 + dir) * 4 + h]); }
            float x = la;
#pragma unroll
            for (int o = 1; o < 64; o <<= 1) { const float y = __shfl_up(x, o); if (lane >= o) x += y; }
            const float bl = __shfl(x, 63);
            const float kgn = MODE == 2 ? 0.08838834764831845f * __expf(ig) : 1.f;
            BV[tid] = x; IG[tid] = kgn; FV[tid] = kgn * __expf(bl - x); DTV[tid] = MODE == 0 ? rdt : 1.f;
            if (MODE == 2) { float ml = bl - x + ig;
#pragma unroll
                for (int o = 1; o < 64; o <<= 1) ml = fmaxf(ml, __shfl_xor(ml, o));
                if (tid == 0) MS[0] = fmaxf(bl + MS[0], ml); }
        }
        __syncthreads();
        if (MODE == 1) {
            const int k = tid & 127, qd = tid >> 7; float run = 0.f;
#pragma unroll
            for (int jj = 0; jj < 16; ++jj) { run += LA[(16 * qd + jj) * 128 + k]; LA[(16 * qd + jj) * 128 + k] = run; }
            TOT[qd * 128 + k] = run;
            __syncthreads();
            if (tid < 128) TOT[4 * 128 + tid] = __expf(TOT[tid] + TOT[128 + tid] + TOT[256 + tid] + TOT[384 + tid]);
        }
        {
            float q[16], k[16]; unpack8(rq0, q); unpack8(rq1, q + 8); unpack8(rk0, k); unpack8(rk1, k + 8);
            float qs[16], ks[16];
            if (MODE == 1) { const int qd = si >> 4;
#pragma unroll
                for (int e4 = 0; e4 < 4; ++e4) { const int kk = 16 * kq + 4 * e4; const f32x4 bb = *(LAS f32x4*)(LA + si * 128 + kk), t0 = *(LAS f32x4*)(TOT + kk), t1 = *(LAS f32x4*)(TOT + 128 + kk), t2 = *(LAS f32x4*)(TOT + 256 + kk);
#pragma unroll
                    for (int e = 0; e < 4; ++e) { const float b = bb[e] + (qd > 0 ? t0[e] : 0.f) + (qd > 1 ? t1[e] : 0.f) + (qd > 2 ? t2[e] : 0.f);
                        qs[4 * e4 + e] = q[4 * e4 + e] * 0.08838834764831845f * __expf(b); ks[4 * e4 + e] = k[4 * e4 + e] * __expf(fminf(-b, 80.f)); } }
            } else { const float kgn = IG[si];
#pragma unroll
                for (int e = 0; e < 16; ++e) { qs[e] = q[e]; ks[e] = k[e] * kgn; } }
            *(LAS u32x4*)(Qs + si * CS_QLD + 16 * kq) = pack8(qs); *(LAS u32x4*)(Qs + si * CS_QLD + 16 * kq + 8) = pack8(qs + 8);
            *(LAS u32x4*)(Ks + si * CS_QLD + 16 * kq) = pack8(ks); *(LAS u32x4*)(Ks + si * CS_QLD + 16 * kq + 8) = pack8(ks + 8);
        }
        {
            float kt[16];
            if (MODE == 1) { float off = 0.f; const float t0 = TOT[kx], t1 = TOT[128 + kx], t2 = TOT[256 + kx], t3 = TOT[384 + kx];
                off = (tgk > 0 ? t0 : 0.f) + (tgk > 1 ? t1 : 0.f) + (tgk > 2 ? t2 : 0.f); const float bl = (t0 + t1) + (t2 + t3);
#pragma unroll
                for (int jj = 0; jj < 16; ++jj) kt[jj] = bf2f(rkt[jj]) * __expf(bl - (LA[(16 * tgk + jj) * 128 + kx] + off));
            } else {
#pragma unroll
                for (int jj = 0; jj < 16; ++jj) kt[jj] = bf2f(rkt[jj]) * FV[16 * tgk + jj]; }
            *(LAS u32x4*)(Kt + kx * CS_SLD + 16 * tgk) = pack8(kt); *(LAS u32x4*)(Kt + kx * CS_SLD + 16 * tgk + 8) = pack8(kt + 8);
            float vt8[8];
#pragma unroll
            for (int jj = 0; jj < 8; ++jj) vt8[jj] = bf2f(rvt[jj]) * (MODE == 0 ? DTV[8 * tgv + jj] : 1.f);
            *(LAS u32x4*)(Vt + vx * CS_SLD + 8 * tgv) = pack8(vt8);
        }
        __syncthreads();
        if (c + 1 < nch) load_raw(c + 1);
        const int tt = w >> 1;
#pragma unroll
        for (int sj = 0; sj < 2; ++sj) { const int st = 2 * (w & 1) + sj; u32x2 wv; wv.x = 0u; wv.y = 0u;
            if (st <= tt) { f32x4 acc = (f32x4){0.f, 0.f, 0.f, 0.f};
#pragma unroll
                for (int kk = 0; kk < 4; ++kk) acc = __builtin_amdgcn_mfma_f32_16x16x32_bf16(lds_frag(Ks + (16 * st + fr) * CS_QLD + 32 * kk + 8 * fq), lds_frag(Qs + (16 * tt + fr) * CS_QLD + 32 * kk + 8 * fq), acc, 0, 0, 0);
                const int tg = 16 * tt + fr, sg = 16 * st + 4 * fq;
                if (MODE != 1) { const float bt = BV[tg]; const f32x4 bs = *(LAS f32x4*)(BV + sg);
#pragma unroll
                    for (int e = 0; e < 4; ++e) acc[e] *= __expf(fminf(bt - bs[e], 0.f)); }
#pragma unroll
                for (int e = 0; e < 4; ++e) acc[e] = (sg + e <= tg) ? acc[e] : 0.f;
                wv.x = pk2(acc[0], acc[1]); wv.y = pk2(acc[2], acc[3]); }
            *(LAS u32x2*)(Ps + (16 * tt + fr) * CS_SLD + 16 * st + 4 * fq) = wv; }
        __syncthreads();
        {
            const int tg = 16 * tt + fr; const int stp = c * 64 + tg; const int m = base + (dir ? (T - 1 - stp) : stp);
            const float ebt = MODE == 1 ? 1.f : __expf(BV[tg]);
            bf16x8 pf[2], qf[4];
#pragma unroll
            for (int ks2 = 0; ks2 < 2; ++ks2) pf[ks2] = lds_frag(Ps + tg * CS_SLD + 32 * ks2 + 8 * fq);
#pragma unroll
            for (int kk = 0; kk < 4; ++kk) qf[kk] = lds_frag(Qs + tg * CS_QLD + 32 * kk + 8 * fq);
            float rden = 1.f;
            if (MODE == 2) { f32x4 ai = (f32x4){0.f, 0.f, 0.f, 0.f}, ao = (f32x4){0.f, 0.f, 0.f, 0.f};
#pragma unroll
                for (int ks2 = 0; ks2 < 2; ++ks2) ai = __builtin_amdgcn_mfma_f32_16x16x32_bf16(lds_frag(Vt + (64 + fr) * CS_SLD + 32 * ks2 + 8 * fq), pf[ks2], ai, 0, 0, 0);
#pragma unroll
                for (int kk = 0; kk < 4; ++kk) ao = __builtin_amdgcn_mfma_f32_16x16x32_bf16(lds_frag(St + (64 + fr) * CS_QLD + 32 * kk + 8 * fq), qf[kk], ao, 0, 0, 0);
                const float den = __shfl(ai[0] + ao[0] * ebt, fr); rden = 1.f / fmaxf(fabsf(den), 1.f); }
#pragma unroll
            for (int vj = 0; vj < 2; ++vj) { const int vt = 2 * (w & 1) + vj; f32x4 ai = (f32x4){0.f, 0.f, 0.f, 0.f}, ao = (f32x4){0.f, 0.f, 0.f, 0.f};
#pragma unroll
                for (int ks2 = 0; ks2 < 2; ++ks2) ai = __builtin_amdgcn_mfma_f32_16x16x32_bf16(lds_frag(Vt + (16 * vt + fr) * CS_SLD + 32 * ks2 + 8 * fq), pf[ks2], ai, 0, 0, 0);
#pragma unroll
                for (int kk = 0; kk < 4; ++kk) ao = __builtin_amdgcn_mfma_f32_16x16x32_bf16(lds_frag(St + (16 * vt + fr) * CS_QLD + 32 * kk + 8 * fq), qf[kk], ao, 0, 0, 0);
                u32x2 wv; wv.x = pk2((ai[0] + ao[0] * ebt) * rden, (ai[1] + ao[1] * ebt) * rden); wv.y = pk2((ai[2] + ao[2] * ebt) * rden, (ai[3] + ao[3] * ebt) * rden);
                *(u32x2*)(Y + (size_t)m * YLD + ycol0 + 16 * vt + 4 * fq) = wv; }
        }
        {
            f32x4 dec; if (MODE == 1) dec = *(LAS f32x4*)(TOT + 4 * 128 + 16 * w + 4 * fq); else { const float d = __expf(BV[63]); dec = (f32x4){d, d, d, d}; }
            bf16x8 kf[2];
#pragma unroll
            for (int ks2 = 0; ks2 < 2; ++ks2) kf[ks2] = lds_frag(Kt + (16 * w + fr) * CS_SLD + 32 * ks2 + 8 * fq);
#pragma unroll
            for (int vt = 0; vt < NVT; ++vt) { Sacc[vt] = Sacc[vt] * dec;
#pragma unroll
                for (int ks2 = 0; ks2 < 2; ++ks2) Sacc[vt] = __builtin_amdgcn_mfma_f32_16x16x32_bf16(kf[ks2], lds_frag(Vt + (16 * vt + fr) * CS_SLD + 32 * ks2 + 8 * fq), Sacc[vt], 0, 0, 0); }
        }
        __syncthreads();
#pragma unroll
        for (int vt = 0; vt < NVT; ++vt) { u32x2 wv; wv.x = pk2(Sacc[vt][0], Sacc[vt][1]); wv.y = pk2(Sacc[vt][2], Sacc[vt][3]); *(LAS u32x2*)(St + (16 * vt + fr) * CS_QLD + 16 * w + 4 * fq) = wv; }
    }
    if (s < 16) {
        float* o; int kstride; float sc = 1.f;
        if (MODE == 0) { o = P.out + O_SSD + ((size_t)((s * 2 + j) * 2 + dir) * 16 + h) * 8192; kstride = 64; }
        else { o = P.out + (MODE == 1 ? O_GLA : O_MC) + ((size_t)((s * 2 + j) * 2 + dir) * 4 + h) * 32768 + vs * 64; kstride = 256; }
        if (MODE == 2) { __syncthreads(); sc = __expf(-MS[0]); }
#pragma unroll
        for (int vt = 0; vt < 4; ++vt)
#pragma unroll
            for (int e = 0; e < 4; ++e) o[(size_t)(16 * w + 4 * fq + e) * kstride + 16 * vt + fr] = Sacc[vt][e] * sc;
        if (MODE == 2 && vs == 0) {
            if (fr == 0) {
#pragma unroll
                for (int e = 0; e < 4; ++e) P.out[O_MN + ((size_t)((s * 2 + j) * 2 + dir) * 4 + h) * 128 + 16 * w + 4 * fq + e] = Sacc[NVT - 1][e] * sc; }
            if (tid == 0) P.out[O_MM + ((s * 2 + j) * 2 + dir) * 4 + h] = MS[0]; }
    }
}

struct RwOps { f32x4 kk0, kk1, w0, w1, kd0, kd1, ka0, ka1, r0, r1; f32x2 vv; };
__device__ __forceinline__ RwOps rw_ops(const LAS float* B, int tt, int kg, int vg) {
    const LAS float* p = B + tt * 64 + 4 * kg; RwOps o;
    o.kk0 = *(const LAS f32x4*)(p + 4096); o.kk1 = *(const LAS f32x4*)(p + 4096 + 32); o.w0 = *(const LAS f32x4*)(p + 1024); o.w1 = *(const LAS f32x4*)(p + 1024 + 32);
    o.kd0 = *(const LAS f32x4*)(p + 2048); o.kd1 = *(const LAS f32x4*)(p + 2048 + 32); o.ka0 = *(const LAS f32x4*)(p + 5120); o.ka1 = *(const LAS f32x4*)(p + 5120 + 32);
    o.r0 = *(const LAS f32x4*)(p); o.r1 = *(const LAS f32x4*)(p + 32); o.vv = *(const LAS f32x2*)(B + 3072 + tt * 64 + 2 * vg); return o;
}
__device__ __forceinline__ void rwkv_pair(const Params& P, const Ctx& C, int j, int bq, bool lng) {
    const int niter = lng ? 64 : 32; const bool act = !lng || C.tid < 256;
    const int tid = C.tid, half = tid >> 8, tl = tid & 255, kg = tl & 7, vg = tl >> 3;
    const bf16_t* PREP = (const bf16_t*)(P.ws + WS_PREP); const bf16_t* LOUT = (const bf16_t*)(P.ws + WS_PROJ);
    constexpr int BUFSZ = 6 * 1024;
    LAS float* L0 = (LAS float*)C.lds + half * 2 * BUFSZ;
    const int stt = tl >> 4, sc4 = (tl & 15) * 4;
    auto unit_of = [&](int cc, int& s, int& dir, int& h, int& lc) {
        if (lng) { s = 16 + (bq >> 5); dir = (bq >> 4) & 1; h = bq & 15; lc = cc; }
        else { const int q = 4 * bq + 2 * half + (cc >> 4); s = q >> 5; dir = (q >> 4) & 1; h = q & 15; lc = cc & 15; } };
    f32x2 S2[8];
    auto init_state = [&](int s, int dir, int h) {
        const float* s0 = s >= 16 ? P.in[I_SRWKV] + (((size_t)(((s - 16) * 2 + j) * 2 + dir) * 16 + h) * 64 + 2 * vg) * 64 : nullptr;
#pragma unroll
        for (int hh = 0; hh < 2; ++hh) { const f32x4 u0 = s0 ? *(const f32x4*)(s0 + 32 * hh + 4 * kg) : (f32x4){0.f, 0.f, 0.f, 0.f}, u1 = s0 ? *(const f32x4*)(s0 + 64 + 32 * hh + 4 * kg) : (f32x4){0.f, 0.f, 0.f, 0.f};
#pragma unroll
            for (int e = 0; e < 4; ++e) S2[hh * 4 + e] = (f32x2){u0[e], u1[e]}; } };
    u32x2 rr, rk, rv, rkk, rwl, ral; f32x4 cw0, ca0, cka;
    auto load_raw = [&](int cc) {
        int s, dir, h, lc; unit_of(cc, s, dir, h, lc);
        const int T = s < 16 ? 256 : 1024, base = s < 16 ? s * 256 : 4096 + (s - 16) * 1024;
        const int step = lc * 16 + stt; const int m = base + (dir ? (T - 1 - step) : step);
        const bf16_t* pp = PREP + (size_t)m * PREP_LD + h * 64 + sc4; const bf16_t* lo = LOUT + (size_t)m * LOUT_LD + dir * 1024 + h * 64 + sc4;
        rr = *(const u32x2*)(pp + 3072); rk = *(const u32x2*)(pp + 4096); rv = *(const u32x2*)(pp + 5120); rkk = *(const u32x2*)(pp + 6144);
        rwl = *(const u32x2*)lo; ral = *(const u32x2*)(lo + 2048);
        cw0 = *(const f32x4*)(P.in[I_W0] + (j * 2 + dir) * 1024 + h * 64 + sc4); ca0 = *(const f32x4*)(P.in[I_A0] + (j * 2 + dir) * 1024 + h * 64 + sc4); cka = *(const f32x4*)(P.in[I_KA] + j * 1024 + h * 64 + sc4);
    };
    auto write_lds = [&](LAS float* B) {
        const f32x4 r = unpack4(rr), k = unpack4(rk), v = unpack4(rv), kk = unpack4(rkk), wl = unpack4(rwl), al = unpack4(ral);
        f32x4 w, kd, kka;
#pragma unroll
        for (int e = 0; e < 4; ++e) { const float wp = cw0[e] + wl[e]; const float lw = -__expf(-softplusf_(-wp) - 0.5f); w[e] = __expf(lw);
            const float a = sigmoidf_(ca0[e] + al[e]); kd[e] = k[e] * (1.f + (a - 1.f) * cka[e]); kka[e] = kk[e] * a; }
        LAS float* p = B + stt * 64 + sc4;
        *(LAS f32x4*)(p) = r; *(LAS f32x4*)(p + 1024) = w; *(LAS f32x4*)(p + 2048) = kd; *(LAS f32x4*)(p + 3072) = v; *(LAS f32x4*)(p + 4096) = kk; *(LAS f32x4*)(p + 5120) = kka;
    };
    __syncthreads();
    if (act) { load_raw(0); write_lds(L0);
    { int s, dir, h, lc; unit_of(0, s, dir, h, lc); init_state(s, dir, h); } }
    __syncthreads();
#pragma unroll 1
    for (int cc = 0; cc < niter; ++cc) {
        if (act) {
        LAS float* B = L0 + (cc & 1) * BUFSZ;
        int s, dir, h, lc; unit_of(cc, s, dir, h, lc);
        const int T = s < 16 ? 256 : 1024, base = s < 16 ? s * 256 : 4096 + (s - 16) * 1024;
        if (cc + 1 < niter) load_raw(cc + 1);
        bf16_t* Y = (bf16_t*)(P.ws + WS_MP) + (size_t)dir * MTOK * YLD + 1024 + h * 64 + 2 * vg;
        RwOps cur = rw_ops(B, 0, kg, vg);
#pragma unroll 2
        for (int tt = 0; tt < 16; ++tt) {
            const RwOps nx = rw_ops(B, (tt + 1) & 15, kg, vg);
            const int step = lc * 16 + tt; const int m = base + (dir ? (T - 1 - step) : step);
            f32x2 da = (f32x2){0.f, 0.f}, db = (f32x2){0.f, 0.f};
#pragma unroll
            for (int e = 0; e < 4; ++e) { da = da + S2[e] * (f32x2){cur.kk0[e], cur.kk0[e]}; db = db + S2[4 + e] * (f32x2){cur.kk1[e], cur.kk1[e]}; }
            const f32x2 d2 = da + db;
            f32x2 sk2; sk2.x = row_sum8(d2.x); sk2.y = row_sum8(d2.y);
            f32x2 ya = (f32x2){0.f, 0.f}, yb = (f32x2){0.f, 0.f};
#pragma unroll
            for (int e = 0; e < 4; ++e) {
                S2[e] = S2[e] * (f32x2){cur.w0[e], cur.w0[e]} - sk2 * (f32x2){cur.ka0[e], cur.ka0[e]} + cur.vv * (f32x2){cur.kd0[e], cur.kd0[e]};
                S2[4 + e] = S2[4 + e] * (f32x2){cur.w1[e], cur.w1[e]} - sk2 * (f32x2){cur.ka1[e], cur.ka1[e]} + cur.vv * (f32x2){cur.kd1[e], cur.kd1[e]};
                ya = ya + S2[e] * (f32x2){cur.r0[e], cur.r0[e]}; yb = yb + S2[4 + e] * (f32x2){cur.r1[e], cur.r1[e]}; }
            const f32x2 y2 = ya + yb;
            const float y0 = row_sum8(y2.x), y1 = row_sum8(y2.y);
            if (kg == 0) *(unsigned*)(Y + (size_t)m * YLD) = pg8::cvt_pk_bf16(y0, y1);
            cur = nx;
        }
        const int nchU = lng ? 64 : 16;
        if (lc == nchU - 1 && s < 16) { float* o = P.out + O_RWKV + (((size_t)((s * 2 + j) * 2 + dir) * 16 + h) * 64 + 2 * vg) * 64;
#pragma unroll
            for (int hh = 0; hh < 2; ++hh) { *(f32x4*)(o + 32 * hh + 4 * kg) = (f32x4){S2[hh * 4].x, S2[hh * 4 + 1].x, S2[hh * 4 + 2].x, S2[hh * 4 + 3].x};
                *(f32x4*)(o + 64 + 32 * hh + 4 * kg) = (f32x4){S2[hh * 4].y, S2[hh * 4 + 1].y, S2[hh * 4 + 2].y, S2[hh * 4 + 3].y}; } }
        if (cc + 1 < niter) { write_lds(L0 + ((cc + 1) & 1) * BUFSZ);
            if (lc == nchU - 1) { int s2, d2_, h2, lc2; unit_of(cc + 1, s2, d2_, h2, lc2); init_state(s2, d2_, h2); } }
        }
        __syncthreads();
    }
}

__device__ __forceinline__ void scan_unit(const Params& P, const Ctx& C, int l, int type, int q) {
    const int j = l >> 1; const bool ev = (l & 1) == 0;
    int s, idx;
    if (q < 128) { s = 16 + (q >> 5); idx = q & 31; } else { const int r = q - 128; s = r >> 5; idx = r & 31; }
    if (ev) { const int dir = idx >> 4, h = idx & 15; chunk_scan<0>(P, C, j, s, dir, h, 0); }
    else { const int dir = idx >> 4, h = (idx >> 2) & 3, vs = idx & 3; if (type == 0) chunk_scan<1>(P, C, j, s, dir, h, vs); else chunk_scan<2>(P, C, j, s, dir, h, vs); }
}
__device__ __forceinline__ void phase_scan(const Params& P, const Ctx& C0, int l) {
    const int G = C0.G, bid = C0.bid; const bool ev = (l & 1) == 0;
    if (ev) {
        if (G == 256) {
            rwkv_pair(P, fresh_ctx(C0.lds), l >> 1, bid < 128 ? bid : bid - 128, bid < 128);
#pragma unroll 1
            for (int it = 0; it < 4; ++it) { if (bid < 128 && it > 0) break; const int q = bid < 128 ? bid : 128 + (bid - 128) * 4 + it; scan_unit(P, fresh_ctx(C0.lds), l, 0, q); }
        } else {
#pragma unroll 1
            for (int x = bid; x < 256 + 640; x += G) { if (x < 256) rwkv_pair(P, fresh_ctx(C0.lds), l >> 1, x < 128 ? x : x - 128, x < 128); else scan_unit(P, fresh_ctx(C0.lds), l, 0, x - 256); }
        }
        return;
    }
#pragma unroll 1
    for (int it = 0; it < 1280; ++it) {
        int type, q;
        if (G == 256) { if (bid < 128) { if (it >= 2) break; type = 1 - it; q = bid; } else { if (it >= 8) break; type = 1 - (it >> 2); q = 128 + (bid - 128) * 4 + (it & 3); } }
        else { const int x = bid + it * G; if (x >= 1280) break; type = 1 - x / 640; q = x % 640; }
        scan_unit(P, fresh_ctx(C0.lds), l, type, q);
    }
}

__device__ __forceinline__ void ld16(const bf16_t* p, float* o) { unpack8(*(const u32x4*)p, o); unpack8(*(const u32x4*)(p + 8), o + 8); }
__device__ __forceinline__ void ld16f(const float* p, float* o) {
#pragma unroll
    for (int q = 0; q < 4; ++q) { const f32x4 v = *(const f32x4*)(p + 4 * q); o[4 * q] = v.x; o[4 * q + 1] = v.y; o[4 * q + 2] = v.z; o[4 * q + 3] = v.w; } }
__device__ __forceinline__ void st16(bf16_t* p, const float* o) { *(u32x4*)p = pack8(o); *(u32x4*)(p + 8) = pack8(o + 8); }
__device__ __forceinline__ void phase_post(const Params& P, const Ctx& C, int l) {
    const int j = l >> 1; const bool ev = (l & 1) == 0;
    const bf16_t* PROJ = (const bf16_t*)(P.ws + WS_PROJ); const bf16_t* PREP = (const bf16_t*)(P.ws + WS_PREP);
    const bf16_t* Y0 = (const bf16_t*)(P.ws + WS_MP); const bf16_t* Y1 = Y0 + (size_t)MTOK * YLD; bf16_t* MIX = (bf16_t*)(P.ws + WS_MIX);
    const int gw = C.bid * 8 + C.wave, NGW = C.G * 8, lane = C.lane, c0 = lane * 16;
    for (int m = gw; m < MTOK; m += NGW) {
        float ya[16], yb[16], t0[16], t1[16], o[16];
        if (ev) {
            const bf16_t* pp = PREP + (size_t)m * PREP_LD;
            ld16(Y0 + (size_t)m * YLD + c0, ya); ld16(Y1 + (size_t)m * YLD + c0, yb); ld16(pp + c0, t0); ld16(pp + 2048 + c0, t1);
            const float dsk = P.in[I_SSDD][j * 16 + (lane >> 2)]; float ss = 0.f;
#pragma unroll
            for (int e = 0; e < 16; ++e) { o[e] = (ya[e] + yb[e] + t0[e] * dsk) * t1[e]; ss += o[e] * o[e]; }
            const float rs = rsqrtf(wave_sum(ss) * (1.f / 1024.f) + 1e-6f);
            ld16f(P.in[I_SSDN] + j * 1024 + c0, t0);
#pragma unroll
            for (int e = 0; e < 16; ++e) o[e] = o[e] * rs * t0[e];
            st16(MIX + (size_t)m * 2048 + c0, o);
            ld16(Y0 + (size_t)m * YLD + 1024 + c0, ya); ld16(Y1 + (size_t)m * YLD + 1024 + c0, yb);
            float mu = 0.f;
#pragma unroll
            for (int e = 0; e < 16; ++e) { ya[e] += yb[e]; mu += ya[e]; }
            mu += __shfl_xor(mu, 1); mu += __shfl_xor(mu, 2); mu *= (1.f / 64.f);
            float var = 0.f;
#pragma unroll
            for (int e = 0; e < 16; ++e) { ya[e] -= mu; var += ya[e] * ya[e]; }
            var += __shfl_xor(var, 1); var += __shfl_xor(var, 2); var *= (1.f / 64.f);
            const float rstd = rsqrtf(var + 64e-5f);
            ld16f(P.in[I_LNW] + j * 1024 + c0, t0); ld16f(P.in[I_LNB] + j * 1024 + c0, t1);
#pragma unroll
            for (int e = 0; e < 16; ++e) o[e] = ya[e] * rstd * t0[e] + t1[e];
            ld16(pp + 3072 + c0, ya); ld16(pp + 4096 + c0, yb); ld16f(P.in[I_RK] + j * 1024 + c0, t0);
            float bs = 0.f;
#pragma unroll
            for (int e = 0; e < 16; ++e) bs += ya[e] * yb[e] * t0[e];
            bs += __shfl_xor(bs, 1); bs += __shfl_xor(bs, 2);
            ld16(pp + 5120 + c0, ya); ld16(PROJ + (size_t)m * LOUT_LD + 4096 + c0, yb);
#pragma unroll
            for (int e = 0; e < 16; ++e) o[e] = (o[e] + bs * ya[e]) * yb[e];
            st16(MIX + (size_t)m * 2048 + 1024 + c0, o);
        } else {
            const bf16_t* pr = PROJ + (size_t)m * PROJ_LD_CD;
#pragma unroll
            for (int g = 0; g < 2; ++g) {
                ld16(Y0 + (size_t)m * YLD + g * 1024 + c0, ya); ld16(Y1 + (size_t)m * YLD + g * 1024 + c0, yb);
                float ss = 0.f;
#pragma unroll
                for (int e = 0; e < 16; ++e) { ya[e] += yb[e]; ss += ya[e] * ya[e]; }
                ss += __shfl_xor(ss, 1); ss += __shfl_xor(ss, 2); ss += __shfl_xor(ss, 4); ss += __shfl_xor(ss, 8);
                const float rs = rsqrtf(ss * (1.f / 256.f) + 1e-6f);
                ld16f((g == 0 ? P.in[I_GLAN] : P.in[I_MLN]) + j * 1024 + c0, t0);
                ld16(pr + (g == 0 ? 2048 : IN_GLA + 2048) + c0, t1);
#pragma unroll
                for (int e = 0; e < 16; ++e) o[e] = ya[e] * rs * t0[e] * (g == 0 ? siluf_(t1[e]) : sigmoidf_(t1[e]));
                st16(MIX + (size_t)m * 2048 + g * 1024 + c0, o);
            }
        }
    }
}

__global__ void __launch_bounds__(512, 2) hybrid_fwd(Params P) {
    extern __shared__ __attribute__((aligned(16))) unsigned char lds_raw[];
    cg::grid_group grid = cg::this_grid();
    Ctx C; C.lds = (LAS unsigned char*)lds_raw; C.tid = threadIdx.x; C.lane = C.tid & 63; C.wave = __builtin_amdgcn_readfirstlane(C.tid >> 6); C.G = gridDim.x; C.bid = blockIdx.x;
    const float* MOD = (const float*)(P.ws + WS_MOD);
    const bf16_t* H = (const bf16_t*)(P.ws + WS_H);
    if (C.tid < 4) ((volatile LAS unsigned*)(C.lds + LDS_BYTES - 16))[C.tid] = 0u;
    __syncthreads();
    const XcdBarrier xb = xcd_barrier_post((unsigned*)(P.ws + WS_CTL), (volatile LAS unsigned*)(C.lds + LDS_BYTES - 16));
    REP(1) if (PH & 1) phase_mod(P, fresh_ctx(C.lds));
    REP(2) if (PH & 2) phase_convert(P, fresh_ctx(C.lds), 0);
    grid.sync();
    if (PH & 4) phase_rows(P, fresh_ctx(C.lds), 0, nullptr, nullptr, true, P.in[I_NORMG] + 0, MOD + 0);
    GSYNC();
#pragma unroll 1
    for (int l = 0; l < 4; ++l) {
        const bool ev = (l & 1) == 0; const float* modl = MOD + (size_t)l * 5 * 6144; const float* ng = P.in[I_NORMG] + l * 4 * 1024;
        REP(8) if (PH & 8) { pg8::Gemm g{H, (const bf16_t*)(P.ws + WS_WIN), 1024, 1024, 1024}; pg8::Sched<0> S; S.init(MTOK, ev ? N_AB_P : N_CD_P, 1, 1024, C.G, C.bid);
          pg8::EpiBf16<0> E{(bf16_t*)(P.ws + WS_PROJ), ev ? PROJ_LD_AB : PROJ_LD_CD, 0}; pg8::gemm_phase(C.lds, g, S, E); }
        GSYNC();
        REP(16) if (PH & 16) { if (ev) phase_prep_even(P, fresh_ctx(C.lds), l >> 1); else phase_prep_odd(P, fresh_ctx(C.lds), l >> 1); }
        GSYNC();
        if (ev && (PH & 32)) {
            REP(32) {
            pg8::Gemm g{(const bf16_t*)(P.ws + WS_LORAA), (const bf16_t*)(P.ws + WS_WLORA), LORA_K, 128, 128}; pg8::Sched<1> S; S.init(MTOK, LOUT_LD, 1, 128, C.G, C.bid);
            pg8::EpiBf16<0> E{(bf16_t*)(P.ws + WS_PROJ), LOUT_LD, 0}; pg8::gemm_phase(C.lds, g, S, E); }
            GSYNC();
        }
        for (int rep_ = 0; rep_ < (((DUP & 64) && ev) || ((DUP & 0x4000) && !ev) ? 2 : 1); ++rep_) if (PH & 64) phase_scan(P, fresh_ctx(C.lds), l);
        GSYNC();
        REP(128) if (PH & 128) phase_post(P, fresh_ctx(C.lds), l);
        GSYNC();
        REP(256) if (PH & 256) { pg8::Gemm g{(const bf16_t*)(P.ws + WS_MIX), (const bf16_t*)(P.ws + WS_WOUT), 2048, 2048, 1024}; pg8::Sched<0> S; S.init(MTOK, 1024, 2, 1024, C.G, C.bid);
          pg8::EpiBf16<0> E{(bf16_t*)(P.ws + WS_MP), 1024, (size_t)MTOK * 1024}; pg8::gemm_phase(C.lds, g, S, E); }
        GSYNC();
        if (DUP & 512) phase_rows(P, fresh_ctx(C.lds), 1, ng + 1024, modl + 2048, true, ng + 2048, modl + 3072, true);
        if (PH & 512) phase_rows(P, fresh_ctx(C.lds), 1, ng + 1024, modl + 2048, true, ng + 2048, modl + 3072);
        GSYNC();
        REP(1024) if (PH & 1024) { pg8::Gemm g{H, (const bf16_t*)(P.ws + WS_WUP), 1024, 1024, 1024}; pg8::Sched<0> S; S.init(MTOK, 4096, 1, 1024, C.G, C.bid);
          pg8::EpiBf16<2> E{(bf16_t*)(P.ws + WS_PROJ), 4096, 0}; pg8::gemm_phase(C.lds, g, S, E); }
        GSYNC();
        REP(2048) if (PH & 2048) { pg8::Gemm g{(const bf16_t*)(P.ws + WS_PROJ), (const bf16_t*)(P.ws + WS_WDN), 4096, 4096, 2048}; pg8::Sched<0> S; S.init(MTOK, 1024, 2, 2048, C.G, C.bid);
          pg8::EpiBf16<0> E{(bf16_t*)(P.ws + WS_MP), 1024, (size_t)MTOK * 1024}; pg8::gemm_phase(C.lds, g, S, E); }
        GSYNC();
        if (DUP & 4096) phase_rows(P, fresh_ctx(C.lds), 1, ng + 3072, modl + 5120, true, ng + 2048, modl + 3072, true);
        if (PH & 4096) { if (l < 3) { phase_rows(P, fresh_ctx(C.lds), 1, ng + 3072, modl + 5120, true, ng + 4096, modl + 5 * 6144); phase_convert(P, fresh_ctx(C.lds), l + 1); }
        else phase_rows(P, fresh_ctx(C.lds), 1, ng + 3072, modl + 5120, false, nullptr, nullptr); }
        if (l < 3) GSYNC();
    }
}

extern "C" void kernel_launch(void* const* d_in, const int* in_sizes, int n_in, void* d_out, int out_size, void* d_ws, size_t ws_size, hipStream_t stream) {
    static int grid = 0;
    if (grid == 0) {
        if (n_in != 44 || ws_size < WS_END) { fprintf(stderr, "kernel_launch: unexpected n_in %d / ws %zu\n", n_in, ws_size); grid = -1; return; }
        int dev = 0, cus = 0, per_cu = 0;
        hipGetDevice(&dev); hipDeviceGetAttribute(&cus, hipDeviceAttributeMultiprocessorCount, dev);
        if (hipFuncSetAttribute((const void*)hybrid_fwd, hipFuncAttributeMaxDynamicSharedMemorySize, LDS_BYTES) != hipSuccess) { fprintf(stderr, "hipFuncSetAttribute failed\n"); grid = -1; return; }
        hipOccupancyMaxActiveBlocksPerMultiprocessor(&per_cu, (const void*)hybrid_fwd, 512, LDS_BYTES);
        (void)hipGetLastError();
        if (per_cu < 1) per_cu = 1;
        grid = cus * 1;
    }
    if (grid < 0) return;
    if (hipMemsetAsync((char*)d_ws + WS_CTL, 0, CTL_BYTES, stream) != hipSuccess) { fprintf(stderr, "memset failed\n"); return; }
    Params p{};
    for (int i = 0; i < 44; ++i) p.in[i] = (const float*)d_in[i];
    p.out = (float*)d_out; p.ws = (unsigned char*)d_ws;
    void* args[] = {&p};
    hipError_t e = hipLaunchCooperativeKernel((const void*)hybrid_fwd, dim3(grid), dim3(512), args, LDS_BYTES, stream);
    if (e != hipSuccess) fprintf(stderr, "cooperative launch failed: %s (grid %d)\n", hipGetErrorString(e), grid);
}
```

```cpp
#include <hip/hip_runtime.h>
#include <hip/hip_cooperative_groups.h>
#include <cstdio>
#include <cstdint>
namespace cg = cooperative_groups;

#define LAS __attribute__((address_space(3)))
typedef unsigned short bf16_t;
typedef short bf16x8 __attribute__((ext_vector_type(8)));
typedef float f32x4 __attribute__((ext_vector_type(4)));
typedef float f32x2 __attribute__((ext_vector_type(2)));
typedef unsigned u32x4 __attribute__((ext_vector_type(4)));
typedef unsigned u32x2 __attribute__((ext_vector_type(2)));

constexpr int MTOK = 8192, DM = 1024, DFF = 4096;
constexpr int N_AB = 6560, N_AB_P = 6656, N_CD = 6192, N_CD_P = 6400;
constexpr int PROJ_LD_AB = N_AB_P, PROJ_LD_CD = N_CD_P;
constexpr int PREP_LD = 7168, LOUT_LD = 5120, LORA_K = 384, YLD = 2048;
constexpr int IN_SSD = 3104, IN_GLA = 3104;
constexpr size_t MiB = 1u << 20;
constexpr size_t WS_MOD = 0, WS_CTL = 512 * 1024, CTL_BYTES = 16384, WS_DT = 1 * MiB, WS_DA = 3 * MiB, WS_WIN = 5 * MiB, WS_WOUT = 19 * MiB, WS_WUP = 23 * MiB, WS_WDN = 31 * MiB,
                 WS_WLORA = 39 * MiB, WS_H = 41 * MiB, WS_PROJ = 57 * MiB, WS_PREP = 161 * MiB, WS_MIX = 273 * MiB, WS_MP = 305 * MiB,
                 WS_LORAA = 369 * MiB, WS_END = 375 * MiB;
constexpr size_t O_X = 0, O_SSD = 8388608, O_RWKV = 16777216, O_GLA = 20971520, O_MC = 29360128, O_MN = 37748736, O_MM = 37781504;

struct Params { const float* in[44]; float* out; unsigned char* ws; };
enum { I_XP = 0, I_XS, I_SSSD, I_SRWKV, I_SGLA, I_SMC, I_SMN, I_SMM, I_C, I_CCTX, I_WMOD, I_BMOD, I_NORMG, I_WUP, I_WDN, I_WINAB, I_SCONVW, I_SCONVB,
       I_DTB, I_ALOG, I_SSDD, I_SSDN, I_MU, I_W0, I_W2, I_A0, I_A2, I_G2, I_KK, I_KA, I_RK, I_LNW, I_LNB, I_WOUTAB, I_WINCD, I_GGW, I_GGB, I_GLAN,
       I_MCONVW, I_MCONVB, I_MIB, I_MFB, I_MLN, I_WOUTCD };

__device__ __forceinline__ float bf2f(unsigned b) { return __uint_as_float(b << 16); }
__device__ __forceinline__ unsigned f2bf(float f) { unsigned u = __float_as_uint(f); return (u + 0x7fffu + ((u >> 16) & 1u)) >> 16; }
typedef __bf16 bf16x2_hw __attribute__((ext_vector_type(2)));
__device__ __forceinline__ unsigned pk2(float lo, float hi) { const f32x2 v = {lo, hi}; const bf16x2_hw b = __builtin_convertvector(v, bf16x2_hw); return __builtin_bit_cast(unsigned, b); }
__device__ __forceinline__ float lo16(unsigned w) { return __uint_as_float(w << 16); }
__device__ __forceinline__ float hi16(unsigned w) { return __uint_as_float(w & 0xffff0000u); }
__device__ __forceinline__ void unpack8(u32x4 w, float* o) { o[0] = lo16(w.x); o[1] = hi16(w.x); o[2] = lo16(w.y); o[3] = hi16(w.y); o[4] = lo16(w.z); o[5] = hi16(w.z); o[6] = lo16(w.w); o[7] = hi16(w.w); }
__device__ __forceinline__ f32x4 unpack4(u32x2 w) { return (f32x4){lo16(w.x), hi16(w.x), lo16(w.y), hi16(w.y)}; }
__device__ __forceinline__ u32x4 pack8(const float* o) { u32x4 w; w.x = pk2(o[0], o[1]); w.y = pk2(o[2], o[3]); w.z = pk2(o[4], o[5]); w.w = pk2(o[6], o[7]); return w; }
__device__ __forceinline__ float sigmoidf_(float x) { return 1.f / (1.f + __expf(-x)); }
__device__ __forceinline__ float siluf_(float x) { return x / (1.f + __expf(-x)); }
__device__ __forceinline__ float softplusf_(float x) { return fmaxf(x, 0.f) + __logf(1.f + __expf(-fabsf(x))); }
__device__ __forceinline__ float logsigmoidf_(float x) { return fminf(x, 0.f) - __logf(1.f + __expf(-fabsf(x))); }
__device__ __forceinline__ float tanhf_(float x) { const float e = __expf(-2.f * fabsf(x)); const float r = (1.f - e) / (1.f + e); return x < 0.f ? -r : r; }
__device__ __forceinline__ float wave_sum(float v) {
#pragma unroll
    for (int o = 1; o < 64; o <<= 1) v += __shfl_xor(v, o);
    return v;
}
__device__ __forceinline__ float quad_sum(float x) {
    x += __int_as_float(__builtin_amdgcn_update_dpp(0, __float_as_int(x), 0xB1, 0xF, 0xF, true));
    x += __int_as_float(__builtin_amdgcn_update_dpp(0, __float_as_int(x), 0x4E, 0xF, 0xF, true));
    return x;
}

#define DPP_ADD(x, ctrl) ((x) + __int_as_float(__builtin_amdgcn_update_dpp(0, __float_as_int(x), (ctrl), 0xF, 0xF, true)))
__device__ __forceinline__ float row_sum8(float x) { x = DPP_ADD(x, 0xB1); x = DPP_ADD(x, 0x4E); x = DPP_ADD(x, 0x141); return x; }
__device__ __forceinline__ float row_sum16(float x) { x = row_sum8(x); x = DPP_ADD(x, 0x140); return x; }
namespace pg8 {
constexpr int BM = 256, BK = 64, HALF = 128, HTB = HALF * BK * 2, STAGE_BYTES = 8 * HTB, NXCD = 8, WGM = 8;
__host__ __device__ __forceinline__ int lds_byte(int r, int c) { const int st = (r >> 4) * 2 + (c >> 5), rr = r & 15, cc = c & 31, ob = rr * 64 + cc * 2; return st * 1024 + (ob ^ (((ob >> 9) & 1) << 5)); }
__host__ __device__ __forceinline__ void stage_rc(int b, int& R, int& C) { const int st = b / 1024, sb = b % 1024, swz = sb ^ (((sb >> 9) & 1) << 5); R = (st >> 1) * 16 + swz / 64; C = (st & 1) * 32 + (swz % 64) / 2; }
__host__ __device__ __forceinline__ int perm32(int rho) { const int n = rho >> 4, i = rho & 15; return 8 * (i >> 2) + 4 * n + (i & 3); }

struct Unit { int pm, pn, ks; };
struct Gemm { const bf16_t* A; const bf16_t* Bt; int lda, ldb, K; };
template <int mode> struct Sched {
    int nM, nN, nNv, nwg, G, c, K;
    __device__ void init(int M, int N, int nK, int K_, int G_, int c_) { nM = M / BM; nN = N / BM; nNv = nN * nK; nwg = nM * nNv; G = G_; c = c_; K = K_; }
    __device__ bool next(int i, Unit& u) const {
        const long L = (long)i * G + c; if (L >= nwg) return false;
        int wgid = (int)L; { const int q = nwg / NXCD, r = nwg % NXCD, xcd = wgid % NXCD, off = wgid / NXCD; wgid = (xcd < r ? xcd * (q + 1) : r * (q + 1) + (xcd - r) * q) + off; }
        const int nig = WGM * nNv, gid = wgid / nig, fm = gid * WGM, gsz = (nM - fm) < WGM ? (nM - fm) : WGM;
        u.pm = fm + ((wgid % nig) % gsz); const int pnv = (wgid % nig) / gsz; u.pn = pnv % nN; u.ks = pnv / nN; return true;
    }
    __device__ __forceinline__ size_t aoff(const Unit& u) const { if (mode == 1) { const int g = u.pn >> 2; return (size_t)(g < 2 ? 0 : (g < 4 ? 128 : 256)) * 2; } return (size_t)u.ks * K * 2; }
    __device__ __forceinline__ size_t boff(const Unit& u) const { return mode == 1 ? 0 : (size_t)u.ks * K * 2; }
};

__device__ __forceinline__ unsigned cvt_pk_bf16(float lo, float hi) { unsigned r; asm volatile("v_cvt_pk_bf16_f32 %0, %1, %2" : "=v"(r) : "v"(lo), "v"(hi)); return r; }

template <int ACT> struct EpiBf16 {
    static constexpr bool PERM = true;
    bf16_t* O; int ldc; size_t pstride;
    __device__ __forceinline__ void operator()(const f32x4 (&acc)[2][2][4][2], const Unit& u, int wr, int wc, int fr, int fq) const {
        const int row0 = u.pm * BM + wr * 64 + fr; const int col0 = u.pn * BM + wc * 32 + 8 * fq; bf16_t* Ob = O + (size_t)u.ks * pstride;
#pragma unroll
        for (int ai = 0; ai < 2; ++ai)
#pragma unroll
            for (int m = 0; m < 4; ++m) { bf16_t* rowp = Ob + (size_t)(row0 + ai * HALF + m * 16) * ldc + col0;
#pragma unroll
                for (int bj = 0; bj < 2; ++bj) { f32x4 v0 = acc[ai][bj][m][0], v1 = acc[ai][bj][m][1];
                    if (ACT == 2) {
#pragma unroll
                        for (int e = 0; e < 4; ++e) { const float a = fmaxf(v0[e], 0.f), b = fmaxf(v1[e], 0.f); v0[e] = a * a; v1[e] = b * b; } }
                    u32x4 w; w.x = cvt_pk_bf16(v0[0], v0[1]); w.y = cvt_pk_bf16(v0[2], v0[3]); w.z = cvt_pk_bf16(v1[0], v1[1]); w.w = cvt_pk_bf16(v1[2], v1[3]);
                    *(u32x4*)(rowp + bj * HALF) = w; } }
    }
};
struct EpiF32 {
    static constexpr bool PERM = false;
    float* O; int ldc; size_t pstride;
    __device__ __forceinline__ void operator()(const f32x4 (&acc)[2][2][4][2], const Unit& u, int wr, int wc, int fr, int fq) const {
        float* base = O + (size_t)u.ks * pstride; const int col0 = u.pn * BM + wc * 32 + 4 * fq;
#pragma unroll
        for (int ai = 0; ai < 2; ++ai)
#pragma unroll
            for (int m = 0; m < 4; ++m) { float* rowp = base + (size_t)(u.pm * BM + ai * HALF + wr * 64 + m * 16 + fr) * ldc + col0;
#pragma unroll
                for (int bj = 0; bj < 2; ++bj)
#pragma unroll
                    for (int n = 0; n < 2; ++n) *(f32x4*)(rowp + bj * HALF + n * 16) = acc[ai][bj][m][n]; }
    }
};

template <class Epi, class SchedT>
__device__ __forceinline__ void gemm_phase(LAS unsigned char* lds, const Gemm g, const SchedT& S, const Epi& E) {
    int tid_ = threadIdx.x; asm volatile("" : "+v"(tid_));
    const int tid = tid_, wid = __builtin_amdgcn_readfirstlane(tid >> 6), lane = tid & 63, wr = wid >> 2, wc = wid & 3, fr = lane & 15, fq = lane >> 4;
    int K_ = g.K; asm volatile("" : "+s"(K_));
    const int K = K_, nt = K / BK;
    unsigned voffA[2], voffB[2];
#pragma unroll
    for (int i = 0; i < 2; ++i) { int R, C; stage_rc(tid * 16 + i * 8192, R, C); const int Rb = Epi::PERM ? ((R & ~31) + perm32(R & 31)) : R;
        voffA[i] = (unsigned)(R * g.lda + C) * 2u; voffB[i] = (unsigned)(Rb * g.ldb + C) * 2u; }
    const size_t kstep = (size_t)(BK * 2);
    const size_t hstepA = (size_t)HALF * g.lda * 2, hstepB = (size_t)HALF * g.ldb * 2;
    const size_t tstepA = 2 * hstepA, tstepB = 2 * hstepB;
    const unsigned ldsw = (unsigned)wid * 1024u;
    const int aoff = lds_byte(wr * 64 + fr, fq * 8), boff = lds_byte(wc * 32 + fr, fq * 8);
#define PG8_SA(b, h) (((b) * 2 + (h)) * HTB)
#define PG8_SB(b, h) ((4 + (b) * 2 + (h)) * HTB)
#define PG8_STAGE(bufoff, gbase, voff) do { _Pragma("unroll") for (int _i = 0; _i < 2; ++_i) \
        __builtin_amdgcn_global_load_lds((const unsigned*)((const char*)(gbase) + (voff)[_i]), (LAS unsigned*)(lds + (bufoff) + ldsw + _i * 8192), 16, 0, 0); } while (0)
#define PG8_LDA(dst, b, h) do { _Pragma("unroll") for (int m = 0; m < 4; ++m) _Pragma("unroll") for (int k = 0; k < 2; ++k) dst[m][k] = *(const LAS bf16x8*)(lds + PG8_SA(b, h) + aoff + m * 2048 + k * 1024); } while (0)
#define PG8_LDB(dst, b, h) do { _Pragma("unroll") for (int n = 0; n < 2; ++n) _Pragma("unroll") for (int k = 0; k < 2; ++k) dst[n][k] = *(const LAS bf16x8*)(lds + PG8_SB(b, h) + boff + n * 2048 + k * 1024); } while (0)
#define PG8_MMA(ai, bj, At, Bt) do { __builtin_amdgcn_s_setprio(1); _Pragma("unroll") for (int m = 0; m < 4; ++m) _Pragma("unroll") for (int n = 0; n < 2; ++n) _Pragma("unroll") for (int k = 0; k < 2; ++k) \
        acc[ai][bj][m][n] = __builtin_amdgcn_mfma_f32_16x16x32_bf16(Bt[n][k], At[m][k], acc[ai][bj][m][n], 0, 0, 0); __builtin_amdgcn_s_setprio(0); } while (0)
#define PG8_WAIT_V(n) asm volatile("s_waitcnt vmcnt(" #n ")" ::: "memory")
#define PG8_WAIT_L(n) asm volatile("s_waitcnt lgkmcnt(" #n ")" ::: "memory")
#define PG8_BAR __builtin_amdgcn_s_barrier()
#define PG8_SCHED __builtin_amdgcn_sched_barrier(0)
    Unit cur, nxt; int ui = 0;
    if (!S.next(0, cur)) return;
    f32x4 acc[2][2][4][2];
#pragma unroll
    for (int a = 0; a < 2; ++a)
#pragma unroll
        for (int b = 0; b < 2; ++b)
#pragma unroll
            for (int m = 0; m < 4; ++m)
#pragma unroll
                for (int n = 0; n < 2; ++n) acc[a][b][m][n] = (f32x4){0.f, 0.f, 0.f, 0.f};
    bf16x8 At[4][2], B0[2][2], B1[2][2];
    const char* cA = (const char*)g.A + (size_t)cur.pm * tstepA + S.aoff(cur); const char* cB = (const char*)g.Bt + (size_t)cur.pn * tstepB + S.boff(cur);
    PG8_STAGE(PG8_SB(0, 0), cB, voffB); PG8_STAGE(PG8_SB(0, 1), cB + hstepB, voffB); PG8_STAGE(PG8_SA(0, 0), cA, voffA); PG8_STAGE(PG8_SA(0, 1), cA + hstepA, voffA);
    if (wr == 1) PG8_BAR;
    PG8_WAIT_V(2); PG8_BAR;
    PG8_STAGE(PG8_SB(1, 0), cB + kstep, voffB); PG8_STAGE(PG8_SA(1, 0), cA + kstep, voffA); PG8_STAGE(PG8_SB(1, 1), cB + hstepB + kstep, voffB);
    PG8_WAIT_V(6); PG8_BAR;
    for (;;) {
        const bool has_next = S.next(ui + 1, nxt);
        const char* nA = has_next ? (const char*)g.A + (size_t)nxt.pm * tstepA + S.aoff(nxt) : cA; const char* nB = has_next ? (const char*)g.Bt + (size_t)nxt.pn * tstepB + S.boff(nxt) : cB;
        for (int t = 0; t < nt; t += 2) {
            const bool last = (t == nt - 2);
            const char* a1 = cA + (size_t)(t + 1) * kstep;
            const char* a2 = last ? nA : cA + (size_t)(t + 2) * kstep; const char* b2 = last ? nB : cB + (size_t)(t + 2) * kstep;
            const char* a3 = a2 + kstep; const char* b3 = b2 + kstep;
            PG8_LDB(B0, 0, 0); PG8_LDB(B1, 0, 1); PG8_SCHED; PG8_LDA(At, 0, 0); PG8_STAGE(PG8_SA(1, 1), a1 + hstepA, voffA);
            PG8_WAIT_V(8); PG8_WAIT_L(0); PG8_BAR; PG8_MMA(0, 0, At, B0); PG8_MMA(0, 1, At, B1); PG8_BAR; PG8_SCHED;
            PG8_LDA(At, 0, 1); PG8_STAGE(PG8_SB(0, 0), b2, voffB); PG8_STAGE(PG8_SB(0, 1), b2 + hstepB, voffB); PG8_STAGE(PG8_SA(0, 0), a2, voffA);
            PG8_WAIT_V(8); PG8_WAIT_L(0); PG8_BAR; PG8_MMA(1, 0, At, B0); PG8_MMA(1, 1, At, B1); PG8_BAR; PG8_SCHED;
            PG8_LDB(B0, 1, 0); PG8_LDB(B1, 1, 1); PG8_SCHED; PG8_LDA(At, 1, 0); PG8_STAGE(PG8_SA(0, 1), a2 + hstepA, voffA);
            PG8_WAIT_V(8); PG8_WAIT_L(0); PG8_BAR; PG8_MMA(0, 0, At, B0); PG8_MMA(0, 1, At, B1); PG8_BAR; PG8_SCHED;
            PG8_LDA(At, 1, 1); PG8_STAGE(PG8_SB(1, 0), b3, voffB); PG8_STAGE(PG8_SB(1, 1), b3 + hstepB, voffB); PG8_STAGE(PG8_SA(1, 0), a3, voffA);
            PG8_WAIT_V(8); PG8_WAIT_L(0); PG8_BAR; PG8_MMA(1, 0, At, B0); PG8_MMA(1, 1, At, B1); PG8_BAR; PG8_SCHED;
        }
        if (wr == 0) PG8_BAR;
        E(acc, cur, wr, wc, fr, fq);
        if (!has_next) break;
#pragma unroll
        for (int a = 0; a < 2; ++a)
#pragma unroll
            for (int b = 0; b < 2; ++b)
#pragma unroll
                for (int m = 0; m < 4; ++m)
#pragma unroll
                    for (int n = 0; n < 2; ++n) acc[a][b][m][n] = (f32x4){0.f, 0.f, 0.f, 0.f};
        cur = nxt; cA = nA; cB = nB; ++ui;
        if (wr == 1) PG8_BAR;
    }
    PG8_WAIT_V(0);
    PG8_BAR;
#undef PG8_SA
#undef PG8_SB
#undef PG8_STAGE
#undef PG8_LDA
#undef PG8_LDB
#undef PG8_MMA
#undef PG8_WAIT_V
#undef PG8_WAIT_L
#undef PG8_BAR
#undef PG8_SCHED
}
}

#define XB_TMO      128
#define XB_XCNT(j)  (256  + 64 * (j))
#define XB_XSUB(j)  (1280 + 64 * (j))
#define XB_XGEN(j)  (2304 + 64 * (j))
#define XB_TOP      3328
#define XB_TOPGEN   3392
#define XCD_BAR_WORDS 3456
#define XB_SPIN_CAP (1u << 18)
__device__ __forceinline__ unsigned xb_ld(unsigned* p)              { return __hip_atomic_load(p, __ATOMIC_RELAXED, __HIP_MEMORY_SCOPE_AGENT); }
__device__ __forceinline__ unsigned xb_add(unsigned* p, unsigned v) { return __hip_atomic_fetch_add(p, v, __ATOMIC_RELAXED, __HIP_MEMORY_SCOPE_AGENT); }
__device__ __forceinline__ unsigned xb_xcc_id() { return (unsigned)__builtin_amdgcn_s_getreg((3 << 11) | 20) & 0xFu; }
#define XB_SPIN(cond, bar) do { unsigned _sp = 0; while (cond) { __builtin_amdgcn_s_sleep(1); \
    if ((++_sp & 255u) == 0u) { if (xb_ld(&(bar)[XB_TMO])) break; if (_sp > XB_SPIN_CAP) { atomicAdd(&(bar)[XB_TMO], 1u); break; } } } } while (0)
struct XcdBarrier { unsigned* bar; unsigned x; volatile LAS unsigned* st; };
__device__ __forceinline__ XcdBarrier xcd_barrier_post(unsigned* bar, volatile LAS unsigned* st) {
    XcdBarrier b; b.bar = bar; b.x = xb_xcc_id(); b.st = st;
    if (threadIdx.x == 0) (void)xb_add(&bar[XB_XCNT(b.x)], 1u);
    return b;
}
__device__ __forceinline__ void xcd_barrier_complete(unsigned* bar, unsigned x, unsigned& nloc, unsigned& nx) {
    const unsigned G = gridDim.x * gridDim.y * gridDim.z;
    unsigned sum, cnt, mine, sp = 0u;
    for (;;) {
        sum = 0u; cnt = 0u; mine = 0u;
#pragma unroll
        for (unsigned j = 0; j < 16; ++j) { const unsigned c = xb_ld(&bar[XB_XCNT(j)]); sum += c; cnt += (c > 0u) ? 1u : 0u; mine = (j == x) ? c : mine; }
        if (sum == G) break;
        __builtin_amdgcn_s_sleep(1);
        if ((++sp & 255u) == 0u) { if (xb_ld(&bar[XB_TMO])) break; if (sp > XB_SPIN_CAP) { atomicAdd(&bar[XB_TMO], 1u); break; } }
    }
    nloc = mine > 0u ? mine : 1u; nx = cnt > 0u ? cnt : 1u;
}
__device__ __forceinline__ void xcd_barrier(const XcdBarrier& b) {
    asm volatile("s_waitcnt vmcnt(0)" ::: "memory");
    __syncthreads();
    if (threadIdx.x == 0) {
        unsigned* bar = b.bar;
        __builtin_amdgcn_s_waitcnt(0);
        unsigned nloc = b.st[0], nx = b.st[1];
        if (nloc == 0u) { xcd_barrier_complete(bar, b.x, nloc, nx); b.st[0] = nloc; b.st[1] = nx; }
        const unsigned old = xb_add(&bar[XB_XSUB(b.x)], 1u);
        const unsigned gen = old / nloc;
        if (old + 1u == (gen + 1u) * nloc) {
            __builtin_amdgcn_fence(__ATOMIC_RELEASE, "agent");
            asm volatile("s_waitcnt vmcnt(0)" ::: "memory");
            const unsigned og = xb_add(&bar[XB_TOP], 1u);
            const unsigned tg = og / nx;
            if (og + 1u == (tg + 1u) * nx) xb_add(&bar[XB_TOPGEN], 1u);
            else XB_SPIN(xb_ld(&bar[XB_TOPGEN]) == tg, bar);
            __builtin_amdgcn_fence(__ATOMIC_ACQUIRE, "agent");
            xb_add(&bar[XB_XGEN(b.x)], 1u);
            asm volatile("s_waitcnt vmcnt(0)" ::: "memory");
        } else {
            XB_SPIN(xb_ld(&bar[XB_XGEN(b.x)]) == gen, bar);
            __builtin_amdgcn_fence(__ATOMIC_ACQUIRE, "agent");
            asm volatile("s_waitcnt vmcnt(0)" ::: "memory");
        }
    }
    __syncthreads();
}

constexpr int LDS_BYTES = 147456;
#ifndef PH
#define PH 0xFFFF
#endif
#ifndef DUP
#define DUP 0
#endif
#define GSYNC() do { xcd_barrier(xb); if (DUP & 0x8000) { xcd_barrier(xb); xcd_barrier(xb); } } while (0)
#define REP(bit) for (int rep_ = 0; rep_ < ((DUP & (bit)) ? 2 : 1); ++rep_)
struct Ctx { LAS unsigned char* lds; int tid, lane, wave, G, bid; };
__device__ __forceinline__ Ctx fresh_ctx(LAS unsigned char* lds) { Ctx C; int t = threadIdx.x; asm volatile("" : "+v"(t)); C.lds = lds; C.tid = t; C.lane = t & 63; C.wave = __builtin_amdgcn_readfirstlane(t >> 6); C.G = gridDim.x; C.bid = blockIdx.x; return C; }

__device__ __forceinline__ void phase_mod(const Params& P, const Ctx& C) {
    LAS float* sc = (LAS float*)C.lds; LAS float* red = sc + 5120;
    for (int i = C.tid; i < 5120; i += 512) { const int r = i >> 10, k = i & 1023; const float x = r == 0 ? P.in[I_CCTX][k] : P.in[I_C][(r - 1) * 1024 + k]; sc[i] = siluf_(x); }
    __syncthreads();
    float* MOD = (float*)(P.ws + WS_MOD);
    const int kg = C.tid >> 5, c = C.tid & 31;
    for (int tile = C.bid; tile < 768; tile += C.G) {
        const int l = tile / 192, col = (tile % 192) * 32 + c;
        const float* w = P.in[I_WMOD] + (size_t)l * 1024 * 6144 + col;
        float a0 = 0.f, a1 = 0.f, a2 = 0.f, a3 = 0.f, a4 = 0.f;
#pragma unroll 16
        for (int k = kg * 64; k < kg * 64 + 64; ++k) { const float wv = w[(size_t)k * 6144]; a0 += sc[k] * wv; a1 += sc[1024 + k] * wv; a2 += sc[2048 + k] * wv; a3 += sc[3072 + k] * wv; a4 += sc[4096 + k] * wv; }
        red[(kg * 5 + 0) * 32 + c] = a0; red[(kg * 5 + 1) * 32 + c] = a1; red[(kg * 5 + 2) * 32 + c] = a2; red[(kg * 5 + 3) * 32 + c] = a3; red[(kg * 5 + 4) * 32 + c] = a4;
        __syncthreads();
        if (C.tid < 160) { const int r = C.tid >> 5; float s = 0.f;
#pragma unroll
            for (int q = 0; q < 16; ++q) s += red[(q * 5 + r) * 32 + c];
            MOD[(size_t)(l * 5 + r) * 6144 + col] = s + P.in[I_BMOD][l * 6144 + col]; }
        __syncthreads();
    }
}

__device__ __forceinline__ void transpose_item(const float* W, int K, int N, bf16_t* WT, LAS float* scr, int item, int nblk, int lane) {
    const int kb = item / nblk, nb = item % nblk, k0 = 64 * kb, n0 = 32 * nb;
    const bool nok = (n0 + (lane & 31)) < N;
#pragma unroll 8
    for (int i = 0; i < 32; ++i) { const int kk = 2 * i + (lane >> 5); scr[kk * 33 + (lane & 31)] = nok ? W[(size_t)(k0 + kk) * N + n0 + (lane & 31)] : 0.f; }
    asm volatile("s_waitcnt lgkmcnt(0)" ::: "memory");
    const int c = lane & 7;
#pragma unroll
    for (int j = 0; j < 4; ++j) { const int n = (lane >> 3) + 8 * j; const LAS float* s = scr + (8 * c) * 33 + n;
        u32x4 o; o.x = pk2(s[0 * 33], s[1 * 33]); o.y = pk2(s[2 * 33], s[3 * 33]); o.z = pk2(s[4 * 33], s[5 * 33]); o.w = pk2(s[6 * 33], s[7 * 33]);
        *(u32x4*)(WT + (size_t)(n0 + n) * K + k0 + 8 * c) = o; }
    asm volatile("s_waitcnt lgkmcnt(0)" ::: "memory");
}
__device__ __forceinline__ void phase_convert(const Params& P, const Ctx& C, int l) {
    LAS float* scr = (LAS float*)(C.lds + 32768 + C.wave * 8704);
    const int gw = C.bid * 8 + C.wave, NGW = C.G * 8; const int j = l >> 1; const bool ev = (l & 1) == 0;
    const float* win = ev ? P.in[I_WINAB] + (size_t)j * 1024 * N_AB : P.in[I_WINCD] + (size_t)j * 1024 * N_CD;
    const float* wout = (ev ? P.in[I_WOUTAB] : P.in[I_WOUTCD]) + (size_t)j * 2048 * 1024;
    const float* wup = P.in[I_WUP] + (size_t)l * 1024 * 4096; const float* wdn = P.in[I_WDN] + (size_t)l * 4096 * 1024;
    const int N_in = ev ? N_AB : N_CD, Np = ev ? N_AB_P : N_CD_P;
    const int I0 = 16 * (Np / 32), I1 = 32 * 32, I2 = 16 * 128, I3 = 64 * 32;
    for (int it = gw; it < I0 + I1 + I2 + I3; it += NGW) {
        int r = it;
        if (r < I0) { transpose_item(win, 1024, N_in, (bf16_t*)(P.ws + WS_WIN), scr, r, Np / 32, C.lane); continue; } r -= I0;
        if (r < I1) { transpose_item(wout, 2048, 1024, (bf16_t*)(P.ws + WS_WOUT), scr, r, 32, C.lane); continue; } r -= I1;
        if (r < I2) { transpose_item(wup, 1024, 4096, (bf16_t*)(P.ws + WS_WUP), scr, r, 128, C.lane); continue; } r -= I2;
        transpose_item(wdn, 4096, 1024, (bf16_t*)(P.ws + WS_WDN), scr, r, 32, C.lane);
    }
    if (ev) {
        bf16_t* WL = (bf16_t*)(P.ws + WS_WLORA);
        for (int idx = C.bid * 512 + C.tid; idx < 5120 * 16; idx += C.G * 512) {
            const int n = idx % 5120, k8 = idx / 5120, g = n >> 10, cc = n & 1023; float o[8];
#pragma unroll
            for (int e = 0; e < 8; ++e) { const int k = k8 * 8 + e; float v = 0.f;
                if (g == 0) { if (k < 64) v = P.in[I_W2][((size_t)(j * 2 + 0) * 64 + k) * 1024 + cc]; }
                else if (g == 1) { if (k >= 64) v = P.in[I_W2][((size_t)(j * 2 + 1) * 64 + (k - 64)) * 1024 + cc]; }
                else if (g == 2) { if (k < 64) v = P.in[I_A2][((size_t)(j * 2 + 0) * 64 + k) * 1024 + cc]; }
                else if (g == 3) { if (k >= 64) v = P.in[I_A2][((size_t)(j * 2 + 1) * 64 + (k - 64)) * 1024 + cc]; }
                else v = P.in[I_G2][((size_t)j * 128 + k) * 1024 + cc];
                o[e] = v; }
            *(u32x4*)(WL + (size_t)n * 128 + k8 * 8) = pack8(o);
        }
    }
}

__device__ __forceinline__ void phase_rows(const Params& P, const Ctx& C, int mode, const float* gpost, const float* gate_mod  ,
                                           bool next, const float* gpre, const float* mod_next  , bool dummy = false) {
    float* X = P.out + O_X; const bf16_t* MP0 = (const bf16_t*)(P.ws + WS_MP); const bf16_t* MP1 = MP0 + (size_t)MTOK * DM; bf16_t* H = (bf16_t*)(P.ws + WS_H);
    const int gw = C.bid * 8 + C.wave, NGW = C.G * 8;
    for (int m = gw; m < MTOK; m += NGW) {
        const int mr = m < 4096 ? 0 : 1 + ((m - 4096) >> 10);
        f32x4 x[4];
        if (mode == 0) { const f32x4* src = (const f32x4*)(m < 4096 ? P.in[I_XP] + (size_t)m * DM : P.in[I_XS] + (size_t)(m - 4096) * DM) + C.lane;
#pragma unroll
            for (int j = 0; j < 4; ++j) x[j] = src[64 * j];
        } else {
            const f32x4* xs = (const f32x4*)(X + (size_t)m * DM) + C.lane; const u32x2* p0 = (const u32x2*)(MP0 + (size_t)m * DM) + C.lane; const u32x2* p1 = (const u32x2*)(MP1 + (size_t)m * DM) + C.lane;
            f32x4 f[4]; float ss = 0.f;
#pragma unroll
            for (int j = 0; j < 4; ++j) { x[j] = xs[64 * j]; f[j] = unpack4(p0[64 * j]) + unpack4(p1[64 * j]); ss += (f[j].x * f[j].x + f[j].y * f[j].y) + (f[j].z * f[j].z + f[j].w * f[j].w); }
            const float rs = rsqrtf(wave_sum(ss) * (1.f / DM) + 1e-6f);
            const f32x4* gp = (const f32x4*)gpost + C.lane; const f32x4* gt = (const f32x4*)(gate_mod + (size_t)mr * 6144) + C.lane;
#pragma unroll
            for (int j = 0; j < 4; ++j) x[j] = x[j] + gt[64 * j] * (f[j] * rs * gp[64 * j]);
        }
        f32x4* xo = (f32x4*)((dummy ? (float*)(P.ws + WS_PREP) : X) + (size_t)m * DM) + C.lane;
#pragma unroll
        for (int j = 0; j < 4; ++j) xo[64 * j] = x[j];
        if (next) {
            float ss = 0.f;
#pragma unroll
            for (int j = 0; j < 4; ++j) ss += (x[j].x * x[j].x + x[j].y * x[j].y) + (x[j].z * x[j].z + x[j].w * x[j].w);
            const float rs = rsqrtf(wave_sum(ss) * (1.f / DM) + 1e-6f);
            const f32x4* gp = (const f32x4*)gpre + C.lane; const f32x4* sh = (const f32x4*)(mod_next + (size_t)mr * 6144) + C.lane; const f32x4* sl = (const f32x4*)(mod_next + (size_t)mr * 6144 + 1024) + C.lane;
            u32x2* ho = (u32x2*)((dummy ? (bf16_t*)(P.ws + WS_PREP + 40 * MiB) : H) + (size_t)m * DM) + C.lane;
#pragma unroll
            for (int j = 0; j < 4; ++j) { const f32x4 h = (x[j] * rs * gp[64 * j]) * (sl[64 * j] + 1.f) + sh[64 * j]; u32x2 w; w.x = pk2(h.x, h.y); w.y = pk2(h.z, h.w); ho[64 * j] = w; }
        }
    }
}

__device__ __forceinline__ void conv8(const bf16_t* src, int ld, int col0, int base, int t, bool samp, const float* w, const float* b, int NC, int ch, float* acc) {
    { const f32x4 b0 = *(const f32x4*)(b + ch), b1 = *(const f32x4*)(b + ch + 4); acc[0] = b0.x; acc[1] = b0.y; acc[2] = b0.z; acc[3] = b0.w; acc[4] = b1.x; acc[5] = b1.y; acc[6] = b1.z; acc[7] = b1.w; }
    if (!samp) {
#pragma unroll
        for (int d = 0; d < 3; ++d) { const int tt = t + d - 1; if (tt < 0 || tt >= 256) continue;
            float xv[8]; unpack8(*(const u32x4*)(src + (size_t)(base + tt) * ld + col0 + ch), xv);
            const f32x4 w0 = *(const f32x4*)(w + (3 + d) * NC + ch), w1 = *(const f32x4*)(w + (3 + d) * NC + ch + 4);
            acc[0] += w0.x * xv[0]; acc[1] += w0.y * xv[1]; acc[2] += w0.z * xv[2]; acc[3] += w0.w * xv[3]; acc[4] += w1.x * xv[4]; acc[5] += w1.y * xv[5]; acc[6] += w1.z * xv[6]; acc[7] += w1.w * xv[7]; }
    } else {
        const int r = t >> 6, c = t & 63;
#pragma unroll
        for (int i = 0; i < 3; ++i)
#pragma unroll
            for (int d = 0; d < 3; ++d) { const int rr = r + i - 1, cc = c + d - 1; if (rr < 0 || rr >= 16 || cc < 0 || cc >= 64) continue;
                float xv[8]; unpack8(*(const u32x4*)(src + (size_t)(base + rr * 64 + cc) * ld + col0 + ch), xv);
                const f32x4 w0 = *(const f32x4*)(w + (i * 3 + d) * NC + ch), w1 = *(const f32x4*)(w + (i * 3 + d) * NC + ch + 4);
                acc[0] += w0.x * xv[0]; acc[1] += w0.y * xv[1]; acc[2] += w0.z * xv[2]; acc[3] += w0.w * xv[3]; acc[4] += w1.x * xv[4]; acc[5] += w1.y * xv[5]; acc[6] += w1.z * xv[6]; acc[7] += w1.w * xv[7]; }
    }
}

__device__ __forceinline__ void phase_prep_even(const Params& P, const Ctx& C, int j) {
    const bf16_t* PROJ = (const bf16_t*)(P.ws + WS_PROJ); bf16_t* PREP = (bf16_t*)(P.ws + WS_PREP); bf16_t* LA = (bf16_t*)(P.ws + WS_LORAA);
    float* DT = (float*)(P.ws + WS_DT); float* DA = (float*)(P.ws + WS_DA);
    const float* cw = P.in[I_SCONVW] + (size_t)j * 9 * 2048; const float* cb = P.in[I_SCONVB] + j * 2048;
    const float* mu = P.in[I_MU] + j * 3456; const float* kkw = P.in[I_KK] + j * 1024;
    const int gw = C.bid * 8 + C.wave, NGW = C.G * 8, lane = C.lane;
    for (int m = gw; m < MTOK; m += NGW) {
        const bool samp = m >= 4096; const int T = samp ? 1024 : 256; const int t = samp ? ((m - 4096) & 1023) : (m & 255); const int base = m - t;
        const bf16_t* prow = PROJ + (size_t)m * PROJ_LD_AB; bf16_t* orow = PREP + (size_t)m * PREP_LD;
#pragma unroll 1
        for (int it = 0; it < 4; ++it) { const int ch = it * 512 + lane * 8; float acc[8];
            conv8(PROJ, PROJ_LD_AB, 1024, base, t, samp, cw, cb, 2048, ch, acc);
#pragma unroll
            for (int e = 0; e < 8; ++e) acc[e] = siluf_(acc[e]);
            *(u32x4*)(orow + ch) = pack8(acc); }
#pragma unroll
        for (int it = 0; it < 2; ++it) { const int ch = it * 512 + lane * 8; float z[8]; unpack8(*(const u32x4*)(prow + ch), z);
#pragma unroll
            for (int e = 0; e < 8; ++e) z[e] = siluf_(z[e]);
            *(u32x4*)(orow + 2048 + ch) = pack8(z); }
        if (lane < 32) { const float raw = bf2f(prow[3072 + lane]); const float dt = softplusf_(raw + P.in[I_DTB][j * 32 + lane]);
            DT[(size_t)m * 32 + lane] = dt; DA[(size_t)m * 32 + lane] = -dt * __expf(P.in[I_ALOG][j * 32 + lane]); }
        const bool hp = t > 0, hn = t < T - 1;
#pragma unroll 1
        for (int it = 0; it < 7; ++it) { const int c = it * 512 + lane * 8; if (c >= 3456) break;
            float x[8], xp[8], xn[8];
            unpack8(*(const u32x4*)(prow + IN_SSD + c), x);
            if (hp) unpack8(*(const u32x4*)(prow - PROJ_LD_AB + IN_SSD + c), xp); else {
#pragma unroll
                for (int e = 0; e < 8; ++e) xp[e] = 0.f; }
            if (hn) unpack8(*(const u32x4*)(prow + PROJ_LD_AB + IN_SSD + c), xn); else {
#pragma unroll
                for (int e = 0; e < 8; ++e) xn[e] = 0.f; }
            const f32x4 m0 = *(const f32x4*)(mu + c), m1 = *(const f32x4*)(mu + c + 4);
            const float mv[8] = {m0.x, m0.y, m0.z, m0.w, m1.x, m1.y, m1.z, m1.w};
#pragma unroll
            for (int e = 0; e < 8; ++e) x[e] = x[e] + mv[e] * (0.5f * (xp[e] + xn[e]) - x[e]);
            if (it < 2) { *(u32x4*)(orow + 3072 + c) = pack8(x); }
            else if (it < 4) { *(u32x4*)(orow + 4096 + (c - 1024)) = pack8(x);
                const f32x4 k0 = *(const f32x4*)(kkw + c - 1024), k1 = *(const f32x4*)(kkw + c - 1024 + 4);
                const float kv[8] = {k0.x, k0.y, k0.z, k0.w, k1.x, k1.y, k1.z, k1.w}; float ss = 0.f;
#pragma unroll
                for (int e = 0; e < 8; ++e) { x[e] *= kv[e]; ss += x[e] * x[e]; }
                ss += __shfl_xor(ss, 1); ss += __shfl_xor(ss, 2); ss += __shfl_xor(ss, 4);
                const float rn = rsqrtf(ss + 1e-12f);
#pragma unroll
                for (int e = 0; e < 8; ++e) x[e] *= rn;
                *(u32x4*)(orow + 6144 + (c - 1024)) = pack8(x); }
            else if (it < 6) { *(u32x4*)(orow + 5120 + (c - 2048)) = pack8(x); }
            else { const int cc = c - 3072;
#pragma unroll
                for (int e = 0; e < 8; ++e) x[e] = cc < 128 ? tanhf_(x[e]) : (cc < 256 ? x[e] : sigmoidf_(x[e]));
                *(u32x4*)(LA + (size_t)m * LORA_K + cc) = pack8(x); }
        }
    }
}
__device__ __forceinline__ void phase_prep_odd(const Params& P, const Ctx& C, int j) {
    const bf16_t* PROJ = (const bf16_t*)(P.ws + WS_PROJ); bf16_t* PREP = (bf16_t*)(P.ws + WS_PREP);
    const float* cw = P.in[I_MCONVW] + (size_t)j * 9 * 1024; const float* cb = P.in[I_MCONVB] + j * 1024;
    const int gw = C.bid * 8 + C.wave, NGW = C.G * 8, lane = C.lane;
    for (int m = gw; m < MTOK; m += NGW) {
        const bool samp = m >= 4096; const int t = samp ? ((m - 4096) & 1023) : (m & 255); const int base = m - t;
#pragma unroll 1
        for (int it = 0; it < 2; ++it) { const int ch = it * 512 + lane * 8; float acc[8];
            conv8(PROJ, PROJ_LD_CD, IN_GLA, base, t, samp, cw, cb, 1024, ch, acc);
#pragma unroll
            for (int e = 0; e < 8; ++e) acc[e] = siluf_(acc[e]);
            *(u32x4*)(PREP + (size_t)m * PREP_LD + ch) = pack8(acc); }
    }
}

constexpr int CS_QLD = 136, CS_SLD = 72;
constexpr int CS_QS = 0, CS_KS = 17408, CS_KT = 34816, CS_VT = 53248, CS_PS = 64768, CS_ST = 73984, CS_LA = 95744, CS_TOT = 128512, CS_BV = 131072, CS_IG = 131328, CS_GW = 131584, CS_MS = 140288, CS_FV = 140352, CS_DTV = 140608;
__device__ __forceinline__ bf16x8 lds_frag(const LAS bf16_t* p) { return *(const LAS bf16x8*)p; }
template <int MODE>
__device__ __forceinline__ void chunk_scan(const Params& P, const Ctx& C, int j, int s, int dir, int h, int vs) {
    const int tid = C.tid, lane = C.lane, w = C.wave, fr = lane & 15, fq = lane >> 4;
    const int T = s < 16 ? 256 : 1024, base = s < 16 ? s * 256 : 4096 + (s - 16) * 1024, nch = T >> 6;
    const bf16_t* PROJ = (const bf16_t*)(P.ws + WS_PROJ); const bf16_t* PREP = (const bf16_t*)(P.ws + WS_PREP);
    bf16_t* Y = (bf16_t*)(P.ws + WS_MP) + (size_t)dir * MTOK * YLD;
    LAS bf16_t* Qs = (LAS bf16_t*)(C.lds + CS_QS); LAS bf16_t* Ks = (LAS bf16_t*)(C.lds + CS_KS); LAS bf16_t* Kt = (LAS bf16_t*)(C.lds + CS_KT); LAS bf16_t* Vt = (LAS bf16_t*)(C.lds + CS_VT);
    LAS bf16_t* Ps = (LAS bf16_t*)(C.lds + CS_PS); LAS bf16_t* St = (LAS bf16_t*)(C.lds + CS_ST);
    LAS float* LA = (LAS float*)(C.lds + CS_LA); LAS float* TOT = (LAS float*)(C.lds + CS_TOT); LAS float* BV = (LAS float*)(C.lds + CS_BV); LAS float* IG = (LAS float*)(C.lds + CS_IG);
    LAS float* GW = (LAS float*)(C.lds + CS_GW); LAS float* MS = (LAS float*)(C.lds + CS_MS); LAS float* FV = (LAS float*)(C.lds + CS_FV); LAS float* DTV = (LAS float*)(C.lds + CS_DTV);
    constexpr int NVT = MODE == 2 ? 5 : 4;
    const int si = tid >> 3, kq = tid & 7;
    __syncthreads();
    if (MODE == 1) {
        const float* gwp = P.in[I_GGW] + (size_t)(j * 2 + dir) * 16 * 512 + h * 128;
        for (int i = tid; i < 16 * 128; i += 512) GW[i] = gwp[(i >> 7) * 512 + (i & 127)];
        if (tid < 128) GW[2048 + tid] = P.in[I_GGB][(j * 2 + dir) * 512 + h * 128 + tid];
    }
    f32x4 Sacc[NVT];
    {
        const float* s0 = nullptr; int kstride = 64; float em0 = 1.f;
        if (s >= 16) { const int b = s - 16;
            if (MODE == 0) { s0 = P.in[I_SSSD] + ((size_t)((b * 2 + j) * 2 + dir) * 16 + h) * 8192; kstride = 64; }
            if (MODE == 1) { s0 = P.in[I_SGLA] + ((size_t)((b * 2 + j) * 2 + dir) * 4 + h) * 32768 + vs * 64; kstride = 256; }
            if (MODE == 2) { s0 = P.in[I_SMC] + ((size_t)((b * 2 + j) * 2 + dir) * 4 + h) * 32768 + vs * 64; kstride = 256; em0 = __expf(P.in[I_SMM][((b * 2 + j) * 2 + dir) * 4 + h]); } }
#pragma unroll
        for (int vt = 0; vt < 4; ++vt)
#pragma unroll
            for (int e = 0; e < 4; ++e) Sacc[vt][e] = s0 ? s0[(size_t)(16 * w + 4 * fq + e) * kstride + 16 * vt + fr] * em0 : 0.f;
        if (MODE == 2) {
            const float* n0 = s >= 16 ? P.in[I_SMN] + ((size_t)(((s - 16) * 2 + j) * 2 + dir) * 4 + h) * 128 : nullptr;
#pragma unroll
            for (int e = 0; e < 4; ++e) Sacc[NVT - 1][e] = (n0 && fr == 0) ? n0[16 * w + 4 * fq + e] * em0 : 0.f;
            if (tid == 0) MS[0] = s >= 16 ? P.in[I_SMM][(((s - 16) * 2 + j) * 2 + dir) * 4 + h] : 0.f;
            for (int i = tid; i < 16 * CS_SLD; i += 512) Vt[64 * CS_SLD + i] = (bf16_t)((i < CS_SLD) ? 0x3F80 : 0);
        }
#pragma unroll
        for (int vt = 0; vt < NVT; ++vt) { u32x2 wv; wv.x = pk2(Sacc[vt][0], Sacc[vt][1]); wv.y = pk2(Sacc[vt][2], Sacc[vt][3]); *(LAS u32x2*)(St + (16 * vt + fr) * CS_QLD + 16 * w + 4 * fq) = wv; }
    }
    u32x4 rq0, rq1, rk0, rk1, rg0, rg1; float rla = 0.f, rig = 0.f, rdt = 0.f;
    unsigned short rkt[16], rvt[8];
    const int kx = tid & 127, tgk = tid >> 7, vx = tid & 63, tgv = tid >> 6;
    auto tok = [&](int c, int i) { const int st0 = c * 64 + i; return base + (dir ? (T - 1 - st0) : st0); };
    auto load_raw = [&](int c) {
        const int m = tok(c, si); const int m1 = tok(c, tid & 63);
        const bf16_t* krow; const bf16_t* vrow; int kld, vld;
        if (MODE == 0) { const int g = h >> 2; const bf16_t* pr = PREP + (size_t)m * PREP_LD;
            rq0 = *(const u32x4*)(pr + 1536 + g * 128 + 16 * kq); rq1 = *(const u32x4*)(pr + 1536 + g * 128 + 16 * kq + 8);
            rk0 = *(const u32x4*)(pr + 1024 + g * 128 + 16 * kq); rk1 = *(const u32x4*)(pr + 1024 + g * 128 + 16 * kq + 8);
            if (tid < 64) { rla = ((const float*)(P.ws + WS_DA))[(size_t)m1 * 32 + dir * 16 + h]; rdt = ((const float*)(P.ws + WS_DT))[(size_t)m1 * 32 + dir * 16 + h]; }
            krow = PREP + 1024 + g * 128 + kx; kld = PREP_LD; vrow = PREP + h * 64 + vx; vld = PREP_LD; }
        if (MODE == 1) { const bf16_t* pr = PROJ + (size_t)m * PROJ_LD_CD;
            rq0 = *(const u32x4*)(pr + h * 128 + 16 * kq); rq1 = *(const u32x4*)(pr + h * 128 + 16 * kq + 8);
            rk0 = *(const u32x4*)(pr + 512 + h * 128 + 16 * kq); rk1 = *(const u32x4*)(pr + 512 + h * 128 + 16 * kq + 8);
            rg0 = *(const u32x4*)(pr + 3072 + dir * 16); rg1 = *(const u32x4*)(pr + 3072 + dir * 16 + 8);
            krow = PROJ + 512 + h * 128 + kx; kld = PROJ_LD_CD; vrow = PROJ + 1024 + h * 256 + vs * 64 + vx; vld = PROJ_LD_CD; }
        if (MODE == 2) { const bf16_t* pp = PREP + (size_t)m * PREP_LD;
            rq0 = *(const u32x4*)(pp + h * 128 + 16 * kq); rq1 = *(const u32x4*)(pp + h * 128 + 16 * kq + 8);
            rk0 = *(const u32x4*)(pp + 512 + h * 128 + 16 * kq); rk1 = *(const u32x4*)(pp + 512 + h * 128 + 16 * kq + 8);
            if (tid < 64) { const bf16_t* p1 = PROJ + (size_t)m1 * PROJ_LD_CD + IN_GLA + 3072; rig = bf2f(p1[dir * 4 + h]); rla = bf2f(p1[8 + dir * 4 + h]); }
            krow = PREP + 512 + h * 128 + kx; kld = PREP_LD; vrow = PROJ + IN_GLA + 1024 + h * 256 + vs * 64 + vx; vld = PROJ_LD_CD; }
        { const bf16_t* kp = krow + (size_t)tok(c, 16 * tgk) * kld; const long ks_ = dir ? -(long)kld : (long)kld;
#pragma unroll
          for (int jj = 0; jj < 16; ++jj) { rkt[jj] = *kp; kp += ks_; }
          const bf16_t* vp = vrow + (size_t)tok(c, 8 * tgv) * vld; const long vs_ = dir ? -(long)vld : (long)vld;
#pragma unroll
          for (int jj = 0; jj < 8; ++jj) { rvt[jj] = *vp; vp += vs_; } }
    };
    load_raw(0);
    __syncthreads();
    const int ycol0 = (MODE == 0 ? h * 64 : (MODE == 1 ? h * 256 + vs * 64 : 1024 + h * 256 + vs * 64));
    for (int c = 0; c < nch; ++c) {
        if (MODE == 1) {
            float gd[16]; unpack8(rg0, gd); unpack8(rg1, gd + 8);
#pragma unroll
            for (int q4 = 0; q4 < 4; ++q4) { f32x4 gp = *(LAS f32x4*)(GW + 2048 + 16 * kq + 4 * q4);
#pragma unroll
                for (int r = 0; r < 16; ++r) gp = gp + *(LAS f32x4*)(GW + r * 128 + 16 * kq + 4 * q4) * gd[r];
                f32x4 la;
#pragma unroll
                for (int e = 0; e < 4; ++e) la[e] = logsigmoidf_(gp[e]) * 0.0625f;
                *(LAS f32x4*)(LA + si * 128 + 16 * kq + 4 * q4) = la; }
        } else if (tid < 64) {
            float ig = 0.f, la = rla;
            if (MODE == 2) { ig = rig + P.in[I_MIB][(j * 2 + dir) * 4 + h]; la = logsigmoidf_(rla + P.in[I_MFB][(j * 2 + dir) * 4 + h]); }
            float x = la;
            x += __int_as_float(__builtin_amdgcn_update_dpp(0, __float_as_int(x), 0x111, 0xF, 0xF, true));
            x += __int_as_float(__builtin_amdgcn_update_dpp(0, __float_as_int(x), 0x112, 0xF, 0xF, true));
            x += __int_as_float(__builtin_amdgcn_update_dpp(0, __float_as_int(x), 0x114, 0xF, 0xF, true));
            x += __int_as_float(__builtin_amdgcn_update_dpp(0, __float_as_int(x), 0x118, 0xF, 0xF, true));
            { const float t0 = __int_as_float(__builtin_amdgcn_readlane(__float_as_int(x), 15)), t1 = __int_as_float(__builtin_amdgcn_readlane(__float_as_int(x), 31)), t2 = __int_as_float(__builtin_amdgcn_readlane(__float_as_int(x), 47));
              const int rw = lane >> 4; x += (rw > 0 ? t0 : 0.f) + (rw > 1 ? t1 : 0.f) + (rw > 2 ? t2 : 0.f); }
            const float bl = __int_as_float(__builtin_amdgcn_readlane(__float_as_int(x), 63));
            const float kgn = MODE == 2 ? 0.08838834764831845f * __expf(ig) : 1.f;
            BV[tid] = x; IG[tid] = kgn; FV[tid] = kgn * __expf(bl - x); DTV[tid] = MODE == 0 ? rdt : 1.f;
            if (MODE == 2) { float ml = bl - x + ig;
                ml = fmaxf(ml, __int_as_float(__builtin_amdgcn_update_dpp(__float_as_int(ml), __float_as_int(ml), 0xB1, 0xF, 0xF, false)));
                ml = fmaxf(ml, __int_as_float(__builtin_amdgcn_update_dpp(__float_as_int(ml), __float_as_int(ml), 0x4E, 0xF, 0xF, false)));
                ml = fmaxf(ml, __int_as_float(__builtin_amdgcn_update_dpp(__float_as_int(ml), __float_as_int(ml), 0x141, 0xF, 0xF, false)));
                ml = fmaxf(ml, __int_as_float(__builtin_amdgcn_update_dpp(__float_as_int(ml), __float_as_int(ml), 0x140, 0xF, 0xF, false)));
                const float m01 = fmaxf(__int_as_float(__builtin_amdgcn_readlane(__float_as_int(ml), 0)), __int_as_float(__builtin_amdgcn_readlane(__float_as_int(ml), 16)));
                const float m23 = fmaxf(__int_as_float(__builtin_amdgcn_readlane(__float_as_int(ml), 32)), __int_as_float(__builtin_amdgcn_readlane(__float_as_int(ml), 48)));
                if (tid == 0) MS[0] = fmaxf(bl + MS[0], fmaxf(m01, m23)); }
        }
        __syncthreads();
        if (MODE == 1) {
            const int k = tid & 127, qd = tid >> 7; float run = 0.f;
#pragma unroll
            for (int jj = 0; jj < 16; ++jj) { run += LA[(16 * qd + jj) * 128 + k]; LA[(16 * qd + jj) * 128 + k] = run; }
            TOT[qd * 128 + k] = run;
            __syncthreads();
            if (tid < 128) TOT[4 * 128 + tid] = __expf(TOT[tid] + TOT[128 + tid] + TOT[256 + tid] + TOT[384 + tid]);
        }
        {
            float q[16], k[16]; unpack8(rq0, q); unpack8(rq1, q + 8); unpack8(rk0, k); unpack8(rk1, k + 8);
            float qs[16], ks[16];
            if (MODE == 1) { const int qd = si >> 4;
#pragma unroll
                for (int e4 = 0; e4 < 4; ++e4) { const int kk = 16 * kq + 4 * e4; const f32x4 bb = *(LAS f32x4*)(LA + si * 128 + kk), t0 = *(LAS f32x4*)(TOT + kk), t1 = *(LAS f32x4*)(TOT + 128 + kk), t2 = *(LAS f32x4*)(TOT + 256 + kk);
#pragma unroll
                    for (int e = 0; e < 4; ++e) { const float b = bb[e] + (qd > 0 ? t0[e] : 0.f) + (qd > 1 ? t1[e] : 0.f) + (qd > 2 ? t2[e] : 0.f);
                        qs[4 * e4 + e] = q[4 * e4 + e] * 0.08838834764831845f * __expf(b); ks[4 * e4 + e] = k[4 * e4 + e] * __expf(fminf(-b, 80.f)); } }
            } else { const float kgn = IG[si];
#pragma unroll
                for (int e = 0; e < 16; ++e) { qs[e] = q[e]; ks[e] = k[e] * kgn; } }
            *(LAS u32x4*)(Qs + si * CS_QLD + 16 * kq) = pack8(qs); *(LAS u32x4*)(Qs + si * CS_QLD + 16 * kq + 8) = pack8(qs + 8);
            *(LAS u32x4*)(Ks + si * CS_QLD + 16 * kq) = pack8(ks); *(LAS u32x4*)(Ks + si * CS_QLD + 16 * kq + 8) = pack8(ks + 8);
        }
        __syncthreads();
        {
            float kt[16];
            if (MODE == 1) { float off = 0.f; const float t0 = TOT[kx], t1 = TOT[128 + kx], t2 = TOT[256 + kx], t3 = TOT[384 + kx];
                off = (tgk > 0 ? t0 : 0.f) + (tgk > 1 ? t1 : 0.f) + (tgk > 2 ? t2 : 0.f); const float bl = (t0 + t1) + (t2 + t3);
#pragma unroll
                for (int jj = 0; jj < 16; ++jj) kt[jj] = bf2f(rkt[jj]) * __expf(bl - (LA[(16 * tgk + jj) * 128 + kx] + off));
            } else {
#pragma unroll
                for (int jj = 0; jj < 16; ++jj) kt[jj] = bf2f(rkt[jj]) * FV[16 * tgk + jj]; }
            *(LAS u32x4*)(Kt + kx * CS_SLD + 16 * tgk) = pack8(kt); *(LAS u32x4*)(Kt + kx * CS_SLD + 16 * tgk + 8) = pack8(kt + 8);
            float vt8[8];
#pragma unroll
            for (int jj = 0; jj < 8; ++jj) vt8[jj] = bf2f(rvt[jj]) * (MODE == 0 ? DTV[8 * tgv + jj] : 1.f);
            *(LAS u32x4*)(Vt + vx * CS_SLD + 8 * tgv) = pack8(vt8);
        }
        if (c + 1 < nch) load_raw(c + 1);
        const int tt = w >> 1;
#pragma unroll
        for (int sj = 0; sj < 2; ++sj) { const int st = 2 * (w & 1) + sj; u32x2 wv; wv.x = 0u; wv.y = 0u;
            if (st <= tt) { f32x4 acc = (f32x4){0.f, 0.f, 0.f, 0.f};
#pragma unroll
                for (int kk = 0; kk < 4; ++kk) acc = __builtin_amdgcn_mfma_f32_16x16x32_bf16(lds_frag(Ks + (16 * st + fr) * CS_QLD + 32 * kk + 8 * fq), lds_frag(Qs + (16 * tt + fr) * CS_QLD + 32 * kk + 8 * fq), acc, 0, 0, 0);
                const int tg = 16 * tt + fr, sg = 16 * st + 4 * fq;
                if (MODE != 1) { const float bt = BV[tg]; const f32x4 bs = *(LAS f32x4*)(BV + sg);
#pragma unroll
                    for (int e = 0; e < 4; ++e) acc[e] *= __expf(fminf(bt - bs[e], 0.f)); }
#pragma unroll
                for (int e = 0; e < 4; ++e) acc[e] = (sg + e <= tg) ? acc[e] : 0.f;
                wv.x = pk2(acc[0], acc[1]); wv.y = pk2(acc[2], acc[3]); }
            *(LAS u32x2*)(Ps + (16 * tt + fr) * CS_SLD + 16 * st + 4 * fq) = wv; }
        __syncthreads();
        {
            const int tg = 16 * tt + fr; const int stp = c * 64 + tg; const int m = base + (dir ? (T - 1 - stp) : stp);
            const float ebt = MODE == 1 ? 1.f : __expf(BV[tg]);
            bf16x8 pf[2], qf[4];
#pragma unroll
            for (int ks2 = 0; ks2 < 2; ++ks2) pf[ks2] = lds_frag(Ps + tg * CS_SLD + 32 * ks2 + 8 * fq);
#pragma unroll
            for (int kk = 0; kk < 4; ++kk) qf[kk] = lds_frag(Qs + tg * CS_QLD + 32 * kk + 8 * fq);
            float rden = 1.f;
            if (MODE == 2) { f32x4 ai = (f32x4){0.f, 0.f, 0.f, 0.f}, ao = (f32x4){0.f, 0.f, 0.f, 0.f};
#pragma unroll
                for (int ks2 = 0; ks2 < 2; ++ks2) ai = __builtin_amdgcn_mfma_f32_16x16x32_bf16(lds_frag(Vt + (64 + fr) * CS_SLD + 32 * ks2 + 8 * fq), pf[ks2], ai, 0, 0, 0);
#pragma unroll
                for (int kk = 0; kk < 4; ++kk) ao = __builtin_amdgcn_mfma_f32_16x16x32_bf16(lds_frag(St + (64 + fr) * CS_QLD + 32 * kk + 8 * fq), qf[kk], ao, 0, 0, 0);
                const float den = __shfl(ai[0] + ao[0] * ebt, fr); rden = 1.f / fmaxf(fabsf(den), 1.f); }
#pragma unroll
            for (int vj = 0; vj < 2; ++vj) { const int vt = 2 * (w & 1) + vj; f32x4 ai = (f32x4){0.f, 0.f, 0.f, 0.f}, ao = (f32x4){0.f, 0.f, 0.f, 0.f};
#pragma unroll
                for (int ks2 = 0; ks2 < 2; ++ks2) ai = __builtin_amdgcn_mfma_f32_16x16x32_bf16(lds_frag(Vt + (16 * vt + fr) * CS_SLD + 32 * ks2 + 8 * fq), pf[ks2], ai, 0, 0, 0);
#pragma unroll
                for (int kk = 0; kk < 4; ++kk) ao = __builtin_amdgcn_mfma_f32_16x16x32_bf16(lds_frag(St + (16 * vt + fr) * CS_QLD + 32 * kk + 8 * fq), qf[kk], ao, 0, 0, 0);
                u32x2 wv; wv.x = pk2((ai[0] + ao[0] * ebt) * rden, (ai[1] + ao[1] * ebt) * rden); wv.y = pk2((ai[2] + ao[2] * ebt) * rden, (ai[3] + ao[3] * ebt) * rden);
                *(u32x2*)(Y + (size_t)m * YLD + ycol0 + 16 * vt + 4 * fq) = wv; }
        }
        {
            f32x4 dec; if (MODE == 1) dec = *(LAS f32x4*)(TOT + 4 * 128 + 16 * w + 4 * fq); else { const float d = __expf(BV[63]); dec = (f32x4){d, d, d, d}; }
            bf16x8 kf[2];
#pragma unroll
            for (int ks2 = 0; ks2 < 2; ++ks2) kf[ks2] = lds_frag(Kt + (16 * w + fr) * CS_SLD + 32 * ks2 + 8 * fq);
#pragma unroll
            for (int vt = 0; vt < NVT; ++vt) { Sacc[vt] = Sacc[vt] * dec;
#pragma unroll
                for (int ks2 = 0; ks2 < 2; ++ks2) Sacc[vt] = __builtin_amdgcn_mfma_f32_16x16x32_bf16(kf[ks2], lds_frag(Vt + (16 * vt + fr) * CS_SLD + 32 * ks2 + 8 * fq), Sacc[vt], 0, 0, 0); }
        }
        __syncthreads();
#pragma unroll
        for (int vt = 0; vt < NVT; ++vt) { u32x2 wv; wv.x = pk2(Sacc[vt][0], Sacc[vt][1]); wv.y = pk2(Sacc[vt][2], Sacc[vt][3]); *(LAS u32x2*)(St + (16 * vt + fr) * CS_QLD + 16 * w + 4 * fq) = wv; }
    }
    if (s < 16) {
        float* o; int kstride; float sc = 1.f;
        if (MODE == 0) { o = P.out + O_SSD + ((size_t)((s * 2 + j) * 2 + dir) * 16 + h) * 8192; kstride = 64; }
        else { o = P.out + (MODE == 1 ? O_GLA : O_MC) + ((size_t)((s * 2 + j) * 2 + dir) * 4 + h) * 32768 + vs * 64; kstride = 256; }
        if (MODE == 2) { __syncthreads(); sc = __expf(-MS[0]); }
#pragma unroll
        for (int vt = 0; vt < 4; ++vt)
#pragma unroll
            for (int e = 0; e < 4; ++e) o[(size_t)(16 * w + 4 * fq + e) * kstride + 16 * vt + fr] = Sacc[vt][e] * sc;
        if (MODE == 2 && vs == 0) {
            if (fr == 0) {
#pragma unroll
                for (int e = 0; e < 4; ++e) P.out[O_MN + ((size_t)((s * 2 + j) * 2 + dir) * 4 + h) * 128 + 16 * w + 4 * fq + e] = Sacc[NVT - 1][e] * sc; }
            if (tid == 0) P.out[O_MM + ((s * 2 + j) * 2 + dir) * 4 + h] = MS[0]; }
    }
}

struct RwOps { f32x4 kk0, kk1, w0, w1, kd0, kd1, ka0, ka1, r0, r1; f32x2 vv; };
__device__ __forceinline__ RwOps rw_ops(const LAS float* B, int tt, int kg, int vg) {
    const LAS float* p = B + tt * 64 + 4 * kg; RwOps o;
    o.kk0 = *(const LAS f32x4*)(p + 4096); o.kk1 = *(const LAS f32x4*)(p + 4096 + 32); o.w0 = *(const LAS f32x4*)(p + 1024); o.w1 = *(const LAS f32x4*)(p + 1024 + 32);
    o.kd0 = *(const LAS f32x4*)(p + 2048); o.kd1 = *(const LAS f32x4*)(p + 2048 + 32); o.ka0 = *(const LAS f32x4*)(p + 5120); o.ka1 = *(const LAS f32x4*)(p + 5120 + 32);
    o.r0 = *(const LAS f32x4*)(p); o.r1 = *(const LAS f32x4*)(p + 32); o.vv = *(const LAS f32x2*)(B + 3072 + tt * 64 + 2 * vg); return o;
}
__device__ __forceinline__ void rwkv_pair(const Params& P, const Ctx& C, int j, int bq, bool lng) {
    const int niter = lng ? 64 : 32; const bool act = !lng || C.tid < 256;
    const int tid = C.tid, half = tid >> 8, tl = tid & 255, kg = tl & 7, vg = tl >> 3;
    const bf16_t* PREP = (const bf16_t*)(P.ws + WS_PREP); const bf16_t* LOUT = (const bf16_t*)(P.ws + WS_PROJ);
    constexpr int BUFSZ = 6 * 1024;
    LAS float* L0 = (LAS float*)C.lds + half * 2 * BUFSZ;
    const int stt = tl >> 4, sc4 = (tl & 15) * 4;
    auto unit_of = [&](int cc, int& s, int& dir, int& h, int& lc) {
        if (lng) { s = 16 + (bq >> 5); dir = (bq >> 4) & 1; h = bq & 15; lc = cc; }
        else { const int q = 4 * bq + 2 * half + (cc >> 4); s = q >> 5; dir = (q >> 4) & 1; h = q & 15; lc = cc & 15; } };
    f32x2 S2[8];
    auto init_state = [&](int s, int dir, int h) {
        const float* s0 = s >= 16 ? P.in[I_SRWKV] + (((size_t)(((s - 16) * 2 + j) * 2 + dir) * 16 + h) * 64 + 2 * vg) * 64 : nullptr;
#pragma unroll
        for (int hh = 0; hh < 2; ++hh) { const f32x4 u0 = s0 ? *(const f32x4*)(s0 + 32 * hh + 4 * kg) : (f32x4){0.f, 0.f, 0.f, 0.f}, u1 = s0 ? *(const f32x4*)(s0 + 64 + 32 * hh + 4 * kg) : (f32x4){0.f, 0.f, 0.f, 0.f};
#pragma unroll
            for (int e = 0; e < 4; ++e) S2[hh * 4 + e] = (f32x2){u0[e], u1[e]}; } };
    u32x2 rr, rk, rv, rkk, rwl, ral; f32x4 cw0, ca0, cka;
    auto load_raw = [&](int cc) {
        int s, dir, h, lc; unit_of(cc, s, dir, h, lc);
        const int T = s < 16 ? 256 : 1024, base = s < 16 ? s * 256 : 4096 + (s - 16) * 1024;
        const int step = lc * 16 + stt; const int m = base + (dir ? (T - 1 - step) : step);
        const bf16_t* pp = PREP + (size_t)m * PREP_LD + h * 64 + sc4; const bf16_t* lo = LOUT + (size_t)m * LOUT_LD + dir * 1024 + h * 64 + sc4;
        rr = *(const u32x2*)(pp + 3072); rk = *(const u32x2*)(pp + 4096); rv = *(const u32x2*)(pp + 5120); rkk = *(const u32x2*)(pp + 6144);
        rwl = *(const u32x2*)lo; ral = *(const u32x2*)(lo + 2048);
        cw0 = *(const f32x4*)(P.in[I_W0] + (j * 2 + dir) * 1024 + h * 64 + sc4); ca0 = *(const f32x4*)(P.in[I_A0] + (j * 2 + dir) * 1024 + h * 64 + sc4); cka = *(const f32x4*)(P.in[I_KA] + j * 1024 + h * 64 + sc4);
    };
    auto write_lds = [&](LAS float* B) {
        const f32x4 r = unpack4(rr), k = unpack4(rk), v = unpack4(rv), kk = unpack4(rkk), wl = unpack4(rwl), al = unpack4(ral);
        f32x4 w, kd, kka;
#pragma unroll
        for (int e = 0; e < 4; ++e) { const float wp = cw0[e] + wl[e]; const float lw = -__expf(-softplusf_(-wp) - 0.5f); w[e] = __expf(lw);
            const float a = sigmoidf_(ca0[e] + al[e]); kd[e] = k[e] * (1.f + (a - 1.f) * cka[e]); kka[e] = kk[e] * a; }
        LAS float* p = B + stt * 64 + sc4;
        *(LAS f32x4*)(p) = r; *(LAS f32x4*)(p + 1024) = w; *(LAS f32x4*)(p + 2048) = kd; *(LAS f32x4*)(p + 3072) = v; *(LAS f32x4*)(p + 4096) = kk; *(LAS f32x4*)(p + 5120) = kka;
    };
    __syncthreads();
    if (act) { load_raw(0); write_lds(L0);
    { int s, dir, h, lc; unit_of(0, s, dir, h, lc); init_state(s, dir, h); } }
    __syncthreads();
#pragma unroll 1
    for (int cc = 0; cc < niter; ++cc) {
        if (act) {
        LAS float* B = L0 + (cc & 1) * BUFSZ;
        int s, dir, h, lc; unit_of(cc, s, dir, h, lc);
        const int T = s < 16 ? 256 : 1024, base = s < 16 ? s * 256 : 4096 + (s - 16) * 1024;
        if (cc + 1 < niter) load_raw(cc + 1);
        bf16_t* Y = (bf16_t*)(P.ws + WS_MP) + (size_t)dir * MTOK * YLD + 1024 + h * 64 + 2 * vg;
        RwOps cur = rw_ops(B, 0, kg, vg);
#pragma unroll 2
        for (int tt = 0; tt < 16; ++tt) {
            const RwOps nx = rw_ops(B, (tt + 1) & 15, kg, vg);
            const int step = lc * 16 + tt; const int m = base + (dir ? (T - 1 - step) : step);
            f32x2 da = (f32x2){0.f, 0.f}, db = (f32x2){0.f, 0.f};
#pragma unroll
            for (int e = 0; e < 4; ++e) { da = da + S2[e] * (f32x2){cur.kk0[e], cur.kk0[e]}; db = db + S2[4 + e] * (f32x2){cur.kk1[e], cur.kk1[e]}; }
            const f32x2 d2 = da + db;
            f32x2 sk2; sk2.x = row_sum8(d2.x); sk2.y = row_sum8(d2.y);
            f32x2 ya = (f32x2){0.f, 0.f}, yb = (f32x2){0.f, 0.f};
#pragma unroll
            for (int e = 0; e < 4; ++e) {
                S2[e] = S2[e] * (f32x2){cur.w0[e], cur.w0[e]} - sk2 * (f32x2){cur.ka0[e], cur.ka0[e]} + cur.vv * (f32x2){cur.kd0[e], cur.kd0[e]};
                S2[4 + e] = S2[4 + e] * (f32x2){cur.w1[e], cur.w1[e]} - sk2 * (f32x2){cur.ka1[e], cur.ka1[e]} + cur.vv * (f32x2){cur.kd1[e], cur.kd1[e]};
                ya = ya + S2[e] * (f32x2){cur.r0[e], cur.r0[e]}; yb = yb + S2[4 + e] * (f32x2){cur.r1[e], cur.r1[e]}; }
            const f32x2 y2 = ya + yb;
            const float y0 = row_sum8(y2.x), y1 = row_sum8(y2.y);
            if (kg == 0) *(unsigned*)(Y + (size_t)m * YLD) = pg8::cvt_pk_bf16(y0, y1);
            cur = nx;
        }
        const int nchU = lng ? 64 : 16;
        if (lc == nchU - 1 && s < 16) { float* o = P.out + O_RWKV + (((size_t)((s * 2 + j) * 2 + dir) * 16 + h) * 64 + 2 * vg) * 64;
#pragma unroll
            for (int hh = 0; hh < 2; ++hh) { *(f32x4*)(o + 32 * hh + 4 * kg) = (f32x4){S2[hh * 4].x, S2[hh * 4 + 1].x, S2[hh * 4 + 2].x, S2[hh * 4 + 3].x};
                *(f32x4*)(o + 64 + 32 * hh + 4 * kg) = (f32x4){S2[hh * 4].y, S2[hh * 4 + 1].y, S2[hh * 4 + 2].y, S2[hh * 4 + 3].y}; } }
        if (cc + 1 < niter) { write_lds(L0 + ((cc + 1) & 1) * BUFSZ);
            if (lc == nchU - 1) { int s2, d2_, h2, lc2; unit_of(cc + 1, s2, d2_, h2, lc2); init_state(s2, d2_, h2); } }
        }
        __syncthreads();
    }
}

__device__ __forceinline__ void scan_unit(const Params& P, const Ctx& C, int l, int type, int q) {
    const int j = l >> 1; const bool ev = (l & 1) == 0;
    int s, idx;
    if (q < 128) { s = 16 + (q >> 5); idx = q & 31; } else { const int r = q - 128; s = r >> 5; idx = r & 31; }
    if (ev) { const int dir = idx >> 4, h = idx & 15; chunk_scan<0>(P, C, j, s, dir, h, 0); }
    else { const int dir = idx >> 4, h = (idx >> 2) & 3, vs = idx & 3; if (type == 0) chunk_scan<1>(P, C, j, s, dir, h, vs); else chunk_scan<2>(P, C, j, s, dir, h, vs); }
}
__device__ __forceinline__ void phase_scan(const Params& P, const Ctx& C0, int l) {
    const int G = C0.G, bid = C0.bid; const bool ev = (l & 1) == 0;
    if (ev) {
        if (G == 256) {
            rwkv_pair(P, fresh_ctx(C0.lds), l >> 1, bid < 128 ? bid : bid - 128, bid < 128);
#pragma unroll 1
            for (int it = 0; it < 4; ++it) { if (bid < 128 && it > 0) break; const int q = bid < 128 ? bid : 128 + (bid - 128) * 4 + it; scan_unit(P, fresh_ctx(C0.lds), l, 0, q); }
        } else {
#pragma unroll 1
            for (int x = bid; x < 256 + 640; x += G) { if (x < 256) rwkv_pair(P, fresh_ctx(C0.lds), l >> 1, x < 128 ? x : x - 128, x < 128); else scan_unit(P, fresh_ctx(C0.lds), l, 0, x - 256); }
        }
        return;
    }
#pragma unroll 1
    for (int it = 0; it < 1280; ++it) {
        int type, q;
        if (G == 256) { if (bid < 128) { if (it >= 2) break; type = 1 - it; q = bid; } else { if (it >= 8) break; type = 1 - (it >> 2); q = 128 + (bid - 128) * 4 + (it & 3); } }
        else { const int x = bid + it * G; if (x >= 1280) break; type = 1 - x / 640; q = x % 640; }
        scan_unit(P, fresh_ctx(C0.lds), l, type, q);
    }
}

__device__ __forceinline__ void ld16(const bf16_t* p, float* o) { unpack8(*(const u32x4*)p, o); unpack8(*(const u32x4*)(p + 8), o + 8); }
__device__ __forceinline__ void ld16f(const float* p, float* o) {
#pragma unroll
    for (int q = 0; q < 4; ++q) { const f32x4 v = *(const f32x4*)(p + 4 * q); o[4 * q] = v.x; o[4 * q + 1] = v.y; o[4 * q + 2] = v.z; o[4 * q + 3] = v.w; } }
__device__ __forceinline__ void st16(bf16_t* p, const float* o) { *(u32x4*)p = pack8(o); *(u32x4*)(p + 8) = pack8(o + 8); }
__device__ __forceinline__ void phase_post(const Params& P, const Ctx& C, int l) {
    const int j = l >> 1; const bool ev = (l & 1) == 0;
    const bf16_t* PROJ = (const bf16_t*)(P.ws + WS_PROJ); const bf16_t* PREP = (const bf16_t*)(P.ws + WS_PREP);
    const bf16_t* Y0 = (const bf16_t*)(P.ws + WS_MP); const bf16_t* Y1 = Y0 + (size_t)MTOK * YLD; bf16_t* MIX = (bf16_t*)(P.ws + WS_MIX);
    const int gw = C.bid * 8 + C.wave, NGW = C.G * 8, lane = C.lane, c0 = lane * 16;
    for (int m = gw; m < MTOK; m += NGW) {
        float ya[16], yb[16], t0[16], t1[16], o[16];
        if (ev) {
            const bf16_t* pp = PREP + (size_t)m * PREP_LD;
            ld16(Y0 + (size_t)m * YLD + c0, ya); ld16(Y1 + (size_t)m * YLD + c0, yb); ld16(pp + c0, t0); ld16(pp + 2048 + c0, t1);
            const float dsk = P.in[I_SSDD][j * 16 + (lane >> 2)]; float ss = 0.f;
#pragma unroll
            for (int e = 0; e < 16; ++e) { o[e] = (ya[e] + yb[e] + t0[e] * dsk) * t1[e]; ss += o[e] * o[e]; }
            const float rs = rsqrtf(wave_sum(ss) * (1.f / 1024.f) + 1e-6f);
            ld16f(P.in[I_SSDN] + j * 1024 + c0, t0);
#pragma unroll
            for (int e = 0; e < 16; ++e) o[e] = o[e] * rs * t0[e];
            st16(MIX + (size_t)m * 2048 + c0, o);
            ld16(Y0 + (size_t)m * YLD + 1024 + c0, ya); ld16(Y1 + (size_t)m * YLD + 1024 + c0, yb);
            float mu = 0.f;
#pragma unroll
            for (int e = 0; e < 16; ++e) { ya[e] += yb[e]; mu += ya[e]; }
            mu += __shfl_xor(mu, 1); mu += __shfl_xor(mu, 2); mu *= (1.f / 64.f);
            float var = 0.f;
#pragma unroll
            for (int e = 0; e < 16; ++e) { ya[e] -= mu; var += ya[e] * ya[e]; }
            var += __shfl_xor(var, 1); var += __shfl_xor(var, 2); var *= (1.f / 64.f);
            const float rstd = rsqrtf(var + 64e-5f);
            ld16f(P.in[I_LNW] + j * 1024 + c0, t0); ld16f(P.in[I_LNB] + j * 1024 + c0, t1);
#pragma unroll
            for (int e = 0; e < 16; ++e) o[e] = ya[e] * rstd * t0[e] + t1[e];
            ld16(pp + 3072 + c0, ya); ld16(pp + 4096 + c0, yb); ld16f(P.in[I_RK] + j * 1024 + c0, t0);
            float bs = 0.f;
#pragma unroll
            for (int e = 0; e < 16; ++e) bs += ya[e] * yb[e] * t0[e];
            bs += __shfl_xor(bs, 1); bs += __shfl_xor(bs, 2);
            ld16(pp + 5120 + c0, ya); ld16(PROJ + (size_t)m * LOUT_LD + 4096 + c0, yb);
#pragma unroll
            for (int e = 0; e < 16; ++e) o[e] = (o[e] + bs * ya[e]) * yb[e];
            st16(MIX + (size_t)m * 2048 + 1024 + c0, o);
        } else {
            const bf16_t* pr = PROJ + (size_t)m * PROJ_LD_CD;
#pragma unroll
            for (int g = 0; g < 2; ++g) {
                ld16(Y0 + (size_t)m * YLD + g * 1024 + c0, ya); ld16(Y1 + (size_t)m * YLD + g * 1024 + c0, yb);
                float ss = 0.f;
#pragma unroll
                for (int e = 0; e < 16; ++e) { ya[e] += yb[e]; ss += ya[e] * ya[e]; }
                ss += __shfl_xor(ss, 1); ss += __shfl_xor(ss, 2); ss += __shfl_xor(ss, 4); ss += __shfl_xor(ss, 8);
                const float rs = rsqrtf(ss * (1.f / 256.f) + 1e-6f);
                ld16f((g == 0 ? P.in[I_GLAN] : P.in[I_MLN]) + j * 1024 + c0, t0);
                ld16(pr + (g == 0 ? 2048 : IN_GLA + 2048) + c0, t1);
#pragma unroll
                for (int e = 0; e < 16; ++e) o[e] = ya[e] * rs * t0[e] * (g == 0 ? siluf_(t1[e]) : sigmoidf_(t1[e]));
                st16(MIX + (size_t)m * 2048 + g * 1024 + c0, o);
            }
        }
    }
}

__global__ void __launch_bounds__(512, 2) hybrid_fwd(Params P) {
    extern __shared__ __attribute__((aligned(16))) unsigned char lds_raw[];
    cg::grid_group grid = cg::this_grid();
    Ctx C; C.lds = (LAS unsigned char*)lds_raw; C.tid = threadIdx.x; C.lane = C.tid & 63; C.wave = __builtin_amdgcn_readfirstlane(C.tid >> 6); C.G = gridDim.x; C.bid = blockIdx.x;
    const float* MOD = (const float*)(P.ws + WS_MOD);
    const bf16_t* H = (const bf16_t*)(P.ws + WS_H);
    if (C.tid < 4) ((volatile LAS unsigned*)(C.lds + LDS_BYTES - 16))[C.tid] = 0u;
    __syncthreads();
    const XcdBarrier xb = xcd_barrier_post((unsigned*)(P.ws + WS_CTL), (volatile LAS unsigned*)(C.lds + LDS_BYTES - 16));
    REP(1) if (PH & 1) phase_mod(P, fresh_ctx(C.lds));
    REP(2) if (PH & 2) phase_convert(P, fresh_ctx(C.lds), 0);
    grid.sync();
    if (PH & 4) phase_rows(P, fresh_ctx(C.lds), 0, nullptr, nullptr, true, P.in[I_NORMG] + 0, MOD + 0);
    GSYNC();
#pragma unroll 1
    for (int l = 0; l < 4; ++l) {
        const bool ev = (l & 1) == 0; const float* modl = MOD + (size_t)l * 5 * 6144; const float* ng = P.in[I_NORMG] + l * 4 * 1024;
        REP(8) if (PH & 8) { pg8::Gemm g{H, (const bf16_t*)(P.ws + WS_WIN), 1024, 1024, 1024}; pg8::Sched<0> S; S.init(MTOK, ev ? N_AB_P : N_CD_P, 1, 1024, C.G, C.bid);
          pg8::EpiBf16<0> E{(bf16_t*)(P.ws + WS_PROJ), ev ? PROJ_LD_AB : PROJ_LD_CD, 0}; pg8::gemm_phase(C.lds, g, S, E); }
        GSYNC();
        REP(16) if (PH & 16) { if (ev) phase_prep_even(P, fresh_ctx(C.lds), l >> 1); else phase_prep_odd(P, fresh_ctx(C.lds), l >> 1); }
        GSYNC();
        if (ev && (PH & 32)) {
            REP(32) {
            pg8::Gemm g{(const bf16_t*)(P.ws + WS_LORAA), (const bf16_t*)(P.ws + WS_WLORA), LORA_K, 128, 128}; pg8::Sched<1> S; S.init(MTOK, LOUT_LD, 1, 128, C.G, C.bid);
            pg8::EpiBf16<0> E{(bf16_t*)(P.ws + WS_PROJ), LOUT_LD, 0}; pg8::gemm_phase(C.lds, g, S, E); }
            GSYNC();
        }
        for (int rep_ = 0; rep_ < (((DUP & 64) && ev) || ((DUP & 0x4000) && !ev) ? 2 : 1); ++rep_) if (PH & 64) phase_scan(P, fresh_ctx(C.lds), l);
        GSYNC();
        REP(128) if (PH & 128) phase_post(P, fresh_ctx(C.lds), l);
        GSYNC();
        REP(256) if (PH & 256) { pg8::Gemm g{(const bf16_t*)(P.ws + WS_MIX), (const bf16_t*)(P.ws + WS_WOUT), 2048, 2048, 1024}; pg8::Sched<0> S; S.init(MTOK, 1024, 2, 1024, C.G, C.bid);
          pg8::EpiBf16<0> E{(bf16_t*)(P.ws + WS_MP), 1024, (size_t)MTOK * 1024}; pg8::gemm_phase(C.lds, g, S, E); }
        GSYNC();
        if (DUP & 512) phase_rows(P, fresh_ctx(C.lds), 1, ng + 1024, modl + 2048, true, ng + 2048, modl + 3072, true);
        if (PH & 512) phase_rows(P, fresh_ctx(C.lds), 1, ng + 1024, modl + 2048, true, ng + 2048, modl + 3072);
        GSYNC();
        REP(1024) if (PH & 1024) { pg8::Gemm g{H, (const bf16_t*)(P.ws + WS_WUP), 1024, 1024, 1024}; pg8::Sched<0> S; S.init(MTOK, 4096, 1, 1024, C.G, C.bid);
          pg8::EpiBf16<2> E{(bf16_t*)(P.ws + WS_PROJ), 4096, 0}; pg8::gemm_phase(C.lds, g, S, E); }
        GSYNC();
        REP(2048) if (PH & 2048) { pg8::Gemm g{(const bf16_t*)(P.ws + WS_PROJ), (const bf16_t*)(P.ws + WS_WDN), 4096, 4096, 2048}; pg8::Sched<0> S; S.init(MTOK, 1024, 2, 2048, C.G, C.bid);
          pg8::EpiBf16<0> E{(bf16_t*)(P.ws + WS_MP), 1024, (size_t)MTOK * 1024}; pg8::gemm_phase(C.lds, g, S, E); }
        GSYNC();
        if (DUP & 4096) phase_rows(P, fresh_ctx(C.lds), 1, ng + 3072, modl + 5120, true, ng + 2048, modl + 3072, true);
        if (PH & 4096) { if (l < 3) { phase_rows(P, fresh_ctx(C.lds), 1, ng + 3072, modl + 5120, true, ng + 4096, modl + 5 * 6144); phase_convert(P, fresh_ctx(C.lds), l + 1); }
        else phase_rows(P, fresh_ctx(C.lds), 1, ng + 3072, modl + 5120, false, nullptr, nullptr); }
        if (l < 3) GSYNC();
    }
}

extern "C" void kernel_launch(void* const* d_in, const int* in_sizes, int n_in, void* d_out, int out_size, void* d_ws, size_t ws_size, hipStream_t stream) {
    static int grid = 0;
    if (grid == 0) {
        if (n_in != 44 || ws_size < WS_END) { fprintf(stderr, "kernel_launch: unexpected n_in %d / ws %zu\n", n_in, ws_size); grid = -1; return; }
        int dev = 0, cus = 0, per_cu = 0;
        hipGetDevice(&dev); hipDeviceGetAttribute(&cus, hipDeviceAttributeMultiprocessorCount, dev);
        if (hipFuncSetAttribute((const void*)hybrid_fwd, hipFuncAttributeMaxDynamicSharedMemorySize, LDS_BYTES) != hipSuccess) { fprintf(stderr, "hipFuncSetAttribute failed\n"); grid = -1; return; }
        hipOccupancyMaxActiveBlocksPerMultiprocessor(&per_cu, (const void*)hybrid_fwd, 512, LDS_BYTES);
        (void)hipGetLastError();
        if (per_cu < 1) per_cu = 1;
        grid = cus * 1;
    }
    if (grid < 0) return;
    if (hipMemsetAsync((char*)d_ws + WS_CTL, 0, CTL_BYTES, stream) != hipSuccess) { fprintf(stderr, "memset failed\n"); return; }
    Params p{};
    for (int i = 0; i < 44; ++i) p.in[i] = (const float*)d_in[i];
    p.out = (float*)d_out; p.ws = (unsigned char*)d_ws;
    void* args[] = {&p};
    hipError_t e = hipLaunchCooperativeKernel((const void*)hybrid_fwd, dim3(grid), dim3(512), args, LDS_BYTES, stream);
    if (e != hipSuccess) fprintf(stderr, "cooperative launch failed: %s (grid %d)\n", hipGetErrorString(e), grid);
}
```

```cpp
#include <hip/hip_runtime.h>
#include <hip/hip_cooperative_groups.h>
#include <cstdio>
#include <cstdint>
namespace cg = cooperative_groups;

#define LAS __attribute__((address_space(3)))
typedef unsigned short bf16_t;
typedef short bf16x8 __attribute__((ext_vector_type(8)));
typedef float f32x4 __attribute__((ext_vector_type(4)));
typedef float f32x2 __attribute__((ext_vector_type(2)));
typedef unsigned u32x4 __attribute__((ext_vector_type(4)));
typedef unsigned u32x2 __attribute__((ext_vector_type(2)));

constexpr int MTOK = 8192, DM = 1024, DFF = 4096;
constexpr int N_AB = 6560, N_AB_P = 6656, N_CD = 6192, N_CD_P = 6400;
constexpr int PROJ_LD_AB = N_AB_P, PROJ_LD_CD = N_CD_P;
constexpr int PREP_LD = 7168, LOUT_LD = 5120, LORA_K = 384, YLD = 2048;
constexpr int IN_SSD = 3104, IN_GLA = 3104;
constexpr size_t MiB = 1u << 20;
constexpr size_t WS_MOD = 0, WS_CTL = 512 * 1024, CTL_BYTES = 16384, WS_DT = 1 * MiB, WS_DA = 3 * MiB, WS_WIN = 5 * MiB, WS_WOUT = 19 * MiB, WS_WUP = 23 * MiB, WS_WDN = 31 * MiB,
                 WS_WLORA = 39 * MiB, WS_H = 41 * MiB, WS_PROJ = 57 * MiB, WS_PREP = 161 * MiB, WS_MIX = 273 * MiB, WS_MP = 305 * MiB,
                 WS_LORAA = 369 * MiB, WS_END = 375 * MiB;
constexpr size_t O_X = 0, O_SSD = 8388608, O_RWKV = 16777216, O_GLA = 20971520, O_MC = 29360128, O_MN = 37748736, O_MM = 37781504;

struct Params { const float* in[44]; float* out; unsigned char* ws; };
enum { I_XP = 0, I_XS, I_SSSD, I_SRWKV, I_SGLA, I_SMC, I_SMN, I_SMM, I_C, I_CCTX, I_WMOD, I_BMOD, I_NORMG, I_WUP, I_WDN, I_WINAB, I_SCONVW, I_SCONVB,
       I_DTB, I_ALOG, I_SSDD, I_SSDN, I_MU, I_W0, I_W2, I_A0, I_A2, I_G2, I_KK, I_KA, I_RK, I_LNW, I_LNB, I_WOUTAB, I_WINCD, I_GGW, I_GGB, I_GLAN,
       I_MCONVW, I_MCONVB, I_MIB, I_MFB, I_MLN, I_WOUTCD };

__device__ __forceinline__ float bf2f(unsigned b) { return __uint_as_float(b << 16); }
__device__ __forceinline__ unsigned f2bf(float f) { unsigned u = __float_as_uint(f); return (u + 0x7fffu + ((u >> 16) & 1u)) >> 16; }
typedef __bf16 bf16x2_hw __attribute__((ext_vector_type(2)));
__device__ __forceinline__ unsigned pk2(float lo, float hi) { const f32x2 v = {lo, hi}; const bf16x2_hw b = __builtin_convertvector(v, bf16x2_hw); return __builtin_bit_cast(unsigned, b); }
__device__ __forceinline__ float lo16(unsigned w) { return __uint_as_float(w << 16); }
__device__ __forceinline__ float hi16(unsigned w) { return __uint_as_float(w & 0xffff0000u); }
__device__ __forceinline__ void unpack8(u32x4 w, float* o) { o[0] = lo16(w.x); o[1] = hi16(w.x); o[2] = lo16(w.y); o[3] = hi16(w.y); o[4] = lo16(w.z); o[5] = hi16(w.z); o[6] = lo16(w.w); o[7] = hi16(w.w); }
__device__ __forceinline__ f32x4 unpack4(u32x2 w) { return (f32x4){lo16(w.x), hi16(w.x), lo16(w.y), hi16(w.y)}; }
__device__ __forceinline__ u32x4 pack8(const float* o) { u32x4 w; w.x = pk2(o[0], o[1]); w.y = pk2(o[2], o[3]); w.z = pk2(o[4], o[5]); w.w = pk2(o[6], o[7]); return w; }
__device__ __forceinline__ float sigmoidf_(float x) { return 1.f / (1.f + __expf(-x)); }
__device__ __forceinline__ float siluf_(float x) { return x / (1.f + __expf(-x)); }
__device__ __forceinline__ float softplusf_(float x) { return fmaxf(x, 0.f) + __logf(1.f + __expf(-fabsf(x))); }
__device__ __forceinline__ float logsigmoidf_(float x) { return fminf(x, 0.f) - __logf(1.f + __expf(-fabsf(x))); }
__device__ __forceinline__ float tanhf_(float x) { const float e = __expf(-2.f * fabsf(x)); const float r = (1.f - e) / (1.f + e); return x < 0.f ? -r : r; }
__device__ __forceinline__ float wave_sum(float v) {
#pragma unroll
    for (int o = 1; o < 64; o <<= 1) v += __shfl_xor(v, o);
    return v;
}
__device__ __forceinline__ float quad_sum(float x) {
    x += __int_as_float(__builtin_amdgcn_update_dpp(0, __float_as_int(x), 0xB1, 0xF, 0xF, true));
    x += __int_as_float(__builtin_amdgcn_update_dpp(0, __float_as_int(x), 0x4E, 0xF, 0xF, true));
    return x;
}

#define DPP_ADD(x, ctrl) ((x) + __int_as_float(__builtin_amdgcn_update_dpp(0, __float_as_int(x), (ctrl), 0xF, 0xF, true)))
__device__ __forceinline__ float row_sum8(float x) { x = DPP_ADD(x, 0xB1); x = DPP_ADD(x, 0x4E); x = DPP_ADD(x, 0x141); return x; }
__device__ __forceinline__ float row_sum16(float x) { x = row_sum8(x); x = DPP_ADD(x, 0x140); return x; }
namespace pg8 {
constexpr int BM = 256, BK = 64, HALF = 128, HTB = HALF * BK * 2, STAGE_BYTES = 8 * HTB, NXCD = 8, WGM = 8;
__host__ __device__ __forceinline__ int lds_byte(int r, int c) { const int st = (r >> 4) * 2 + (c >> 5), rr = r & 15, cc = c & 31, ob = rr * 64 + cc * 2; return st * 1024 + (ob ^ (((ob >> 9) & 1) << 5)); }
__host__ __device__ __forceinline__ void stage_rc(int b, int& R, int& C) { const int st = b / 1024, sb = b % 1024, swz = sb ^ (((sb >> 9) & 1) << 5); R = (st >> 1) * 16 + swz / 64; C = (st & 1) * 32 + (swz % 64) / 2; }
__host__ __device__ __forceinline__ int perm32(int rho) { const int n = rho >> 4, i = rho & 15; return 8 * (i >> 2) + 4 * n + (i & 3); }

struct Unit { int pm, pn, ks; };
struct Gemm { const bf16_t* A; const bf16_t* Bt; int lda, ldb, K; };
template <int mode> struct Sched {
    int nM, nN, nNv, nwg, G, c, K;
    __device__ void init(int M, int N, int nK, int K_, int G_, int c_) { nM = M / BM; nN = N / BM; nNv = nN * nK; nwg = nM * nNv; G = G_; c = c_; K = K_; }
    __device__ bool next(int i, Unit& u) const {
        const long L = (long)i * G + c; if (L >= nwg) return false;
        int wgid = (int)L; { const int q = nwg / NXCD, r = nwg % NXCD, xcd = wgid % NXCD, off = wgid / NXCD; wgid = (xcd < r ? xcd * (q + 1) : r * (q + 1) + (xcd - r) * q) + off; }
        const int nig = WGM * nNv, gid = wgid / nig, fm = gid * WGM, gsz = (nM - fm) < WGM ? (nM - fm) : WGM;
        u.pm = fm + ((wgid % nig) % gsz); const int pnv = (wgid % nig) / gsz; u.pn = pnv % nN; u.ks = pnv / nN; return true;
    }
    __device__ __forceinline__ size_t aoff(const Unit& u) const { if (mode == 1) { const int g = u.pn >> 2; return (size_t)(g < 2 ? 0 : (g < 4 ? 128 : 256)) * 2; } return (size_t)u.ks * K * 2; }
    __device__ __forceinline__ size_t boff(const Unit& u) const { return mode == 1 ? 0 : (size_t)u.ks * K * 2; }
};

__device__ __forceinline__ unsigned cvt_pk_bf16(float lo, float hi) { unsigned r; asm volatile("v_cvt_pk_bf16_f32 %0, %1, %2" : "=v"(r) : "v"(lo), "v"(hi)); return r; }

template <int ACT> struct EpiBf16 {
    static constexpr bool PERM = true;
    bf16_t* O; int ldc; size_t pstride;
    __device__ __forceinline__ void operator()(const f32x4 (&acc)[2][2][4][2], const Unit& u, int wr, int wc, int fr, int fq) const {
        const int row0 = u.pm * BM + wr * 64 + fr; const int col0 = u.pn * BM + wc * 32 + 8 * fq; bf16_t* Ob = O + (size_t)u.ks * pstride;
#pragma unroll
        for (int ai = 0; ai < 2; ++ai)
#pragma unroll
            for (int m = 0; m < 4; ++m) { bf16_t* rowp = Ob + (size_t)(row0 + ai * HALF + m * 16) * ldc + col0;
#pragma unroll
                for (int bj = 0; bj < 2; ++bj) { f32x4 v0 = acc[ai][bj][m][0], v1 = acc[ai][bj][m][1];
                    if (ACT == 2) {
#pragma unroll
                        for (int e = 0; e < 4; ++e) { const float a = fmaxf(v0[e], 0.f), b = fmaxf(v1[e], 0.f); v0[e] = a * a; v1[e] = b * b; } }
                    u32x4 w; w.x = cvt_pk_bf16(v0[0], v0[1]); w.y = cvt_pk_bf16(v0[2], v0[3]); w.z = cvt_pk_bf16(v1[0], v1[1]); w.w = cvt_pk_bf16(v1[2], v1[3]);
                    *(u32x4*)(rowp + bj * HALF) = w; } }
    }
};
struct EpiF32 {
    static constexpr bool PERM = false;
    float* O; int ldc; size_t pstride;
    __device__ __forceinline__ void operator()(const f32x4 (&acc)[2][2][4][2], const Unit& u, int wr, int wc, int fr, int fq) const {
        float* base = O + (size_t)u.ks * pstride; const int col0 = u.pn * BM + wc * 32 + 4 * fq;
#pragma unroll
        for (int ai = 0; ai < 2; ++ai)
#pragma unroll
            for (int m = 0; m < 4; ++m) { float* rowp = base + (size_t)(u.pm * BM + ai * HALF + wr * 64 + m * 16 + fr) * ldc + col0;
#pragma unroll
                for (int bj = 0; bj < 2; ++bj)
#pragma unroll
                    for (int n = 0; n < 2; ++n) *(f32x4*)(rowp + bj * HALF + n * 16) = acc[ai][bj][m][n]; }
    }
};

template <class Epi, class SchedT>
__device__ __forceinline__ void gemm_phase(LAS unsigned char* lds, const Gemm g, const SchedT& S, const Epi& E) {
    int tid_ = threadIdx.x; asm volatile("" : "+v"(tid_));
    const int tid = tid_, wid = __builtin_amdgcn_readfirstlane(tid >> 6), lane = tid & 63, wr = wid >> 2, wc = wid & 3, fr = lane & 15, fq = lane >> 4;
    int K_ = g.K; asm volatile("" : "+s"(K_));
    const int K = K_, nt = K / BK;
    unsigned voffA[2], voffB[2];
#pragma unroll
    for (int i = 0; i < 2; ++i) { int R, C; stage_rc(tid * 16 + i * 8192, R, C); const int Rb = Epi::PERM ? ((R & ~31) + perm32(R & 31)) : R;
        voffA[i] = (unsigned)(R * g.lda + C) * 2u; voffB[i] = (unsigned)(Rb * g.ldb + C) * 2u; }
    const size_t kstep = (size_t)(BK * 2);
    const size_t hstepA = (size_t)HALF * g.lda * 2, hstepB = (size_t)HALF * g.ldb * 2;
    const size_t tstepA = 2 * hstepA, tstepB = 2 * hstepB;
    const unsigned ldsw = (unsigned)wid * 1024u;
    const int aoff = lds_byte(wr * 64 + fr, fq * 8), boff = lds_byte(wc * 32 + fr, fq * 8);
#define PG8_SA(b, h) (((b) * 2 + (h)) * HTB)
#define PG8_SB(b, h) ((4 + (b) * 2 + (h)) * HTB)
#define PG8_STAGE(bufoff, gbase, voff) do { _Pragma("unroll") for (int _i = 0; _i < 2; ++_i) \
        __builtin_amdgcn_global_load_lds((const unsigned*)((const char*)(gbase) + (voff)[_i]), (LAS unsigned*)(lds + (bufoff) + ldsw + _i * 8192), 16, 0, 0); } while (0)
#define PG8_LDA(dst, b, h) do { _Pragma("unroll") for (int m = 0; m < 4; ++m) _Pragma("unroll") for (int k = 0; k < 2; ++k) dst[m][k] = *(const LAS bf16x8*)(lds + PG8_SA(b, h) + aoff + m * 2048 + k * 1024); } while (0)
#define PG8_LDB(dst, b, h) do { _Pragma("unroll") for (int n = 0; n < 2; ++n) _Pragma("unroll") for (int k = 0; k < 2; ++k) dst[n][k] = *(const LAS bf16x8*)(lds + PG8_SB(b, h) + boff + n * 2048 + k * 1024); } while (0)
#define PG8_MMA(ai, bj, At, Bt) do { __builtin_amdgcn_s_setprio(1); _Pragma("unroll") for (int m = 0; m < 4; ++m) _Pragma("unroll") for (int n = 0; n < 2; ++n) _Pragma("unroll") for (int k = 0; k < 2; ++k) \
        acc[ai][bj][m][n] = __builtin_amdgcn_mfma_f32_16x16x32_bf16(Bt[n][k], At[m][k], acc[ai][bj][m][n], 0, 0, 0); __builtin_amdgcn_s_setprio(0); } while (0)
#define PG8_WAIT_V(n) asm volatile("s_waitcnt vmcnt(" #n ")" ::: "memory")
#define PG8_WAIT_L(n) asm volatile("s_waitcnt lgkmcnt(" #n ")" ::: "memory")
#define PG8_BAR __builtin_amdgcn_s_barrier()
#define PG8_SCHED __builtin_amdgcn_sched_barrier(0)
    Unit cur, nxt; int ui = 0;
    if (!S.next(0, cur)) return;
    f32x4 acc[2][2][4][2];
#pragma unroll
    for (int a = 0; a < 2; ++a)
#pragma unroll
        for (int b = 0; b < 2; ++b)
#pragma unroll
            for (int m = 0; m < 4; ++m)
#pragma unroll
                for (int n = 0; n < 2; ++n) acc[a][b][m][n] = (f32x4){0.f, 0.f, 0.f, 0.f};
    bf16x8 At[4][2], B0[2][2], B1[2][2];
    const char* cA = (const char*)g.A + (size_t)cur.pm * tstepA + S.aoff(cur); const char* cB = (const char*)g.Bt + (size_t)cur.pn * tstepB + S.boff(cur);
    PG8_STAGE(PG8_SB(0, 0), cB, voffB); PG8_STAGE(PG8_SB(0, 1), cB + hstepB, voffB); PG8_STAGE(PG8_SA(0, 0), cA, voffA); PG8_STAGE(PG8_SA(0, 1), cA + hstepA, voffA);
    if (wr == 1) PG8_BAR;
    PG8_WAIT_V(2); PG8_BAR;
    PG8_STAGE(PG8_SB(1, 0), cB + kstep, voffB); PG8_STAGE(PG8_SA(1, 0), cA + kstep, voffA); PG8_STAGE(PG8_SB(1, 1), cB + hstepB + kstep, voffB);
    PG8_WAIT_V(6); PG8_BAR;
    for (;;) {
        const bool has_next = S.next(ui + 1, nxt);
        const char* nA = has_next ? (const char*)g.A + (size_t)nxt.pm * tstepA + S.aoff(nxt) : cA; const char* nB = has_next ? (const char*)g.Bt + (size_t)nxt.pn * tstepB + S.boff(nxt) : cB;
        for (int t = 0; t < nt; t += 2) {
            const bool last = (t == nt - 2);
            const char* a1 = cA + (size_t)(t + 1) * kstep;
            const char* a2 = last ? nA : cA + (size_t)(t + 2) * kstep; const char* b2 = last ? nB : cB + (size_t)(t + 2) * kstep;
            const char* a3 = a2 + kstep; const char* b3 = b2 + kstep;
            PG8_LDB(B0, 0, 0); PG8_LDB(B1, 0, 1); PG8_SCHED; PG8_LDA(At, 0, 0); PG8_STAGE(PG8_SA(1, 1), a1 + hstepA, voffA);
            PG8_WAIT_V(8); PG8_WAIT_L(0); PG8_BAR; PG8_MMA(0, 0, At, B0); PG8_MMA(0, 1, At, B1); PG8_BAR; PG8_SCHED;
            PG8_LDA(At, 0, 1); PG8_STAGE(PG8_SB(0, 0), b2, voffB); PG8_STAGE(PG8_SB(0, 1), b2 + hstepB, voffB); PG8_STAGE(PG8_SA(0, 0), a2, voffA);
            PG8_WAIT_V(8); PG8_WAIT_L(0); PG8_BAR; PG8_MMA(1, 0, At, B0); PG8_MMA(1, 1, At, B1); PG8_BAR; PG8_SCHED;
            PG8_LDB(B0, 1, 0); PG8_LDB(B1, 1, 1); PG8_SCHED; PG8_LDA(At, 1, 0); PG8_STAGE(PG8_SA(0, 1), a2 + hstepA, voffA);
            PG8_WAIT_V(8); PG8_WAIT_L(0); PG8_BAR; PG8_MMA(0, 0, At, B0); PG8_MMA(0, 1, At, B1); PG8_BAR; PG8_SCHED;
            PG8_LDA(At, 1, 1); PG8_STAGE(PG8_SB(1, 0), b3, voffB); PG8_STAGE(PG8_SB(1, 1), b3 + hstepB, voffB); PG8_STAGE(PG8_SA(1, 0), a3, voffA);
            PG8_WAIT_V(8); PG8_WAIT_L(0); PG8_BAR; PG8_MMA(1, 0, At, B0); PG8_MMA(1, 1, At, B1); PG8_BAR; PG8_SCHED;
        }
        if (wr == 0) PG8_BAR;
        E(acc, cur, wr, wc, fr, fq);
        if (!has_next) break;
#pragma unroll
        for (int a = 0; a < 2; ++a)
#pragma unroll
            for (int b = 0; b < 2; ++b)
#pragma unroll
                for (int m = 0; m < 4; ++m)
#pragma unroll
                    for (int n = 0; n < 2; ++n) acc[a][b][m][n] = (f32x4){0.f, 0.f, 0.f, 0.f};
        cur = nxt; cA = nA; cB = nB; ++ui;
        if (wr == 1) PG8_BAR;
    }
    PG8_WAIT_V(0);
    PG8_BAR;
#undef PG8_SA
#undef PG8_SB
#undef PG8_STAGE
#undef PG8_LDA
#undef PG8_LDB
#undef PG8_MMA
#undef PG8_WAIT_V
#undef PG8_WAIT_L
#undef PG8_BAR
#undef PG8_SCHED
}
}

#define XB_TMO      128
#define XB_XCNT(j)  (256  + 64 * (j))
#define XB_XSUB(j)  (1280 + 64 * (j))
#define XB_XGEN(j)  (2304 + 64 * (j))
#define XB_TOP      3328
#define XB_TOPGEN   3392
#define XCD_BAR_WORDS 3456
#define XB_SPIN_CAP (1u << 18)
__device__ __forceinline__ unsigned xb_ld(unsigned* p)              { return __hip_atomic_load(p, __ATOMIC_RELAXED, __HIP_MEMORY_SCOPE_AGENT); }
__device__ __forceinline__ unsigned xb_add(unsigned* p, unsigned v) { return __hip_atomic_fetch_add(p, v, __ATOMIC_RELAXED, __HIP_MEMORY_SCOPE_AGENT); }
__device__ __forceinline__ unsigned xb_xcc_id() { return (unsigned)__builtin_amdgcn_s_getreg((3 << 11) | 20) & 0xFu; }
#define XB_SPIN(cond, bar) do { unsigned _sp = 0; while (cond) { __builtin_amdgcn_s_sleep(1); \
    if ((++_sp & 255u) == 0u) { if (xb_ld(&(bar)[XB_TMO])) break; if (_sp > XB_SPIN_CAP) { atomicAdd(&(bar)[XB_TMO], 1u); break; } } } } while (0)
struct XcdBarrier { unsigned* bar; unsigned x; volatile LAS unsigned* st; };
__device__ __forceinline__ XcdBarrier xcd_barrier_post(unsigned* bar, volatile LAS unsigned* st) {
    XcdBarrier b; b.bar = bar; b.x = xb_xcc_id(); b.st = st;
    if (threadIdx.x == 0) (void)xb_add(&bar[XB_XCNT(b.x)], 1u);
    return b;
}
__device__ __forceinline__ void xcd_barrier_complete(unsigned* bar, unsigned x, unsigned& nloc, unsigned& nx) {
    const unsigned G = gridDim.x * gridDim.y * gridDim.z;
    unsigned sum, cnt, mine, sp = 0u;
    for (;;) {
        sum = 0u; cnt = 0u; mine = 0u;
#pragma unroll
        for (unsigned j = 0; j < 16; ++j) { const unsigned c = xb_ld(&bar[XB_XCNT(j)]); sum += c; cnt += (c > 0u) ? 1u : 0u; mine = (j == x) ? c : mine; }
        if (sum == G) break;
        __builtin_amdgcn_s_sleep(1);
        if ((++sp & 255u) == 0u) { if (xb_ld(&bar[XB_TMO])) break; if (sp > XB_SPIN_CAP) { atomicAdd(&bar[XB_TMO], 1u); break; } }
    }
    nloc = mine > 0u ? mine : 1u; nx = cnt > 0u ? cnt : 1u;
}
__device__ __forceinline__ void xcd_barrier(const XcdBarrier& b) {
    asm volatile("s_waitcnt vmcnt(0)" ::: "memory");
    __syncthreads();
    if (threadIdx.x == 0) {
        unsigned* bar = b.bar;
        __builtin_amdgcn_s_waitcnt(0);
        unsigned nloc = b.st[0], nx = b.st[1];
        if (nloc == 0u) { xcd_barrier_complete(bar, b.x, nloc, nx); b.st[0] = nloc; b.st[1] = nx; }
        const unsigned old = xb_add(&bar[XB_XSUB(b.x)], 1u);
        const unsigned gen = old / nloc;
        if (old + 1u == (gen + 1u) * nloc) {
            __builtin_amdgcn_fence(__ATOMIC_RELEASE, "agent");
            asm volatile("s_waitcnt vmcnt(0)" ::: "memory");
            const unsigned og = xb_add(&bar[XB_TOP], 1u);
            const unsigned tg = og / nx;
            if (og + 1u == (tg + 1u) * nx) xb_add(&bar[XB_TOPGEN], 1u);
            else XB_SPIN(xb_ld(&bar[XB_TOPGEN]) == tg, bar);
            __builtin_amdgcn_fence(__ATOMIC_ACQUIRE, "agent");
            xb_add(&bar[XB_XGEN(b.x)], 1u);
            asm volatile("s_waitcnt vmcnt(0)" ::: "memory");
        } else {
            XB_SPIN(xb_ld(&bar[XB_XGEN(b.x)]) == gen, bar);
            __builtin_amdgcn_fence(__ATOMIC_ACQUIRE, "agent");
            asm volatile("s_waitcnt vmcnt(0)" ::: "memory");
        }
    }
    __syncthreads();
}

constexpr int LDS_BYTES = 147456;
#ifndef PH
#define PH 0xFFFF
#endif
#ifndef DUP
#define DUP 0
#endif
#define GSYNC() do { xcd_barrier(xb); if (DUP & 0x8000) { xcd_barrier(xb); xcd_barrier(xb); } } while (0)
#define REP(bit) for (int rep_ = 0; rep_ < ((DUP & (bit)) ? 2 : 1); ++rep_)
struct Ctx { LAS unsigned char* lds; int tid, lane, wave, G, bid; };
__device__ __forceinline__ Ctx fresh_ctx(LAS unsigned char* lds) { Ctx C; int t = threadIdx.x; asm volatile("" : "+v"(t)); C.lds = lds; C.tid = t; C.lane = t & 63; C.wave = __builtin_amdgcn_readfirstlane(t >> 6); C.G = gridDim.x; C.bid = blockIdx.x; return C; }

__device__ __forceinline__ void phase_mod(const Params& P, const Ctx& C) {
    LAS float* sc = (LAS float*)C.lds; LAS float* red = sc + 5120;
    for (int i = C.tid; i < 5120; i += 512) { const int r = i >> 10, k = i & 1023; const float x = r == 0 ? P.in[I_CCTX][k] : P.in[I_C][(r - 1) * 1024 + k]; sc[i] = siluf_(x); }
    __syncthreads();
    float* MOD = (float*)(P.ws + WS_MOD);
    const int kg = C.tid >> 5, c = C.tid & 31;
    for (int tile = C.bid; tile < 768; tile += C.G) {
        const int l = tile / 192, col = (tile % 192) * 32 + c;
        const float* w = P.in[I_WMOD] + (size_t)l * 1024 * 6144 + col;
        float a0 = 0.f, a1 = 0.f, a2 = 0.f, a3 = 0.f, a4 = 0.f;
#pragma unroll 16
        for (int k = kg * 64; k < kg * 64 + 64; ++k) { const float wv = w[(size_t)k * 6144]; a0 += sc[k] * wv; a1 += sc[1024 + k] * wv; a2 += sc[2048 + k] * wv; a3 += sc[3072 + k] * wv; a4 += sc[4096 + k] * wv; }
        red[(kg * 5 + 0) * 32 + c] = a0; red[(kg * 5 + 1) * 32 + c] = a1; red[(kg * 5 + 2) * 32 + c] = a2; red[(kg * 5 + 3) * 32 + c] = a3; red[(kg * 5 + 4) * 32 + c] = a4;
        __syncthreads();
        if (C.tid < 160) { const int r = C.tid >> 5; float s = 0.f;
#pragma unroll
            for (int q = 0; q < 16; ++q) s += red[(q * 5 + r) * 32 + c];
            MOD[(size_t)(l * 5 + r) * 6144 + col] = s + P.in[I_BMOD][l * 6144 + col]; }
        __syncthreads();
    }
}

__device__ __forceinline__ void transpose_item(const float* W, int K, int N, bf16_t* WT, LAS float* scr, int item, int nblk, int lane) {
    const int kb = item / nblk, nb = item % nblk, k0 = 64 * kb, n0 = 32 * nb;
    const bool nok = (n0 + (lane & 31)) < N;
#pragma unroll 8
    for (int i = 0; i < 32; ++i) { const int kk = 2 * i + (lane >> 5); scr[kk * 33 + (lane & 31)] = nok ? W[(size_t)(k0 + kk) * N + n0 + (lane & 31)] : 0.f; }
    asm volatile("s_waitcnt lgkmcnt(0)" ::: "memory");
    const int c = lane & 7;
#pragma unroll
    for (int j = 0; j < 4; ++j) { const int n = (lane >> 3) + 8 * j; const LAS float* s = scr + (8 * c) * 33 + n;
        u32x4 o; o.x = pk2(s[0 * 33], s[1 * 33]); o.y = pk2(s[2 * 33], s[3 * 33]); o.z = pk2(s[4 * 33], s[5 * 33]); o.w = pk2(s[6 * 33], s[7 * 33]);
        *(u32x4*)(WT + (size_t)(n0 + n) * K + k0 + 8 * c) = o; }
    asm volatile("s_waitcnt lgkmcnt(0)" ::: "memory");
}
__device__ __forceinline__ void phase_convert(const Params& P, const Ctx& C, int l) {
    LAS float* scr = (LAS float*)(C.lds + 32768 + C.wave * 8704);
    const int gw = C.bid * 8 + C.wave, NGW = C.G * 8; const int j = l >> 1; const bool ev = (l & 1) == 0;
    const float* win = ev ? P.in[I_WINAB] + (size_t)j * 1024 * N_AB : P.in[I_WINCD] + (size_t)j * 1024 * N_CD;
    const float* wout = (ev ? P.in[I_WOUTAB] : P.in[I_WOUTCD]) + (size_t)j * 2048 * 1024;
    const float* wup = P.in[I_WUP] + (size_t)l * 1024 * 4096; const float* wdn = P.in[I_WDN] + (size_t)l * 4096 * 1024;
    const int N_in = ev ? N_AB : N_CD, Np = ev ? N_AB_P : N_CD_P;
    const int I0 = 16 * (Np / 32), I1 = 32 * 32, I2 = 16 * 128, I3 = 64 * 32;
    for (int it = gw; it < I0 + I1 + I2 + I3; it += NGW) {
        int r = it;
        if (r < I0) { transpose_item(win, 1024, N_in, (bf16_t*)(P.ws + WS_WIN), scr, r, Np / 32, C.lane); continue; } r -= I0;
        if (r < I1) { transpose_item(wout, 2048, 1024, (bf16_t*)(P.ws + WS_WOUT), scr, r, 32, C.lane); continue; } r -= I1;
        if (r < I2) { transpose_item(wup, 1024, 4096, (bf16_t*)(P.ws + WS_WUP), scr, r, 128, C.lane); continue; } r -= I2;
        transpose_item(wdn, 4096, 1024, (bf16_t*)(P.ws + WS_WDN), scr, r, 32, C.lane);
    }
    if (ev) {
        bf16_t* WL = (bf16_t*)(P.ws + WS_WLORA);
        for (int idx = C.bid * 512 + C.tid; idx < 5120 * 16; idx += C.G * 512) {
            const int n = idx % 5120, k8 = idx / 5120, g = n >> 10, cc = n & 1023; float o[8];
#pragma unroll
            for (int e = 0; e < 8; ++e) { const int k = k8 * 8 + e; float v = 0.f;
                if (g == 0) { if (k < 64) v = P.in[I_W2][((size_t)(j * 2 + 0) * 64 + k) * 1024 + cc]; }
                else if (g == 1) { if (k >= 64) v = P.in[I_W2][((size_t)(j * 2 + 1) * 64 + (k - 64)) * 1024 + cc]; }
                else if (g == 2) { if (k < 64) v = P.in[I_A2][((size_t)(j * 2 + 0) * 64 + k) * 1024 + cc]; }
                else if (g == 3) { if (k >= 64) v = P.in[I_A2][((size_t)(j * 2 + 1) * 64 + (k - 64)) * 1024 + cc]; }
                else v = P.in[I_G2][((size_t)j * 128 + k) * 1024 + cc];
                o[e] = v; }
            *(u32x4*)(WL + (size_t)n * 128 + k8 * 8) = pack8(o);
        }
    }
}

__device__ __forceinline__ void phase_rows(const Params& P, const Ctx& C, int mode, const float* gpost, const float* gate_mod  ,
                                           bool next, const float* gpre, const float* mod_next  , bool dummy = false) {
    float* X = P.out + O_X; const bf16_t* MP0 = (const bf16_t*)(P.ws + WS_MP); const bf16_t* MP1 = MP0 + (size_t)MTOK * DM; bf16_t* H = (bf16_t*)(P.ws + WS_H);
    const int gw = C.bid * 8 + C.wave, NGW = C.G * 8;
    for (int m = gw; m < MTOK; m += NGW) {
        const int mr = m < 4096 ? 0 : 1 + ((m - 4096) >> 10);
        f32x4 x[4];
        if (mode == 0) { const f32x4* src = (const f32x4*)(m < 4096 ? P.in[I_XP] + (size_t)m * DM : P.in[I_XS] + (size_t)(m - 4096) * DM) + C.lane;
#pragma unroll
            for (int j = 0; j < 4; ++j) x[j] = src[64 * j];
        } else {
            const f32x4* xs = (const f32x4*)(X + (size_t)m * DM) + C.lane; const u32x2* p0 = (const u32x2*)(MP0 + (size_t)m * DM) + C.lane; const u32x2* p1 = (const u32x2*)(MP1 + (size_t)m * DM) + C.lane;
            f32x4 f[4]; float ss = 0.f;
#pragma unroll
            for (int j = 0; j < 4; ++j) { x[j] = xs[64 * j]; f[j] = unpack4(p0[64 * j]) + unpack4(p1[64 * j]); ss += (f[j].x * f[j].x + f[j].y * f[j].y) + (f[j].z * f[j].z + f[j].w * f[j].w); }
            const float rs = rsqrtf(wave_sum(ss) * (1.f / DM) + 1e-6f);
            const f32x4* gp = (const f32x4*)gpost + C.lane; const f32x4* gt = (const f32x4*)(gate_mod + (size_t)mr * 6144) + C.lane;
#pragma unroll
            for (int j = 0; j < 4; ++j) x[j] = x[j] + gt[64 * j] * (f[j] * rs * gp[64 * j]);
        }
        f32x4* xo = (f32x4*)((dummy ? (float*)(P.ws + WS_PREP) : X) + (size_t)m * DM) + C.lane;
#pragma unroll
        for (int j = 0; j < 4; ++j) xo[64 * j] = x[j];
        if (next) {
            float ss = 0.f;
#pragma unroll
            for (int j = 0; j < 4; ++j) ss += (x[j].x * x[j].x + x[j].y * x[j].y) + (x[j].z * x[j].z + x[j].w * x[j].w);
            const float rs = rsqrtf(wave_sum(ss) * (1.f / DM) + 1e-6f);
            const f32x4* gp = (const f32x4*)gpre + C.lane; const f32x4* sh = (const f32x4*)(mod_next + (size_t)mr * 6144) + C.lane; const f32x4* sl = (const f32x4*)(mod_next + (size_t)mr * 6144 + 1024) + C.lane;
            u32x2* ho = (u32x2*)((dummy ? (bf16_t*)(P.ws + WS_PREP + 40 * MiB) : H) + (size_t)m * DM) + C.lane;
#pragma unroll
            for (int j = 0; j < 4; ++j) { const f32x4 h = (x[j] * rs * gp[64 * j]) * (sl[64 * j] + 1.f) + sh[64 * j]; u32x2 w; w.x = pk2(h.x, h.y); w.y = pk2(h.z, h.w); ho[64 * j] = w; }
        }
    }
}

__device__ __forceinline__ void conv8(const bf16_t* src, int ld, int col0, int base, int t, bool samp, const float* w, const float* b, int NC, int ch, float* acc) {
    { const f32x4 b0 = *(const f32x4*)(b + ch), b1 = *(const f32x4*)(b + ch + 4); acc[0] = b0.x; acc[1] = b0.y; acc[2] = b0.z; acc[3] = b0.w; acc[4] = b1.x; acc[5] = b1.y; acc[6] = b1.z; acc[7] = b1.w; }
    if (!samp) {
#pragma unroll
        for (int d = 0; d < 3; ++d) { const int tt = t + d - 1; if (tt < 0 || tt >= 256) continue;
            float xv[8]; unpack8(*(const u32x4*)(src + (size_t)(base + tt) * ld + col0 + ch), xv);
            const f32x4 w0 = *(const f32x4*)(w + (3 + d) * NC + ch), w1 = *(const f32x4*)(w + (3 + d) * NC + ch + 4);
            acc[0] += w0.x * xv[0]; acc[1] += w0.y * xv[1]; acc[2] += w0.z * xv[2]; acc[3] += w0.w * xv[3]; acc[4] += w1.x * xv[4]; acc[5] += w1.y * xv[5]; acc[6] += w1.z * xv[6]; acc[7] += w1.w * xv[7]; }
    } else {
        const int r = t >> 6, c = t & 63;
#pragma unroll
        for (int i = 0; i < 3; ++i)
#pragma unroll
            for (int d = 0; d < 3; ++d) { const int rr = r + i - 1, cc = c + d - 1; if (rr < 0 || rr >= 16 || cc < 0 || cc >= 64) continue;
                float xv[8]; unpack8(*(const u32x4*)(src + (size_t)(base + rr * 64 + cc) * ld + col0 + ch), xv);
                const f32x4 w0 = *(const f32x4*)(w + (i * 3 + d) * NC + ch), w1 = *(const f32x4*)(w + (i * 3 + d) * NC + ch + 4);
                acc[0] += w0.x * xv[0]; acc[1] += w0.y * xv[1]; acc[2] += w0.z * xv[2]; acc[3] += w0.w * xv[3]; acc[4] += w1.x * xv[4]; acc[5] += w1.y * xv[5]; acc[6] += w1.z * xv[6]; acc[7] += w1.w * xv[7]; }
    }
}

__device__ __forceinline__ void phase_prep_even(const Params& P, const Ctx& C, int j) {
    const bf16_t* PROJ = (const bf16_t*)(P.ws + WS_PROJ); bf16_t* PREP = (bf16_t*)(P.ws + WS_PREP); bf16_t* LA = (bf16_t*)(P.ws + WS_LORAA);
    float* DT = (float*)(P.ws + WS_DT); float* DA = (float*)(P.ws + WS_DA);
    const float* cw = P.in[I_SCONVW] + (size_t)j * 9 * 2048; const float* cb = P.in[I_SCONVB] + j * 2048;
    const float* mu = P.in[I_MU] + j * 3456; const float* kkw = P.in[I_KK] + j * 1024;
    const int gw = C.bid * 8 + C.wave, NGW = C.G * 8, lane = C.lane;
    for (int m = gw; m < MTOK; m += NGW) {
        const bool samp = m >= 4096; const int T = samp ? 1024 : 256; const int t = samp ? ((m - 4096) & 1023) : (m & 255); const int base = m - t;
        const bf16_t* prow = PROJ + (size_t)m * PROJ_LD_AB; bf16_t* orow = PREP + (size_t)m * PREP_LD;
#pragma unroll 1
        for (int it = 0; it < 4; ++it) { const int ch = it * 512 + lane * 8; float acc[8];
            conv8(PROJ, PROJ_LD_AB, 1024, base, t, samp, cw, cb, 2048, ch, acc);
#pragma unroll
            for (int e = 0; e < 8; ++e) acc[e] = siluf_(acc[e]);
            *(u32x4*)(orow + ch) = pack8(acc); }
#pragma unroll
        for (int it = 0; it < 2; ++it) { const int ch = it * 512 + lane * 8; float z[8]; unpack8(*(const u32x4*)(prow + ch), z);
#pragma unroll
            for (int e = 0; e < 8; ++e) z[e] = siluf_(z[e]);
            *(u32x4*)(orow + 2048 + ch) = pack8(z); }
        if (lane < 32) { const float raw = bf2f(prow[3072 + lane]); const float dt = softplusf_(raw + P.in[I_DTB][j * 32 + lane]);
            DT[(size_t)m * 32 + lane] = dt; DA[(size_t)m * 32 + lane] = -dt * __expf(P.in[I_ALOG][j * 32 + lane]); }
        const bool hp = t > 0, hn = t < T - 1;
#pragma unroll 1
        for (int it = 0; it < 7; ++it) { const int c = it * 512 + lane * 8; if (c >= 3456) break;
            float x[8], xp[8], xn[8];
            unpack8(*(const u32x4*)(prow + IN_SSD + c), x);
            if (hp) unpack8(*(const u32x4*)(prow - PROJ_LD_AB + IN_SSD + c), xp); else {
#pragma unroll
                for (int e = 0; e < 8; ++e) xp[e] = 0.f; }
            if (hn) unpack8(*(const u32x4*)(prow + PROJ_LD_AB + IN_SSD + c), xn); else {
#pragma unroll
                for (int e = 0; e < 8; ++e) xn[e] = 0.f; }
            const f32x4 m0 = *(const f32x4*)(mu + c), m1 = *(const f32x4*)(mu + c + 4);
            const float mv[8] = {m0.x, m0.y, m0.z, m0.w, m1.x, m1.y, m1.z, m1.w};
#pragma unroll
            for (int e = 0; e < 8; ++e) x[e] = x[e] + mv[e] * (0.5f * (xp[e] + xn[e]) - x[e]);
            if (it < 2) { *(u32x4*)(orow + 3072 + c) = pack8(x); }
            else if (it < 4) { *(u32x4*)(orow + 4096 + (c - 1024)) = pack8(x);
                const f32x4 k0 = *(const f32x4*)(kkw + c - 1024), k1 = *(const f32x4*)(kkw + c - 1024 + 4);
                const float kv[8] = {k0.x, k0.y, k0.z, k0.w, k1.x, k1.y, k1.z, k1.w}; float ss = 0.f;
#pragma unroll
                for (int e = 0; e < 8; ++e) { x[e] *= kv[e]; ss += x[e] * x[e]; }
                ss += __shfl_xor(ss, 1); ss += __shfl_xor(ss, 2); ss += __shfl_xor(ss, 4);
                const float rn = rsqrtf(ss + 1e-12f);
#pragma unroll
                for (int e = 0; e < 8; ++e) x[e] *= rn;
                *(u32x4*)(orow + 6144 + (c - 1024)) = pack8(x); }
            else if (it < 6) { *(u32x4*)(orow + 5120 + (c - 2048)) = pack8(x); }
            else { const int cc = c - 3072;
#pragma unroll
                for (int e = 0; e < 8; ++e) x[e] = cc < 128 ? tanhf_(x[e]) : (cc < 256 ? x[e] : sigmoidf_(x[e]));
                *(u32x4*)(LA + (size_t)m * LORA_K + cc) = pack8(x); }
        }
    }
}
__device__ __forceinline__ void phase_prep_odd(const Params& P, const Ctx& C, int j) {
    const bf16_t* PROJ = (const bf16_t*)(P.ws + WS_PROJ); bf16_t* PREP = (bf16_t*)(P.ws + WS_PREP);
    const float* cw = P.in[I_MCONVW] + (size_t)j * 9 * 1024; const float* cb = P.in[I_MCONVB] + j * 1024;
    const int gw = C.bid * 8 + C.wave, NGW = C.G * 8, lane = C.lane;
    for (int m = gw; m < MTOK; m += NGW) {
        const bool samp = m >= 4096; const int t = samp ? ((m - 4096) & 1023) : (m & 255); const int base = m - t;
#pragma unroll 1
        for (int it = 0; it < 2; ++it) { const int ch = it * 512 + lane * 8; float acc[8];
            conv8(PROJ, PROJ_LD_CD, IN_GLA, base, t, samp, cw, cb, 1024, ch, acc);
#pragma unroll
            for (int e = 0; e < 8; ++e) acc[e] = siluf_(acc[e]);
            *(u32x4*)(PREP + (size_t)m * PREP_LD + ch) = pack8(acc); }
    }
}

constexpr int CS_QLD = 136, CS_SLD = 72;
constexpr int CS_QS = 0, CS_KS = 17408, CS_KT = 34816, CS_VT = 53248;
__device__ __forceinline__ bf16x8 lds_frag(const LAS bf16_t* p) { return *(const LAS bf16x8*)p; }
template <int MODE>
__device__ __forceinline__ void chunk_scan(const Params& P, const Ctx& C, int j, int s, int dir, int h, int vs) {
    const int tid = C.tid, lane = C.lane, w = C.wave, fr = lane & 15, fq = lane >> 4;
    const int T = s < 16 ? 256 : 1024, base = s < 16 ? s * 256 : 4096 + (s - 16) * 1024, nch = T >> 6;
    const bf16_t* PROJ = (const bf16_t*)(P.ws + WS_PROJ); const bf16_t* PREP = (const bf16_t*)(P.ws + WS_PREP);
    bf16_t* Y = (bf16_t*)(P.ws + WS_MP) + (size_t)dir * MTOK * YLD;
    LAS bf16_t* Qs = (LAS bf16_t*)(C.lds + CS_QS); LAS bf16_t* Ks = (LAS bf16_t*)(C.lds + CS_KS); LAS bf16_t* Kt = (LAS bf16_t*)(C.lds + CS_KT); LAS bf16_t* Vt = (LAS bf16_t*)(C.lds + CS_VT);
    constexpr int NV = MODE == 1 ? 128 : 64, NVC = NV / 16, VROWS = NV + (MODE == 2 ? 16 : 0);
    constexpr int CS_ST = CS_VT + VROWS * CS_SLD * 2, CS_LA = CS_ST + VROWS * CS_QLD * 2, CS_PS = CS_LA  , CS_TOT = CS_LA + 32768,
                  CS_BV = CS_TOT + 2560, CS_IG = CS_BV + 256, CS_FV = CS_IG + 256, CS_DTV = CS_FV + 256, CS_MS = CS_DTV + 256;
    static_assert(CS_MS + 64 <= LDS_BYTES - 16, "chunk-scan LDS map");
    LAS bf16_t* Ps = (LAS bf16_t*)(C.lds + CS_PS); LAS bf16_t* St = (LAS bf16_t*)(C.lds + CS_ST);
    LAS float* LA = (LAS float*)(C.lds + CS_LA); LAS float* TOT = (LAS float*)(C.lds + CS_TOT); LAS float* BV = (LAS float*)(C.lds + CS_BV); LAS float* IG = (LAS float*)(C.lds + CS_IG);
    LAS float* MS = (LAS float*)(C.lds + CS_MS); LAS float* FV = (LAS float*)(C.lds + CS_FV); LAS float* DTV = (LAS float*)(C.lds + CS_DTV);
    constexpr int NVT = NVC + (MODE == 2 ? 1 : 0);
    const int si = tid >> 3, kq = tid & 7;
    __syncthreads();
    bf16x8 gwa_hi = {0, 0, 0, 0, 0, 0, 0, 0}, gwa_lo = {0, 0, 0, 0, 0, 0, 0, 0}; f32x4 gb4 = {0.f, 0.f, 0.f, 0.f};
    if (MODE == 1) {
        const float* gwp = P.in[I_GGW] + (size_t)(j * 2 + dir) * 16 * 512 + h * 128 + 16 * w + fr;
        if (fq < 2) {
#pragma unroll
            for (int e = 0; e < 8; ++e) { const float g = gwp[(8 * fq + e) * 512]; const unsigned hb = f2bf(g); const float rem = g - bf2f(hb); gwa_hi[e] = (short)hb; gwa_lo[e] = (short)f2bf(rem); } }
        gb4 = *(const f32x4*)(P.in[I_GGB] + (j * 2 + dir) * 512 + h * 128 + 16 * w + 4 * fq);
    }
    f32x4 Sacc[NVT];
    {
        const float* s0 = nullptr; int kstride = 64; float em0 = 1.f;
        if (s >= 16) { const int b = s - 16;
            if (MODE == 0) { s0 = P.in[I_SSSD] + ((size_t)((b * 2 + j) * 2 + dir) * 16 + h) * 8192; kstride = 64; }
            if (MODE == 1) { s0 = P.in[I_SGLA] + ((size_t)((b * 2 + j) * 2 + dir) * 4 + h) * 32768 + vs * NV; kstride = 256; }
            if (MODE == 2) { s0 = P.in[I_SMC] + ((size_t)((b * 2 + j) * 2 + dir) * 4 + h) * 32768 + vs * 64; kstride = 256; em0 = __expf(P.in[I_SMM][((b * 2 + j) * 2 + dir) * 4 + h]); } }
#pragma unroll
        for (int vt = 0; vt < NVC; ++vt)
#pragma unroll
            for (int e = 0; e < 4; ++e) Sacc[vt][e] = s0 ? s0[(size_t)(16 * w + 4 * fq + e) * kstride + 16 * vt + fr] * em0 : 0.f;
        if (MODE == 2) {
            const float* n0 = s >= 16 ? P.in[I_SMN] + ((size_t)(((s - 16) * 2 + j) * 2 + dir) * 4 + h) * 128 : nullptr;
#pragma unroll
            for (int e = 0; e < 4; ++e) Sacc[NVT - 1][e] = (n0 && fr == 0) ? n0[16 * w + 4 * fq + e] * em0 : 0.f;
            if (tid == 0) MS[0] = s >= 16 ? P.in[I_SMM][(((s - 16) * 2 + j) * 2 + dir) * 4 + h] : 0.f;
            for (int i = tid; i < 16 * CS_SLD; i += 512) Vt[64 * CS_SLD + i] = (bf16_t)((i < CS_SLD) ? 0x3F80 : 0);
        }
#pragma unroll
        for (int vt = 0; vt < NVT; ++vt) { u32x2 wv; wv.x = pk2(Sacc[vt][0], Sacc[vt][1]); wv.y = pk2(Sacc[vt][2], Sacc[vt][3]); *(LAS u32x2*)(St + (16 * vt + fr) * CS_QLD + 16 * w + 4 * fq) = wv; }
    }
    u32x4 rq0, rq1, rk0, rk1, rgd[4]; float rla = 0.f, rig = 0.f, rdt = 0.f;
    constexpr int NVTOK = MODE == 1 ? 16 : 8;
    unsigned short rkt[16], rvt[NVTOK];
    const int kx = tid & 127, tgk = tid >> 7, vx = tid & (NV - 1), tgv = MODE == 1 ? (tid >> 7) : (tid >> 6);
    auto tok = [&](int c, int i) { const int st0 = c * 64 + i; return base + (dir ? (T - 1 - st0) : st0); };
    auto load_raw = [&](int c) {
        const int m = tok(c, si); const int m1 = tok(c, tid & 63);
        const bf16_t* krow; const bf16_t* vrow; int kld, vld;
        if (MODE == 0) { const int g = h >> 2; const bf16_t* pr = PREP + (size_t)m * PREP_LD;
            rq0 = *(const u32x4*)(pr + 1536 + g * 128 + 16 * kq); rq1 = *(const u32x4*)(pr + 1536 + g * 128 + 16 * kq + 8);
            rk0 = *(const u32x4*)(pr + 1024 + g * 128 + 16 * kq); rk1 = *(const u32x4*)(pr + 1024 + g * 128 + 16 * kq + 8);
            if (tid < 64) { rla = ((const float*)(P.ws + WS_DA))[(size_t)m1 * 32 + dir * 16 + h]; rdt = ((const float*)(P.ws + WS_DT))[(size_t)m1 * 32 + dir * 16 + h]; }
            krow = PREP + 1024 + g * 128 + kx; kld = PREP_LD; vrow = PREP + h * 64 + vx; vld = PREP_LD; }
        if (MODE == 1) { const bf16_t* pr = PROJ + (size_t)m * PROJ_LD_CD;
            rq0 = *(const u32x4*)(pr + h * 128 + 16 * kq); rq1 = *(const u32x4*)(pr + h * 128 + 16 * kq + 8);
            rk0 = *(const u32x4*)(pr + 512 + h * 128 + 16 * kq); rk1 = *(const u32x4*)(pr + 512 + h * 128 + 16 * kq + 8);
#pragma unroll
            for (int t4 = 0; t4 < 4; ++t4) { rgd[t4] = (u32x4){0u, 0u, 0u, 0u}; if (fq < 2) rgd[t4] = *(const u32x4*)(PROJ + (size_t)tok(c, 16 * t4 + fr) * PROJ_LD_CD + 3072 + dir * 16 + 8 * fq); }
            krow = PROJ + 512 + h * 128 + kx; kld = PROJ_LD_CD; vrow = PROJ + 1024 + h * 256 + vs * NV + vx; vld = PROJ_LD_CD; }
        if (MODE == 2) { const bf16_t* pp = PREP + (size_t)m * PREP_LD;
            rq0 = *(const u32x4*)(pp + h * 128 + 16 * kq); rq1 = *(const u32x4*)(pp + h * 128 + 16 * kq + 8);
            rk0 = *(const u32x4*)(pp + 512 + h * 128 + 16 * kq); rk1 = *(const u32x4*)(pp + 512 + h * 128 + 16 * kq + 8);
            if (tid < 64) { const bf16_t* p1 = PROJ + (size_t)m1 * PROJ_LD_CD + IN_GLA + 3072; rig = bf2f(p1[dir * 4 + h]); rla = bf2f(p1[8 + dir * 4 + h]); }
            krow = PREP + 512 + h * 128 + kx; kld = PREP_LD; vrow = PROJ + IN_GLA + 1024 + h * 256 + vs * 64 + vx; vld = PROJ_LD_CD; }
        { const bf16_t* kp = krow + (size_t)tok(c, 16 * tgk) * kld; const long ks_ = dir ? -(long)kld : (long)kld;
#pragma unroll
          for (int jj = 0; jj < 16; ++jj) { rkt[jj] = *kp; kp += ks_; }
          const bf16_t* vp = vrow + (size_t)tok(c, NVTOK * tgv) * vld; const long vs_ = dir ? -(long)vld : (long)vld;
#pragma unroll
          for (int jj = 0; jj < NVTOK; ++jj) { rvt[jj] = *vp; vp += vs_; } }
    };
    load_raw(0);
    __syncthreads();
    const int ycol0 = (MODE == 0 ? h * 64 : (MODE == 1 ? h * 256 + vs * NV : 1024 + h * 256 + vs * 64));
    for (int c = 0; c < nch; ++c) {
        if (MODE == 1) {
#pragma unroll
            for (int t4 = 0; t4 < 4; ++t4) { f32x4 acc = (f32x4){0.f, 0.f, 0.f, 0.f}; const bf16x8 gf = __builtin_bit_cast(bf16x8, rgd[t4]);
                acc = __builtin_amdgcn_mfma_f32_16x16x32_bf16(gwa_hi, gf, acc, 0, 0, 0); acc = __builtin_amdgcn_mfma_f32_16x16x32_bf16(gwa_lo, gf, acc, 0, 0, 0);
                f32x4 la;
#pragma unroll
                for (int e = 0; e < 4; ++e) la[e] = logsigmoidf_(acc[e] + gb4[e]) * 0.0625f;
                *(LAS f32x4*)(LA + (16 * t4 + fr) * 128 + 16 * w + 4 * fq) = la; }
        } else if (tid < 64) {
            float ig = 0.f, la = rla;
            if (MODE == 2) { ig = rig + P.in[I_MIB][(j * 2 + dir) * 4 + h]; la = logsigmoidf_(rla + P.in[I_MFB][(j * 2 + dir) * 4 + h]); }
            float x = la;
            x += __int_as_float(__builtin_amdgcn_update_dpp(0, __float_as_int(x), 0x111, 0xF, 0xF, true));
            x += __int_as_float(__builtin_amdgcn_update_dpp(0, __float_as_int(x), 0x112, 0xF, 0xF, true));
            x += __int_as_float(__builtin_amdgcn_update_dpp(0, __float_as_int(x), 0x114, 0xF, 0xF, true));
            x += __int_as_float(__builtin_amdgcn_update_dpp(0, __float_as_int(x), 0x118, 0xF, 0xF, true));
            { const float t0 = __int_as_float(__builtin_amdgcn_readlane(__float_as_int(x), 15)), t1 = __int_as_float(__builtin_amdgcn_readlane(__float_as_int(x), 31)), t2 = __int_as_float(__builtin_amdgcn_readlane(__float_as_int(x), 47));
              const int rw = lane >> 4; x += (rw > 0 ? t0 : 0.f) + (rw > 1 ? t1 : 0.f) + (rw > 2 ? t2 : 0.f); }
            const float bl = __int_as_float(__builtin_amdgcn_readlane(__float_as_int(x), 63));
            const float kgn = MODE == 2 ? 0.08838834764831845f * __expf(ig) : 1.f;
            BV[tid] = x; IG[tid] = kgn; FV[tid] = kgn * __expf(bl - x); DTV[tid] = MODE == 0 ? rdt : 1.f;
            if (MODE == 2) { float ml = bl - x + ig;
                ml = fmaxf(ml, __int_as_float(__builtin_amdgcn_update_dpp(__float_as_int(ml), __float_as_int(ml), 0xB1, 0xF, 0xF, false)));
                ml = fmaxf(ml, __int_as_float(__builtin_amdgcn_update_dpp(__float_as_int(ml), __float_as_int(ml), 0x4E, 0xF, 0xF, false)));
                ml = fmaxf(ml, __int_as_float(__builtin_amdgcn_update_dpp(__float_as_int(ml), __float_as_int(ml), 0x141, 0xF, 0xF, false)));
                ml = fmaxf(ml, __int_as_float(__builtin_amdgcn_update_dpp(__float_as_int(ml), __float_as_int(ml), 0x140, 0xF, 0xF, false)));
                const float m01 = fmaxf(__int_as_float(__builtin_amdgcn_readlane(__float_as_int(ml), 0)), __int_as_float(__builtin_amdgcn_readlane(__float_as_int(ml), 16)));
                const float m23 = fmaxf(__int_as_float(__builtin_amdgcn_readlane(__float_as_int(ml), 32)), __int_as_float(__builtin_amdgcn_readlane(__float_as_int(ml), 48)));
                if (tid == 0) MS[0] = fmaxf(bl + MS[0], fmaxf(m01, m23)); }
        }
        __syncthreads();
        if (MODE == 1) {
            const int k = tid & 127, qd = tid >> 7; float run = 0.f;
#pragma unroll
            for (int jj = 0; jj < 16; ++jj) { run += LA[(16 * qd + jj) * 128 + k]; LA[(16 * qd + jj) * 128 + k] = run; }
            TOT[qd * 128 + k] = run;
            __syncthreads();
            if (tid < 128) TOT[4 * 128 + tid] = __expf(TOT[tid] + TOT[128 + tid] + TOT[256 + tid] + TOT[384 + tid]);
        }
        {
            float q[16], k[16]; unpack8(rq0, q); unpack8(rq1, q + 8); unpack8(rk0, k); unpack8(rk1, k + 8);
            float qs[16], ks[16];
            if (MODE == 1) { const int qd = si >> 4;
#pragma unroll
                for (int e4 = 0; e4 < 4; ++e4) { const int kk = 16 * kq + 4 * e4; const f32x4 bb = *(LAS f32x4*)(LA + si * 128 + kk), t0 = *(LAS f32x4*)(TOT + kk), t1 = *(LAS f32x4*)(TOT + 128 + kk), t2 = *(LAS f32x4*)(TOT + 256 + kk);
#pragma unroll
                    for (int e = 0; e < 4; ++e) { const float b = bb[e] + (qd > 0 ? t0[e] : 0.f) + (qd > 1 ? t1[e] : 0.f) + (qd > 2 ? t2[e] : 0.f);
                        qs[4 * e4 + e] = q[4 * e4 + e] * 0.08838834764831845f * __expf(b); ks[4 * e4 + e] = k[4 * e4 + e] * __expf(fminf(-b, 80.f)); } }
            } else { const float kgn = IG[si];
#pragma unroll
                for (int e = 0; e < 16; ++e) { qs[e] = q[e]; ks[e] = k[e] * kgn; } }
            *(LAS u32x4*)(Qs + si * CS_QLD + 16 * kq) = pack8(qs); *(LAS u32x4*)(Qs + si * CS_QLD + 16 * kq + 8) = pack8(qs + 8);
            *(LAS u32x4*)(Ks + si * CS_QLD + 16 * kq) = pack8(ks); *(LAS u32x4*)(Ks + si * CS_QLD + 16 * kq + 8) = pack8(ks + 8);
        }
        if (MODE == 1)
        {
            float kt[16];
            if (MODE == 1) { float off = 0.f; const float t0 = TOT[kx], t1 = TOT[128 + kx], t2 = TOT[256 + kx], t3 = TOT[384 + kx];
                off = (tgk > 0 ? t0 : 0.f) + (tgk > 1 ? t1 : 0.f) + (tgk > 2 ? t2 : 0.f); const float bl = (t0 + t1) + (t2 + t3);
#pragma unroll
                for (int jj = 0; jj < 16; ++jj) kt[jj] = bf2f(rkt[jj]) * __expf(bl - (LA[(16 * tgk + jj) * 128 + kx] + off));
            } else {
#pragma unroll
                for (int jj = 0; jj < 16; ++jj) kt[jj] = bf2f(rkt[jj]) * FV[16 * tgk + jj]; }
            *(LAS u32x4*)(Kt + kx * CS_SLD + 16 * tgk) = pack8(kt); *(LAS u32x4*)(Kt + kx * CS_SLD + 16 * tgk + 8) = pack8(kt + 8);
            float vt8[NVTOK];
#pragma unroll
            for (int jj = 0; jj < NVTOK; ++jj) vt8[jj] = bf2f(rvt[jj]) * (MODE == 0 ? DTV[NVTOK * tgv + jj] : 1.f);
            *(LAS u32x4*)(Vt + vx * CS_SLD + NVTOK * tgv) = pack8(vt8);
            if (NVTOK == 16) *(LAS u32x4*)(Vt + vx * CS_SLD + NVTOK * tgv + 8) = pack8(vt8 + 8);
        }
        __syncthreads();
        if (MODE != 1)
        {
            float kt[16];
            if (MODE == 1) { float off = 0.f; const float t0 = TOT[kx], t1 = TOT[128 + kx], t2 = TOT[256 + kx], t3 = TOT[384 + kx];
                off = (tgk > 0 ? t0 : 0.f) + (tgk > 1 ? t1 : 0.f) + (tgk > 2 ? t2 : 0.f); const float bl = (t0 + t1) + (t2 + t3);
#pragma unroll
                for (int jj = 0; jj < 16; ++jj) kt[jj] = bf2f(rkt[jj]) * __expf(bl - (LA[(16 * tgk + jj) * 128 + kx] + off));
            } else {
#pragma unroll
                for (int jj = 0; jj < 16; ++jj) kt[jj] = bf2f(rkt[jj]) * FV[16 * tgk + jj]; }
            *(LAS u32x4*)(Kt + kx * CS_SLD + 16 * tgk) = pack8(kt); *(LAS u32x4*)(Kt + kx * CS_SLD + 16 * tgk + 8) = pack8(kt + 8);
            float vt8[NVTOK];
#pragma unroll
            for (int jj = 0; jj < NVTOK; ++jj) vt8[jj] = bf2f(rvt[jj]) * (MODE == 0 ? DTV[NVTOK * tgv + jj] : 1.f);
            *(LAS u32x4*)(Vt + vx * CS_SLD + NVTOK * tgv) = pack8(vt8);
            if (NVTOK == 16) *(LAS u32x4*)(Vt + vx * CS_SLD + NVTOK * tgv + 8) = pack8(vt8 + 8);
        }
        if (c + 1 < nch) load_raw(c + 1);
        const int tt = w >> 1;
#pragma unroll
        for (int sj = 0; sj < 2; ++sj) { const int st = 2 * (w & 1) + sj; u32x2 wv; wv.x = 0u; wv.y = 0u;
            if (st <= tt) { f32x4 acc = (f32x4){0.f, 0.f, 0.f, 0.f};
#pragma unroll
                for (int kk = 0; kk < 4; ++kk) acc = __builtin_amdgcn_mfma_f32_16x16x32_bf16(lds_frag(Ks + (16 * st + fr) * CS_QLD + 32 * kk + 8 * fq), lds_frag(Qs + (16 * tt + fr) * CS_QLD + 32 * kk + 8 * fq), acc, 0, 0, 0);
                const int tg = 16 * tt + fr, sg = 16 * st + 4 * fq;
                if (MODE != 1) { const float bt = BV[tg]; const f32x4 bs = *(LAS f32x4*)(BV + sg);
#pragma unroll
                    for (int e = 0; e < 4; ++e) acc[e] *= __expf(fminf(bt - bs[e], 0.f)); }
#pragma unroll
                for (int e = 0; e < 4; ++e) acc[e] = (sg + e <= tg) ? acc[e] : 0.f;
                wv.x = pk2(acc[0], acc[1]); wv.y = pk2(acc[2], acc[3]); }
            *(LAS u32x2*)(Ps + (16 * tt + fr) * CS_SLD + 16 * st + 4 * fq) = wv; }
        __syncthreads();
        {
            const int tg = 16 * tt + fr; const int stp = c * 64 + tg; const int m = base + (dir ? (T - 1 - stp) : stp);
            const float ebt = MODE == 1 ? 1.f : __expf(BV[tg]);
            bf16x8 pf[2], qf[4];
#pragma unroll
            for (int ks2 = 0; ks2 < 2; ++ks2) pf[ks2] = lds_frag(Ps + tg * CS_SLD + 32 * ks2 + 8 * fq);
#pragma unroll
            for (int kk = 0; kk < 4; ++kk) qf[kk] = lds_frag(Qs + tg * CS_QLD + 32 * kk + 8 * fq);
            float rden = 1.f;
            if (MODE == 2) { f32x4 ai = (f32x4){0.f, 0.f, 0.f, 0.f}, ao = (f32x4){0.f, 0.f, 0.f, 0.f};
#pragma unroll
                for (int ks2 = 0; ks2 < 2; ++ks2) ai = __builtin_amdgcn_mfma_f32_16x16x32_bf16(lds_frag(Vt + (64 + fr) * CS_SLD + 32 * ks2 + 8 * fq), pf[ks2], ai, 0, 0, 0);
#pragma unroll
                for (int kk = 0; kk < 4; ++kk) ao = __builtin_amdgcn_mfma_f32_16x16x32_bf16(lds_frag(St + (64 + fr) * CS_QLD + 32 * kk + 8 * fq), qf[kk], ao, 0, 0, 0);
                const float den = __shfl(ai[0] + ao[0] * ebt, fr); rden = 1.f / fmaxf(fabsf(den), 1.f); }
#pragma unroll
            for (int vj = 0; vj < NVC / 2; ++vj) { const int vt = (NVC / 2) * (w & 1) + vj; f32x4 ai = (f32x4){0.f, 0.f, 0.f, 0.f}, ao = (f32x4){0.f, 0.f, 0.f, 0.f};
#pragma unroll
                for (int ks2 = 0; ks2 < 2; ++ks2) ai = __builtin_amdgcn_mfma_f32_16x16x32_bf16(lds_frag(Vt + (16 * vt + fr) * CS_SLD + 32 * ks2 + 8 * fq), pf[ks2], ai, 0, 0, 0);
#pragma unroll
                for (int kk = 0; kk < 4; ++kk) ao = __builtin_amdgcn_mfma_f32_16x16x32_bf16(lds_frag(St + (16 * vt + fr) * CS_QLD + 32 * kk + 8 * fq), qf[kk], ao, 0, 0, 0);
                u32x2 wv; wv.x = pk2((ai[0] + ao[0] * ebt) * rden, (ai[1] + ao[1] * ebt) * rden); wv.y = pk2((ai[2] + ao[2] * ebt) * rden, (ai[3] + ao[3] * ebt) * rden);
                *(u32x2*)(Y + (size_t)m * YLD + ycol0 + 16 * vt + 4 * fq) = wv; }
        }
        {
            f32x4 dec; if (MODE == 1) dec = *(LAS f32x4*)(TOT + 4 * 128 + 16 * w + 4 * fq); else { const float d = __expf(BV[63]); dec = (f32x4){d, d, d, d}; }
            bf16x8 kf[2];
#pragma unroll
            for (int ks2 = 0; ks2 < 2; ++ks2) kf[ks2] = lds_frag(Kt + (16 * w + fr) * CS_SLD + 32 * ks2 + 8 * fq);
#pragma unroll
            for (int vt = 0; vt < NVT; ++vt) { Sacc[vt] = Sacc[vt] * dec;
#pragma unroll
                for (int ks2 = 0; ks2 < 2; ++ks2) Sacc[vt] = __builtin_amdgcn_mfma_f32_16x16x32_bf16(kf[ks2], lds_frag(Vt + (16 * vt + fr) * CS_SLD + 32 * ks2 + 8 * fq), Sacc[vt], 0, 0, 0); }
        }
        __syncthreads();
#pragma unroll
        for (int vt = 0; vt < NVT; ++vt) { u32x2 wv; wv.x = pk2(Sacc[vt][0], Sacc[vt][1]); wv.y = pk2(Sacc[vt][2], Sacc[vt][3]); *(LAS u32x2*)(St + (16 * vt + fr) * CS_QLD + 16 * w + 4 * fq) = wv; }
    }
    if (s < 16) {
        float* o; int kstride; float sc = 1.f;
        if (MODE == 0) { o = P.out + O_SSD + ((size_t)((s * 2 + j) * 2 + dir) * 16 + h) * 8192; kstride = 64; }
        else { o = P.out + (MODE == 1 ? O_GLA : O_MC) + ((size_t)((s * 2 + j) * 2 + dir) * 4 + h) * 32768 + vs * NV; kstride = 256; }
        if (MODE == 2) { __syncthreads(); sc = __expf(-MS[0]); }
#pragma unroll
        for (int vt = 0; vt < NVC; ++vt)
#pragma unroll
            for (int e = 0; e < 4; ++e) o[(size_t)(16 * w + 4 * fq + e) * kstride + 16 * vt + fr] = Sacc[vt][e] * sc;
        if (MODE == 2 && vs == 0) {
            if (fr == 0) {
#pragma unroll
                for (int e = 0; e < 4; ++e) P.out[O_MN + ((size_t)((s * 2 + j) * 2 + dir) * 4 + h) * 128 + 16 * w + 4 * fq + e] = Sacc[NVT - 1][e] * sc; }
            if (tid == 0) P.out[O_MM + ((s * 2 + j) * 2 + dir) * 4 + h] = MS[0]; }
    }
}

struct RwOps { f32x4 kk0, kk1, w0, w1, kd0, kd1, ka0, ka1, r0, r1; f32x2 vv; };
__device__ __forceinline__ RwOps rw_ops(const LAS float* B, int tt, int kg, int vg) {
    const LAS float* p = B + tt * 64 + 4 * kg; RwOps o;
    o.kk0 = *(const LAS f32x4*)(p + 4096); o.kk1 = *(const LAS f32x4*)(p + 4096 + 32); o.w0 = *(const LAS f32x4*)(p + 1024); o.w1 = *(const LAS f32x4*)(p + 1024 + 32);
    o.kd0 = *(const LAS f32x4*)(p + 2048); o.kd1 = *(const LAS f32x4*)(p + 2048 + 32); o.ka0 = *(const LAS f32x4*)(p + 5120); o.ka1 = *(const LAS f32x4*)(p + 5120 + 32);
    o.r0 = *(const LAS f32x4*)(p); o.r1 = *(const LAS f32x4*)(p + 32); o.vv = *(const LAS f32x2*)(B + 3072 + tt * 64 + 2 * vg); return o;
}
__device__ __forceinline__ void rwkv_pair(const Params& P, const Ctx& C, int j, int bq, bool lng) {
    const int niter = lng ? 64 : 32; const bool act = !lng || C.tid < 256;
    const int tid = C.tid, half = tid >> 8, tl = tid & 255, kg = tl & 7, vg = tl >> 3;
    const bf16_t* PREP = (const bf16_t*)(P.ws + WS_PREP); const bf16_t* LOUT = (const bf16_t*)(P.ws + WS_PROJ);
    constexpr int BUFSZ = 6 * 1024;
    LAS float* L0 = (LAS float*)C.lds + half * 2 * BUFSZ;
    const int stt = tl >> 4, sc4 = (tl & 15) * 4;
    auto unit_of = [&](int cc, int& s, int& dir, int& h, int& lc) {
        if (lng) { s = 16 + (bq >> 5); dir = (bq >> 4) & 1; h = bq & 15; lc = cc; }
        else { const int q = 4 * bq + 2 * half + (cc >> 4); s = q >> 5; dir = (q >> 4) & 1; h = q & 15; lc = cc & 15; } };
    f32x2 S2[8];
    auto init_state = [&](int s, int dir, int h) {
        const float* s0 = s >= 16 ? P.in[I_SRWKV] + (((size_t)(((s - 16) * 2 + j) * 2 + dir) * 16 + h) * 64 + 2 * vg) * 64 : nullptr;
#pragma unroll
        for (int hh = 0; hh < 2; ++hh) { const f32x4 u0 = s0 ? *(const f32x4*)(s0 + 32 * hh + 4 * kg) : (f32x4){0.f, 0.f, 0.f, 0.f}, u1 = s0 ? *(const f32x4*)(s0 + 64 + 32 * hh + 4 * kg) : (f32x4){0.f, 0.f, 0.f, 0.f};
#pragma unroll
            for (int e = 0; e < 4; ++e) S2[hh * 4 + e] = (f32x2){u0[e], u1[e]}; } };
    u32x2 rr, rk, rv, rkk, rwl, ral; f32x4 cw0, ca0, cka;
    auto load_raw = [&](int cc) {
        int s, dir, h, lc; unit_of(cc, s, dir, h, lc);
        const int T = s < 16 ? 256 : 1024, base = s < 16 ? s * 256 : 4096 + (s - 16) * 1024;
        const int step = lc * 16 + stt; const int m = base + (dir ? (T - 1 - step) : step);
        const bf16_t* pp = PREP + (size_t)m * PREP_LD + h * 64 + sc4; const bf16_t* lo = LOUT + (size_t)m * LOUT_LD + dir * 1024 + h * 64 + sc4;
        rr = *(const u32x2*)(pp + 3072); rk = *(const u32x2*)(pp + 4096); rv = *(const u32x2*)(pp + 5120); rkk = *(const u32x2*)(pp + 6144);
        rwl = *(const u32x2*)lo; ral = *(const u32x2*)(lo + 2048);
        cw0 = *(const f32x4*)(P.in[I_W0] + (j * 2 + dir) * 1024 + h * 64 + sc4); ca0 = *(const f32x4*)(P.in[I_A0] + (j * 2 + dir) * 1024 + h * 64 + sc4); cka = *(const f32x4*)(P.in[I_KA] + j * 1024 + h * 64 + sc4);
    };
    auto write_lds = [&](LAS float* B) {
        const f32x4 r = unpack4(rr), k = unpack4(rk), v = unpack4(rv), kk = unpack4(rkk), wl = unpack4(rwl), al = unpack4(ral);
        f32x4 w, kd, kka;
#pragma unroll
        for (int e = 0; e < 4; ++e) { const float wp = cw0[e] + wl[e]; const float lw = -__expf(-softplusf_(-wp) - 0.5f); w[e] = __expf(lw);
            const float a = sigmoidf_(ca0[e] + al[e]); kd[e] = k[e] * (1.f + (a - 1.f) * cka[e]); kka[e] = kk[e] * a; }
        LAS float* p = B + stt * 64 + sc4;
        *(LAS f32x4*)(p) = r; *(LAS f32x4*)(p + 1024) = w; *(LAS f32x4*)(p + 2048) = kd; *(LAS f32x4*)(p + 3072) = v; *(LAS f32x4*)(p + 4096) = kk; *(LAS f32x4*)(p + 5120) = kka;
    };
    __syncthreads();
    if (act) { load_raw(0); write_lds(L0);
    { int s, dir, h, lc; unit_of(0, s, dir, h, lc); init_state(s, dir, h); } }
    __syncthreads();
#pragma unroll 1
    for (int cc = 0; cc < niter; ++cc) {
        if (act) {
        LAS float* B = L0 + (cc & 1) * BUFSZ;
        int s, dir, h, lc; unit_of(cc, s, dir, h, lc);
        const int T = s < 16 ? 256 : 1024, base = s < 16 ? s * 256 : 4096 + (s - 16) * 1024;
        if (cc + 1 < niter) load_raw(cc + 1);
        bf16_t* Y = (bf16_t*)(P.ws + WS_MP) + (size_t)dir * MTOK * YLD + 1024 + h * 64 + 2 * vg;
        RwOps cur = rw_ops(B, 0, kg, vg);
#pragma unroll 2
        for (int tt = 0; tt < 16; ++tt) {
            const RwOps nx = rw_ops(B, (tt + 1) & 15, kg, vg);
            const int step = lc * 16 + tt; const int m = base + (dir ? (T - 1 - step) : step);
            f32x2 da = (f32x2){0.f, 0.f}, db = (f32x2){0.f, 0.f};
#pragma unroll
            for (int e = 0; e < 4; ++e) { da = da + S2[e] * (f32x2){cur.kk0[e], cur.kk0[e]}; db = db + S2[4 + e] * (f32x2){cur.kk1[e], cur.kk1[e]}; }
            const f32x2 d2 = da + db;
            f32x2 sk2; sk2.x = row_sum8(d2.x); sk2.y = row_sum8(d2.y);
            f32x2 ya = (f32x2){0.f, 0.f}, yb = (f32x2){0.f, 0.f};
#pragma unroll
            for (int e = 0; e < 4; ++e) {
                S2[e] = S2[e] * (f32x2){cur.w0[e], cur.w0[e]} - sk2 * (f32x2){cur.ka0[e], cur.ka0[e]} + cur.vv * (f32x2){cur.kd0[e], cur.kd0[e]};
                S2[4 + e] = S2[4 + e] * (f32x2){cur.w1[e], cur.w1[e]} - sk2 * (f32x2){cur.ka1[e], cur.ka1[e]} + cur.vv * (f32x2){cur.kd1[e], cur.kd1[e]};
                ya = ya + S2[e] * (f32x2){cur.r0[e], cur.r0[e]}; yb = yb + S2[4 + e] * (f32x2){cur.r1[e], cur.r1[e]}; }
            const f32x2 y2 = ya + yb;
            const float y0 = row_sum8(y2.x), y1 = row_sum8(y2.y);
            if (kg == 0) *(unsigned*)(Y + (size_t)m * YLD) = pg8::cvt_pk_bf16(y0, y1);
            cur = nx;
        }
        const int nchU = lng ? 64 : 16;
        if (lc == nchU - 1 && s < 16) { float* o = P.out + O_RWKV + (((size_t)((s * 2 + j) * 2 + dir) * 16 + h) * 64 + 2 * vg) * 64;
#pragma unroll
            for (int hh = 0; hh < 2; ++hh) { *(f32x4*)(o + 32 * hh + 4 * kg) = (f32x4){S2[hh * 4].x, S2[hh * 4 + 1].x, S2[hh * 4 + 2].x, S2[hh * 4 + 3].x};
                *(f32x4*)(o + 64 + 32 * hh + 4 * kg) = (f32x4){S2[hh * 4].y, S2[hh * 4 + 1].y, S2[hh * 4 + 2].y, S2[hh * 4 + 3].y}; } }
        if (cc + 1 < niter) { write_lds(L0 + ((cc + 1) & 1) * BUFSZ);
            if (lc == nchU - 1) { int s2, d2_, h2, lc2; unit_of(cc + 1, s2, d2_, h2, lc2); init_state(s2, d2_, h2); } }
        }
        __syncthreads();
    }
}

__device__ __forceinline__ void scan_unit(const Params& P, const Ctx& C, int l, int type, int q) {
    const int j = l >> 1; const bool ev = (l & 1) == 0;
    if (ev || type == 1) { int s, idx; if (q < 128) { s = 16 + (q >> 5); idx = q & 31; } else { const int r = q - 128; s = r >> 5; idx = r & 31; }
        if (ev) chunk_scan<0>(P, C, j, s, idx >> 4, idx & 15, 0); else chunk_scan<2>(P, C, j, s, idx >> 4, (idx >> 2) & 3, idx & 3); }
    else { int s, idx; if (q < 64) { s = 16 + (q >> 4); idx = q & 15; } else { const int r = q - 64; s = r >> 4; idx = r & 15; }
        chunk_scan<1>(P, C, j, s, idx >> 3, (idx >> 1) & 3, idx & 1); }
}
__device__ __forceinline__ void phase_scan(const Params& P, const Ctx& C0, int l) {
    const int G = C0.G, bid = C0.bid; const bool ev = (l & 1) == 0;
    if (ev) {
        if (G == 256) {
            rwkv_pair(P, fresh_ctx(C0.lds), l >> 1, bid < 128 ? bid : bid - 128, bid < 128);
#pragma unroll 1
            for (int it = 0; it < 4; ++it) { if (bid < 128 && it > 0) break; const int q = bid < 128 ? bid : 128 + (bid - 128) * 4 + it; scan_unit(P, fresh_ctx(C0.lds), l, 0, q); }
        } else {
#pragma unroll 1
            for (int x = bid; x < 256 + 640; x += G) { if (x < 256) rwkv_pair(P, fresh_ctx(C0.lds), l >> 1, x < 128 ? x : x - 128, x < 128); else scan_unit(P, fresh_ctx(C0.lds), l, 0, x - 256); }
        }
        return;
    }
#pragma unroll 1
    for (int it = 0; it < 960; ++it) {
        int type, q;
        if (G == 256) {
            if (bid < 64) { if (it >= 2) break; type = it; q = it == 0 ? bid : 128 + bid; }
            else if (bid < 192) { if (it >= 3) break; type = it == 0 ? 1 : 0; q = it == 0 ? bid - 64 : 64 + 2 * (bid - 64) + (it - 1); }
            else { if (it >= 7) break; type = 1; q = 128 + 64 + 7 * (bid - 192) + it; }
        } else { const int x = bid + it * G; if (x >= 960) break; type = x < 320 ? 0 : 1; q = x < 320 ? x : x - 320; }
        scan_unit(P, fresh_ctx(C0.lds), l, type, q);
    }
}

__device__ __forceinline__ void ld16(const bf16_t* p, float* o) { unpack8(*(const u32x4*)p, o); unpack8(*(const u32x4*)(p + 8), o + 8); }
__device__ __forceinline__ void ld16f(const float* p, float* o) {
#pragma unroll
    for (int q = 0; q < 4; ++q) { const f32x4 v = *(const f32x4*)(p + 4 * q); o[4 * q] = v.x; o[4 * q + 1] = v.y; o[4 * q + 2] = v.z; o[4 * q + 3] = v.w; } }
__device__ __forceinline__ void st16(bf16_t* p, const float* o) { *(u32x4*)p = pack8(o); *(u32x4*)(p + 8) = pack8(o + 8); }
__device__ __forceinline__ void phase_post(const Params& P, const Ctx& C, int l) {
    const int j = l >> 1; const bool ev = (l & 1) == 0;
    const bf16_t* PROJ = (const bf16_t*)(P.ws + WS_PROJ); const bf16_t* PREP = (const bf16_t*)(P.ws + WS_PREP);
    const bf16_t* Y0 = (const bf16_t*)(P.ws + WS_MP); const bf16_t* Y1 = Y0 + (size_t)MTOK * YLD; bf16_t* MIX = (bf16_t*)(P.ws + WS_MIX);
    const int gw = C.bid * 8 + C.wave, NGW = C.G * 8, lane = C.lane, c0 = lane * 16;
    for (int m = gw; m < MTOK; m += NGW) {
        float ya[16], yb[16], t0[16], t1[16], o[16];
        if (ev) {
            const bf16_t* pp = PREP + (size_t)m * PREP_LD;
            ld16(Y0 + (size_t)m * YLD + c0, ya); ld16(Y1 + (size_t)m * YLD + c0, yb); ld16(pp + c0, t0); ld16(pp + 2048 + c0, t1);
            const float dsk = P.in[I_SSDD][j * 16 + (lane >> 2)]; float ss = 0.f;
#pragma unroll
            for (int e = 0; e < 16; ++e) { o[e] = (ya[e] + yb[e] + t0[e] * dsk) * t1[e]; ss += o[e] * o[e]; }
            const float rs = rsqrtf(wave_sum(ss) * (1.f / 1024.f) + 1e-6f);
            ld16f(P.in[I_SSDN] + j * 1024 + c0, t0);
#pragma unroll
            for (int e = 0; e < 16; ++e) o[e] = o[e] * rs * t0[e];
            st16(MIX + (size_t)m * 2048 + c0, o);
            ld16(Y0 + (size_t)m * YLD + 1024 + c0, ya); ld16(Y1 + (size_t)m * YLD + 1024 + c0, yb);
            float mu = 0.f;
#pragma unroll
            for (int e = 0; e < 16; ++e) { ya[e] += yb[e]; mu += ya[e]; }
            mu += __shfl_xor(mu, 1); mu += __shfl_xor(mu, 2); mu *= (1.f / 64.f);
            float var = 0.f;
#pragma unroll
            for (int e = 0; e < 16; ++e) { ya[e] -= mu; var += ya[e] * ya[e]; }
            var += __shfl_xor(var, 1); var += __shfl_xor(var, 2); var *= (1.f / 64.f);
            const float rstd = rsqrtf(var + 64e-5f);
            ld16f(P.in[I_LNW] + j * 1024 + c0, t0); ld16f(P.in[I_LNB] + j * 1024 + c0, t1);
#pragma unroll
            for (int e = 0; e < 16; ++e) o[e] = ya[e] * rstd * t0[e] + t1[e];
            ld16(pp + 3072 + c0, ya); ld16(pp + 4096 + c0, yb); ld16f(P.in[I_RK] + j * 1024 + c0, t0);
            float bs = 0.f;
#pragma unroll
            for (int e = 0; e < 16; ++e) bs += ya[e] * yb[e] * t0[e];
            bs += __shfl_xor(bs, 1); bs += __shfl_xor(bs, 2);
            ld16(pp + 5120 + c0, ya); ld16(PROJ + (size_t)m * LOUT_LD + 4096 + c0, yb);
#pragma unroll
            for (int e = 0; e < 16; ++e) o[e] = (o[e] + bs * ya[e]) * yb[e];
            st16(MIX + (size_t)m * 2048 + 1024 + c0, o);
        } else {
            const bf16_t* pr = PROJ + (size_t)m * PROJ_LD_CD;
#pragma unroll
            for (int g = 0; g < 2; ++g) {
                ld16(Y0 + (size_t)m * YLD + g * 1024 + c0, ya); ld16(Y1 + (size_t)m * YLD + g * 1024 + c0, yb);
                float ss = 0.f;
#pragma unroll
                for (int e = 0; e < 16; ++e) { ya[e] += yb[e]; ss += ya[e] * ya[e]; }
                ss += __shfl_xor(ss, 1); ss += __shfl_xor(ss, 2); ss += __shfl_xor(ss, 4); ss += __shfl_xor(ss, 8);
                const float rs = rsqrtf(ss * (1.f / 256.f) + 1e-6f);
                ld16f((g == 0 ? P.in[I_GLAN] : P.in[I_MLN]) + j * 1024 + c0, t0);
                ld16(pr + (g == 0 ? 2048 : IN_GLA + 2048) + c0, t1);
#pragma unroll
                for (int e = 0; e < 16; ++e) o[e] = ya[e] * rs * t0[e] * (g == 0 ? siluf_(t1[e]) : sigmoidf_(t1[e]));
                st16(MIX + (size_t)m * 2048 + g * 1024 + c0, o);
            }
        }
    }
}

__global__ void __launch_bounds__(512, 2) hybrid_fwd(Params P) {
    extern __shared__ __attribute__((aligned(16))) unsigned char lds_raw[];
    cg::grid_group grid = cg::this_grid();
    Ctx C; C.lds = (LAS unsigned char*)lds_raw; C.tid = threadIdx.x; C.lane = C.tid & 63; C.wave = __builtin_amdgcn_readfirstlane(C.tid >> 6); C.G = gridDim.x; C.bid = blockIdx.x;
    const float* MOD = (const float*)(P.ws + WS_MOD);
    const bf16_t* H = (const bf16_t*)(P.ws + WS_H);
    if (C.tid < 4) ((volatile LAS unsigned*)(C.lds + LDS_BYTES - 16))[C.tid] = 0u;
    __syncthreads();
    const XcdBarrier xb = xcd_barrier_post((unsigned*)(P.ws + WS_CTL), (volatile LAS unsigned*)(C.lds + LDS_BYTES - 16));
    REP(1) if (PH & 1) phase_mod(P, fresh_ctx(C.lds));
    REP(2) if (PH & 2) phase_convert(P, fresh_ctx(C.lds), 0);
    grid.sync();
    if (PH & 4) phase_rows(P, fresh_ctx(C.lds), 0, nullptr, nullptr, true, P.in[I_NORMG] + 0, MOD + 0);
    GSYNC();
#pragma unroll 1
    for (int l = 0; l < 4; ++l) {
        const bool ev = (l & 1) == 0; const float* modl = MOD + (size_t)l * 5 * 6144; const float* ng = P.in[I_NORMG] + l * 4 * 1024;
        REP(8) if (PH & 8) { pg8::Gemm g{H, (const bf16_t*)(P.ws + WS_WIN), 1024, 1024, 1024}; pg8::Sched<0> S; S.init(MTOK, ev ? N_AB_P : N_CD_P, 1, 1024, C.G, C.bid);
          pg8::EpiBf16<0> E{(bf16_t*)(P.ws + WS_PROJ), ev ? PROJ_LD_AB : PROJ_LD_CD, 0}; pg8::gemm_phase(C.lds, g, S, E); }
        GSYNC();
        REP(16) if (PH & 16) { if (ev) phase_prep_even(P, fresh_ctx(C.lds), l >> 1); else phase_prep_odd(P, fresh_ctx(C.lds), l >> 1); }
        GSYNC();
        if (ev && (PH & 32)) {
            REP(32) {
            pg8::Gemm g{(const bf16_t*)(P.ws + WS_LORAA), (const bf16_t*)(P.ws + WS_WLORA), LORA_K, 128, 128}; pg8::Sched<1> S; S.init(MTOK, LOUT_LD, 1, 128, C.G, C.bid);
            pg8::EpiBf16<0> E{(bf16_t*)(P.ws + WS_PROJ), LOUT_LD, 0}; pg8::gemm_phase(C.lds, g, S, E); }
            GSYNC();
        }
        for (int rep_ = 0; rep_ < (((DUP & 64) && ev) || ((DUP & 0x4000) && !ev) ? 2 : 1); ++rep_) if (PH & 64) phase_scan(P, fresh_ctx(C.lds), l);
        GSYNC();
        REP(128) if (PH & 128) phase_post(P, fresh_ctx(C.lds), l);
        GSYNC();
        REP(256) if (PH & 256) { pg8::Gemm g{(const bf16_t*)(P.ws + WS_MIX), (const bf16_t*)(P.ws + WS_WOUT), 2048, 2048, 1024}; pg8::Sched<0> S; S.init(MTOK, 1024, 2, 1024, C.G, C.bid);
          pg8::EpiBf16<0> E{(bf16_t*)(P.ws + WS_MP), 1024, (size_t)MTOK * 1024}; pg8::gemm_phase(C.lds, g, S, E); }
        GSYNC();
        if (DUP & 512) phase_rows(P, fresh_ctx(C.lds), 1, ng + 1024, modl + 2048, true, ng + 2048, modl + 3072, true);
        if (PH & 512) phase_rows(P, fresh_ctx(C.lds), 1, ng + 1024, modl + 2048, true, ng + 2048, modl + 3072);
        GSYNC();
        REP(1024) if (PH & 1024) { pg8::Gemm g{H, (const bf16_t*)(P.ws + WS_WUP), 1024, 1024, 1024}; pg8::Sched<0> S; S.init(MTOK, 4096, 1, 1024, C.G, C.bid);
          pg8::EpiBf16<2> E{(bf16_t*)(P.ws + WS_PROJ), 4096, 0}; pg8::gemm_phase(C.lds, g, S, E); }
        GSYNC();
        REP(2048) if (PH & 2048) { pg8::Gemm g{(const bf16_t*)(P.ws + WS_PROJ), (const bf16_t*)(P.ws + WS_WDN), 4096, 4096, 2048}; pg8::Sched<0> S; S.init(MTOK, 1024, 2, 2048, C.G, C.bid);
          pg8::EpiBf16<0> E{(bf16_t*)(P.ws + WS_MP), 1024, (size_t)MTOK * 1024}; pg8::gemm_phase(C.lds, g, S, E); }
        GSYNC();
        if (DUP & 4096) phase_rows(P, fresh_ctx(C.lds), 1, ng + 3072, modl + 5120, true, ng + 2048, modl + 3072, true);
        if (PH & 4096) { if (l < 3) { phase_rows(P, fresh_ctx(C.lds), 1, ng + 3072, modl + 5120, true, ng + 4096, modl + 5 * 6144); phase_convert(P, fresh_ctx(C.lds), l + 1); }
        else phase_rows(P, fresh_ctx(C.lds), 1, ng + 3072, modl + 5120, false, nullptr, nullptr); }
        if (l < 3) GSYNC();
    }
}

extern "C" void kernel_launch(void* const* d_in, const int* in_sizes, int n_in, void* d_out, int out_size, void* d_ws, size_t ws_size, hipStream_t stream) {
    static int grid = 0;
    if (grid == 0) {
        if (n_in != 44 || ws_size < WS_END) { fprintf(stderr, "kernel_launch: unexpected n_in %d / ws %zu\n", n_in, ws_size); grid = -1; return; }
        int dev = 0, cus = 0, per_cu = 0;
        hipGetDevice(&dev); hipDeviceGetAttribute(&cus, hipDeviceAttributeMultiprocessorCount, dev);
        if (hipFuncSetAttribute((const void*)hybrid_fwd, hipFuncAttributeMaxDynamicSharedMemorySize, LDS_BYTES) != hipSuccess) { fprintf(stderr, "hipFuncSetAttribute failed\n"); grid = -1; return; }
        hipOccupancyMaxActiveBlocksPerMultiprocessor(&per_cu, (const void*)hybrid_fwd, 512, LDS_BYTES);
        (void)hipGetLastError();
        if (per_cu < 1) per_cu = 1;
        grid = cus * 1;
    }
    if (grid < 0) return;
    if (hipMemsetAsync((char*)d_ws + WS_CTL, 0, CTL_BYTES, stream) != hipSuccess) { fprintf(stderr, "memset failed\n"); return; }
    Params p{};
    for (int i = 0; i < 44; ++i) p.in[i] = (const float*)d_in[i];
    p.out = (float*)d_out; p.ws = (unsigned char*)d_ws;
    void* args[] = {&p};
    hipError_t e = hipLaunchCooperativeKernel((const void*)hybrid_fwd, dim3(grid), dim3(512), args, LDS_BYTES, stream);
    if (e != hipSuccess) fprintf(stderr, "cooperative launch failed: %s (grid %d)\n", hipGetErrorString(e), grid);
}
```

```cpp
#include <hip/hip_runtime.h>
#include <hip/hip_cooperative_groups.h>
#include <cstdio>
#include <cstdint>
namespace cg = cooperative_groups;

#define LAS __attribute__((address_space(3)))
typedef unsigned short bf16_t;
typedef short bf16x8 __attribute__((ext_vector_type(8)));
typedef float f32x4 __attribute__((ext_vector_type(4)));
typedef float f32x2 __attribute__((ext_vector_type(2)));
typedef unsigned u32x4 __attribute__((ext_vector_type(4)));
typedef unsigned u32x2 __attribute__((ext_vector_type(2)));

constexpr int MTOK = 8192, DM = 1024, DFF = 4096;
constexpr int N_AB = 6560, N_AB_P = 6656, N_CD = 6192, N_CD_P = 6400;
constexpr int PROJ_LD_AB = N_AB_P, PROJ_LD_CD = N_CD_P;
constexpr int PREP_LD = 7168, LOUT_LD = 5120, LORA_K = 384, YLD = 2048;
constexpr int IN_SSD = 3104, IN_GLA = 3104;
constexpr size_t MiB = 1u << 20;
constexpr size_t WS_MOD = 0, WS_CTL = 512 * 1024, CTL_BYTES = 16384, WS_DT = 1 * MiB, WS_DA = 3 * MiB, WS_WIN = 5 * MiB, WS_WOUT = 19 * MiB, WS_WUP = 23 * MiB, WS_WDN = 31 * MiB,
                 WS_WLORA = 39 * MiB, WS_H = 41 * MiB, WS_PROJ = 57 * MiB, WS_PREP = 161 * MiB, WS_MIX = 273 * MiB, WS_MP = 305 * MiB,
                 WS_LORAA = 369 * MiB, WS_END = 375 * MiB;
constexpr size_t O_X = 0, O_SSD = 8388608, O_RWKV = 16777216, O_GLA = 20971520, O_MC = 29360128, O_MN = 37748736, O_MM = 37781504;

struct Params { const float* in[44]; float* out; unsigned char* ws; };
enum { I_XP = 0, I_XS, I_SSSD, I_SRWKV, I_SGLA, I_SMC, I_SMN, I_SMM, I_C, I_CCTX, I_WMOD, I_BMOD, I_NORMG, I_WUP, I_WDN, I_WINAB, I_SCONVW, I_SCONVB,
       I_DTB, I_ALOG, I_SSDD, I_SSDN, I_MU, I_W0, I_W2, I_A0, I_A2, I_G2, I_KK, I_KA, I_RK, I_LNW, I_LNB, I_WOUTAB, I_WINCD, I_GGW, I_GGB, I_GLAN,
       I_MCONVW, I_MCONVB, I_MIB, I_MFB, I_MLN, I_WOUTCD };

__device__ __forceinline__ float bf2f(unsigned b) { return __uint_as_float(b << 16); }
__device__ __forceinline__ unsigned f2bf(float f) { unsigned u = __float_as_uint(f); return (u + 0x7fffu + ((u >> 16) & 1u)) >> 16; }
typedef __bf16 bf16x2_hw __attribute__((ext_vector_type(2)));
__device__ __forceinline__ unsigned pk2(float lo, float hi) { const f32x2 v = {lo, hi}; const bf16x2_hw b = __builtin_convertvector(v, bf16x2_hw); return __builtin_bit_cast(unsigned, b); }
__device__ __forceinline__ float lo16(unsigned w) { return __uint_as_float(w << 16); }
__device__ __forceinline__ float hi16(unsigned w) { return __uint_as_float(w & 0xffff0000u); }
__device__ __forceinline__ void unpack8(u32x4 w, float* o) { o[0] = lo16(w.x); o[1] = hi16(w.x); o[2] = lo16(w.y); o[3] = hi16(w.y); o[4] = lo16(w.z); o[5] = hi16(w.z); o[6] = lo16(w.w); o[7] = hi16(w.w); }
__device__ __forceinline__ f32x4 unpack4(u32x2 w) { return (f32x4){lo16(w.x), hi16(w.x), lo16(w.y), hi16(w.y)}; }
__device__ __forceinline__ u32x4 pack8(const float* o) { u32x4 w; w.x = pk2(o[0], o[1]); w.y = pk2(o[2], o[3]); w.z = pk2(o[4], o[5]); w.w = pk2(o[6], o[7]); return w; }
__device__ __forceinline__ float sigmoidf_(float x) { return 1.f / (1.f + __expf(-x)); }
__device__ __forceinline__ float siluf_(float x) { return x / (1.f + __expf(-x)); }
__device__ __forceinline__ float softplusf_(float x) { return fmaxf(x, 0.f) + __logf(1.f + __expf(-fabsf(x))); }
__device__ __forceinline__ float logsigmoidf_(float x) { return fminf(x, 0.f) - __logf(1.f + __expf(-fabsf(x))); }
__device__ __forceinline__ float tanhf_(float x) { const float e = __expf(-2.f * fabsf(x)); const float r = (1.f - e) / (1.f + e); return x < 0.f ? -r : r; }
__device__ __forceinline__ float wave_sum(float v) {
#pragma unroll
    for (int o = 1; o < 64; o <<= 1) v += __shfl_xor(v, o);
    return v;
}
__device__ __forceinline__ float quad_sum(float x) {
    x += __int_as_float(__builtin_amdgcn_update_dpp(0, __float_as_int(x), 0xB1, 0xF, 0xF, true));
    x += __int_as_float(__builtin_amdgcn_update_dpp(0, __float_as_int(x), 0x4E, 0xF, 0xF, true));
    return x;
}

#define DPP_ADD(x, ctrl) ((x) + __int_as_float(__builtin_amdgcn_update_dpp(0, __float_as_int(x), (ctrl), 0xF, 0xF, true)))
__device__ __forceinline__ float row_sum8(float x) { x = DPP_ADD(x, 0xB1); x = DPP_ADD(x, 0x4E); x = DPP_ADD(x, 0x141); return x; }
__device__ __forceinline__ float row_sum16(float x) { x = row_sum8(x); x = DPP_ADD(x, 0x140); return x; }
namespace pg8 {
constexpr int BM = 256, BK = 64, HALF = 128, HTB = HALF * BK * 2, STAGE_BYTES = 8 * HTB, NXCD = 8, WGM = 8;
__host__ __device__ __forceinline__ int lds_byte(int r, int c) { const int st = (r >> 4) * 2 + (c >> 5), rr = r & 15, cc = c & 31, ob = rr * 64 + cc * 2; return st * 1024 + (ob ^ (((ob >> 9) & 1) << 5)); }
__host__ __device__ __forceinline__ void stage_rc(int b, int& R, int& C) { const int st = b / 1024, sb = b % 1024, swz = sb ^ (((sb >> 9) & 1) << 5); R = (st >> 1) * 16 + swz / 64; C = (st & 1) * 32 + (swz % 64) / 2; }
__host__ __device__ __forceinline__ int perm32(int rho) { const int n = rho >> 4, i = rho & 15; return 8 * (i >> 2) + 4 * n + (i & 3); }

struct Unit { int pm, pn, ks; };
struct Gemm { const bf16_t* A; const bf16_t* Bt; int lda, ldb, K; };
template <int mode> struct Sched {
    int nM, nN, nNv, nwg, G, c, K;
    __device__ void init(int M, int N, int nK, int K_, int G_, int c_) { nM = M / BM; nN = N / BM; nNv = nN * nK; nwg = nM * nNv; G = G_; c = c_; K = K_; }
    __device__ bool next(int i, Unit& u) const {
        const long L = (long)i * G + c; if (L >= nwg) return false;
        int wgid = (int)L; { const int q = nwg / NXCD, r = nwg % NXCD, xcd = wgid % NXCD, off = wgid / NXCD; wgid = (xcd < r ? xcd * (q + 1) : r * (q + 1) + (xcd - r) * q) + off; }
        const int nig = WGM * nNv, gid = wgid / nig, fm = gid * WGM, gsz = (nM - fm) < WGM ? (nM - fm) : WGM;
        u.pm = fm + ((wgid % nig) % gsz); const int pnv = (wgid % nig) / gsz; u.pn = pnv % nN; u.ks = pnv / nN; return true;
    }
    __device__ __forceinline__ size_t aoff(const Unit& u) const { if (mode == 1) { const int g = u.pn >> 2; return (size_t)(g < 2 ? 0 : (g < 4 ? 128 : 256)) * 2; } return (size_t)u.ks * K * 2; }
    __device__ __forceinline__ size_t boff(const Unit& u) const { return mode == 1 ? 0 : (size_t)u.ks * K * 2; }
};

__device__ __forceinline__ unsigned cvt_pk_bf16(float lo, float hi) { unsigned r; asm volatile("v_cvt_pk_bf16_f32 %0, %1, %2" : "=v"(r) : "v"(lo), "v"(hi)); return r; }

template <int ACT> struct EpiBf16 {
    static constexpr bool PERM = true;
    bf16_t* O; int ldc; size_t pstride;
    __device__ __forceinline__ void operator()(const f32x4 (&acc)[2][2][4][2], const Unit& u, int wr, int wc, int fr, int fq) const {
        const int row0 = u.pm * BM + wr * 64 + fr; const int col0 = u.pn * BM + wc * 32 + 8 * fq; bf16_t* Ob = O + (size_t)u.ks * pstride;
#pragma unroll
        for (int ai = 0; ai < 2; ++ai)
#pragma unroll
            for (int m = 0; m < 4; ++m) { bf16_t* rowp = Ob + (size_t)(row0 + ai * HALF + m * 16) * ldc + col0;
#pragma unroll
                for (int bj = 0; bj < 2; ++bj) { f32x4 v0 = acc[ai][bj][m][0], v1 = acc[ai][bj][m][1];
                    if (ACT == 2) {
#pragma unroll
                        for (int e = 0; e < 4; ++e) { const float a = fmaxf(v0[e], 0.f), b = fmaxf(v1[e], 0.f); v0[e] = a * a; v1[e] = b * b; } }
                    u32x4 w; w.x = cvt_pk_bf16(v0[0], v0[1]); w.y = cvt_pk_bf16(v0[2], v0[3]); w.z = cvt_pk_bf16(v1[0], v1[1]); w.w = cvt_pk_bf16(v1[2], v1[3]);
                    *(u32x4*)(rowp + bj * HALF) = w; } }
    }
};
struct EpiF32 {
    static constexpr bool PERM = false;
    float* O; int ldc; size_t pstride;
    __device__ __forceinline__ void operator()(const f32x4 (&acc)[2][2][4][2], const Unit& u, int wr, int wc, int fr, int fq) const {
        float* base = O + (size_t)u.ks * pstride; const int col0 = u.pn * BM + wc * 32 + 4 * fq;
#pragma unroll
        for (int ai = 0; ai < 2; ++ai)
#pragma unroll
            for (int m = 0; m < 4; ++m) { float* rowp = base + (size_t)(u.pm * BM + ai * HALF + wr * 64 + m * 16 + fr) * ldc + col0;
#pragma unroll
                for (int bj = 0; bj < 2; ++bj)
#pragma unroll
                    for (int n = 0; n < 2; ++n) *(f32x4*)(rowp + bj * HALF + n * 16) = acc[ai][bj][m][n]; }
    }
};

template <class Epi, class SchedT>
__device__ __forceinline__ void gemm_phase(LAS unsigned char* lds, const Gemm g, const SchedT& S, const Epi& E) {
    int tid_ = threadIdx.x; asm volatile("" : "+v"(tid_));
    const int tid = tid_, wid = __builtin_amdgcn_readfirstlane(tid >> 6), lane = tid & 63, wr = wid >> 2, wc = wid & 3, fr = lane & 15, fq = lane >> 4;
    int K_ = g.K; asm volatile("" : "+s"(K_));
    const int K = K_, nt = K / BK;
    unsigned voffA[2], voffB[2];
#pragma unroll
    for (int i = 0; i < 2; ++i) { int R, C; stage_rc(tid * 16 + i * 8192, R, C); const int Rb = Epi::PERM ? ((R & ~31) + perm32(R & 31)) : R;
        voffA[i] = (unsigned)(R * g.lda + C) * 2u; voffB[i] = (unsigned)(Rb * g.ldb + C) * 2u; }
    const size_t kstep = (size_t)(BK * 2);
    const size_t hstepA = (size_t)HALF * g.lda * 2, hstepB = (size_t)HALF * g.ldb * 2;
    const size_t tstepA = 2 * hstepA, tstepB = 2 * hstepB;
    const unsigned ldsw = (unsigned)wid * 1024u;
    const int aoff = lds_byte(wr * 64 + fr, fq * 8), boff = lds_byte(wc * 32 + fr, fq * 8);
#define PG8_SA(b, h) (((b) * 2 + (h)) * HTB)
#define PG8_SB(b, h) ((4 + (b) * 2 + (h)) * HTB)
#define PG8_STAGE(bufoff, gbase, voff) do { _Pragma("unroll") for (int _i = 0; _i < 2; ++_i) \
        __builtin_amdgcn_global_load_lds((const unsigned*)((const char*)(gbase) + (voff)[_i]), (LAS unsigned*)(lds + (bufoff) + ldsw + _i * 8192), 16, 0, 0); } while (0)
#define PG8_LDA(dst, b, h) do { _Pragma("unroll") for (int m = 0; m < 4; ++m) _Pragma("unroll") for (int k = 0; k < 2; ++k) dst[m][k] = *(const LAS bf16x8*)(lds + PG8_SA(b, h) + aoff + m * 2048 + k * 1024); } while (0)
#define PG8_LDB(dst, b, h) do { _Pragma("unroll") for (int n = 0; n < 2; ++n) _Pragma("unroll") for (int k = 0; k < 2; ++k) dst[n][k] = *(const LAS bf16x8*)(lds + PG8_SB(b, h) + boff + n * 2048 + k * 1024); } while (0)
#define PG8_MMA(ai, bj, At, Bt) do { __builtin_amdgcn_s_setprio(1); _Pragma("unroll") for (int m = 0; m < 4; ++m) _Pragma("unroll") for (int n = 0; n < 2; ++n) _Pragma("unroll") for (int k = 0; k < 2; ++k) \
        acc[ai][bj][m][n] = __builtin_amdgcn_mfma_f32_16x16x32_bf16(Bt[n][k], At[m][k], acc[ai][bj][m][n], 0, 0, 0); __builtin_amdgcn_s_setprio(0); } while (0)
#define PG8_WAIT_V(n) asm volatile("s_waitcnt vmcnt(" #n ")" ::: "memory")
#define PG8_WAIT_L(n) asm volatile("s_waitcnt lgkmcnt(" #n ")" ::: "memory")
#define PG8_BAR __builtin_amdgcn_s_barrier()
#define PG8_SCHED __builtin_amdgcn_sched_barrier(0)
    Unit cur, nxt; int ui = 0;
    if (!S.next(0, cur)) return;
    f32x4 acc[2][2][4][2];
#pragma unroll
    for (int a = 0; a < 2; ++a)
#pragma unroll
        for (int b = 0; b < 2; ++b)
#pragma unroll
            for (int m = 0; m < 4; ++m)
#pragma unroll
                for (int n = 0; n < 2; ++n) acc[a][b][m][n] = (f32x4){0.f, 0.f, 0.f, 0.f};
    bf16x8 At[4][2], B0[2][2], B1[2][2];
    const char* cA = (const char*)g.A + (size_t)cur.pm * tstepA + S.aoff(cur); const char* cB = (const char*)g.Bt + (size_t)cur.pn * tstepB + S.boff(cur);
    PG8_STAGE(PG8_SB(0, 0), cB, voffB); PG8_STAGE(PG8_SB(0, 1), cB + hstepB, voffB); PG8_STAGE(PG8_SA(0, 0), cA, voffA); PG8_STAGE(PG8_SA(0, 1), cA + hstepA, voffA);
    if (wr == 1) PG8_BAR;
    PG8_WAIT_V(2); PG8_BAR;
    PG8_STAGE(PG8_SB(1, 0), cB + kstep, voffB); PG8_STAGE(PG8_SA(1, 0), cA + kstep, voffA); PG8_STAGE(PG8_SB(1, 1), cB + hstepB + kstep, voffB);
    PG8_WAIT_V(6); PG8_BAR;
    for (;;) {
        const bool has_next = S.next(ui + 1, nxt);
        const char* nA = has_next ? (const char*)g.A + (size_t)nxt.pm * tstepA + S.aoff(nxt) : cA; const char* nB = has_next ? (const char*)g.Bt + (size_t)nxt.pn * tstepB + S.boff(nxt) : cB;
        for (int t = 0; t < nt; t += 2) {
            const bool last = (t == nt - 2);
            const char* a1 = cA + (size_t)(t + 1) * kstep;
            const char* a2 = last ? nA : cA + (size_t)(t + 2) * kstep; const char* b2 = last ? nB : cB + (size_t)(t + 2) * kstep;
            const char* a3 = a2 + kstep; const char* b3 = b2 + kstep;
            PG8_LDB(B0, 0, 0); PG8_LDB(B1, 0, 1); PG8_SCHED; PG8_LDA(At, 0, 0); PG8_STAGE(PG8_SA(1, 1), a1 + hstepA, voffA);
            PG8_WAIT_V(8); PG8_WAIT_L(0); PG8_BAR; PG8_MMA(0, 0, At, B0); PG8_MMA(0, 1, At, B1); PG8_BAR; PG8_SCHED;
            PG8_LDA(At, 0, 1); PG8_STAGE(PG8_SB(0, 0), b2, voffB); PG8_STAGE(PG8_SB(0, 1), b2 + hstepB, voffB); PG8_STAGE(PG8_SA(0, 0), a2, voffA);
            PG8_WAIT_V(8); PG8_WAIT_L(0); PG8_BAR; PG8_MMA(1, 0, At, B0); PG8_MMA(1, 1, At, B1); PG8_BAR; PG8_SCHED;
            PG8_LDB(B0, 1, 0); PG8_LDB(B1, 1, 1); PG8_SCHED; PG8_LDA(At, 1, 0); PG8_STAGE(PG8_SA(0, 1), a2 + hstepA, voffA);
            PG8_WAIT_V(8); PG8_WAIT_L(0); PG8_BAR; PG8_MMA(0, 0, At, B0); PG8_MMA(0, 1, At, B1); PG8_BAR; PG8_SCHED;
            PG8_LDA(At, 1, 1); PG8_STAGE(PG8_SB(1, 0), b3, voffB); PG8_STAGE(PG8_SB(1, 1), b3 + hstepB, voffB); PG8_STAGE(PG8_SA(1, 0), a3, voffA);
            PG8_WAIT_V(8); PG8_WAIT_L(0); PG8_BAR; PG8_MMA(1, 0, At, B0); PG8_MMA(1, 1, At, B1); PG8_BAR; PG8_SCHED;
        }
        if (wr == 0) PG8_BAR;
        E(acc, cur, wr, wc, fr, fq);
        if (!has_next) break;
#pragma unroll
        for (int a = 0; a < 2; ++a)
#pragma unroll
            for (int b = 0; b < 2; ++b)
#pragma unroll
                for (int m = 0; m < 4; ++m)
#pragma unroll
                    for (int n = 0; n < 2; ++n) acc[a][b][m][n] = (f32x4){0.f, 0.f, 0.f, 0.f};
        cur = nxt; cA = nA; cB = nB; ++ui;
        if (wr == 1) PG8_BAR;
    }
    PG8_WAIT_V(0);
    PG8_BAR;
#undef PG8_SA
#undef PG8_SB
#undef PG8_STAGE
#undef PG8_LDA
#undef PG8_LDB
#undef PG8_MMA
#undef PG8_WAIT_V
#undef PG8_WAIT_L
#undef PG8_BAR
#undef PG8_SCHED
}
}

#define XB_TMO      128
#define XB_XCNT(j)  (256  + 64 * (j))
#define XB_XSUB(j)  (1280 + 64 * (j))
#define XB_XGEN(j)  (2304 + 64 * (j))
#define XB_TOP      3328
#define XB_TOPGEN   3392
#define XCD_BAR_WORDS 3456
#define XB_SPIN_CAP (1u << 18)
__device__ __forceinline__ unsigned xb_ld(unsigned* p)              { return __hip_atomic_load(p, __ATOMIC_RELAXED, __HIP_MEMORY_SCOPE_AGENT); }
__device__ __forceinline__ unsigned xb_add(unsigned* p, unsigned v) { return __hip_atomic_fetch_add(p, v, __ATOMIC_RELAXED, __HIP_MEMORY_SCOPE_AGENT); }
__device__ __forceinline__ unsigned xb_xcc_id() { return (unsigned)__builtin_amdgcn_s_getreg((3 << 11) | 20) & 0xFu; }
#define XB_SPIN(cond, bar) do { unsigned _sp = 0; while (cond) { __builtin_amdgcn_s_sleep(1); \
    if ((++_sp & 255u) == 0u) { if (xb_ld(&(bar)[XB_TMO])) break; if (_sp > XB_SPIN_CAP) { atomicAdd(&(bar)[XB_TMO], 1u); break; } } } } while (0)
struct XcdBarrier { unsigned* bar; unsigned x; volatile LAS unsigned* st; };
__device__ __forceinline__ XcdBarrier xcd_barrier_post(unsigned* bar, volatile LAS unsigned* st) {
    XcdBarrier b; b.bar = bar; b.x = xb_xcc_id(); b.st = st;
    if (threadIdx.x == 0) (void)xb_add(&bar[XB_XCNT(b.x)], 1u);
    return b;
}
__device__ __forceinline__ void xcd_barrier_complete(unsigned* bar, unsigned x, unsigned& nloc, unsigned& nx) {
    const unsigned G = gridDim.x * gridDim.y * gridDim.z;
    unsigned sum, cnt, mine, sp = 0u;
    for (;;) {
        sum = 0u; cnt = 0u; mine = 0u;
#pragma unroll
        for (unsigned j = 0; j < 16; ++j) { const unsigned c = xb_ld(&bar[XB_XCNT(j)]); sum += c; cnt += (c > 0u) ? 1u : 0u; mine = (j == x) ? c : mine; }
        if (sum == G) break;
        __builtin_amdgcn_s_sleep(1);
        if ((++sp & 255u) == 0u) { if (xb_ld(&bar[XB_TMO])) break; if (sp > XB_SPIN_CAP) { atomicAdd(&bar[XB_TMO], 1u); break; } }
    }
    nloc = mine > 0u ? mine : 1u; nx = cnt > 0u ? cnt : 1u;
}
__device__ __forceinline__ void xcd_barrier(const XcdBarrier& b) {
    asm volatile("s_waitcnt vmcnt(0)" ::: "memory");
    __syncthreads();
    if (threadIdx.x == 0) {
        unsigned* bar = b.bar;
        __builtin_amdgcn_s_waitcnt(0);
        unsigned nloc = b.st[0], nx = b.st[1];
        if (nloc == 0u) { xcd_barrier_complete(bar, b.x, nloc, nx); b.st[0] = nloc; b.st[1] = nx; }
        const unsigned old = xb_add(&bar[XB_XSUB(b.x)], 1u);
        const unsigned gen = old / nloc;
        if (old + 1u == (gen + 1u) * nloc) {
            __builtin_amdgcn_fence(__ATOMIC_RELEASE, "agent");
            asm volatile("s_waitcnt vmcnt(0)" ::: "memory");
            const unsigned og = xb_add(&bar[XB_TOP], 1u);
            const unsigned tg = og / nx;
            if (og + 1u == (tg + 1u) * nx) xb_add(&bar[XB_TOPGEN], 1u);
            else XB_SPIN(xb_ld(&bar[XB_TOPGEN]) == tg, bar);
            __builtin_amdgcn_fence(__ATOMIC_ACQUIRE, "agent");
            xb_add(&bar[XB_XGEN(b.x)], 1u);
            asm volatile("s_waitcnt vmcnt(0)" ::: "memory");
        } else {
            XB_SPIN(xb_ld(&bar[XB_XGEN(b.x)]) == gen, bar);
            __builtin_amdgcn_fence(__ATOMIC_ACQUIRE, "agent");
            asm volatile("s_waitcnt vmcnt(0)" ::: "memory");
        }
    }
    __syncthreads();
}

constexpr int LDS_BYTES = 147456;
#ifndef PH
#define PH 0xFFFF
#endif
#ifndef DUP
#define DUP 0
#endif
#define GSYNC() do { xcd_barrier(xb); if (DUP & 0x8000) { xcd_barrier(xb); xcd_barrier(xb); } } while (0)
#define REP(bit) for (int rep_ = 0; rep_ < ((DUP & (bit)) ? 2 : 1); ++rep_)
struct Ctx { LAS unsigned char* lds; int tid, lane, wave, G, bid; };
__device__ __forceinline__ Ctx fresh_ctx(LAS unsigned char* lds) { Ctx C; int t = threadIdx.x; asm volatile("" : "+v"(t)); C.lds = lds; C.tid = t; C.lane = t & 63; C.wave = __builtin_amdgcn_readfirstlane(t >> 6); C.G = gridDim.x; C.bid = blockIdx.x; return C; }

__device__ __forceinline__ void phase_mod(const Params& P, const Ctx& C) {
    LAS float* sc = (LAS float*)C.lds; LAS float* red = sc + 5120;
    for (int i = C.tid; i < 5120; i += 512) { const int r = i >> 10, k = i & 1023; const float x = r == 0 ? P.in[I_CCTX][k] : P.in[I_C][(r - 1) * 1024 + k]; sc[i] = siluf_(x); }
    __syncthreads();
    float* MOD = (float*)(P.ws + WS_MOD);
    const int kg = C.tid >> 5, c = C.tid & 31;
    for (int tile = C.bid; tile < 768; tile += C.G) {
        const int l = tile / 192, col = (tile % 192) * 32 + c;
        const float* w = P.in[I_WMOD] + (size_t)l * 1024 * 6144 + col;
        float a0 = 0.f, a1 = 0.f, a2 = 0.f, a3 = 0.f, a4 = 0.f;
#pragma unroll 16
        for (int k = kg * 64; k < kg * 64 + 64; ++k) { const float wv = w[(size_t)k * 6144]; a0 += sc[k] * wv; a1 += sc[1024 + k] * wv; a2 += sc[2048 + k] * wv; a3 += sc[3072 + k] * wv; a4 += sc[4096 + k] * wv; }
        red[(kg * 5 + 0) * 32 + c] = a0; red[(kg * 5 + 1) * 32 + c] = a1; red[(kg * 5 + 2) * 32 + c] = a2; red[(kg * 5 + 3) * 32 + c] = a3; red[(kg * 5 + 4) * 32 + c] = a4;
        __syncthreads();
        if (C.tid < 160) { const int r = C.tid >> 5; float s = 0.f;
#pragma unroll
            for (int q = 0; q < 16; ++q) s += red[(q * 5 + r) * 32 + c];
            MOD[(size_t)(l * 5 + r) * 6144 + col] = s + P.in[I_BMOD][l * 6144 + col]; }
        __syncthreads();
    }
}

__device__ __forceinline__ void transpose_item(const float* W, int K, int N, bf16_t* WT, LAS float* scr, int item, int nblk, int lane) {
    const int kb = item / nblk, nb = item % nblk, k0 = 64 * kb, n0 = 32 * nb;
    const bool nok = (n0 + (lane & 31)) < N;
#pragma unroll 8
    for (int i = 0; i < 32; ++i) { const int kk = 2 * i + (lane >> 5); scr[kk * 33 + (lane & 31)] = nok ? W[(size_t)(k0 + kk) * N + n0 + (lane & 31)] : 0.f; }
    asm volatile("s_waitcnt lgkmcnt(0)" ::: "memory");
    const int c = lane & 7;
#pragma unroll
    for (int j = 0; j < 4; ++j) { const int n = (lane >> 3) + 8 * j; const LAS float* s = scr + (8 * c) * 33 + n;
        u32x4 o; o.x = pk2(s[0 * 33], s[1 * 33]); o.y = pk2(s[2 * 33], s[3 * 33]); o.z = pk2(s[4 * 33], s[5 * 33]); o.w = pk2(s[6 * 33], s[7 * 33]);
        *(u32x4*)(WT + (size_t)(n0 + n) * K + k0 + 8 * c) = o; }
    asm volatile("s_waitcnt lgkmcnt(0)" ::: "memory");
}
__device__ __forceinline__ void phase_convert(const Params& P, const Ctx& C, int l) {
    LAS float* scr = (LAS float*)(C.lds + 32768 + C.wave * 8704);
    const int gw = C.bid * 8 + C.wave, NGW = C.G * 8; const int j = l >> 1; const bool ev = (l & 1) == 0;
    const float* win = ev ? P.in[I_WINAB] + (size_t)j * 1024 * N_AB : P.in[I_WINCD] + (size_t)j * 1024 * N_CD;
    const float* wout = (ev ? P.in[I_WOUTAB] : P.in[I_WOUTCD]) + (size_t)j * 2048 * 1024;
    const float* wup = P.in[I_WUP] + (size_t)l * 1024 * 4096; const float* wdn = P.in[I_WDN] + (size_t)l * 4096 * 1024;
    const int N_in = ev ? N_AB : N_CD, Np = ev ? N_AB_P : N_CD_P;
    const int I0 = 16 * (Np / 32), I1 = 32 * 32, I2 = 16 * 128, I3 = 64 * 32;
    for (int it = gw; it < I0 + I1 + I2 + I3; it += NGW) {
        int r = it;
        if (r < I0) { transpose_item(win, 1024, N_in, (bf16_t*)(P.ws + WS_WIN), scr, r, Np / 32, C.lane); continue; } r -= I0;
        if (r < I1) { transpose_item(wout, 2048, 1024, (bf16_t*)(P.ws + WS_WOUT), scr, r, 32, C.lane); continue; } r -= I1;
        if (r < I2) { transpose_item(wup, 1024, 4096, (bf16_t*)(P.ws + WS_WUP), scr, r, 128, C.lane); continue; } r -= I2;
        transpose_item(wdn, 4096, 1024, (bf16_t*)(P.ws + WS_WDN), scr, r, 32, C.lane);
    }
    if (ev) {
        bf16_t* WL = (bf16_t*)(P.ws + WS_WLORA);
        for (int idx = C.bid * 512 + C.tid; idx < 5120 * 16; idx += C.G * 512) {
            const int n = idx % 5120, k8 = idx / 5120, g = n >> 10, cc = n & 1023; float o[8];
#pragma unroll
            for (int e = 0; e < 8; ++e) { const int k = k8 * 8 + e; float v = 0.f;
                if (g == 0) { if (k < 64) v = P.in[I_W2][((size_t)(j * 2 + 0) * 64 + k) * 1024 + cc]; }
                else if (g == 1) { if (k >= 64) v = P.in[I_W2][((size_t)(j * 2 + 1) * 64 + (k - 64)) * 1024 + cc]; }
                else if (g == 2) { if (k < 64) v = P.in[I_A2][((size_t)(j * 2 + 0) * 64 + k) * 1024 + cc]; }
                else if (g == 3) { if (k >= 64) v = P.in[I_A2][((size_t)(j * 2 + 1) * 64 + (k - 64)) * 1024 + cc]; }
                else v = P.in[I_G2][((size_t)j * 128 + k) * 1024 + cc];
                o[e] = v; }
            *(u32x4*)(WL + (size_t)n * 128 + k8 * 8) = pack8(o);
        }
    }
}

__device__ __forceinline__ void phase_rows(const Params& P, const Ctx& C, int mode, const float* gpost, const float* gate_mod  ,
                                           bool next, const float* gpre, const float* mod_next  , bool dummy = false) {
    float* X = P.out + O_X; const bf16_t* MP0 = (const bf16_t*)(P.ws + WS_MP); const bf16_t* MP1 = MP0 + (size_t)MTOK * DM; bf16_t* H = (bf16_t*)(P.ws + WS_H);
    const int gw = C.bid * 8 + C.wave, NGW = C.G * 8;
    for (int m = gw; m < MTOK; m += NGW) {
        const int mr = m < 4096 ? 0 : 1 + ((m - 4096) >> 10);
        f32x4 x[4];
        if (mode == 0) { const f32x4* src = (const f32x4*)(m < 4096 ? P.in[I_XP] + (size_t)m * DM : P.in[I_XS] + (size_t)(m - 4096) * DM) + C.lane;
#pragma unroll
            for (int j = 0; j < 4; ++j) x[j] = src[64 * j];
        } else {
            const f32x4* xs = (const f32x4*)(X + (size_t)m * DM) + C.lane; const u32x2* p0 = (const u32x2*)(MP0 + (size_t)m * DM) + C.lane; const u32x2* p1 = (const u32x2*)(MP1 + (size_t)m * DM) + C.lane;
            f32x4 f[4]; float ss = 0.f;
#pragma unroll
            for (int j = 0; j < 4; ++j) { x[j] = xs[64 * j]; f[j] = unpack4(p0[64 * j]) + unpack4(p1[64 * j]); ss += (f[j].x * f[j].x + f[j].y * f[j].y) + (f[j].z * f[j].z + f[j].w * f[j].w); }
            const float rs = rsqrtf(wave_sum(ss) * (1.f / DM) + 1e-6f);
            const f32x4* gp = (const f32x4*)gpost + C.lane; const f32x4* gt = (const f32x4*)(gate_mod + (size_t)mr * 6144) + C.lane;
#pragma unroll
            for (int j = 0; j < 4; ++j) x[j] = x[j] + gt[64 * j] * (f[j] * rs * gp[64 * j]);
        }
        f32x4* xo = (f32x4*)((dummy ? (float*)(P.ws + WS_PREP) : X) + (size_t)m * DM) + C.lane;
#pragma unroll
        for (int j = 0; j < 4; ++j) xo[64 * j] = x[j];
        if (next) {
            float ss = 0.f;
#pragma unroll
            for (int j = 0; j < 4; ++j) ss += (x[j].x * x[j].x + x[j].y * x[j].y) + (x[j].z * x[j].z + x[j].w * x[j].w);
            const float rs = rsqrtf(wave_sum(ss) * (1.f / DM) + 1e-6f);
            const f32x4* gp = (const f32x4*)gpre + C.lane; const f32x4* sh = (const f32x4*)(mod_next + (size_t)mr * 6144) + C.lane; const f32x4* sl = (const f32x4*)(mod_next + (size_t)mr * 6144 + 1024) + C.lane;
            u32x2* ho = (u32x2*)((dummy ? (bf16_t*)(P.ws + WS_PREP + 40 * MiB) : H) + (size_t)m * DM) + C.lane;
#pragma unroll
            for (int j = 0; j < 4; ++j) { const f32x4 h = (x[j] * rs * gp[64 * j]) * (sl[64 * j] + 1.f) + sh[64 * j]; u32x2 w; w.x = pk2(h.x, h.y); w.y = pk2(h.z, h.w); ho[64 * j] = w; }
        }
    }
}

__device__ __forceinline__ void conv8(const bf16_t* src, int ld, int col0, int base, int t, bool samp, const float* w, const float* b, int NC, int ch, float* acc) {
    { const f32x4 b0 = *(const f32x4*)(b + ch), b1 = *(const f32x4*)(b + ch + 4); acc[0] = b0.x; acc[1] = b0.y; acc[2] = b0.z; acc[3] = b0.w; acc[4] = b1.x; acc[5] = b1.y; acc[6] = b1.z; acc[7] = b1.w; }
    if (!samp) {
#pragma unroll
        for (int d = 0; d < 3; ++d) { const int tt = t + d - 1; if (tt < 0 || tt >= 256) continue;
            float xv[8]; unpack8(*(const u32x4*)(src + (size_t)(base + tt) * ld + col0 + ch), xv);
            const f32x4 w0 = *(const f32x4*)(w + (3 + d) * NC + ch), w1 = *(const f32x4*)(w + (3 + d) * NC + ch + 4);
            acc[0] += w0.x * xv[0]; acc[1] += w0.y * xv[1]; acc[2] += w0.z * xv[2]; acc[3] += w0.w * xv[3]; acc[4] += w1.x * xv[4]; acc[5] += w1.y * xv[5]; acc[6] += w1.z * xv[6]; acc[7] += w1.w * xv[7]; }
    } else {
        const int r = t >> 6, c = t & 63;
#pragma unroll
        for (int i = 0; i < 3; ++i)
#pragma unroll
            for (int d = 0; d < 3; ++d) { const int rr = r + i - 1, cc = c + d - 1; if (rr < 0 || rr >= 16 || cc < 0 || cc >= 64) continue;
                float xv[8]; unpack8(*(const u32x4*)(src + (size_t)(base + rr * 64 + cc) * ld + col0 + ch), xv);
                const f32x4 w0 = *(const f32x4*)(w + (i * 3 + d) * NC + ch), w1 = *(const f32x4*)(w + (i * 3 + d) * NC + ch + 4);
                acc[0] += w0.x * xv[0]; acc[1] += w0.y * xv[1]; acc[2] += w0.z * xv[2]; acc[3] += w0.w * xv[3]; acc[4] += w1.x * xv[4]; acc[5] += w1.y * xv[5]; acc[6] += w1.z * xv[6]; acc[7] += w1.w * xv[7]; }
    }
}

__device__ __forceinline__ void phase_prep_even(const Params& P, const Ctx& C, int j) {
    const bf16_t* PROJ = (const bf16_t*)(P.ws + WS_PROJ); bf16_t* PREP = (bf16_t*)(P.ws + WS_PREP); bf16_t* LA = (bf16_t*)(P.ws + WS_LORAA);
    float* DT = (float*)(P.ws + WS_DT); float* DA = (float*)(P.ws + WS_DA);
    const float* cw = P.in[I_SCONVW] + (size_t)j * 9 * 2048; const float* cb = P.in[I_SCONVB] + j * 2048;
    const float* mu = P.in[I_MU] + j * 3456; const float* kkw = P.in[I_KK] + j * 1024;
    const int gw = C.bid * 8 + C.wave, NGW = C.G * 8, lane = C.lane;
    for (int m = gw; m < MTOK; m += NGW) {
        const bool samp = m >= 4096; const int T = samp ? 1024 : 256; const int t = samp ? ((m - 4096) & 1023) : (m & 255); const int base = m - t;
        const bf16_t* prow = PROJ + (size_t)m * PROJ_LD_AB; bf16_t* orow = PREP + (size_t)m * PREP_LD;
#pragma unroll 1
        for (int it = 0; it < 4; ++it) { const int ch = it * 512 + lane * 8; float acc[8];
            conv8(PROJ, PROJ_LD_AB, 1024, base, t, samp, cw, cb, 2048, ch, acc);
#pragma unroll
            for (int e = 0; e < 8; ++e) acc[e] = siluf_(acc[e]);
            *(u32x4*)(orow + ch) = pack8(acc); }
#pragma unroll
        for (int it = 0; it < 2; ++it) { const int ch = it * 512 + lane * 8; float z[8]; unpack8(*(const u32x4*)(prow + ch), z);
#pragma unroll
            for (int e = 0; e < 8; ++e) z[e] = siluf_(z[e]);
            *(u32x4*)(orow + 2048 + ch) = pack8(z); }
        if (lane < 32) { const float raw = bf2f(prow[3072 + lane]); const float dt = softplusf_(raw + P.in[I_DTB][j * 32 + lane]);
            DT[(size_t)m * 32 + lane] = dt; DA[(size_t)m * 32 + lane] = -dt * __expf(P.in[I_ALOG][j * 32 + lane]); }
        const bool hp = t > 0, hn = t < T - 1;
#pragma unroll 1
        for (int it = 0; it < 7; ++it) { const int c = it * 512 + lane * 8; if (c >= 3456) break;
            float x[8], xp[8], xn[8];
            unpack8(*(const u32x4*)(prow + IN_SSD + c), x);
            if (hp) unpack8(*(const u32x4*)(prow - PROJ_LD_AB + IN_SSD + c), xp); else {
#pragma unroll
                for (int e = 0; e < 8; ++e) xp[e] = 0.f; }
            if (hn) unpack8(*(const u32x4*)(prow + PROJ_LD_AB + IN_SSD + c), xn); else {
#pragma unroll
                for (int e = 0; e < 8; ++e) xn[e] = 0.f; }
            const f32x4 m0 = *(const f32x4*)(mu + c), m1 = *(const f32x4*)(mu + c + 4);
            const float mv[8] = {m0.x, m0.y, m0.z, m0.w, m1.x, m1.y, m1.z, m1.w};
#pragma unroll
            for (int e = 0; e < 8; ++e) x[e] = x[e] + mv[e] * (0.5f * (xp[e] + xn[e]) - x[e]);
            if (it < 2) { *(u32x4*)(orow + 3072 + c) = pack8(x); }
            else if (it < 4) { *(u32x4*)(orow + 4096 + (c - 1024)) = pack8(x);
                const f32x4 k0 = *(const f32x4*)(kkw + c - 1024), k1 = *(const f32x4*)(kkw + c - 1024 + 4);
                const float kv[8] = {k0.x, k0.y, k0.z, k0.w, k1.x, k1.y, k1.z, k1.w}; float ss = 0.f;
#pragma unroll
                for (int e = 0; e < 8; ++e) { x[e] *= kv[e]; ss += x[e] * x[e]; }
                ss += __shfl_xor(ss, 1); ss += __shfl_xor(ss, 2); ss += __shfl_xor(ss, 4);
                const float rn = rsqrtf(ss + 1e-12f);
#pragma unroll
                for (int e = 0; e < 8; ++e) x[e] *= rn;
                *(u32x4*)(orow + 6144 + (c - 1024)) = pack8(x); }
            else if (it < 6) { *(u32x4*)(orow + 5120 + (c - 2048)) = pack8(x); }
            else { const int cc = c - 3072;
#pragma unroll
                for (int e = 0; e < 8; ++e) x[e] = cc < 128 ? tanhf_(x[e]) : (cc < 256 ? x[e] : sigmoidf_(x[e]));
                *(u32x4*)(LA + (size_t)m * LORA_K + cc) = pack8(x); }
        }
    }
}
__device__ __forceinline__ void phase_prep_odd(const Params& P, const Ctx& C, int j) {
    const bf16_t* PROJ = (const bf16_t*)(P.ws + WS_PROJ); bf16_t* PREP = (bf16_t*)(P.ws + WS_PREP);
    const float* cw = P.in[I_MCONVW] + (size_t)j * 9 * 1024; const float* cb = P.in[I_MCONVB] + j * 1024;
    const int gw = C.bid * 8 + C.wave, NGW = C.G * 8, lane = C.lane;
    for (int m = gw; m < MTOK; m += NGW) {
        const bool samp = m >= 4096; const int t = samp ? ((m - 4096) & 1023) : (m & 255); const int base = m - t;
#pragma unroll 1
        for (int it = 0; it < 2; ++it) { const int ch = it * 512 + lane * 8; float acc[8];
            conv8(PROJ, PROJ_LD_CD, IN_GLA, base, t, samp, cw, cb, 1024, ch, acc);
#pragma unroll
            for (int e = 0; e < 8; ++e) acc[e] = siluf_(acc[e]);
            *(u32x4*)(PREP + (size_t)m * PREP_LD + ch) = pack8(acc); }
    }
}

constexpr int CS_QLD = 136, CS_SLD = 72;
constexpr int CS_QS = 0, CS_KS = 17408, CS_KT = 34816, CS_VT = 53248;
__device__ __forceinline__ bf16x8 lds_frag(const LAS bf16_t* p) { return *(const LAS bf16x8*)p; }
template <int MODE>
__device__ __forceinline__ void chunk_scan(const Params& P, const Ctx& C, int j, int s, int dir, int h, int vs) {
    const int tid = C.tid, lane = C.lane, w = C.wave, fr = lane & 15, fq = lane >> 4;
    const int T = s < 16 ? 256 : 1024, base = s < 16 ? s * 256 : 4096 + (s - 16) * 1024, nch = T >> 6;
    const bf16_t* PROJ = (const bf16_t*)(P.ws + WS_PROJ); const bf16_t* PREP = (const bf16_t*)(P.ws + WS_PREP);
    bf16_t* Y = (bf16_t*)(P.ws + WS_MP) + (size_t)dir * MTOK * YLD;
    LAS bf16_t* Qs = (LAS bf16_t*)(C.lds + CS_QS); LAS bf16_t* Ks = (LAS bf16_t*)(C.lds + CS_KS); LAS bf16_t* Kt = (LAS bf16_t*)(C.lds + CS_KT); LAS bf16_t* Vt = (LAS bf16_t*)(C.lds + CS_VT);
    constexpr int NV = MODE == 0 ? 64 : 128, NVC = NV / 16, VROWS = NV + (MODE == 2 ? 16 : 0);
    constexpr int CS_ST = CS_VT + VROWS * CS_SLD * 2, CS_LA = CS_ST + VROWS * CS_QLD * 2, CS_PS = CS_LA  , CS_TOT = CS_LA + (MODE == 1 ? 32768 : 9216),
                  CS_BV = CS_TOT + 2560, CS_IG = CS_BV + 256, CS_FV = CS_IG + 256, CS_DTV = CS_FV + 256, CS_MS = CS_DTV + 256;
    static_assert(CS_MS + 64 <= LDS_BYTES - 16, "chunk-scan LDS map");
    LAS bf16_t* Ps = (LAS bf16_t*)(C.lds + CS_PS); LAS bf16_t* St = (LAS bf16_t*)(C.lds + CS_ST);
    LAS float* LA = (LAS float*)(C.lds + CS_LA); LAS float* TOT = (LAS float*)(C.lds + CS_TOT); LAS float* BV = (LAS float*)(C.lds + CS_BV); LAS float* IG = (LAS float*)(C.lds + CS_IG);
    LAS float* MS = (LAS float*)(C.lds + CS_MS); LAS float* FV = (LAS float*)(C.lds + CS_FV); LAS float* DTV = (LAS float*)(C.lds + CS_DTV);
    constexpr int NVT = NVC + (MODE == 2 ? 1 : 0);
    const int si = tid >> 3, kq = tid & 7;
    __syncthreads();
    bf16x8 gwa_hi = {0, 0, 0, 0, 0, 0, 0, 0}, gwa_lo = {0, 0, 0, 0, 0, 0, 0, 0}; f32x4 gb4 = {0.f, 0.f, 0.f, 0.f};
    if (MODE == 1) {
        const float* gwp = P.in[I_GGW] + (size_t)(j * 2 + dir) * 16 * 512 + h * 128 + 16 * w + fr;
        if (fq < 2) {
#pragma unroll
            for (int e = 0; e < 8; ++e) { const float g = gwp[(8 * fq + e) * 512]; const unsigned hb = f2bf(g); const float rem = g - bf2f(hb); gwa_hi[e] = (short)hb; gwa_lo[e] = (short)f2bf(rem); } }
        gb4 = *(const f32x4*)(P.in[I_GGB] + (j * 2 + dir) * 512 + h * 128 + 16 * w + 4 * fq);
    }
    f32x4 Sacc[NVT];
    {
        const float* s0 = nullptr; int kstride = 64; float em0 = 1.f;
        if (s >= 16) { const int b = s - 16;
            if (MODE == 0) { s0 = P.in[I_SSSD] + ((size_t)((b * 2 + j) * 2 + dir) * 16 + h) * 8192; kstride = 64; }
            if (MODE == 1) { s0 = P.in[I_SGLA] + ((size_t)((b * 2 + j) * 2 + dir) * 4 + h) * 32768 + vs * NV; kstride = 256; }
            if (MODE == 2) { s0 = P.in[I_SMC] + ((size_t)((b * 2 + j) * 2 + dir) * 4 + h) * 32768 + vs * NV; kstride = 256; em0 = __expf(P.in[I_SMM][((b * 2 + j) * 2 + dir) * 4 + h]); } }
#pragma unroll
        for (int vt = 0; vt < NVC; ++vt)
#pragma unroll
            for (int e = 0; e < 4; ++e) Sacc[vt][e] = s0 ? s0[(size_t)(16 * w + 4 * fq + e) * kstride + 16 * vt + fr] * em0 : 0.f;
        if (MODE == 2) {
            const float* n0 = s >= 16 ? P.in[I_SMN] + ((size_t)(((s - 16) * 2 + j) * 2 + dir) * 4 + h) * 128 : nullptr;
#pragma unroll
            for (int e = 0; e < 4; ++e) Sacc[NVT - 1][e] = (n0 && fr == 0) ? n0[16 * w + 4 * fq + e] * em0 : 0.f;
            if (tid == 0) MS[0] = s >= 16 ? P.in[I_SMM][(((s - 16) * 2 + j) * 2 + dir) * 4 + h] : 0.f;
            for (int i = tid; i < 16 * CS_SLD; i += 512) Vt[NV * CS_SLD + i] = (bf16_t)((i < CS_SLD) ? 0x3F80 : 0);
        }
#pragma unroll
        for (int vt = 0; vt < NVT; ++vt) { u32x2 wv; wv.x = pk2(Sacc[vt][0], Sacc[vt][1]); wv.y = pk2(Sacc[vt][2], Sacc[vt][3]); *(LAS u32x2*)(St + (16 * vt + fr) * CS_QLD + 16 * w + 4 * fq) = wv; }
    }
    u32x4 rq0, rq1, rk0, rk1, rgd[4]; float rla = 0.f, rig = 0.f, rdt = 0.f;
    constexpr int NVTOK = MODE == 0 ? 8 : 16;
    unsigned short rkt[16], rvt[NVTOK];
    const int kx = tid & 127, tgk = tid >> 7, vx = tid & (NV - 1), tgv = MODE == 0 ? (tid >> 6) : (tid >> 7);
    auto tok = [&](int c, int i) { const int st0 = c * 64 + i; return base + (dir ? (T - 1 - st0) : st0); };
    auto load_raw = [&](int c) {
        const int m = tok(c, si); const int m1 = tok(c, tid & 63);
        const bf16_t* krow; const bf16_t* vrow; int kld, vld;
        if (MODE == 0) { const int g = h >> 2; const bf16_t* pr = PREP + (size_t)m * PREP_LD;
            rq0 = *(const u32x4*)(pr + 1536 + g * 128 + 16 * kq); rq1 = *(const u32x4*)(pr + 1536 + g * 128 + 16 * kq + 8);
            rk0 = *(const u32x4*)(pr + 1024 + g * 128 + 16 * kq); rk1 = *(const u32x4*)(pr + 1024 + g * 128 + 16 * kq + 8);
            if (tid < 64) { rla = ((const float*)(P.ws + WS_DA))[(size_t)m1 * 32 + dir * 16 + h]; rdt = ((const float*)(P.ws + WS_DT))[(size_t)m1 * 32 + dir * 16 + h]; }
            krow = PREP + 1024 + g * 128 + kx; kld = PREP_LD; vrow = PREP + h * 64 + vx; vld = PREP_LD; }
        if (MODE == 1) { const bf16_t* pr = PROJ + (size_t)m * PROJ_LD_CD;
            rq0 = *(const u32x4*)(pr + h * 128 + 16 * kq); rq1 = *(const u32x4*)(pr + h * 128 + 16 * kq + 8);
            rk0 = *(const u32x4*)(pr + 512 + h * 128 + 16 * kq); rk1 = *(const u32x4*)(pr + 512 + h * 128 + 16 * kq + 8);
#pragma unroll
            for (int t4 = 0; t4 < 4; ++t4) { rgd[t4] = (u32x4){0u, 0u, 0u, 0u}; if (fq < 2) rgd[t4] = *(const u32x4*)(PROJ + (size_t)tok(c, 16 * t4 + fr) * PROJ_LD_CD + 3072 + dir * 16 + 8 * fq); }
            krow = PROJ + 512 + h * 128 + kx; kld = PROJ_LD_CD; vrow = PROJ + 1024 + h * 256 + vs * NV + vx; vld = PROJ_LD_CD; }
        if (MODE == 2) { const bf16_t* pp = PREP + (size_t)m * PREP_LD;
            rq0 = *(const u32x4*)(pp + h * 128 + 16 * kq); rq1 = *(const u32x4*)(pp + h * 128 + 16 * kq + 8);
            rk0 = *(const u32x4*)(pp + 512 + h * 128 + 16 * kq); rk1 = *(const u32x4*)(pp + 512 + h * 128 + 16 * kq + 8);
            if (tid < 64) { const bf16_t* p1 = PROJ + (size_t)m1 * PROJ_LD_CD + IN_GLA + 3072; rig = bf2f(p1[dir * 4 + h]); rla = bf2f(p1[8 + dir * 4 + h]); }
            krow = PREP + 512 + h * 128 + kx; kld = PREP_LD; vrow = PROJ + IN_GLA + 1024 + h * 256 + vs * NV + vx; vld = PROJ_LD_CD; }
        { const bf16_t* kp = krow + (size_t)tok(c, 16 * tgk) * kld; const long ks_ = dir ? -(long)kld : (long)kld;
#pragma unroll
          for (int jj = 0; jj < 16; ++jj) { rkt[jj] = *kp; kp += ks_; }
          const bf16_t* vp = vrow + (size_t)tok(c, NVTOK * tgv) * vld; const long vs_ = dir ? -(long)vld : (long)vld;
#pragma unroll
          for (int jj = 0; jj < NVTOK; ++jj) { rvt[jj] = *vp; vp += vs_; } }
    };
    load_raw(0);
    __syncthreads();
    const int ycol0 = (MODE == 0 ? h * 64 : (MODE == 1 ? h * 256 + vs * NV : 1024 + h * 256 + vs * NV));
    for (int c = 0; c < nch; ++c) {
        if (MODE == 1) {
#pragma unroll
            for (int t4 = 0; t4 < 4; ++t4) { f32x4 acc = (f32x4){0.f, 0.f, 0.f, 0.f}; const bf16x8 gf = __builtin_bit_cast(bf16x8, rgd[t4]);
                acc = __builtin_amdgcn_mfma_f32_16x16x32_bf16(gwa_hi, gf, acc, 0, 0, 0); acc = __builtin_amdgcn_mfma_f32_16x16x32_bf16(gwa_lo, gf, acc, 0, 0, 0);
                f32x4 la;
#pragma unroll
                for (int e = 0; e < 4; ++e) la[e] = logsigmoidf_(acc[e] + gb4[e]) * 0.0625f;
                *(LAS f32x4*)(LA + (16 * t4 + fr) * 128 + 16 * w + 4 * fq) = la; }
        } else if (tid < 64) {
            float ig = 0.f, la = rla;
            if (MODE == 2) { ig = rig + P.in[I_MIB][(j * 2 + dir) * 4 + h]; la = logsigmoidf_(rla + P.in[I_MFB][(j * 2 + dir) * 4 + h]); }
            float x = la;
            x += __int_as_float(__builtin_amdgcn_update_dpp(0, __float_as_int(x), 0x111, 0xF, 0xF, true));
            x += __int_as_float(__builtin_amdgcn_update_dpp(0, __float_as_int(x), 0x112, 0xF, 0xF, true));
            x += __int_as_float(__builtin_amdgcn_update_dpp(0, __float_as_int(x), 0x114, 0xF, 0xF, true));
            x += __int_as_float(__builtin_amdgcn_update_dpp(0, __float_as_int(x), 0x118, 0xF, 0xF, true));
            { const float t0 = __int_as_float(__builtin_amdgcn_readlane(__float_as_int(x), 15)), t1 = __int_as_float(__builtin_amdgcn_readlane(__float_as_int(x), 31)), t2 = __int_as_float(__builtin_amdgcn_readlane(__float_as_int(x), 47));
              const int rw = lane >> 4; x += (rw > 0 ? t0 : 0.f) + (rw > 1 ? t1 : 0.f) + (rw > 2 ? t2 : 0.f); }
            const float bl = __int_as_float(__builtin_amdgcn_readlane(__float_as_int(x), 63));
            const float kgn = MODE == 2 ? 0.08838834764831845f * __expf(ig) : 1.f;
            BV[tid] = x; IG[tid] = kgn; FV[tid] = kgn * __expf(bl - x); DTV[tid] = MODE == 0 ? rdt : 1.f;
            if (MODE == 2) { float ml = bl - x + ig;
                ml = fmaxf(ml, __int_as_float(__builtin_amdgcn_update_dpp(__float_as_int(ml), __float_as_int(ml), 0xB1, 0xF, 0xF, false)));
                ml = fmaxf(ml, __int_as_float(__builtin_amdgcn_update_dpp(__float_as_int(ml), __float_as_int(ml), 0x4E, 0xF, 0xF, false)));
                ml = fmaxf(ml, __int_as_float(__builtin_amdgcn_update_dpp(__float_as_int(ml), __float_as_int(ml), 0x141, 0xF, 0xF, false)));
                ml = fmaxf(ml, __int_as_float(__builtin_amdgcn_update_dpp(__float_as_int(ml), __float_as_int(ml), 0x140, 0xF, 0xF, false)));
                const float m01 = fmaxf(__int_as_float(__builtin_amdgcn_readlane(__float_as_int(ml), 0)), __int_as_float(__builtin_amdgcn_readlane(__float_as_int(ml), 16)));
                const float m23 = fmaxf(__int_as_float(__builtin_amdgcn_readlane(__float_as_int(ml), 32)), __int_as_float(__builtin_amdgcn_readlane(__float_as_int(ml), 48)));
                if (tid == 0) MS[0] = fmaxf(bl + MS[0], fmaxf(m01, m23)); }
        }
        __syncthreads();
        if (MODE == 1) {
            const int k = tid & 127, qd = tid >> 7; float run = 0.f;
#pragma unroll
            for (int jj = 0; jj < 16; ++jj) { run += LA[(16 * qd + jj) * 128 + k]; LA[(16 * qd + jj) * 128 + k] = run; }
            TOT[qd * 128 + k] = run;
            __syncthreads();
            if (tid < 128) TOT[4 * 128 + tid] = __expf(TOT[tid] + TOT[128 + tid] + TOT[256 + tid] + TOT[384 + tid]);
        }
        {
            float q[16], k[16]; unpack8(rq0, q); unpack8(rq1, q + 8); unpack8(rk0, k); unpack8(rk1, k + 8);
            float qs[16], ks[16];
            if (MODE == 1) { const int qd = si >> 4;
#pragma unroll
                for (int e4 = 0; e4 < 4; ++e4) { const int kk = 16 * kq + 4 * e4; const f32x4 bb = *(LAS f32x4*)(LA + si * 128 + kk), t0 = *(LAS f32x4*)(TOT + kk), t1 = *(LAS f32x4*)(TOT + 128 + kk), t2 = *(LAS f32x4*)(TOT + 256 + kk);
#pragma unroll
                    for (int e = 0; e < 4; ++e) { const float b = bb[e] + (qd > 0 ? t0[e] : 0.f) + (qd > 1 ? t1[e] : 0.f) + (qd > 2 ? t2[e] : 0.f);
                        qs[4 * e4 + e] = q[4 * e4 + e] * 0.08838834764831845f * __expf(b); ks[4 * e4 + e] = k[4 * e4 + e] * __expf(fminf(-b, 80.f)); } }
            } else { const float kgn = IG[si];
#pragma unroll
                for (int e = 0; e < 16; ++e) { qs[e] = q[e]; ks[e] = k[e] * kgn; } }
            *(LAS u32x4*)(Qs + si * CS_QLD + 16 * kq) = pack8(qs); *(LAS u32x4*)(Qs + si * CS_QLD + 16 * kq + 8) = pack8(qs + 8);
            *(LAS u32x4*)(Ks + si * CS_QLD + 16 * kq) = pack8(ks); *(LAS u32x4*)(Ks + si * CS_QLD + 16 * kq + 8) = pack8(ks + 8);
        }
        if (MODE == 1)
        {
            float kt[16];
            if (MODE == 1) { float off = 0.f; const float t0 = TOT[kx], t1 = TOT[128 + kx], t2 = TOT[256 + kx], t3 = TOT[384 + kx];
                off = (tgk > 0 ? t0 : 0.f) + (tgk > 1 ? t1 : 0.f) + (tgk > 2 ? t2 : 0.f); const float bl = (t0 + t1) + (t2 + t3);
#pragma unroll
                for (int jj = 0; jj < 16; ++jj) kt[jj] = bf2f(rkt[jj]) * __expf(bl - (LA[(16 * tgk + jj) * 128 + kx] + off));
            } else {
#pragma unroll
                for (int jj = 0; jj < 16; ++jj) kt[jj] = bf2f(rkt[jj]) * FV[16 * tgk + jj]; }
            *(LAS u32x4*)(Kt + kx * CS_SLD + 16 * tgk) = pack8(kt); *(LAS u32x4*)(Kt + kx * CS_SLD + 16 * tgk + 8) = pack8(kt + 8);
            float vt8[NVTOK];
#pragma unroll
            for (int jj = 0; jj < NVTOK; ++jj) vt8[jj] = bf2f(rvt[jj]) * (MODE == 0 ? DTV[NVTOK * tgv + jj] : 1.f);
            *(LAS u32x4*)(Vt + vx * CS_SLD + NVTOK * tgv) = pack8(vt8);
            if (NVTOK == 16) *(LAS u32x4*)(Vt + vx * CS_SLD + NVTOK * tgv + 8) = pack8(vt8 + 8);
        }
        __syncthreads();
        if (MODE != 1)
        {
            float kt[16];
            if (MODE == 1) { float off = 0.f; const float t0 = TOT[kx], t1 = TOT[128 + kx], t2 = TOT[256 + kx], t3 = TOT[384 + kx];
                off = (tgk > 0 ? t0 : 0.f) + (tgk > 1 ? t1 : 0.f) + (tgk > 2 ? t2 : 0.f); const float bl = (t0 + t1) + (t2 + t3);
#pragma unroll
                for (int jj = 0; jj < 16; ++jj) kt[jj] = bf2f(rkt[jj]) * __expf(bl - (LA[(16 * tgk + jj) * 128 + kx] + off));
            } else {
#pragma unroll
                for (int jj = 0; jj < 16; ++jj) kt[jj] = bf2f(rkt[jj]) * FV[16 * tgk + jj]; }
            *(LAS u32x4*)(Kt + kx * CS_SLD + 16 * tgk) = pack8(kt); *(LAS u32x4*)(Kt + kx * CS_SLD + 16 * tgk + 8) = pack8(kt + 8);
            float vt8[NVTOK];
#pragma unroll
            for (int jj = 0; jj < NVTOK; ++jj) vt8[jj] = bf2f(rvt[jj]) * (MODE == 0 ? DTV[NVTOK * tgv + jj] : 1.f);
            *(LAS u32x4*)(Vt + vx * CS_SLD + NVTOK * tgv) = pack8(vt8);
            if (NVTOK == 16) *(LAS u32x4*)(Vt + vx * CS_SLD + NVTOK * tgv + 8) = pack8(vt8 + 8);
        }
        if (c + 1 < nch) load_raw(c + 1);
        const int tt = w >> 1;
#pragma unroll
        for (int sj = 0; sj < 2; ++sj) { const int st = 2 * (w & 1) + sj; u32x2 wv; wv.x = 0u; wv.y = 0u;
            if (st <= tt) { f32x4 acc = (f32x4){0.f, 0.f, 0.f, 0.f};
#pragma unroll
                for (int kk = 0; kk < 4; ++kk) acc = __builtin_amdgcn_mfma_f32_16x16x32_bf16(lds_frag(Ks + (16 * st + fr) * CS_QLD + 32 * kk + 8 * fq), lds_frag(Qs + (16 * tt + fr) * CS_QLD + 32 * kk + 8 * fq), acc, 0, 0, 0);
                const int tg = 16 * tt + fr, sg = 16 * st + 4 * fq;
                if (MODE != 1) { const float bt = BV[tg]; const f32x4 bs = *(LAS f32x4*)(BV + sg);
#pragma unroll
                    for (int e = 0; e < 4; ++e) acc[e] *= __expf(fminf(bt - bs[e], 0.f)); }
#pragma unroll
                for (int e = 0; e < 4; ++e) acc[e] = (sg + e <= tg) ? acc[e] : 0.f;
                wv.x = pk2(acc[0], acc[1]); wv.y = pk2(acc[2], acc[3]); }
            *(LAS u32x2*)(Ps + (16 * tt + fr) * CS_SLD + 16 * st + 4 * fq) = wv; }
        __syncthreads();
        {
            const int tg = 16 * tt + fr; const int stp = c * 64 + tg; const int m = base + (dir ? (T - 1 - stp) : stp);
            const float ebt = MODE == 1 ? 1.f : __expf(BV[tg]);
            bf16x8 pf[2], qf[4];
#pragma unroll
            for (int ks2 = 0; ks2 < 2; ++ks2) pf[ks2] = lds_frag(Ps + tg * CS_SLD + 32 * ks2 + 8 * fq);
#pragma unroll
            for (int kk = 0; kk < 4; ++kk) qf[kk] = lds_frag(Qs + tg * CS_QLD + 32 * kk + 8 * fq);
            float rden = 1.f;
            if (MODE == 2) { f32x4 ai = (f32x4){0.f, 0.f, 0.f, 0.f}, ao = (f32x4){0.f, 0.f, 0.f, 0.f};
#pragma unroll
                for (int ks2 = 0; ks2 < 2; ++ks2) ai = __builtin_amdgcn_mfma_f32_16x16x32_bf16(lds_frag(Vt + (NV + fr) * CS_SLD + 32 * ks2 + 8 * fq), pf[ks2], ai, 0, 0, 0);
#pragma unroll
                for (int kk = 0; kk < 4; ++kk) ao = __builtin_amdgcn_mfma_f32_16x16x32_bf16(lds_frag(St + (NV + fr) * CS_QLD + 32 * kk + 8 * fq), qf[kk], ao, 0, 0, 0);
                const float den = __shfl(ai[0] + ao[0] * ebt, fr); rden = 1.f / fmaxf(fabsf(den), 1.f); }
#pragma unroll
            for (int vj = 0; vj < NVC / 2; ++vj) { const int vt = (NVC / 2) * (w & 1) + vj; f32x4 ai = (f32x4){0.f, 0.f, 0.f, 0.f}, ao = (f32x4){0.f, 0.f, 0.f, 0.f};
#pragma unroll
                for (int ks2 = 0; ks2 < 2; ++ks2) ai = __builtin_amdgcn_mfma_f32_16x16x32_bf16(lds_frag(Vt + (16 * vt + fr) * CS_SLD + 32 * ks2 + 8 * fq), pf[ks2], ai, 0, 0, 0);
#pragma unroll
                for (int kk = 0; kk < 4; ++kk) ao = __builtin_amdgcn_mfma_f32_16x16x32_bf16(lds_frag(St + (16 * vt + fr) * CS_QLD + 32 * kk + 8 * fq), qf[kk], ao, 0, 0, 0);
                u32x2 wv; wv.x = pk2((ai[0] + ao[0] * ebt) * rden, (ai[1] + ao[1] * ebt) * rden); wv.y = pk2((ai[2] + ao[2] * ebt) * rden, (ai[3] + ao[3] * ebt) * rden);
                *(u32x2*)(Y + (size_t)m * YLD + ycol0 + 16 * vt + 4 * fq) = wv; }
        }
        {
            f32x4 dec; if (MODE == 1) dec = *(LAS f32x4*)(TOT + 4 * 128 + 16 * w + 4 * fq); else { const float d = __expf(BV[63]); dec = (f32x4){d, d, d, d}; }
            bf16x8 kf[2];
#pragma unroll
            for (int ks2 = 0; ks2 < 2; ++ks2) kf[ks2] = lds_frag(Kt + (16 * w + fr) * CS_SLD + 32 * ks2 + 8 * fq);
#pragma unroll
            for (int vt = 0; vt < NVT; ++vt) { Sacc[vt] = Sacc[vt] * dec;
#pragma unroll
                for (int ks2 = 0; ks2 < 2; ++ks2) Sacc[vt] = __builtin_amdgcn_mfma_f32_16x16x32_bf16(kf[ks2], lds_frag(Vt + (16 * vt + fr) * CS_SLD + 32 * ks2 + 8 * fq), Sacc[vt], 0, 0, 0); }
        }
        __syncthreads();
#pragma unroll
        for (int vt = 0; vt < NVT; ++vt) { u32x2 wv; wv.x = pk2(Sacc[vt][0], Sacc[vt][1]); wv.y = pk2(Sacc[vt][2], Sacc[vt][3]); *(LAS u32x2*)(St + (16 * vt + fr) * CS_QLD + 16 * w + 4 * fq) = wv; }
    }
    if (s < 16) {
        float* o; int kstride; float sc = 1.f;
        if (MODE == 0) { o = P.out + O_SSD + ((size_t)((s * 2 + j) * 2 + dir) * 16 + h) * 8192; kstride = 64; }
        else { o = P.out + (MODE == 1 ? O_GLA : O_MC) + ((size_t)((s * 2 + j) * 2 + dir) * 4 + h) * 32768 + vs * NV; kstride = 256; }
        if (MODE == 2) { __syncthreads(); sc = __expf(-MS[0]); }
#pragma unroll
        for (int vt = 0; vt < NVC; ++vt)
#pragma unroll
            for (int e = 0; e < 4; ++e) o[(size_t)(16 * w + 4 * fq + e) * kstride + 16 * vt + fr] = Sacc[vt][e] * sc;
        if (MODE == 2 && vs == 0) {
            if (fr == 0) {
#pragma unroll
                for (int e = 0; e < 4; ++e) P.out[O_MN + ((size_t)((s * 2 + j) * 2 + dir) * 4 + h) * 128 + 16 * w + 4 * fq + e] = Sacc[NVT - 1][e] * sc; }
            if (tid == 0) P.out[O_MM + ((s * 2 + j) * 2 + dir) * 4 + h] = MS[0]; }
    }
}

struct RwOps { f32x4 kk0, kk1, w0, w1, kd0, kd1, ka0, ka1, r0, r1; f32x2 vv; };
__device__ __forceinline__ RwOps rw_ops(const LAS float* B, int tt, int kg, int vg) {
    const LAS float* p = B + tt * 64 + 4 * kg; RwOps o;
    o.kk0 = *(const LAS f32x4*)(p + 4096); o.kk1 = *(const LAS f32x4*)(p + 4096 + 32); o.w0 = *(const LAS f32x4*)(p + 1024); o.w1 = *(const LAS f32x4*)(p + 1024 + 32);
    o.kd0 = *(const LAS f32x4*)(p + 2048); o.kd1 = *(const LAS f32x4*)(p + 2048 + 32); o.ka0 = *(const LAS f32x4*)(p + 5120); o.ka1 = *(const LAS f32x4*)(p + 5120 + 32);
    o.r0 = *(const LAS f32x4*)(p); o.r1 = *(const LAS f32x4*)(p + 32); o.vv = *(const LAS f32x2*)(B + 3072 + tt * 64 + 2 * vg); return o;
}
__device__ __forceinline__ void rwkv_pair(const Params& P, const Ctx& C, int j, int bq, bool lng) {
    const int niter = lng ? 64 : 32; const bool act = !lng || C.tid < 256;
    const int tid = C.tid, half = tid >> 8, tl = tid & 255, kg = tl & 7, vg = tl >> 3;
    const bf16_t* PREP = (const bf16_t*)(P.ws + WS_PREP); const bf16_t* LOUT = (const bf16_t*)(P.ws + WS_PROJ);
    constexpr int BUFSZ = 6 * 1024;
    LAS float* L0 = (LAS float*)C.lds + half * 2 * BUFSZ;
    const int stt = tl >> 4, sc4 = (tl & 15) * 4;
    auto unit_of = [&](int cc, int& s, int& dir, int& h, int& lc) {
        if (lng) { s = 16 + (bq >> 5); dir = (bq >> 4) & 1; h = bq & 15; lc = cc; }
        else { const int q = 4 * bq + 2 * half + (cc >> 4); s = q >> 5; dir = (q >> 4) & 1; h = q & 15; lc = cc & 15; } };
    f32x2 S2[8];
    auto init_state = [&](int s, int dir, int h) {
        const float* s0 = s >= 16 ? P.in[I_SRWKV] + (((size_t)(((s - 16) * 2 + j) * 2 + dir) * 16 + h) * 64 + 2 * vg) * 64 : nullptr;
#pragma unroll
        for (int hh = 0; hh < 2; ++hh) { const f32x4 u0 = s0 ? *(const f32x4*)(s0 + 32 * hh + 4 * kg) : (f32x4){0.f, 0.f, 0.f, 0.f}, u1 = s0 ? *(const f32x4*)(s0 + 64 + 32 * hh + 4 * kg) : (f32x4){0.f, 0.f, 0.f, 0.f};
#pragma unroll
            for (int e = 0; e < 4; ++e) S2[hh * 4 + e] = (f32x2){u0[e], u1[e]}; } };
    u32x2 rr, rk, rv, rkk, rwl, ral; f32x4 cw0, ca0, cka;
    auto load_raw = [&](int cc) {
        int s, dir, h, lc; unit_of(cc, s, dir, h, lc);
        const int T = s < 16 ? 256 : 1024, base = s < 16 ? s * 256 : 4096 + (s - 16) * 1024;
        const int step = lc * 16 + stt; const int m = base + (dir ? (T - 1 - step) : step);
        const bf16_t* pp = PREP + (size_t)m * PREP_LD + h * 64 + sc4; const bf16_t* lo = LOUT + (size_t)m * LOUT_LD + dir * 1024 + h * 64 + sc4;
        rr = *(const u32x2*)(pp + 3072); rk = *(const u32x2*)(pp + 4096); rv = *(const u32x2*)(pp + 5120); rkk = *(const u32x2*)(pp + 6144);
        rwl = *(const u32x2*)lo; ral = *(const u32x2*)(lo + 2048);
        cw0 = *(const f32x4*)(P.in[I_W0] + (j * 2 + dir) * 1024 + h * 64 + sc4); ca0 = *(const f32x4*)(P.in[I_A0] + (j * 2 + dir) * 1024 + h * 64 + sc4); cka = *(const f32x4*)(P.in[I_KA] + j * 1024 + h * 64 + sc4);
    };
    auto write_lds = [&](LAS float* B) {
        const f32x4 r = unpack4(rr), k = unpack4(rk), v = unpack4(rv), kk = unpack4(rkk), wl = unpack4(rwl), al = unpack4(ral);
        f32x4 w, kd, kka;
#pragma unroll
        for (int e = 0; e < 4; ++e) { const float wp = cw0[e] + wl[e]; const float lw = -__expf(-softplusf_(-wp) - 0.5f); w[e] = __expf(lw);
            const float a = sigmoidf_(ca0[e] + al[e]); kd[e] = k[e] * (1.f + (a - 1.f) * cka[e]); kka[e] = kk[e] * a; }
        LAS float* p = B + stt * 64 + sc4;
        *(LAS f32x4*)(p) = r; *(LAS f32x4*)(p + 1024) = w; *(LAS f32x4*)(p + 2048) = kd; *(LAS f32x4*)(p + 3072) = v; *(LAS f32x4*)(p + 4096) = kk; *(LAS f32x4*)(p + 5120) = kka;
    };
    __syncthreads();
    if (act) { load_raw(0); write_lds(L0);
    { int s, dir, h, lc; unit_of(0, s, dir, h, lc); init_state(s, dir, h); } }
    __syncthreads();
#pragma unroll 1
    for (int cc = 0; cc < niter; ++cc) {
        if (act) {
        LAS float* B = L0 + (cc & 1) * BUFSZ;
        int s, dir, h, lc; unit_of(cc, s, dir, h, lc);
        const int T = s < 16 ? 256 : 1024, base = s < 16 ? s * 256 : 4096 + (s - 16) * 1024;
        if (cc + 1 < niter) load_raw(cc + 1);
        bf16_t* Y = (bf16_t*)(P.ws + WS_MP) + (size_t)dir * MTOK * YLD + 1024 + h * 64 + 2 * vg;
        RwOps cur = rw_ops(B, 0, kg, vg);
#pragma unroll 2
        for (int tt = 0; tt < 16; ++tt) {
            const RwOps nx = rw_ops(B, (tt + 1) & 15, kg, vg);
            const int step = lc * 16 + tt; const int m = base + (dir ? (T - 1 - step) : step);
            f32x2 da = (f32x2){0.f, 0.f}, db = (f32x2){0.f, 0.f};
#pragma unroll
            for (int e = 0; e < 4; ++e) { da = da + S2[e] * (f32x2){cur.kk0[e], cur.kk0[e]}; db = db + S2[4 + e] * (f32x2){cur.kk1[e], cur.kk1[e]}; }
            const f32x2 d2 = da + db;
            f32x2 sk2; sk2.x = row_sum8(d2.x); sk2.y = row_sum8(d2.y);
            f32x2 ya = (f32x2){0.f, 0.f}, yb = (f32x2){0.f, 0.f};
#pragma unroll
            for (int e = 0; e < 4; ++e) {
                S2[e] = S2[e] * (f32x2){cur.w0[e], cur.w0[e]} - sk2 * (f32x2){cur.ka0[e], cur.ka0[e]} + cur.vv * (f32x2){cur.kd0[e], cur.kd0[e]};
                S2[4 + e] = S2[4 + e] * (f32x2){cur.w1[e], cur.w1[e]} - sk2 * (f32x2){cur.ka1[e], cur.ka1[e]} + cur.vv * (f32x2){cur.kd1[e], cur.kd1[e]};
                ya = ya + S2[e] * (f32x2){cur.r0[e], cur.r0[e]}; yb = yb + S2[4 + e] * (f32x2){cur.r1[e], cur.r1[e]}; }
            const f32x2 y2 = ya + yb;
            const float y0 = row_sum8(y2.x), y1 = row_sum8(y2.y);
            if (kg == 0) *(unsigned*)(Y + (size_t)m * YLD) = pg8::cvt_pk_bf16(y0, y1);
            cur = nx;
        }
        const int nchU = lng ? 64 : 16;
        if (lc == nchU - 1 && s < 16) { float* o = P.out + O_RWKV + (((size_t)((s * 2 + j) * 2 + dir) * 16 + h) * 64 + 2 * vg) * 64;
#pragma unroll
            for (int hh = 0; hh < 2; ++hh) { *(f32x4*)(o + 32 * hh + 4 * kg) = (f32x4){S2[hh * 4].x, S2[hh * 4 + 1].x, S2[hh * 4 + 2].x, S2[hh * 4 + 3].x};
                *(f32x4*)(o + 64 + 32 * hh + 4 * kg) = (f32x4){S2[hh * 4].y, S2[hh * 4 + 1].y, S2[hh * 4 + 2].y, S2[hh * 4 + 3].y}; } }
        if (cc + 1 < niter) { write_lds(L0 + ((cc + 1) & 1) * BUFSZ);
            if (lc == nchU - 1) { int s2, d2_, h2, lc2; unit_of(cc + 1, s2, d2_, h2, lc2); init_state(s2, d2_, h2); } }
        }
        __syncthreads();
    }
}

__device__ __forceinline__ void scan_unit(const Params& P, const Ctx& C, int l, int type, int q) {
    const int j = l >> 1; const bool ev = (l & 1) == 0;
    if (ev) { int s, idx; if (q < 128) { s = 16 + (q >> 5); idx = q & 31; } else { const int r = q - 128; s = r >> 5; idx = r & 31; }
        chunk_scan<0>(P, C, j, s, idx >> 4, idx & 15, 0); }
    else { int s, idx; if (q < 64) { s = 16 + (q >> 4); idx = q & 15; } else { const int r = q - 64; s = r >> 4; idx = r & 15; }
        const int dir = idx >> 3, h = (idx >> 1) & 3, vs = idx & 1; if (type == 0) chunk_scan<1>(P, C, j, s, dir, h, vs); else chunk_scan<2>(P, C, j, s, dir, h, vs); }
}
__device__ __forceinline__ void phase_scan(const Params& P, const Ctx& C0, int l) {
    const int G = C0.G, bid = C0.bid; const bool ev = (l & 1) == 0;
    if (ev) {
        if (G == 256) {
            rwkv_pair(P, fresh_ctx(C0.lds), l >> 1, bid < 128 ? bid : bid - 128, bid < 128);
#pragma unroll 1
            for (int it = 0; it < 4; ++it) { if (bid < 128 && it > 0) break; const int q = bid < 128 ? bid : 128 + (bid - 128) * 4 + it; scan_unit(P, fresh_ctx(C0.lds), l, 0, q); }
        } else {
#pragma unroll 1
            for (int x = bid; x < 256 + 640; x += G) { if (x < 256) rwkv_pair(P, fresh_ctx(C0.lds), l >> 1, x < 128 ? x : x - 128, x < 128); else scan_unit(P, fresh_ctx(C0.lds), l, 0, x - 256); }
        }
        return;
    }
#pragma unroll 1
    for (int it = 0; it < 640; ++it) {
        int type, q;
        if (G == 256) {
            if (bid < 128) { if (it >= 1) break; type = bid >> 6; q = bid & 63; }
            else { if (it >= 4) break; type = it >> 1; q = 64 + 2 * (bid - 128) + (it & 1); }
        } else { const int x = bid + it * G; if (x >= 640) break; type = x / 320; q = x % 320; }
        scan_unit(P, fresh_ctx(C0.lds), l, type, q);
    }
}

__device__ __forceinline__ void ld16(const bf16_t* p, float* o) { unpack8(*(const u32x4*)p, o); unpack8(*(const u32x4*)(p + 8), o + 8); }
__device__ __forceinline__ void ld16f(const float* p, float* o) {
#pragma unroll
    for (int q = 0; q < 4; ++q) { const f32x4 v = *(const f32x4*)(p + 4 * q); o[4 * q] = v.x; o[4 * q + 1] = v.y; o[4 * q + 2] = v.z; o[4 * q + 3] = v.w; } }
__device__ __forceinline__ void st16(bf16_t* p, const float* o) { *(u32x4*)p = pack8(o); *(u32x4*)(p + 8) = pack8(o + 8); }
__device__ __forceinline__ void phase_post(const Params& P, const Ctx& C, int l) {
    const int j = l >> 1; const bool ev = (l & 1) == 0;
    const bf16_t* PROJ = (const bf16_t*)(P.ws + WS_PROJ); const bf16_t* PREP = (const bf16_t*)(P.ws + WS_PREP);
    const bf16_t* Y0 = (const bf16_t*)(P.ws + WS_MP); const bf16_t* Y1 = Y0 + (size_t)MTOK * YLD; bf16_t* MIX = (bf16_t*)(P.ws + WS_MIX);
    const int gw = C.bid * 8 + C.wave, NGW = C.G * 8, lane = C.lane, c0 = lane * 16;
    for (int m = gw; m < MTOK; m += NGW) {
        float ya[16], yb[16], t0[16], t1[16], o[16];
        if (ev) {
            const bf16_t* pp = PREP + (size_t)m * PREP_LD;
            ld16(Y0 + (size_t)m * YLD + c0, ya); ld16(Y1 + (size_t)m * YLD + c0, yb); ld16(pp + c0, t0); ld16(pp + 2048 + c0, t1);
            const float dsk = P.in[I_SSDD][j * 16 + (lane >> 2)]; float ss = 0.f;
#pragma unroll
            for (int e = 0; e < 16; ++e) { o[e] = (ya[e] + yb[e] + t0[e] * dsk) * t1[e]; ss += o[e] * o[e]; }
            const float rs = rsqrtf(wave_sum(ss) * (1.f / 1024.f) + 1e-6f);
            ld16f(P.in[I_SSDN] + j * 1024 + c0, t0);
#pragma unroll
            for (int e = 0; e < 16; ++e) o[e] = o[e] * rs * t0[e];
            st16(MIX + (size_t)m * 2048 + c0, o);
            ld16(Y0 + (size_t)m * YLD + 1024 + c0, ya); ld16(Y1 + (size_t)m * YLD + 1024 + c0, yb);
            float mu = 0.f;
#pragma unroll
            for (int e = 0; e < 16; ++e) { ya[e] += yb[e]; mu += ya[e]; }
            mu += __shfl_xor(mu, 1); mu += __shfl_xor(mu, 2); mu *= (1.f / 64.f);
            float var = 0.f;
#pragma unroll
            for (int e = 0; e < 16; ++e) { ya[e] -= mu; var += ya[e] * ya[e]; }
            var += __shfl_xor(var, 1); var += __shfl_xor(var, 2); var *= (1.f / 64.f);
            const float rstd = rsqrtf(var + 64e-5f);
            ld16f(P.in[I_LNW] + j * 1024 + c0, t0); ld16f(P.in[I_LNB] + j * 1024 + c0, t1);
#pragma unroll
            for (int e = 0; e < 16; ++e) o[e] = ya[e] * rstd * t0[e] + t1[e];
            ld16(pp + 3072 + c0, ya); ld16(pp + 4096 + c0, yb); ld16f(P.in[I_RK] + j * 1024 + c0, t0);
            float bs = 0.f;
#pragma unroll
            for (int e = 0; e < 16; ++e) bs += ya[e] * yb[e] * t0[e];
            bs += __shfl_xor(bs, 1); bs += __shfl_xor(bs, 2);
            ld16(pp + 5120 + c0, ya); ld16(PROJ + (size_t)m * LOUT_LD + 4096 + c0, yb);
#pragma unroll
            for (int e = 0; e < 16; ++e) o[e] = (o[e] + bs * ya[e]) * yb[e];
            st16(MIX + (size_t)m * 2048 + 1024 + c0, o);
        } else {
            const bf16_t* pr = PROJ + (size_t)m * PROJ_LD_CD;
#pragma unroll
            for (int g = 0; g < 2; ++g) {
                ld16(Y0 + (size_t)m * YLD + g * 1024 + c0, ya); ld16(Y1 + (size_t)m * YLD + g * 1024 + c0, yb);
                float ss = 0.f;
#pragma unroll
                for (int e = 0; e < 16; ++e) { ya[e] += yb[e]; ss += ya[e] * ya[e]; }
                ss += __shfl_xor(ss, 1); ss += __shfl_xor(ss, 2); ss += __shfl_xor(ss, 4); ss += __shfl_xor(ss, 8);
                const float rs = rsqrtf(ss * (1.f / 256.f) + 1e-6f);
                ld16f((g == 0 ? P.in[I_GLAN] : P.in[I_MLN]) + j * 1024 + c0, t0);
                ld16(pr + (g == 0 ? 2048 : IN_GLA + 2048) + c0, t1);
#pragma unroll
                for (int e = 0; e < 16; ++e) o[e] = ya[e] * rs * t0[e] * (g == 0 ? siluf_(t1[e]) : sigmoidf_(t1[e]));
                st16(MIX + (size_t)m * 2048 + g * 1024 + c0, o);
            }
        }
    }
}

__global__ void __launch_bounds__(512, 2) hybrid_fwd(Params P) {
    extern __shared__ __attribute__((aligned(16))) unsigned char lds_raw[];
    cg::grid_group grid = cg::this_grid();
    Ctx C; C.lds = (LAS unsigned char*)lds_raw; C.tid = threadIdx.x; C.lane = C.tid & 63; C.wave = __builtin_amdgcn_readfirstlane(C.tid >> 6); C.G = gridDim.x; C.bid = blockIdx.x;
    const float* MOD = (const float*)(P.ws + WS_MOD);
    const bf16_t* H = (const bf16_t*)(P.ws + WS_H);
    if (C.tid < 4) ((volatile LAS unsigned*)(C.lds + LDS_BYTES - 16))[C.tid] = 0u;
    __syncthreads();
    const XcdBarrier xb = xcd_barrier_post((unsigned*)(P.ws + WS_CTL), (volatile LAS unsigned*)(C.lds + LDS_BYTES - 16));
    REP(1) if (PH & 1) phase_mod(P, fresh_ctx(C.lds));
    REP(2) if (PH & 2) phase_convert(P, fresh_ctx(C.lds), 0);
    grid.sync();
    if (PH & 4) phase_rows(P, fresh_ctx(C.lds), 0, nullptr, nullptr, true, P.in[I_NORMG] + 0, MOD + 0);
    GSYNC();
#pragma unroll 1
    for (int l = 0; l < 4; ++l) {
        const bool ev = (l & 1) == 0; const float* modl = MOD + (size_t)l * 5 * 6144; const float* ng = P.in[I_NORMG] + l * 4 * 1024;
        REP(8) if (PH & 8) { pg8::Gemm g{H, (const bf16_t*)(P.ws + WS_WIN), 1024, 1024, 1024}; pg8::Sched<0> S; S.init(MTOK, ev ? N_AB_P : N_CD_P, 1, 1024, C.G, C.bid);
          pg8::EpiBf16<0> E{(bf16_t*)(P.ws + WS_PROJ), ev ? PROJ_LD_AB : PROJ_LD_CD, 0}; pg8::gemm_phase(C.lds, g, S, E); }
        GSYNC();
        REP(16) if (PH & 16) { if (ev) phase_prep_even(P, fresh_ctx(C.lds), l >> 1); else phase_prep_odd(P, fresh_ctx(C.lds), l >> 1); }
        GSYNC();
        if (ev && (PH & 32)) {
            REP(32) {
            pg8::Gemm g{(const bf16_t*)(P.ws + WS_LORAA), (const bf16_t*)(P.ws + WS_WLORA), LORA_K, 128, 128}; pg8::Sched<1> S; S.init(MTOK, LOUT_LD, 1, 128, C.G, C.bid);
            pg8::EpiBf16<0> E{(bf16_t*)(P.ws + WS_PROJ), LOUT_LD, 0}; pg8::gemm_phase(C.lds, g, S, E); }
            GSYNC();
        }
        for (int rep_ = 0; rep_ < (((DUP & 64) && ev) || ((DUP & 0x4000) && !ev) ? 2 : 1); ++rep_) if (PH & 64) phase_scan(P, fresh_ctx(C.lds), l);
        GSYNC();
        REP(128) if (PH & 128) phase_post(P, fresh_ctx(C.lds), l);
        GSYNC();
        REP(256) if (PH & 256) { pg8::Gemm g{(const bf16_t*)(P.ws + WS_MIX), (const bf16_t*)(P.ws + WS_WOUT), 2048, 2048, 1024}; pg8::Sched<0> S; S.init(MTOK, 1024, 2, 1024, C.G, C.bid);
          pg8::EpiBf16<0> E{(bf16_t*)(P.ws + WS_MP), 1024, (size_t)MTOK * 1024}; pg8::gemm_phase(C.lds, g, S, E); }
        GSYNC();
        if (DUP & 512) phase_rows(P, fresh_ctx(C.lds), 1, ng + 1024, modl + 2048, true, ng + 2048, modl + 3072, true);
        if (PH & 512) phase_rows(P, fresh_ctx(C.lds), 1, ng + 1024, modl + 2048, true, ng + 2048, modl + 3072);
        GSYNC();
        REP(1024) if (PH & 1024) { pg8::Gemm g{H, (const bf16_t*)(P.ws + WS_WUP), 1024, 1024, 1024}; pg8::Sched<0> S; S.init(MTOK, 4096, 1, 1024, C.G, C.bid);
          pg8::EpiBf16<2> E{(bf16_t*)(P.ws + WS_PROJ), 4096, 0}; pg8::gemm_phase(C.lds, g, S, E); }
        GSYNC();
        REP(2048) if (PH & 2048) { pg8::Gemm g{(const bf16_t*)(P.ws + WS_PROJ), (const bf16_t*)(P.ws + WS_WDN), 4096, 4096, 2048}; pg8::Sched<0> S; S.init(MTOK, 1024, 2, 2048, C.G, C.bid);
          pg8::EpiBf16<0> E{(bf16_t*)(P.ws + WS_MP), 1024, (size_t)MTOK * 1024}; pg8::gemm_phase(C.lds, g, S, E); }
        GSYNC();
        if (DUP & 4096) phase_rows(P, fresh_ctx(C.lds), 1, ng + 3072, modl + 5120, true, ng + 2048, modl + 3072, true);
        if (PH & 4096) { if (l < 3) { phase_rows(P, fresh_ctx(C.lds), 1, ng + 3072, modl + 5120, true, ng + 4096, modl + 5 * 6144); phase_convert(P, fresh_ctx(C.lds), l + 1); }
        else phase_rows(P, fresh_ctx(C.lds), 1, ng + 3072, modl + 5120, false, nullptr, nullptr); }
        if (l < 3) GSYNC();
    }
}

extern "C" void kernel_launch(void* const* d_in, const int* in_sizes, int n_in, void* d_out, int out_size, void* d_ws, size_t ws_size, hipStream_t stream) {
    static int grid = 0;
    if (grid == 0) {
        if (n_in != 44 || ws_size < WS_END) { fprintf(stderr, "kernel_launch: unexpected n_in %d / ws %zu\n", n_in, ws_size); grid = -1; return; }
        int dev = 0, cus = 0, per_cu = 0;
        hipGetDevice(&dev); hipDeviceGetAttribute(&cus, hipDeviceAttributeMultiprocessorCount, dev);
        if (hipFuncSetAttribute((const void*)hybrid_fwd, hipFuncAttributeMaxDynamicSharedMemorySize, LDS_BYTES) != hipSuccess) { fprintf(stderr, "hipFuncSetAttribute failed\n"); grid = -1; return; }
        hipOccupancyMaxActiveBlocksPerMultiprocessor(&per_cu, (const void*)hybrid_fwd, 512, LDS_BYTES);
        (void)hipGetLastError();
        if (per_cu < 1) per_cu = 1;
        grid = cus * 1;
    }
    if (grid < 0) return;
    if (hipMemsetAsync((char*)d_ws + WS_CTL, 0, CTL_BYTES, stream) != hipSuccess) { fprintf(stderr, "memset failed\n"); return; }
    Params p{};
    for (int i = 0; i < 44; ++i) p.in[i] = (const float*)d_in[i];
    p.out = (float*)d_out; p.ws = (unsigned char*)d_ws;
    void* args[] = {&p};
    hipError_t e = hipLaunchCooperativeKernel((const void*)hybrid_fwd, dim3(grid), dim3(512), args, LDS_BYTES, stream);
    if (e != hipSuccess) fprintf(stderr, "cooperative launch failed: %s (grid %d)\n", hipGetErrorString(e), grid);
}
```

```cpp
#include <hip/hip_runtime.h>
#include <hip/hip_cooperative_groups.h>
#include <cstdio>
#include <cstdint>
namespace cg = cooperative_groups;

#define LAS __attribute__((address_space(3)))
typedef unsigned short bf16_t;
typedef short bf16x8 __attribute__((ext_vector_type(8)));
typedef float f32x4 __attribute__((ext_vector_type(4)));
typedef float f32x2 __attribute__((ext_vector_type(2)));
typedef unsigned u32x4 __attribute__((ext_vector_type(4)));
typedef unsigned u32x2 __attribute__((ext_vector_type(2)));

constexpr int MTOK = 8192, DM = 1024, DFF = 4096;
constexpr int N_AB = 6560, N_AB_P = 6656, N_CD = 6192, N_CD_P = 6400;
constexpr int PROJ_LD_AB = N_AB_P, PROJ_LD_CD = N_CD_P;
constexpr int PREP_LD = 7168, LOUT_LD = 5120, LORA_K = 384, YLD = 2048;
constexpr int IN_SSD = 3104, IN_GLA = 3104;
constexpr size_t MiB = 1u << 20;
constexpr size_t WS_MOD = 0, WS_CTL = 512 * 1024, CTL_BYTES = 32768, WS_DT = 1 * MiB, WS_DA = 3 * MiB, WS_WIN = 5 * MiB, WS_WOUT = 19 * MiB, WS_WUP = 23 * MiB, WS_WDN = 31 * MiB,
                 WS_WLORA = 39 * MiB, WS_H = 41 * MiB, WS_PROJ = 57 * MiB, WS_PREP = 161 * MiB, WS_MIX = 273 * MiB, WS_MP = 305 * MiB,
                 WS_LORAA = 369 * MiB, WS_END = 375 * MiB;
constexpr size_t O_X = 0, O_SSD = 8388608, O_RWKV = 16777216, O_GLA = 20971520, O_MC = 29360128, O_MN = 37748736, O_MM = 37781504;

struct Params { const float* in[44]; float* out; unsigned char* ws; };
enum { I_XP = 0, I_XS, I_SSSD, I_SRWKV, I_SGLA, I_SMC, I_SMN, I_SMM, I_C, I_CCTX, I_WMOD, I_BMOD, I_NORMG, I_WUP, I_WDN, I_WINAB, I_SCONVW, I_SCONVB,
       I_DTB, I_ALOG, I_SSDD, I_SSDN, I_MU, I_W0, I_W2, I_A0, I_A2, I_G2, I_KK, I_KA, I_RK, I_LNW, I_LNB, I_WOUTAB, I_WINCD, I_GGW, I_GGB, I_GLAN,
       I_MCONVW, I_MCONVB, I_MIB, I_MFB, I_MLN, I_WOUTCD };

__device__ __forceinline__ float bf2f(unsigned b) { return __uint_as_float(b << 16); }
__device__ __forceinline__ unsigned f2bf(float f) { unsigned u = __float_as_uint(f); return (u + 0x7fffu + ((u >> 16) & 1u)) >> 16; }
typedef __bf16 bf16x2_hw __attribute__((ext_vector_type(2)));
__device__ __forceinline__ unsigned pk2(float lo, float hi) { const f32x2 v = {lo, hi}; const bf16x2_hw b = __builtin_convertvector(v, bf16x2_hw); return __builtin_bit_cast(unsigned, b); }
__device__ __forceinline__ float lo16(unsigned w) { return __uint_as_float(w << 16); }
__device__ __forceinline__ float hi16(unsigned w) { return __uint_as_float(w & 0xffff0000u); }
__device__ __forceinline__ void unpack8(u32x4 w, float* o) { o[0] = lo16(w.x); o[1] = hi16(w.x); o[2] = lo16(w.y); o[3] = hi16(w.y); o[4] = lo16(w.z); o[5] = hi16(w.z); o[6] = lo16(w.w); o[7] = hi16(w.w); }
__device__ __forceinline__ f32x4 unpack4(u32x2 w) { return (f32x4){lo16(w.x), hi16(w.x), lo16(w.y), hi16(w.y)}; }
__device__ __forceinline__ u32x4 pack8(const float* o) { u32x4 w; w.x = pk2(o[0], o[1]); w.y = pk2(o[2], o[3]); w.z = pk2(o[4], o[5]); w.w = pk2(o[6], o[7]); return w; }
__device__ __forceinline__ float sigmoidf_(float x) { return 1.f / (1.f + __expf(-x)); }
__device__ __forceinline__ float siluf_(float x) { return x / (1.f + __expf(-x)); }
__device__ __forceinline__ float softplusf_(float x) { return fmaxf(x, 0.f) + __logf(1.f + __expf(-fabsf(x))); }
__device__ __forceinline__ float logsigmoidf_(float x) { return fminf(x, 0.f) - __logf(1.f + __expf(-fabsf(x))); }
__device__ __forceinline__ float tanhf_(float x) { const float e = __expf(-2.f * fabsf(x)); const float r = (1.f - e) / (1.f + e); return x < 0.f ? -r : r; }
__device__ __forceinline__ float wave_sum(float v) {
#pragma unroll
    for (int o = 1; o < 64; o <<= 1) v += __shfl_xor(v, o);
    return v;
}
__device__ __forceinline__ float quad_sum(float x) {
    x += __int_as_float(__builtin_amdgcn_update_dpp(0, __float_as_int(x), 0xB1, 0xF, 0xF, true));
    x += __int_as_float(__builtin_amdgcn_update_dpp(0, __float_as_int(x), 0x4E, 0xF, 0xF, true));
    return x;
}

#define DPP_ADD(x, ctrl) ((x) + __int_as_float(__builtin_amdgcn_update_dpp(0, __float_as_int(x), (ctrl), 0xF, 0xF, true)))
__device__ __forceinline__ float row_sum8(float x) { x = DPP_ADD(x, 0xB1); x = DPP_ADD(x, 0x4E); x = DPP_ADD(x, 0x141); return x; }
__device__ __forceinline__ float row_sum16(float x) { x = row_sum8(x); x = DPP_ADD(x, 0x140); return x; }
namespace pg8 {
constexpr int BM = 256, BK = 64, HALF = 128, HTB = HALF * BK * 2, STAGE_BYTES = 8 * HTB, NXCD = 8, WGM = 8;
__host__ __device__ __forceinline__ int lds_byte(int r, int c) { const int st = (r >> 4) * 2 + (c >> 5), rr = r & 15, cc = c & 31, ob = rr * 64 + cc * 2; return st * 1024 + (ob ^ (((ob >> 9) & 1) << 5)); }
__host__ __device__ __forceinline__ void stage_rc(int b, int& R, int& C) { const int st = b / 1024, sb = b % 1024, swz = sb ^ (((sb >> 9) & 1) << 5); R = (st >> 1) * 16 + swz / 64; C = (st & 1) * 32 + (swz % 64) / 2; }
__host__ __device__ __forceinline__ int perm32(int rho) { const int n = rho >> 4, i = rho & 15; return 8 * (i >> 2) + 4 * n + (i & 3); }

struct Unit { int pm, pn, ks; };
struct Gemm { const bf16_t* A; const bf16_t* Bt; int lda, ldb, K; };
template <int mode> struct Sched {
    int nM, nN, nNv, nwg, G, c, K;
    __device__ void init(int M, int N, int nK, int K_, int G_, int c_) { nM = M / BM; nN = N / BM; nNv = nN * nK; nwg = nM * nNv; G = G_; c = c_; K = K_; }
    __device__ bool next(int i, Unit& u) const {
        const long L = (long)i * G + c; if (L >= nwg) return false;
        int wgid = (int)L; { const int q = nwg / NXCD, r = nwg % NXCD, xcd = wgid % NXCD, off = wgid / NXCD; wgid = (xcd < r ? xcd * (q + 1) : r * (q + 1) + (xcd - r) * q) + off; }
        const int nig = WGM * nNv, gid = wgid / nig, fm = gid * WGM, gsz = (nM - fm) < WGM ? (nM - fm) : WGM;
        u.pm = fm + ((wgid % nig) % gsz); const int pnv = (wgid % nig) / gsz; u.pn = pnv % nN; u.ks = pnv / nN; return true;
    }
    __device__ __forceinline__ size_t aoff(const Unit& u) const { if (mode == 1) { const int g = u.pn >> 2; return (size_t)(g < 2 ? 0 : (g < 4 ? 128 : 256)) * 2; } return (size_t)u.ks * K * 2; }
    __device__ __forceinline__ size_t boff(const Unit& u) const { return mode == 1 ? 0 : (size_t)u.ks * K * 2; }
};

__device__ __forceinline__ unsigned cvt_pk_bf16(float lo, float hi) { unsigned r; asm volatile("v_cvt_pk_bf16_f32 %0, %1, %2" : "=v"(r) : "v"(lo), "v"(hi)); return r; }

template <int ACT> struct EpiBf16 {
    static constexpr bool PERM = true;
    bf16_t* O; int ldc; size_t pstride;
    __device__ __forceinline__ void operator()(const f32x4 (&acc)[2][2][4][2], const Unit& u, int wr, int wc, int fr, int fq) const {
        const int row0 = u.pm * BM + wr * 64 + fr; const int col0 = u.pn * BM + wc * 32 + 8 * fq; bf16_t* Ob = O + (size_t)u.ks * pstride;
#pragma unroll
        for (int ai = 0; ai < 2; ++ai)
#pragma unroll
            for (int m = 0; m < 4; ++m) { bf16_t* rowp = Ob + (size_t)(row0 + ai * HALF + m * 16) * ldc + col0;
#pragma unroll
                for (int bj = 0; bj < 2; ++bj) { f32x4 v0 = acc[ai][bj][m][0], v1 = acc[ai][bj][m][1];
                    if (ACT == 2) {
#pragma unroll
                        for (int e = 0; e < 4; ++e) { const float a = fmaxf(v0[e], 0.f), b = fmaxf(v1[e], 0.f); v0[e] = a * a; v1[e] = b * b; } }
                    u32x4 w; w.x = cvt_pk_bf16(v0[0], v0[1]); w.y = cvt_pk_bf16(v0[2], v0[3]); w.z = cvt_pk_bf16(v1[0], v1[1]); w.w = cvt_pk_bf16(v1[2], v1[3]);
                    *(u32x4*)(rowp + bj * HALF) = w; } }
    }
};
struct EpiF32 {
    static constexpr bool PERM = false;
    float* O; int ldc; size_t pstride;
    __device__ __forceinline__ void operator()(const f32x4 (&acc)[2][2][4][2], const Unit& u, int wr, int wc, int fr, int fq) const {
        float* base = O + (size_t)u.ks * pstride; const int col0 = u.pn * BM + wc * 32 + 4 * fq;
#pragma unroll
        for (int ai = 0; ai < 2; ++ai)
#pragma unroll
            for (int m = 0; m < 4; ++m) { float* rowp = base + (size_t)(u.pm * BM + ai * HALF + wr * 64 + m * 16 + fr) * ldc + col0;
#pragma unroll
                for (int bj = 0; bj < 2; ++bj)
#pragma unroll
                    for (int n = 0; n < 2; ++n) *(f32x4*)(rowp + bj * HALF + n * 16) = acc[ai][bj][m][n]; }
    }
};

template <class Epi, class SchedT>
__device__ __forceinline__ void gemm_phase(LAS unsigned char* lds, const Gemm g, const SchedT& S, const Epi& E) {
    int tid_ = threadIdx.x; asm volatile("" : "+v"(tid_));
    const int tid = tid_, wid = __builtin_amdgcn_readfirstlane(tid >> 6), lane = tid & 63, wr = wid >> 2, wc = wid & 3, fr = lane & 15, fq = lane >> 4;
    int K_ = g.K; asm volatile("" : "+s"(K_));
    const int K = K_, nt = K / BK;
    unsigned voffA[2], voffB[2];
#pragma unroll
    for (int i = 0; i < 2; ++i) { int R, C; stage_rc(tid * 16 + i * 8192, R, C); const int Rb = Epi::PERM ? ((R & ~31) + perm32(R & 31)) : R;
        voffA[i] = (unsigned)(R * g.lda + C) * 2u; voffB[i] = (unsigned)(Rb * g.ldb + C) * 2u; }
    const size_t kstep = (size_t)(BK * 2);
    const size_t hstepA = (size_t)HALF * g.lda * 2, hstepB = (size_t)HALF * g.ldb * 2;
    const size_t tstepA = 2 * hstepA, tstepB = 2 * hstepB;
    const unsigned ldsw = (unsigned)wid * 1024u;
    const int aoff = lds_byte(wr * 64 + fr, fq * 8), boff = lds_byte(wc * 32 + fr, fq * 8);
#define PG8_SA(b, h) (((b) * 2 + (h)) * HTB)
#define PG8_SB(b, h) ((4 + (b) * 2 + (h)) * HTB)
#define PG8_STAGE(bufoff, gbase, voff) do { _Pragma("unroll") for (int _i = 0; _i < 2; ++_i) \
        __builtin_amdgcn_global_load_lds((const unsigned*)((const char*)(gbase) + (voff)[_i]), (LAS unsigned*)(lds + (bufoff) + ldsw + _i * 8192), 16, 0, 0); } while (0)
#define PG8_LDA(dst, b, h) do { _Pragma("unroll") for (int m = 0; m < 4; ++m) _Pragma("unroll") for (int k = 0; k < 2; ++k) dst[m][k] = *(const LAS bf16x8*)(lds + PG8_SA(b, h) + aoff + m * 2048 + k * 1024); } while (0)
#define PG8_LDB(dst, b, h) do { _Pragma("unroll") for (int n = 0; n < 2; ++n) _Pragma("unroll") for (int k = 0; k < 2; ++k) dst[n][k] = *(const LAS bf16x8*)(lds + PG8_SB(b, h) + boff + n * 2048 + k * 1024); } while (0)
#define PG8_MMA(ai, bj, At, Bt) do { __builtin_amdgcn_s_setprio(1); _Pragma("unroll") for (int m = 0; m < 4; ++m) _Pragma("unroll") for (int n = 0; n < 2; ++n) _Pragma("unroll") for (int k = 0; k < 2; ++k) \
        acc[ai][bj][m][n] = __builtin_amdgcn_mfma_f32_16x16x32_bf16(Bt[n][k], At[m][k], acc[ai][bj][m][n], 0, 0, 0); __builtin_amdgcn_s_setprio(0); } while (0)
#define PG8_WAIT_V(n) asm volatile("s_waitcnt vmcnt(" #n ")" ::: "memory")
#define PG8_WAIT_L(n) asm volatile("s_waitcnt lgkmcnt(" #n ")" ::: "memory")
#define PG8_BAR __builtin_amdgcn_s_barrier()
#define PG8_SCHED __builtin_amdgcn_sched_barrier(0)
    Unit cur, nxt; int ui = 0;
    if (!S.next(0, cur)) return;
    f32x4 acc[2][2][4][2];
#pragma unroll
    for (int a = 0; a < 2; ++a)
#pragma unroll
        for (int b = 0; b < 2; ++b)
#pragma unroll
            for (int m = 0; m < 4; ++m)
#pragma unroll
                for (int n = 0; n < 2; ++n) acc[a][b][m][n] = (f32x4){0.f, 0.f, 0.f, 0.f};
    bf16x8 At[4][2], B0[2][2], B1[2][2];
    const char* cA = (const char*)g.A + (size_t)cur.pm * tstepA + S.aoff(cur); const char* cB = (const char*)g.Bt + (size_t)cur.pn * tstepB + S.boff(cur);
    PG8_STAGE(PG8_SB(0, 0), cB, voffB); PG8_STAGE(PG8_SB(0, 1), cB + hstepB, voffB); PG8_STAGE(PG8_SA(0, 0), cA, voffA); PG8_STAGE(PG8_SA(0, 1), cA + hstepA, voffA);
    if (wr == 1) PG8_BAR;
    PG8_WAIT_V(2); PG8_BAR;
    PG8_STAGE(PG8_SB(1, 0), cB + kstep, voffB); PG8_STAGE(PG8_SA(1, 0), cA + kstep, voffA); PG8_STAGE(PG8_SB(1, 1), cB + hstepB + kstep, voffB);
    PG8_WAIT_V(6); PG8_BAR;
    for (;;) {
        const bool has_next = S.next(ui + 1, nxt);
        const char* nA = has_next ? (const char*)g.A + (size_t)nxt.pm * tstepA + S.aoff(nxt) : cA; const char* nB = has_next ? (const char*)g.Bt + (size_t)nxt.pn * tstepB + S.boff(nxt) : cB;
        for (int t = 0; t < nt; t += 2) {
            const bool last = (t == nt - 2);
            const char* a1 = cA + (size_t)(t + 1) * kstep;
            const char* a2 = last ? nA : cA + (size_t)(t + 2) * kstep; const char* b2 = last ? nB : cB + (size_t)(t + 2) * kstep;
            const char* a3 = a2 + kstep; const char* b3 = b2 + kstep;
            PG8_LDB(B0, 0, 0); PG8_LDB(B1, 0, 1); PG8_SCHED; PG8_LDA(At, 0, 0); PG8_STAGE(PG8_SA(1, 1), a1 + hstepA, voffA);
            PG8_WAIT_V(8); PG8_WAIT_L(0); PG8_BAR; PG8_MMA(0, 0, At, B0); PG8_MMA(0, 1, At, B1); PG8_BAR; PG8_SCHED;
            PG8_LDA(At, 0, 1); PG8_STAGE(PG8_SB(0, 0), b2, voffB); PG8_STAGE(PG8_SB(0, 1), b2 + hstepB, voffB); PG8_STAGE(PG8_SA(0, 0), a2, voffA);
            PG8_WAIT_V(8); PG8_WAIT_L(0); PG8_BAR; PG8_MMA(1, 0, At, B0); PG8_MMA(1, 1, At, B1); PG8_BAR; PG8_SCHED;
            PG8_LDB(B0, 1, 0); PG8_LDB(B1, 1, 1); PG8_SCHED; PG8_LDA(At, 1, 0); PG8_STAGE(PG8_SA(0, 1), a2 + hstepA, voffA);
            PG8_WAIT_V(8); PG8_WAIT_L(0); PG8_BAR; PG8_MMA(0, 0, At, B0); PG8_MMA(0, 1, At, B1); PG8_BAR; PG8_SCHED;
            PG8_LDA(At, 1, 1); PG8_STAGE(PG8_SB(1, 0), b3, voffB); PG8_STAGE(PG8_SB(1, 1), b3 + hstepB, voffB); PG8_STAGE(PG8_SA(1, 0), a3, voffA);
            PG8_WAIT_V(8); PG8_WAIT_L(0); PG8_BAR; PG8_MMA(1, 0, At, B0); PG8_MMA(1, 1, At, B1); PG8_BAR; PG8_SCHED;
        }
        if (wr == 0) PG8_BAR;
        E(acc, cur, wr, wc, fr, fq);
        if (!has_next) break;
#pragma unroll
        for (int a = 0; a < 2; ++a)
#pragma unroll
            for (int b = 0; b < 2; ++b)
#pragma unroll
                for (int m = 0; m < 4; ++m)
#pragma unroll
                    for (int n = 0; n < 2; ++n) acc[a][b][m][n] = (f32x4){0.f, 0.f, 0.f, 0.f};
        cur = nxt; cA = nA; cB = nB; ++ui;
        if (wr == 1) PG8_BAR;
    }
    PG8_WAIT_V(0);
    PG8_BAR;
#undef PG8_SA
#undef PG8_SB
#undef PG8_STAGE
#undef PG8_LDA
#undef PG8_LDB
#undef PG8_MMA
#undef PG8_WAIT_V
#undef PG8_WAIT_L
#undef PG8_BAR
#undef PG8_SCHED
}
}

#define XB_TMO      128
#define XB_XCNT(j)  (256  + 64 * (j))
#define XB_XSUB(j)  (1280 + 64 * (j))
#define XB_XGEN(j)  (2304 + 64 * (j))
#define XB_TOP      3328
#define XB_TOPGEN   3392
#define XCD_BAR_WORDS 3456
#define XB_SPIN_CAP (1u << 18)
__device__ __forceinline__ unsigned xb_ld(unsigned* p)              { return __hip_atomic_load(p, __ATOMIC_RELAXED, __HIP_MEMORY_SCOPE_AGENT); }
__device__ __forceinline__ unsigned xb_add(unsigned* p, unsigned v) { return __hip_atomic_fetch_add(p, v, __ATOMIC_RELAXED, __HIP_MEMORY_SCOPE_AGENT); }
__device__ __forceinline__ unsigned xb_xcc_id() { return (unsigned)__builtin_amdgcn_s_getreg((3 << 11) | 20) & 0xFu; }
#define XB_SPIN(cond, bar) do { unsigned _sp = 0; while (cond) { __builtin_amdgcn_s_sleep(1); \
    if ((++_sp & 255u) == 0u) { if (xb_ld(&(bar)[XB_TMO])) break; if (_sp > XB_SPIN_CAP) { atomicAdd(&(bar)[XB_TMO], 1u); break; } } } } while (0)
struct XcdBarrier { unsigned* bar; unsigned x; volatile LAS unsigned* st; };
__device__ __forceinline__ XcdBarrier xcd_barrier_post(unsigned* bar, volatile LAS unsigned* st) {
    XcdBarrier b; b.bar = bar; b.x = xb_xcc_id(); b.st = st;
    if (threadIdx.x == 0) (void)xb_add(&bar[XB_XCNT(b.x)], 1u);
    return b;
}
__device__ __forceinline__ void xcd_barrier_complete(unsigned* bar, unsigned x, unsigned& nloc, unsigned& nx) {
    const unsigned G = gridDim.x * gridDim.y * gridDim.z;
    unsigned sum, cnt, mine, sp = 0u;
    for (;;) {
        sum = 0u; cnt = 0u; mine = 0u;
#pragma unroll
        for (unsigned j = 0; j < 16; ++j) { const unsigned c = xb_ld(&bar[XB_XCNT(j)]); sum += c; cnt += (c > 0u) ? 1u : 0u; mine = (j == x) ? c : mine; }
        if (sum == G) break;
        __builtin_amdgcn_s_sleep(1);
        if ((++sp & 255u) == 0u) { if (xb_ld(&bar[XB_TMO])) break; if (sp > XB_SPIN_CAP) { atomicAdd(&bar[XB_TMO], 1u); break; } }
    }
    nloc = mine > 0u ? mine : 1u; nx = cnt > 0u ? cnt : 1u;
}
__device__ __forceinline__ void xcd_barrier(const XcdBarrier& b) {
    asm volatile("s_waitcnt vmcnt(0)" ::: "memory");
    __syncthreads();
    if (threadIdx.x == 0) {
        unsigned* bar = b.bar;
        __builtin_amdgcn_s_waitcnt(0);
        unsigned nloc = b.st[0], nx = b.st[1];
        if (nloc == 0u) { xcd_barrier_complete(bar, b.x, nloc, nx); b.st[0] = nloc; b.st[1] = nx; }
        const unsigned old = xb_add(&bar[XB_XSUB(b.x)], 1u);
        const unsigned gen = old / nloc;
        if (old + 1u == (gen + 1u) * nloc) {
            __builtin_amdgcn_fence(__ATOMIC_RELEASE, "agent");
            asm volatile("s_waitcnt vmcnt(0)" ::: "memory");
            const unsigned og = xb_add(&bar[XB_TOP], 1u);
            const unsigned tg = og / nx;
            if (og + 1u == (tg + 1u) * nx) xb_add(&bar[XB_TOPGEN], 1u);
            else XB_SPIN(xb_ld(&bar[XB_TOPGEN]) == tg, bar);
            __builtin_amdgcn_fence(__ATOMIC_ACQUIRE, "agent");
            xb_add(&bar[XB_XGEN(b.x)], 1u);
            asm volatile("s_waitcnt vmcnt(0)" ::: "memory");
        } else {
            XB_SPIN(xb_ld(&bar[XB_XGEN(b.x)]) == gen, bar);
            __builtin_amdgcn_fence(__ATOMIC_ACQUIRE, "agent");
            asm volatile("s_waitcnt vmcnt(0)" ::: "memory");
        }
    }
    __syncthreads();
}

constexpr int LDS_BYTES = 147456;
#ifndef PH
#define PH 0xFFFF
#endif
#ifndef DUP
#define DUP 0
#endif
#define GSYNC() do { xcd_barrier(xb); if (DUP & 0x8000) { xcd_barrier(xb); xcd_barrier(xb); } } while (0)
#define REP(bit) for (int rep_ = 0; rep_ < ((DUP & (bit)) ? 2 : 1); ++rep_)
struct Ctx { LAS unsigned char* lds; int tid, lane, wave, G, bid; };
__device__ __forceinline__ Ctx fresh_ctx(LAS unsigned char* lds) { Ctx C; int t = threadIdx.x; asm volatile("" : "+v"(t)); C.lds = lds; C.tid = t; C.lane = t & 63; C.wave = __builtin_amdgcn_readfirstlane(t >> 6); C.G = gridDim.x; C.bid = blockIdx.x; return C; }

__device__ __forceinline__ void phase_mod(const Params& P, const Ctx& C) {
    LAS float* sc = (LAS float*)C.lds; LAS float* red = sc + 5120;
    for (int i = C.tid; i < 5120; i += 512) { const int r = i >> 10, k = i & 1023; const float x = r == 0 ? P.in[I_CCTX][k] : P.in[I_C][(r - 1) * 1024 + k]; sc[i] = siluf_(x); }
    __syncthreads();
    float* MOD = (float*)(P.ws + WS_MOD);
    const int kg = C.tid >> 5, c = C.tid & 31;
    for (int tile = C.bid; tile < 768; tile += C.G) {
        const int l = tile / 192, col = (tile % 192) * 32 + c;
        const float* w = P.in[I_WMOD] + (size_t)l * 1024 * 6144 + col;
        float a0 = 0.f, a1 = 0.f, a2 = 0.f, a3 = 0.f, a4 = 0.f;
#pragma unroll 16
        for (int k = kg * 64; k < kg * 64 + 64; ++k) { const float wv = w[(size_t)k * 6144]; a0 += sc[k] * wv; a1 += sc[1024 + k] * wv; a2 += sc[2048 + k] * wv; a3 += sc[3072 + k] * wv; a4 += sc[4096 + k] * wv; }
        red[(kg * 5 + 0) * 32 + c] = a0; red[(kg * 5 + 1) * 32 + c] = a1; red[(kg * 5 + 2) * 32 + c] = a2; red[(kg * 5 + 3) * 32 + c] = a3; red[(kg * 5 + 4) * 32 + c] = a4;
        __syncthreads();
        if (C.tid < 160) { const int r = C.tid >> 5; float s = 0.f;
#pragma unroll
            for (int q = 0; q < 16; ++q) s += red[(q * 5 + r) * 32 + c];
            MOD[(size_t)(l * 5 + r) * 6144 + col] = s + P.in[I_BMOD][l * 6144 + col]; }
        __syncthreads();
    }
}

__device__ __forceinline__ void transpose_item(const float* W, int K, int N, bf16_t* WT, LAS float* scr, int item, int nblk, int lane) {
    const int kb = item / nblk, nb = item % nblk, k0 = 64 * kb, n0 = 32 * nb;
    const bool nok = (n0 + (lane & 31)) < N;
#pragma unroll 8
    for (int i = 0; i < 32; ++i) { const int kk = 2 * i + (lane >> 5); scr[kk * 33 + (lane & 31)] = nok ? W[(size_t)(k0 + kk) * N + n0 + (lane & 31)] : 0.f; }
    asm volatile("s_waitcnt lgkmcnt(0)" ::: "memory");
    const int c = lane & 7;
#pragma unroll
    for (int j = 0; j < 4; ++j) { const int n = (lane >> 3) + 8 * j; const LAS float* s = scr + (8 * c) * 33 + n;
        u32x4 o; o.x = pk2(s[0 * 33], s[1 * 33]); o.y = pk2(s[2 * 33], s[3 * 33]); o.z = pk2(s[4 * 33], s[5 * 33]); o.w = pk2(s[6 * 33], s[7 * 33]);
        *(u32x4*)(WT + (size_t)(n0 + n) * K + k0 + 8 * c) = o; }
    asm volatile("s_waitcnt lgkmcnt(0)" ::: "memory");
}
__device__ __forceinline__ void phase_convert(const Params& P, const Ctx& C, int l) {
    LAS float* scr = (LAS float*)(C.lds + 32768 + C.wave * 8704);
    const int gw = C.bid * 8 + C.wave, NGW = C.G * 8; const int j = l >> 1; const bool ev = (l & 1) == 0;
    const float* win = ev ? P.in[I_WINAB] + (size_t)j * 1024 * N_AB : P.in[I_WINCD] + (size_t)j * 1024 * N_CD;
    const float* wout = (ev ? P.in[I_WOUTAB] : P.in[I_WOUTCD]) + (size_t)j * 2048 * 1024;
    const float* wup = P.in[I_WUP] + (size_t)l * 1024 * 4096; const float* wdn = P.in[I_WDN] + (size_t)l * 4096 * 1024;
    const int N_in = ev ? N_AB : N_CD, Np = ev ? N_AB_P : N_CD_P;
    const int I0 = 16 * (Np / 32), I1 = 32 * 32, I2 = 16 * 128, I3 = 64 * 32;
    for (int it = gw; it < I0 + I1 + I2 + I3; it += NGW) {
        int r = it;
        if (r < I0) { transpose_item(win, 1024, N_in, (bf16_t*)(P.ws + WS_WIN), scr, r, Np / 32, C.lane); continue; } r -= I0;
        if (r < I1) { transpose_item(wout, 2048, 1024, (bf16_t*)(P.ws + WS_WOUT), scr, r, 32, C.lane); continue; } r -= I1;
        if (r < I2) { transpose_item(wup, 1024, 4096, (bf16_t*)(P.ws + WS_WUP), scr, r, 128, C.lane); continue; } r -= I2;
        transpose_item(wdn, 4096, 1024, (bf16_t*)(P.ws + WS_WDN), scr, r, 32, C.lane);
    }
    if (ev) {
        bf16_t* WL = (bf16_t*)(P.ws + WS_WLORA);
        for (int idx = C.bid * 512 + C.tid; idx < 5120 * 16; idx += C.G * 512) {
            const int n = idx % 5120, k8 = idx / 5120, g = n >> 10, cc = n & 1023; float o[8];
#pragma unroll
            for (int e = 0; e < 8; ++e) { const int k = k8 * 8 + e; float v = 0.f;
                if (g == 0) { if (k < 64) v = P.in[I_W2][((size_t)(j * 2 + 0) * 64 + k) * 1024 + cc]; }
                else if (g == 1) { if (k >= 64) v = P.in[I_W2][((size_t)(j * 2 + 1) * 64 + (k - 64)) * 1024 + cc]; }
                else if (g == 2) { if (k < 64) v = P.in[I_A2][((size_t)(j * 2 + 0) * 64 + k) * 1024 + cc]; }
                else if (g == 3) { if (k >= 64) v = P.in[I_A2][((size_t)(j * 2 + 1) * 64 + (k - 64)) * 1024 + cc]; }
                else v = P.in[I_G2][((size_t)j * 128 + k) * 1024 + cc];
                o[e] = v; }
            *(u32x4*)(WL + (size_t)n * 128 + k8 * 8) = pack8(o);
        }
    }
}

__device__ __forceinline__ void phase_rows(const Params& P, const Ctx& C, int mode, const float* gpost, const float* gate_mod  ,
                                           bool next, const float* gpre, const float* mod_next  , bool dummy = false) {
    float* X = P.out + O_X; const bf16_t* MP0 = (const bf16_t*)(P.ws + WS_MP); const bf16_t* MP1 = MP0 + (size_t)MTOK * DM; bf16_t* H = (bf16_t*)(P.ws + WS_H);
    const int gw = C.bid * 8 + C.wave, NGW = C.G * 8;
    for (int m = gw; m < MTOK; m += NGW) {
        const int mr = m < 4096 ? 0 : 1 + ((m - 4096) >> 10);
        f32x4 x[4];
        if (mode == 0) { const f32x4* src = (const f32x4*)(m < 4096 ? P.in[I_XP] + (size_t)m * DM : P.in[I_XS] + (size_t)(m - 4096) * DM) + C.lane;
#pragma unroll
            for (int j = 0; j < 4; ++j) x[j] = src[64 * j];
        } else {
            const f32x4* xs = (const f32x4*)(X + (size_t)m * DM) + C.lane; const u32x2* p0 = (const u32x2*)(MP0 + (size_t)m * DM) + C.lane; const u32x2* p1 = (const u32x2*)(MP1 + (size_t)m * DM) + C.lane;
            f32x4 f[4]; float ss = 0.f;
#pragma unroll
            for (int j = 0; j < 4; ++j) { x[j] = xs[64 * j]; f[j] = unpack4(p0[64 * j]) + unpack4(p1[64 * j]); ss += (f[j].x * f[j].x + f[j].y * f[j].y) + (f[j].z * f[j].z + f[j].w * f[j].w); }
            const float rs = rsqrtf(wave_sum(ss) * (1.f / DM) + 1e-6f);
            const f32x4* gp = (const f32x4*)gpost + C.lane; const f32x4* gt = (const f32x4*)(gate_mod + (size_t)mr * 6144) + C.lane;
#pragma unroll
            for (int j = 0; j < 4; ++j) x[j] = x[j] + gt[64 * j] * (f[j] * rs * gp[64 * j]);
        }
        f32x4* xo = (f32x4*)((dummy ? (float*)(P.ws + WS_PREP) : X) + (size_t)m * DM) + C.lane;
#pragma unroll
        for (int j = 0; j < 4; ++j) xo[64 * j] = x[j];
        if (next) {
            float ss = 0.f;
#pragma unroll
            for (int j = 0; j < 4; ++j) ss += (x[j].x * x[j].x + x[j].y * x[j].y) + (x[j].z * x[j].z + x[j].w * x[j].w);
            const float rs = rsqrtf(wave_sum(ss) * (1.f / DM) + 1e-6f);
            const f32x4* gp = (const f32x4*)gpre + C.lane; const f32x4* sh = (const f32x4*)(mod_next + (size_t)mr * 6144) + C.lane; const f32x4* sl = (const f32x4*)(mod_next + (size_t)mr * 6144 + 1024) + C.lane;
            u32x2* ho = (u32x2*)((dummy ? (bf16_t*)(P.ws + WS_PREP + 40 * MiB) : H) + (size_t)m * DM) + C.lane;
#pragma unroll
            for (int j = 0; j < 4; ++j) { const f32x4 h = (x[j] * rs * gp[64 * j]) * (sl[64 * j] + 1.f) + sh[64 * j]; u32x2 w; w.x = pk2(h.x, h.y); w.y = pk2(h.z, h.w); ho[64 * j] = w; }
        }
    }
}

__device__ __forceinline__ void conv8(const bf16_t* src, int ld, int col0, int base, int t, bool samp, const float* w, const float* b, int NC, int ch, float* acc) {
    { const f32x4 b0 = *(const f32x4*)(b + ch), b1 = *(const f32x4*)(b + ch + 4); acc[0] = b0.x; acc[1] = b0.y; acc[2] = b0.z; acc[3] = b0.w; acc[4] = b1.x; acc[5] = b1.y; acc[6] = b1.z; acc[7] = b1.w; }
    if (!samp) {
#pragma unroll
        for (int d = 0; d < 3; ++d) { const int tt = t + d - 1; if (tt < 0 || tt >= 256) continue;
            float xv[8]; unpack8(*(const u32x4*)(src + (size_t)(base + tt) * ld + col0 + ch), xv);
            const f32x4 w0 = *(const f32x4*)(w + (3 + d) * NC + ch), w1 = *(const f32x4*)(w + (3 + d) * NC + ch + 4);
            acc[0] += w0.x * xv[0]; acc[1] += w0.y * xv[1]; acc[2] += w0.z * xv[2]; acc[3] += w0.w * xv[3]; acc[4] += w1.x * xv[4]; acc[5] += w1.y * xv[5]; acc[6] += w1.z * xv[6]; acc[7] += w1.w * xv[7]; }
    } else {
        const int r = t >> 6, c = t & 63;
#pragma unroll
        for (int i = 0; i < 3; ++i)
#pragma unroll
            for (int d = 0; d < 3; ++d) { const int rr = r + i - 1, cc = c + d - 1; if (rr < 0 || rr >= 16 || cc < 0 || cc >= 64) continue;
                float xv[8]; unpack8(*(const u32x4*)(src + (size_t)(base + rr * 64 + cc) * ld + col0 + ch), xv);
                const f32x4 w0 = *(const f32x4*)(w + (i * 3 + d) * NC + ch), w1 = *(const f32x4*)(w + (i * 3 + d) * NC + ch + 4);
                acc[0] += w0.x * xv[0]; acc[1] += w0.y * xv[1]; acc[2] += w0.z * xv[2]; acc[3] += w0.w * xv[3]; acc[4] += w1.x * xv[4]; acc[5] += w1.y * xv[5]; acc[6] += w1.z * xv[6]; acc[7] += w1.w * xv[7]; }
    }
}

__device__ __forceinline__ void phase_prep_even(const Params& P, const Ctx& C, int j) {
    const bf16_t* PROJ = (const bf16_t*)(P.ws + WS_PROJ); bf16_t* PREP = (bf16_t*)(P.ws + WS_PREP); bf16_t* LA = (bf16_t*)(P.ws + WS_LORAA);
    float* DT = (float*)(P.ws + WS_DT); float* DA = (float*)(P.ws + WS_DA);
    const float* cw = P.in[I_SCONVW] + (size_t)j * 9 * 2048; const float* cb = P.in[I_SCONVB] + j * 2048;
    const float* mu = P.in[I_MU] + j * 3456; const float* kkw = P.in[I_KK] + j * 1024;
    const int gw = C.bid * 8 + C.wave, NGW = C.G * 8, lane = C.lane;
    for (int m = gw; m < MTOK; m += NGW) {
        const bool samp = m >= 4096; const int T = samp ? 1024 : 256; const int t = samp ? ((m - 4096) & 1023) : (m & 255); const int base = m - t;
        const bf16_t* prow = PROJ + (size_t)m * PROJ_LD_AB; bf16_t* orow = PREP + (size_t)m * PREP_LD;
#pragma unroll 1
        for (int it = 0; it < 4; ++it) { const int ch = it * 512 + lane * 8; float acc[8];
            conv8(PROJ, PROJ_LD_AB, 1024, base, t, samp, cw, cb, 2048, ch, acc);
#pragma unroll
            for (int e = 0; e < 8; ++e) acc[e] = siluf_(acc[e]);
            *(u32x4*)(orow + ch) = pack8(acc); }
#pragma unroll
        for (int it = 0; it < 2; ++it) { const int ch = it * 512 + lane * 8; float z[8]; unpack8(*(const u32x4*)(prow + ch), z);
#pragma unroll
            for (int e = 0; e < 8; ++e) z[e] = siluf_(z[e]);
            *(u32x4*)(orow + 2048 + ch) = pack8(z); }
        if (lane < 32) { const float raw = bf2f(prow[3072 + lane]); const float dt = softplusf_(raw + P.in[I_DTB][j * 32 + lane]);
            DT[(size_t)m * 32 + lane] = dt; DA[(size_t)m * 32 + lane] = -dt * __expf(P.in[I_ALOG][j * 32 + lane]); }
        const bool hp = t > 0, hn = t < T - 1;
#pragma unroll 1
        for (int it = 0; it < 7; ++it) { const int c = it * 512 + lane * 8; if (c >= 3456) break;
            float x[8], xp[8], xn[8];
            unpack8(*(const u32x4*)(prow + IN_SSD + c), x);
            if (hp) unpack8(*(const u32x4*)(prow - PROJ_LD_AB + IN_SSD + c), xp); else {
#pragma unroll
                for (int e = 0; e < 8; ++e) xp[e] = 0.f; }
            if (hn) unpack8(*(const u32x4*)(prow + PROJ_LD_AB + IN_SSD + c), xn); else {
#pragma unroll
                for (int e = 0; e < 8; ++e) xn[e] = 0.f; }
            const f32x4 m0 = *(const f32x4*)(mu + c), m1 = *(const f32x4*)(mu + c + 4);
            const float mv[8] = {m0.x, m0.y, m0.z, m0.w, m1.x, m1.y, m1.z, m1.w};
#pragma unroll
            for (int e = 0; e < 8; ++e) x[e] = x[e] + mv[e] * (0.5f * (xp[e] + xn[e]) - x[e]);
            if (it < 2) { *(u32x4*)(orow + 3072 + c) = pack8(x); }
            else if (it < 4) { *(u32x4*)(orow + 4096 + (c - 1024)) = pack8(x);
                const f32x4 k0 = *(const f32x4*)(kkw + c - 1024), k1 = *(const f32x4*)(kkw + c - 1024 + 4);
                const float kv[8] = {k0.x, k0.y, k0.z, k0.w, k1.x, k1.y, k1.z, k1.w}; float ss = 0.f;
#pragma unroll
                for (int e = 0; e < 8; ++e) { x[e] *= kv[e]; ss += x[e] * x[e]; }
                ss += __shfl_xor(ss, 1); ss += __shfl_xor(ss, 2); ss += __shfl_xor(ss, 4);
                const float rn = rsqrtf(ss + 1e-12f);
#pragma unroll
                for (int e = 0; e < 8; ++e) x[e] *= rn;
                *(u32x4*)(orow + 6144 + (c - 1024)) = pack8(x); }
            else if (it < 6) { *(u32x4*)(orow + 5120 + (c - 2048)) = pack8(x); }
            else { const int cc = c - 3072;
#pragma unroll
                for (int e = 0; e < 8; ++e) x[e] = cc < 128 ? tanhf_(x[e]) : (cc < 256 ? x[e] : sigmoidf_(x[e]));
                *(u32x4*)(LA + (size_t)m * LORA_K + cc) = pack8(x); }
        }
    }
}
__device__ __forceinline__ void phase_prep_odd(const Params& P, const Ctx& C, int j) {
    const bf16_t* PROJ = (const bf16_t*)(P.ws + WS_PROJ); bf16_t* PREP = (bf16_t*)(P.ws + WS_PREP);
    const float* cw = P.in[I_MCONVW] + (size_t)j * 9 * 1024; const float* cb = P.in[I_MCONVB] + j * 1024;
    const int gw = C.bid * 8 + C.wave, NGW = C.G * 8, lane = C.lane;
    for (int m = gw; m < MTOK; m += NGW) {
        const bool samp = m >= 4096; const int t = samp ? ((m - 4096) & 1023) : (m & 255); const int base = m - t;
#pragma unroll 1
        for (int it = 0; it < 2; ++it) { const int ch = it * 512 + lane * 8; float acc[8];
            conv8(PROJ, PROJ_LD_CD, IN_GLA, base, t, samp, cw, cb, 1024, ch, acc);
#pragma unroll
            for (int e = 0; e < 8; ++e) acc[e] = siluf_(acc[e]);
            *(u32x4*)(PREP + (size_t)m * PREP_LD + ch) = pack8(acc); }
    }
}

constexpr int CS_QLD = 136, CS_SLD = 72;
constexpr int CS_QS = 0, CS_KS = 17408, CS_KT = 34816, CS_VT = 53248;
__device__ __forceinline__ bf16x8 lds_frag(const LAS bf16_t* p) { return *(const LAS bf16x8*)p; }
template <int MODE>
__device__ __forceinline__ void chunk_scan(const Params& P, const Ctx& C, int j, int s, int dir, int h, int vs) {
    const int tid = C.tid, lane = C.lane, w = C.wave, fr = lane & 15, fq = lane >> 4;
    const int T = s < 16 ? 256 : 1024, base = s < 16 ? s * 256 : 4096 + (s - 16) * 1024, nch = T >> 6;
    const bf16_t* PROJ = (const bf16_t*)(P.ws + WS_PROJ); const bf16_t* PREP = (const bf16_t*)(P.ws + WS_PREP);
    bf16_t* Y = (bf16_t*)(P.ws + WS_MP) + (size_t)dir * MTOK * YLD;
    LAS bf16_t* Qs = (LAS bf16_t*)(C.lds + CS_QS); LAS bf16_t* Ks = (LAS bf16_t*)(C.lds + CS_KS); LAS bf16_t* Kt = (LAS bf16_t*)(C.lds + CS_KT); LAS bf16_t* Vt = (LAS bf16_t*)(C.lds + CS_VT);
    constexpr int NV = MODE == 0 ? 64 : 128, NVC = NV / 16, VROWS = NV + (MODE == 2 ? 16 : 0);
    constexpr int CS_ST = CS_VT + VROWS * CS_SLD * 2, CS_LA = CS_ST + VROWS * CS_QLD * 2, CS_PS = CS_LA  , CS_TOT = CS_LA + (MODE == 1 ? 32768 : 9216),
                  CS_BV = CS_TOT + 2560, CS_IG = CS_BV + 256, CS_FV = CS_IG + 256, CS_DTV = CS_FV + 256, CS_MS = CS_DTV + 256;
    static_assert(CS_MS + 64 <= LDS_BYTES - 16, "chunk-scan LDS map");
    LAS bf16_t* Ps = (LAS bf16_t*)(C.lds + CS_PS); LAS bf16_t* St = (LAS bf16_t*)(C.lds + CS_ST);
    LAS float* LA = (LAS float*)(C.lds + CS_LA); LAS float* TOT = (LAS float*)(C.lds + CS_TOT); LAS float* BV = (LAS float*)(C.lds + CS_BV); LAS float* IG = (LAS float*)(C.lds + CS_IG);
    LAS float* MS = (LAS float*)(C.lds + CS_MS); LAS float* FV = (LAS float*)(C.lds + CS_FV); LAS float* DTV = (LAS float*)(C.lds + CS_DTV);
    constexpr int NVT = NVC + (MODE == 2 ? 1 : 0);
    const int si = tid >> 3, kq = tid & 7;
    __syncthreads();
    bf16x8 gwa_hi = {0, 0, 0, 0, 0, 0, 0, 0}, gwa_lo = {0, 0, 0, 0, 0, 0, 0, 0}; f32x4 gb4 = {0.f, 0.f, 0.f, 0.f};
    if (MODE == 1) {
        const float* gwp = P.in[I_GGW] + (size_t)(j * 2 + dir) * 16 * 512 + h * 128 + 16 * w + fr;
        if (fq < 2) {
#pragma unroll
            for (int e = 0; e < 8; ++e) { const float g = gwp[(8 * fq + e) * 512]; const unsigned hb = f2bf(g); const float rem = g - bf2f(hb); gwa_hi[e] = (short)hb; gwa_lo[e] = (short)f2bf(rem); } }
        gb4 = *(const f32x4*)(P.in[I_GGB] + (j * 2 + dir) * 512 + h * 128 + 16 * w + 4 * fq);
    }
    f32x4 Sacc[NVT];
    {
        const float* s0 = nullptr; int kstride = 64; float em0 = 1.f;
        if (s >= 16) { const int b = s - 16;
            if (MODE == 0) { s0 = P.in[I_SSSD] + ((size_t)((b * 2 + j) * 2 + dir) * 16 + h) * 8192; kstride = 64; }
            if (MODE == 1) { s0 = P.in[I_SGLA] + ((size_t)((b * 2 + j) * 2 + dir) * 4 + h) * 32768 + vs * NV; kstride = 256; }
            if (MODE == 2) { s0 = P.in[I_SMC] + ((size_t)((b * 2 + j) * 2 + dir) * 4 + h) * 32768 + vs * NV; kstride = 256; em0 = __expf(P.in[I_SMM][((b * 2 + j) * 2 + dir) * 4 + h]); } }
#pragma unroll
        for (int vt = 0; vt < NVC; ++vt)
#pragma unroll
            for (int e = 0; e < 4; ++e) Sacc[vt][e] = s0 ? s0[(size_t)(16 * w + 4 * fq + e) * kstride + 16 * vt + fr] * em0 : 0.f;
        if (MODE == 2) {
            const float* n0 = s >= 16 ? P.in[I_SMN] + ((size_t)(((s - 16) * 2 + j) * 2 + dir) * 4 + h) * 128 : nullptr;
#pragma unroll
            for (int e = 0; e < 4; ++e) Sacc[NVT - 1][e] = (n0 && fr == 0) ? n0[16 * w + 4 * fq + e] * em0 : 0.f;
            if (tid == 0) MS[0] = s >= 16 ? P.in[I_SMM][(((s - 16) * 2 + j) * 2 + dir) * 4 + h] : 0.f;
            for (int i = tid; i < 16 * CS_SLD; i += 512) Vt[NV * CS_SLD + i] = (bf16_t)((i < CS_SLD) ? 0x3F80 : 0);
        }
#pragma unroll
        for (int vt = 0; vt < NVT; ++vt) { u32x2 wv; wv.x = pk2(Sacc[vt][0], Sacc[vt][1]); wv.y = pk2(Sacc[vt][2], Sacc[vt][3]); *(LAS u32x2*)(St + (16 * vt + fr) * CS_QLD + 16 * w + 4 * fq) = wv; }
    }
    u32x4 rq0, rq1, rk0, rk1, rgd[4]; float rla = 0.f, rig = 0.f, rdt = 0.f;
    constexpr int NVTOK = MODE == 0 ? 8 : 16;
    unsigned short rkt[16], rvt[NVTOK];
    const int kx = tid & 127, tgk = tid >> 7, vx = tid & (NV - 1), tgv = MODE == 0 ? (tid >> 6) : (tid >> 7);
    auto tok = [&](int c, int i) { const int st0 = c * 64 + i; return base + (dir ? (T - 1 - st0) : st0); };
    auto load_raw = [&](int c) {
        const int m = tok(c, si); const int m1 = tok(c, tid & 63);
        const bf16_t* krow; const bf16_t* vrow; int kld, vld;
        if (MODE == 0) { const int g = h >> 2; const bf16_t* pr = PREP + (size_t)m * PREP_LD;
            rq0 = *(const u32x4*)(pr + 1536 + g * 128 + 16 * kq); rq1 = *(const u32x4*)(pr + 1536 + g * 128 + 16 * kq + 8);
            rk0 = *(const u32x4*)(pr + 1024 + g * 128 + 16 * kq); rk1 = *(const u32x4*)(pr + 1024 + g * 128 + 16 * kq + 8);
            if (tid < 64) { rla = ((const float*)(P.ws + WS_DA))[(size_t)m1 * 32 + dir * 16 + h]; rdt = ((const float*)(P.ws + WS_DT))[(size_t)m1 * 32 + dir * 16 + h]; }
            krow = PREP + 1024 + g * 128 + kx; kld = PREP_LD; vrow = PREP + h * 64 + vx; vld = PREP_LD; }
        if (MODE == 1) { const bf16_t* pr = PROJ + (size_t)m * PROJ_LD_CD;
            rq0 = *(const u32x4*)(pr + h * 128 + 16 * kq); rq1 = *(const u32x4*)(pr + h * 128 + 16 * kq + 8);
            rk0 = *(const u32x4*)(pr + 512 + h * 128 + 16 * kq); rk1 = *(const u32x4*)(pr + 512 + h * 128 + 16 * kq + 8);
#pragma unroll
            for (int t4 = 0; t4 < 4; ++t4) { rgd[t4] = (u32x4){0u, 0u, 0u, 0u}; if (fq < 2) rgd[t4] = *(const u32x4*)(PROJ + (size_t)tok(c, 16 * t4 + fr) * PROJ_LD_CD + 3072 + dir * 16 + 8 * fq); }
            krow = PROJ + 512 + h * 128 + kx; kld = PROJ_LD_CD; vrow = PROJ + 1024 + h * 256 + vs * NV + vx; vld = PROJ_LD_CD; }
        if (MODE == 2) { const bf16_t* pp = PREP + (size_t)m * PREP_LD;
            rq0 = *(const u32x4*)(pp + h * 128 + 16 * kq); rq1 = *(const u32x4*)(pp + h * 128 + 16 * kq + 8);
            rk0 = *(const u32x4*)(pp + 512 + h * 128 + 16 * kq); rk1 = *(const u32x4*)(pp + 512 + h * 128 + 16 * kq + 8);
            if (tid < 64) { const bf16_t* p1 = PROJ + (size_t)m1 * PROJ_LD_CD + IN_GLA + 3072; rig = bf2f(p1[dir * 4 + h]); rla = bf2f(p1[8 + dir * 4 + h]); }
            krow = PREP + 512 + h * 128 + kx; kld = PREP_LD; vrow = PROJ + IN_GLA + 1024 + h * 256 + vs * NV + vx; vld = PROJ_LD_CD; }
        { const bf16_t* kp = krow + (size_t)tok(c, 16 * tgk) * kld; const long ks_ = dir ? -(long)kld : (long)kld;
#pragma unroll
          for (int jj = 0; jj < 16; ++jj) { rkt[jj] = *kp; kp += ks_; }
          const bf16_t* vp = vrow + (size_t)tok(c, NVTOK * tgv) * vld; const long vs_ = dir ? -(long)vld : (long)vld;
#pragma unroll
          for (int jj = 0; jj < NVTOK; ++jj) { rvt[jj] = *vp; vp += vs_; } }
    };
    load_raw(0);
    __syncthreads();
    const int ycol0 = (MODE == 0 ? h * 64 : (MODE == 1 ? h * 256 + vs * NV : 1024 + h * 256 + vs * NV));
    for (int c = 0; c < nch; ++c) {
        if (MODE == 1) {
#pragma unroll
            for (int t4 = 0; t4 < 4; ++t4) { f32x4 acc = (f32x4){0.f, 0.f, 0.f, 0.f}; const bf16x8 gf = __builtin_bit_cast(bf16x8, rgd[t4]);
                acc = __builtin_amdgcn_mfma_f32_16x16x32_bf16(gwa_hi, gf, acc, 0, 0, 0); acc = __builtin_amdgcn_mfma_f32_16x16x32_bf16(gwa_lo, gf, acc, 0, 0, 0);
                f32x4 la;
#pragma unroll
                for (int e = 0; e < 4; ++e) la[e] = logsigmoidf_(acc[e] + gb4[e]) * 0.0625f;
                *(LAS f32x4*)(LA + (16 * t4 + fr) * 128 + 16 * w + 4 * fq) = la; }
        } else if (tid < 64) {
            float ig = 0.f, la = rla;
            if (MODE == 2) { ig = rig + P.in[I_MIB][(j * 2 + dir) * 4 + h]; la = logsigmoidf_(rla + P.in[I_MFB][(j * 2 + dir) * 4 + h]); }
            float x = la;
            x += __int_as_float(__builtin_amdgcn_update_dpp(0, __float_as_int(x), 0x111, 0xF, 0xF, true));
            x += __int_as_float(__builtin_amdgcn_update_dpp(0, __float_as_int(x), 0x112, 0xF, 0xF, true));
            x += __int_as_float(__builtin_amdgcn_update_dpp(0, __float_as_int(x), 0x114, 0xF, 0xF, true));
            x += __int_as_float(__builtin_amdgcn_update_dpp(0, __float_as_int(x), 0x118, 0xF, 0xF, true));
            { const float t0 = __int_as_float(__builtin_amdgcn_readlane(__float_as_int(x), 15)), t1 = __int_as_float(__builtin_amdgcn_readlane(__float_as_int(x), 31)), t2 = __int_as_float(__builtin_amdgcn_readlane(__float_as_int(x), 47));
              const int rw = lane >> 4; x += (rw > 0 ? t0 : 0.f) + (rw > 1 ? t1 : 0.f) + (rw > 2 ? t2 : 0.f); }
            const float bl = __int_as_float(__builtin_amdgcn_readlane(__float_as_int(x), 63));
            const float kgn = MODE == 2 ? 0.08838834764831845f * __expf(ig) : 1.f;
            BV[tid] = x; IG[tid] = kgn; FV[tid] = kgn * __expf(bl - x); DTV[tid] = MODE == 0 ? rdt : 1.f;
            if (MODE == 2) { float ml = bl - x + ig;
                ml = fmaxf(ml, __int_as_float(__builtin_amdgcn_update_dpp(__float_as_int(ml), __float_as_int(ml), 0xB1, 0xF, 0xF, false)));
                ml = fmaxf(ml, __int_as_float(__builtin_amdgcn_update_dpp(__float_as_int(ml), __float_as_int(ml), 0x4E, 0xF, 0xF, false)));
                ml = fmaxf(ml, __int_as_float(__builtin_amdgcn_update_dpp(__float_as_int(ml), __float_as_int(ml), 0x141, 0xF, 0xF, false)));
                ml = fmaxf(ml, __int_as_float(__builtin_amdgcn_update_dpp(__float_as_int(ml), __float_as_int(ml), 0x140, 0xF, 0xF, false)));
                const float m01 = fmaxf(__int_as_float(__builtin_amdgcn_readlane(__float_as_int(ml), 0)), __int_as_float(__builtin_amdgcn_readlane(__float_as_int(ml), 16)));
                const float m23 = fmaxf(__int_as_float(__builtin_amdgcn_readlane(__float_as_int(ml), 32)), __int_as_float(__builtin_amdgcn_readlane(__float_as_int(ml), 48)));
                if (tid == 0) MS[0] = fmaxf(bl + MS[0], fmaxf(m01, m23)); }
        }
        __syncthreads();
        if (MODE == 1) {
            const int k = tid & 127, qd = tid >> 7; float run = 0.f;
#pragma unroll
            for (int jj = 0; jj < 16; ++jj) { run += LA[(16 * qd + jj) * 128 + k]; LA[(16 * qd + jj) * 128 + k] = run; }
            TOT[qd * 128 + k] = run;
            __syncthreads();
            if (tid < 128) TOT[4 * 128 + tid] = __expf(TOT[tid] + TOT[128 + tid] + TOT[256 + tid] + TOT[384 + tid]);
        }
        {
            float q[16], k[16]; unpack8(rq0, q); unpack8(rq1, q + 8); unpack8(rk0, k); unpack8(rk1, k + 8);
            float qs[16], ks[16];
            if (MODE == 1) { const int qd = si >> 4;
#pragma unroll
                for (int e4 = 0; e4 < 4; ++e4) { const int kk = 16 * kq + 4 * e4; const f32x4 bb = *(LAS f32x4*)(LA + si * 128 + kk), t0 = *(LAS f32x4*)(TOT + kk), t1 = *(LAS f32x4*)(TOT + 128 + kk), t2 = *(LAS f32x4*)(TOT + 256 + kk);
#pragma unroll
                    for (int e = 0; e < 4; ++e) { const float b = bb[e] + (qd > 0 ? t0[e] : 0.f) + (qd > 1 ? t1[e] : 0.f) + (qd > 2 ? t2[e] : 0.f);
                        qs[4 * e4 + e] = q[4 * e4 + e] * 0.08838834764831845f * __expf(b); ks[4 * e4 + e] = k[4 * e4 + e] * __expf(fminf(-b, 80.f)); } }
            } else { const float kgn = IG[si];
#pragma unroll
                for (int e = 0; e < 16; ++e) { qs[e] = q[e]; ks[e] = k[e] * kgn; } }
            *(LAS u32x4*)(Qs + si * CS_QLD + 16 * kq) = pack8(qs); *(LAS u32x4*)(Qs + si * CS_QLD + 16 * kq + 8) = pack8(qs + 8);
            *(LAS u32x4*)(Ks + si * CS_QLD + 16 * kq) = pack8(ks); *(LAS u32x4*)(Ks + si * CS_QLD + 16 * kq + 8) = pack8(ks + 8);
        }
        if (MODE == 1)
        {
            float kt[16];
            if (MODE == 1) { float off = 0.f; const float t0 = TOT[kx], t1 = TOT[128 + kx], t2 = TOT[256 + kx], t3 = TOT[384 + kx];
                off = (tgk > 0 ? t0 : 0.f) + (tgk > 1 ? t1 : 0.f) + (tgk > 2 ? t2 : 0.f); const float bl = (t0 + t1) + (t2 + t3);
#pragma unroll
                for (int jj = 0; jj < 16; ++jj) kt[jj] = bf2f(rkt[jj]) * __expf(bl - (LA[(16 * tgk + jj) * 128 + kx] + off));
            } else {
#pragma unroll
                for (int jj = 0; jj < 16; ++jj) kt[jj] = bf2f(rkt[jj]) * FV[16 * tgk + jj]; }
            *(LAS u32x4*)(Kt + kx * CS_SLD + 16 * tgk) = pack8(kt); *(LAS u32x4*)(Kt + kx * CS_SLD + 16 * tgk + 8) = pack8(kt + 8);
            float vt8[NVTOK];
#pragma unroll
            for (int jj = 0; jj < NVTOK; ++jj) vt8[jj] = bf2f(rvt[jj]) * (MODE == 0 ? DTV[NVTOK * tgv + jj] : 1.f);
            *(LAS u32x4*)(Vt + vx * CS_SLD + NVTOK * tgv) = pack8(vt8);
            if (NVTOK == 16) *(LAS u32x4*)(Vt + vx * CS_SLD + NVTOK * tgv + 8) = pack8(vt8 + 8);
        }
        __syncthreads();
        if (MODE != 1)
        {
            float kt[16];
            if (MODE == 1) { float off = 0.f; const float t0 = TOT[kx], t1 = TOT[128 + kx], t2 = TOT[256 + kx], t3 = TOT[384 + kx];
                off = (tgk > 0 ? t0 : 0.f) + (tgk > 1 ? t1 : 0.f) + (tgk > 2 ? t2 : 0.f); const float bl = (t0 + t1) + (t2 + t3);
#pragma unroll
                for (int jj = 0; jj < 16; ++jj) kt[jj] = bf2f(rkt[jj]) * __expf(bl - (LA[(16 * tgk + jj) * 128 + kx] + off));
            } else {
#pragma unroll
                for (int jj = 0; jj < 16; ++jj) kt[jj] = bf2f(rkt[jj]) * FV[16 * tgk + jj]; }
            *(LAS u32x4*)(Kt + kx * CS_SLD + 16 * tgk) = pack8(kt); *(LAS u32x4*)(Kt + kx * CS_SLD + 16 * tgk + 8) = pack8(kt + 8);
            float vt8[NVTOK];
#pragma unroll
            for (int jj = 0; jj < NVTOK; ++jj) vt8[jj] = bf2f(rvt[jj]) * (MODE == 0 ? DTV[NVTOK * tgv + jj] : 1.f);
            *(LAS u32x4*)(Vt + vx * CS_SLD + NVTOK * tgv) = pack8(vt8);
            if (NVTOK == 16) *(LAS u32x4*)(Vt + vx * CS_SLD + NVTOK * tgv + 8) = pack8(vt8 + 8);
        }
        if (c + 1 < nch) load_raw(c + 1);
        const int tt = w >> 1;
#pragma unroll
        for (int sj = 0; sj < 2; ++sj) { const int st = 2 * (w & 1) + sj; u32x2 wv; wv.x = 0u; wv.y = 0u;
            if (st <= tt) { f32x4 acc = (f32x4){0.f, 0.f, 0.f, 0.f};
#pragma unroll
                for (int kk = 0; kk < 4; ++kk) acc = __builtin_amdgcn_mfma_f32_16x16x32_bf16(lds_frag(Ks + (16 * st + fr) * CS_QLD + 32 * kk + 8 * fq), lds_frag(Qs + (16 * tt + fr) * CS_QLD + 32 * kk + 8 * fq), acc, 0, 0, 0);
                const int tg = 16 * tt + fr, sg = 16 * st + 4 * fq;
                if (MODE != 1) { const float bt = BV[tg]; const f32x4 bs = *(LAS f32x4*)(BV + sg);
#pragma unroll
                    for (int e = 0; e < 4; ++e) acc[e] *= __expf(fminf(bt - bs[e], 0.f)); }
#pragma unroll
                for (int e = 0; e < 4; ++e) acc[e] = (sg + e <= tg) ? acc[e] : 0.f;
                wv.x = pk2(acc[0], acc[1]); wv.y = pk2(acc[2], acc[3]); }
            *(LAS u32x2*)(Ps + (16 * tt + fr) * CS_SLD + 16 * st + 4 * fq) = wv; }
        __syncthreads();
        {
            const int tg = 16 * tt + fr; const int stp = c * 64 + tg; const int m = base + (dir ? (T - 1 - stp) : stp);
            const float ebt = MODE == 1 ? 1.f : __expf(BV[tg]);
            bf16x8 pf[2], qf[4];
#pragma unroll
            for (int ks2 = 0; ks2 < 2; ++ks2) pf[ks2] = lds_frag(Ps + tg * CS_SLD + 32 * ks2 + 8 * fq);
#pragma unroll
            for (int kk = 0; kk < 4; ++kk) qf[kk] = lds_frag(Qs + tg * CS_QLD + 32 * kk + 8 * fq);
            float rden = 1.f;
            if (MODE == 2) { f32x4 ai = (f32x4){0.f, 0.f, 0.f, 0.f}, ao = (f32x4){0.f, 0.f, 0.f, 0.f};
#pragma unroll
                for (int ks2 = 0; ks2 < 2; ++ks2) ai = __builtin_amdgcn_mfma_f32_16x16x32_bf16(lds_frag(Vt + (NV + fr) * CS_SLD + 32 * ks2 + 8 * fq), pf[ks2], ai, 0, 0, 0);
#pragma unroll
                for (int kk = 0; kk < 4; ++kk) ao = __builtin_amdgcn_mfma_f32_16x16x32_bf16(lds_frag(St + (NV + fr) * CS_QLD + 32 * kk + 8 * fq), qf[kk], ao, 0, 0, 0);
                const float den = __shfl(ai[0] + ao[0] * ebt, fr); rden = 1.f / fmaxf(fabsf(den), 1.f); }
#pragma unroll
            for (int vj = 0; vj < NVC / 2; ++vj) { const int vt = (NVC / 2) * (w & 1) + vj; f32x4 ai = (f32x4){0.f, 0.f, 0.f, 0.f}, ao = (f32x4){0.f, 0.f, 0.f, 0.f};
#pragma unroll
                for (int ks2 = 0; ks2 < 2; ++ks2) ai = __builtin_amdgcn_mfma_f32_16x16x32_bf16(lds_frag(Vt + (16 * vt + fr) * CS_SLD + 32 * ks2 + 8 * fq), pf[ks2], ai, 0, 0, 0);
#pragma unroll
                for (int kk = 0; kk < 4; ++kk) ao = __builtin_amdgcn_mfma_f32_16x16x32_bf16(lds_frag(St + (16 * vt + fr) * CS_QLD + 32 * kk + 8 * fq), qf[kk], ao, 0, 0, 0);
                u32x2 wv; wv.x = pk2((ai[0] + ao[0] * ebt) * rden, (ai[1] + ao[1] * ebt) * rden); wv.y = pk2((ai[2] + ao[2] * ebt) * rden, (ai[3] + ao[3] * ebt) * rden);
                *(u32x2*)(Y + (size_t)m * YLD + ycol0 + 16 * vt + 4 * fq) = wv; }
        }
        {
            f32x4 dec; if (MODE == 1) dec = *(LAS f32x4*)(TOT + 4 * 128 + 16 * w + 4 * fq); else { const float d = __expf(BV[63]); dec = (f32x4){d, d, d, d}; }
            bf16x8 kf[2];
#pragma unroll
            for (int ks2 = 0; ks2 < 2; ++ks2) kf[ks2] = lds_frag(Kt + (16 * w + fr) * CS_SLD + 32 * ks2 + 8 * fq);
#pragma unroll
            for (int vt = 0; vt < NVT; ++vt) { Sacc[vt] = Sacc[vt] * dec;
#pragma unroll
                for (int ks2 = 0; ks2 < 2; ++ks2) Sacc[vt] = __builtin_amdgcn_mfma_f32_16x16x32_bf16(kf[ks2], lds_frag(Vt + (16 * vt + fr) * CS_SLD + 32 * ks2 + 8 * fq), Sacc[vt], 0, 0, 0); }
        }
        __syncthreads();
#pragma unroll
        for (int vt = 0; vt < NVT; ++vt) { u32x2 wv; wv.x = pk2(Sacc[vt][0], Sacc[vt][1]); wv.y = pk2(Sacc[vt][2], Sacc[vt][3]); *(LAS u32x2*)(St + (16 * vt + fr) * CS_QLD + 16 * w + 4 * fq) = wv; }
    }
    if (s < 16) {
        float* o; int kstride; float sc = 1.f;
        if (MODE == 0) { o = P.out + O_SSD + ((size_t)((s * 2 + j) * 2 + dir) * 16 + h) * 8192; kstride = 64; }
        else { o = P.out + (MODE == 1 ? O_GLA : O_MC) + ((size_t)((s * 2 + j) * 2 + dir) * 4 + h) * 32768 + vs * NV; kstride = 256; }
        if (MODE == 2) { __syncthreads(); sc = __expf(-MS[0]); }
#pragma unroll
        for (int vt = 0; vt < NVC; ++vt)
#pragma unroll
            for (int e = 0; e < 4; ++e) o[(size_t)(16 * w + 4 * fq + e) * kstride + 16 * vt + fr] = Sacc[vt][e] * sc;
        if (MODE == 2 && vs == 0) {
            if (fr == 0) {
#pragma unroll
                for (int e = 0; e < 4; ++e) P.out[O_MN + ((size_t)((s * 2 + j) * 2 + dir) * 4 + h) * 128 + 16 * w + 4 * fq + e] = Sacc[NVT - 1][e] * sc; }
            if (tid == 0) P.out[O_MM + ((s * 2 + j) * 2 + dir) * 4 + h] = MS[0]; }
    }
}

struct RwOps { f32x4 kk0, kk1, w0, w1, kd0, kd1, ka0, ka1, r0, r1; f32x2 vv; };
__device__ __forceinline__ RwOps rw_ops(const LAS float* B, int tt, int kg, int vg) {
    const LAS float* p = B + tt * 64 + 4 * kg; RwOps o;
    o.kk0 = *(const LAS f32x4*)(p + 4096); o.kk1 = *(const LAS f32x4*)(p + 4096 + 32); o.w0 = *(const LAS f32x4*)(p + 1024); o.w1 = *(const LAS f32x4*)(p + 1024 + 32);
    o.kd0 = *(const LAS f32x4*)(p + 2048); o.kd1 = *(const LAS f32x4*)(p + 2048 + 32); o.ka0 = *(const LAS f32x4*)(p + 5120); o.ka1 = *(const LAS f32x4*)(p + 5120 + 32);
    o.r0 = *(const LAS f32x4*)(p); o.r1 = *(const LAS f32x4*)(p + 32); o.vv = *(const LAS f32x2*)(B + 3072 + tt * 64 + 2 * vg); return o;
}
__device__ __forceinline__ void rwkv_pair(const Params& P, const Ctx& C, int j, int bq, bool lng) {
    const int niter = lng ? 64 : 32; const bool act = !lng || C.tid < 256;
    const int tid = C.tid, half = tid >> 8, tl = tid & 255, kg = tl & 7, vg = tl >> 3;
    const bf16_t* PREP = (const bf16_t*)(P.ws + WS_PREP); const bf16_t* LOUT = (const bf16_t*)(P.ws + WS_PROJ);
    constexpr int BUFSZ = 6 * 1024;
    LAS float* L0 = (LAS float*)C.lds + half * 2 * BUFSZ;
    const int stt = tl >> 4, sc4 = (tl & 15) * 4;
    auto unit_of = [&](int cc, int& s, int& dir, int& h, int& lc) {
        if (lng) { s = 16 + (bq >> 5); dir = (bq >> 4) & 1; h = bq & 15; lc = cc; }
        else { const int q = 4 * bq + 2 * half + (cc >> 4); s = q >> 5; dir = (q >> 4) & 1; h = q & 15; lc = cc & 15; } };
    f32x2 S2[8];
    auto init_state = [&](int s, int dir, int h) {
        const float* s0 = s >= 16 ? P.in[I_SRWKV] + (((size_t)(((s - 16) * 2 + j) * 2 + dir) * 16 + h) * 64 + 2 * vg) * 64 : nullptr;
#pragma unroll
        for (int hh = 0; hh < 2; ++hh) { const f32x4 u0 = s0 ? *(const f32x4*)(s0 + 32 * hh + 4 * kg) : (f32x4){0.f, 0.f, 0.f, 0.f}, u1 = s0 ? *(const f32x4*)(s0 + 64 + 32 * hh + 4 * kg) : (f32x4){0.f, 0.f, 0.f, 0.f};
#pragma unroll
            for (int e = 0; e < 4; ++e) S2[hh * 4 + e] = (f32x2){u0[e], u1[e]}; } };
    u32x2 rr, rk, rv, rkk, rwl, ral; f32x4 cw0, ca0, cka;
    auto load_raw = [&](int cc) {
        int s, dir, h, lc; unit_of(cc, s, dir, h, lc);
        const int T = s < 16 ? 256 : 1024, base = s < 16 ? s * 256 : 4096 + (s - 16) * 1024;
        const int step = lc * 16 + stt; const int m = base + (dir ? (T - 1 - step) : step);
        const bf16_t* pp = PREP + (size_t)m * PREP_LD + h * 64 + sc4; const bf16_t* lo = LOUT + (size_t)m * LOUT_LD + dir * 1024 + h * 64 + sc4;
        rr = *(const u32x2*)(pp + 3072); rk = *(const u32x2*)(pp + 4096); rv = *(const u32x2*)(pp + 5120); rkk = *(const u32x2*)(pp + 6144);
        rwl = *(const u32x2*)lo; ral = *(const u32x2*)(lo + 2048);
        cw0 = *(const f32x4*)(P.in[I_W0] + (j * 2 + dir) * 1024 + h * 64 + sc4); ca0 = *(const f32x4*)(P.in[I_A0] + (j * 2 + dir) * 1024 + h * 64 + sc4); cka = *(const f32x4*)(P.in[I_KA] + j * 1024 + h * 64 + sc4);
    };
    auto write_lds = [&](LAS float* B) {
        const f32x4 r = unpack4(rr), k = unpack4(rk), v = unpack4(rv), kk = unpack4(rkk), wl = unpack4(rwl), al = unpack4(ral);
        f32x4 w, kd, kka;
#pragma unroll
        for (int e = 0; e < 4; ++e) { const float wp = cw0[e] + wl[e]; const float lw = -__expf(-softplusf_(-wp) - 0.5f); w[e] = __expf(lw);
            const float a = sigmoidf_(ca0[e] + al[e]); kd[e] = k[e] * (1.f + (a - 1.f) * cka[e]); kka[e] = kk[e] * a; }
        LAS float* p = B + stt * 64 + sc4;
        *(LAS f32x4*)(p) = r; *(LAS f32x4*)(p + 1024) = w; *(LAS f32x4*)(p + 2048) = kd; *(LAS f32x4*)(p + 3072) = v; *(LAS f32x4*)(p + 4096) = kk; *(LAS f32x4*)(p + 5120) = kka;
    };
    __syncthreads();
    if (act) { load_raw(0); write_lds(L0);
    { int s, dir, h, lc; unit_of(0, s, dir, h, lc); init_state(s, dir, h); } }
    __syncthreads();
#pragma unroll 1
    for (int cc = 0; cc < niter; ++cc) {
        if (act) {
        LAS float* B = L0 + (cc & 1) * BUFSZ;
        int s, dir, h, lc; unit_of(cc, s, dir, h, lc);
        const int T = s < 16 ? 256 : 1024, base = s < 16 ? s * 256 : 4096 + (s - 16) * 1024;
        if (cc + 1 < niter) load_raw(cc + 1);
        bf16_t* Y = (bf16_t*)(P.ws + WS_MP) + (size_t)dir * MTOK * YLD + 1024 + h * 64 + 2 * vg;
        RwOps cur = rw_ops(B, 0, kg, vg);
#pragma unroll 2
        for (int tt = 0; tt < 16; ++tt) {
            const RwOps nx = rw_ops(B, (tt + 1) & 15, kg, vg);
            const int step = lc * 16 + tt; const int m = base + (dir ? (T - 1 - step) : step);
            f32x2 da = (f32x2){0.f, 0.f}, db = (f32x2){0.f, 0.f};
#pragma unroll
            for (int e = 0; e < 4; ++e) { da = da + S2[e] * (f32x2){cur.kk0[e], cur.kk0[e]}; db = db + S2[4 + e] * (f32x2){cur.kk1[e], cur.kk1[e]}; }
            const f32x2 d2 = da + db;
            f32x2 sk2; sk2.x = row_sum8(d2.x); sk2.y = row_sum8(d2.y);
            f32x2 ya = (f32x2){0.f, 0.f}, yb = (f32x2){0.f, 0.f};
#pragma unroll
            for (int e = 0; e < 4; ++e) {
                S2[e] = S2[e] * (f32x2){cur.w0[e], cur.w0[e]} - sk2 * (f32x2){cur.ka0[e], cur.ka0[e]} + cur.vv * (f32x2){cur.kd0[e], cur.kd0[e]};
                S2[4 + e] = S2[4 + e] * (f32x2){cur.w1[e], cur.w1[e]} - sk2 * (f32x2){cur.ka1[e], cur.ka1[e]} + cur.vv * (f32x2){cur.kd1[e], cur.kd1[e]};
                ya = ya + S2[e] * (f32x2){cur.r0[e], cur.r0[e]}; yb = yb + S2[4 + e] * (f32x2){cur.r1[e], cur.r1[e]}; }
            const f32x2 y2 = ya + yb;
            const float y0 = row_sum8(y2.x), y1 = row_sum8(y2.y);
            if (kg == 0) *(unsigned*)(Y + (size_t)m * YLD) = pg8::cvt_pk_bf16(y0, y1);
            cur = nx;
        }
        const int nchU = lng ? 64 : 16;
        if (lc == nchU - 1 && s < 16) { float* o = P.out + O_RWKV + (((size_t)((s * 2 + j) * 2 + dir) * 16 + h) * 64 + 2 * vg) * 64;
#pragma unroll
            for (int hh = 0; hh < 2; ++hh) { *(f32x4*)(o + 32 * hh + 4 * kg) = (f32x4){S2[hh * 4].x, S2[hh * 4 + 1].x, S2[hh * 4 + 2].x, S2[hh * 4 + 3].x};
                *(f32x4*)(o + 64 + 32 * hh + 4 * kg) = (f32x4){S2[hh * 4].y, S2[hh * 4 + 1].y, S2[hh * 4 + 2].y, S2[hh * 4 + 3].y}; } }
        if (cc + 1 < niter) { write_lds(L0 + ((cc + 1) & 1) * BUFSZ);
            if (lc == nchU - 1) { int s2, d2_, h2, lc2; unit_of(cc + 1, s2, d2_, h2, lc2); init_state(s2, d2_, h2); } }
        }
        __syncthreads();
    }
}

__device__ __forceinline__ void scan_unit(const Params& P, const Ctx& C, int l, int type, int q) {
    const int j = l >> 1; const bool ev = (l & 1) == 0;
    if (ev) { int s, idx; if (q < 128) { s = 16 + (q >> 5); idx = q & 31; } else { const int r = q - 128; s = r >> 5; idx = r & 31; }
        chunk_scan<0>(P, C, j, s, idx >> 4, idx & 15, 0); }
    else { int s, idx; if (q < 64) { s = 16 + (q >> 4); idx = q & 15; } else { const int r = q - 64; s = r >> 4; idx = r & 15; }
        const int dir = idx >> 3, h = (idx >> 1) & 3, vs = idx & 1; if (type == 0) chunk_scan<1>(P, C, j, s, dir, h, vs); else chunk_scan<2>(P, C, j, s, dir, h, vs); }
}
__device__ __forceinline__ int queue_next(const Params& P, const Ctx& C, int l) {
    volatile LAS unsigned* qw = (volatile LAS unsigned*)(C.lds + LDS_BYTES - 16);
    __syncthreads();
    if (C.tid == 0) qw[3] = __hip_atomic_fetch_add((unsigned*)(P.ws + WS_CTL) + 6144 + 64 * l, 1u, __ATOMIC_RELAXED, __HIP_MEMORY_SCOPE_AGENT);
    __syncthreads();
    return __builtin_amdgcn_readfirstlane((int)qw[3]);
}
__device__ __forceinline__ void phase_scan(const Params& P, const Ctx& C0, int l) {
    const int G = C0.G, bid = C0.bid; const bool ev = (l & 1) == 0;
    if (ev) {
        if (G == 256) rwkv_pair(P, fresh_ctx(C0.lds), l >> 1, bid < 128 ? bid : bid - 128, bid < 128);
        else {
#pragma unroll 1
            for (int x = bid; x < 256; x += G) rwkv_pair(P, fresh_ctx(C0.lds), l >> 1, x < 128 ? x : x - 128, x < 128);
        }
#pragma unroll 1
        for (;;) { const Ctx C = fresh_ctx(C0.lds); const int x = queue_next(P, C, l); if (x >= 640) break; scan_unit(P, C, l, 0, x); }
        return;
    }
#pragma unroll 1
    for (;;) { const Ctx C = fresh_ctx(C0.lds); const int x = queue_next(P, C, l); if (x >= 640) break;
        int type, q; if (x < 128) { type = x >> 6; q = x & 63; } else { const int r = x - 128; type = r & 1; q = 64 + (r >> 1); }
        scan_unit(P, C, l, type, q); }
}

__device__ __forceinline__ void ld16(const bf16_t* p, float* o) { unpack8(*(const u32x4*)p, o); unpack8(*(const u32x4*)(p + 8), o + 8); }
__device__ __forceinline__ void ld16f(const float* p, float* o) {
#pragma unroll
    for (int q = 0; q < 4; ++q) { const f32x4 v = *(const f32x4*)(p + 4 * q); o[4 * q] = v.x; o[4 * q + 1] = v.y; o[4 * q + 2] = v.z; o[4 * q + 3] = v.w; } }
__device__ __forceinline__ void st16(bf16_t* p, const float* o) { *(u32x4*)p = pack8(o); *(u32x4*)(p + 8) = pack8(o + 8); }
__device__ __forceinline__ void phase_post(const Params& P, const Ctx& C, int l) {
    const int j = l >> 1; const bool ev = (l & 1) == 0;
    const bf16_t* PROJ = (const bf16_t*)(P.ws + WS_PROJ); const bf16_t* PREP = (const bf16_t*)(P.ws + WS_PREP);
    const bf16_t* Y0 = (const bf16_t*)(P.ws + WS_MP); const bf16_t* Y1 = Y0 + (size_t)MTOK * YLD; bf16_t* MIX = (bf16_t*)(P.ws + WS_MIX);
    const int gw = C.bid * 8 + C.wave, NGW = C.G * 8, lane = C.lane, c0 = lane * 16;
    for (int m = gw; m < MTOK; m += NGW) {
        float ya[16], yb[16], t0[16], t1[16], o[16];
        if (ev) {
            const bf16_t* pp = PREP + (size_t)m * PREP_LD;
            ld16(Y0 + (size_t)m * YLD + c0, ya); ld16(Y1 + (size_t)m * YLD + c0, yb); ld16(pp + c0, t0); ld16(pp + 2048 + c0, t1);
            const float dsk = P.in[I_SSDD][j * 16 + (lane >> 2)]; float ss = 0.f;
#pragma unroll
            for (int e = 0; e < 16; ++e) { o[e] = (ya[e] + yb[e] + t0[e] * dsk) * t1[e]; ss += o[e] * o[e]; }
            const float rs = rsqrtf(wave_sum(ss) * (1.f / 1024.f) + 1e-6f);
            ld16f(P.in[I_SSDN] + j * 1024 + c0, t0);
#pragma unroll
            for (int e = 0; e < 16; ++e) o[e] = o[e] * rs * t0[e];
            st16(MIX + (size_t)m * 2048 + c0, o);
            ld16(Y0 + (size_t)m * YLD + 1024 + c0, ya); ld16(Y1 + (size_t)m * YLD + 1024 + c0, yb);
            float mu = 0.f;
#pragma unroll
            for (int e = 0; e < 16; ++e) { ya[e] += yb[e]; mu += ya[e]; }
            mu += __shfl_xor(mu, 1); mu += __shfl_xor(mu, 2); mu *= (1.f / 64.f);
            float var = 0.f;
#pragma unroll
            for (int e = 0; e < 16; ++e) { ya[e] -= mu; var += ya[e] * ya[e]; }
            var += __shfl_xor(var, 1); var += __shfl_xor(var, 2); var *= (1.f / 64.f);
            const float rstd = rsqrtf(var + 64e-5f);
            ld16f(P.in[I_LNW] + j * 1024 + c0, t0); ld16f(P.in[I_LNB] + j * 1024 + c0, t1);
#pragma unroll
            for (int e = 0; e < 16; ++e) o[e] = ya[e] * rstd * t0[e] + t1[e];
            ld16(pp + 3072 + c0, ya); ld16(pp + 4096 + c0, yb); ld16f(P.in[I_RK] + j * 1024 + c0, t0);
            float bs = 0.f;
#pragma unroll
            for (int e = 0; e < 16; ++e) bs += ya[e] * yb[e] * t0[e];
            bs += __shfl_xor(bs, 1); bs += __shfl_xor(bs, 2);
            ld16(pp + 5120 + c0, ya); ld16(PROJ + (size_t)m * LOUT_LD + 4096 + c0, yb);
#pragma unroll
            for (int e = 0; e < 16; ++e) o[e] = (o[e] + bs * ya[e]) * yb[e];
            st16(MIX + (size_t)m * 2048 + 1024 + c0, o);
        } else {
            const bf16_t* pr = PROJ + (size_t)m * PROJ_LD_CD;
#pragma unroll
            for (int g = 0; g < 2; ++g) {
                ld16(Y0 + (size_t)m * YLD + g * 1024 + c0, ya); ld16(Y1 + (size_t)m * YLD + g * 1024 + c0, yb);
                float ss = 0.f;
#pragma unroll
                for (int e = 0; e < 16; ++e) { ya[e] += yb[e]; ss += ya[e] * ya[e]; }
                ss += __shfl_xor(ss, 1); ss += __shfl_xor(ss, 2); ss += __shfl_xor(ss, 4); ss += __shfl_xor(ss, 8);
                const float rs = rsqrtf(ss * (1.f / 256.f) + 1e-6f);
                ld16f((g == 0 ? P.in[I_GLAN] : P.in[I_MLN]) + j * 1024 + c0, t0);
                ld16(pr + (g == 0 ? 2048 : IN_GLA + 2048) + c0, t1);
#pragma unroll
                for (int e = 0; e < 16; ++e) o[e] = ya[e] * rs * t0[e] * (g == 0 ? siluf_(t1[e]) : sigmoidf_(t1[e]));
                st16(MIX + (size_t)m * 2048 + g * 1024 + c0, o);
            }
        }
    }
}

__global__ void __launch_bounds__(512, 2) hybrid_fwd(Params P) {
    extern __shared__ __attribute__((aligned(16))) unsigned char lds_raw[];
    cg::grid_group grid = cg::this_grid();
    Ctx C; C.lds = (LAS unsigned char*)lds_raw; C.tid = threadIdx.x; C.lane = C.tid & 63; C.wave = __builtin_amdgcn_readfirstlane(C.tid >> 6); C.G = gridDim.x; C.bid = blockIdx.x;
    const float* MOD = (const float*)(P.ws + WS_MOD);
    const bf16_t* H = (const bf16_t*)(P.ws + WS_H);
    if (C.tid < 4) ((volatile LAS unsigned*)(C.lds + LDS_BYTES - 16))[C.tid] = 0u;
    __syncthreads();
    const XcdBarrier xb = xcd_barrier_post((unsigned*)(P.ws + WS_CTL), (volatile LAS unsigned*)(C.lds + LDS_BYTES - 16));
    REP(1) if (PH & 1) phase_mod(P, fresh_ctx(C.lds));
    REP(2) if (PH & 2) phase_convert(P, fresh_ctx(C.lds), 0);
    grid.sync();
    if (PH & 4) phase_rows(P, fresh_ctx(C.lds), 0, nullptr, nullptr, true, P.in[I_NORMG] + 0, MOD + 0);
    GSYNC();
#pragma unroll 1
    for (int l = 0; l < 4; ++l) {
        const bool ev = (l & 1) == 0; const float* modl = MOD + (size_t)l * 5 * 6144; const float* ng = P.in[I_NORMG] + l * 4 * 1024;
        REP(8) if (PH & 8) { pg8::Gemm g{H, (const bf16_t*)(P.ws + WS_WIN), 1024, 1024, 1024}; pg8::Sched<0> S; S.init(MTOK, ev ? N_AB_P : N_CD_P, 1, 1024, C.G, C.bid);
          pg8::EpiBf16<0> E{(bf16_t*)(P.ws + WS_PROJ), ev ? PROJ_LD_AB : PROJ_LD_CD, 0}; pg8::gemm_phase(C.lds, g, S, E); }
        GSYNC();
        REP(16) if (PH & 16) { if (ev) phase_prep_even(P, fresh_ctx(C.lds), l >> 1); else phase_prep_odd(P, fresh_ctx(C.lds), l >> 1); }
        GSYNC();
        if (ev && (PH & 32)) {
            REP(32) {
            pg8::Gemm g{(const bf16_t*)(P.ws + WS_LORAA), (const bf16_t*)(P.ws + WS_WLORA), LORA_K, 128, 128}; pg8::Sched<1> S; S.init(MTOK, LOUT_LD, 1, 128, C.G, C.bid);
            pg8::EpiBf16<0> E{(bf16_t*)(P.ws + WS_PROJ), LOUT_LD, 0}; pg8::gemm_phase(C.lds, g, S, E); }
            GSYNC();
        }
        for (int rep_ = 0; rep_ < (((DUP & 64) && ev) || ((DUP & 0x4000) && !ev) ? 2 : 1); ++rep_) if (PH & 64) phase_scan(P, fresh_ctx(C.lds), l);
        GSYNC();
        REP(128) if (PH & 128) phase_post(P, fresh_ctx(C.lds), l);
        GSYNC();
        REP(256) if (PH & 256) { pg8::Gemm g{(const bf16_t*)(P.ws + WS_MIX), (const bf16_t*)(P.ws + WS_WOUT), 2048, 2048, 1024}; pg8::Sched<0> S; S.init(MTOK, 1024, 2, 1024, C.G, C.bid);
          pg8::EpiBf16<0> E{(bf16_t*)(P.ws + WS_MP), 1024, (size_t)MTOK * 1024}; pg8::gemm_phase(C.lds, g, S, E); }
        GSYNC();
        if (DUP & 512) phase_rows(P, fresh_ctx(C.lds), 1, ng + 1024, modl + 2048, true, ng + 2048, modl + 3072, true);
        if (PH & 512) phase_rows(P, fresh_ctx(C.lds), 1, ng + 1024, modl + 2048, true, ng + 2048, modl + 3072);
        GSYNC();
        REP(1024) if (PH & 1024) { pg8::Gemm g{H, (const bf16_t*)(P.ws + WS_WUP), 1024, 1024, 1024}; pg8::Sched<0> S; S.init(MTOK, 4096, 1, 1024, C.G, C.bid);
          pg8::EpiBf16<2> E{(bf16_t*)(P.ws + WS_PROJ), 4096, 0}; pg8::gemm_phase(C.lds, g, S, E); }
        GSYNC();
        REP(2048) if (PH & 2048) { pg8::Gemm g{(const bf16_t*)(P.ws + WS_PROJ), (const bf16_t*)(P.ws + WS_WDN), 4096, 4096, 2048}; pg8::Sched<0> S; S.init(MTOK, 1024, 2, 2048, C.G, C.bid);
          pg8::EpiBf16<0> E{(bf16_t*)(P.ws + WS_MP), 1024, (size_t)MTOK * 1024}; pg8::gemm_phase(C.lds, g, S, E); }
        GSYNC();
        if (DUP & 4096) phase_rows(P, fresh_ctx(C.lds), 1, ng + 3072, modl + 5120, true, ng + 2048, modl + 3072, true);
        if (PH & 4096) { if (l < 3) { phase_rows(P, fresh_ctx(C.lds), 1, ng + 3072, modl + 5120, true, ng + 4096, modl + 5 * 6144); phase_convert(P, fresh_ctx(C.lds), l + 1); }
        else phase_rows(P, fresh_ctx(C.lds), 1, ng + 3072, modl + 5120, false, nullptr, nullptr); }
        if (l < 3) GSYNC();
    }
}

extern "C" void kernel_launch(void* const* d_in, const int* in_sizes, int n_in, void* d_out, int out_size, void* d_ws, size_t ws_size, hipStream_t stream) {
    static int grid = 0;
    if (grid == 0) {
        if (n_in != 44 || ws_size < WS_END) { fprintf(stderr, "kernel_launch: unexpected n_in %d / ws %zu\n", n_in, ws_size); grid = -1; return; }
        int dev = 0, cus = 0, per_cu = 0;
        hipGetDevice(&dev); hipDeviceGetAttribute(&cus, hipDeviceAttributeMultiprocessorCount, dev);
        if (hipFuncSetAttribute((const void*)hybrid_fwd, hipFuncAttributeMaxDynamicSharedMemorySize, LDS_BYTES) != hipSuccess) { fprintf(stderr, "hipFuncSetAttribute failed\n"); grid = -1; return; }
        hipOccupancyMaxActiveBlocksPerMultiprocessor(&per_cu, (const void*)hybrid_fwd, 512, LDS_BYTES);
        (void)hipGetLastError();
        if (per_cu < 1) per_cu = 1;
        grid = cus * 1;
    }
    if (grid < 0) return;
    if (hipMemsetAsync((char*)d_ws + WS_CTL, 0, CTL_BYTES, stream) != hipSuccess) { fprintf(stderr, "memset failed\n"); return; }
    Params p{};
    for (int i = 0; i < 44; ++i) p.in[i] = (const float*)d_in[i];
    p.out = (float*)d_out; p.ws = (unsigned char*)d_ws;
    void* args[] = {&p};
    hipError_t e = hipLaunchCooperativeKernel((const void*)hybrid_fwd, dim3(grid), dim3(512), args, LDS_BYTES, stream);
    if (e != hipSuccess) fprintf(stderr, "cooperative launch failed: %s (grid %d)\n", hipGetErrorString(e), grid);
}
```

```cpp
#include <hip/hip_runtime.h>
#include <hip/hip_cooperative_groups.h>
#include <cstdio>
#include <cstdint>
namespace cg = cooperative_groups;

#define LAS __attribute__((address_space(3)))
typedef unsigned short bf16_t;
typedef short bf16x8 __attribute__((ext_vector_type(8)));
typedef float f32x4 __attribute__((ext_vector_type(4)));
typedef float f32x2 __attribute__((ext_vector_type(2)));
typedef unsigned u32x4 __attribute__((ext_vector_type(4)));
typedef unsigned u32x2 __attribute__((ext_vector_type(2)));

constexpr int MTOK = 8192, DM = 1024, DFF = 4096;
constexpr int N_AB = 6560, N_AB_P = 6656, N_CD = 6192, N_CD_P = 6400;
constexpr int PROJ_LD_AB = N_AB_P, PROJ_LD_CD = N_CD_P;
constexpr int PREP_LD = 7168, LOUT_LD = 5120, LORA_K = 384, YLD = 2048;
constexpr int IN_SSD = 3104, IN_GLA = 3104;
constexpr size_t MiB = 1u << 20;
constexpr size_t WS_MOD = 0, WS_CTL = 512 * 1024, CTL_BYTES = 32768, WS_DT = 1 * MiB, WS_DA = 3 * MiB, WS_WIN = 5 * MiB, WS_WOUT = 19 * MiB, WS_WUP = 23 * MiB, WS_WDN = 31 * MiB,
                 WS_WLORA = 39 * MiB, WS_H = 41 * MiB, WS_PROJ = 57 * MiB, WS_PREP = 161 * MiB, WS_MIX = 273 * MiB, WS_MP = 305 * MiB,
                 WS_LORAA = 369 * MiB, WS_END = 375 * MiB;
constexpr size_t O_X = 0, O_SSD = 8388608, O_RWKV = 16777216, O_GLA = 20971520, O_MC = 29360128, O_MN = 37748736, O_MM = 37781504;

struct Params { const float* in[44]; float* out; unsigned char* ws; };
enum { I_XP = 0, I_XS, I_SSSD, I_SRWKV, I_SGLA, I_SMC, I_SMN, I_SMM, I_C, I_CCTX, I_WMOD, I_BMOD, I_NORMG, I_WUP, I_WDN, I_WINAB, I_SCONVW, I_SCONVB,
       I_DTB, I_ALOG, I_SSDD, I_SSDN, I_MU, I_W0, I_W2, I_A0, I_A2, I_G2, I_KK, I_KA, I_RK, I_LNW, I_LNB, I_WOUTAB, I_WINCD, I_GGW, I_GGB, I_GLAN,
       I_MCONVW, I_MCONVB, I_MIB, I_MFB, I_MLN, I_WOUTCD };

__device__ __forceinline__ float bf2f(unsigned b) { return __uint_as_float(b << 16); }
__device__ __forceinline__ unsigned f2bf(float f) { unsigned u = __float_as_uint(f); return (u + 0x7fffu + ((u >> 16) & 1u)) >> 16; }
typedef __bf16 bf16x2_hw __attribute__((ext_vector_type(2)));
__device__ __forceinline__ unsigned pk2(float lo, float hi) { const f32x2 v = {lo, hi}; const bf16x2_hw b = __builtin_convertvector(v, bf16x2_hw); return __builtin_bit_cast(unsigned, b); }
__device__ __forceinline__ float lo16(unsigned w) { return __uint_as_float(w << 16); }
__device__ __forceinline__ float hi16(unsigned w) { return __uint_as_float(w & 0xffff0000u); }
__device__ __forceinline__ void unpack8(u32x4 w, float* o) { o[0] = lo16(w.x); o[1] = hi16(w.x); o[2] = lo16(w.y); o[3] = hi16(w.y); o[4] = lo16(w.z); o[5] = hi16(w.z); o[6] = lo16(w.w); o[7] = hi16(w.w); }
__device__ __forceinline__ f32x4 unpack4(u32x2 w) { return (f32x4){lo16(w.x), hi16(w.x), lo16(w.y), hi16(w.y)}; }
__device__ __forceinline__ u32x4 pack8(const float* o) { u32x4 w; w.x = pk2(o[0], o[1]); w.y = pk2(o[2], o[3]); w.z = pk2(o[4], o[5]); w.w = pk2(o[6], o[7]); return w; }
__device__ __forceinline__ float sigmoidf_(float x) { return 1.f / (1.f + __expf(-x)); }
__device__ __forceinline__ float siluf_(float x) { return x / (1.f + __expf(-x)); }
__device__ __forceinline__ float softplusf_(float x) { return fmaxf(x, 0.f) + __logf(1.f + __expf(-fabsf(x))); }
__device__ __forceinline__ float logsigmoidf_(float x) { return fminf(x, 0.f) - __logf(1.f + __expf(-fabsf(x))); }
__device__ __forceinline__ float tanhf_(float x) { const float e = __expf(-2.f * fabsf(x)); const float r = (1.f - e) / (1.f + e); return x < 0.f ? -r : r; }
__device__ __forceinline__ float wave_sum(float v) {
#pragma unroll
    for (int o = 1; o < 64; o <<= 1) v += __shfl_xor(v, o);
    return v;
}
__device__ __forceinline__ float quad_sum(float x) {
    x += __int_as_float(__builtin_amdgcn_update_dpp(0, __float_as_int(x), 0xB1, 0xF, 0xF, true));
    x += __int_as_float(__builtin_amdgcn_update_dpp(0, __float_as_int(x), 0x4E, 0xF, 0xF, true));
    return x;
}

#define DPP_ADD(x, ctrl) ((x) + __int_as_float(__builtin_amdgcn_update_dpp(0, __float_as_int(x), (ctrl), 0xF, 0xF, true)))
__device__ __forceinline__ float row_sum8(float x) { x = DPP_ADD(x, 0xB1); x = DPP_ADD(x, 0x4E); x = DPP_ADD(x, 0x141); return x; }
__device__ __forceinline__ float row_sum16(float x) { x = row_sum8(x); x = DPP_ADD(x, 0x140); return x; }
namespace pg8 {
constexpr int BM = 256, BK = 64, HALF = 128, HTB = HALF * BK * 2, STAGE_BYTES = 8 * HTB, NXCD = 8, WGM = 8;
__host__ __device__ __forceinline__ int lds_byte(int r, int c) { const int st = (r >> 4) * 2 + (c >> 5), rr = r & 15, cc = c & 31, ob = rr * 64 + cc * 2; return st * 1024 + (ob ^ (((ob >> 9) & 1) << 5)); }
__host__ __device__ __forceinline__ void stage_rc(int b, int& R, int& C) { const int st = b / 1024, sb = b % 1024, swz = sb ^ (((sb >> 9) & 1) << 5); R = (st >> 1) * 16 + swz / 64; C = (st & 1) * 32 + (swz % 64) / 2; }
__host__ __device__ __forceinline__ int perm32(int rho) { const int n = rho >> 4, i = rho & 15; return 8 * (i >> 2) + 4 * n + (i & 3); }

struct Unit { int pm, pn, ks; };
struct Gemm { const bf16_t* A; const bf16_t* Bt; int lda, ldb, K; };
template <int mode> struct Sched {
    int nM, nN, nNv, nwg, G, c, K;
    __device__ void init(int M, int N, int nK, int K_, int G_, int c_) { nM = M / BM; nN = N / BM; nNv = nN * nK; nwg = nM * nNv; G = G_; c = c_; K = K_; }
    __device__ bool next(int i, Unit& u) const {
        const long L = (long)i * G + c; if (L >= nwg) return false;
        int wgid = (int)L; { const int q = nwg / NXCD, r = nwg % NXCD, xcd = wgid % NXCD, off = wgid / NXCD; wgid = (xcd < r ? xcd * (q + 1) : r * (q + 1) + (xcd - r) * q) + off; }
        const int nig = WGM * nNv, gid = wgid / nig, fm = gid * WGM, gsz = (nM - fm) < WGM ? (nM - fm) : WGM;
        u.pm = fm + ((wgid % nig) % gsz); const int pnv = (wgid % nig) / gsz; u.pn = pnv % nN; u.ks = pnv / nN; return true;
    }
    __device__ __forceinline__ size_t aoff(const Unit& u) const { if (mode == 1) { const int g = u.pn >> 2; return (size_t)(g < 2 ? 0 : (g < 4 ? 128 : 256)) * 2; } return (size_t)u.ks * K * 2; }
    __device__ __forceinline__ size_t boff(const Unit& u) const { return mode == 1 ? 0 : (size_t)u.ks * K * 2; }
};

__device__ __forceinline__ unsigned cvt_pk_bf16(float lo, float hi) { unsigned r; asm volatile("v_cvt_pk_bf16_f32 %0, %1, %2" : "=v"(r) : "v"(lo), "v"(hi)); return r; }

template <int ACT> struct EpiBf16 {
    static constexpr bool PERM = true;
    bf16_t* O; int ldc; size_t pstride;
    __device__ __forceinline__ void operator()(const f32x4 (&acc)[2][2][4][2], const Unit& u, int wr, int wc, int fr, int fq) const {
        const int row0 = u.pm * BM + wr * 64 + fr; const int col0 = u.pn * BM + wc * 32 + 8 * fq; bf16_t* Ob = O + (size_t)u.ks * pstride;
#pragma unroll
        for (int ai = 0; ai < 2; ++ai)
#pragma unroll
            for (int m = 0; m < 4; ++m) { bf16_t* rowp = Ob + (size_t)(row0 + ai * HALF + m * 16) * ldc + col0;
#pragma unroll
                for (int bj = 0; bj < 2; ++bj) { f32x4 v0 = acc[ai][bj][m][0], v1 = acc[ai][bj][m][1];
                    if (ACT == 2) {
#pragma unroll
                        for (int e = 0; e < 4; ++e) { const float a = fmaxf(v0[e], 0.f), b = fmaxf(v1[e], 0.f); v0[e] = a * a; v1[e] = b * b; } }
                    u32x4 w; w.x = cvt_pk_bf16(v0[0], v0[1]); w.y = cvt_pk_bf16(v0[2], v0[3]); w.z = cvt_pk_bf16(v1[0], v1[1]); w.w = cvt_pk_bf16(v1[2], v1[3]);
                    *(u32x4*)(rowp + bj * HALF) = w; } }
    }
};
struct EpiF32 {
    static constexpr bool PERM = false;
    float* O; int ldc; size_t pstride;
    __device__ __forceinline__ void operator()(const f32x4 (&acc)[2][2][4][2], const Unit& u, int wr, int wc, int fr, int fq) const {
        float* base = O + (size_t)u.ks * pstride; const int col0 = u.pn * BM + wc * 32 + 4 * fq;
#pragma unroll
        for (int ai = 0; ai < 2; ++ai)
#pragma unroll
            for (int m = 0; m < 4; ++m) { float* rowp = base + (size_t)(u.pm * BM + ai * HALF + wr * 64 + m * 16 + fr) * ldc + col0;
#pragma unroll
                for (int bj = 0; bj < 2; ++bj)
#pragma unroll
                    for (int n = 0; n < 2; ++n) *(f32x4*)(rowp + bj * HALF + n * 16) = acc[ai][bj][m][n]; }
    }
};

template <class Epi, class SchedT>
__device__ __forceinline__ void gemm_phase(LAS unsigned char* lds, const Gemm g, const SchedT& S, const Epi& E) {
    int tid_ = threadIdx.x; asm volatile("" : "+v"(tid_));
    const int tid = tid_, wid = __builtin_amdgcn_readfirstlane(tid >> 6), lane = tid & 63, wr = wid >> 2, wc = wid & 3, fr = lane & 15, fq = lane >> 4;
    int K_ = g.K; asm volatile("" : "+s"(K_));
    const int K = K_, nt = K / BK;
    unsigned voffA[2], voffB[2];
#pragma unroll
    for (int i = 0; i < 2; ++i) { int R, C; stage_rc(tid * 16 + i * 8192, R, C); const int Rb = Epi::PERM ? ((R & ~31) + perm32(R & 31)) : R;
        voffA[i] = (unsigned)(R * g.lda + C) * 2u; voffB[i] = (unsigned)(Rb * g.ldb + C) * 2u; }
    const size_t kstep = (size_t)(BK * 2);
    const size_t hstepA = (size_t)HALF * g.lda * 2, hstepB = (size_t)HALF * g.ldb * 2;
    const size_t tstepA = 2 * hstepA, tstepB = 2 * hstepB;
    const unsigned ldsw = (unsigned)wid * 1024u;
    const int aoff = lds_byte(wr * 64 + fr, fq * 8), boff = lds_byte(wc * 32 + fr, fq * 8);
#define PG8_SA(b, h) (((b) * 2 + (h)) * HTB)
#define PG8_SB(b, h) ((4 + (b) * 2 + (h)) * HTB)
#define PG8_STAGE(bufoff, gbase, voff) do { _Pragma("unroll") for (int _i = 0; _i < 2; ++_i) \
        __builtin_amdgcn_global_load_lds((const unsigned*)((const char*)(gbase) + (voff)[_i]), (LAS unsigned*)(lds + (bufoff) + ldsw + _i * 8192), 16, 0, 0); } while (0)
#define PG8_LDA(dst, b, h) do { _Pragma("unroll") for (int m = 0; m < 4; ++m) _Pragma("unroll") for (int k = 0; k < 2; ++k) dst[m][k] = *(const LAS bf16x8*)(lds + PG8_SA(b, h) + aoff + m * 2048 + k * 1024); } while (0)
#define PG8_LDB(dst, b, h) do { _Pragma("unroll") for (int n = 0; n < 2; ++n) _Pragma("unroll") for (int k = 0; k < 2; ++k) dst[n][k] = *(const LAS bf16x8*)(lds + PG8_SB(b, h) + boff + n * 2048 + k * 1024); } while (0)
#define PG8_MMA(ai, bj, At, Bt) do { __builtin_amdgcn_s_setprio(1); _Pragma("unroll") for (int m = 0; m < 4; ++m) _Pragma("unroll") for (int n = 0; n < 2; ++n) _Pragma("unroll") for (int k = 0; k < 2; ++k) \
        acc[ai][bj][m][n] = __builtin_amdgcn_mfma_f32_16x16x32_bf16(Bt[n][k], At[m][k], acc[ai][bj][m][n], 0, 0, 0); __builtin_amdgcn_s_setprio(0); } while (0)
#define PG8_WAIT_V(n) asm volatile("s_waitcnt vmcnt(" #n ")" ::: "memory")
#define PG8_WAIT_L(n) asm volatile("s_waitcnt lgkmcnt(" #n ")" ::: "memory")
#define PG8_BAR __builtin_amdgcn_s_barrier()
#define PG8_SCHED __builtin_amdgcn_sched_barrier(0)
    Unit cur, nxt; int ui = 0;
    if (!S.next(0, cur)) return;
    f32x4 acc[2][2][4][2];
#pragma unroll
    for (int a = 0; a < 2; ++a)
#pragma unroll
        for (int b = 0; b < 2; ++b)
#pragma unroll
            for (int m = 0; m < 4; ++m)
#pragma unroll
                for (int n = 0; n < 2; ++n) acc[a][b][m][n] = (f32x4){0.f, 0.f, 0.f, 0.f};
    bf16x8 At[4][2], B0[2][2], B1[2][2];
    const char* cA = (const char*)g.A + (size_t)cur.pm * tstepA + S.aoff(cur); const char* cB = (const char*)g.Bt + (size_t)cur.pn * tstepB + S.boff(cur);
    PG8_STAGE(PG8_SB(0, 0), cB, voffB); PG8_STAGE(PG8_SB(0, 1), cB + hstepB, voffB); PG8_STAGE(PG8_SA(0, 0), cA, voffA); PG8_STAGE(PG8_SA(0, 1), cA + hstepA, voffA);
    if (wr == 1) PG8_BAR;
    PG8_WAIT_V(2); PG8_BAR;
    PG8_STAGE(PG8_SB(1, 0), cB + kstep, voffB); PG8_STAGE(PG8_SA(1, 0), cA + kstep, voffA); PG8_STAGE(PG8_SB(1, 1), cB + hstepB + kstep, voffB);
    PG8_WAIT_V(6); PG8_BAR;
    for (;;) {
        const bool has_next = S.next(ui + 1, nxt);
        const char* nA = has_next ? (const char*)g.A + (size_t)nxt.pm * tstepA + S.aoff(nxt) : cA; const char* nB = has_next ? (const char*)g.Bt + (size_t)nxt.pn * tstepB + S.boff(nxt) : cB;
        for (int t = 0; t < nt; t += 2) {
            const bool last = (t == nt - 2);
            const char* a1 = cA + (size_t)(t + 1) * kstep;
            const char* a2 = last ? nA : cA + (size_t)(t + 2) * kstep; const char* b2 = last ? nB : cB + (size_t)(t + 2) * kstep;
            const char* a3 = a2 + kstep; const char* b3 = b2 + kstep;
            PG8_LDB(B0, 0, 0); PG8_LDB(B1, 0, 1); PG8_SCHED; PG8_LDA(At, 0, 0); PG8_STAGE(PG8_SA(1, 1), a1 + hstepA, voffA);
            PG8_WAIT_V(8); PG8_WAIT_L(0); PG8_BAR; PG8_MMA(0, 0, At, B0); PG8_MMA(0, 1, At, B1); PG8_BAR; PG8_SCHED;
            PG8_LDA(At, 0, 1); PG8_STAGE(PG8_SB(0, 0), b2, voffB); PG8_STAGE(PG8_SB(0, 1), b2 + hstepB, voffB); PG8_STAGE(PG8_SA(0, 0), a2, voffA);
            PG8_WAIT_V(8); PG8_WAIT_L(0); PG8_BAR; PG8_MMA(1, 0, At, B0); PG8_MMA(1, 1, At, B1); PG8_BAR; PG8_SCHED;
            PG8_LDB(B0, 1, 0); PG8_LDB(B1, 1, 1); PG8_SCHED; PG8_LDA(At, 1, 0); PG8_STAGE(PG8_SA(0, 1), a2 + hstepA, voffA);
            PG8_WAIT_V(8); PG8_WAIT_L(0); PG8_BAR; PG8_MMA(0, 0, At, B0); PG8_MMA(0, 1, At, B1); PG8_BAR; PG8_SCHED;
            PG8_LDA(At, 1, 1); PG8_STAGE(PG8_SB(1, 0), b3, voffB); PG8_STAGE(PG8_SB(1, 1), b3 + hstepB, voffB); PG8_STAGE(PG8_SA(1, 0), a3, voffA);
            PG8_WAIT_V(8); PG8_WAIT_L(0); PG8_BAR; PG8_MMA(1, 0, At, B0); PG8_MMA(1, 1, At, B1); PG8_BAR; PG8_SCHED;
        }
        if (wr == 0) PG8_BAR;
        E(acc, cur, wr, wc, fr, fq);
        if (!has_next) break;
#pragma unroll
        for (int a = 0; a < 2; ++a)
#pragma unroll
            for (int b = 0; b < 2; ++b)
#pragma unroll
                for (int m = 0; m < 4; ++m)
#pragma unroll
                    for (int n = 0; n < 2; ++n) acc[a][b][m][n] = (f32x4){0.f, 0.f, 0.f, 0.f};
        cur = nxt; cA = nA; cB = nB; ++ui;
        if (wr == 1) PG8_BAR;
    }
    PG8_WAIT_V(0);
    PG8_BAR;
#undef PG8_SA
#undef PG8_SB
#undef PG8_STAGE
#undef PG8_LDA
#undef PG8_LDB
#undef PG8_MMA
#undef PG8_WAIT_V
#undef PG8_WAIT_L
#undef PG8_BAR
#undef PG8_SCHED
}
}

#define XB_TMO      128
#define XB_XCNT(j)  (256  + 64 * (j))
#define XB_XSUB(j)  (1280 + 64 * (j))
#define XB_XGEN(j)  (2304 + 64 * (j))
#define XB_TOP      3328
#define XB_TOPGEN   3392
#define XCD_BAR_WORDS 3456
#define XB_SPIN_CAP (1u << 18)
__device__ __forceinline__ unsigned xb_ld(unsigned* p)              { return __hip_atomic_load(p, __ATOMIC_RELAXED, __HIP_MEMORY_SCOPE_AGENT); }
__device__ __forceinline__ unsigned xb_add(unsigned* p, unsigned v) { return __hip_atomic_fetch_add(p, v, __ATOMIC_RELAXED, __HIP_MEMORY_SCOPE_AGENT); }
__device__ __forceinline__ unsigned xb_xcc_id() { return (unsigned)__builtin_amdgcn_s_getreg((3 << 11) | 20) & 0xFu; }
#define XB_SPIN(cond, bar) do { unsigned _sp = 0; while (cond) { __builtin_amdgcn_s_sleep(1); \
    if ((++_sp & 255u) == 0u) { if (xb_ld(&(bar)[XB_TMO])) break; if (_sp > XB_SPIN_CAP) { atomicAdd(&(bar)[XB_TMO], 1u); break; } } } } while (0)
struct XcdBarrier { unsigned* bar; unsigned x; volatile LAS unsigned* st; };
__device__ __forceinline__ XcdBarrier xcd_barrier_post(unsigned* bar, volatile LAS unsigned* st) {
    XcdBarrier b; b.bar = bar; b.x = xb_xcc_id(); b.st = st;
    if (threadIdx.x == 0) (void)xb_add(&bar[XB_XCNT(b.x)], 1u);
    return b;
}
__device__ __forceinline__ void xcd_barrier_complete(unsigned* bar, unsigned x, unsigned& nloc, unsigned& nx) {
    const unsigned G = gridDim.x * gridDim.y * gridDim.z;
    unsigned sum, cnt, mine, sp = 0u;
    for (;;) {
        sum = 0u; cnt = 0u; mine = 0u;
#pragma unroll
        for (unsigned j = 0; j < 16; ++j) { const unsigned c = xb_ld(&bar[XB_XCNT(j)]); sum += c; cnt += (c > 0u) ? 1u : 0u; mine = (j == x) ? c : mine; }
        if (sum == G) break;
        __builtin_amdgcn_s_sleep(1);
        if ((++sp & 255u) == 0u) { if (xb_ld(&bar[XB_TMO])) break; if (sp > XB_SPIN_CAP) { atomicAdd(&bar[XB_TMO], 1u); break; } }
    }
    nloc = mine > 0u ? mine : 1u; nx = cnt > 0u ? cnt : 1u;
}
__device__ __forceinline__ void xcd_barrier(const XcdBarrier& b) {
    asm volatile("s_waitcnt vmcnt(0)" ::: "memory");
    __syncthreads();
    if (threadIdx.x == 0) {
        unsigned* bar = b.bar;
        __builtin_amdgcn_s_waitcnt(0);
        unsigned nloc = b.st[0], nx = b.st[1];
        if (nloc == 0u) { xcd_barrier_complete(bar, b.x, nloc, nx); b.st[0] = nloc; b.st[1] = nx; }
        const unsigned old = xb_add(&bar[XB_XSUB(b.x)], 1u);
        const unsigned gen = old / nloc;
        if (old + 1u == (gen + 1u) * nloc) {
            __builtin_amdgcn_fence(__ATOMIC_RELEASE, "agent");
            asm volatile("s_waitcnt vmcnt(0)" ::: "memory");
            const unsigned og = xb_add(&bar[XB_TOP], 1u);
            const unsigned tg = og / nx;
            if (og + 1u == (tg + 1u) * nx) xb_add(&bar[XB_TOPGEN], 1u);
            else XB_SPIN(xb_ld(&bar[XB_TOPGEN]) == tg, bar);
            __builtin_amdgcn_fence(__ATOMIC_ACQUIRE, "agent");
            xb_add(&bar[XB_XGEN(b.x)], 1u);
            asm volatile("s_waitcnt vmcnt(0)" ::: "memory");
        } else {
            XB_SPIN(xb_ld(&bar[XB_XGEN(b.x)]) == gen, bar);
            __builtin_amdgcn_fence(__ATOMIC_ACQUIRE, "agent");
            asm volatile("s_waitcnt vmcnt(0)" ::: "memory");
        }
    }
    __syncthreads();
}

constexpr int LDS_BYTES = 147456;
#ifndef PH
#define PH 0xFFFF
#endif
#ifndef DUP
#define DUP 0
#endif
#define GSYNC() do { xcd_barrier(xb); if (DUP & 0x8000) { xcd_barrier(xb); xcd_barrier(xb); } } while (0)
#define REP(bit) for (int rep_ = 0; rep_ < ((DUP & (bit)) ? 2 : 1); ++rep_)
struct Ctx { LAS unsigned char* lds; int tid, lane, wave, G, bid; };
__device__ __forceinline__ Ctx fresh_ctx(LAS unsigned char* lds) { Ctx C; int t = threadIdx.x; asm volatile("" : "+v"(t)); C.lds = lds; C.tid = t; C.lane = t & 63; C.wave = __builtin_amdgcn_readfirstlane(t >> 6); C.G = gridDim.x; C.bid = blockIdx.x; return C; }

__device__ __forceinline__ void phase_mod(const Params& P, const Ctx& C) {
    LAS float* sc = (LAS float*)C.lds; LAS float* red = sc + 5120;
    for (int i = C.tid; i < 5120; i += 512) { const int r = i >> 10, k = i & 1023; const float x = r == 0 ? P.in[I_CCTX][k] : P.in[I_C][(r - 1) * 1024 + k]; sc[i] = siluf_(x); }
    __syncthreads();
    float* MOD = (float*)(P.ws + WS_MOD);
    const int kg = C.tid >> 5, c = C.tid & 31;
    for (int tile = C.bid; tile < 768; tile += C.G) {
        const int l = tile / 192, col = (tile % 192) * 32 + c;
        const float* w = P.in[I_WMOD] + (size_t)l * 1024 * 6144 + col;
        float a0 = 0.f, a1 = 0.f, a2 = 0.f, a3 = 0.f, a4 = 0.f;
#pragma unroll 16
        for (int k = kg * 64; k < kg * 64 + 64; ++k) { const float wv = w[(size_t)k * 6144]; a0 += sc[k] * wv; a1 += sc[1024 + k] * wv; a2 += sc[2048 + k] * wv; a3 += sc[3072 + k] * wv; a4 += sc[4096 + k] * wv; }
        red[(kg * 5 + 0) * 32 + c] = a0; red[(kg * 5 + 1) * 32 + c] = a1; red[(kg * 5 + 2) * 32 + c] = a2; red[(kg * 5 + 3) * 32 + c] = a3; red[(kg * 5 + 4) * 32 + c] = a4;
        __syncthreads();
        if (C.tid < 160) { const int r = C.tid >> 5; float s = 0.f;
#pragma unroll
            for (int q = 0; q < 16; ++q) s += red[(q * 5 + r) * 32 + c];
            MOD[(size_t)(l * 5 + r) * 6144 + col] = s + P.in[I_BMOD][l * 6144 + col]; }
        __syncthreads();
    }
}

__device__ __forceinline__ void transpose_item(const float* W, int K, int N, bf16_t* WT, LAS float* scr, int item, int nblk, int lane) {
    const int kb = item / nblk, nb = item % nblk, k0 = 64 * kb, n0 = 32 * nb;
    const bool nok = (n0 + (lane & 31)) < N;
#pragma unroll 8
    for (int i = 0; i < 32; ++i) { const int kk = 2 * i + (lane >> 5); scr[kk * 33 + (lane & 31)] = nok ? W[(size_t)(k0 + kk) * N + n0 + (lane & 31)] : 0.f; }
    asm volatile("s_waitcnt lgkmcnt(0)" ::: "memory");
    const int c = lane & 7;
#pragma unroll
    for (int j = 0; j < 4; ++j) { const int n = (lane >> 3) + 8 * j; const LAS float* s = scr + (8 * c) * 33 + n;
        u32x4 o; o.x = pk2(s[0 * 33], s[1 * 33]); o.y = pk2(s[2 * 33], s[3 * 33]); o.z = pk2(s[4 * 33], s[5 * 33]); o.w = pk2(s[6 * 33], s[7 * 33]);
        *(u32x4*)(WT + (size_t)(n0 + n) * K + k0 + 8 * c) = o; }
    asm volatile("s_waitcnt lgkmcnt(0)" ::: "memory");
}
__device__ __forceinline__ void phase_convert(const Params& P, const Ctx& C, int l) {
    LAS float* scr = (LAS float*)(C.lds + 32768 + C.wave * 8704);
    const int gw = C.bid * 8 + C.wave, NGW = C.G * 8; const int j = l >> 1; const bool ev = (l & 1) == 0;
    const float* win = ev ? P.in[I_WINAB] + (size_t)j * 1024 * N_AB : P.in[I_WINCD] + (size_t)j * 1024 * N_CD;
    const float* wout = (ev ? P.in[I_WOUTAB] : P.in[I_WOUTCD]) + (size_t)j * 2048 * 1024;
    const float* wup = P.in[I_WUP] + (size_t)l * 1024 * 4096; const float* wdn = P.in[I_WDN] + (size_t)l * 4096 * 1024;
    const int N_in = ev ? N_AB : N_CD, Np = ev ? N_AB_P : N_CD_P;
    const int I0 = 16 * (Np / 32), I1 = 32 * 32, I2 = 16 * 128, I3 = 64 * 32;
    for (int it = gw; it < I0 + I1 + I2 + I3; it += NGW) {
        int r = it;
        if (r < I0) { transpose_item(win, 1024, N_in, (bf16_t*)(P.ws + WS_WIN), scr, r, Np / 32, C.lane); continue; } r -= I0;
        if (r < I1) { transpose_item(wout, 2048, 1024, (bf16_t*)(P.ws + WS_WOUT), scr, r, 32, C.lane); continue; } r -= I1;
        if (r < I2) { transpose_item(wup, 1024, 4096, (bf16_t*)(P.ws + WS_WUP), scr, r, 128, C.lane); continue; } r -= I2;
        transpose_item(wdn, 4096, 1024, (bf16_t*)(P.ws + WS_WDN), scr, r, 32, C.lane);
    }
    if (ev) {
        bf16_t* WL = (bf16_t*)(P.ws + WS_WLORA);
        for (int idx = C.bid * 512 + C.tid; idx < 5120 * 16; idx += C.G * 512) {
            const int n = idx % 5120, k8 = idx / 5120, g = n >> 10, cc = n & 1023; float o[8];
#pragma unroll
            for (int e = 0; e < 8; ++e) { const int k = k8 * 8 + e; float v = 0.f;
                if (g == 0) { if (k < 64) v = P.in[I_W2][((size_t)(j * 2 + 0) * 64 + k) * 1024 + cc]; }
                else if (g == 1) { if (k >= 64) v = P.in[I_W2][((size_t)(j * 2 + 1) * 64 + (k - 64)) * 1024 + cc]; }
                else if (g == 2) { if (k < 64) v = P.in[I_A2][((size_t)(j * 2 + 0) * 64 + k) * 1024 + cc]; }
                else if (g == 3) { if (k >= 64) v = P.in[I_A2][((size_t)(j * 2 + 1) * 64 + (k - 64)) * 1024 + cc]; }
                else v = P.in[I_G2][((size_t)j * 128 + k) * 1024 + cc];
                o[e] = v; }
            *(u32x4*)(WL + (size_t)n * 128 + k8 * 8) = pack8(o);
        }
    }
}

__device__ __forceinline__ void phase_rows(const Params& P, const Ctx& C, int mode, const float* gpost, const float* gate_mod  ,
                                           bool next, const float* gpre, const float* mod_next  , bool dummy = false) {
    float* X = P.out + O_X; const bf16_t* MP0 = (const bf16_t*)(P.ws + WS_MP); const bf16_t* MP1 = MP0 + (size_t)MTOK * DM; bf16_t* H = (bf16_t*)(P.ws + WS_H);
    const int gw = C.bid * 8 + C.wave, NGW = C.G * 8;
    for (int m = gw; m < MTOK; m += NGW) {
        const int mr = m < 4096 ? 0 : 1 + ((m - 4096) >> 10);
        f32x4 x[4];
        f32x4 gq[4], sh[4], sl[4];
        if (next) { const f32x4* gp_ = (const f32x4*)gpre + C.lane; const f32x4* sh_ = (const f32x4*)(mod_next + (size_t)mr * 6144) + C.lane; const f32x4* sl_ = (const f32x4*)(mod_next + (size_t)mr * 6144 + 1024) + C.lane;
#pragma unroll
            for (int j = 0; j < 4; ++j) { gq[j] = gp_[64 * j]; sh[j] = sh_[64 * j]; sl[j] = sl_[64 * j]; } }
        if (mode == 0) { const f32x4* src = (const f32x4*)(m < 4096 ? P.in[I_XP] + (size_t)m * DM : P.in[I_XS] + (size_t)(m - 4096) * DM) + C.lane;
#pragma unroll
            for (int j = 0; j < 4; ++j) x[j] = src[64 * j];
        } else {
            const f32x4* xs = (const f32x4*)(X + (size_t)m * DM) + C.lane; const u32x2* p0 = (const u32x2*)(MP0 + (size_t)m * DM) + C.lane; const u32x2* p1 = (const u32x2*)(MP1 + (size_t)m * DM) + C.lane;
            const f32x4* gp = (const f32x4*)gpost + C.lane; const f32x4* gt = (const f32x4*)(gate_mod + (size_t)mr * 6144) + C.lane;
            f32x4 gpv[4], gtv[4];
#pragma unroll
            for (int j = 0; j < 4; ++j) { gpv[j] = gp[64 * j]; gtv[j] = gt[64 * j]; }
            f32x4 f[4]; float ss = 0.f;
#pragma unroll
            for (int j = 0; j < 4; ++j) { x[j] = xs[64 * j]; f[j] = unpack4(p0[64 * j]) + unpack4(p1[64 * j]); ss += (f[j].x * f[j].x + f[j].y * f[j].y) + (f[j].z * f[j].z + f[j].w * f[j].w); }
            const float rs = rsqrtf(wave_sum(ss) * (1.f / DM) + 1e-6f);
#pragma unroll
            for (int j = 0; j < 4; ++j) x[j] = x[j] + gtv[j] * (f[j] * rs * gpv[j]);
        }
        f32x4* xo = (f32x4*)((dummy ? (float*)(P.ws + WS_PREP) : X) + (size_t)m * DM) + C.lane;
#pragma unroll
        for (int j = 0; j < 4; ++j) xo[64 * j] = x[j];
        if (next) {
            float ss = 0.f;
#pragma unroll
            for (int j = 0; j < 4; ++j) ss += (x[j].x * x[j].x + x[j].y * x[j].y) + (x[j].z * x[j].z + x[j].w * x[j].w);
            const float rs = rsqrtf(wave_sum(ss) * (1.f / DM) + 1e-6f);
            u32x2* ho = (u32x2*)((dummy ? (bf16_t*)(P.ws + WS_PREP + 40 * MiB) : H) + (size_t)m * DM) + C.lane;
#pragma unroll
            for (int j = 0; j < 4; ++j) { const f32x4 h = (x[j] * rs * gq[j]) * (sl[j] + 1.f) + sh[j]; u32x2 w; w.x = pk2(h.x, h.y); w.y = pk2(h.z, h.w); ho[64 * j] = w; }
        }
    }
}

__device__ __forceinline__ void conv8(const bf16_t* src, int ld, int col0, int base, int t, bool samp, const float* w, const float* b, int NC, int ch, float* acc) {
    { const f32x4 b0 = *(const f32x4*)(b + ch), b1 = *(const f32x4*)(b + ch + 4); acc[0] = b0.x; acc[1] = b0.y; acc[2] = b0.z; acc[3] = b0.w; acc[4] = b1.x; acc[5] = b1.y; acc[6] = b1.z; acc[7] = b1.w; }
    if (!samp) {
#pragma unroll
        for (int d = 0; d < 3; ++d) { const int tt = t + d - 1; if (tt < 0 || tt >= 256) continue;
            float xv[8]; unpack8(*(const u32x4*)(src + (size_t)(base + tt) * ld + col0 + ch), xv);
            const f32x4 w0 = *(const f32x4*)(w + (3 + d) * NC + ch), w1 = *(const f32x4*)(w + (3 + d) * NC + ch + 4);
            acc[0] += w0.x * xv[0]; acc[1] += w0.y * xv[1]; acc[2] += w0.z * xv[2]; acc[3] += w0.w * xv[3]; acc[4] += w1.x * xv[4]; acc[5] += w1.y * xv[5]; acc[6] += w1.z * xv[6]; acc[7] += w1.w * xv[7]; }
    } else {
        const int r = t >> 6, c = t & 63;
#pragma unroll
        for (int i = 0; i < 3; ++i)
#pragma unroll
            for (int d = 0; d < 3; ++d) { const int rr = r + i - 1, cc = c + d - 1; if (rr < 0 || rr >= 16 || cc < 0 || cc >= 64) continue;
                float xv[8]; unpack8(*(const u32x4*)(src + (size_t)(base + rr * 64 + cc) * ld + col0 + ch), xv);
                const f32x4 w0 = *(const f32x4*)(w + (i * 3 + d) * NC + ch), w1 = *(const f32x4*)(w + (i * 3 + d) * NC + ch + 4);
                acc[0] += w0.x * xv[0]; acc[1] += w0.y * xv[1]; acc[2] += w0.z * xv[2]; acc[3] += w0.w * xv[3]; acc[4] += w1.x * xv[4]; acc[5] += w1.y * xv[5]; acc[6] += w1.z * xv[6]; acc[7] += w1.w * xv[7]; }
    }
}

__device__ __forceinline__ void phase_prep_even(const Params& P, const Ctx& C, int j) {
    const bf16_t* PROJ = (const bf16_t*)(P.ws + WS_PROJ); bf16_t* PREP = (bf16_t*)(P.ws + WS_PREP); bf16_t* LA = (bf16_t*)(P.ws + WS_LORAA);
    float* DT = (float*)(P.ws + WS_DT); float* DA = (float*)(P.ws + WS_DA);
    const float* cw = P.in[I_SCONVW] + (size_t)j * 9 * 2048; const float* cb = P.in[I_SCONVB] + j * 2048;
    const float* mu = P.in[I_MU] + j * 3456; const float* kkw = P.in[I_KK] + j * 1024;
    const int gw = C.bid * 8 + C.wave, NGW = C.G * 8, lane = C.lane;
    for (int m = gw; m < MTOK; m += NGW) {
        const bool samp = m >= 4096; const int T = samp ? 1024 : 256; const int t = samp ? ((m - 4096) & 1023) : (m & 255); const int base = m - t;
        const bf16_t* prow = PROJ + (size_t)m * PROJ_LD_AB; bf16_t* orow = PREP + (size_t)m * PREP_LD;
#pragma unroll 1
        for (int it = 0; it < 4; ++it) { const int ch = it * 512 + lane * 8; float acc[8];
            conv8(PROJ, PROJ_LD_AB, 1024, base, t, samp, cw, cb, 2048, ch, acc);
#pragma unroll
            for (int e = 0; e < 8; ++e) acc[e] = siluf_(acc[e]);
            *(u32x4*)(orow + ch) = pack8(acc); }
#pragma unroll
        for (int it = 0; it < 2; ++it) { const int ch = it * 512 + lane * 8; float z[8]; unpack8(*(const u32x4*)(prow + ch), z);
#pragma unroll
            for (int e = 0; e < 8; ++e) z[e] = siluf_(z[e]);
            *(u32x4*)(orow + 2048 + ch) = pack8(z); }
        if (lane < 32) { const float raw = bf2f(prow[3072 + lane]); const float dt = softplusf_(raw + P.in[I_DTB][j * 32 + lane]);
            DT[(size_t)m * 32 + lane] = dt; DA[(size_t)m * 32 + lane] = -dt * __expf(P.in[I_ALOG][j * 32 + lane]); }
        const bool hp = t > 0, hn = t < T - 1;
#pragma unroll 1
        for (int it = 0; it < 7; ++it) { const int c = it * 512 + lane * 8; if (c >= 3456) break;
            float x[8], xp[8], xn[8];
            unpack8(*(const u32x4*)(prow + IN_SSD + c), x);
            if (hp) unpack8(*(const u32x4*)(prow - PROJ_LD_AB + IN_SSD + c), xp); else {
#pragma unroll
                for (int e = 0; e < 8; ++e) xp[e] = 0.f; }
            if (hn) unpack8(*(const u32x4*)(prow + PROJ_LD_AB + IN_SSD + c), xn); else {
#pragma unroll
                for (int e = 0; e < 8; ++e) xn[e] = 0.f; }
            const f32x4 m0 = *(const f32x4*)(mu + c), m1 = *(const f32x4*)(mu + c + 4);
            const float mv[8] = {m0.x, m0.y, m0.z, m0.w, m1.x, m1.y, m1.z, m1.w};
#pragma unroll
            for (int e = 0; e < 8; ++e) x[e] = x[e] + mv[e] * (0.5f * (xp[e] + xn[e]) - x[e]);
            if (it < 2) { *(u32x4*)(orow + 3072 + c) = pack8(x); }
            else if (it < 4) { *(u32x4*)(orow + 4096 + (c - 1024)) = pack8(x);
                const f32x4 k0 = *(const f32x4*)(kkw + c - 1024), k1 = *(const f32x4*)(kkw + c - 1024 + 4);
                const float kv[8] = {k0.x, k0.y, k0.z, k0.w, k1.x, k1.y, k1.z, k1.w}; float ss = 0.f;
#pragma unroll
                for (int e = 0; e < 8; ++e) { x[e] *= kv[e]; ss += x[e] * x[e]; }
                ss += __shfl_xor(ss, 1); ss += __shfl_xor(ss, 2); ss += __shfl_xor(ss, 4);
                const float rn = rsqrtf(ss + 1e-12f);
#pragma unroll
                for (int e = 0; e < 8; ++e) x[e] *= rn;
                *(u32x4*)(orow + 6144 + (c - 1024)) = pack8(x); }
            else if (it < 6) { *(u32x4*)(orow + 5120 + (c - 2048)) = pack8(x); }
            else { const int cc = c - 3072;
#pragma unroll
                for (int e = 0; e < 8; ++e) x[e] = cc < 128 ? tanhf_(x[e]) : (cc < 256 ? x[e] : sigmoidf_(x[e]));
                *(u32x4*)(LA + (size_t)m * LORA_K + cc) = pack8(x); }
        }
    }
}
__device__ __forceinline__ void phase_prep_odd(const Params& P, const Ctx& C, int j) {
    const bf16_t* PROJ = (const bf16_t*)(P.ws + WS_PROJ); bf16_t* PREP = (bf16_t*)(P.ws + WS_PREP);
    const float* cw = P.in[I_MCONVW] + (size_t)j * 9 * 1024; const float* cb = P.in[I_MCONVB] + j * 1024;
    const int gw = C.bid * 8 + C.wave, NGW = C.G * 8, lane = C.lane;
    for (int m = gw; m < MTOK; m += NGW) {
        const bool samp = m >= 4096; const int t = samp ? ((m - 4096) & 1023) : (m & 255); const int base = m - t;
#pragma unroll 1
        for (int it = 0; it < 2; ++it) { const int ch = it * 512 + lane * 8; float acc[8];
            conv8(PROJ, PROJ_LD_CD, IN_GLA, base, t, samp, cw, cb, 1024, ch, acc);
#pragma unroll
            for (int e = 0; e < 8; ++e) acc[e] = siluf_(acc[e]);
            *(u32x4*)(PREP + (size_t)m * PREP_LD + ch) = pack8(acc); }
    }
}

constexpr int CS_QLD = 136, CS_SLD = 72;
constexpr int CS_QS = 0, CS_KS = 17408, CS_KT = 34816, CS_VT = 53248;
__device__ __forceinline__ bf16x8 lds_frag(const LAS bf16_t* p) { return *(const LAS bf16x8*)p; }
template <int MODE>
__device__ __forceinline__ void chunk_scan(const Params& P, const Ctx& C, int j, int s, int dir, int h, int vs) {
    const int tid = C.tid, lane = C.lane, w = C.wave, fr = lane & 15, fq = lane >> 4;
    const int T = s < 16 ? 256 : 1024, base = s < 16 ? s * 256 : 4096 + (s - 16) * 1024, nch = T >> 6;
    const bf16_t* PROJ = (const bf16_t*)(P.ws + WS_PROJ); const bf16_t* PREP = (const bf16_t*)(P.ws + WS_PREP);
    bf16_t* Y = (bf16_t*)(P.ws + WS_MP) + (size_t)dir * MTOK * YLD;
    LAS bf16_t* Qs = (LAS bf16_t*)(C.lds + CS_QS); LAS bf16_t* Ks = (LAS bf16_t*)(C.lds + CS_KS); LAS bf16_t* Kt = (LAS bf16_t*)(C.lds + CS_KT); LAS bf16_t* Vt = (LAS bf16_t*)(C.lds + CS_VT);
    constexpr int NV = MODE == 0 ? 64 : 128, NVC = NV / 16, VROWS = NV + (MODE == 2 ? 16 : 0);
    constexpr int CS_ST = CS_VT + VROWS * CS_SLD * 2, CS_LA = CS_ST + VROWS * CS_QLD * 2, CS_PS = CS_LA  , CS_TOT = CS_LA + (MODE == 1 ? 32768 : 9216),
                  CS_BV = CS_TOT + 2560, CS_IG = CS_BV + 256, CS_FV = CS_IG + 256, CS_DTV = CS_FV + 256, CS_MS = CS_DTV + 256;
    static_assert(CS_MS + 64 <= LDS_BYTES - 16, "chunk-scan LDS map");
    LAS bf16_t* Ps = (LAS bf16_t*)(C.lds + CS_PS); LAS bf16_t* St = (LAS bf16_t*)(C.lds + CS_ST);
    LAS float* LA = (LAS float*)(C.lds + CS_LA); LAS float* TOT = (LAS float*)(C.lds + CS_TOT); LAS float* BV = (LAS float*)(C.lds + CS_BV); LAS float* IG = (LAS float*)(C.lds + CS_IG);
    LAS float* MS = (LAS float*)(C.lds + CS_MS); LAS float* FV = (LAS float*)(C.lds + CS_FV); LAS float* DTV = (LAS float*)(C.lds + CS_DTV);
    constexpr int NVT = NVC + (MODE == 2 ? 1 : 0);
    const int si = tid >> 3, kq = tid & 7;
    __syncthreads();
    bf16x8 gwa_hi = {0, 0, 0, 0, 0, 0, 0, 0}, gwa_lo = {0, 0, 0, 0, 0, 0, 0, 0}; f32x4 gb4 = {0.f, 0.f, 0.f, 0.f};
    if (MODE == 1) {
        const float* gwp = P.in[I_GGW] + (size_t)(j * 2 + dir) * 16 * 512 + h * 128 + 16 * w + fr;
        if (fq < 2) {
#pragma unroll
            for (int e = 0; e < 8; ++e) { const float g = gwp[(8 * fq + e) * 512]; const unsigned hb = f2bf(g); const float rem = g - bf2f(hb); gwa_hi[e] = (short)hb; gwa_lo[e] = (short)f2bf(rem); } }
        gb4 = *(const f32x4*)(P.in[I_GGB] + (j * 2 + dir) * 512 + h * 128 + 16 * w + 4 * fq);
    }
    f32x4 Sacc[NVT];
    {
        const float* s0 = nullptr; int kstride = 64; float em0 = 1.f;
        if (s >= 16) { const int b = s - 16;
            if (MODE == 0) { s0 = P.in[I_SSSD] + ((size_t)((b * 2 + j) * 2 + dir) * 16 + h) * 8192; kstride = 64; }
            if (MODE == 1) { s0 = P.in[I_SGLA] + ((size_t)((b * 2 + j) * 2 + dir) * 4 + h) * 32768 + vs * NV; kstride = 256; }
            if (MODE == 2) { s0 = P.in[I_SMC] + ((size_t)((b * 2 + j) * 2 + dir) * 4 + h) * 32768 + vs * NV; kstride = 256; em0 = __expf(P.in[I_SMM][((b * 2 + j) * 2 + dir) * 4 + h]); } }
#pragma unroll
        for (int vt = 0; vt < NVC; ++vt)
#pragma unroll
            for (int e = 0; e < 4; ++e) Sacc[vt][e] = s0 ? s0[(size_t)(16 * w + 4 * fq + e) * kstride + 16 * vt + fr] * em0 : 0.f;
        if (MODE == 2) {
            const float* n0 = s >= 16 ? P.in[I_SMN] + ((size_t)(((s - 16) * 2 + j) * 2 + dir) * 4 + h) * 128 : nullptr;
#pragma unroll
            for (int e = 0; e < 4; ++e) Sacc[NVT - 1][e] = (n0 && fr == 0) ? n0[16 * w + 4 * fq + e] * em0 : 0.f;
            if (tid == 0) MS[0] = s >= 16 ? P.in[I_SMM][(((s - 16) * 2 + j) * 2 + dir) * 4 + h] : 0.f;
            for (int i = tid; i < 16 * CS_SLD; i += 512) Vt[NV * CS_SLD + i] = (bf16_t)((i < CS_SLD) ? 0x3F80 : 0);
        }
#pragma unroll
        for (int vt = 0; vt < NVT; ++vt) { u32x2 wv; wv.x = pk2(Sacc[vt][0], Sacc[vt][1]); wv.y = pk2(Sacc[vt][2], Sacc[vt][3]); *(LAS u32x2*)(St + (16 * vt + fr) * CS_QLD + 16 * w + 4 * fq) = wv; }
    }
    u32x4 rq0, rq1, rk0, rk1, rgd[4]; float rla = 0.f, rig = 0.f, rdt = 0.f;
    constexpr int NVTOK = MODE == 0 ? 8 : 16;
    unsigned short rkt[16], rvt[NVTOK];
    const int kx = tid & 127, tgk = tid >> 7, vx = tid & (NV - 1), tgv = MODE == 0 ? (tid >> 6) : (tid >> 7);
    auto tok = [&](int c, int i) { const int st0 = c * 64 + i; return base + (dir ? (T - 1 - st0) : st0); };
    auto load_raw = [&](int c) {
        const int m = tok(c, si); const int m1 = tok(c, tid & 63);
        const bf16_t* krow; const bf16_t* vrow; int kld, vld;
        if (MODE == 0) { const int g = h >> 2; const bf16_t* pr = PREP + (size_t)m * PREP_LD;
            rq0 = *(const u32x4*)(pr + 1536 + g * 128 + 16 * kq); rq1 = *(const u32x4*)(pr + 1536 + g * 128 + 16 * kq + 8);
            rk0 = *(const u32x4*)(pr + 1024 + g * 128 + 16 * kq); rk1 = *(const u32x4*)(pr + 1024 + g * 128 + 16 * kq + 8);
            if (tid < 64) { rla = ((const float*)(P.ws + WS_DA))[(size_t)m1 * 32 + dir * 16 + h]; rdt = ((const float*)(P.ws + WS_DT))[(size_t)m1 * 32 + dir * 16 + h]; }
            krow = PREP + 1024 + g * 128 + kx; kld = PREP_LD; vrow = PREP + h * 64 + vx; vld = PREP_LD; }
        if (MODE == 1) { const bf16_t* pr = PROJ + (size_t)m * PROJ_LD_CD;
            rq0 = *(const u32x4*)(pr + h * 128 + 16 * kq); rq1 = *(const u32x4*)(pr + h * 128 + 16 * kq + 8);
            rk0 = *(const u32x4*)(pr + 512 + h * 128 + 16 * kq); rk1 = *(const u32x4*)(pr + 512 + h * 128 + 16 * kq + 8);
#pragma unroll
            for (int t4 = 0; t4 < 4; ++t4) { rgd[t4] = (u32x4){0u, 0u, 0u, 0u}; if (fq < 2) rgd[t4] = *(const u32x4*)(PROJ + (size_t)tok(c, 16 * t4 + fr) * PROJ_LD_CD + 3072 + dir * 16 + 8 * fq); }
            krow = PROJ + 512 + h * 128 + kx; kld = PROJ_LD_CD; vrow = PROJ + 1024 + h * 256 + vs * NV + vx; vld = PROJ_LD_CD; }
        if (MODE == 2) { const bf16_t* pp = PREP + (size_t)m * PREP_LD;
            rq0 = *(const u32x4*)(pp + h * 128 + 16 * kq); rq1 = *(const u32x4*)(pp + h * 128 + 16 * kq + 8);
            rk0 = *(const u32x4*)(pp + 512 + h * 128 + 16 * kq); rk1 = *(const u32x4*)(pp + 512 + h * 128 + 16 * kq + 8);
            if (tid < 64) { const bf16_t* p1 = PROJ + (size_t)m1 * PROJ_LD_CD + IN_GLA + 3072; rig = bf2f(p1[dir * 4 + h]); rla = bf2f(p1[8 + dir * 4 + h]); }
            krow = PREP + 512 + h * 128 + kx; kld = PREP_LD; vrow = PROJ + IN_GLA + 1024 + h * 256 + vs * NV + vx; vld = PROJ_LD_CD; }
        { const bf16_t* kp = krow + (size_t)tok(c, 16 * tgk) * kld; const long ks_ = dir ? -(long)kld : (long)kld;
#pragma unroll
          for (int jj = 0; jj < 16; ++jj) { rkt[jj] = *kp; kp += ks_; }
          const bf16_t* vp = vrow + (size_t)tok(c, NVTOK * tgv) * vld; const long vs_ = dir ? -(long)vld : (long)vld;
#pragma unroll
          for (int jj = 0; jj < NVTOK; ++jj) { rvt[jj] = *vp; vp += vs_; } }
    };
    load_raw(0);
    __syncthreads();
    const int ycol0 = (MODE == 0 ? h * 64 : (MODE == 1 ? h * 256 + vs * NV : 1024 + h * 256 + vs * NV));
    for (int c = 0; c < nch; ++c) {
        if (MODE == 1) {
#pragma unroll
            for (int t4 = 0; t4 < 4; ++t4) { f32x4 acc = (f32x4){0.f, 0.f, 0.f, 0.f}; const bf16x8 gf = __builtin_bit_cast(bf16x8, rgd[t4]);
                acc = __builtin_amdgcn_mfma_f32_16x16x32_bf16(gwa_hi, gf, acc, 0, 0, 0); acc = __builtin_amdgcn_mfma_f32_16x16x32_bf16(gwa_lo, gf, acc, 0, 0, 0);
                f32x4 la;
#pragma unroll
                for (int e = 0; e < 4; ++e) la[e] = logsigmoidf_(acc[e] + gb4[e]) * 0.0625f;
                *(LAS f32x4*)(LA + (16 * t4 + fr) * 128 + 16 * w + 4 * fq) = la; }
        } else if (tid < 64) {
            float ig = 0.f, la = rla;
            if (MODE == 2) { ig = rig + P.in[I_MIB][(j * 2 + dir) * 4 + h]; la = logsigmoidf_(rla + P.in[I_MFB][(j * 2 + dir) * 4 + h]); }
            float x = la;
            x += __int_as_float(__builtin_amdgcn_update_dpp(0, __float_as_int(x), 0x111, 0xF, 0xF, true));
            x += __int_as_float(__builtin_amdgcn_update_dpp(0, __float_as_int(x), 0x112, 0xF, 0xF, true));
            x += __int_as_float(__builtin_amdgcn_update_dpp(0, __float_as_int(x), 0x114, 0xF, 0xF, true));
            x += __int_as_float(__builtin_amdgcn_update_dpp(0, __float_as_int(x), 0x118, 0xF, 0xF, true));
            { const float t0 = __int_as_float(__builtin_amdgcn_readlane(__float_as_int(x), 15)), t1 = __int_as_float(__builtin_amdgcn_readlane(__float_as_int(x), 31)), t2 = __int_as_float(__builtin_amdgcn_readlane(__float_as_int(x), 47));
              const int rw = lane >> 4; x += (rw > 0 ? t0 : 0.f) + (rw > 1 ? t1 : 0.f) + (rw > 2 ? t2 : 0.f); }
            const float bl = __int_as_float(__builtin_amdgcn_readlane(__float_as_int(x), 63));
            const float kgn = MODE == 2 ? 0.08838834764831845f * __expf(ig) : 1.f;
            BV[tid] = x; IG[tid] = kgn; FV[tid] = kgn * __expf(bl - x); DTV[tid] = MODE == 0 ? rdt : 1.f;
            if (MODE == 2) { float ml = bl - x + ig;
                ml = fmaxf(ml, __int_as_float(__builtin_amdgcn_update_dpp(__float_as_int(ml), __float_as_int(ml), 0xB1, 0xF, 0xF, false)));
                ml = fmaxf(ml, __int_as_float(__builtin_amdgcn_update_dpp(__float_as_int(ml), __float_as_int(ml), 0x4E, 0xF, 0xF, false)));
                ml = fmaxf(ml, __int_as_float(__builtin_amdgcn_update_dpp(__float_as_int(ml), __float_as_int(ml), 0x141, 0xF, 0xF, false)));
                ml = fmaxf(ml, __int_as_float(__builtin_amdgcn_update_dpp(__float_as_int(ml), __float_as_int(ml), 0x140, 0xF, 0xF, false)));
                const float m01 = fmaxf(__int_as_float(__builtin_amdgcn_readlane(__float_as_int(ml), 0)), __int_as_float(__builtin_amdgcn_readlane(__float_as_int(ml), 16)));
                const float m23 = fmaxf(__int_as_float(__builtin_amdgcn_readlane(__float_as_int(ml), 32)), __int_as_float(__builtin_amdgcn_readlane(__float_as_int(ml), 48)));
                if (tid == 0) MS[0] = fmaxf(bl + MS[0], fmaxf(m01, m23)); }
        }
        __syncthreads();
        if (MODE == 1) {
            const int k = tid & 127, qd = tid >> 7; float run = 0.f;
#pragma unroll
            for (int jj = 0; jj < 16; ++jj) { run += LA[(16 * qd + jj) * 128 + k]; LA[(16 * qd + jj) * 128 + k] = run; }
            TOT[qd * 128 + k] = run;
            __syncthreads();
            if (tid < 128) TOT[4 * 128 + tid] = __expf(TOT[tid] + TOT[128 + tid] + TOT[256 + tid] + TOT[384 + tid]);
        }
        {
            float q[16], k[16]; unpack8(rq0, q); unpack8(rq1, q + 8); unpack8(rk0, k); unpack8(rk1, k + 8);
            float qs[16], ks[16];
            if (MODE == 1) { const int qd = si >> 4;
#pragma unroll
                for (int e4 = 0; e4 < 4; ++e4) { const int kk = 16 * kq + 4 * e4; const f32x4 bb = *(LAS f32x4*)(LA + si * 128 + kk), t0 = *(LAS f32x4*)(TOT + kk), t1 = *(LAS f32x4*)(TOT + 128 + kk), t2 = *(LAS f32x4*)(TOT + 256 + kk);
#pragma unroll
                    for (int e = 0; e < 4; ++e) { const float b = bb[e] + (qd > 0 ? t0[e] : 0.f) + (qd > 1 ? t1[e] : 0.f) + (qd > 2 ? t2[e] : 0.f);
                        qs[4 * e4 + e] = q[4 * e4 + e] * 0.08838834764831845f * __expf(b); ks[4 * e4 + e] = k[4 * e4 + e] * __expf(fminf(-b, 80.f)); } }
            } else { const float kgn = IG[si];
#pragma unroll
                for (int e = 0; e < 16; ++e) { qs[e] = q[e]; ks[e] = k[e] * kgn; } }
            *(LAS u32x4*)(Qs + si * CS_QLD + 16 * kq) = pack8(qs); *(LAS u32x4*)(Qs + si * CS_QLD + 16 * kq + 8) = pack8(qs + 8);
            *(LAS u32x4*)(Ks + si * CS_QLD + 16 * kq) = pack8(ks); *(LAS u32x4*)(Ks + si * CS_QLD + 16 * kq + 8) = pack8(ks + 8);
        }
        if (MODE == 1)
        {
            float kt[16];
            if (MODE == 1) { float off = 0.f; const float t0 = TOT[kx], t1 = TOT[128 + kx], t2 = TOT[256 + kx], t3 = TOT[384 + kx];
                off = (tgk > 0 ? t0 : 0.f) + (tgk > 1 ? t1 : 0.f) + (tgk > 2 ? t2 : 0.f); const float bl = (t0 + t1) + (t2 + t3);
#pragma unroll
                for (int jj = 0; jj < 16; ++jj) kt[jj] = bf2f(rkt[jj]) * __expf(bl - (LA[(16 * tgk + jj) * 128 + kx] + off));
            } else {
#pragma unroll
                for (int jj = 0; jj < 16; ++jj) kt[jj] = bf2f(rkt[jj]) * FV[16 * tgk + jj]; }
            *(LAS u32x4*)(Kt + kx * CS_SLD + 16 * tgk) = pack8(kt); *(LAS u32x4*)(Kt + kx * CS_SLD + 16 * tgk + 8) = pack8(kt + 8);
            float vt8[NVTOK];
#pragma unroll
            for (int jj = 0; jj < NVTOK; ++jj) vt8[jj] = bf2f(rvt[jj]) * (MODE == 0 ? DTV[NVTOK * tgv + jj] : 1.f);
            *(LAS u32x4*)(Vt + vx * CS_SLD + NVTOK * tgv) = pack8(vt8);
            if (NVTOK == 16) *(LAS u32x4*)(Vt + vx * CS_SLD + NVTOK * tgv + 8) = pack8(vt8 + 8);
        }
        __syncthreads();
        if (MODE != 1)
        {
            float kt[16];
            if (MODE == 1) { float off = 0.f; const float t0 = TOT[kx], t1 = TOT[128 + kx], t2 = TOT[256 + kx], t3 = TOT[384 + kx];
                off = (tgk > 0 ? t0 : 0.f) + (tgk > 1 ? t1 : 0.f) + (tgk > 2 ? t2 : 0.f); const float bl = (t0 + t1) + (t2 + t3);
#pragma unroll
                for (int jj = 0; jj < 16; ++jj) kt[jj] = bf2f(rkt[jj]) * __expf(bl - (LA[(16 * tgk + jj) * 128 + kx] + off));
            } else {
#pragma unroll
                for (int jj = 0; jj < 16; ++jj) kt[jj] = bf2f(rkt[jj]) * FV[16 * tgk + jj]; }
            *(LAS u32x4*)(Kt + kx * CS_SLD + 16 * tgk) = pack8(kt); *(LAS u32x4*)(Kt + kx * CS_SLD + 16 * tgk + 8) = pack8(kt + 8);
            float vt8[NVTOK];
#pragma unroll
            for (int jj = 0; jj < NVTOK; ++jj) vt8[jj] = bf2f(rvt[jj]) * (MODE == 0 ? DTV[NVTOK * tgv + jj] : 1.f);
            *(LAS u32x4*)(Vt + vx * CS_SLD + NVTOK * tgv) = pack8(vt8);
            if (NVTOK == 16) *(LAS u32x4*)(Vt + vx * CS_SLD + NVTOK * tgv + 8) = pack8(vt8 + 8);
        }
        if (c + 1 < nch) load_raw(c + 1);
        const int tt = w >> 1;
#pragma unroll
        for (int sj = 0; sj < 2; ++sj) { const int st = 2 * (w & 1) + sj; u32x2 wv; wv.x = 0u; wv.y = 0u;
            if (st <= tt) { f32x4 acc = (f32x4){0.f, 0.f, 0.f, 0.f};
#pragma unroll
                for (int kk = 0; kk < 4; ++kk) acc = __builtin_amdgcn_mfma_f32_16x16x32_bf16(lds_frag(Ks + (16 * st + fr) * CS_QLD + 32 * kk + 8 * fq), lds_frag(Qs + (16 * tt + fr) * CS_QLD + 32 * kk + 8 * fq), acc, 0, 0, 0);
                const int tg = 16 * tt + fr, sg = 16 * st + 4 * fq;
                if (MODE != 1) { const float bt = BV[tg]; const f32x4 bs = *(LAS f32x4*)(BV + sg);
#pragma unroll
                    for (int e = 0; e < 4; ++e) acc[e] *= __expf(fminf(bt - bs[e], 0.f)); }
#pragma unroll
                for (int e = 0; e < 4; ++e) acc[e] = (sg + e <= tg) ? acc[e] : 0.f;
                wv.x = pk2(acc[0], acc[1]); wv.y = pk2(acc[2], acc[3]); }
            *(LAS u32x2*)(Ps + (16 * tt + fr) * CS_SLD + 16 * st + 4 * fq) = wv; }
        __syncthreads();
        {
            const int tg = 16 * tt + fr; const int stp = c * 64 + tg; const int m = base + (dir ? (T - 1 - stp) : stp);
            const float ebt = MODE == 1 ? 1.f : __expf(BV[tg]);
            bf16x8 pf[2], qf[4];
#pragma unroll
            for (int ks2 = 0; ks2 < 2; ++ks2) pf[ks2] = lds_frag(Ps + tg * CS_SLD + 32 * ks2 + 8 * fq);
#pragma unroll
            for (int kk = 0; kk < 4; ++kk) qf[kk] = lds_frag(Qs + tg * CS_QLD + 32 * kk + 8 * fq);
            float rden = 1.f;
            if (MODE == 2) { f32x4 ai = (f32x4){0.f, 0.f, 0.f, 0.f}, ao = (f32x4){0.f, 0.f, 0.f, 0.f};
#pragma unroll
                for (int ks2 = 0; ks2 < 2; ++ks2) ai = __builtin_amdgcn_mfma_f32_16x16x32_bf16(lds_frag(Vt + (NV + fr) * CS_SLD + 32 * ks2 + 8 * fq), pf[ks2], ai, 0, 0, 0);
#pragma unroll
                for (int kk = 0; kk < 4; ++kk) ao = __builtin_amdgcn_mfma_f32_16x16x32_bf16(lds_frag(St + (NV + fr) * CS_QLD + 32 * kk + 8 * fq), qf[kk], ao, 0, 0, 0);
                const float den = __shfl(ai[0] + ao[0] * ebt, fr); rden = 1.f / fmaxf(fabsf(den), 1.f); }
#pragma unroll
            for (int vj = 0; vj < NVC / 2; ++vj) { const int vt = (NVC / 2) * (w & 1) + vj; f32x4 ai = (f32x4){0.f, 0.f, 0.f, 0.f}, ao = (f32x4){0.f, 0.f, 0.f, 0.f};
#pragma unroll
                for (int ks2 = 0; ks2 < 2; ++ks2) ai = __builtin_amdgcn_mfma_f32_16x16x32_bf16(lds_frag(Vt + (16 * vt + fr) * CS_SLD + 32 * ks2 + 8 * fq), pf[ks2], ai, 0, 0, 0);
#pragma unroll
                for (int kk = 0; kk < 4; ++kk) ao = __builtin_amdgcn_mfma_f32_16x16x32_bf16(lds_frag(St + (16 * vt + fr) * CS_QLD + 32 * kk + 8 * fq), qf[kk], ao, 0, 0, 0);
                u32x2 wv; wv.x = pk2((ai[0] + ao[0] * ebt) * rden, (ai[1] + ao[1] * ebt) * rden); wv.y = pk2((ai[2] + ao[2] * ebt) * rden, (ai[3] + ao[3] * ebt) * rden);
                *(u32x2*)(Y + (size_t)m * YLD + ycol0 + 16 * vt + 4 * fq) = wv; }
        }
        {
            f32x4 dec; if (MODE == 1) dec = *(LAS f32x4*)(TOT + 4 * 128 + 16 * w + 4 * fq); else { const float d = __expf(BV[63]); dec = (f32x4){d, d, d, d}; }
            bf16x8 kf[2];
#pragma unroll
            for (int ks2 = 0; ks2 < 2; ++ks2) kf[ks2] = lds_frag(Kt + (16 * w + fr) * CS_SLD + 32 * ks2 + 8 * fq);
#pragma unroll
            for (int vt = 0; vt < NVT; ++vt) { Sacc[vt] = Sacc[vt] * dec;
#pragma unroll
                for (int ks2 = 0; ks2 < 2; ++ks2) Sacc[vt] = __builtin_amdgcn_mfma_f32_16x16x32_bf16(kf[ks2], lds_frag(Vt + (16 * vt + fr) * CS_SLD + 32 * ks2 + 8 * fq), Sacc[vt], 0, 0, 0); }
        }
        __syncthreads();
#pragma unroll
        for (int vt = 0; vt < NVT; ++vt) { u32x2 wv; wv.x = pk2(Sacc[vt][0], Sacc[vt][1]); wv.y = pk2(Sacc[vt][2], Sacc[vt][3]); *(LAS u32x2*)(St + (16 * vt + fr) * CS_QLD + 16 * w + 4 * fq) = wv; }
    }
    if (s < 16) {
        float* o; int kstride; float sc = 1.f;
        if (MODE == 0) { o = P.out + O_SSD + ((size_t)((s * 2 + j) * 2 + dir) * 16 + h) * 8192; kstride = 64; }
        else { o = P.out + (MODE == 1 ? O_GLA : O_MC) + ((size_t)((s * 2 + j) * 2 + dir) * 4 + h) * 32768 + vs * NV; kstride = 256; }
        if (MODE == 2) { __syncthreads(); sc = __expf(-MS[0]); }
#pragma unroll
        for (int vt = 0; vt < NVC; ++vt)
#pragma unroll
            for (int e = 0; e < 4; ++e) o[(size_t)(16 * w + 4 * fq + e) * kstride + 16 * vt + fr] = Sacc[vt][e] * sc;
        if (MODE == 2 && vs == 0) {
            if (fr == 0) {
#pragma unroll
                for (int e = 0; e < 4; ++e) P.out[O_MN + ((size_t)((s * 2 + j) * 2 + dir) * 4 + h) * 128 + 16 * w + 4 * fq + e] = Sacc[NVT - 1][e] * sc; }
            if (tid == 0) P.out[O_MM + ((s * 2 + j) * 2 + dir) * 4 + h] = MS[0]; }
    }
}

struct RwOps { f32x4 kk0, kk1, w0, w1, kd0, kd1, ka0, ka1, r0, r1; f32x2 vv; };
__device__ __forceinline__ RwOps rw_ops(const LAS float* B, int tt, int kg, int vg) {
    const LAS float* p = B + tt * 64 + 4 * kg; RwOps o;
    o.kk0 = *(const LAS f32x4*)(p + 4096); o.kk1 = *(const LAS f32x4*)(p + 4096 + 32); o.w0 = *(const LAS f32x4*)(p + 1024); o.w1 = *(const LAS f32x4*)(p + 1024 + 32);
    o.kd0 = *(const LAS f32x4*)(p + 2048); o.kd1 = *(const LAS f32x4*)(p + 2048 + 32); o.ka0 = *(const LAS f32x4*)(p + 5120); o.ka1 = *(const LAS f32x4*)(p + 5120 + 32);
    o.r0 = *(const LAS f32x4*)(p); o.r1 = *(const LAS f32x4*)(p + 32); o.vv = *(const LAS f32x2*)(B + 3072 + tt * 64 + 2 * vg); return o;
}
__device__ __forceinline__ void rwkv_pair(const Params& P, const Ctx& C, int j, int bq, bool lng) {
    const int niter = lng ? 64 : 32; const bool act = !lng || C.tid < 256;
    const int tid = C.tid, half = tid >> 8, tl = tid & 255, kg = tl & 7, vg = tl >> 3;
    const bf16_t* PREP = (const bf16_t*)(P.ws + WS_PREP); const bf16_t* LOUT = (const bf16_t*)(P.ws + WS_PROJ);
    constexpr int BUFSZ = 6 * 1024;
    LAS float* L0 = (LAS float*)C.lds + half * 2 * BUFSZ;
    const int stt = tl >> 4, sc4 = (tl & 15) * 4;
    auto unit_of = [&](int cc, int& s, int& dir, int& h, int& lc) {
        if (lng) { s = 16 + (bq >> 5); dir = (bq >> 4) & 1; h = bq & 15; lc = cc; }
        else { const int q = 4 * bq + 2 * half + (cc >> 4); s = q >> 5; dir = (q >> 4) & 1; h = q & 15; lc = cc & 15; } };
    f32x2 S2[8];
    auto init_state = [&](int s, int dir, int h) {
        const float* s0 = s >= 16 ? P.in[I_SRWKV] + (((size_t)(((s - 16) * 2 + j) * 2 + dir) * 16 + h) * 64 + 2 * vg) * 64 : nullptr;
#pragma unroll
        for (int hh = 0; hh < 2; ++hh) { const f32x4 u0 = s0 ? *(const f32x4*)(s0 + 32 * hh + 4 * kg) : (f32x4){0.f, 0.f, 0.f, 0.f}, u1 = s0 ? *(const f32x4*)(s0 + 64 + 32 * hh + 4 * kg) : (f32x4){0.f, 0.f, 0.f, 0.f};
#pragma unroll
            for (int e = 0; e < 4; ++e) S2[hh * 4 + e] = (f32x2){u0[e], u1[e]}; } };
    u32x2 rr, rk, rv, rkk, rwl, ral; f32x4 cw0, ca0, cka;
    auto load_raw = [&](int cc) {
        int s, dir, h, lc; unit_of(cc, s, dir, h, lc);
        const int T = s < 16 ? 256 : 1024, base = s < 16 ? s * 256 : 4096 + (s - 16) * 1024;
        const int step = lc * 16 + stt; const int m = base + (dir ? (T - 1 - step) : step);
        const bf16_t* pp = PREP + (size_t)m * PREP_LD + h * 64 + sc4; const bf16_t* lo = LOUT + (size_t)m * LOUT_LD + dir * 1024 + h * 64 + sc4;
        rr = *(const u32x2*)(pp + 3072); rk = *(const u32x2*)(pp + 4096); rv = *(const u32x2*)(pp + 5120); rkk = *(const u32x2*)(pp + 6144);
        rwl = *(const u32x2*)lo; ral = *(const u32x2*)(lo + 2048);
        cw0 = *(const f32x4*)(P.in[I_W0] + (j * 2 + dir) * 1024 + h * 64 + sc4); ca0 = *(const f32x4*)(P.in[I_A0] + (j * 2 + dir) * 1024 + h * 64 + sc4); cka = *(const f32x4*)(P.in[I_KA] + j * 1024 + h * 64 + sc4);
    };
    auto write_lds = [&](LAS float* B) {
        const f32x4 r = unpack4(rr), k = unpack4(rk), v = unpack4(rv), kk = unpack4(rkk), wl = unpack4(rwl), al = unpack4(ral);
        f32x4 w, kd, kka;
#pragma unroll
        for (int e = 0; e < 4; ++e) { const float wp = cw0[e] + wl[e]; const float lw = -__expf(-softplusf_(-wp) - 0.5f); w[e] = __expf(lw);
            const float a = sigmoidf_(ca0[e] + al[e]); kd[e] = k[e] * (1.f + (a - 1.f) * cka[e]); kka[e] = kk[e] * a; }
        LAS float* p = B + stt * 64 + sc4;
        *(LAS f32x4*)(p) = r; *(LAS f32x4*)(p + 1024) = w; *(LAS f32x4*)(p + 2048) = kd; *(LAS f32x4*)(p + 3072) = v; *(LAS f32x4*)(p + 4096) = kk; *(LAS f32x4*)(p + 5120) = kka;
    };
    __syncthreads();
    if (act) { load_raw(0); write_lds(L0);
    { int s, dir, h, lc; unit_of(0, s, dir, h, lc); init_state(s, dir, h); } }
    __syncthreads();
#pragma unroll 1
    for (int cc = 0; cc < niter; ++cc) {
        if (act) {
        LAS float* B = L0 + (cc & 1) * BUFSZ;
        int s, dir, h, lc; unit_of(cc, s, dir, h, lc);
        const int T = s < 16 ? 256 : 1024, base = s < 16 ? s * 256 : 4096 + (s - 16) * 1024;
        if (cc + 1 < niter) load_raw(cc + 1);
        bf16_t* Y = (bf16_t*)(P.ws + WS_MP) + (size_t)dir * MTOK * YLD + 1024 + h * 64 + 2 * vg;
        RwOps cur = rw_ops(B, 0, kg, vg);
#pragma unroll 2
        for (int tt = 0; tt < 16; ++tt) {
            const RwOps nx = rw_ops(B, (tt + 1) & 15, kg, vg);
            const int step = lc * 16 + tt; const int m = base + (dir ? (T - 1 - step) : step);
            f32x2 da = (f32x2){0.f, 0.f}, db = (f32x2){0.f, 0.f};
#pragma unroll
            for (int e = 0; e < 4; ++e) { da = da + S2[e] * (f32x2){cur.kk0[e], cur.kk0[e]}; db = db + S2[4 + e] * (f32x2){cur.kk1[e], cur.kk1[e]}; }
            const f32x2 d2 = da + db;
            f32x2 sk2; sk2.x = row_sum8(d2.x); sk2.y = row_sum8(d2.y);
            f32x2 ya = (f32x2){0.f, 0.f}, yb = (f32x2){0.f, 0.f};
#pragma unroll
            for (int e = 0; e < 4; ++e) {
                S2[e] = S2[e] * (f32x2){cur.w0[e], cur.w0[e]} - sk2 * (f32x2){cur.ka0[e], cur.ka0[e]} + cur.vv * (f32x2){cur.kd0[e], cur.kd0[e]};
                S2[4 + e] = S2[4 + e] * (f32x2){cur.w1[e], cur.w1[e]} - sk2 * (f32x2){cur.ka1[e], cur.ka1[e]} + cur.vv * (f32x2){cur.kd1[e], cur.kd1[e]};
                ya = ya + S2[e] * (f32x2){cur.r0[e], cur.r0[e]}; yb = yb + S2[4 + e] * (f32x2){cur.r1[e], cur.r1[e]}; }
            const f32x2 y2 = ya + yb;
            const float y0 = row_sum8(y2.x), y1 = row_sum8(y2.y);
            if (kg == 0) *(unsigned*)(Y + (size_t)m * YLD) = pg8::cvt_pk_bf16(y0, y1);
            cur = nx;
        }
        const int nchU = lng ? 64 : 16;
        if (lc == nchU - 1 && s < 16) { float* o = P.out + O_RWKV + (((size_t)((s * 2 + j) * 2 + dir) * 16 + h) * 64 + 2 * vg) * 64;
#pragma unroll
            for (int hh = 0; hh < 2; ++hh) { *(f32x4*)(o + 32 * hh + 4 * kg) = (f32x4){S2[hh * 4].x, S2[hh * 4 + 1].x, S2[hh * 4 + 2].x, S2[hh * 4 + 3].x};
                *(f32x4*)(o + 64 + 32 * hh + 4 * kg) = (f32x4){S2[hh * 4].y, S2[hh * 4 + 1].y, S2[hh * 4 + 2].y, S2[hh * 4 + 3].y}; } }
        if (cc + 1 < niter) { write_lds(L0 + ((cc + 1) & 1) * BUFSZ);
            if (lc == nchU - 1) { int s2, d2_, h2, lc2; unit_of(cc + 1, s2, d2_, h2, lc2); init_state(s2, d2_, h2); } }
        }
        __syncthreads();
    }
}

__device__ __forceinline__ void scan_unit(const Params& P, const Ctx& C, int l, int type, int q) {
    const int j = l >> 1; const bool ev = (l & 1) == 0;
    if (ev) { int s, idx; if (q < 128) { s = 16 + (q >> 5); idx = q & 31; } else { const int r = q - 128; s = r >> 5; idx = r & 31; }
        chunk_scan<0>(P, C, j, s, idx >> 4, idx & 15, 0); }
    else { int s, idx; if (q < 64) { s = 16 + (q >> 4); idx = q & 15; } else { const int r = q - 64; s = r >> 4; idx = r & 15; }
        const int dir = idx >> 3, h = (idx >> 1) & 3, vs = idx & 1; if (type == 0) chunk_scan<1>(P, C, j, s, dir, h, vs); else chunk_scan<2>(P, C, j, s, dir, h, vs); }
}
__device__ __forceinline__ int queue_next(const Params& P, const Ctx& C, int l) {
    volatile LAS unsigned* qw = (volatile LAS unsigned*)(C.lds + LDS_BYTES - 16);
    __syncthreads();
    if (C.tid == 0) qw[3] = __hip_atomic_fetch_add((unsigned*)(P.ws + WS_CTL) + 6144 + 64 * l, 1u, __ATOMIC_RELAXED, __HIP_MEMORY_SCOPE_AGENT);
    __syncthreads();
    return __builtin_amdgcn_readfirstlane((int)qw[3]);
}
__device__ __forceinline__ void phase_scan(const Params& P, const Ctx& C0, int l) {
    const int G = C0.G, bid = C0.bid; const bool ev = (l & 1) == 0;
    if (ev) {
        if (G == 256) rwkv_pair(P, fresh_ctx(C0.lds), l >> 1, bid < 128 ? bid : bid - 128, bid < 128);
        else {
#pragma unroll 1
            for (int x = bid; x < 256; x += G) rwkv_pair(P, fresh_ctx(C0.lds), l >> 1, x < 128 ? x : x - 128, x < 128);
        }
#pragma unroll 1
        for (;;) { const Ctx C = fresh_ctx(C0.lds); const int x = queue_next(P, C, l); if (x >= 640) break; scan_unit(P, C, l, 0, x); }
        return;
    }
#pragma unroll 1
    for (;;) { const Ctx C = fresh_ctx(C0.lds); const int x = queue_next(P, C, l); if (x >= 640) break;
        int type, q; if (x < 128) { type = x >> 6; q = x & 63; } else { const int r = x - 128; type = r & 1; q = 64 + (r >> 1); }
        scan_unit(P, C, l, type, q); }
}

__device__ __forceinline__ void ld16(const bf16_t* p, float* o) { unpack8(*(const u32x4*)p, o); unpack8(*(const u32x4*)(p + 8), o + 8); }
__device__ __forceinline__ void ld16f(const float* p, float* o) {
#pragma unroll
    for (int q = 0; q < 4; ++q) { const f32x4 v = *(const f32x4*)(p + 4 * q); o[4 * q] = v.x; o[4 * q + 1] = v.y; o[4 * q + 2] = v.z; o[4 * q + 3] = v.w; } }
__device__ __forceinline__ void st16(bf16_t* p, const float* o) { *(u32x4*)p = pack8(o); *(u32x4*)(p + 8) = pack8(o + 8); }
__device__ __forceinline__ void phase_post(const Params& P, const Ctx& C, int l) {
    const int j = l >> 1; const bool ev = (l & 1) == 0;
    const bf16_t* PROJ = (const bf16_t*)(P.ws + WS_PROJ); const bf16_t* PREP = (const bf16_t*)(P.ws + WS_PREP);
    const bf16_t* Y0 = (const bf16_t*)(P.ws + WS_MP); const bf16_t* Y1 = Y0 + (size_t)MTOK * YLD; bf16_t* MIX = (bf16_t*)(P.ws + WS_MIX);
    const int gw = C.bid * 8 + C.wave, NGW = C.G * 8, lane = C.lane, c0 = lane * 16;
    for (int m = gw; m < MTOK; m += NGW) {
        float ya[16], yb[16], t0[16], t1[16], o[16];
        if (ev) {
            const bf16_t* pp = PREP + (size_t)m * PREP_LD;
            ld16(Y0 + (size_t)m * YLD + c0, ya); ld16(Y1 + (size_t)m * YLD + c0, yb); ld16(pp + c0, t0); ld16(pp + 2048 + c0, t1);
            const float dsk = P.in[I_SSDD][j * 16 + (lane >> 2)]; float ss = 0.f;
#pragma unroll
            for (int e = 0; e < 16; ++e) { o[e] = (ya[e] + yb[e] + t0[e] * dsk) * t1[e]; ss += o[e] * o[e]; }
            const float rs = rsqrtf(wave_sum(ss) * (1.f / 1024.f) + 1e-6f);
            ld16f(P.in[I_SSDN] + j * 1024 + c0, t0);
#pragma unroll
            for (int e = 0; e < 16; ++e) o[e] = o[e] * rs * t0[e];
            st16(MIX + (size_t)m * 2048 + c0, o);
            ld16(Y0 + (size_t)m * YLD + 1024 + c0, ya); ld16(Y1 + (size_t)m * YLD + 1024 + c0, yb);
            float mu = 0.f;
#pragma unroll
            for (int e = 0; e < 16; ++e) { ya[e] += yb[e]; mu += ya[e]; }
            mu += __shfl_xor(mu, 1); mu += __shfl_xor(mu, 2); mu *= (1.f / 64.f);
            float var = 0.f;
#pragma unroll
            for (int e = 0; e < 16; ++e) { ya[e] -= mu; var += ya[e] * ya[e]; }
            var += __shfl_xor(var, 1); var += __shfl_xor(var, 2); var *= (1.f / 64.f);
            const float rstd = rsqrtf(var + 64e-5f);
            ld16f(P.in[I_LNW] + j * 1024 + c0, t0); ld16f(P.in[I_LNB] + j * 1024 + c0, t1);
#pragma unroll
            for (int e = 0; e < 16; ++e) o[e] = ya[e] * rstd * t0[e] + t1[e];
            ld16(pp + 3072 + c0, ya); ld16(pp + 4096 + c0, yb); ld16f(P.in[I_RK] + j * 1024 + c0, t0);
            float bs = 0.f;
#pragma unroll
            for (int e = 0; e < 16; ++e) bs += ya[e] * yb[e] * t0[e];
            bs += __shfl_xor(bs, 1); bs += __shfl_xor(bs, 2);
            ld16(pp + 5120 + c0, ya); ld16(PROJ + (size_t)m * LOUT_LD + 4096 + c0, yb);
#pragma unroll
            for (int e = 0; e < 16; ++e) o[e] = (o[e] + bs * ya[e]) * yb[e];
            st16(MIX + (size_t)m * 2048 + 1024 + c0, o);
        } else {
            const bf16_t* pr = PROJ + (size_t)m * PROJ_LD_CD;
#pragma unroll
            for (int g = 0; g < 2; ++g) {
                ld16(Y0 + (size_t)m * YLD + g * 1024 + c0, ya); ld16(Y1 + (size_t)m * YLD + g * 1024 + c0, yb);
                float ss = 0.f;
#pragma unroll
                for (int e = 0; e < 16; ++e) { ya[e] += yb[e]; ss += ya[e] * ya[e]; }
                ss += __shfl_xor(ss, 1); ss += __shfl_xor(ss, 2); ss += __shfl_xor(ss, 4); ss += __shfl_xor(ss, 8);
                const float rs = rsqrtf(ss * (1.f / 256.f) + 1e-6f);
                ld16f((g == 0 ? P.in[I_GLAN] : P.in[I_MLN]) + j * 1024 + c0, t0);
                ld16(pr + (g == 0 ? 2048 : IN_GLA + 2048) + c0, t1);
#pragma unroll
                for (int e = 0; e < 16; ++e) o[e] = ya[e] * rs * t0[e] * (g == 0 ? siluf_(t1[e]) : sigmoidf_(t1[e]));
                st16(MIX + (size_t)m * 2048 + g * 1024 + c0, o);
            }
        }
    }
}

__global__ void __launch_bounds__(512, 2) hybrid_fwd(Params P) {
    extern __shared__ __attribute__((aligned(16))) unsigned char lds_raw[];
    cg::grid_group grid = cg::this_grid();
    Ctx C; C.lds = (LAS unsigned char*)lds_raw; C.tid = threadIdx.x; C.lane = C.tid & 63; C.wave = __builtin_amdgcn_readfirstlane(C.tid >> 6); C.G = gridDim.x; C.bid = blockIdx.x;
    const float* MOD = (const float*)(P.ws + WS_MOD);
    const bf16_t* H = (const bf16_t*)(P.ws + WS_H);
    if (C.tid < 4) ((volatile LAS unsigned*)(C.lds + LDS_BYTES - 16))[C.tid] = 0u;
    __syncthreads();
    const XcdBarrier xb = xcd_barrier_post((unsigned*)(P.ws + WS_CTL), (volatile LAS unsigned*)(C.lds + LDS_BYTES - 16));
    REP(1) if (PH & 1) phase_mod(P, fresh_ctx(C.lds));
    REP(2) if (PH & 2) phase_convert(P, fresh_ctx(C.lds), 0);
    grid.sync();
    if (PH & 4) phase_rows(P, fresh_ctx(C.lds), 0, nullptr, nullptr, true, P.in[I_NORMG] + 0, MOD + 0);
    GSYNC();
#pragma unroll 1
    for (int l = 0; l < 4; ++l) {
        const bool ev = (l & 1) == 0; const float* modl = MOD + (size_t)l * 5 * 6144; const float* ng = P.in[I_NORMG] + l * 4 * 1024;
        REP(8) if (PH & 8) { pg8::Gemm g{H, (const bf16_t*)(P.ws + WS_WIN), 1024, 1024, 1024}; pg8::Sched<0> S; S.init(MTOK, ev ? N_AB_P : N_CD_P, 1, 1024, C.G, C.bid);
          pg8::EpiBf16<0> E{(bf16_t*)(P.ws + WS_PROJ), ev ? PROJ_LD_AB : PROJ_LD_CD, 0}; pg8::gemm_phase(C.lds, g, S, E); }
        GSYNC();
        REP(16) if (PH & 16) { if (ev) phase_prep_even(P, fresh_ctx(C.lds), l >> 1); else phase_prep_odd(P, fresh_ctx(C.lds), l >> 1); }
        GSYNC();
        if (ev && (PH & 32)) {
            REP(32) {
            pg8::Gemm g{(const bf16_t*)(P.ws + WS_LORAA), (const bf16_t*)(P.ws + WS_WLORA), LORA_K, 128, 128}; pg8::Sched<1> S; S.init(MTOK, LOUT_LD, 1, 128, C.G, C.bid);
            pg8::EpiBf16<0> E{(bf16_t*)(P.ws + WS_PROJ), LOUT_LD, 0}; pg8::gemm_phase(C.lds, g, S, E); }
            GSYNC();
        }
        for (int rep_ = 0; rep_ < (((DUP & 64) && ev) || ((DUP & 0x4000) && !ev) ? 2 : 1); ++rep_) if (PH & 64) phase_scan(P, fresh_ctx(C.lds), l);
        GSYNC();
        REP(128) if (PH & 128) phase_post(P, fresh_ctx(C.lds), l);
        GSYNC();
        REP(256) if (PH & 256) { pg8::Gemm g{(const bf16_t*)(P.ws + WS_MIX), (const bf16_t*)(P.ws + WS_WOUT), 2048, 2048, 1024}; pg8::Sched<0> S; S.init(MTOK, 1024, 2, 1024, C.G, C.bid);
          pg8::EpiBf16<0> E{(bf16_t*)(P.ws + WS_MP), 1024, (size_t)MTOK * 1024}; pg8::gemm_phase(C.lds, g, S, E); }
        GSYNC();
        if (DUP & 512) phase_rows(P, fresh_ctx(C.lds), 1, ng + 1024, modl + 2048, true, ng + 2048, modl + 3072, true);
        if (PH & 512) phase_rows(P, fresh_ctx(C.lds), 1, ng + 1024, modl + 2048, true, ng + 2048, modl + 3072);
        GSYNC();
        REP(1024) if (PH & 1024) { pg8::Gemm g{H, (const bf16_t*)(P.ws + WS_WUP), 1024, 1024, 1024}; pg8::Sched<0> S; S.init(MTOK, 4096, 1, 1024, C.G, C.bid);
          pg8::EpiBf16<2> E{(bf16_t*)(P.ws + WS_PROJ), 4096, 0}; pg8::gemm_phase(C.lds, g, S, E); }
        GSYNC();
        REP(2048) if (PH & 2048) { pg8::Gemm g{(const bf16_t*)(P.ws + WS_PROJ), (const bf16_t*)(P.ws + WS_WDN), 4096, 4096, 2048}; pg8::Sched<0> S; S.init(MTOK, 1024, 2, 2048, C.G, C.bid);
          pg8::EpiBf16<0> E{(bf16_t*)(P.ws + WS_MP), 1024, (size_t)MTOK * 1024}; pg8::gemm_phase(C.lds, g, S, E); }
        GSYNC();
        if (DUP & 4096) phase_rows(P, fresh_ctx(C.lds), 1, ng + 3072, modl + 5120, true, ng + 2048, modl + 3072, true);
        if (PH & 4096) { if (l < 3) { phase_rows(P, fresh_ctx(C.lds), 1, ng + 3072, modl + 5120, true, ng + 4096, modl + 5 * 6144); phase_convert(P, fresh_ctx(C.lds), l + 1); }
        else phase_rows(P, fresh_ctx(C.lds), 1, ng + 3072, modl + 5120, false, nullptr, nullptr); }
        if (l < 3) GSYNC();
    }
}

extern "C" void kernel_launch(void* const* d_in, const int* in_sizes, int n_in, void* d_out, int out_size, void* d_ws, size_t ws_size, hipStream_t stream) {
    static int grid = 0;
    if (grid == 0) {
        if (n_in != 44 || ws_size < WS_END) { fprintf(stderr, "kernel_launch: unexpected n_in %d / ws %zu\n", n_in, ws_size); grid = -1; return; }
        int dev = 0, cus = 0, per_cu = 0;
        hipGetDevice(&dev); hipDeviceGetAttribute(&cus, hipDeviceAttributeMultiprocessorCount, dev);
        if (hipFuncSetAttribute((const void*)hybrid_fwd, hipFuncAttributeMaxDynamicSharedMemorySize, LDS_BYTES) != hipSuccess) { fprintf(stderr, "hipFuncSetAttribute failed\n"); grid = -1; return; }
        hipOccupancyMaxActiveBlocksPerMultiprocessor(&per_cu, (const void*)hybrid_fwd, 512, LDS_BYTES);
        (void)hipGetLastError();
        if (per_cu < 1) per_cu = 1;
        grid = cus * 1;
    }
    if (grid < 0) return;
    if (hipMemsetAsync((char*)d_ws + WS_CTL, 0, CTL_BYTES, stream) != hipSuccess) { fprintf(stderr, "memset failed\n"); return; }
    Params p{};
    for (int i = 0; i < 44; ++i) p.in[i] = (const float*)d_in[i];
    p.out = (float*)d_out; p.ws = (unsigned char*)d_ws;
    void* args[] = {&p};
    hipError_t e = hipLaunchCooperativeKernel((const void*)hybrid_fwd, dim3(grid), dim3(512), args, LDS_BYTES, stream);
    if (e != hipSuccess) fprintf(stderr, "cooperative launch failed: %s (grid %d)\n", hipGetErrorString(e), grid);
}
```

```cpp
#include <hip/hip_runtime.h>
#include <hip/hip_cooperative_groups.h>
#include <cstdio>
#include <cstdint>
namespace cg = cooperative_groups;

#define LAS __attribute__((address_space(3)))
typedef unsigned short bf16_t;
typedef short bf16x8 __attribute__((ext_vector_type(8)));
typedef float f32x4 __attribute__((ext_vector_type(4)));
typedef float f32x2 __attribute__((ext_vector_type(2)));
typedef unsigned u32x4 __attribute__((ext_vector_type(4)));
typedef unsigned u32x2 __attribute__((ext_vector_type(2)));

constexpr int MTOK = 8192, DM = 1024, DFF = 4096;
constexpr int N_AB = 6560, N_AB_P = 6656, N_CD = 6192, N_CD_P = 6400;
constexpr int PROJ_LD_AB = N_AB_P, PROJ_LD_CD = N_CD_P;
constexpr int PREP_LD = 7168, LOUT_LD = 5120, LORA_K = 384, YLD = 2048;
constexpr int IN_SSD = 3104, IN_GLA = 3104;
constexpr size_t MiB = 1u << 20;
constexpr size_t WS_MOD = 0, WS_CTL = 512 * 1024, CTL_BYTES = 32768, WS_DT = 1 * MiB, WS_DA = 3 * MiB, WS_WIN = 5 * MiB, WS_WOUT = 19 * MiB, WS_WUP = 23 * MiB, WS_WDN = 31 * MiB,
                 WS_WLORA = 39 * MiB, WS_H = 41 * MiB, WS_PROJ = 57 * MiB, WS_PREP = 161 * MiB, WS_MIX = 273 * MiB, WS_MP = 305 * MiB,
                 WS_LORAA = 369 * MiB, WS_END = 375 * MiB;
constexpr size_t O_X = 0, O_SSD = 8388608, O_RWKV = 16777216, O_GLA = 20971520, O_MC = 29360128, O_MN = 37748736, O_MM = 37781504;

struct Params { const float* in[44]; float* out; unsigned char* ws; };
enum { I_XP = 0, I_XS, I_SSSD, I_SRWKV, I_SGLA, I_SMC, I_SMN, I_SMM, I_C, I_CCTX, I_WMOD, I_BMOD, I_NORMG, I_WUP, I_WDN, I_WINAB, I_SCONVW, I_SCONVB,
       I_DTB, I_ALOG, I_SSDD, I_SSDN, I_MU, I_W0, I_W2, I_A0, I_A2, I_G2, I_KK, I_KA, I_RK, I_LNW, I_LNB, I_WOUTAB, I_WINCD, I_GGW, I_GGB, I_GLAN,
       I_MCONVW, I_MCONVB, I_MIB, I_MFB, I_MLN, I_WOUTCD };

__device__ __forceinline__ float bf2f(unsigned b) { return __uint_as_float(b << 16); }
__device__ __forceinline__ unsigned f2bf(float f) { unsigned u = __float_as_uint(f); return (u + 0x7fffu + ((u >> 16) & 1u)) >> 16; }
typedef __bf16 bf16x2_hw __attribute__((ext_vector_type(2)));
__device__ __forceinline__ unsigned pk2(float lo, float hi) { const f32x2 v = {lo, hi}; const bf16x2_hw b = __builtin_convertvector(v, bf16x2_hw); return __builtin_bit_cast(unsigned, b); }
__device__ __forceinline__ float lo16(unsigned w) { return __uint_as_float(w << 16); }
__device__ __forceinline__ float hi16(unsigned w) { return __uint_as_float(w & 0xffff0000u); }
__device__ __forceinline__ void unpack8(u32x4 w, float* o) { o[0] = lo16(w.x); o[1] = hi16(w.x); o[2] = lo16(w.y); o[3] = hi16(w.y); o[4] = lo16(w.z); o[5] = hi16(w.z); o[6] = lo16(w.w); o[7] = hi16(w.w); }
__device__ __forceinline__ f32x4 unpack4(u32x2 w) { return (f32x4){lo16(w.x), hi16(w.x), lo16(w.y), hi16(w.y)}; }
__device__ __forceinline__ u32x4 pack8(const float* o) { u32x4 w; w.x = pk2(o[0], o[1]); w.y = pk2(o[2], o[3]); w.z = pk2(o[4], o[5]); w.w = pk2(o[6], o[7]); return w; }
__device__ __forceinline__ float sigmoidf_(float x) { return 1.f / (1.f + __expf(-x)); }
__device__ __forceinline__ float siluf_(float x) { return x / (1.f + __expf(-x)); }
__device__ __forceinline__ float softplusf_(float x) { return fmaxf(x, 0.f) + __logf(1.f + __expf(-fabsf(x))); }
__device__ __forceinline__ float logsigmoidf_(float x) { return fminf(x, 0.f) - __logf(1.f + __expf(-fabsf(x))); }
__device__ __forceinline__ float tanhf_(float x) { const float e = __expf(-2.f * fabsf(x)); const float r = (1.f - e) / (1.f + e); return x < 0.f ? -r : r; }
__device__ __forceinline__ float wave_sum(float v) {
#pragma unroll
    for (int o = 1; o < 64; o <<= 1) v += __shfl_xor(v, o);
    return v;
}
__device__ __forceinline__ float quad_sum(float x) {
    x += __int_as_float(__builtin_amdgcn_update_dpp(0, __float_as_int(x), 0xB1, 0xF, 0xF, true));
    x += __int_as_float(__builtin_amdgcn_update_dpp(0, __float_as_int(x), 0x4E, 0xF, 0xF, true));
    return x;
}

#define DPP_ADD(x, ctrl) ((x) + __int_as_float(__builtin_amdgcn_update_dpp(0, __float_as_int(x), (ctrl), 0xF, 0xF, true)))
__device__ __forceinline__ float row_sum8(float x) { x = DPP_ADD(x, 0xB1); x = DPP_ADD(x, 0x4E); x = DPP_ADD(x, 0x141); return x; }
__device__ __forceinline__ float row_sum16(float x) { x = row_sum8(x); x = DPP_ADD(x, 0x140); return x; }
namespace pg8 {
constexpr int BM = 256, BK = 64, HALF = 128, HTB = HALF * BK * 2, STAGE_BYTES = 8 * HTB, NXCD = 8, WGM = 8;
__host__ __device__ __forceinline__ int lds_byte(int r, int c) { const int st = (r >> 4) * 2 + (c >> 5), rr = r & 15, cc = c & 31, ob = rr * 64 + cc * 2; return st * 1024 + (ob ^ (((ob >> 9) & 1) << 5)); }
__host__ __device__ __forceinline__ void stage_rc(int b, int& R, int& C) { const int st = b / 1024, sb = b % 1024, swz = sb ^ (((sb >> 9) & 1) << 5); R = (st >> 1) * 16 + swz / 64; C = (st & 1) * 32 + (swz % 64) / 2; }
__host__ __device__ __forceinline__ int perm32(int rho) { const int n = rho >> 4, i = rho & 15; return 8 * (i >> 2) + 4 * n + (i & 3); }

struct Unit { int pm, pn, ks; };
struct Gemm { const bf16_t* A; const bf16_t* Bt; int lda, ldb, K; };
template <int mode> struct Sched {
    int nM, nN, nNv, nwg, G, c, K;
    __device__ void init(int M, int N, int nK, int K_, int G_, int c_) { nM = M / BM; nN = N / BM; nNv = nN * nK; nwg = nM * nNv; G = G_; c = c_; K = K_; }
    __device__ bool next(int i, Unit& u) const {
        const long L = (long)i * G + c; if (L >= nwg) return false;
        int wgid = (int)L; { const int q = nwg / NXCD, r = nwg % NXCD, xcd = wgid % NXCD, off = wgid / NXCD; wgid = (xcd < r ? xcd * (q + 1) : r * (q + 1) + (xcd - r) * q) + off; }
        const int nig = WGM * nNv, gid = wgid / nig, fm = gid * WGM, gsz = (nM - fm) < WGM ? (nM - fm) : WGM;
        u.pm = fm + ((wgid % nig) % gsz); const int pnv = (wgid % nig) / gsz; u.pn = pnv % nN; u.ks = pnv / nN; return true;
    }
    __device__ __forceinline__ size_t aoff(const Unit& u) const { if (mode == 1) { const int g = u.pn >> 2; return (size_t)(g < 2 ? 0 : (g < 4 ? 128 : 256)) * 2; } return (size_t)u.ks * K * 2; }
    __device__ __forceinline__ size_t boff(const Unit& u) const { return mode == 1 ? 0 : (size_t)u.ks * K * 2; }
};

__device__ __forceinline__ unsigned cvt_pk_bf16(float lo, float hi) { unsigned r; asm volatile("v_cvt_pk_bf16_f32 %0, %1, %2" : "=v"(r) : "v"(lo), "v"(hi)); return r; }

template <int ACT> struct EpiBf16 {
    static constexpr bool PERM = true;
    bf16_t* O; int ldc; size_t pstride;
    __device__ __forceinline__ void operator()(const f32x4 (&acc)[2][2][4][2], const Unit& u, int wr, int wc, int fr, int fq) const {
        const int row0 = u.pm * BM + wr * 64 + fr; const int col0 = u.pn * BM + wc * 32 + 8 * fq; bf16_t* Ob = O + (size_t)u.ks * pstride;
#pragma unroll
        for (int ai = 0; ai < 2; ++ai)
#pragma unroll
            for (int m = 0; m < 4; ++m) { bf16_t* rowp = Ob + (size_t)(row0 + ai * HALF + m * 16) * ldc + col0;
#pragma unroll
                for (int bj = 0; bj < 2; ++bj) { f32x4 v0 = acc[ai][bj][m][0], v1 = acc[ai][bj][m][1];
                    if (ACT == 2) {
#pragma unroll
                        for (int e = 0; e < 4; ++e) { const float a = fmaxf(v0[e], 0.f), b = fmaxf(v1[e], 0.f); v0[e] = a * a; v1[e] = b * b; } }
                    u32x4 w; w.x = cvt_pk_bf16(v0[0], v0[1]); w.y = cvt_pk_bf16(v0[2], v0[3]); w.z = cvt_pk_bf16(v1[0], v1[1]); w.w = cvt_pk_bf16(v1[2], v1[3]);
                    *(u32x4*)(rowp + bj * HALF) = w; } }
    }
};
struct EpiF32 {
    static constexpr bool PERM = false;
    float* O; int ldc; size_t pstride;
    __device__ __forceinline__ void operator()(const f32x4 (&acc)[2][2][4][2], const Unit& u, int wr, int wc, int fr, int fq) const {
        float* base = O + (size_t)u.ks * pstride; const int col0 = u.pn * BM + wc * 32 + 4 * fq;
#pragma unroll
        for (int ai = 0; ai < 2; ++ai)
#pragma unroll
            for (int m = 0; m < 4; ++m) { float* rowp = base + (size_t)(u.pm * BM + ai * HALF + wr * 64 + m * 16 + fr) * ldc + col0;
#pragma unroll
                for (int bj = 0; bj < 2; ++bj)
#pragma unroll
                    for (int n = 0; n < 2; ++n) *(f32x4*)(rowp + bj * HALF + n * 16) = acc[ai][bj][m][n]; }
    }
};

template <class Epi, class SchedT>
__device__ __forceinline__ void gemm_phase(LAS unsigned char* lds, const Gemm g, const SchedT& S, const Epi& E) {
    int tid_ = threadIdx.x; asm volatile("" : "+v"(tid_));
    const int tid = tid_, wid = __builtin_amdgcn_readfirstlane(tid >> 6), lane = tid & 63, wr = wid >> 2, wc = wid & 3, fr = lane & 15, fq = lane >> 4;
    int K_ = g.K; asm volatile("" : "+s"(K_));
    const int K = K_, nt = K / BK;
    unsigned voffA[2], voffB[2];
#pragma unroll
    for (int i = 0; i < 2; ++i) { int R, C; stage_rc(tid * 16 + i * 8192, R, C); const int Rb = Epi::PERM ? ((R & ~31) + perm32(R & 31)) : R;
        voffA[i] = (unsigned)(R * g.lda + C) * 2u; voffB[i] = (unsigned)(Rb * g.ldb + C) * 2u; }
    const size_t kstep = (size_t)(BK * 2);
    const size_t hstepA = (size_t)HALF * g.lda * 2, hstepB = (size_t)HALF * g.ldb * 2;
    const size_t tstepA = 2 * hstepA, tstepB = 2 * hstepB;
    const unsigned ldsw = (unsigned)wid * 1024u;
    const int aoff = lds_byte(wr * 64 + fr, fq * 8), boff = lds_byte(wc * 32 + fr, fq * 8);
#define PG8_SA(b, h) (((b) * 2 + (h)) * HTB)
#define PG8_SB(b, h) ((4 + (b) * 2 + (h)) * HTB)
#define PG8_STAGE(bufoff, gbase, voff) do { _Pragma("unroll") for (int _i = 0; _i < 2; ++_i) \
        __builtin_amdgcn_global_load_lds((const unsigned*)((const char*)(gbase) + (voff)[_i]), (LAS unsigned*)(lds + (bufoff) + ldsw + _i * 8192), 16, 0, 0); } while (0)
#define PG8_LDA(dst, b, h) do { _Pragma("unroll") for (int m = 0; m < 4; ++m) _Pragma("unroll") for (int k = 0; k < 2; ++k) dst[m][k] = *(const LAS bf16x8*)(lds + PG8_SA(b, h) + aoff + m * 2048 + k * 1024); } while (0)
#define PG8_LDB(dst, b, h) do { _Pragma("unroll") for (int n = 0; n < 2; ++n) _Pragma("unroll") for (int k = 0; k < 2; ++k) dst[n][k] = *(const LAS bf16x8*)(lds + PG8_SB(b, h) + boff + n * 2048 + k * 1024); } while (0)
#define PG8_MMA(ai, bj, At, Bt) do { __builtin_amdgcn_s_setprio(1); _Pragma("unroll") for (int m = 0; m < 4; ++m) _Pragma("unroll") for (int n = 0; n < 2; ++n) _Pragma("unroll") for (int k = 0; k < 2; ++k) \
        acc[ai][bj][m][n] = __builtin_amdgcn_mfma_f32_16x16x32_bf16(Bt[n][k], At[m][k], acc[ai][bj][m][n], 0, 0, 0); __builtin_amdgcn_s_setprio(0); } while (0)
#define PG8_WAIT_V(n) asm volatile("s_waitcnt vmcnt(" #n ")" ::: "memory")
#define PG8_WAIT_L(n) asm volatile("s_waitcnt lgkmcnt(" #n ")" ::: "memory")
#define PG8_BAR __builtin_amdgcn_s_barrier()
#define PG8_SCHED __builtin_amdgcn_sched_barrier(0)
    Unit cur, nxt; int ui = 0;
    if (!S.next(0, cur)) return;
    f32x4 acc[2][2][4][2];
#pragma unroll
    for (int a = 0; a < 2; ++a)
#pragma unroll
        for (int b = 0; b < 2; ++b)
#pragma unroll
            for (int m = 0; m < 4; ++m)
#pragma unroll
                for (int n = 0; n < 2; ++n) acc[a][b][m][n] = (f32x4){0.f, 0.f, 0.f, 0.f};
    bf16x8 At[4][2], B0[2][2], B1[2][2];
    const char* cA = (const char*)g.A + (size_t)cur.pm * tstepA + S.aoff(cur); const char* cB = (const char*)g.Bt + (size_t)cur.pn * tstepB + S.boff(cur);
    PG8_STAGE(PG8_SB(0, 0), cB, voffB); PG8_STAGE(PG8_SB(0, 1), cB + hstepB, voffB); PG8_STAGE(PG8_SA(0, 0), cA, voffA); PG8_STAGE(PG8_SA(0, 1), cA + hstepA, voffA);
    if (wr == 1) PG8_BAR;
    PG8_WAIT_V(2); PG8_BAR;
    PG8_STAGE(PG8_SB(1, 0), cB + kstep, voffB); PG8_STAGE(PG8_SA(1, 0), cA + kstep, voffA); PG8_STAGE(PG8_SB(1, 1), cB + hstepB + kstep, voffB);
    PG8_WAIT_V(6); PG8_BAR;
    for (;;) {
        const bool has_next = S.next(ui + 1, nxt);
        const char* nA = has_next ? (const char*)g.A + (size_t)nxt.pm * tstepA + S.aoff(nxt) : cA; const char* nB = has_next ? (const char*)g.Bt + (size_t)nxt.pn * tstepB + S.boff(nxt) : cB;
        for (int t = 0; t < nt; t += 2) {
            const bool last = (t == nt - 2);
            const char* a1 = cA + (size_t)(t + 1) * kstep;
            const char* a2 = last ? nA : cA + (size_t)(t + 2) * kstep; const char* b2 = last ? nB : cB + (size_t)(t + 2) * kstep;
            const char* a3 = a2 + kstep; const char* b3 = b2 + kstep;
            PG8_LDB(B0, 0, 0); PG8_LDB(B1, 0, 1); PG8_SCHED; PG8_LDA(At, 0, 0); PG8_STAGE(PG8_SA(1, 1), a1 + hstepA, voffA);
            PG8_WAIT_V(8); PG8_WAIT_L(0); PG8_BAR; PG8_MMA(0, 0, At, B0); PG8_MMA(0, 1, At, B1); PG8_BAR; PG8_SCHED;
            PG8_LDA(At, 0, 1); PG8_STAGE(PG8_SB(0, 0), b2, voffB); PG8_STAGE(PG8_SB(0, 1), b2 + hstepB, voffB); PG8_STAGE(PG8_SA(0, 0), a2, voffA);
            PG8_WAIT_V(8); PG8_WAIT_L(0); PG8_BAR; PG8_MMA(1, 0, At, B0); PG8_MMA(1, 1, At, B1); PG8_BAR; PG8_SCHED;
            PG8_LDB(B0, 1, 0); PG8_LDB(B1, 1, 1); PG8_SCHED; PG8_LDA(At, 1, 0); PG8_STAGE(PG8_SA(0, 1), a2 + hstepA, voffA);
            PG8_WAIT_V(8); PG8_WAIT_L(0); PG8_BAR; PG8_MMA(0, 0, At, B0); PG8_MMA(0, 1, At, B1); PG8_BAR; PG8_SCHED;
            PG8_LDA(At, 1, 1); PG8_STAGE(PG8_SB(1, 0), b3, voffB); PG8_STAGE(PG8_SB(1, 1), b3 + hstepB, voffB); PG8_STAGE(PG8_SA(1, 0), a3, voffA);
            PG8_WAIT_V(8); PG8_WAIT_L(0); PG8_BAR; PG8_MMA(1, 0, At, B0); PG8_MMA(1, 1, At, B1); PG8_BAR; PG8_SCHED;
        }
        if (wr == 0) PG8_BAR;
        E(acc, cur, wr, wc, fr, fq);
        if (!has_next) break;
#pragma unroll
        for (int a = 0; a < 2; ++a)
#pragma unroll
            for (int b = 0; b < 2; ++b)
#pragma unroll
                for (int m = 0; m < 4; ++m)
#pragma unroll
                    for (int n = 0; n < 2; ++n) acc[a][b][m][n] = (f32x4){0.f, 0.f, 0.f, 0.f};
        cur = nxt; cA = nA; cB = nB; ++ui;
        if (wr == 1) PG8_BAR;
    }
    PG8_WAIT_V(0);
    PG8_BAR;
#undef PG8_SA
#undef PG8_SB
#undef PG8_STAGE
#undef PG8_LDA
#undef PG8_LDB
#undef PG8_MMA
#undef PG8_WAIT_V
#undef PG8_WAIT_L
#undef PG8_BAR
#undef PG8_SCHED
}
}

#define XB_TMO      128
#define XB_XCNT(j)  (256  + 64 * (j))
#define XB_XSUB(j)  (1280 + 64 * (j))
#define XB_XGEN(j)  (2304 + 64 * (j))
#define XB_TOP      3328
#define XB_TOPGEN   3392
#define XCD_BAR_WORDS 3456
#define XB_SPIN_CAP (1u << 18)
__device__ __forceinline__ unsigned xb_ld(unsigned* p)              { return __hip_atomic_load(p, __ATOMIC_RELAXED, __HIP_MEMORY_SCOPE_AGENT); }
__device__ __forceinline__ unsigned xb_add(unsigned* p, unsigned v) { return __hip_atomic_fetch_add(p, v, __ATOMIC_RELAXED, __HIP_MEMORY_SCOPE_AGENT); }
__device__ __forceinline__ unsigned xb_xcc_id() { return (unsigned)__builtin_amdgcn_s_getreg((3 << 11) | 20) & 0xFu; }
#define XB_SPIN(cond, bar) do { unsigned _sp = 0; while (cond) { __builtin_amdgcn_s_sleep(1); \
    if ((++_sp & 255u) == 0u) { if (xb_ld(&(bar)[XB_TMO])) break; if (_sp > XB_SPIN_CAP) { atomicAdd(&(bar)[XB_TMO], 1u); break; } } } } while (0)
struct XcdBarrier { unsigned* bar; unsigned x; volatile LAS unsigned* st; };
__device__ __forceinline__ XcdBarrier xcd_barrier_post(unsigned* bar, volatile LAS unsigned* st) {
    XcdBarrier b; b.bar = bar; b.x = xb_xcc_id(); b.st = st;
    if (threadIdx.x == 0) (void)xb_add(&bar[XB_XCNT(b.x)], 1u);
    return b;
}
__device__ __forceinline__ void xcd_barrier_complete(unsigned* bar, unsigned x, unsigned& nloc, unsigned& nx) {
    const unsigned G = gridDim.x * gridDim.y * gridDim.z;
    unsigned sum, cnt, mine, sp = 0u;
    for (;;) {
        sum = 0u; cnt = 0u; mine = 0u;
#pragma unroll
        for (unsigned j = 0; j < 16; ++j) { const unsigned c = xb_ld(&bar[XB_XCNT(j)]); sum += c; cnt += (c > 0u) ? 1u : 0u; mine = (j == x) ? c : mine; }
        if (sum == G) break;
        __builtin_amdgcn_s_sleep(1);
        if ((++sp & 255u) == 0u) { if (xb_ld(&bar[XB_TMO])) break; if (sp > XB_SPIN_CAP) { atomicAdd(&bar[XB_TMO], 1u); break; } }
    }
    nloc = mine > 0u ? mine : 1u; nx = cnt > 0u ? cnt : 1u;
}
__device__ __forceinline__ void xcd_barrier(const XcdBarrier& b) {
    asm volatile("s_waitcnt vmcnt(0)" ::: "memory");
    __syncthreads();
    if (threadIdx.x == 0) {
        unsigned* bar = b.bar;
        __builtin_amdgcn_s_waitcnt(0);
        unsigned nloc = b.st[0], nx = b.st[1];
        if (nloc == 0u) { xcd_barrier_complete(bar, b.x, nloc, nx); b.st[0] = nloc; b.st[1] = nx; }
        const unsigned old = xb_add(&bar[XB_XSUB(b.x)], 1u);
        const unsigned gen = old / nloc;
        if (old + 1u == (gen + 1u) * nloc) {
            __builtin_amdgcn_fence(__ATOMIC_RELEASE, "agent");
            asm volatile("s_waitcnt vmcnt(0)" ::: "memory");
            const unsigned og = xb_add(&bar[XB_TOP], 1u);
            const unsigned tg = og / nx;
            if (og + 1u == (tg + 1u) * nx) xb_add(&bar[XB_TOPGEN], 1u);
            else XB_SPIN(xb_ld(&bar[XB_TOPGEN]) == tg, bar);
            __builtin_amdgcn_fence(__ATOMIC_ACQUIRE, "agent");
            xb_add(&bar[XB_XGEN(b.x)], 1u);
            asm volatile("s_waitcnt vmcnt(0)" ::: "memory");
        } else {
            XB_SPIN(xb_ld(&bar[XB_XGEN(b.x)]) == gen, bar);
            __builtin_amdgcn_fence(__ATOMIC_ACQUIRE, "agent");
            asm volatile("s_waitcnt vmcnt(0)" ::: "memory");
        }
    }
    __syncthreads();
}

constexpr int LDS_BYTES = 147456;
#ifndef PH
#define PH 0xFFFF
#endif
#ifndef DUP
#define DUP 0
#endif
#define GSYNC() do { xcd_barrier(xb); if (DUP & 0x8000) { xcd_barrier(xb); xcd_barrier(xb); } } while (0)
#define REP(bit) for (int rep_ = 0; rep_ < ((DUP & (bit)) ? 2 : 1); ++rep_)
struct Ctx { LAS unsigned char* lds; int tid, lane, wave, G, bid; };
__device__ __forceinline__ Ctx fresh_ctx(LAS unsigned char* lds) { Ctx C; int t = threadIdx.x; asm volatile("" : "+v"(t)); C.lds = lds; C.tid = t; C.lane = t & 63; C.wave = __builtin_amdgcn_readfirstlane(t >> 6); C.G = gridDim.x; C.bid = blockIdx.x; return C; }

__device__ __forceinline__ void phase_mod(const Params& P, const Ctx& C) {
    LAS float* sc = (LAS float*)C.lds; LAS float* red = sc + 5120;
    for (int i = C.tid; i < 5120; i += 512) { const int r = i >> 10, k = i & 1023; const float x = r == 0 ? P.in[I_CCTX][k] : P.in[I_C][(r - 1) * 1024 + k]; sc[i] = siluf_(x); }
    __syncthreads();
    float* MOD = (float*)(P.ws + WS_MOD);
    const int kg = C.tid >> 5, c = C.tid & 31;
    for (int tile = C.bid; tile < 768; tile += C.G) {
        const int l = tile / 192, col = (tile % 192) * 32 + c;
        const float* w = P.in[I_WMOD] + (size_t)l * 1024 * 6144 + col;
        float a0 = 0.f, a1 = 0.f, a2 = 0.f, a3 = 0.f, a4 = 0.f;
#pragma unroll 16
        for (int k = kg * 64; k < kg * 64 + 64; ++k) { const float wv = w[(size_t)k * 6144]; a0 += sc[k] * wv; a1 += sc[1024 + k] * wv; a2 += sc[2048 + k] * wv; a3 += sc[3072 + k] * wv; a4 += sc[4096 + k] * wv; }
        red[(kg * 5 + 0) * 32 + c] = a0; red[(kg * 5 + 1) * 32 + c] = a1; red[(kg * 5 + 2) * 32 + c] = a2; red[(kg * 5 + 3) * 32 + c] = a3; red[(kg * 5 + 4) * 32 + c] = a4;
        __syncthreads();
        if (C.tid < 160) { const int r = C.tid >> 5; float s = 0.f;
#pragma unroll
            for (int q = 0; q < 16; ++q) s += red[(q * 5 + r) * 32 + c];
            MOD[(size_t)(l * 5 + r) * 6144 + col] = s + P.in[I_BMOD][l * 6144 + col]; }
        __syncthreads();
    }
}

__device__ __forceinline__ void transpose_item(const float* W, int K, int N, bf16_t* WT, LAS float* scr, int item, int nblk, int lane) {
    const int kb = item / nblk, nb = item % nblk, k0 = 64 * kb, n0 = 32 * nb;
    const bool nok = (n0 + (lane & 31)) < N;
#pragma unroll 8
    for (int i = 0; i < 32; ++i) { const int kk = 2 * i + (lane >> 5); scr[kk * 33 + (lane & 31)] = nok ? W[(size_t)(k0 + kk) * N + n0 + (lane & 31)] : 0.f; }
    asm volatile("s_waitcnt lgkmcnt(0)" ::: "memory");
    const int c = lane & 7;
#pragma unroll
    for (int j = 0; j < 4; ++j) { const int n = (lane >> 3) + 8 * j; const LAS float* s = scr + (8 * c) * 33 + n;
        u32x4 o; o.x = pk2(s[0 * 33], s[1 * 33]); o.y = pk2(s[2 * 33], s[3 * 33]); o.z = pk2(s[4 * 33], s[5 * 33]); o.w = pk2(s[6 * 33], s[7 * 33]);
        *(u32x4*)(WT + (size_t)(n0 + n) * K + k0 + 8 * c) = o; }
    asm volatile("s_waitcnt lgkmcnt(0)" ::: "memory");
}
__device__ __forceinline__ void phase_convert(const Params& P, const Ctx& C, int l) {
    LAS float* scr = (LAS float*)(C.lds + 32768 + C.wave * 8704);
    const int gw = C.bid * 8 + C.wave, NGW = C.G * 8; const int j = l >> 1; const bool ev = (l & 1) == 0;
    const float* win = ev ? P.in[I_WINAB] + (size_t)j * 1024 * N_AB : P.in[I_WINCD] + (size_t)j * 1024 * N_CD;
    const float* wout = (ev ? P.in[I_WOUTAB] : P.in[I_WOUTCD]) + (size_t)j * 2048 * 1024;
    const float* wup = P.in[I_WUP] + (size_t)l * 1024 * 4096; const float* wdn = P.in[I_WDN] + (size_t)l * 4096 * 1024;
    const int N_in = ev ? N_AB : N_CD, Np = ev ? N_AB_P : N_CD_P;
    const int I0 = 16 * (Np / 32), I1 = 32 * 32, I2 = 16 * 128, I3 = 64 * 32;
    for (int it = gw; it < I0 + I1 + I2 + I3; it += NGW) {
        int r = it;
        if (r < I0) { transpose_item(win, 1024, N_in, (bf16_t*)(P.ws + WS_WIN), scr, r, Np / 32, C.lane); continue; } r -= I0;
        if (r < I1) { transpose_item(wout, 2048, 1024, (bf16_t*)(P.ws + WS_WOUT), scr, r, 32, C.lane); continue; } r -= I1;
        if (r < I2) { transpose_item(wup, 1024, 4096, (bf16_t*)(P.ws + WS_WUP), scr, r, 128, C.lane); continue; } r -= I2;
        transpose_item(wdn, 4096, 1024, (bf16_t*)(P.ws + WS_WDN), scr, r, 32, C.lane);
    }
    if (ev) {
        bf16_t* WL = (bf16_t*)(P.ws + WS_WLORA);
        for (int idx = C.bid * 512 + C.tid; idx < 5120 * 16; idx += C.G * 512) {
            const int n = idx % 5120, k8 = idx / 5120, g = n >> 10, cc = n & 1023; float o[8];
#pragma unroll
            for (int e = 0; e < 8; ++e) { const int k = k8 * 8 + e; float v = 0.f;
                if (g == 0) { if (k < 64) v = P.in[I_W2][((size_t)(j * 2 + 0) * 64 + k) * 1024 + cc]; }
                else if (g == 1) { if (k >= 64) v = P.in[I_W2][((size_t)(j * 2 + 1) * 64 + (k - 64)) * 1024 + cc]; }
                else if (g == 2) { if (k < 64) v = P.in[I_A2][((size_t)(j * 2 + 0) * 64 + k) * 1024 + cc]; }
                else if (g == 3) { if (k >= 64) v = P.in[I_A2][((size_t)(j * 2 + 1) * 64 + (k - 64)) * 1024 + cc]; }
                else v = P.in[I_G2][((size_t)j * 128 + k) * 1024 + cc];
                o[e] = v; }
            *(u32x4*)(WL + (size_t)n * 128 + k8 * 8) = pack8(o);
        }
    }
}

__device__ __forceinline__ void phase_rows(const Params& P, const Ctx& C, int mode, const float* gpost, const float* gate_mod  ,
                                           bool next, const float* gpre, const float* mod_next  , bool dummy = false) {
    float* X = P.out + O_X; const bf16_t* MP0 = (const bf16_t*)(P.ws + WS_MP); const bf16_t* MP1 = MP0 + (size_t)MTOK * DM; bf16_t* H = (bf16_t*)(P.ws + WS_H);
    const int gw = C.bid * 8 + C.wave, NGW = C.G * 8;
    for (int m = gw; m < MTOK; m += NGW) {
        const int mr = m < 4096 ? 0 : 1 + ((m - 4096) >> 10);
        f32x4 x[4];
        f32x4 gq[4], sh[4], sl[4];
        if (next) { const f32x4* gp_ = (const f32x4*)gpre + C.lane; const f32x4* sh_ = (const f32x4*)(mod_next + (size_t)mr * 6144) + C.lane; const f32x4* sl_ = (const f32x4*)(mod_next + (size_t)mr * 6144 + 1024) + C.lane;
#pragma unroll
            for (int j = 0; j < 4; ++j) { gq[j] = gp_[64 * j]; sh[j] = sh_[64 * j]; sl[j] = sl_[64 * j]; } }
        if (mode == 0) { const f32x4* src = (const f32x4*)(m < 4096 ? P.in[I_XP] + (size_t)m * DM : P.in[I_XS] + (size_t)(m - 4096) * DM) + C.lane;
#pragma unroll
            for (int j = 0; j < 4; ++j) x[j] = src[64 * j];
        } else {
            const f32x4* xs = (const f32x4*)(X + (size_t)m * DM) + C.lane; const u32x2* p0 = (const u32x2*)(MP0 + (size_t)m * DM) + C.lane; const u32x2* p1 = (const u32x2*)(MP1 + (size_t)m * DM) + C.lane;
            const f32x4* gp = (const f32x4*)gpost + C.lane; const f32x4* gt = (const f32x4*)(gate_mod + (size_t)mr * 6144) + C.lane;
            f32x4 gpv[4], gtv[4];
#pragma unroll
            for (int j = 0; j < 4; ++j) { gpv[j] = gp[64 * j]; gtv[j] = gt[64 * j]; }
            f32x4 f[4]; float ss = 0.f;
#pragma unroll
            for (int j = 0; j < 4; ++j) { x[j] = xs[64 * j]; f[j] = unpack4(p0[64 * j]) + unpack4(p1[64 * j]); ss += (f[j].x * f[j].x + f[j].y * f[j].y) + (f[j].z * f[j].z + f[j].w * f[j].w); }
            const float rs = rsqrtf(wave_sum(ss) * (1.f / DM) + 1e-6f);
#pragma unroll
            for (int j = 0; j < 4; ++j) x[j] = x[j] + gtv[j] * (f[j] * rs * gpv[j]);
        }
        f32x4* xo = (f32x4*)((dummy ? (float*)(P.ws + WS_PREP) : X) + (size_t)m * DM) + C.lane;
#pragma unroll
        for (int j = 0; j < 4; ++j) xo[64 * j] = x[j];
        if (next) {
            float ss = 0.f;
#pragma unroll
            for (int j = 0; j < 4; ++j) ss += (x[j].x * x[j].x + x[j].y * x[j].y) + (x[j].z * x[j].z + x[j].w * x[j].w);
            const float rs = rsqrtf(wave_sum(ss) * (1.f / DM) + 1e-6f);
            u32x2* ho = (u32x2*)((dummy ? (bf16_t*)(P.ws + WS_PREP + 40 * MiB) : H) + (size_t)m * DM) + C.lane;
#pragma unroll
            for (int j = 0; j < 4; ++j) { const f32x4 h = (x[j] * rs * gq[j]) * (sl[j] + 1.f) + sh[j]; u32x2 w; w.x = pk2(h.x, h.y); w.y = pk2(h.z, h.w); ho[64 * j] = w; }
        }
    }
}

__device__ __forceinline__ void conv8(const bf16_t* src, int ld, int col0, int base, int t, bool samp, const float* w, const float* b, int NC, int ch, float* acc) {
    { const f32x4 b0 = *(const f32x4*)(b + ch), b1 = *(const f32x4*)(b + ch + 4); acc[0] = b0.x; acc[1] = b0.y; acc[2] = b0.z; acc[3] = b0.w; acc[4] = b1.x; acc[5] = b1.y; acc[6] = b1.z; acc[7] = b1.w; }
    if (!samp) {
#pragma unroll
        for (int d = 0; d < 3; ++d) { const int tt = t + d - 1; if (tt < 0 || tt >= 256) continue;
            float xv[8]; unpack8(*(const u32x4*)(src + (size_t)(base + tt) * ld + col0 + ch), xv);
            const f32x4 w0 = *(const f32x4*)(w + (3 + d) * NC + ch), w1 = *(const f32x4*)(w + (3 + d) * NC + ch + 4);
            acc[0] += w0.x * xv[0]; acc[1] += w0.y * xv[1]; acc[2] += w0.z * xv[2]; acc[3] += w0.w * xv[3]; acc[4] += w1.x * xv[4]; acc[5] += w1.y * xv[5]; acc[6] += w1.z * xv[6]; acc[7] += w1.w * xv[7]; }
    } else {
        const int r = t >> 6, c = t & 63;
#pragma unroll
        for (int i = 0; i < 3; ++i)
#pragma unroll
            for (int d = 0; d < 3; ++d) { const int rr = r + i - 1, cc = c + d - 1; if (rr < 0 || rr >= 16 || cc < 0 || cc >= 64) continue;
                float xv[8]; unpack8(*(const u32x4*)(src + (size_t)(base + rr * 64 + cc) * ld + col0 + ch), xv);
                const f32x4 w0 = *(const f32x4*)(w + (i * 3 + d) * NC + ch), w1 = *(const f32x4*)(w + (i * 3 + d) * NC + ch + 4);
                acc[0] += w0.x * xv[0]; acc[1] += w0.y * xv[1]; acc[2] += w0.z * xv[2]; acc[3] += w0.w * xv[3]; acc[4] += w1.x * xv[4]; acc[5] += w1.y * xv[5]; acc[6] += w1.z * xv[6]; acc[7] += w1.w * xv[7]; }
    }
}

__device__ __forceinline__ void phase_prep_even(const Params& P, const Ctx& C, int j) {
    const bf16_t* PROJ = (const bf16_t*)(P.ws + WS_PROJ); bf16_t* PREP = (bf16_t*)(P.ws + WS_PREP); bf16_t* LA = (bf16_t*)(P.ws + WS_LORAA);
    float* DT = (float*)(P.ws + WS_DT); float* DA = (float*)(P.ws + WS_DA);
    const float* cw = P.in[I_SCONVW] + (size_t)j * 9 * 2048; const float* cb = P.in[I_SCONVB] + j * 2048;
    const float* mu = P.in[I_MU] + j * 3456; const float* kkw = P.in[I_KK] + j * 1024;
    const int gw = C.bid * 8 + C.wave, NGW = C.G * 8, lane = C.lane;
    for (int m = gw; m < MTOK; m += NGW) {
        const bool samp = m >= 4096; const int T = samp ? 1024 : 256; const int t = samp ? ((m - 4096) & 1023) : (m & 255); const int base = m - t;
        const bf16_t* prow = PROJ + (size_t)m * PROJ_LD_AB; bf16_t* orow = PREP + (size_t)m * PREP_LD;
        const bool hp = t > 0, hn = t < T - 1;
        u32x4 rx[7], rxp[7], rxn[7], rz[2];
#pragma unroll
        for (int it = 0; it < 7; ++it) { const int c = it * 512 + lane * 8; const bool ok = c < 3456; const u32x4 z4 = (u32x4){0u, 0u, 0u, 0u};
            rx[it] = ok ? *(const u32x4*)(prow + IN_SSD + c) : z4; rxp[it] = (ok && hp) ? *(const u32x4*)(prow - PROJ_LD_AB + IN_SSD + c) : z4; rxn[it] = (ok && hn) ? *(const u32x4*)(prow + PROJ_LD_AB + IN_SSD + c) : z4; }
#pragma unroll
        for (int it = 0; it < 2; ++it) rz[it] = *(const u32x4*)(prow + it * 512 + lane * 8);
#pragma unroll 1
        for (int it = 0; it < 4; ++it) { const int ch = it * 512 + lane * 8; float acc[8];
            conv8(PROJ, PROJ_LD_AB, 1024, base, t, samp, cw, cb, 2048, ch, acc);
#pragma unroll
            for (int e = 0; e < 8; ++e) acc[e] = siluf_(acc[e]);
            *(u32x4*)(orow + ch) = pack8(acc); }
#pragma unroll
        for (int it = 0; it < 2; ++it) { const int ch = it * 512 + lane * 8; float z[8]; unpack8(rz[it], z);
#pragma unroll
            for (int e = 0; e < 8; ++e) z[e] = siluf_(z[e]);
            *(u32x4*)(orow + 2048 + ch) = pack8(z); }
        if (lane < 32) { const float raw = bf2f(prow[3072 + lane]); const float dt = softplusf_(raw + P.in[I_DTB][j * 32 + lane]);
            DT[(size_t)m * 32 + lane] = dt; DA[(size_t)m * 32 + lane] = -dt * __expf(P.in[I_ALOG][j * 32 + lane]); }
#pragma unroll
        for (int it = 0; it < 7; ++it) { const int c = it * 512 + lane * 8; if (c >= 3456) break;
            float x[8], xp[8], xn[8];
            unpack8(rx[it], x); unpack8(rxp[it], xp); unpack8(rxn[it], xn);
            const f32x4 m0 = *(const f32x4*)(mu + c), m1 = *(const f32x4*)(mu + c + 4);
            const float mv[8] = {m0.x, m0.y, m0.z, m0.w, m1.x, m1.y, m1.z, m1.w};
#pragma unroll
            for (int e = 0; e < 8; ++e) x[e] = x[e] + mv[e] * (0.5f * (xp[e] + xn[e]) - x[e]);
            if (it < 2) { *(u32x4*)(orow + 3072 + c) = pack8(x); }
            else if (it < 4) { *(u32x4*)(orow + 4096 + (c - 1024)) = pack8(x);
                const f32x4 k0 = *(const f32x4*)(kkw + c - 1024), k1 = *(const f32x4*)(kkw + c - 1024 + 4);
                const float kv[8] = {k0.x, k0.y, k0.z, k0.w, k1.x, k1.y, k1.z, k1.w}; float ss = 0.f;
#pragma unroll
                for (int e = 0; e < 8; ++e) { x[e] *= kv[e]; ss += x[e] * x[e]; }
                ss += __shfl_xor(ss, 1); ss += __shfl_xor(ss, 2); ss += __shfl_xor(ss, 4);
                const float rn = rsqrtf(ss + 1e-12f);
#pragma unroll
                for (int e = 0; e < 8; ++e) x[e] *= rn;
                *(u32x4*)(orow + 6144 + (c - 1024)) = pack8(x); }
            else if (it < 6) { *(u32x4*)(orow + 5120 + (c - 2048)) = pack8(x); }
            else { const int cc = c - 3072;
#pragma unroll
                for (int e = 0; e < 8; ++e) x[e] = cc < 128 ? tanhf_(x[e]) : (cc < 256 ? x[e] : sigmoidf_(x[e]));
                *(u32x4*)(LA + (size_t)m * LORA_K + cc) = pack8(x); }
        }
    }
}
__device__ __forceinline__ void phase_prep_odd(const Params& P, const Ctx& C, int j) {
    const bf16_t* PROJ = (const bf16_t*)(P.ws + WS_PROJ); bf16_t* PREP = (bf16_t*)(P.ws + WS_PREP);
    const float* cw = P.in[I_MCONVW] + (size_t)j * 9 * 1024; const float* cb = P.in[I_MCONVB] + j * 1024;
    const int gw = C.bid * 8 + C.wave, NGW = C.G * 8, lane = C.lane;
    for (int m = gw; m < MTOK; m += NGW) {
        const bool samp = m >= 4096; const int t = samp ? ((m - 4096) & 1023) : (m & 255); const int base = m - t;
#pragma unroll 1
        for (int it = 0; it < 2; ++it) { const int ch = it * 512 + lane * 8; float acc[8];
            conv8(PROJ, PROJ_LD_CD, IN_GLA, base, t, samp, cw, cb, 1024, ch, acc);
#pragma unroll
            for (int e = 0; e < 8; ++e) acc[e] = siluf_(acc[e]);
            *(u32x4*)(PREP + (size_t)m * PREP_LD + ch) = pack8(acc); }
    }
}

constexpr int CS_QLD = 136, CS_SLD = 72;
constexpr int CS_QS = 0, CS_KS = 17408, CS_KT = 34816, CS_VT = 53248;
__device__ __forceinline__ bf16x8 lds_frag(const LAS bf16_t* p) { return *(const LAS bf16x8*)p; }
template <int MODE>
__device__ __forceinline__ void chunk_scan(const Params& P, const Ctx& C, int j, int s, int dir, int h, int vs) {
    const int tid = C.tid, lane = C.lane, w = C.wave, fr = lane & 15, fq = lane >> 4;
    const int T = s < 16 ? 256 : 1024, base = s < 16 ? s * 256 : 4096 + (s - 16) * 1024, nch = T >> 6;
    const bf16_t* PROJ = (const bf16_t*)(P.ws + WS_PROJ); const bf16_t* PREP = (const bf16_t*)(P.ws + WS_PREP);
    bf16_t* Y = (bf16_t*)(P.ws + WS_MP) + (size_t)dir * MTOK * YLD;
    LAS bf16_t* Qs = (LAS bf16_t*)(C.lds + CS_QS); LAS bf16_t* Ks = (LAS bf16_t*)(C.lds + CS_KS); LAS bf16_t* Kt = (LAS bf16_t*)(C.lds + CS_KT); LAS bf16_t* Vt = (LAS bf16_t*)(C.lds + CS_VT);
    constexpr int NV = MODE == 0 ? 64 : 128, NVC = NV / 16, VROWS = NV + (MODE == 2 ? 16 : 0);
    constexpr int CS_ST = CS_VT + VROWS * CS_SLD * 2, CS_LA = CS_ST + VROWS * CS_QLD * 2, CS_PS = CS_LA  , CS_TOT = CS_LA + (MODE == 1 ? 32768 : 9216),
                  CS_BV = CS_TOT + 2560, CS_IG = CS_BV + 256, CS_FV = CS_IG + 256, CS_DTV = CS_FV + 256, CS_MS = CS_DTV + 256;
    static_assert(CS_MS + 64 <= LDS_BYTES - 16, "chunk-scan LDS map");
    LAS bf16_t* Ps = (LAS bf16_t*)(C.lds + CS_PS); LAS bf16_t* St = (LAS bf16_t*)(C.lds + CS_ST);
    LAS float* LA = (LAS float*)(C.lds + CS_LA); LAS float* TOT = (LAS float*)(C.lds + CS_TOT); LAS float* BV = (LAS float*)(C.lds + CS_BV); LAS float* IG = (LAS float*)(C.lds + CS_IG);
    LAS float* MS = (LAS float*)(C.lds + CS_MS); LAS float* FV = (LAS float*)(C.lds + CS_FV); LAS float* DTV = (LAS float*)(C.lds + CS_DTV);
    constexpr int NVT = NVC + (MODE == 2 ? 1 : 0);
    const int si = tid >> 3, kq = tid & 7;
    __syncthreads();
    bf16x8 gwa_hi = {0, 0, 0, 0, 0, 0, 0, 0}, gwa_lo = {0, 0, 0, 0, 0, 0, 0, 0}; f32x4 gb4 = {0.f, 0.f, 0.f, 0.f};
    if (MODE == 1) {
        const float* gwp = P.in[I_GGW] + (size_t)(j * 2 + dir) * 16 * 512 + h * 128 + 16 * w + fr;
        if (fq < 2) {
#pragma unroll
            for (int e = 0; e < 8; ++e) { const float g = gwp[(8 * fq + e) * 512]; const unsigned hb = f2bf(g); const float rem = g - bf2f(hb); gwa_hi[e] = (short)hb; gwa_lo[e] = (short)f2bf(rem); } }
        gb4 = *(const f32x4*)(P.in[I_GGB] + (j * 2 + dir) * 512 + h * 128 + 16 * w + 4 * fq);
    }
    f32x4 Sacc[NVT];
    {
        const float* s0 = nullptr; int kstride = 64; float em0 = 1.f;
        if (s >= 16) { const int b = s - 16;
            if (MODE == 0) { s0 = P.in[I_SSSD] + ((size_t)((b * 2 + j) * 2 + dir) * 16 + h) * 8192; kstride = 64; }
            if (MODE == 1) { s0 = P.in[I_SGLA] + ((size_t)((b * 2 + j) * 2 + dir) * 4 + h) * 32768 + vs * NV; kstride = 256; }
            if (MODE == 2) { s0 = P.in[I_SMC] + ((size_t)((b * 2 + j) * 2 + dir) * 4 + h) * 32768 + vs * NV; kstride = 256; em0 = __expf(P.in[I_SMM][((b * 2 + j) * 2 + dir) * 4 + h]); } }
#pragma unroll
        for (int vt = 0; vt < NVC; ++vt)
#pragma unroll
            for (int e = 0; e < 4; ++e) Sacc[vt][e] = s0 ? s0[(size_t)(16 * w + 4 * fq + e) * kstride + 16 * vt + fr] * em0 : 0.f;
        if (MODE == 2) {
            const float* n0 = s >= 16 ? P.in[I_SMN] + ((size_t)(((s - 16) * 2 + j) * 2 + dir) * 4 + h) * 128 : nullptr;
#pragma unroll
            for (int e = 0; e < 4; ++e) Sacc[NVT - 1][e] = (n0 && fr == 0) ? n0[16 * w + 4 * fq + e] * em0 : 0.f;
            if (tid == 0) MS[0] = s >= 16 ? P.in[I_SMM][(((s - 16) * 2 + j) * 2 + dir) * 4 + h] : 0.f;
            for (int i = tid; i < 16 * CS_SLD; i += 512) Vt[NV * CS_SLD + i] = (bf16_t)((i < CS_SLD) ? 0x3F80 : 0);
        }
#pragma unroll
        for (int vt = 0; vt < NVT; ++vt) { u32x2 wv; wv.x = pk2(Sacc[vt][0], Sacc[vt][1]); wv.y = pk2(Sacc[vt][2], Sacc[vt][3]); *(LAS u32x2*)(St + (16 * vt + fr) * CS_QLD + 16 * w + 4 * fq) = wv; }
    }
    u32x4 rq0, rq1, rk0, rk1, rgd[4]; float rla = 0.f, rig = 0.f, rdt = 0.f;
    constexpr int NVTOK = MODE == 0 ? 8 : 16;
    unsigned short rkt[16], rvt[NVTOK];
    const int kx = tid & 127, tgk = tid >> 7, vx = tid & (NV - 1), tgv = MODE == 0 ? (tid >> 6) : (tid >> 7);
    auto tok = [&](int c, int i) { const int st0 = c * 64 + i; return base + (dir ? (T - 1 - st0) : st0); };
    auto load_raw = [&](int c) {
        const int m = tok(c, si); const int m1 = tok(c, tid & 63);
        const bf16_t* krow; const bf16_t* vrow; int kld, vld;
        if (MODE == 0) { const int g = h >> 2; const bf16_t* pr = PREP + (size_t)m * PREP_LD;
            rq0 = *(const u32x4*)(pr + 1536 + g * 128 + 16 * kq); rq1 = *(const u32x4*)(pr + 1536 + g * 128 + 16 * kq + 8);
            rk0 = *(const u32x4*)(pr + 1024 + g * 128 + 16 * kq); rk1 = *(const u32x4*)(pr + 1024 + g * 128 + 16 * kq + 8);
            if (tid < 64) { rla = ((const float*)(P.ws + WS_DA))[(size_t)m1 * 32 + dir * 16 + h]; rdt = ((const float*)(P.ws + WS_DT))[(size_t)m1 * 32 + dir * 16 + h]; }
            krow = PREP + 1024 + g * 128 + kx; kld = PREP_LD; vrow = PREP + h * 64 + vx; vld = PREP_LD; }
        if (MODE == 1) { const bf16_t* pr = PROJ + (size_t)m * PROJ_LD_CD;
            rq0 = *(const u32x4*)(pr + h * 128 + 16 * kq); rq1 = *(const u32x4*)(pr + h * 128 + 16 * kq + 8);
            rk0 = *(const u32x4*)(pr + 512 + h * 128 + 16 * kq); rk1 = *(const u32x4*)(pr + 512 + h * 128 + 16 * kq + 8);
#pragma unroll
            for (int t4 = 0; t4 < 4; ++t4) { rgd[t4] = (u32x4){0u, 0u, 0u, 0u}; if (fq < 2) rgd[t4] = *(const u32x4*)(PROJ + (size_t)tok(c, 16 * t4 + fr) * PROJ_LD_CD + 3072 + dir * 16 + 8 * fq); }
            krow = PROJ + 512 + h * 128 + kx; kld = PROJ_LD_CD; vrow = PROJ + 1024 + h * 256 + vs * NV + vx; vld = PROJ_LD_CD; }
        if (MODE == 2) { const bf16_t* pp = PREP + (size_t)m * PREP_LD;
            rq0 = *(const u32x4*)(pp + h * 128 + 16 * kq); rq1 = *(const u32x4*)(pp + h * 128 + 16 * kq + 8);
            rk0 = *(const u32x4*)(pp + 512 + h * 128 + 16 * kq); rk1 = *(const u32x4*)(pp + 512 + h * 128 + 16 * kq + 8);
            if (tid < 64) { const bf16_t* p1 = PROJ + (size_t)m1 * PROJ_LD_CD + IN_GLA + 3072; rig = bf2f(p1[dir * 4 + h]); rla = bf2f(p1[8 + dir * 4 + h]); }
            krow = PREP + 512 + h * 128 + kx; kld = PREP_LD; vrow = PROJ + IN_GLA + 1024 + h * 256 + vs * NV + vx; vld = PROJ_LD_CD; }
        { const bf16_t* kp = krow + (size_t)tok(c, 16 * tgk) * kld; const long ks_ = dir ? -(long)kld : (long)kld;
#pragma unroll
          for (int jj = 0; jj < 16; ++jj) { rkt[jj] = *kp; kp += ks_; }
          const bf16_t* vp = vrow + (size_t)tok(c, NVTOK * tgv) * vld; const long vs_ = dir ? -(long)vld : (long)vld;
#pragma unroll
          for (int jj = 0; jj < NVTOK; ++jj) { rvt[jj] = *vp; vp += vs_; } }
    };
    load_raw(0);
    __syncthreads();
    const int ycol0 = (MODE == 0 ? h * 64 : (MODE == 1 ? h * 256 + vs * NV : 1024 + h * 256 + vs * NV));
    for (int c = 0; c < nch; ++c) {
        if (MODE == 1) {
#pragma unroll
            for (int t4 = 0; t4 < 4; ++t4) { f32x4 acc = (f32x4){0.f, 0.f, 0.f, 0.f}; const bf16x8 gf = __builtin_bit_cast(bf16x8, rgd[t4]);
                acc = __builtin_amdgcn_mfma_f32_16x16x32_bf16(gwa_hi, gf, acc, 0, 0, 0); acc = __builtin_amdgcn_mfma_f32_16x16x32_bf16(gwa_lo, gf, acc, 0, 0, 0);
                f32x4 la;
#pragma unroll
                for (int e = 0; e < 4; ++e) la[e] = logsigmoidf_(acc[e] + gb4[e]) * 0.0625f;
                *(LAS f32x4*)(LA + (16 * t4 + fr) * 128 + 16 * w + 4 * fq) = la; }
        } else if (tid < 64) {
            float ig = 0.f, la = rla;
            if (MODE == 2) { ig = rig + P.in[I_MIB][(j * 2 + dir) * 4 + h]; la = logsigmoidf_(rla + P.in[I_MFB][(j * 2 + dir) * 4 + h]); }
            float x = la;
            x += __int_as_float(__builtin_amdgcn_update_dpp(0, __float_as_int(x), 0x111, 0xF, 0xF, true));
            x += __int_as_float(__builtin_amdgcn_update_dpp(0, __float_as_int(x), 0x112, 0xF, 0xF, true));
            x += __int_as_float(__builtin_amdgcn_update_dpp(0, __float_as_int(x), 0x114, 0xF, 0xF, true));
            x += __int_as_float(__builtin_amdgcn_update_dpp(0, __float_as_int(x), 0x118, 0xF, 0xF, true));
            { const float t0 = __int_as_float(__builtin_amdgcn_readlane(__float_as_int(x), 15)), t1 = __int_as_float(__builtin_amdgcn_readlane(__float_as_int(x), 31)), t2 = __int_as_float(__builtin_amdgcn_readlane(__float_as_int(x), 47));
              const int rw = lane >> 4; x += (rw > 0 ? t0 : 0.f) + (rw > 1 ? t1 : 0.f) + (rw > 2 ? t2 : 0.f); }
            const float bl = __int_as_float(__builtin_amdgcn_readlane(__float_as_int(x), 63));
            const float kgn = MODE == 2 ? 0.08838834764831845f * __expf(ig) : 1.f;
            BV[tid] = x; IG[tid] = kgn; FV[tid] = kgn * __expf(bl - x); DTV[tid] = MODE == 0 ? rdt : 1.f;
            if (MODE == 2) { float ml = bl - x + ig;
                ml = fmaxf(ml, __int_as_float(__builtin_amdgcn_update_dpp(__float_as_int(ml), __float_as_int(ml), 0xB1, 0xF, 0xF, false)));
                ml = fmaxf(ml, __int_as_float(__builtin_amdgcn_update_dpp(__float_as_int(ml), __float_as_int(ml), 0x4E, 0xF, 0xF, false)));
                ml = fmaxf(ml, __int_as_float(__builtin_amdgcn_update_dpp(__float_as_int(ml), __float_as_int(ml), 0x141, 0xF, 0xF, false)));
                ml = fmaxf(ml, __int_as_float(__builtin_amdgcn_update_dpp(__float_as_int(ml), __float_as_int(ml), 0x140, 0xF, 0xF, false)));
                const float m01 = fmaxf(__int_as_float(__builtin_amdgcn_readlane(__float_as_int(ml), 0)), __int_as_float(__builtin_amdgcn_readlane(__float_as_int(ml), 16)));
                const float m23 = fmaxf(__int_as_float(__builtin_amdgcn_readlane(__float_as_int(ml), 32)), __int_as_float(__builtin_amdgcn_readlane(__float_as_int(ml), 48)));
                if (tid == 0) MS[0] = fmaxf(bl + MS[0], fmaxf(m01, m23)); }
        }
        __syncthreads();
        if (MODE == 1) {
            const int k = tid & 127, qd = tid >> 7; float run = 0.f;
#pragma unroll
            for (int jj = 0; jj < 16; ++jj) { run += LA[(16 * qd + jj) * 128 + k]; LA[(16 * qd + jj) * 128 + k] = run; }
            TOT[qd * 128 + k] = run;
            __syncthreads();
            if (tid < 128) TOT[4 * 128 + tid] = __expf(TOT[tid] + TOT[128 + tid] + TOT[256 + tid] + TOT[384 + tid]);
        }
        {
            float q[16], k[16]; unpack8(rq0, q); unpack8(rq1, q + 8); unpack8(rk0, k); unpack8(rk1, k + 8);
            float qs[16], ks[16];
            if (MODE == 1) { const int qd = si >> 4;
#pragma unroll
                for (int e4 = 0; e4 < 4; ++e4) { const int kk = 16 * kq + 4 * e4; const f32x4 bb = *(LAS f32x4*)(LA + si * 128 + kk), t0 = *(LAS f32x4*)(TOT + kk), t1 = *(LAS f32x4*)(TOT + 128 + kk), t2 = *(LAS f32x4*)(TOT + 256 + kk);
#pragma unroll
                    for (int e = 0; e < 4; ++e) { const float b = bb[e] + (qd > 0 ? t0[e] : 0.f) + (qd > 1 ? t1[e] : 0.f) + (qd > 2 ? t2[e] : 0.f);
                        qs[4 * e4 + e] = q[4 * e4 + e] * 0.08838834764831845f * __expf(b); ks[4 * e4 + e] = k[4 * e4 + e] * __expf(fminf(-b, 80.f)); } }
            } else { const float kgn = IG[si];
#pragma unroll
                for (int e = 0; e < 16; ++e) { qs[e] = q[e]; ks[e] = k[e] * kgn; } }
            *(LAS u32x4*)(Qs + si * CS_QLD + 16 * kq) = pack8(qs); *(LAS u32x4*)(Qs + si * CS_QLD + 16 * kq + 8) = pack8(qs + 8);
            *(LAS u32x4*)(Ks + si * CS_QLD + 16 * kq) = pack8(ks); *(LAS u32x4*)(Ks + si * CS_QLD + 16 * kq + 8) = pack8(ks + 8);
        }
        if (MODE == 1)
        {
            float kt[16];
            if (MODE == 1) { float off = 0.f; const float t0 = TOT[kx], t1 = TOT[128 + kx], t2 = TOT[256 + kx], t3 = TOT[384 + kx];
                off = (tgk > 0 ? t0 : 0.f) + (tgk > 1 ? t1 : 0.f) + (tgk > 2 ? t2 : 0.f); const float bl = (t0 + t1) + (t2 + t3);
#pragma unroll
                for (int jj = 0; jj < 16; ++jj) kt[jj] = bf2f(rkt[jj]) * __expf(bl - (LA[(16 * tgk + jj) * 128 + kx] + off));
            } else {
#pragma unroll
                for (int jj = 0; jj < 16; ++jj) kt[jj] = bf2f(rkt[jj]) * FV[16 * tgk + jj]; }
            *(LAS u32x4*)(Kt + kx * CS_SLD + 16 * tgk) = pack8(kt); *(LAS u32x4*)(Kt + kx * CS_SLD + 16 * tgk + 8) = pack8(kt + 8);
            float vt8[NVTOK];
#pragma unroll
            for (int jj = 0; jj < NVTOK; ++jj) vt8[jj] = bf2f(rvt[jj]) * (MODE == 0 ? DTV[NVTOK * tgv + jj] : 1.f);
            *(LAS u32x4*)(Vt + vx * CS_SLD + NVTOK * tgv) = pack8(vt8);
            if (NVTOK == 16) *(LAS u32x4*)(Vt + vx * CS_SLD + NVTOK * tgv + 8) = pack8(vt8 + 8);
        }
        __syncthreads();
        if (MODE != 1)
        {
            float kt[16];
            if (MODE == 1) { float off = 0.f; const float t0 = TOT[kx], t1 = TOT[128 + kx], t2 = TOT[256 + kx], t3 = TOT[384 + kx];
                off = (tgk > 0 ? t0 : 0.f) + (tgk > 1 ? t1 : 0.f) + (tgk > 2 ? t2 : 0.f); const float bl = (t0 + t1) + (t2 + t3);
#pragma unroll
                for (int jj = 0; jj < 16; ++jj) kt[jj] = bf2f(rkt[jj]) * __expf(bl - (LA[(16 * tgk + jj) * 128 + kx] + off));
            } else {
#pragma unroll
                for (int jj = 0; jj < 16; ++jj) kt[jj] = bf2f(rkt[jj]) * FV[16 * tgk + jj]; }
            *(LAS u32x4*)(Kt + kx * CS_SLD + 16 * tgk) = pack8(kt); *(LAS u32x4*)(Kt + kx * CS_SLD + 16 * tgk + 8) = pack8(kt + 8);
            float vt8[NVTOK];
#pragma unroll
            for (int jj = 0; jj < NVTOK; ++jj) vt8[jj] = bf2f(rvt[jj]) * (MODE == 0 ? DTV[NVTOK * tgv + jj] : 1.f);
            *(LAS u32x4*)(Vt + vx * CS_SLD + NVTOK * tgv) = pack8(vt8);
            if (NVTOK == 16) *(LAS u32x4*)(Vt + vx * CS_SLD + NVTOK * tgv + 8) = pack8(vt8 + 8);
        }
        if (c + 1 < nch) load_raw(c + 1);
        const int tt = w >> 1;
#pragma unroll
        for (int sj = 0; sj < 2; ++sj) { const int st = 2 * (w & 1) + sj; u32x2 wv; wv.x = 0u; wv.y = 0u;
            if (st <= tt) { f32x4 acc = (f32x4){0.f, 0.f, 0.f, 0.f};
#pragma unroll
                for (int kk = 0; kk < 4; ++kk) acc = __builtin_amdgcn_mfma_f32_16x16x32_bf16(lds_frag(Ks + (16 * st + fr) * CS_QLD + 32 * kk + 8 * fq), lds_frag(Qs + (16 * tt + fr) * CS_QLD + 32 * kk + 8 * fq), acc, 0, 0, 0);
                const int tg = 16 * tt + fr, sg = 16 * st + 4 * fq;
                if (MODE != 1) { const float bt = BV[tg]; const f32x4 bs = *(LAS f32x4*)(BV + sg);
#pragma unroll
                    for (int e = 0; e < 4; ++e) acc[e] *= __expf(fminf(bt - bs[e], 0.f)); }
#pragma unroll
                for (int e = 0; e < 4; ++e) acc[e] = (sg + e <= tg) ? acc[e] : 0.f;
                wv.x = pk2(acc[0], acc[1]); wv.y = pk2(acc[2], acc[3]); }
            *(LAS u32x2*)(Ps + (16 * tt + fr) * CS_SLD + 16 * st + 4 * fq) = wv; }
        __syncthreads();
        {
            const int tg = 16 * tt + fr; const int stp = c * 64 + tg; const int m = base + (dir ? (T - 1 - stp) : stp);
            const float ebt = MODE == 1 ? 1.f : __expf(BV[tg]);
            bf16x8 pf[2], qf[4];
#pragma unroll
            for (int ks2 = 0; ks2 < 2; ++ks2) pf[ks2] = lds_frag(Ps + tg * CS_SLD + 32 * ks2 + 8 * fq);
#pragma unroll
            for (int kk = 0; kk < 4; ++kk) qf[kk] = lds_frag(Qs + tg * CS_QLD + 32 * kk + 8 * fq);
            float rden = 1.f;
            if (MODE == 2) { f32x4 ai = (f32x4){0.f, 0.f, 0.f, 0.f}, ao = (f32x4){0.f, 0.f, 0.f, 0.f};
#pragma unroll
                for (int ks2 = 0; ks2 < 2; ++ks2) ai = __builtin_amdgcn_mfma_f32_16x16x32_bf16(lds_frag(Vt + (NV + fr) * CS_SLD + 32 * ks2 + 8 * fq), pf[ks2], ai, 0, 0, 0);
#pragma unroll
                for (int kk = 0; kk < 4; ++kk) ao = __builtin_amdgcn_mfma_f32_16x16x32_bf16(lds_frag(St + (NV + fr) * CS_QLD + 32 * kk + 8 * fq), qf[kk], ao, 0, 0, 0);
                const float den = __shfl(ai[0] + ao[0] * ebt, fr); rden = 1.f / fmaxf(fabsf(den), 1.f); }
#pragma unroll
            for (int vj = 0; vj < NVC / 2; ++vj) { const int vt = (NVC / 2) * (w & 1) + vj; f32x4 ai = (f32x4){0.f, 0.f, 0.f, 0.f}, ao = (f32x4){0.f, 0.f, 0.f, 0.f};
#pragma unroll
                for (int ks2 = 0; ks2 < 2; ++ks2) ai = __builtin_amdgcn_mfma_f32_16x16x32_bf16(lds_frag(Vt + (16 * vt + fr) * CS_SLD + 32 * ks2 + 8 * fq), pf[ks2], ai, 0, 0, 0);
#pragma unroll
                for (int kk = 0; kk < 4; ++kk) ao = __builtin_amdgcn_mfma_f32_16x16x32_bf16(lds_frag(St + (16 * vt + fr) * CS_QLD + 32 * kk + 8 * fq), qf[kk], ao, 0, 0, 0);
                u32x2 wv; wv.x = pk2((ai[0] + ao[0] * ebt) * rden, (ai[1] + ao[1] * ebt) * rden); wv.y = pk2((ai[2] + ao[2] * ebt) * rden, (ai[3] + ao[3] * ebt) * rden);
                *(u32x2*)(Y + (size_t)m * YLD + ycol0 + 16 * vt + 4 * fq) = wv; }
        }
        {
            f32x4 dec; if (MODE == 1) dec = *(LAS f32x4*)(TOT + 4 * 128 + 16 * w + 4 * fq); else { const float d = __expf(BV[63]); dec = (f32x4){d, d, d, d}; }
            bf16x8 kf[2];
#pragma unroll
            for (int ks2 = 0; ks2 < 2; ++ks2) kf[ks2] = lds_frag(Kt + (16 * w + fr) * CS_SLD + 32 * ks2 + 8 * fq);
#pragma unroll
            for (int vt = 0; vt < NVT; ++vt) { Sacc[vt] = Sacc[vt] * dec;
#pragma unroll
                for (int ks2 = 0; ks2 < 2; ++ks2) Sacc[vt] = __builtin_amdgcn_mfma_f32_16x16x32_bf16(kf[ks2], lds_frag(Vt + (16 * vt + fr) * CS_SLD + 32 * ks2 + 8 * fq), Sacc[vt], 0, 0, 0); }
        }
        __syncthreads();
#pragma unroll
        for (int vt = 0; vt < NVT; ++vt) { u32x2 wv; wv.x = pk2(Sacc[vt][0], Sacc[vt][1]); wv.y = pk2(Sacc[vt][2], Sacc[vt][3]); *(LAS u32x2*)(St + (16 * vt + fr) * CS_QLD + 16 * w + 4 * fq) = wv; }
    }
    if (s < 16) {
        float* o; int kstride; float sc = 1.f;
        if (MODE == 0) { o = P.out + O_SSD + ((size_t)((s * 2 + j) * 2 + dir) * 16 + h) * 8192; kstride = 64; }
        else { o = P.out + (MODE == 1 ? O_GLA : O_MC) + ((size_t)((s * 2 + j) * 2 + dir) * 4 + h) * 32768 + vs * NV; kstride = 256; }
        if (MODE == 2) { __syncthreads(); sc = __expf(-MS[0]); }
#pragma unroll
        for (int vt = 0; vt < NVC; ++vt)
#pragma unroll
            for (int e = 0; e < 4; ++e) o[(size_t)(16 * w + 4 * fq + e) * kstride + 16 * vt + fr] = Sacc[vt][e] * sc;
        if (MODE == 2 && vs == 0) {
            if (fr == 0) {
#pragma unroll
                for (int e = 0; e < 4; ++e) P.out[O_MN + ((size_t)((s * 2 + j) * 2 + dir) * 4 + h) * 128 + 16 * w + 4 * fq + e] = Sacc[NVT - 1][e] * sc; }
            if (tid == 0) P.out[O_MM + ((s * 2 + j) * 2 + dir) * 4 + h] = MS[0]; }
    }
}

struct RwOps { f32x4 kk0, kk1, w0, w1, kd0, kd1, ka0, ka1, r0, r1; f32x2 vv; };
__device__ __forceinline__ RwOps rw_ops(const LAS float* B, int tt, int kg, int vg) {
    const LAS float* p = B + tt * 64 + 4 * kg; RwOps o;
    o.kk0 = *(const LAS f32x4*)(p + 4096); o.kk1 = *(const LAS f32x4*)(p + 4096 + 32); o.w0 = *(const LAS f32x4*)(p + 1024); o.w1 = *(const LAS f32x4*)(p + 1024 + 32);
    o.kd0 = *(const LAS f32x4*)(p + 2048); o.kd1 = *(const LAS f32x4*)(p + 2048 + 32); o.ka0 = *(const LAS f32x4*)(p + 5120); o.ka1 = *(const LAS f32x4*)(p + 5120 + 32);
    o.r0 = *(const LAS f32x4*)(p); o.r1 = *(const LAS f32x4*)(p + 32); o.vv = *(const LAS f32x2*)(B + 3072 + tt * 64 + 2 * vg); return o;
}
__device__ __forceinline__ void rwkv_pair(const Params& P, const Ctx& C, int j, int bq, bool lng) {
    const int niter = lng ? 64 : 32; const bool act = !lng || C.tid < 256;
    const int tid = C.tid, half = tid >> 8, tl = tid & 255, kg = tl & 7, vg = tl >> 3;
    const bf16_t* PREP = (const bf16_t*)(P.ws + WS_PREP); const bf16_t* LOUT = (const bf16_t*)(P.ws + WS_PROJ);
    constexpr int BUFSZ = 6 * 1024;
    LAS float* L0 = (LAS float*)C.lds + half * 2 * BUFSZ;
    const int stt = tl >> 4, sc4 = (tl & 15) * 4;
    auto unit_of = [&](int cc, int& s, int& dir, int& h, int& lc) {
        if (lng) { s = 16 + (bq >> 5); dir = (bq >> 4) & 1; h = bq & 15; lc = cc; }
        else { const int q = 4 * bq + 2 * half + (cc >> 4); s = q >> 5; dir = (q >> 4) & 1; h = q & 15; lc = cc & 15; } };
    f32x2 S2[8];
    auto init_state = [&](int s, int dir, int h) {
        const float* s0 = s >= 16 ? P.in[I_SRWKV] + (((size_t)(((s - 16) * 2 + j) * 2 + dir) * 16 + h) * 64 + 2 * vg) * 64 : nullptr;
#pragma unroll
        for (int hh = 0; hh < 2; ++hh) { const f32x4 u0 = s0 ? *(const f32x4*)(s0 + 32 * hh + 4 * kg) : (f32x4){0.f, 0.f, 0.f, 0.f}, u1 = s0 ? *(const f32x4*)(s0 + 64 + 32 * hh + 4 * kg) : (f32x4){0.f, 0.f, 0.f, 0.f};
#pragma unroll
            for (int e = 0; e < 4; ++e) S2[hh * 4 + e] = (f32x2){u0[e], u1[e]}; } };
    u32x2 rr, rk, rv, rkk, rwl, ral; f32x4 cw0, ca0, cka;
    auto load_raw = [&](int cc) {
        int s, dir, h, lc; unit_of(cc, s, dir, h, lc);
        const int T = s < 16 ? 256 : 1024, base = s < 16 ? s * 256 : 4096 + (s - 16) * 1024;
        const int step = lc * 16 + stt; const int m = base + (dir ? (T - 1 - step) : step);
        const bf16_t* pp = PREP + (size_t)m * PREP_LD + h * 64 + sc4; const bf16_t* lo = LOUT + (size_t)m * LOUT_LD + dir * 1024 + h * 64 + sc4;
        rr = *(const u32x2*)(pp + 3072); rk = *(const u32x2*)(pp + 4096); rv = *(const u32x2*)(pp + 5120); rkk = *(const u32x2*)(pp + 6144);
        rwl = *(const u32x2*)lo; ral = *(const u32x2*)(lo + 2048);
        cw0 = *(const f32x4*)(P.in[I_W0] + (j * 2 + dir) * 1024 + h * 64 + sc4); ca0 = *(const f32x4*)(P.in[I_A0] + (j * 2 + dir) * 1024 + h * 64 + sc4); cka = *(const f32x4*)(P.in[I_KA] + j * 1024 + h * 64 + sc4);
    };
    auto write_lds = [&](LAS float* B) {
        const f32x4 r = unpack4(rr), k = unpack4(rk), v = unpack4(rv), kk = unpack4(rkk), wl = unpack4(rwl), al = unpack4(ral);
        f32x4 w, kd, kka;
#pragma unroll
        for (int e = 0; e < 4; ++e) { const float wp = cw0[e] + wl[e]; const float lw = -__expf(-softplusf_(-wp) - 0.5f); w[e] = __expf(lw);
            const float a = sigmoidf_(ca0[e] + al[e]); kd[e] = k[e] * (1.f + (a - 1.f) * cka[e]); kka[e] = kk[e] * a; }
        LAS float* p = B + stt * 64 + sc4;
        *(LAS f32x4*)(p) = r; *(LAS f32x4*)(p + 1024) = w; *(LAS f32x4*)(p + 2048) = kd; *(LAS f32x4*)(p + 3072) = v; *(LAS f32x4*)(p + 4096) = kk; *(LAS f32x4*)(p + 5120) = kka;
    };
    __syncthreads();
    if (act) { load_raw(0); write_lds(L0);
    { int s, dir, h, lc; unit_of(0, s, dir, h, lc); init_state(s, dir, h); } }
    __syncthreads();
#pragma unroll 1
    for (int cc = 0; cc < niter; ++cc) {
        if (act) {
        LAS float* B = L0 + (cc & 1) * BUFSZ;
        int s, dir, h, lc; unit_of(cc, s, dir, h, lc);
        const int T = s < 16 ? 256 : 1024, base = s < 16 ? s * 256 : 4096 + (s - 16) * 1024;
        if (cc + 1 < niter) load_raw(cc + 1);
        bf16_t* Y = (bf16_t*)(P.ws + WS_MP) + (size_t)dir * MTOK * YLD + 1024 + h * 64 + 2 * vg;
        RwOps cur = rw_ops(B, 0, kg, vg);
#pragma unroll 2
        for (int tt = 0; tt < 16; ++tt) {
            const RwOps nx = rw_ops(B, (tt + 1) & 15, kg, vg);
            const int step = lc * 16 + tt; const int m = base + (dir ? (T - 1 - step) : step);
            f32x2 da = (f32x2){0.f, 0.f}, db = (f32x2){0.f, 0.f};
#pragma unroll
            for (int e = 0; e < 4; ++e) { da = da + S2[e] * (f32x2){cur.kk0[e], cur.kk0[e]}; db = db + S2[4 + e] * (f32x2){cur.kk1[e], cur.kk1[e]}; }
            const f32x2 d2 = da + db;
            f32x2 sk2; sk2.x = row_sum8(d2.x); sk2.y = row_sum8(d2.y);
            f32x2 ya = (f32x2){0.f, 0.f}, yb = (f32x2){0.f, 0.f};
#pragma unroll
            for (int e = 0; e < 4; ++e) {
                S2[e] = S2[e] * (f32x2){cur.w0[e], cur.w0[e]} - sk2 * (f32x2){cur.ka0[e], cur.ka0[e]} + cur.vv * (f32x2){cur.kd0[e], cur.kd0[e]};
                S2[4 + e] = S2[4 + e] * (f32x2){cur.w1[e], cur.w1[e]} - sk2 * (f32x2){cur.ka1[e], cur.ka1[e]} + cur.vv * (f32x2){cur.kd1[e], cur.kd1[e]};
                ya = ya + S2[e] * (f32x2){cur.r0[e], cur.r0[e]}; yb = yb + S2[4 + e] * (f32x2){cur.r1[e], cur.r1[e]}; }
            const f32x2 y2 = ya + yb;
            const float y0 = row_sum8(y2.x), y1 = row_sum8(y2.y);
            if (kg == 0) *(unsigned*)(Y + (size_t)m * YLD) = pg8::cvt_pk_bf16(y0, y1);
            cur = nx;
        }
        const int nchU = lng ? 64 : 16;
        if (lc == nchU - 1 && s < 16) { float* o = P.out + O_RWKV + (((size_t)((s * 2 + j) * 2 + dir) * 16 + h) * 64 + 2 * vg) * 64;
#pragma unroll
            for (int hh = 0; hh < 2; ++hh) { *(f32x4*)(o + 32 * hh + 4 * kg) = (f32x4){S2[hh * 4].x, S2[hh * 4 + 1].x, S2[hh * 4 + 2].x, S2[hh * 4 + 3].x};
                *(f32x4*)(o + 64 + 32 * hh + 4 * kg) = (f32x4){S2[hh * 4].y, S2[hh * 4 + 1].y, S2[hh * 4 + 2].y, S2[hh * 4 + 3].y}; } }
        if (cc + 1 < niter) { write_lds(L0 + ((cc + 1) & 1) * BUFSZ);
            if (lc == nchU - 1) { int s2, d2_, h2, lc2; unit_of(cc + 1, s2, d2_, h2, lc2); init_state(s2, d2_, h2); } }
        }
        __syncthreads();
    }
}

__device__ __forceinline__ void scan_unit(const Params& P, const Ctx& C, int l, int type, int q) {
    const int j = l >> 1; const bool ev = (l & 1) == 0;
    if (ev) { int s, idx; if (q < 128) { s = 16 + (q >> 5); idx = q & 31; } else { const int r = q - 128; s = r >> 5; idx = r & 31; }
        chunk_scan<0>(P, C, j, s, idx >> 4, idx & 15, 0); }
    else { int s, idx; if (q < 64) { s = 16 + (q >> 4); idx = q & 15; } else { const int r = q - 64; s = r >> 4; idx = r & 15; }
        const int dir = idx >> 3, h = (idx >> 1) & 3, vs = idx & 1; if (type == 0) chunk_scan<1>(P, C, j, s, dir, h, vs); else chunk_scan<2>(P, C, j, s, dir, h, vs); }
}
__device__ __forceinline__ int queue_next(const Params& P, const Ctx& C, int l) {
    volatile LAS unsigned* qw = (volatile LAS unsigned*)(C.lds + LDS_BYTES - 16);
    __syncthreads();
    if (C.tid == 0) qw[3] = __hip_atomic_fetch_add((unsigned*)(P.ws + WS_CTL) + 6144 + 64 * l, 1u, __ATOMIC_RELAXED, __HIP_MEMORY_SCOPE_AGENT);
    __syncthreads();
    return __builtin_amdgcn_readfirstlane((int)qw[3]);
}
__device__ __forceinline__ void phase_scan(const Params& P, const Ctx& C0, int l) {
    const int G = C0.G, bid = C0.bid; const bool ev = (l & 1) == 0;
    if (ev) {
        if (G == 256) rwkv_pair(P, fresh_ctx(C0.lds), l >> 1, bid < 128 ? bid : bid - 128, bid < 128);
        else {
#pragma unroll 1
            for (int x = bid; x < 256; x += G) rwkv_pair(P, fresh_ctx(C0.lds), l >> 1, x < 128 ? x : x - 128, x < 128);
        }
#pragma unroll 1
        for (;;) { const Ctx C = fresh_ctx(C0.lds); const int x = queue_next(P, C, l); if (x >= 640) break; scan_unit(P, C, l, 0, x); }
        return;
    }
#pragma unroll 1
    for (;;) { const Ctx C = fresh_ctx(C0.lds); const int x = queue_next(P, C, l); if (x >= 640) break;
        int type, q; if (x < 128) { type = x >> 6; q = x & 63; } else { const int r = x - 128; type = r & 1; q = 64 + (r >> 1); }
        scan_unit(P, C, l, type, q); }
}

__device__ __forceinline__ void ld16(const bf16_t* p, float* o) { unpack8(*(const u32x4*)p, o); unpack8(*(const u32x4*)(p + 8), o + 8); }
__device__ __forceinline__ void ld16f(const float* p, float* o) {
#pragma unroll
    for (int q = 0; q < 4; ++q) { const f32x4 v = *(const f32x4*)(p + 4 * q); o[4 * q] = v.x; o[4 * q + 1] = v.y; o[4 * q + 2] = v.z; o[4 * q + 3] = v.w; } }
__device__ __forceinline__ void st16(bf16_t* p, const float* o) { *(u32x4*)p = pack8(o); *(u32x4*)(p + 8) = pack8(o + 8); }
struct R16 { u32x4 a, b; };
__device__ __forceinline__ R16 ldraw(const bf16_t* p) { R16 r; r.a = *(const u32x4*)p; r.b = *(const u32x4*)(p + 8); return r; }
__device__ __forceinline__ void cvt16(const R16& r, float* o) { unpack8(r.a, o); unpack8(r.b, o + 8); }
__device__ __forceinline__ void phase_post(const Params& P, const Ctx& C, int l) {
    const int j = l >> 1; const bool ev = (l & 1) == 0;
    const bf16_t* PROJ = (const bf16_t*)(P.ws + WS_PROJ); const bf16_t* PREP = (const bf16_t*)(P.ws + WS_PREP);
    const bf16_t* Y0 = (const bf16_t*)(P.ws + WS_MP); const bf16_t* Y1 = Y0 + (size_t)MTOK * YLD; bf16_t* MIX = (bf16_t*)(P.ws + WS_MIX);
    const int gw = C.bid * 8 + C.wave, NGW = C.G * 8, lane = C.lane, c0 = lane * 16;
#pragma unroll 1
    for (int m = gw; m < MTOK; m += NGW) {
        float ya[16], yb[16], t0[16], t1[16], o[16];
        if (ev) {
            const bf16_t* pp = PREP + (size_t)m * PREP_LD;
            const R16 rY0a = ldraw(Y0 + (size_t)m * YLD + c0), rY1a = ldraw(Y1 + (size_t)m * YLD + c0), rXS = ldraw(pp + c0), rSZ = ldraw(pp + 2048 + c0);
            const R16 rY0b = ldraw(Y0 + (size_t)m * YLD + 1024 + c0), rY1b = ldraw(Y1 + (size_t)m * YLD + 1024 + c0);
            const R16 rR = ldraw(pp + 3072 + c0), rK = ldraw(pp + 4096 + c0), rV = ldraw(pp + 5120 + c0), rG = ldraw(PROJ + (size_t)m * LOUT_LD + 4096 + c0);
            float pn[16], pw[16], pb[16], pk[16];
            ld16f(P.in[I_SSDN] + j * 1024 + c0, pn); ld16f(P.in[I_LNW] + j * 1024 + c0, pw); ld16f(P.in[I_LNB] + j * 1024 + c0, pb); ld16f(P.in[I_RK] + j * 1024 + c0, pk);
            cvt16(rY0a, ya); cvt16(rY1a, yb); cvt16(rXS, t0); cvt16(rSZ, t1);
            const float dsk = P.in[I_SSDD][j * 16 + (lane >> 2)]; float ss = 0.f;
#pragma unroll
            for (int e = 0; e < 16; ++e) { o[e] = (ya[e] + yb[e] + t0[e] * dsk) * t1[e]; ss += o[e] * o[e]; }
            const float rs = rsqrtf(wave_sum(ss) * (1.f / 1024.f) + 1e-6f);
#pragma unroll
            for (int e = 0; e < 16; ++e) o[e] = o[e] * rs * pn[e];
            st16(MIX + (size_t)m * 2048 + c0, o);
            cvt16(rY0b, ya); cvt16(rY1b, yb);
            float mu = 0.f;
#pragma unroll
            for (int e = 0; e < 16; ++e) { ya[e] += yb[e]; mu += ya[e]; }
            mu += __shfl_xor(mu, 1); mu += __shfl_xor(mu, 2); mu *= (1.f / 64.f);
            float var = 0.f;
#pragma unroll
            for (int e = 0; e < 16; ++e) { ya[e] -= mu; var += ya[e] * ya[e]; }
            var += __shfl_xor(var, 1); var += __shfl_xor(var, 2); var *= (1.f / 64.f);
            const float rstd = rsqrtf(var + 64e-5f);
#pragma unroll
            for (int e = 0; e < 16; ++e) o[e] = ya[e] * rstd * pw[e] + pb[e];
            cvt16(rR, ya); cvt16(rK, yb);
            float bs = 0.f;
#pragma unroll
            for (int e = 0; e < 16; ++e) bs += ya[e] * yb[e] * pk[e];
            bs += __shfl_xor(bs, 1); bs += __shfl_xor(bs, 2);
            cvt16(rV, ya); cvt16(rG, yb);
#pragma unroll
            for (int e = 0; e < 16; ++e) o[e] = (o[e] + bs * ya[e]) * yb[e];
            st16(MIX + (size_t)m * 2048 + 1024 + c0, o);
        } else {
            const bf16_t* pr = PROJ + (size_t)m * PROJ_LD_CD;
            const R16 rA0 = ldraw(Y0 + (size_t)m * YLD + c0), rB0 = ldraw(Y1 + (size_t)m * YLD + c0), rA1 = ldraw(Y0 + (size_t)m * YLD + 1024 + c0), rB1 = ldraw(Y1 + (size_t)m * YLD + 1024 + c0);
            const R16 rG0 = ldraw(pr + 2048 + c0), rG1 = ldraw(pr + IN_GLA + 2048 + c0);
            float pg[16], pm[16]; ld16f(P.in[I_GLAN] + j * 1024 + c0, pg); ld16f(P.in[I_MLN] + j * 1024 + c0, pm);
#pragma unroll
            for (int g = 0; g < 2; ++g) {
                cvt16(g == 0 ? rA0 : rA1, ya); cvt16(g == 0 ? rB0 : rB1, yb);
                float ss = 0.f;
#pragma unroll
                for (int e = 0; e < 16; ++e) { ya[e] += yb[e]; ss += ya[e] * ya[e]; }
                ss += __shfl_xor(ss, 1); ss += __shfl_xor(ss, 2); ss += __shfl_xor(ss, 4); ss += __shfl_xor(ss, 8);
                const float rs = rsqrtf(ss * (1.f / 256.f) + 1e-6f);
                cvt16(g == 0 ? rG0 : rG1, t1);
#pragma unroll
                for (int e = 0; e < 16; ++e) o[e] = ya[e] * rs * (g == 0 ? pg[e] : pm[e]) * (g == 0 ? siluf_(t1[e]) : sigmoidf_(t1[e]));
                st16(MIX + (size_t)m * 2048 + g * 1024 + c0, o);
            }
        }
    }
}

__global__ void __launch_bounds__(512, 2) hybrid_fwd(Params P) {
    extern __shared__ __attribute__((aligned(16))) unsigned char lds_raw[];
    cg::grid_group grid = cg::this_grid();
    Ctx C; C.lds = (LAS unsigned char*)lds_raw; C.tid = threadIdx.x; C.lane = C.tid & 63; C.wave = __builtin_amdgcn_readfirstlane(C.tid >> 6); C.G = gridDim.x; C.bid = blockIdx.x;
    const float* MOD = (const float*)(P.ws + WS_MOD);
    const bf16_t* H = (const bf16_t*)(P.ws + WS_H);
    if (C.tid < 4) ((volatile LAS unsigned*)(C.lds + LDS_BYTES - 16))[C.tid] = 0u;
    __syncthreads();
    const XcdBarrier xb = xcd_barrier_post((unsigned*)(P.ws + WS_CTL), (volatile LAS unsigned*)(C.lds + LDS_BYTES - 16));
    REP(1) if (PH & 1) phase_mod(P, fresh_ctx(C.lds));
    REP(2) if (PH & 2) phase_convert(P, fresh_ctx(C.lds), 0);
    grid.sync();
    if (PH & 4) phase_rows(P, fresh_ctx(C.lds), 0, nullptr, nullptr, true, P.in[I_NORMG] + 0, MOD + 0);
    GSYNC();
#pragma unroll 1
    for (int l = 0; l < 4; ++l) {
        const bool ev = (l & 1) == 0; const float* modl = MOD + (size_t)l * 5 * 6144; const float* ng = P.in[I_NORMG] + l * 4 * 1024;
        REP(8) if (PH & 8) { pg8::Gemm g{H, (const bf16_t*)(P.ws + WS_WIN), 1024, 1024, 1024}; pg8::Sched<0> S; S.init(MTOK, ev ? N_AB_P : N_CD_P, 1, 1024, C.G, C.bid);
          pg8::EpiBf16<0> E{(bf16_t*)(P.ws + WS_PROJ), ev ? PROJ_LD_AB : PROJ_LD_CD, 0}; pg8::gemm_phase(C.lds, g, S, E); }
        GSYNC();
        REP(16) if (PH & 16) { if (ev) phase_prep_even(P, fresh_ctx(C.lds), l >> 1); else phase_prep_odd(P, fresh_ctx(C.lds), l >> 1); }
        GSYNC();
        if (ev && (PH & 32)) {
            REP(32) {
            pg8::Gemm g{(const bf16_t*)(P.ws + WS_LORAA), (const bf16_t*)(P.ws + WS_WLORA), LORA_K, 128, 128}; pg8::Sched<1> S; S.init(MTOK, LOUT_LD, 1, 128, C.G, C.bid);
            pg8::EpiBf16<0> E{(bf16_t*)(P.ws + WS_PROJ), LOUT_LD, 0}; pg8::gemm_phase(C.lds, g, S, E); }
            GSYNC();
        }
        for (int rep_ = 0; rep_ < (((DUP & 64) && ev) || ((DUP & 0x4000) && !ev) ? 2 : 1); ++rep_) if (PH & 64) phase_scan(P, fresh_ctx(C.lds), l);
        GSYNC();
        REP(128) if (PH & 128) phase_post(P, fresh_ctx(C.lds), l);
        GSYNC();
        REP(256) if (PH & 256) { pg8::Gemm g{(const bf16_t*)(P.ws + WS_MIX), (const bf16_t*)(P.ws + WS_WOUT), 2048, 2048, 1024}; pg8::Sched<0> S; S.init(MTOK, 1024, 2, 1024, C.G, C.bid);
          pg8::EpiBf16<0> E{(bf16_t*)(P.ws + WS_MP), 1024, (size_t)MTOK * 1024}; pg8::gemm_phase(C.lds, g, S, E); }
        GSYNC();
        if (DUP & 512) phase_rows(P, fresh_ctx(C.lds), 1, ng + 1024, modl + 2048, true, ng + 2048, modl + 3072, true);
        if (PH & 512) phase_rows(P, fresh_ctx(C.lds), 1, ng + 1024, modl + 2048, true, ng + 2048, modl + 3072);
        GSYNC();
        REP(1024) if (PH & 1024) { pg8::Gemm g{H, (const bf16_t*)(P.ws + WS_WUP), 1024, 1024, 1024}; pg8::Sched<0> S; S.init(MTOK, 4096, 1, 1024, C.G, C.bid);
          pg8::EpiBf16<2> E{(bf16_t*)(P.ws + WS_PROJ), 4096, 0}; pg8::gemm_phase(C.lds, g, S, E); }
        GSYNC();
        REP(2048) if (PH & 2048) { pg8::Gemm g{(const bf16_t*)(P.ws + WS_PROJ), (const bf16_t*)(P.ws + WS_WDN), 4096, 4096, 2048}; pg8::Sched<0> S; S.init(MTOK, 1024, 2, 2048, C.G, C.bid);
          pg8::EpiBf16<0> E{(bf16_t*)(P.ws + WS_MP), 1024, (size_t)MTOK * 1024}; pg8::gemm_phase(C.lds, g, S, E); }
        GSYNC();
        if (DUP & 4096) phase_rows(P, fresh_ctx(C.lds), 1, ng + 3072, modl + 5120, true, ng + 2048, modl + 3072, true);
        if (PH & 4096) { if (l < 3) { phase_rows(P, fresh_ctx(C.lds), 1, ng + 3072, modl + 5120, true, ng + 4096, modl + 5 * 6144); phase_convert(P, fresh_ctx(C.lds), l + 1); }
        else phase_rows(P, fresh_ctx(C.lds), 1, ng + 3072, modl + 5120, false, nullptr, nullptr); }
        if (l < 3) GSYNC();
    }
}

extern "C" void kernel_launch(void* const* d_in, const int* in_sizes, int n_in, void* d_out, int out_size, void* d_ws, size_t ws_size, hipStream_t stream) {
    static int grid = 0;
    if (grid == 0) {
        if (n_in != 44 || ws_size < WS_END) { fprintf(stderr, "kernel_launch: unexpected n_in %d / ws %zu\n", n_in, ws_size); grid = -1; return; }
        int dev = 0, cus = 0, per_cu = 0;
        hipGetDevice(&dev); hipDeviceGetAttribute(&cus, hipDeviceAttributeMultiprocessorCount, dev);
        if (hipFuncSetAttribute((const void*)hybrid_fwd, hipFuncAttributeMaxDynamicSharedMemorySize, LDS_BYTES) != hipSuccess) { fprintf(stderr, "hipFuncSetAttribute failed\n"); grid = -1; return; }
        hipOccupancyMaxActiveBlocksPerMultiprocessor(&per_cu, (const void*)hybrid_fwd, 512, LDS_BYTES);
        (void)hipGetLastError();
        if (per_cu < 1) per_cu = 1;
        grid = cus * 1;
    }
    if (grid < 0) return;
    if (hipMemsetAsync((char*)d_ws + WS_CTL, 0, CTL_BYTES, stream) != hipSuccess) { fprintf(stderr, "memset failed\n"); return; }
    Params p{};
    for (int i = 0; i < 44; ++i) p.in[i] = (const float*)d_in[i];
    p.out = (float*)d_out; p.ws = (unsigned char*)d_ws;
    void* args[] = {&p};
    hipError_t e = hipLaunchCooperativeKernel((const void*)hybrid_fwd, dim3(grid), dim3(512), args, LDS_BYTES, stream);
    if (e != hipSuccess) fprintf(stderr, "cooperative launch failed: %s (grid %d)\n", hipGetErrorString(e), grid);
}
```

```cpp
#include <hip/hip_runtime.h>
#include <hip/hip_cooperative_groups.h>
#include <cstdio>
#include <cstdint>
namespace cg = cooperative_groups;

#define LAS __attribute__((address_space(3)))
typedef unsigned short bf16_t;
typedef short bf16x8 __attribute__((ext_vector_type(8)));
typedef float f32x4 __attribute__((ext_vector_type(4)));
typedef float f32x2 __attribute__((ext_vector_type(2)));
typedef unsigned u32x4 __attribute__((ext_vector_type(4)));
typedef unsigned u32x2 __attribute__((ext_vector_type(2)));

constexpr int MTOK = 8192, DM = 1024, DFF = 4096;
constexpr int N_AB = 6560, N_AB_P = 6656, N_CD = 6192, N_CD_P = 6400;
constexpr int PROJ_LD_AB = N_AB_P, PROJ_LD_CD = N_CD_P;
constexpr int PREP_LD = 7168, LOUT_LD = 5120, LORA_K = 384, YLD = 2048;
constexpr int IN_SSD = 3104, IN_GLA = 3104;
constexpr size_t MiB = 1u << 20;
constexpr size_t WS_MOD = 0, WS_CTL = 512 * 1024, CTL_BYTES = 32768, WS_DT = 1 * MiB, WS_DA = 3 * MiB, WS_WIN = 5 * MiB, WS_WOUT = 19 * MiB, WS_WUP = 23 * MiB, WS_WDN = 31 * MiB,
                 WS_WLORA = 39 * MiB, WS_H = 41 * MiB, WS_PROJ = 57 * MiB, WS_PREP = 161 * MiB, WS_MIX = 273 * MiB, WS_MP = 305 * MiB,
                 WS_LORAA = 369 * MiB, WS_END = 375 * MiB;
constexpr size_t O_X = 0, O_SSD = 8388608, O_RWKV = 16777216, O_GLA = 20971520, O_MC = 29360128, O_MN = 37748736, O_MM = 37781504;

struct Params { const float* in[44]; float* out; unsigned char* ws; };
enum { I_XP = 0, I_XS, I_SSSD, I_SRWKV, I_SGLA, I_SMC, I_SMN, I_SMM, I_C, I_CCTX, I_WMOD, I_BMOD, I_NORMG, I_WUP, I_WDN, I_WINAB, I_SCONVW, I_SCONVB,
       I_DTB, I_ALOG, I_SSDD, I_SSDN, I_MU, I_W0, I_W2, I_A0, I_A2, I_G2, I_KK, I_KA, I_RK, I_LNW, I_LNB, I_WOUTAB, I_WINCD, I_GGW, I_GGB, I_GLAN,
       I_MCONVW, I_MCONVB, I_MIB, I_MFB, I_MLN, I_WOUTCD };

__device__ __forceinline__ float bf2f(unsigned b) { return __uint_as_float(b << 16); }
__device__ __forceinline__ unsigned f2bf(float f) { unsigned u = __float_as_uint(f); return (u + 0x7fffu + ((u >> 16) & 1u)) >> 16; }
typedef __bf16 bf16x2_hw __attribute__((ext_vector_type(2)));
__device__ __forceinline__ unsigned pk2(float lo, float hi) { const f32x2 v = {lo, hi}; const bf16x2_hw b = __builtin_convertvector(v, bf16x2_hw); return __builtin_bit_cast(unsigned, b); }
__device__ __forceinline__ float lo16(unsigned w) { return __uint_as_float(w << 16); }
__device__ __forceinline__ float hi16(unsigned w) { return __uint_as_float(w & 0xffff0000u); }
__device__ __forceinline__ void unpack8(u32x4 w, float* o) { o[0] = lo16(w.x); o[1] = hi16(w.x); o[2] = lo16(w.y); o[3] = hi16(w.y); o[4] = lo16(w.z); o[5] = hi16(w.z); o[6] = lo16(w.w); o[7] = hi16(w.w); }
__device__ __forceinline__ f32x4 unpack4(u32x2 w) { return (f32x4){lo16(w.x), hi16(w.x), lo16(w.y), hi16(w.y)}; }
__device__ __forceinline__ u32x4 pack8(const float* o) { u32x4 w; w.x = pk2(o[0], o[1]); w.y = pk2(o[2], o[3]); w.z = pk2(o[4], o[5]); w.w = pk2(o[6], o[7]); return w; }
__device__ __forceinline__ float sigmoidf_(float x) { return 1.f / (1.f + __expf(-x)); }
__device__ __forceinline__ float siluf_(float x) { return x / (1.f + __expf(-x)); }
__device__ __forceinline__ float softplusf_(float x) { return fmaxf(x, 0.f) + __logf(1.f + __expf(-fabsf(x))); }
__device__ __forceinline__ float logsigmoidf_(float x) { return fminf(x, 0.f) - __logf(1.f + __expf(-fabsf(x))); }
__device__ __forceinline__ float tanhf_(float x) { const float e = __expf(-2.f * fabsf(x)); const float r = (1.f - e) / (1.f + e); return x < 0.f ? -r : r; }
__device__ __forceinline__ float wave_sum(float v) {
#pragma unroll
    for (int o = 1; o < 64; o <<= 1) v += __shfl_xor(v, o);
    return v;
}
__device__ __forceinline__ float quad_sum(float x) {
    x += __int_as_float(__builtin_amdgcn_update_dpp(0, __float_as_int(x), 0xB1, 0xF, 0xF, true));
    x += __int_as_float(__builtin_amdgcn_update_dpp(0, __float_as_int(x), 0x4E, 0xF, 0xF, true));
    return x;
}

#define DPP_ADD(x, ctrl) ((x) + __int_as_float(__builtin_amdgcn_update_dpp(0, __float_as_int(x), (ctrl), 0xF, 0xF, true)))
__device__ __forceinline__ float row_sum8(float x) { x = DPP_ADD(x, 0xB1); x = DPP_ADD(x, 0x4E); x = DPP_ADD(x, 0x141); return x; }
__device__ __forceinline__ float row_sum16(float x) { x = row_sum8(x); x = DPP_ADD(x, 0x140); return x; }
namespace pg8 {
constexpr int BM = 256, BK = 64, HALF = 128, HTB = HALF * BK * 2, STAGE_BYTES = 8 * HTB, NXCD = 8, WGM = 8;
__host__ __device__ __forceinline__ int lds_byte(int r, int c) { const int st = (r >> 4) * 2 + (c >> 5), rr = r & 15, cc = c & 31, ob = rr * 64 + cc * 2; return st * 1024 + (ob ^ (((ob >> 9) & 1) << 5)); }
__host__ __device__ __forceinline__ void stage_rc(int b, int& R, int& C) { const int st = b / 1024, sb = b % 1024, swz = sb ^ (((sb >> 9) & 1) << 5); R = (st >> 1) * 16 + swz / 64; C = (st & 1) * 32 + (swz % 64) / 2; }
__host__ __device__ __forceinline__ int perm32(int rho) { const int n = rho >> 4, i = rho & 15; return 8 * (i >> 2) + 4 * n + (i & 3); }

struct Unit { int pm, pn, ks; };
struct Gemm { const bf16_t* A; const bf16_t* Bt; int lda, ldb, K; };
template <int mode> struct Sched {
    int nM, nN, nNv, nwg, G, c, K;
    __device__ void init(int M, int N, int nK, int K_, int G_, int c_) { nM = M / BM; nN = N / BM; nNv = nN * nK; nwg = nM * nNv; G = G_; c = c_; K = K_; }
    __device__ bool next(int i, Unit& u) const {
        const long L = (long)i * G + c; if (L >= nwg) return false;
        int wgid = (int)L; { const int q = nwg / NXCD, r = nwg % NXCD, xcd = wgid % NXCD, off = wgid / NXCD; wgid = (xcd < r ? xcd * (q + 1) : r * (q + 1) + (xcd - r) * q) + off; }
        const int nig = WGM * nNv, gid = wgid / nig, fm = gid * WGM, gsz = (nM - fm) < WGM ? (nM - fm) : WGM;
        u.pm = fm + ((wgid % nig) % gsz); const int pnv = (wgid % nig) / gsz; u.pn = pnv % nN; u.ks = pnv / nN; return true;
    }
    __device__ __forceinline__ size_t aoff(const Unit& u) const { if (mode == 1) { const int g = u.pn >> 2; return (size_t)(g < 2 ? 0 : (g < 4 ? 128 : 256)) * 2; } return (size_t)u.ks * K * 2; }
    __device__ __forceinline__ size_t boff(const Unit& u) const { return mode == 1 ? 0 : (size_t)u.ks * K * 2; }
};

__device__ __forceinline__ unsigned cvt_pk_bf16(float lo, float hi) { unsigned r; asm volatile("v_cvt_pk_bf16_f32 %0, %1, %2" : "=v"(r) : "v"(lo), "v"(hi)); return r; }

template <int ACT> struct EpiBf16 {
    static constexpr bool PERM = true;
    bf16_t* O; int ldc; size_t pstride;
    __device__ __forceinline__ void operator()(const f32x4 (&acc)[2][2][4][2], const Unit& u, int wr, int wc, int fr, int fq) const {
        const int row0 = u.pm * BM + wr * 64 + fr; const int col0 = u.pn * BM + wc * 32 + 8 * fq; bf16_t* Ob = O + (size_t)u.ks * pstride;
#pragma unroll
        for (int ai = 0; ai < 2; ++ai)
#pragma unroll
            for (int m = 0; m < 4; ++m) { bf16_t* rowp = Ob + (size_t)(row0 + ai * HALF + m * 16) * ldc + col0;
#pragma unroll
                for (int bj = 0; bj < 2; ++bj) { f32x4 v0 = acc[ai][bj][m][0], v1 = acc[ai][bj][m][1];
                    if (ACT == 2) {
#pragma unroll
                        for (int e = 0; e < 4; ++e) { const float a = fmaxf(v0[e], 0.f), b = fmaxf(v1[e], 0.f); v0[e] = a * a; v1[e] = b * b; } }
                    u32x4 w; w.x = cvt_pk_bf16(v0[0], v0[1]); w.y = cvt_pk_bf16(v0[2], v0[3]); w.z = cvt_pk_bf16(v1[0], v1[1]); w.w = cvt_pk_bf16(v1[2], v1[3]);
                    *(u32x4*)(rowp + bj * HALF) = w; } }
    }
};
struct EpiF32 {
    static constexpr bool PERM = false;
    float* O; int ldc; size_t pstride;
    __device__ __forceinline__ void operator()(const f32x4 (&acc)[2][2][4][2], const Unit& u, int wr, int wc, int fr, int fq) const {
        float* base = O + (size_t)u.ks * pstride; const int col0 = u.pn * BM + wc * 32 + 4 * fq;
#pragma unroll
        for (int ai = 0; ai < 2; ++ai)
#pragma unroll
            for (int m = 0; m < 4; ++m) { float* rowp = base + (size_t)(u.pm * BM + ai * HALF + wr * 64 + m * 16 + fr) * ldc + col0;
#pragma unroll
                for (int bj = 0; bj < 2; ++bj)
#pragma unroll
                    for (int n = 0; n < 2; ++n) *(f32x4*)(rowp + bj * HALF + n * 16) = acc[ai][bj][m][n]; }
    }
};

template <class Epi, class SchedT>
__device__ __forceinline__ void gemm_phase(LAS unsigned char* lds, const Gemm g, const SchedT& S, const Epi& E) {
    int tid_ = threadIdx.x; asm volatile("" : "+v"(tid_));
    const int tid = tid_, wid = __builtin_amdgcn_readfirstlane(tid >> 6), lane = tid & 63, wr = wid >> 2, wc = wid & 3, fr = lane & 15, fq = lane >> 4;
    int K_ = g.K; asm volatile("" : "+s"(K_));
    const int K = K_, nt = K / BK;
    unsigned voffA[2], voffB[2];
#pragma unroll
    for (int i = 0; i < 2; ++i) { int R, C; stage_rc(tid * 16 + i * 8192, R, C); const int Rb = Epi::PERM ? ((R & ~31) + perm32(R & 31)) : R;
        voffA[i] = (unsigned)(R * g.lda + C) * 2u; voffB[i] = (unsigned)(Rb * g.ldb + C) * 2u; }
    const size_t kstep = (size_t)(BK * 2);
    const size_t hstepA = (size_t)HALF * g.lda * 2, hstepB = (size_t)HALF * g.ldb * 2;
    const size_t tstepA = 2 * hstepA, tstepB = 2 * hstepB;
    const unsigned ldsw = (unsigned)wid * 1024u;
    const int aoff = lds_byte(wr * 64 + fr, fq * 8), boff = lds_byte(wc * 32 + fr, fq * 8);
#define PG8_SA(b, h) (((b) * 2 + (h)) * HTB)
#define PG8_SB(b, h) ((4 + (b) * 2 + (h)) * HTB)
#define PG8_STAGE(bufoff, gbase, voff) do { _Pragma("unroll") for (int _i = 0; _i < 2; ++_i) \
        __builtin_amdgcn_global_load_lds((const unsigned*)((const char*)(gbase) + (voff)[_i]), (LAS unsigned*)(lds + (bufoff) + ldsw + _i * 8192), 16, 0, 0); } while (0)
#define PG8_LDA(dst, b, h) do { _Pragma("unroll") for (int m = 0; m < 4; ++m) _Pragma("unroll") for (int k = 0; k < 2; ++k) dst[m][k] = *(const LAS bf16x8*)(lds + PG8_SA(b, h) + aoff + m * 2048 + k * 1024); } while (0)
#define PG8_LDB(dst, b, h) do { _Pragma("unroll") for (int n = 0; n < 2; ++n) _Pragma("unroll") for (int k = 0; k < 2; ++k) dst[n][k] = *(const LAS bf16x8*)(lds + PG8_SB(b, h) + boff + n * 2048 + k * 1024); } while (0)
#define PG8_MMA(ai, bj, At, Bt) do { __builtin_amdgcn_s_setprio(1); _Pragma("unroll") for (int m = 0; m < 4; ++m) _Pragma("unroll") for (int n = 0; n < 2; ++n) _Pragma("unroll") for (int k = 0; k < 2; ++k) \
        acc[ai][bj][m][n] = __builtin_amdgcn_mfma_f32_16x16x32_bf16(Bt[n][k], At[m][k], acc[ai][bj][m][n], 0, 0, 0); __builtin_amdgcn_s_setprio(0); } while (0)
#define PG8_WAIT_V(n) asm volatile("s_waitcnt vmcnt(" #n ")" ::: "memory")
#define PG8_WAIT_L(n) asm volatile("s_waitcnt lgkmcnt(" #n ")" ::: "memory")
#define PG8_BAR __builtin_amdgcn_s_barrier()
#define PG8_SCHED __builtin_amdgcn_sched_barrier(0)
    Unit cur, nxt; int ui = 0;
    if (!S.next(0, cur)) return;
    f32x4 acc[2][2][4][2];
#pragma unroll
    for (int a = 0; a < 2; ++a)
#pragma unroll
        for (int b = 0; b < 2; ++b)
#pragma unroll
            for (int m = 0; m < 4; ++m)
#pragma unroll
                for (int n = 0; n < 2; ++n) acc[a][b][m][n] = (f32x4){0.f, 0.f, 0.f, 0.f};
    bf16x8 At[4][2], B0[2][2], B1[2][2];
    const char* cA = (const char*)g.A + (size_t)cur.pm * tstepA + S.aoff(cur); const char* cB = (const char*)g.Bt + (size_t)cur.pn * tstepB + S.boff(cur);
    PG8_STAGE(PG8_SB(0, 0), cB, voffB); PG8_STAGE(PG8_SB(0, 1), cB + hstepB, voffB); PG8_STAGE(PG8_SA(0, 0), cA, voffA); PG8_STAGE(PG8_SA(0, 1), cA + hstepA, voffA);
    if (wr == 1) PG8_BAR;
    PG8_WAIT_V(2); PG8_BAR;
    PG8_STAGE(PG8_SB(1, 0), cB + kstep, voffB); PG8_STAGE(PG8_SA(1, 0), cA + kstep, voffA); PG8_STAGE(PG8_SB(1, 1), cB + hstepB + kstep, voffB);
    PG8_WAIT_V(6); PG8_BAR;
    for (;;) {
        const bool has_next = S.next(ui + 1, nxt);
        const char* nA = has_next ? (const char*)g.A + (size_t)nxt.pm * tstepA + S.aoff(nxt) : cA; const char* nB = has_next ? (const char*)g.Bt + (size_t)nxt.pn * tstepB + S.boff(nxt) : cB;
        for (int t = 0; t < nt; t += 2) {
            const bool last = (t == nt - 2);
            const char* a1 = cA + (size_t)(t + 1) * kstep;
            const char* a2 = last ? nA : cA + (size_t)(t + 2) * kstep; const char* b2 = last ? nB : cB + (size_t)(t + 2) * kstep;
            const char* a3 = a2 + kstep; const char* b3 = b2 + kstep;
            PG8_LDB(B0, 0, 0); PG8_LDB(B1, 0, 1); PG8_SCHED; PG8_LDA(At, 0, 0); PG8_STAGE(PG8_SA(1, 1), a1 + hstepA, voffA);
            PG8_WAIT_V(8); PG8_WAIT_L(0); PG8_BAR; PG8_MMA(0, 0, At, B0); PG8_MMA(0, 1, At, B1); PG8_BAR; PG8_SCHED;
            PG8_LDA(At, 0, 1); PG8_STAGE(PG8_SB(0, 0), b2, voffB); PG8_STAGE(PG8_SB(0, 1), b2 + hstepB, voffB); PG8_STAGE(PG8_SA(0, 0), a2, voffA);
            PG8_WAIT_V(8); PG8_WAIT_L(0); PG8_BAR; PG8_MMA(1, 0, At, B0); PG8_MMA(1, 1, At, B1); PG8_BAR; PG8_SCHED;
            PG8_LDB(B0, 1, 0); PG8_LDB(B1, 1, 1); PG8_SCHED; PG8_LDA(At, 1, 0); PG8_STAGE(PG8_SA(0, 1), a2 + hstepA, voffA);
            PG8_WAIT_V(8); PG8_WAIT_L(0); PG8_BAR; PG8_MMA(0, 0, At, B0); PG8_MMA(0, 1, At, B1); PG8_BAR; PG8_SCHED;
            PG8_LDA(At, 1, 1); PG8_STAGE(PG8_SB(1, 0), b3, voffB); PG8_STAGE(PG8_SB(1, 1), b3 + hstepB, voffB); PG8_STAGE(PG8_SA(1, 0), a3, voffA);
            PG8_WAIT_V(8); PG8_WAIT_L(0); PG8_BAR; PG8_MMA(1, 0, At, B0); PG8_MMA(1, 1, At, B1); PG8_BAR; PG8_SCHED;
        }
        if (wr == 0) PG8_BAR;
        E(acc, cur, wr, wc, fr, fq);
        if (!has_next) break;
#pragma unroll
        for (int a = 0; a < 2; ++a)
#pragma unroll
            for (int b = 0; b < 2; ++b)
#pragma unroll
                for (int m = 0; m < 4; ++m)
#pragma unroll
                    for (int n = 0; n < 2; ++n) acc[a][b][m][n] = (f32x4){0.f, 0.f, 0.f, 0.f};
        cur = nxt; cA = nA; cB = nB; ++ui;
        if (wr == 1) PG8_BAR;
    }
    PG8_WAIT_V(0);
    PG8_BAR;
#undef PG8_SA
#undef PG8_SB
#undef PG8_STAGE
#undef PG8_LDA
#undef PG8_LDB
#undef PG8_MMA
#undef PG8_WAIT_V
#undef PG8_WAIT_L
#undef PG8_BAR
#undef PG8_SCHED
}
}

#define XB_TMO      128
#define XB_XCNT(j)  (256  + 64 * (j))
#define XB_XSUB(j)  (1280 + 64 * (j))
#define XB_XGEN(j)  (2304 + 64 * (j))
#define XB_TOP      3328
#define XB_TOPGEN   3392
#define XCD_BAR_WORDS 3456
#define XB_SPIN_CAP (1u << 18)
__device__ __forceinline__ unsigned xb_ld(unsigned* p)              { return __hip_atomic_load(p, __ATOMIC_RELAXED, __HIP_MEMORY_SCOPE_AGENT); }
__device__ __forceinline__ unsigned xb_add(unsigned* p, unsigned v) { return __hip_atomic_fetch_add(p, v, __ATOMIC_RELAXED, __HIP_MEMORY_SCOPE_AGENT); }
__device__ __forceinline__ unsigned xb_xcc_id() { return (unsigned)__builtin_amdgcn_s_getreg((3 << 11) | 20) & 0xFu; }
#define XB_SPIN(cond, bar) do { unsigned _sp = 0; while (cond) { __builtin_amdgcn_s_sleep(1); \
    if ((++_sp & 255u) == 0u) { if (xb_ld(&(bar)[XB_TMO])) break; if (_sp > XB_SPIN_CAP) { atomicAdd(&(bar)[XB_TMO], 1u); break; } } } } while (0)
struct XcdBarrier { unsigned* bar; unsigned x; volatile LAS unsigned* st; };
__device__ __forceinline__ XcdBarrier xcd_barrier_post(unsigned* bar, volatile LAS unsigned* st) {
    XcdBarrier b; b.bar = bar; b.x = xb_xcc_id(); b.st = st;
    if (threadIdx.x == 0) (void)xb_add(&bar[XB_XCNT(b.x)], 1u);
    return b;
}
__device__ __forceinline__ void xcd_barrier_complete(unsigned* bar, unsigned x, unsigned& nloc, unsigned& nx) {
    const unsigned G = gridDim.x * gridDim.y * gridDim.z;
    unsigned sum, cnt, mine, sp = 0u;
    for (;;) {
        sum = 0u; cnt = 0u; mine = 0u;
#pragma unroll
        for (unsigned j = 0; j < 16; ++j) { const unsigned c = xb_ld(&bar[XB_XCNT(j)]); sum += c; cnt += (c > 0u) ? 1u : 0u; mine = (j == x) ? c : mine; }
        if (sum == G) break;
        __builtin_amdgcn_s_sleep(1);
        if ((++sp & 255u) == 0u) { if (xb_ld(&bar[XB_TMO])) break; if (sp > XB_SPIN_CAP) { atomicAdd(&bar[XB_TMO], 1u); break; } }
    }
    nloc = mine > 0u ? mine : 1u; nx = cnt > 0u ? cnt : 1u;
}
__device__ __forceinline__ void xcd_barrier(const XcdBarrier& b) {
    asm volatile("s_waitcnt vmcnt(0)" ::: "memory");
    __syncthreads();
    if (threadIdx.x == 0) {
        unsigned* bar = b.bar;
        __builtin_amdgcn_s_waitcnt(0);
        unsigned nloc = b.st[0], nx = b.st[1];
        if (nloc == 0u) { xcd_barrier_complete(bar, b.x, nloc, nx); b.st[0] = nloc; b.st[1] = nx; }
        const unsigned old = xb_add(&bar[XB_XSUB(b.x)], 1u);
        const unsigned gen = old / nloc;
        if (old + 1u == (gen + 1u) * nloc) {
            __builtin_amdgcn_fence(__ATOMIC_RELEASE, "agent");
            asm volatile("s_waitcnt vmcnt(0)" ::: "memory");
            const unsigned og = xb_add(&bar[XB_TOP], 1u);
            const unsigned tg = og / nx;
            if (og + 1u == (tg + 1u) * nx) xb_add(&bar[XB_TOPGEN], 1u);
            else XB_SPIN(xb_ld(&bar[XB_TOPGEN]) == tg, bar);
            __builtin_amdgcn_fence(__ATOMIC_ACQUIRE, "agent");
            xb_add(&bar[XB_XGEN(b.x)], 1u);
            asm volatile("s_waitcnt vmcnt(0)" ::: "memory");
        } else {
            XB_SPIN(xb_ld(&bar[XB_XGEN(b.x)]) == gen, bar);
            __builtin_amdgcn_fence(__ATOMIC_ACQUIRE, "agent");
            asm volatile("s_waitcnt vmcnt(0)" ::: "memory");
        }
    }
    __syncthreads();
}

constexpr int LDS_BYTES = 147456;
#ifndef PH
#define PH 0xFFFF
#endif
#ifndef DUP
#define DUP 0
#endif
#define GSYNC() do { xcd_barrier(xb); if (DUP & 0x8000) { xcd_barrier(xb); xcd_barrier(xb); } } while (0)
#define REP(bit) for (int rep_ = 0; rep_ < ((DUP & (bit)) ? 2 : 1); ++rep_)
struct Ctx { LAS unsigned char* lds; int tid, lane, wave, G, bid; };
__device__ __forceinline__ Ctx fresh_ctx(LAS unsigned char* lds) { Ctx C; int t = threadIdx.x; asm volatile("" : "+v"(t)); C.lds = lds; C.tid = t; C.lane = t & 63; C.wave = __builtin_amdgcn_readfirstlane(t >> 6); C.G = gridDim.x; C.bid = blockIdx.x; return C; }

__device__ __forceinline__ void phase_mod(const Params& P, const Ctx& C) {
    LAS float* sc = (LAS float*)C.lds; LAS float* red = sc + 5120;
    for (int i = C.tid; i < 5120; i += 512) { const int r = i >> 10, k = i & 1023; const float x = r == 0 ? P.in[I_CCTX][k] : P.in[I_C][(r - 1) * 1024 + k]; sc[i] = siluf_(x); }
    __syncthreads();
    float* MOD = (float*)(P.ws + WS_MOD);
    const int kg = C.tid >> 5, c = C.tid & 31;
    for (int tile = C.bid; tile < 768; tile += C.G) {
        const int l = tile / 192, col = (tile % 192) * 32 + c;
        const float* w = P.in[I_WMOD] + (size_t)l * 1024 * 6144 + col;
        float a0 = 0.f, a1 = 0.f, a2 = 0.f, a3 = 0.f, a4 = 0.f;
#pragma unroll 32
        for (int k = kg * 64; k < kg * 64 + 64; ++k) { const float wv = w[(size_t)k * 6144]; a0 += sc[k] * wv; a1 += sc[1024 + k] * wv; a2 += sc[2048 + k] * wv; a3 += sc[3072 + k] * wv; a4 += sc[4096 + k] * wv; }
        red[(kg * 5 + 0) * 32 + c] = a0; red[(kg * 5 + 1) * 32 + c] = a1; red[(kg * 5 + 2) * 32 + c] = a2; red[(kg * 5 + 3) * 32 + c] = a3; red[(kg * 5 + 4) * 32 + c] = a4;
        __syncthreads();
        if (C.tid < 160) { const int r = C.tid >> 5; float s = 0.f;
#pragma unroll
            for (int q = 0; q < 16; ++q) s += red[(q * 5 + r) * 32 + c];
            MOD[(size_t)(l * 5 + r) * 6144 + col] = s + P.in[I_BMOD][l * 6144 + col]; }
        __syncthreads();
    }
}

__device__ __forceinline__ void transpose_item(const float* W, int K, int N, bf16_t* WT, LAS float* scr, int item, int nblk, int lane) {
    const int kb = item / nblk, nb = item % nblk, k0 = 64 * kb, n0 = 32 * nb;
    const bool nok = (n0 + (lane & 31)) < N;
#pragma unroll
    for (int i = 0; i < 32; ++i) { const int kk = 2 * i + (lane >> 5); scr[kk * 33 + (lane & 31)] = nok ? W[(size_t)(k0 + kk) * N + n0 + (lane & 31)] : 0.f; }
    asm volatile("s_waitcnt lgkmcnt(0)" ::: "memory");
    const int c = lane & 7;
#pragma unroll
    for (int j = 0; j < 4; ++j) { const int n = (lane >> 3) + 8 * j; const LAS float* s = scr + (8 * c) * 33 + n;
        u32x4 o; o.x = pk2(s[0 * 33], s[1 * 33]); o.y = pk2(s[2 * 33], s[3 * 33]); o.z = pk2(s[4 * 33], s[5 * 33]); o.w = pk2(s[6 * 33], s[7 * 33]);
        *(u32x4*)(WT + (size_t)(n0 + n) * K + k0 + 8 * c) = o; }
    asm volatile("s_waitcnt lgkmcnt(0)" ::: "memory");
}
__device__ __forceinline__ void phase_convert(const Params& P, const Ctx& C, int l) {
    LAS float* scr = (LAS float*)(C.lds + 32768 + C.wave * 8704);
    const int gw = C.bid * 8 + C.wave, NGW = C.G * 8; const int j = l >> 1; const bool ev = (l & 1) == 0;
    const float* win = ev ? P.in[I_WINAB] + (size_t)j * 1024 * N_AB : P.in[I_WINCD] + (size_t)j * 1024 * N_CD;
    const float* wout = (ev ? P.in[I_WOUTAB] : P.in[I_WOUTCD]) + (size_t)j * 2048 * 1024;
    const float* wup = P.in[I_WUP] + (size_t)l * 1024 * 4096; const float* wdn = P.in[I_WDN] + (size_t)l * 4096 * 1024;
    const int N_in = ev ? N_AB : N_CD, Np = ev ? N_AB_P : N_CD_P;
    const int I0 = 16 * (Np / 32), I1 = 32 * 32, I2 = 16 * 128, I3 = 64 * 32;
    const int NI = I0 + I1 + I2 + I3; const int lane = C.lane;
    struct Desc { const float* W; bf16_t* WT; int K, N, k0, n0; };
    auto desc = [&](int it) { Desc d; int r = it, nblk;
        if (r < I0) { d.W = win; d.K = 1024; d.N = N_in; d.WT = (bf16_t*)(P.ws + WS_WIN); nblk = Np / 32; }
        else if ((r -= I0) < I1) { d.W = wout; d.K = 2048; d.N = 1024; d.WT = (bf16_t*)(P.ws + WS_WOUT); nblk = 32; }
        else if ((r -= I1) < I2) { d.W = wup; d.K = 1024; d.N = 4096; d.WT = (bf16_t*)(P.ws + WS_WUP); nblk = 128; }
        else { r -= I2; d.W = wdn; d.K = 4096; d.N = 1024; d.WT = (bf16_t*)(P.ws + WS_WDN); nblk = 32; }
        d.k0 = 64 * (r / nblk); d.n0 = 32 * (r % nblk); return d; };
    float v[32];
#define CV_LOAD(d) do { const bool nok_ = ((d).n0 + (lane & 31)) < (d).N; _Pragma("unroll") for (int i = 0; i < 32; ++i) { const int kk = 2 * i + (lane >> 5); \
        v[i] = nok_ ? (d).W[(size_t)((d).k0 + kk) * (d).N + (d).n0 + (lane & 31)] : 0.f; } } while (0)
    int it = gw; Desc d = desc(it < NI ? it : 0);
    if (it < NI) CV_LOAD(d);
    while (it < NI) {
#pragma unroll
        for (int i = 0; i < 32; ++i) { const int kk = 2 * i + (lane >> 5); scr[kk * 33 + (lane & 31)] = v[i]; }
        asm volatile("s_waitcnt lgkmcnt(0)" ::: "memory");
        const int nit = it + NGW; Desc dn = desc(nit < NI ? nit : 0);
        if (nit < NI) CV_LOAD(dn);
        const int c = lane & 7;
#pragma unroll
        for (int jq = 0; jq < 4; ++jq) { const int n = (lane >> 3) + 8 * jq; const LAS float* sp = scr + (8 * c) * 33 + n;
            u32x4 o; o.x = pk2(sp[0 * 33], sp[1 * 33]); o.y = pk2(sp[2 * 33], sp[3 * 33]); o.z = pk2(sp[4 * 33], sp[5 * 33]); o.w = pk2(sp[6 * 33], sp[7 * 33]);
            *(u32x4*)(d.WT + (size_t)(d.n0 + n) * d.K + d.k0 + 8 * c) = o; }
        asm volatile("s_waitcnt lgkmcnt(0)" ::: "memory");
        d = dn; it = nit;
    }
#undef CV_LOAD
    if (ev) {
        bf16_t* WL = (bf16_t*)(P.ws + WS_WLORA);
        for (int idx = C.bid * 512 + C.tid; idx < 5120 * 16; idx += C.G * 512) {
            const int n = idx % 5120, k8 = idx / 5120, g = n >> 10, cc = n & 1023; float o[8];
#pragma unroll
            for (int e = 0; e < 8; ++e) { const int k = k8 * 8 + e; float v = 0.f;
                if (g == 0) { if (k < 64) v = P.in[I_W2][((size_t)(j * 2 + 0) * 64 + k) * 1024 + cc]; }
                else if (g == 1) { if (k >= 64) v = P.in[I_W2][((size_t)(j * 2 + 1) * 64 + (k - 64)) * 1024 + cc]; }
                else if (g == 2) { if (k < 64) v = P.in[I_A2][((size_t)(j * 2 + 0) * 64 + k) * 1024 + cc]; }
                else if (g == 3) { if (k >= 64) v = P.in[I_A2][((size_t)(j * 2 + 1) * 64 + (k - 64)) * 1024 + cc]; }
                else v = P.in[I_G2][((size_t)j * 128 + k) * 1024 + cc];
                o[e] = v; }
            *(u32x4*)(WL + (size_t)n * 128 + k8 * 8) = pack8(o);
        }
    }
}

__device__ __forceinline__ void phase_rows(const Params& P, const Ctx& C, int mode, const float* gpost, const float* gate_mod  ,
                                           bool next, const float* gpre, const float* mod_next  , bool dummy = false) {
    float* X = P.out + O_X; const bf16_t* MP0 = (const bf16_t*)(P.ws + WS_MP); const bf16_t* MP1 = MP0 + (size_t)MTOK * DM; bf16_t* H = (bf16_t*)(P.ws + WS_H);
    const int gw = C.bid * 8 + C.wave, NGW = C.G * 8;
    for (int m = gw; m < MTOK; m += NGW) {
        const int mr = m < 4096 ? 0 : 1 + ((m - 4096) >> 10);
        f32x4 x[4];
        f32x4 gq[4], sh[4], sl[4];
        if (next) { const f32x4* gp_ = (const f32x4*)gpre + C.lane; const f32x4* sh_ = (const f32x4*)(mod_next + (size_t)mr * 6144) + C.lane; const f32x4* sl_ = (const f32x4*)(mod_next + (size_t)mr * 6144 + 1024) + C.lane;
#pragma unroll
            for (int j = 0; j < 4; ++j) { gq[j] = gp_[64 * j]; sh[j] = sh_[64 * j]; sl[j] = sl_[64 * j]; } }
        if (mode == 0) { const f32x4* src = (const f32x4*)(m < 4096 ? P.in[I_XP] + (size_t)m * DM : P.in[I_XS] + (size_t)(m - 4096) * DM) + C.lane;
#pragma unroll
            for (int j = 0; j < 4; ++j) x[j] = src[64 * j];
        } else {
            const f32x4* xs = (const f32x4*)(X + (size_t)m * DM) + C.lane; const u32x2* p0 = (const u32x2*)(MP0 + (size_t)m * DM) + C.lane; const u32x2* p1 = (const u32x2*)(MP1 + (size_t)m * DM) + C.lane;
            const f32x4* gp = (const f32x4*)gpost + C.lane; const f32x4* gt = (const f32x4*)(gate_mod + (size_t)mr * 6144) + C.lane;
            f32x4 gpv[4], gtv[4];
#pragma unroll
            for (int j = 0; j < 4; ++j) { gpv[j] = gp[64 * j]; gtv[j] = gt[64 * j]; }
            f32x4 f[4]; float ss = 0.f;
#pragma unroll
            for (int j = 0; j < 4; ++j) { x[j] = xs[64 * j]; f[j] = unpack4(p0[64 * j]) + unpack4(p1[64 * j]); ss += (f[j].x * f[j].x + f[j].y * f[j].y) + (f[j].z * f[j].z + f[j].w * f[j].w); }
            const float rs = rsqrtf(wave_sum(ss) * (1.f / DM) + 1e-6f);
#pragma unroll
            for (int j = 0; j < 4; ++j) x[j] = x[j] + gtv[j] * (f[j] * rs * gpv[j]);
        }
        f32x4* xo = (f32x4*)((dummy ? (float*)(P.ws + WS_PREP) : X) + (size_t)m * DM) + C.lane;
#pragma unroll
        for (int j = 0; j < 4; ++j) xo[64 * j] = x[j];
        if (next) {
            float ss = 0.f;
#pragma unroll
            for (int j = 0; j < 4; ++j) ss += (x[j].x * x[j].x + x[j].y * x[j].y) + (x[j].z * x[j].z + x[j].w * x[j].w);
            const float rs = rsqrtf(wave_sum(ss) * (1.f / DM) + 1e-6f);
            u32x2* ho = (u32x2*)((dummy ? (bf16_t*)(P.ws + WS_PREP + 40 * MiB) : H) + (size_t)m * DM) + C.lane;
#pragma unroll
            for (int j = 0; j < 4; ++j) { const f32x4 h = (x[j] * rs * gq[j]) * (sl[j] + 1.f) + sh[j]; u32x2 w; w.x = pk2(h.x, h.y); w.y = pk2(h.z, h.w); ho[64 * j] = w; }
        }
    }
}

__device__ __forceinline__ void conv8(const bf16_t* src, int ld, int col0, int base, int t, bool samp, const float* w, const float* b, int NC, int ch, float* acc) {
    { const f32x4 b0 = *(const f32x4*)(b + ch), b1 = *(const f32x4*)(b + ch + 4); acc[0] = b0.x; acc[1] = b0.y; acc[2] = b0.z; acc[3] = b0.w; acc[4] = b1.x; acc[5] = b1.y; acc[6] = b1.z; acc[7] = b1.w; }
    if (!samp) {
#pragma unroll
        for (int d = 0; d < 3; ++d) { const int tt = t + d - 1; if (tt < 0 || tt >= 256) continue;
            float xv[8]; unpack8(*(const u32x4*)(src + (size_t)(base + tt) * ld + col0 + ch), xv);
            const f32x4 w0 = *(const f32x4*)(w + (3 + d) * NC + ch), w1 = *(const f32x4*)(w + (3 + d) * NC + ch + 4);
            acc[0] += w0.x * xv[0]; acc[1] += w0.y * xv[1]; acc[2] += w0.z * xv[2]; acc[3] += w0.w * xv[3]; acc[4] += w1.x * xv[4]; acc[5] += w1.y * xv[5]; acc[6] += w1.z * xv[6]; acc[7] += w1.w * xv[7]; }
    } else {
        const int r = t >> 6, c = t & 63;
#pragma unroll
        for (int i = 0; i < 3; ++i)
#pragma unroll
            for (int d = 0; d < 3; ++d) { const int rr = r + i - 1, cc = c + d - 1; if (rr < 0 || rr >= 16 || cc < 0 || cc >= 64) continue;
                float xv[8]; unpack8(*(const u32x4*)(src + (size_t)(base + rr * 64 + cc) * ld + col0 + ch), xv);
                const f32x4 w0 = *(const f32x4*)(w + (i * 3 + d) * NC + ch), w1 = *(const f32x4*)(w + (i * 3 + d) * NC + ch + 4);
                acc[0] += w0.x * xv[0]; acc[1] += w0.y * xv[1]; acc[2] += w0.z * xv[2]; acc[3] += w0.w * xv[3]; acc[4] += w1.x * xv[4]; acc[5] += w1.y * xv[5]; acc[6] += w1.z * xv[6]; acc[7] += w1.w * xv[7]; }
    }
}

__device__ __forceinline__ void phase_prep_even(const Params& P, const Ctx& C, int j) {
    const bf16_t* PROJ = (const bf16_t*)(P.ws + WS_PROJ); bf16_t* PREP = (bf16_t*)(P.ws + WS_PREP); bf16_t* LA = (bf16_t*)(P.ws + WS_LORAA);
    float* DT = (float*)(P.ws + WS_DT); float* DA = (float*)(P.ws + WS_DA);
    const float* cw = P.in[I_SCONVW] + (size_t)j * 9 * 2048; const float* cb = P.in[I_SCONVB] + j * 2048;
    const float* mu = P.in[I_MU] + j * 3456; const float* kkw = P.in[I_KK] + j * 1024;
    const int gw = C.bid * 8 + C.wave, NGW = C.G * 8, lane = C.lane;
    for (int m = gw; m < MTOK; m += NGW) {
        const bool samp = m >= 4096; const int T = samp ? 1024 : 256; const int t = samp ? ((m - 4096) & 1023) : (m & 255); const int base = m - t;
        const bf16_t* prow = PROJ + (size_t)m * PROJ_LD_AB; bf16_t* orow = PREP + (size_t)m * PREP_LD;
        const bool hp = t > 0, hn = t < T - 1;
        u32x4 rx[7], rxp[7], rxn[7], rz[2];
#pragma unroll
        for (int it = 0; it < 7; ++it) { const int c = it * 512 + lane * 8; const bool ok = c < 3456; const u32x4 z4 = (u32x4){0u, 0u, 0u, 0u};
            rx[it] = ok ? *(const u32x4*)(prow + IN_SSD + c) : z4; rxp[it] = (ok && hp) ? *(const u32x4*)(prow - PROJ_LD_AB + IN_SSD + c) : z4; rxn[it] = (ok && hn) ? *(const u32x4*)(prow + PROJ_LD_AB + IN_SSD + c) : z4; }
#pragma unroll
        for (int it = 0; it < 2; ++it) rz[it] = *(const u32x4*)(prow + it * 512 + lane * 8);
#pragma unroll 1
        for (int it = 0; it < 4; ++it) { const int ch = it * 512 + lane * 8; float acc[8];
            conv8(PROJ, PROJ_LD_AB, 1024, base, t, samp, cw, cb, 2048, ch, acc);
#pragma unroll
            for (int e = 0; e < 8; ++e) acc[e] = siluf_(acc[e]);
            *(u32x4*)(orow + ch) = pack8(acc); }
#pragma unroll
        for (int it = 0; it < 2; ++it) { const int ch = it * 512 + lane * 8; float z[8]; unpack8(rz[it], z);
#pragma unroll
            for (int e = 0; e < 8; ++e) z[e] = siluf_(z[e]);
            *(u32x4*)(orow + 2048 + ch) = pack8(z); }
        if (lane < 32) { const float raw = bf2f(prow[3072 + lane]); const float dt = softplusf_(raw + P.in[I_DTB][j * 32 + lane]);
            DT[(size_t)m * 32 + lane] = dt; DA[(size_t)m * 32 + lane] = -dt * __expf(P.in[I_ALOG][j * 32 + lane]); }
#pragma unroll
        for (int it = 0; it < 7; ++it) { const int c = it * 512 + lane * 8; if (c >= 3456) break;
            float x[8], xp[8], xn[8];
            unpack8(rx[it], x); unpack8(rxp[it], xp); unpack8(rxn[it], xn);
            const f32x4 m0 = *(const f32x4*)(mu + c), m1 = *(const f32x4*)(mu + c + 4);
            const float mv[8] = {m0.x, m0.y, m0.z, m0.w, m1.x, m1.y, m1.z, m1.w};
#pragma unroll
            for (int e = 0; e < 8; ++e) x[e] = x[e] + mv[e] * (0.5f * (xp[e] + xn[e]) - x[e]);
            if (it < 2) { *(u32x4*)(orow + 3072 + c) = pack8(x); }
            else if (it < 4) { *(u32x4*)(orow + 4096 + (c - 1024)) = pack8(x);
                const f32x4 k0 = *(const f32x4*)(kkw + c - 1024), k1 = *(const f32x4*)(kkw + c - 1024 + 4);
                const float kv[8] = {k0.x, k0.y, k0.z, k0.w, k1.x, k1.y, k1.z, k1.w}; float ss = 0.f;
#pragma unroll
                for (int e = 0; e < 8; ++e) { x[e] *= kv[e]; ss += x[e] * x[e]; }
                ss += __shfl_xor(ss, 1); ss += __shfl_xor(ss, 2); ss += __shfl_xor(ss, 4);
                const float rn = rsqrtf(ss + 1e-12f);
#pragma unroll
                for (int e = 0; e < 8; ++e) x[e] *= rn;
                *(u32x4*)(orow + 6144 + (c - 1024)) = pack8(x); }
            else if (it < 6) { *(u32x4*)(orow + 5120 + (c - 2048)) = pack8(x); }
            else { const int cc = c - 3072;
#pragma unroll
                for (int e = 0; e < 8; ++e) x[e] = cc < 128 ? tanhf_(x[e]) : (cc < 256 ? x[e] : sigmoidf_(x[e]));
                *(u32x4*)(LA + (size_t)m * LORA_K + cc) = pack8(x); }
        }
    }
}
__device__ __forceinline__ void phase_prep_odd(const Params& P, const Ctx& C, int j) {
    const bf16_t* PROJ = (const bf16_t*)(P.ws + WS_PROJ); bf16_t* PREP = (bf16_t*)(P.ws + WS_PREP);
    const float* cw = P.in[I_MCONVW] + (size_t)j * 9 * 1024; const float* cb = P.in[I_MCONVB] + j * 1024;
    const int gw = C.bid * 8 + C.wave, NGW = C.G * 8, lane = C.lane;
    for (int m = gw; m < MTOK; m += NGW) {
        const bool samp = m >= 4096; const int t = samp ? ((m - 4096) & 1023) : (m & 255); const int base = m - t;
#pragma unroll 1
        for (int it = 0; it < 2; ++it) { const int ch = it * 512 + lane * 8; float acc[8];
            conv8(PROJ, PROJ_LD_CD, IN_GLA, base, t, samp, cw, cb, 1024, ch, acc);
#pragma unroll
            for (int e = 0; e < 8; ++e) acc[e] = siluf_(acc[e]);
            *(u32x4*)(PREP + (size_t)m * PREP_LD + ch) = pack8(acc); }
    }
}

constexpr int CS_QLD = 136, CS_SLD = 72;
constexpr int CS_QS = 0, CS_KS = 17408, CS_KT = 34816, CS_VT = 53248;
__device__ __forceinline__ bf16x8 lds_frag(const LAS bf16_t* p) { return *(const LAS bf16x8*)p; }
template <int MODE>
__device__ __forceinline__ void chunk_scan(const Params& P, const Ctx& C, int j, int s, int dir, int h, int vs) {
    const int tid = C.tid, lane = C.lane, w = C.wave, fr = lane & 15, fq = lane >> 4;
    const int T = s < 16 ? 256 : 1024, base = s < 16 ? s * 256 : 4096 + (s - 16) * 1024, nch = T >> 6;
    const bf16_t* PROJ = (const bf16_t*)(P.ws + WS_PROJ); const bf16_t* PREP = (const bf16_t*)(P.ws + WS_PREP);
    bf16_t* Y = (bf16_t*)(P.ws + WS_MP) + (size_t)dir * MTOK * YLD;
    LAS bf16_t* Qs = (LAS bf16_t*)(C.lds + CS_QS); LAS bf16_t* Ks = (LAS bf16_t*)(C.lds + CS_KS); LAS bf16_t* Kt = (LAS bf16_t*)(C.lds + CS_KT); LAS bf16_t* Vt = (LAS bf16_t*)(C.lds + CS_VT);
    constexpr int NV = MODE == 0 ? 64 : 128, NVC = NV / 16, VROWS = NV + (MODE == 2 ? 16 : 0);
    constexpr int CS_ST = CS_VT + VROWS * CS_SLD * 2, CS_LA = CS_ST + VROWS * CS_QLD * 2, CS_PS = CS_LA  , CS_TOT = CS_LA + (MODE == 1 ? 32768 : 9216),
                  CS_BV = CS_TOT + 2560, CS_IG = CS_BV + 256, CS_FV = CS_IG + 256, CS_DTV = CS_FV + 256, CS_MS = CS_DTV + 256;
    static_assert(CS_MS + 64 <= LDS_BYTES - 16, "chunk-scan LDS map");
    LAS bf16_t* Ps = (LAS bf16_t*)(C.lds + CS_PS); LAS bf16_t* St = (LAS bf16_t*)(C.lds + CS_ST);
    LAS float* LA = (LAS float*)(C.lds + CS_LA); LAS float* TOT = (LAS float*)(C.lds + CS_TOT); LAS float* BV = (LAS float*)(C.lds + CS_BV); LAS float* IG = (LAS float*)(C.lds + CS_IG);
    LAS float* MS = (LAS float*)(C.lds + CS_MS); LAS float* FV = (LAS float*)(C.lds + CS_FV); LAS float* DTV = (LAS float*)(C.lds + CS_DTV);
    constexpr int NVT = NVC + (MODE == 2 ? 1 : 0);
    const int si = tid >> 3, kq = tid & 7;
    __syncthreads();
    bf16x8 gwa_hi = {0, 0, 0, 0, 0, 0, 0, 0}, gwa_lo = {0, 0, 0, 0, 0, 0, 0, 0}; f32x4 gb4 = {0.f, 0.f, 0.f, 0.f};
    if (MODE == 1) {
        const float* gwp = P.in[I_GGW] + (size_t)(j * 2 + dir) * 16 * 512 + h * 128 + 16 * w + fr;
        if (fq < 2) {
#pragma unroll
            for (int e = 0; e < 8; ++e) { const float g = gwp[(8 * fq + e) * 512]; const unsigned hb = f2bf(g); const float rem = g - bf2f(hb); gwa_hi[e] = (short)hb; gwa_lo[e] = (short)f2bf(rem); } }
        gb4 = *(const f32x4*)(P.in[I_GGB] + (j * 2 + dir) * 512 + h * 128 + 16 * w + 4 * fq);
    }
    f32x4 Sacc[NVT];
    {
        const float* s0 = nullptr; int kstride = 64; float em0 = 1.f;
        if (s >= 16) { const int b = s - 16;
            if (MODE == 0) { s0 = P.in[I_SSSD] + ((size_t)((b * 2 + j) * 2 + dir) * 16 + h) * 8192; kstride = 64; }
            if (MODE == 1) { s0 = P.in[I_SGLA] + ((size_t)((b * 2 + j) * 2 + dir) * 4 + h) * 32768 + vs * NV; kstride = 256; }
            if (MODE == 2) { s0 = P.in[I_SMC] + ((size_t)((b * 2 + j) * 2 + dir) * 4 + h) * 32768 + vs * NV; kstride = 256; em0 = __expf(P.in[I_SMM][((b * 2 + j) * 2 + dir) * 4 + h]); } }
#pragma unroll
        for (int vt = 0; vt < NVC; ++vt)
#pragma unroll
            for (int e = 0; e < 4; ++e) Sacc[vt][e] = s0 ? s0[(size_t)(16 * w + 4 * fq + e) * kstride + 16 * vt + fr] * em0 : 0.f;
        if (MODE == 2) {
            const float* n0 = s >= 16 ? P.in[I_SMN] + ((size_t)(((s - 16) * 2 + j) * 2 + dir) * 4 + h) * 128 : nullptr;
#pragma unroll
            for (int e = 0; e < 4; ++e) Sacc[NVT - 1][e] = (n0 && fr == 0) ? n0[16 * w + 4 * fq + e] * em0 : 0.f;
            if (tid == 0) MS[0] = s >= 16 ? P.in[I_SMM][(((s - 16) * 2 + j) * 2 + dir) * 4 + h] : 0.f;
            for (int i = tid; i < 16 * CS_SLD; i += 512) Vt[NV * CS_SLD + i] = (bf16_t)((i < CS_SLD) ? 0x3F80 : 0);
        }
#pragma unroll
        for (int vt = 0; vt < NVT; ++vt) { u32x2 wv; wv.x = pk2(Sacc[vt][0], Sacc[vt][1]); wv.y = pk2(Sacc[vt][2], Sacc[vt][3]); *(LAS u32x2*)(St + (16 * vt + fr) * CS_QLD + 16 * w + 4 * fq) = wv; }
    }
    u32x4 rq0, rq1, rk0, rk1, rgd[4]; float rla = 0.f, rig = 0.f, rdt = 0.f;
    constexpr int NVTOK = MODE == 0 ? 8 : 16;
    unsigned short rkt[16], rvt[NVTOK];
    const int kx = tid & 127, tgk = tid >> 7, vx = tid & (NV - 1), tgv = MODE == 0 ? (tid >> 6) : (tid >> 7);
    auto tok = [&](int c, int i) { const int st0 = c * 64 + i; return base + (dir ? (T - 1 - st0) : st0); };
    auto load_raw = [&](int c) {
        const int m = tok(c, si); const int m1 = tok(c, tid & 63);
        const bf16_t* krow; const bf16_t* vrow; int kld, vld;
        if (MODE == 0) { const int g = h >> 2; const bf16_t* pr = PREP + (size_t)m * PREP_LD;
            rq0 = *(const u32x4*)(pr + 1536 + g * 128 + 16 * kq); rq1 = *(const u32x4*)(pr + 1536 + g * 128 + 16 * kq + 8);
            rk0 = *(const u32x4*)(pr + 1024 + g * 128 + 16 * kq); rk1 = *(const u32x4*)(pr + 1024 + g * 128 + 16 * kq + 8);
            if (tid < 64) { rla = ((const float*)(P.ws + WS_DA))[(size_t)m1 * 32 + dir * 16 + h]; rdt = ((const float*)(P.ws + WS_DT))[(size_t)m1 * 32 + dir * 16 + h]; }
            krow = PREP + 1024 + g * 128 + kx; kld = PREP_LD; vrow = PREP + h * 64 + vx; vld = PREP_LD; }
        if (MODE == 1) { const bf16_t* pr = PROJ + (size_t)m * PROJ_LD_CD;
            rq0 = *(const u32x4*)(pr + h * 128 + 16 * kq); rq1 = *(const u32x4*)(pr + h * 128 + 16 * kq + 8);
            rk0 = *(const u32x4*)(pr + 512 + h * 128 + 16 * kq); rk1 = *(const u32x4*)(pr + 512 + h * 128 + 16 * kq + 8);
#pragma unroll
            for (int t4 = 0; t4 < 4; ++t4) { rgd[t4] = (u32x4){0u, 0u, 0u, 0u}; if (fq < 2) rgd[t4] = *(const u32x4*)(PROJ + (size_t)tok(c, 16 * t4 + fr) * PROJ_LD_CD + 3072 + dir * 16 + 8 * fq); }
            krow = PROJ + 512 + h * 128 + kx; kld = PROJ_LD_CD; vrow = PROJ + 1024 + h * 256 + vs * NV + vx; vld = PROJ_LD_CD; }
        if (MODE == 2) { const bf16_t* pp = PREP + (size_t)m * PREP_LD;
            rq0 = *(const u32x4*)(pp + h * 128 + 16 * kq); rq1 = *(const u32x4*)(pp + h * 128 + 16 * kq + 8);
            rk0 = *(const u32x4*)(pp + 512 + h * 128 + 16 * kq); rk1 = *(const u32x4*)(pp + 512 + h * 128 + 16 * kq + 8);
            if (tid < 64) { const bf16_t* p1 = PROJ + (size_t)m1 * PROJ_LD_CD + IN_GLA + 3072; rig = bf2f(p1[dir * 4 + h]); rla = bf2f(p1[8 + dir * 4 + h]); }
            krow = PREP + 512 + h * 128 + kx; kld = PREP_LD; vrow = PROJ + IN_GLA + 1024 + h * 256 + vs * NV + vx; vld = PROJ_LD_CD; }
        { const bf16_t* kp = krow + (size_t)tok(c, 16 * tgk) * kld; const long ks_ = dir ? -(long)kld : (long)kld;
#pragma unroll
          for (int jj = 0; jj < 16; ++jj) { rkt[jj] = *kp; kp += ks_; }
          const bf16_t* vp = vrow + (size_t)tok(c, NVTOK * tgv) * vld; const long vs_ = dir ? -(long)vld : (long)vld;
#pragma unroll
          for (int jj = 0; jj < NVTOK; ++jj) { rvt[jj] = *vp; vp += vs_; } }
    };
    load_raw(0);
    __syncthreads();
    const int ycol0 = (MODE == 0 ? h * 64 : (MODE == 1 ? h * 256 + vs * NV : 1024 + h * 256 + vs * NV));
    for (int c = 0; c < nch; ++c) {
        if (MODE == 1) {
#pragma unroll
            for (int t4 = 0; t4 < 4; ++t4) { f32x4 acc = (f32x4){0.f, 0.f, 0.f, 0.f}; const bf16x8 gf = __builtin_bit_cast(bf16x8, rgd[t4]);
                acc = __builtin_amdgcn_mfma_f32_16x16x32_bf16(gwa_hi, gf, acc, 0, 0, 0); acc = __builtin_amdgcn_mfma_f32_16x16x32_bf16(gwa_lo, gf, acc, 0, 0, 0);
                f32x4 la;
#pragma unroll
                for (int e = 0; e < 4; ++e) la[e] = logsigmoidf_(acc[e] + gb4[e]) * 0.0625f;
                *(LAS f32x4*)(LA + (16 * t4 + fr) * 128 + 16 * w + 4 * fq) = la; }
        } else if (tid < 64) {
            float ig = 0.f, la = rla;
            if (MODE == 2) { ig = rig + P.in[I_MIB][(j * 2 + dir) * 4 + h]; la = logsigmoidf_(rla + P.in[I_MFB][(j * 2 + dir) * 4 + h]); }
            float x = la;
            x += __int_as_float(__builtin_amdgcn_update_dpp(0, __float_as_int(x), 0x111, 0xF, 0xF, true));
            x += __int_as_float(__builtin_amdgcn_update_dpp(0, __float_as_int(x), 0x112, 0xF, 0xF, true));
            x += __int_as_float(__builtin_amdgcn_update_dpp(0, __float_as_int(x), 0x114, 0xF, 0xF, true));
            x += __int_as_float(__builtin_amdgcn_update_dpp(0, __float_as_int(x), 0x118, 0xF, 0xF, true));
            { const float t0 = __int_as_float(__builtin_amdgcn_readlane(__float_as_int(x), 15)), t1 = __int_as_float(__builtin_amdgcn_readlane(__float_as_int(x), 31)), t2 = __int_as_float(__builtin_amdgcn_readlane(__float_as_int(x), 47));
              const int rw = lane >> 4; x += (rw > 0 ? t0 : 0.f) + (rw > 1 ? t1 : 0.f) + (rw > 2 ? t2 : 0.f); }
            const float bl = __int_as_float(__builtin_amdgcn_readlane(__float_as_int(x), 63));
            const float kgn = MODE == 2 ? 0.08838834764831845f * __expf(ig) : 1.f;
            BV[tid] = x; IG[tid] = kgn; FV[tid] = kgn * __expf(bl - x); DTV[tid] = MODE == 0 ? rdt : 1.f;
            if (MODE == 2) { float ml = bl - x + ig;
                ml = fmaxf(ml, __int_as_float(__builtin_amdgcn_update_dpp(__float_as_int(ml), __float_as_int(ml), 0xB1, 0xF, 0xF, false)));
                ml = fmaxf(ml, __int_as_float(__builtin_amdgcn_update_dpp(__float_as_int(ml), __float_as_int(ml), 0x4E, 0xF, 0xF, false)));
                ml = fmaxf(ml, __int_as_float(__builtin_amdgcn_update_dpp(__float_as_int(ml), __float_as_int(ml), 0x141, 0xF, 0xF, false)));
                ml = fmaxf(ml, __int_as_float(__builtin_amdgcn_update_dpp(__float_as_int(ml), __float_as_int(ml), 0x140, 0xF, 0xF, false)));
                const float m01 = fmaxf(__int_as_float(__builtin_amdgcn_readlane(__float_as_int(ml), 0)), __int_as_float(__builtin_amdgcn_readlane(__float_as_int(ml), 16)));
                const float m23 = fmaxf(__int_as_float(__builtin_amdgcn_readlane(__float_as_int(ml), 32)), __int_as_float(__builtin_amdgcn_readlane(__float_as_int(ml), 48)));
                if (tid == 0) MS[0] = fmaxf(bl + MS[0], fmaxf(m01, m23)); }
        }
        __syncthreads();
        if (MODE == 1) {
            const int k = tid & 127, qd = tid >> 7; float run = 0.f;
#pragma unroll
            for (int jj = 0; jj < 16; ++jj) { run += LA[(16 * qd + jj) * 128 + k]; LA[(16 * qd + jj) * 128 + k] = run; }
            TOT[qd * 128 + k] = run;
            __syncthreads();
            if (tid < 128) TOT[4 * 128 + tid] = __expf(TOT[tid] + TOT[128 + tid] + TOT[256 + tid] + TOT[384 + tid]);
        }
        {
            float q[16], k[16]; unpack8(rq0, q); unpack8(rq1, q + 8); unpack8(rk0, k); unpack8(rk1, k + 8);
            float qs[16], ks[16];
            if (MODE == 1) { const int qd = si >> 4;
#pragma unroll
                for (int e4 = 0; e4 < 4; ++e4) { const int kk = 16 * kq + 4 * e4; const f32x4 bb = *(LAS f32x4*)(LA + si * 128 + kk), t0 = *(LAS f32x4*)(TOT + kk), t1 = *(LAS f32x4*)(TOT + 128 + kk), t2 = *(LAS f32x4*)(TOT + 256 + kk);
#pragma unroll
                    for (int e = 0; e < 4; ++e) { const float b = bb[e] + (qd > 0 ? t0[e] : 0.f) + (qd > 1 ? t1[e] : 0.f) + (qd > 2 ? t2[e] : 0.f);
                        qs[4 * e4 + e] = q[4 * e4 + e] * 0.08838834764831845f * __expf(b); ks[4 * e4 + e] = k[4 * e4 + e] * __expf(fminf(-b, 80.f)); } }
            } else { const float kgn = IG[si];
#pragma unroll
                for (int e = 0; e < 16; ++e) { qs[e] = q[e]; ks[e] = k[e] * kgn; } }
            *(LAS u32x4*)(Qs + si * CS_QLD + 16 * kq) = pack8(qs); *(LAS u32x4*)(Qs + si * CS_QLD + 16 * kq + 8) = pack8(qs + 8);
            *(LAS u32x4*)(Ks + si * CS_QLD + 16 * kq) = pack8(ks); *(LAS u32x4*)(Ks + si * CS_QLD + 16 * kq + 8) = pack8(ks + 8);
        }
        if (MODE == 1)
        {
            float kt[16];
            if (MODE == 1) { float off = 0.f; const float t0 = TOT[kx], t1 = TOT[128 + kx], t2 = TOT[256 + kx], t3 = TOT[384 + kx];
                off = (tgk > 0 ? t0 : 0.f) + (tgk > 1 ? t1 : 0.f) + (tgk > 2 ? t2 : 0.f); const float bl = (t0 + t1) + (t2 + t3);
#pragma unroll
                for (int jj = 0; jj < 16; ++jj) kt[jj] = bf2f(rkt[jj]) * __expf(bl - (LA[(16 * tgk + jj) * 128 + kx] + off));
            } else {
#pragma unroll
                for (int jj = 0; jj < 16; ++jj) kt[jj] = bf2f(rkt[jj]) * FV[16 * tgk + jj]; }
            *(LAS u32x4*)(Kt + kx * CS_SLD + 16 * tgk) = pack8(kt); *(LAS u32x4*)(Kt + kx * CS_SLD + 16 * tgk + 8) = pack8(kt + 8);
            float vt8[NVTOK];
#pragma unroll
            for (int jj = 0; jj < NVTOK; ++jj) vt8[jj] = bf2f(rvt[jj]) * (MODE == 0 ? DTV[NVTOK * tgv + jj] : 1.f);
            *(LAS u32x4*)(Vt + vx * CS_SLD + NVTOK * tgv) = pack8(vt8);
            if (NVTOK == 16) *(LAS u32x4*)(Vt + vx * CS_SLD + NVTOK * tgv + 8) = pack8(vt8 + 8);
        }
        __syncthreads();
        if (MODE != 1)
        {
            float kt[16];
            if (MODE == 1) { float off = 0.f; const float t0 = TOT[kx], t1 = TOT[128 + kx], t2 = TOT[256 + kx], t3 = TOT[384 + kx];
                off = (tgk > 0 ? t0 : 0.f) + (tgk > 1 ? t1 : 0.f) + (tgk > 2 ? t2 : 0.f); const float bl = (t0 + t1) + (t2 + t3);
#pragma unroll
                for (int jj = 0; jj < 16; ++jj) kt[jj] = bf2f(rkt[jj]) * __expf(bl - (LA[(16 * tgk + jj) * 128 + kx] + off));
            } else {
#pragma unroll
                for (int jj = 0; jj < 16; ++jj) kt[jj] = bf2f(rkt[jj]) * FV[16 * tgk + jj]; }
            *(LAS u32x4*)(Kt + kx * CS_SLD + 16 * tgk) = pack8(kt); *(LAS u32x4*)(Kt + kx * CS_SLD + 16 * tgk + 8) = pack8(kt + 8);
            float vt8[NVTOK];
#pragma unroll
            for (int jj = 0; jj < NVTOK; ++jj) vt8[jj] = bf2f(rvt[jj]) * (MODE == 0 ? DTV[NVTOK * tgv + jj] : 1.f);
            *(LAS u32x4*)(Vt + vx * CS_SLD + NVTOK * tgv) = pack8(vt8);
            if (NVTOK == 16) *(LAS u32x4*)(Vt + vx * CS_SLD + NVTOK * tgv + 8) = pack8(vt8 + 8);
        }
        if (c + 1 < nch) load_raw(c + 1);
        const int tt = w >> 1;
#pragma unroll
        for (int sj = 0; sj < 2; ++sj) { const int st = 2 * (w & 1) + sj; u32x2 wv; wv.x = 0u; wv.y = 0u;
            if (st <= tt) { f32x4 acc = (f32x4){0.f, 0.f, 0.f, 0.f};
#pragma unroll
                for (int kk = 0; kk < 4; ++kk) acc = __builtin_amdgcn_mfma_f32_16x16x32_bf16(lds_frag(Ks + (16 * st + fr) * CS_QLD + 32 * kk + 8 * fq), lds_frag(Qs + (16 * tt + fr) * CS_QLD + 32 * kk + 8 * fq), acc, 0, 0, 0);
                const int tg = 16 * tt + fr, sg = 16 * st + 4 * fq;
                if (MODE != 1) { const float bt = BV[tg]; const f32x4 bs = *(LAS f32x4*)(BV + sg);
#pragma unroll
                    for (int e = 0; e < 4; ++e) acc[e] *= __expf(fminf(bt - bs[e], 0.f)); }
#pragma unroll
                for (int e = 0; e < 4; ++e) acc[e] = (sg + e <= tg) ? acc[e] : 0.f;
                wv.x = pk2(acc[0], acc[1]); wv.y = pk2(acc[2], acc[3]); }
            *(LAS u32x2*)(Ps + (16 * tt + fr) * CS_SLD + 16 * st + 4 * fq) = wv; }
        __syncthreads();
        {
            const int tg = 16 * tt + fr; const int stp = c * 64 + tg; const int m = base + (dir ? (T - 1 - stp) : stp);
            const float ebt = MODE == 1 ? 1.f : __expf(BV[tg]);
            bf16x8 pf[2], qf[4];
#pragma unroll
            for (int ks2 = 0; ks2 < 2; ++ks2) pf[ks2] = lds_frag(Ps + tg * CS_SLD + 32 * ks2 + 8 * fq);
#pragma unroll
            for (int kk = 0; kk < 4; ++kk) qf[kk] = lds_frag(Qs + tg * CS_QLD + 32 * kk + 8 * fq);
            float rden = 1.f;
            if (MODE == 2) { f32x4 ai = (f32x4){0.f, 0.f, 0.f, 0.f}, ao = (f32x4){0.f, 0.f, 0.f, 0.f};
#pragma unroll
                for (int ks2 = 0; ks2 < 2; ++ks2) ai = __builtin_amdgcn_mfma_f32_16x16x32_bf16(lds_frag(Vt + (NV + fr) * CS_SLD + 32 * ks2 + 8 * fq), pf[ks2], ai, 0, 0, 0);
#pragma unroll
                for (int kk = 0; kk < 4; ++kk) ao = __builtin_amdgcn_mfma_f32_16x16x32_bf16(lds_frag(St + (NV + fr) * CS_QLD + 32 * kk + 8 * fq), qf[kk], ao, 0, 0, 0);
                const float den = __shfl(ai[0] + ao[0] * ebt, fr); rden = 1.f / fmaxf(fabsf(den), 1.f); }
#pragma unroll
            for (int vj = 0; vj < NVC / 2; ++vj) { const int vt = (NVC / 2) * (w & 1) + vj; f32x4 ai = (f32x4){0.f, 0.f, 0.f, 0.f}, ao = (f32x4){0.f, 0.f, 0.f, 0.f};
#pragma unroll
                for (int ks2 = 0; ks2 < 2; ++ks2) ai = __builtin_amdgcn_mfma_f32_16x16x32_bf16(lds_frag(Vt + (16 * vt + fr) * CS_SLD + 32 * ks2 + 8 * fq), pf[ks2], ai, 0, 0, 0);
#pragma unroll
                for (int kk = 0; kk < 4; ++kk) ao = __builtin_amdgcn_mfma_f32_16x16x32_bf16(lds_frag(St + (16 * vt + fr) * CS_QLD + 32 * kk + 8 * fq), qf[kk], ao, 0, 0, 0);
                u32x2 wv; wv.x = pk2((ai[0] + ao[0] * ebt) * rden, (ai[1] + ao[1] * ebt) * rden); wv.y = pk2((ai[2] + ao[2] * ebt) * rden, (ai[3] + ao[3] * ebt) * rden);
                *(u32x2*)(Y + (size_t)m * YLD + ycol0 + 16 * vt + 4 * fq) = wv; }
        }
        {
            f32x4 dec; if (MODE == 1) dec = *(LAS f32x4*)(TOT + 4 * 128 + 16 * w + 4 * fq); else { const float d = __expf(BV[63]); dec = (f32x4){d, d, d, d}; }
            bf16x8 kf[2];
#pragma unroll
            for (int ks2 = 0; ks2 < 2; ++ks2) kf[ks2] = lds_frag(Kt + (16 * w + fr) * CS_SLD + 32 * ks2 + 8 * fq);
#pragma unroll
            for (int vt = 0; vt < NVT; ++vt) { Sacc[vt] = Sacc[vt] * dec;
#pragma unroll
                for (int ks2 = 0; ks2 < 2; ++ks2) Sacc[vt] = __builtin_amdgcn_mfma_f32_16x16x32_bf16(kf[ks2], lds_frag(Vt + (16 * vt + fr) * CS_SLD + 32 * ks2 + 8 * fq), Sacc[vt], 0, 0, 0); }
        }
        __syncthreads();
#pragma unroll
        for (int vt = 0; vt < NVT; ++vt) { u32x2 wv; wv.x = pk2(Sacc[vt][0], Sacc[vt][1]); wv.y = pk2(Sacc[vt][2], Sacc[vt][3]); *(LAS u32x2*)(St + (16 * vt + fr) * CS_QLD + 16 * w + 4 * fq) = wv; }
    }
    if (s < 16) {
        float* o; int kstride; float sc = 1.f;
        if (MODE == 0) { o = P.out + O_SSD + ((size_t)((s * 2 + j) * 2 + dir) * 16 + h) * 8192; kstride = 64; }
        else { o = P.out + (MODE == 1 ? O_GLA : O_MC) + ((size_t)((s * 2 + j) * 2 + dir) * 4 + h) * 32768 + vs * NV; kstride = 256; }
        if (MODE == 2) { __syncthreads(); sc = __expf(-MS[0]); }
#pragma unroll
        for (int vt = 0; vt < NVC; ++vt)
#pragma unroll
            for (int e = 0; e < 4; ++e) o[(size_t)(16 * w + 4 * fq + e) * kstride + 16 * vt + fr] = Sacc[vt][e] * sc;
        if (MODE == 2 && vs == 0) {
            if (fr == 0) {
#pragma unroll
                for (int e = 0; e < 4; ++e) P.out[O_MN + ((size_t)((s * 2 + j) * 2 + dir) * 4 + h) * 128 + 16 * w + 4 * fq + e] = Sacc[NVT - 1][e] * sc; }
            if (tid == 0) P.out[O_MM + ((s * 2 + j) * 2 + dir) * 4 + h] = MS[0]; }
    }
}

struct RwOps { f32x4 kk0, kk1, w0, w1, kd0, kd1, ka0, ka1, r0, r1; f32x2 vv; };
__device__ __forceinline__ RwOps rw_ops(const LAS float* B, int tt, int kg, int vg) {
    const LAS float* p = B + tt * 64 + 4 * kg; RwOps o;
    o.kk0 = *(const LAS f32x4*)(p + 4096); o.kk1 = *(const LAS f32x4*)(p + 4096 + 32); o.w0 = *(const LAS f32x4*)(p + 1024); o.w1 = *(const LAS f32x4*)(p + 1024 + 32);
    o.kd0 = *(const LAS f32x4*)(p + 2048); o.kd1 = *(const LAS f32x4*)(p + 2048 + 32); o.ka0 = *(const LAS f32x4*)(p + 5120); o.ka1 = *(const LAS f32x4*)(p + 5120 + 32);
    o.r0 = *(const LAS f32x4*)(p); o.r1 = *(const LAS f32x4*)(p + 32); o.vv = *(const LAS f32x2*)(B + 3072 + tt * 64 + 2 * vg); return o;
}
__device__ __forceinline__ void rwkv_pair(const Params& P, const Ctx& C, int j, int bq, bool lng) {
    const int niter = lng ? 64 : 32; const bool act = !lng || C.tid < 256;
    const int tid = C.tid, half = tid >> 8, tl = tid & 255, kg = tl & 7, vg = tl >> 3;
    const bf16_t* PREP = (const bf16_t*)(P.ws + WS_PREP); const bf16_t* LOUT = (const bf16_t*)(P.ws + WS_PROJ);
    constexpr int BUFSZ = 6 * 1024;
    LAS float* L0 = (LAS float*)C.lds + half * 2 * BUFSZ;
    const int stt = tl >> 4, sc4 = (tl & 15) * 4;
    auto unit_of = [&](int cc, int& s, int& dir, int& h, int& lc) {
        if (lng) { s = 16 + (bq >> 5); dir = (bq >> 4) & 1; h = bq & 15; lc = cc; }
        else { const int q = 4 * bq + 2 * half + (cc >> 4); s = q >> 5; dir = (q >> 4) & 1; h = q & 15; lc = cc & 15; } };
    f32x2 S2[8];
    auto init_state = [&](int s, int dir, int h) {
        const float* s0 = s >= 16 ? P.in[I_SRWKV] + (((size_t)(((s - 16) * 2 + j) * 2 + dir) * 16 + h) * 64 + 2 * vg) * 64 : nullptr;
#pragma unroll
        for (int hh = 0; hh < 2; ++hh) { const f32x4 u0 = s0 ? *(const f32x4*)(s0 + 32 * hh + 4 * kg) : (f32x4){0.f, 0.f, 0.f, 0.f}, u1 = s0 ? *(const f32x4*)(s0 + 64 + 32 * hh + 4 * kg) : (f32x4){0.f, 0.f, 0.f, 0.f};
#pragma unroll
            for (int e = 0; e < 4; ++e) S2[hh * 4 + e] = (f32x2){u0[e], u1[e]}; } };
    u32x2 rr, rk, rv, rkk, rwl, ral; f32x4 cw0, ca0, cka;
    auto load_raw = [&](int cc) {
        int s, dir, h, lc; unit_of(cc, s, dir, h, lc);
        const int T = s < 16 ? 256 : 1024, base = s < 16 ? s * 256 : 4096 + (s - 16) * 1024;
        const int step = lc * 16 + stt; const int m = base + (dir ? (T - 1 - step) : step);
        const bf16_t* pp = PREP + (size_t)m * PREP_LD + h * 64 + sc4; const bf16_t* lo = LOUT + (size_t)m * LOUT_LD + dir * 1024 + h * 64 + sc4;
        rr = *(const u32x2*)(pp + 3072); rk = *(const u32x2*)(pp + 4096); rv = *(const u32x2*)(pp + 5120); rkk = *(const u32x2*)(pp + 6144);
        rwl = *(const u32x2*)lo; ral = *(const u32x2*)(lo + 2048);
        cw0 = *(const f32x4*)(P.in[I_W0] + (j * 2 + dir) * 1024 + h * 64 + sc4); ca0 = *(const f32x4*)(P.in[I_A0] + (j * 2 + dir) * 1024 + h * 64 + sc4); cka = *(const f32x4*)(P.in[I_KA] + j * 1024 + h * 64 + sc4);
    };
    auto write_lds = [&](LAS float* B) {
        const f32x4 r = unpack4(rr), k = unpack4(rk), v = unpack4(rv), kk = unpack4(rkk), wl = unpack4(rwl), al = unpack4(ral);
        f32x4 w, kd, kka;
#pragma unroll
        for (int e = 0; e < 4; ++e) { const float wp = cw0[e] + wl[e]; const float lw = -__expf(-softplusf_(-wp) - 0.5f); w[e] = __expf(lw);
            const float a = sigmoidf_(ca0[e] + al[e]); kd[e] = k[e] * (1.f + (a - 1.f) * cka[e]); kka[e] = kk[e] * a; }
        LAS float* p = B + stt * 64 + sc4;
        *(LAS f32x4*)(p) = r; *(LAS f32x4*)(p + 1024) = w; *(LAS f32x4*)(p + 2048) = kd; *(LAS f32x4*)(p + 3072) = v; *(LAS f32x4*)(p + 4096) = kk; *(LAS f32x4*)(p + 5120) = kka;
    };
    __syncthreads();
    if (act) { load_raw(0); write_lds(L0);
    { int s, dir, h, lc; unit_of(0, s, dir, h, lc); init_state(s, dir, h); } }
    __syncthreads();
#pragma unroll 1
    for (int cc = 0; cc < niter; ++cc) {
        if (act) {
        LAS float* B = L0 + (cc & 1) * BUFSZ;
        int s, dir, h, lc; unit_of(cc, s, dir, h, lc);
        const int T = s < 16 ? 256 : 1024, base = s < 16 ? s * 256 : 4096 + (s - 16) * 1024;
        if (cc + 1 < niter) load_raw(cc + 1);
        bf16_t* Y = (bf16_t*)(P.ws + WS_MP) + (size_t)dir * MTOK * YLD + 1024 + h * 64 + 2 * vg;
        RwOps cur = rw_ops(B, 0, kg, vg);
#pragma unroll 2
        for (int tt = 0; tt < 16; ++tt) {
            const RwOps nx = rw_ops(B, (tt + 1) & 15, kg, vg);
            const int step = lc * 16 + tt; const int m = base + (dir ? (T - 1 - step) : step);
            f32x2 da = (f32x2){0.f, 0.f}, db = (f32x2){0.f, 0.f};
#pragma unroll
            for (int e = 0; e < 4; ++e) { da = da + S2[e] * (f32x2){cur.kk0[e], cur.kk0[e]}; db = db + S2[4 + e] * (f32x2){cur.kk1[e], cur.kk1[e]}; }
            const f32x2 d2 = da + db;
            f32x2 sk2; sk2.x = row_sum8(d2.x); sk2.y = row_sum8(d2.y);
            f32x2 ya = (f32x2){0.f, 0.f}, yb = (f32x2){0.f, 0.f};
#pragma unroll
            for (int e = 0; e < 4; ++e) {
                S2[e] = S2[e] * (f32x2){cur.w0[e], cur.w0[e]} - sk2 * (f32x2){cur.ka0[e], cur.ka0[e]} + cur.vv * (f32x2){cur.kd0[e], cur.kd0[e]};
                S2[4 + e] = S2[4 + e] * (f32x2){cur.w1[e], cur.w1[e]} - sk2 * (f32x2){cur.ka1[e], cur.ka1[e]} + cur.vv * (f32x2){cur.kd1[e], cur.kd1[e]};
                ya = ya + S2[e] * (f32x2){cur.r0[e], cur.r0[e]}; yb = yb + S2[4 + e] * (f32x2){cur.r1[e], cur.r1[e]}; }
            const f32x2 y2 = ya + yb;
            const float y0 = row_sum8(y2.x), y1 = row_sum8(y2.y);
            if (kg == 0) *(unsigned*)(Y + (size_t)m * YLD) = pg8::cvt_pk_bf16(y0, y1);
            cur = nx;
        }
        const int nchU = lng ? 64 : 16;
        if (lc == nchU - 1 && s < 16) { float* o = P.out + O_RWKV + (((size_t)((s * 2 + j) * 2 + dir) * 16 + h) * 64 + 2 * vg) * 64;
#pragma unroll
            for (int hh = 0; hh < 2; ++hh) { *(f32x4*)(o + 32 * hh + 4 * kg) = (f32x4){S2[hh * 4].x, S2[hh * 4 + 1].x, S2[hh * 4 + 2].x, S2[hh * 4 + 3].x};
                *(f32x4*)(o + 64 + 32 * hh + 4 * kg) = (f32x4){S2[hh * 4].y, S2[hh * 4 + 1].y, S2[hh * 4 + 2].y, S2[hh * 4 + 3].y}; } }
        if (cc + 1 < niter) { write_lds(L0 + ((cc + 1) & 1) * BUFSZ);
            if (lc == nchU - 1) { int s2, d2_, h2, lc2; unit_of(cc + 1, s2, d2_, h2, lc2); init_state(s2, d2_, h2); } }
        }
        __syncthreads();
    }
}

__device__ __forceinline__ void scan_unit(const Params& P, const Ctx& C, int l, int type, int q) {
    const int j = l >> 1; const bool ev = (l & 1) == 0;
    if (ev) { int s, idx; if (q < 128) { s = 16 + (q >> 5); idx = q & 31; } else { const int r = q - 128; s = r >> 5; idx = r & 31; }
        chunk_scan<0>(P, C, j, s, idx >> 4, idx & 15, 0); }
    else { int s, idx; if (q < 64) { s = 16 + (q >> 4); idx = q & 15; } else { const int r = q - 64; s = r >> 4; idx = r & 15; }
        const int dir = idx >> 3, h = (idx >> 1) & 3, vs = idx & 1; if (type == 0) chunk_scan<1>(P, C, j, s, dir, h, vs); else chunk_scan<2>(P, C, j, s, dir, h, vs); }
}
__device__ __forceinline__ int queue_next(const Params& P, const Ctx& C, int l) {
    volatile LAS unsigned* qw = (volatile LAS unsigned*)(C.lds + LDS_BYTES - 16);
    __syncthreads();
    if (C.tid == 0) qw[3] = __hip_atomic_fetch_add((unsigned*)(P.ws + WS_CTL) + 6144 + 64 * l, 1u, __ATOMIC_RELAXED, __HIP_MEMORY_SCOPE_AGENT);
    __syncthreads();
    return __builtin_amdgcn_readfirstlane((int)qw[3]);
}
__device__ __forceinline__ void phase_scan(const Params& P, const Ctx& C0, int l) {
    const int G = C0.G, bid = C0.bid; const bool ev = (l & 1) == 0;
    if (ev) {
        if (G == 256) rwkv_pair(P, fresh_ctx(C0.lds), l >> 1, bid < 128 ? bid : bid - 128, bid < 128);
        else {
#pragma unroll 1
            for (int x = bid; x < 256; x += G) rwkv_pair(P, fresh_ctx(C0.lds), l >> 1, x < 128 ? x : x - 128, x < 128);
        }
#pragma unroll 1
        for (;;) { const Ctx C = fresh_ctx(C0.lds); const int x = queue_next(P, C, l); if (x >= 640) break; scan_unit(P, C, l, 0, x); }
        return;
    }
#pragma unroll 1
    for (;;) { const Ctx C = fresh_ctx(C0.lds); const int x = queue_next(P, C, l); if (x >= 640) break;
        int type, q; if (x < 128) { type = x >> 6; q = x & 63; } else { const int r = x - 128; type = r & 1; q = 64 + (r >> 1); }
        scan_unit(P, C, l, type, q); }
}

__device__ __forceinline__ void ld16(const bf16_t* p, float* o) { unpack8(*(const u32x4*)p, o); unpack8(*(const u32x4*)(p + 8), o + 8); }
__device__ __forceinline__ void ld16f(const float* p, float* o) {
#pragma unroll
    for (int q = 0; q < 4; ++q) { const f32x4 v = *(const f32x4*)(p + 4 * q); o[4 * q] = v.x; o[4 * q + 1] = v.y; o[4 * q + 2] = v.z; o[4 * q + 3] = v.w; } }
__device__ __forceinline__ void st16(bf16_t* p, const float* o) { *(u32x4*)p = pack8(o); *(u32x4*)(p + 8) = pack8(o + 8); }
struct R16 { u32x4 a, b; };
__device__ __forceinline__ R16 ldraw(const bf16_t* p) { R16 r; r.a = *(const u32x4*)p; r.b = *(const u32x4*)(p + 8); return r; }
__device__ __forceinline__ void cvt16(const R16& r, float* o) { unpack8(r.a, o); unpack8(r.b, o + 8); }
__device__ __forceinline__ void phase_post(const Params& P, const Ctx& C, int l) {
    const int j = l >> 1; const bool ev = (l & 1) == 0;
    const bf16_t* PROJ = (const bf16_t*)(P.ws + WS_PROJ); const bf16_t* PREP = (const bf16_t*)(P.ws + WS_PREP);
    const bf16_t* Y0 = (const bf16_t*)(P.ws + WS_MP); const bf16_t* Y1 = Y0 + (size_t)MTOK * YLD; bf16_t* MIX = (bf16_t*)(P.ws + WS_MIX);
    const int gw = C.bid * 8 + C.wave, NGW = C.G * 8, lane = C.lane, c0 = lane * 16;
#pragma unroll 1
    for (int m = gw; m < MTOK; m += NGW) {
        float ya[16], yb[16], t0[16], t1[16], o[16];
        if (ev) {
            const bf16_t* pp = PREP + (size_t)m * PREP_LD;
            const R16 rY0a = ldraw(Y0 + (size_t)m * YLD + c0), rY1a = ldraw(Y1 + (size_t)m * YLD + c0), rXS = ldraw(pp + c0), rSZ = ldraw(pp + 2048 + c0);
            const R16 rY0b = ldraw(Y0 + (size_t)m * YLD + 1024 + c0), rY1b = ldraw(Y1 + (size_t)m * YLD + 1024 + c0);
            const R16 rR = ldraw(pp + 3072 + c0), rK = ldraw(pp + 4096 + c0), rV = ldraw(pp + 5120 + c0), rG = ldraw(PROJ + (size_t)m * LOUT_LD + 4096 + c0);
            float pn[16], pw[16], pb[16], pk[16];
            ld16f(P.in[I_SSDN] + j * 1024 + c0, pn); ld16f(P.in[I_LNW] + j * 1024 + c0, pw); ld16f(P.in[I_LNB] + j * 1024 + c0, pb); ld16f(P.in[I_RK] + j * 1024 + c0, pk);
            cvt16(rY0a, ya); cvt16(rY1a, yb); cvt16(rXS, t0); cvt16(rSZ, t1);
            const float dsk = P.in[I_SSDD][j * 16 + (lane >> 2)]; float ss = 0.f;
#pragma unroll
            for (int e = 0; e < 16; ++e) { o[e] = (ya[e] + yb[e] + t0[e] * dsk) * t1[e]; ss += o[e] * o[e]; }
            const float rs = rsqrtf(wave_sum(ss) * (1.f / 1024.f) + 1e-6f);
#pragma unroll
            for (int e = 0; e < 16; ++e) o[e] = o[e] * rs * pn[e];
            st16(MIX + (size_t)m * 2048 + c0, o);
            cvt16(rY0b, ya); cvt16(rY1b, yb);
            float mu = 0.f;
#pragma unroll
            for (int e = 0; e < 16; ++e) { ya[e] += yb[e]; mu += ya[e]; }
            mu += __shfl_xor(mu, 1); mu += __shfl_xor(mu, 2); mu *= (1.f / 64.f);
            float var = 0.f;
#pragma unroll
            for (int e = 0; e < 16; ++e) { ya[e] -= mu; var += ya[e] * ya[e]; }
            var += __shfl_xor(var, 1); var += __shfl_xor(var, 2); var *= (1.f / 64.f);
            const float rstd = rsqrtf(var + 64e-5f);
#pragma unroll
            for (int e = 0; e < 16; ++e) o[e] = ya[e] * rstd * pw[e] + pb[e];
            cvt16(rR, ya); cvt16(rK, yb);
            float bs = 0.f;
#pragma unroll
            for (int e = 0; e < 16; ++e) bs += ya[e] * yb[e] * pk[e];
            bs += __shfl_xor(bs, 1); bs += __shfl_xor(bs, 2);
            cvt16(rV, ya); cvt16(rG, yb);
#pragma unroll
            for (int e = 0; e < 16; ++e) o[e] = (o[e] + bs * ya[e]) * yb[e];
            st16(MIX + (size_t)m * 2048 + 1024 + c0, o);
        } else {
            const bf16_t* pr = PROJ + (size_t)m * PROJ_LD_CD;
            const R16 rA0 = ldraw(Y0 + (size_t)m * YLD + c0), rB0 = ldraw(Y1 + (size_t)m * YLD + c0), rA1 = ldraw(Y0 + (size_t)m * YLD + 1024 + c0), rB1 = ldraw(Y1 + (size_t)m * YLD + 1024 + c0);
            const R16 rG0 = ldraw(pr + 2048 + c0), rG1 = ldraw(pr + IN_GLA + 2048 + c0);
            float pg[16], pm[16]; ld16f(P.in[I_GLAN] + j * 1024 + c0, pg); ld16f(P.in[I_MLN] + j * 1024 + c0, pm);
#pragma unroll
            for (int g = 0; g < 2; ++g) {
                cvt16(g == 0 ? rA0 : rA1, ya); cvt16(g == 0 ? rB0 : rB1, yb);
                float ss = 0.f;
#pragma unroll
                for (int e = 0; e < 16; ++e) { ya[e] += yb[e]; ss += ya[e] * ya[e]; }
                ss += __shfl_xor(ss, 1); ss += __shfl_xor(ss, 2); ss += __shfl_xor(ss, 4); ss += __shfl_xor(ss, 8);
                const float rs = rsqrtf(ss * (1.f / 256.f) + 1e-6f);
                cvt16(g == 0 ? rG0 : rG1, t1);
#pragma unroll
                for (int e = 0; e < 16; ++e) o[e] = ya[e] * rs * (g == 0 ? pg[e] : pm[e]) * (g == 0 ? siluf_(t1[e]) : sigmoidf_(t1[e]));
                st16(MIX + (size_t)m * 2048 + g * 1024 + c0, o);
            }
        }
    }
}

__global__ void __launch_bounds__(512, 2) hybrid_fwd(Params P) {
    extern __shared__ __attribute__((aligned(16))) unsigned char lds_raw[];
    cg::grid_group grid = cg::this_grid();
    Ctx C; C.lds = (LAS unsigned char*)lds_raw; C.tid = threadIdx.x; C.lane = C.tid & 63; C.wave = __builtin_amdgcn_readfirstlane(C.tid >> 6); C.G = gridDim.x; C.bid = blockIdx.x;
    const float* MOD = (const float*)(P.ws + WS_MOD);
    const bf16_t* H = (const bf16_t*)(P.ws + WS_H);
    if (C.tid < 4) ((volatile LAS unsigned*)(C.lds + LDS_BYTES - 16))[C.tid] = 0u;
    __syncthreads();
    const XcdBarrier xb = xcd_barrier_post((unsigned*)(P.ws + WS_CTL), (volatile LAS unsigned*)(C.lds + LDS_BYTES - 16));
    REP(1) if (PH & 1) phase_mod(P, fresh_ctx(C.lds));
    REP(2) if (PH & 2) phase_convert(P, fresh_ctx(C.lds), 0);
    grid.sync();
    if (PH & 4) phase_rows(P, fresh_ctx(C.lds), 0, nullptr, nullptr, true, P.in[I_NORMG] + 0, MOD + 0);
    GSYNC();
#pragma unroll 1
    for (int l = 0; l < 4; ++l) {
        const bool ev = (l & 1) == 0; const float* modl = MOD + (size_t)l * 5 * 6144; const float* ng = P.in[I_NORMG] + l * 4 * 1024;
        REP(8) if (PH & 8) { pg8::Gemm g{H, (const bf16_t*)(P.ws + WS_WIN), 1024, 1024, 1024}; pg8::Sched<0> S; S.init(MTOK, ev ? N_AB_P : N_CD_P, 1, 1024, C.G, C.bid);
          pg8::EpiBf16<0> E{(bf16_t*)(P.ws + WS_PROJ), ev ? PROJ_LD_AB : PROJ_LD_CD, 0}; pg8::gemm_phase(C.lds, g, S, E); }
        GSYNC();
        REP(16) if (PH & 16) { if (ev) phase_prep_even(P, fresh_ctx(C.lds), l >> 1); else phase_prep_odd(P, fresh_ctx(C.lds), l >> 1); }
        GSYNC();
        if (ev && (PH & 32)) {
            REP(32) {
            pg8::Gemm g{(const bf16_t*)(P.ws + WS_LORAA), (const bf16_t*)(P.ws + WS_WLORA), LORA_K, 128, 128}; pg8::Sched<1> S; S.init(MTOK, LOUT_LD, 1, 128, C.G, C.bid);
            pg8::EpiBf16<0> E{(bf16_t*)(P.ws + WS_PROJ), LOUT_LD, 0}; pg8::gemm_phase(C.lds, g, S, E); }
            GSYNC();
        }
        for (int rep_ = 0; rep_ < (((DUP & 64) && ev) || ((DUP & 0x4000) && !ev) ? 2 : 1); ++rep_) if (PH & 64) phase_scan(P, fresh_ctx(C.lds), l);
        GSYNC();
        REP(128) if (PH & 128) phase_post(P, fresh_ctx(C.lds), l);
        GSYNC();
        REP(256) if (PH & 256) { pg8::Gemm g{(const bf16_t*)(P.ws + WS_MIX), (const bf16_t*)(P.ws + WS_WOUT), 2048, 2048, 1024}; pg8::Sched<0> S; S.init(MTOK, 1024, 2, 1024, C.G, C.bid);
          pg8::EpiBf16<0> E{(bf16_t*)(P.ws + WS_MP), 1024, (size_t)MTOK * 1024}; pg8::gemm_phase(C.lds, g, S, E); }
        GSYNC();
        if (DUP & 512) phase_rows(P, fresh_ctx(C.lds), 1, ng + 1024, modl + 2048, true, ng + 2048, modl + 3072, true);
        if (PH & 512) phase_rows(P, fresh_ctx(C.lds), 1, ng + 1024, modl + 2048, true, ng + 2048, modl + 3072);
        GSYNC();
        REP(1024) if (PH & 1024) { pg8::Gemm g{H, (const bf16_t*)(P.ws + WS_WUP), 1024, 1024, 1024}; pg8::Sched<0> S; S.init(MTOK, 4096, 1, 1024, C.G, C.bid);
          pg8::EpiBf16<2> E{(bf16_t*)(P.ws + WS_PROJ), 4096, 0}; pg8::gemm_phase(C.lds, g, S, E); }
        GSYNC();
        REP(2048) if (PH & 2048) { pg8::Gemm g{(const bf16_t*)(P.ws + WS_PROJ), (const bf16_t*)(P.ws + WS_WDN), 4096, 4096, 2048}; pg8::Sched<0> S; S.init(MTOK, 1024, 2, 2048, C.G, C.bid);
          pg8::EpiBf16<0> E{(bf16_t*)(P.ws + WS_MP), 1024, (size_t)MTOK * 1024}; pg8::gemm_phase(C.lds, g, S, E); }
        GSYNC();
        if (DUP & 4096) phase_rows(P, fresh_ctx(C.lds), 1, ng + 3072, modl + 5120, true, ng + 2048, modl + 3072, true);
        if (PH & 4096) { if (l < 3) { phase_rows(P, fresh_ctx(C.lds), 1, ng + 3072, modl + 5120, true, ng + 4096, modl + 5 * 6144); phase_convert(P, fresh_ctx(C.lds), l + 1); }
        else phase_rows(P, fresh_ctx(C.lds), 1, ng + 3072, modl + 5120, false, nullptr, nullptr); }
        if (l < 3) GSYNC();
    }
}

extern "C" void kernel_launch(void* const* d_in, const int* in_sizes, int n_in, void* d_out, int out_size, void* d_ws, size_t ws_size, hipStream_t stream) {
    static int grid = 0;
    if (grid == 0) {
        if (n_in != 44 || ws_size < WS_END) { fprintf(stderr, "kernel_launch: unexpected n_in %d / ws %zu\n", n_in, ws_size); grid = -1; return; }
        int dev = 0, cus = 0, per_cu = 0;
        hipGetDevice(&dev); hipDeviceGetAttribute(&cus, hipDeviceAttributeMultiprocessorCount, dev);
        if (hipFuncSetAttribute((const void*)hybrid_fwd, hipFuncAttributeMaxDynamicSharedMemorySize, LDS_BYTES) != hipSuccess) { fprintf(stderr, "hipFuncSetAttribute failed\n"); grid = -1; return; }
        hipOccupancyMaxActiveBlocksPerMultiprocessor(&per_cu, (const void*)hybrid_fwd, 512, LDS_BYTES);
        (void)hipGetLastError();
        if (per_cu < 1) per_cu = 1;
        grid = cus * 1;
    }
    if (grid < 0) return;
    if (hipMemsetAsync((char*)d_ws + WS_CTL, 0, CTL_BYTES, stream) != hipSuccess) { fprintf(stderr, "memset failed\n"); return; }
    Params p{};
    for (int i = 0; i < 44; ++i) p.in[i] = (const float*)d_in[i];
    p.out = (float*)d_out; p.ws = (unsigned char*)d_ws;
    void* args[] = {&p};
    hipError_t e = hipLaunchCooperativeKernel((const void*)hybrid_fwd, dim3(grid), dim3(512), args, LDS_BYTES, stream);
    if (e != hipSuccess) fprintf(stderr, "cooperative launch failed: %s (grid %d)\n", hipGetErrorString(e), grid);
}
```

```cpp
#include <hip/hip_runtime.h>
#include <hip/hip_cooperative_groups.h>
#include <cstdio>
#include <cstdint>
namespace cg = cooperative_groups;

#define LAS __attribute__((address_space(3)))
typedef unsigned short bf16_t;
typedef short bf16x8 __attribute__((ext_vector_type(8)));
typedef float f32x4 __attribute__((ext_vector_type(4)));
typedef float f32x2 __attribute__((ext_vector_type(2)));
typedef unsigned u32x4 __attribute__((ext_vector_type(4)));
typedef unsigned u32x2 __attribute__((ext_vector_type(2)));

constexpr int MTOK = 8192, DM = 1024, DFF = 4096;
constexpr int N_AB = 6560, N_AB_P = 6656, N_CD = 6192, N_CD_P = 6400;
constexpr int PROJ_LD_AB = N_AB_P, PROJ_LD_CD = N_CD_P;
constexpr int PREP_LD = 7168, LOUT_LD = 5120, LORA_K = 384, YLD = 2048;
constexpr int IN_SSD = 3104, IN_GLA = 3104;
constexpr size_t MiB = 1u << 20;
constexpr size_t WS_MOD = 0, WS_CTL = 512 * 1024, CTL_BYTES = 32768, WS_DT = 1 * MiB, WS_DA = 3 * MiB, WS_WIN = 5 * MiB, WS_WOUT = 19 * MiB, WS_WUP = 23 * MiB, WS_WDN = 31 * MiB,
                 WS_WLORA = 39 * MiB, WS_H = 41 * MiB, WS_PROJ = 57 * MiB, WS_PREP = 161 * MiB, WS_MIX = 273 * MiB, WS_MP = 305 * MiB,
                 WS_LORAA = 369 * MiB, WS_END = 375 * MiB;
constexpr size_t O_X = 0, O_SSD = 8388608, O_RWKV = 16777216, O_GLA = 20971520, O_MC = 29360128, O_MN = 37748736, O_MM = 37781504;

struct Params { const float* in[44]; float* out; unsigned char* ws; };
enum { I_XP = 0, I_XS, I_SSSD, I_SRWKV, I_SGLA, I_SMC, I_SMN, I_SMM, I_C, I_CCTX, I_WMOD, I_BMOD, I_NORMG, I_WUP, I_WDN, I_WINAB, I_SCONVW, I_SCONVB,
       I_DTB, I_ALOG, I_SSDD, I_SSDN, I_MU, I_W0, I_W2, I_A0, I_A2, I_G2, I_KK, I_KA, I_RK, I_LNW, I_LNB, I_WOUTAB, I_WINCD, I_GGW, I_GGB, I_GLAN,
       I_MCONVW, I_MCONVB, I_MIB, I_MFB, I_MLN, I_WOUTCD };

__device__ __forceinline__ float bf2f(unsigned b) { return __uint_as_float(b << 16); }
__device__ __forceinline__ unsigned f2bf(float f) { unsigned u = __float_as_uint(f); return (u + 0x7fffu + ((u >> 16) & 1u)) >> 16; }
typedef __bf16 bf16x2_hw __attribute__((ext_vector_type(2)));
__device__ __forceinline__ unsigned pk2(float lo, float hi) { const f32x2 v = {lo, hi}; const bf16x2_hw b = __builtin_convertvector(v, bf16x2_hw); return __builtin_bit_cast(unsigned, b); }
__device__ __forceinline__ float lo16(unsigned w) { return __uint_as_float(w << 16); }
__device__ __forceinline__ float hi16(unsigned w) { return __uint_as_float(w & 0xffff0000u); }
__device__ __forceinline__ void unpack8(u32x4 w, float* o) { o[0] = lo16(w.x); o[1] = hi16(w.x); o[2] = lo16(w.y); o[3] = hi16(w.y); o[4] = lo16(w.z); o[5] = hi16(w.z); o[6] = lo16(w.w); o[7] = hi16(w.w); }
__device__ __forceinline__ f32x4 unpack4(u32x2 w) { return (f32x4){lo16(w.x), hi16(w.x), lo16(w.y), hi16(w.y)}; }
__device__ __forceinline__ u32x4 pack8(const float* o) { u32x4 w; w.x = pk2(o[0], o[1]); w.y = pk2(o[2], o[3]); w.z = pk2(o[4], o[5]); w.w = pk2(o[6], o[7]); return w; }
__device__ __forceinline__ float sigmoidf_(float x) { return 1.f / (1.f + __expf(-x)); }
__device__ __forceinline__ float siluf_(float x) { return x / (1.f + __expf(-x)); }
__device__ __forceinline__ float softplusf_(float x) { return fmaxf(x, 0.f) + __logf(1.f + __expf(-fabsf(x))); }
__device__ __forceinline__ float logsigmoidf_(float x) { return fminf(x, 0.f) - __logf(1.f + __expf(-fabsf(x))); }
__device__ __forceinline__ float tanhf_(float x) { const float e = __expf(-2.f * fabsf(x)); const float r = (1.f - e) / (1.f + e); return x < 0.f ? -r : r; }
__device__ __forceinline__ float wave_sum(float v) {
#pragma unroll
    for (int o = 1; o < 64; o <<= 1) v += __shfl_xor(v, o);
    return v;
}
__device__ __forceinline__ float quad_sum(float x) {
    x += __int_as_float(__builtin_amdgcn_update_dpp(0, __float_as_int(x), 0xB1, 0xF, 0xF, true));
    x += __int_as_float(__builtin_amdgcn_update_dpp(0, __float_as_int(x), 0x4E, 0xF, 0xF, true));
    return x;
}

#define DPP_ADD(x, ctrl) ((x) + __int_as_float(__builtin_amdgcn_update_dpp(0, __float_as_int(x), (ctrl), 0xF, 0xF, true)))
__device__ __forceinline__ float row_sum8(float x) { x = DPP_ADD(x, 0xB1); x = DPP_ADD(x, 0x4E); x = DPP_ADD(x, 0x141); return x; }
__device__ __forceinline__ float row_sum16(float x) { x = row_sum8(x); x = DPP_ADD(x, 0x140); return x; }
namespace pg8 {
constexpr int BM = 256, BK = 64, HALF = 128, HTB = HALF * BK * 2, STAGE_BYTES = 8 * HTB, NXCD = 8, WGM = 8;
__host__ __device__ __forceinline__ int lds_byte(int r, int c) { const int st = (r >> 4) * 2 + (c >> 5), rr = r & 15, cc = c & 31, ob = rr * 64 + cc * 2; return st * 1024 + (ob ^ (((ob >> 9) & 1) << 5)); }
__host__ __device__ __forceinline__ void stage_rc(int b, int& R, int& C) { const int st = b / 1024, sb = b % 1024, swz = sb ^ (((sb >> 9) & 1) << 5); R = (st >> 1) * 16 + swz / 64; C = (st & 1) * 32 + (swz % 64) / 2; }
__host__ __device__ __forceinline__ int perm32(int rho) { const int n = rho >> 4, i = rho & 15; return 8 * (i >> 2) + 4 * n + (i & 3); }

struct Unit { int pm, pn, ks; };
struct Gemm { const bf16_t* A; const bf16_t* Bt; int lda, ldb, K; };
template <int mode> struct Sched {
    int nM, nN, nNv, nwg, G, c, K;
    __device__ void init(int M, int N, int nK, int K_, int G_, int c_) { nM = M / BM; nN = N / BM; nNv = nN * nK; nwg = nM * nNv; G = G_; c = c_; K = K_; }
    __device__ bool next(int i, Unit& u) const {
        const long L = (long)i * G + c; if (L >= nwg) return false;
        int wgid = (int)L; { const int q = nwg / NXCD, r = nwg % NXCD, xcd = wgid % NXCD, off = wgid / NXCD; wgid = (xcd < r ? xcd * (q + 1) : r * (q + 1) + (xcd - r) * q) + off; }
        const int nig = WGM * nNv, gid = wgid / nig, fm = gid * WGM, gsz = (nM - fm) < WGM ? (nM - fm) : WGM;
        u.pm = fm + ((wgid % nig) % gsz); const int pnv = (wgid % nig) / gsz; u.pn = pnv % nN; u.ks = pnv / nN; return true;
    }
    __device__ __forceinline__ size_t aoff(const Unit& u) const { if (mode == 1) { const int g = u.pn >> 2; return (size_t)(g < 2 ? 0 : (g < 4 ? 128 : 256)) * 2; } return (size_t)u.ks * K * 2; }
    __device__ __forceinline__ size_t boff(const Unit& u) const { return mode == 1 ? 0 : (size_t)u.ks * K * 2; }
};

__device__ __forceinline__ unsigned cvt_pk_bf16(float lo, float hi) { unsigned r; asm volatile("v_cvt_pk_bf16_f32 %0, %1, %2" : "=v"(r) : "v"(lo), "v"(hi)); return r; }

template <int ACT> struct EpiBf16 {
    static constexpr bool PERM = true;
    bf16_t* O; int ldc; size_t pstride;
    __device__ __forceinline__ void operator()(const f32x4 (&acc)[2][2][4][2], const Unit& u, int wr, int wc, int fr, int fq) const {
        const int row0 = u.pm * BM + wr * 64 + fr; const int col0 = u.pn * BM + wc * 32 + 8 * fq; bf16_t* Ob = O + (size_t)u.ks * pstride;
#pragma unroll
        for (int ai = 0; ai < 2; ++ai)
#pragma unroll
            for (int m = 0; m < 4; ++m) { bf16_t* rowp = Ob + (size_t)(row0 + ai * HALF + m * 16) * ldc + col0;
#pragma unroll
                for (int bj = 0; bj < 2; ++bj) { f32x4 v0 = acc[ai][bj][m][0], v1 = acc[ai][bj][m][1];
                    if (ACT == 2) {
#pragma unroll
                        for (int e = 0; e < 4; ++e) { const float a = fmaxf(v0[e], 0.f), b = fmaxf(v1[e], 0.f); v0[e] = a * a; v1[e] = b * b; } }
                    u32x4 w; w.x = cvt_pk_bf16(v0[0], v0[1]); w.y = cvt_pk_bf16(v0[2], v0[3]); w.z = cvt_pk_bf16(v1[0], v1[1]); w.w = cvt_pk_bf16(v1[2], v1[3]);
                    *(u32x4*)(rowp + bj * HALF) = w; } }
    }
};
struct EpiF32 {
    static constexpr bool PERM = false;
    float* O; int ldc; size_t pstride;
    __device__ __forceinline__ void operator()(const f32x4 (&acc)[2][2][4][2], const Unit& u, int wr, int wc, int fr, int fq) const {
        float* base = O + (size_t)u.ks * pstride; const int col0 = u.pn * BM + wc * 32 + 4 * fq;
#pragma unroll
        for (int ai = 0; ai < 2; ++ai)
#pragma unroll
            for (int m = 0; m < 4; ++m) { float* rowp = base + (size_t)(u.pm * BM + ai * HALF + wr * 64 + m * 16 + fr) * ldc + col0;
#pragma unroll
                for (int bj = 0; bj < 2; ++bj)
#pragma unroll
                    for (int n = 0; n < 2; ++n) *(f32x4*)(rowp + bj * HALF + n * 16) = acc[ai][bj][m][n]; }
    }
};

template <class Epi, class SchedT>
__device__ __forceinline__ void gemm_phase(LAS unsigned char* lds, const Gemm g, const SchedT& S, const Epi& E) {
    int tid_ = threadIdx.x; asm volatile("" : "+v"(tid_));
    const int tid = tid_, wid = __builtin_amdgcn_readfirstlane(tid >> 6), lane = tid & 63, wr = wid >> 2, wc = wid & 3, fr = lane & 15, fq = lane >> 4;
    int K_ = g.K; asm volatile("" : "+s"(K_));
    const int K = K_, nt = K / BK;
    unsigned voffA[2], voffB[2];
#pragma unroll
    for (int i = 0; i < 2; ++i) { int R, C; stage_rc(tid * 16 + i * 8192, R, C); const int Rb = Epi::PERM ? ((R & ~31) + perm32(R & 31)) : R;
        voffA[i] = (unsigned)(R * g.lda + C) * 2u; voffB[i] = (unsigned)(Rb * g.ldb + C) * 2u; }
    const size_t kstep = (size_t)(BK * 2);
    const size_t hstepA = (size_t)HALF * g.lda * 2, hstepB = (size_t)HALF * g.ldb * 2;
    const size_t tstepA = 2 * hstepA, tstepB = 2 * hstepB;
    const unsigned ldsw = (unsigned)wid * 1024u;
    const int aoff = lds_byte(wr * 64 + fr, fq * 8), boff = lds_byte(wc * 32 + fr, fq * 8);
#define PG8_SA(b, h) (((b) * 2 + (h)) * HTB)
#define PG8_SB(b, h) ((4 + (b) * 2 + (h)) * HTB)
#define PG8_STAGE(bufoff, gbase, voff) do { _Pragma("unroll") for (int _i = 0; _i < 2; ++_i) \
        __builtin_amdgcn_global_load_lds((const unsigned*)((const char*)(gbase) + (voff)[_i]), (LAS unsigned*)(lds + (bufoff) + ldsw + _i * 8192), 16, 0, 0); } while (0)
#define PG8_LDA(dst, b, h) do { _Pragma("unroll") for (int m = 0; m < 4; ++m) _Pragma("unroll") for (int k = 0; k < 2; ++k) dst[m][k] = *(const LAS bf16x8*)(lds + PG8_SA(b, h) + aoff + m * 2048 + k * 1024); } while (0)
#define PG8_LDB(dst, b, h) do { _Pragma("unroll") for (int n = 0; n < 2; ++n) _Pragma("unroll") for (int k = 0; k < 2; ++k) dst[n][k] = *(const LAS bf16x8*)(lds + PG8_SB(b, h) + boff + n * 2048 + k * 1024); } while (0)
#define PG8_MMA(ai, bj, At, Bt) do { __builtin_amdgcn_s_setprio(1); _Pragma("unroll") for (int m = 0; m < 4; ++m) _Pragma("unroll") for (int n = 0; n < 2; ++n) _Pragma("unroll") for (int k = 0; k < 2; ++k) \
        acc[ai][bj][m][n] = __builtin_amdgcn_mfma_f32_16x16x32_bf16(Bt[n][k], At[m][k], acc[ai][bj][m][n], 0, 0, 0); __builtin_amdgcn_s_setprio(0); } while (0)
#define PG8_WAIT_V(n) asm volatile("s_waitcnt vmcnt(" #n ")" ::: "memory")
#define PG8_WAIT_L(n) asm volatile("s_waitcnt lgkmcnt(" #n ")" ::: "memory")
#define PG8_BAR __builtin_amdgcn_s_barrier()
#define PG8_SCHED __builtin_amdgcn_sched_barrier(0)
    Unit cur, nxt; int ui = 0;
    if (!S.next(0, cur)) return;
    f32x4 acc[2][2][4][2];
#pragma unroll
    for (int a = 0; a < 2; ++a)
#pragma unroll
        for (int b = 0; b < 2; ++b)
#pragma unroll
            for (int m = 0; m < 4; ++m)
#pragma unroll
                for (int n = 0; n < 2; ++n) acc[a][b][m][n] = (f32x4){0.f, 0.f, 0.f, 0.f};
    bf16x8 At[4][2], B0[2][2], B1[2][2];
    const char* cA = (const char*)g.A + (size_t)cur.pm * tstepA + S.aoff(cur); const char* cB = (const char*)g.Bt + (size_t)cur.pn * tstepB + S.boff(cur);
    PG8_STAGE(PG8_SB(0, 0), cB, voffB); PG8_STAGE(PG8_SB(0, 1), cB + hstepB, voffB); PG8_STAGE(PG8_SA(0, 0), cA, voffA); PG8_STAGE(PG8_SA(0, 1), cA + hstepA, voffA);
    if (wr == 1) PG8_BAR;
    PG8_WAIT_V(2); PG8_BAR;
    PG8_STAGE(PG8_SB(1, 0), cB + kstep, voffB); PG8_STAGE(PG8_SA(1, 0), cA + kstep, voffA); PG8_STAGE(PG8_SB(1, 1), cB + hstepB + kstep, voffB);
    PG8_WAIT_V(6); PG8_BAR;
    for (;;) {
        const bool has_next = S.next(ui + 1, nxt);
        const char* nA = has_next ? (const char*)g.A + (size_t)nxt.pm * tstepA + S.aoff(nxt) : cA; const char* nB = has_next ? (const char*)g.Bt + (size_t)nxt.pn * tstepB + S.boff(nxt) : cB;
        for (int t = 0; t < nt; t += 2) {
            const bool last = (t == nt - 2);
            const char* a1 = cA + (size_t)(t + 1) * kstep;
            const char* a2 = last ? nA : cA + (size_t)(t + 2) * kstep; const char* b2 = last ? nB : cB + (size_t)(t + 2) * kstep;
            const char* a3 = a2 + kstep; const char* b3 = b2 + kstep;
            PG8_LDB(B0, 0, 0); PG8_LDB(B1, 0, 1); PG8_SCHED; PG8_LDA(At, 0, 0); PG8_STAGE(PG8_SA(1, 1), a1 + hstepA, voffA);
            PG8_WAIT_V(8); PG8_WAIT_L(0); PG8_BAR; PG8_MMA(0, 0, At, B0); PG8_MMA(0, 1, At, B1); PG8_BAR; PG8_SCHED;
            PG8_LDA(At, 0, 1); PG8_STAGE(PG8_SB(0, 0), b2, voffB); PG8_STAGE(PG8_SB(0, 1), b2 + hstepB, voffB); PG8_STAGE(PG8_SA(0, 0), a2, voffA);
            PG8_WAIT_V(8); PG8_WAIT_L(0); PG8_BAR; PG8_MMA(1, 0, At, B0); PG8_MMA(1, 1, At, B1); PG8_BAR; PG8_SCHED;
            PG8_LDB(B0, 1, 0); PG8_LDB(B1, 1, 1); PG8_SCHED; PG8_LDA(At, 1, 0); PG8_STAGE(PG8_SA(0, 1), a2 + hstepA, voffA);
            PG8_WAIT_V(8); PG8_WAIT_L(0); PG8_BAR; PG8_MMA(0, 0, At, B0); PG8_MMA(0, 1, At, B1); PG8_BAR; PG8_SCHED;
            PG8_LDA(At, 1, 1); PG8_STAGE(PG8_SB(1, 0), b3, voffB); PG8_STAGE(PG8_SB(1, 1), b3 + hstepB, voffB); PG8_STAGE(PG8_SA(1, 0), a3, voffA);
            PG8_WAIT_V(8); PG8_WAIT_L(0); PG8_BAR; PG8_MMA(1, 0, At, B0); PG8_MMA(1, 1, At, B1); PG8_BAR; PG8_SCHED;
        }
        if (wr == 0) PG8_BAR;
        E(acc, cur, wr, wc, fr, fq);
        if (!has_next) break;
#pragma unroll
        for (int a = 0; a < 2; ++a)
#pragma unroll
            for (int b = 0; b < 2; ++b)
#pragma unroll
                for (int m = 0; m < 4; ++m)
#pragma unroll
                    for (int n = 0; n < 2; ++n) acc[a][b][m][n] = (f32x4){0.f, 0.f, 0.f, 0.f};
        cur = nxt; cA = nA; cB = nB; ++ui;
        if (wr == 1) PG8_BAR;
    }
    PG8_WAIT_V(0);
    PG8_BAR;
#undef PG8_SA
#undef PG8_SB
#undef PG8_STAGE
#undef PG8_LDA
#undef PG8_LDB
#undef PG8_MMA
#undef PG8_WAIT_V
#undef PG8_WAIT_L
#undef PG8_BAR
#undef PG8_SCHED
}
}

#define XB_TMO      128
#define XB_XCNT(j)  (256  + 64 * (j))
#define XB_XSUB(j)  (1280 + 64 * (j))
#define XB_XGEN(j)  (2304 + 64 * (j))
#define XB_TOP      3328
#define XB_TOPGEN   3392
#define XCD_BAR_WORDS 3456
#define XB_SPIN_CAP (1u << 18)
__device__ __forceinline__ unsigned xb_ld(unsigned* p)              { return __hip_atomic_load(p, __ATOMIC_RELAXED, __HIP_MEMORY_SCOPE_AGENT); }
__device__ __forceinline__ unsigned xb_add(unsigned* p, unsigned v) { return __hip_atomic_fetch_add(p, v, __ATOMIC_RELAXED, __HIP_MEMORY_SCOPE_AGENT); }
__device__ __forceinline__ unsigned xb_xcc_id() { return (unsigned)__builtin_amdgcn_s_getreg((3 << 11) | 20) & 0xFu; }
#define XB_SPIN(cond, bar) do { unsigned _sp = 0; while (cond) { __builtin_amdgcn_s_sleep(1); \
    if ((++_sp & 255u) == 0u) { if (xb_ld(&(bar)[XB_TMO])) break; if (_sp > XB_SPIN_CAP) { atomicAdd(&(bar)[XB_TMO], 1u); break; } } } } while (0)
struct XcdBarrier { unsigned* bar; unsigned x; volatile LAS unsigned* st; };
__device__ __forceinline__ XcdBarrier xcd_barrier_post(unsigned* bar, volatile LAS unsigned* st) {
    XcdBarrier b; b.bar = bar; b.x = xb_xcc_id(); b.st = st;
    if (threadIdx.x == 0) (void)xb_add(&bar[XB_XCNT(b.x)], 1u);
    return b;
}
__device__ __forceinline__ void xcd_barrier_complete(unsigned* bar, unsigned x, unsigned& nloc, unsigned& nx) {
    const unsigned G = gridDim.x * gridDim.y * gridDim.z;
    unsigned sum, cnt, mine, sp = 0u;
    for (;;) {
        sum = 0u; cnt = 0u; mine = 0u;
#pragma unroll
        for (unsigned j = 0; j < 16; ++j) { const unsigned c = xb_ld(&bar[XB_XCNT(j)]); sum += c; cnt += (c > 0u) ? 1u : 0u; mine = (j == x) ? c : mine; }
        if (sum == G) break;
        __builtin_amdgcn_s_sleep(1);
        if ((++sp & 255u) == 0u) { if (xb_ld(&bar[XB_TMO])) break; if (sp > XB_SPIN_CAP) { atomicAdd(&bar[XB_TMO], 1u); break; } }
    }
    nloc = mine > 0u ? mine : 1u; nx = cnt > 0u ? cnt : 1u;
}
__device__ __forceinline__ void xcd_barrier(const XcdBarrier& b) {
    asm volatile("s_waitcnt vmcnt(0)" ::: "memory");
    __syncthreads();
    if (threadIdx.x == 0) {
        unsigned* bar = b.bar;
        __builtin_amdgcn_s_waitcnt(0);
        unsigned nloc = b.st[0], nx = b.st[1];
        if (nloc == 0u) { xcd_barrier_complete(bar, b.x, nloc, nx); b.st[0] = nloc; b.st[1] = nx; }
        const unsigned old = xb_add(&bar[XB_XSUB(b.x)], 1u);
        const unsigned gen = old / nloc;
        if (old + 1u == (gen + 1u) * nloc) {
            __builtin_amdgcn_fence(__ATOMIC_RELEASE, "agent");
            asm volatile("s_waitcnt vmcnt(0)" ::: "memory");
            const unsigned og = xb_add(&bar[XB_TOP], 1u);
            const unsigned tg = og / nx;
            if (og + 1u == (tg + 1u) * nx) xb_add(&bar[XB_TOPGEN], 1u);
            else XB_SPIN(xb_ld(&bar[XB_TOPGEN]) == tg, bar);
            __builtin_amdgcn_fence(__ATOMIC_ACQUIRE, "agent");
            xb_add(&bar[XB_XGEN(b.x)], 1u);
            asm volatile("s_waitcnt vmcnt(0)" ::: "memory");
        } else {
            XB_SPIN(xb_ld(&bar[XB_XGEN(b.x)]) == gen, bar);
            __builtin_amdgcn_fence(__ATOMIC_ACQUIRE, "agent");
            asm volatile("s_waitcnt vmcnt(0)" ::: "memory");
        }
    }
    __syncthreads();
}

constexpr int LDS_BYTES = 147456;
#ifndef PH
#define PH 0xFFFF
#endif
#ifndef DUP
#define DUP 0
#endif
#define GSYNC() do { xcd_barrier(xb); if (DUP & 0x8000) { xcd_barrier(xb); xcd_barrier(xb); } } while (0)
#define REP(bit) for (int rep_ = 0; rep_ < ((DUP & (bit)) ? 2 : 1); ++rep_)
struct Ctx { LAS unsigned char* lds; int tid, lane, wave, G, bid; };
__device__ __forceinline__ Ctx fresh_ctx(LAS unsigned char* lds) { Ctx C; int t = threadIdx.x; asm volatile("" : "+v"(t)); C.lds = lds; C.tid = t; C.lane = t & 63; C.wave = __builtin_amdgcn_readfirstlane(t >> 6); C.G = gridDim.x; C.bid = blockIdx.x; return C; }

__device__ __forceinline__ void phase_mod(const Params& P, const Ctx& C) {
    LAS float* sc = (LAS float*)C.lds; LAS float* red = sc + 5120;
    for (int i = C.tid; i < 5120; i += 512) { const int r = i >> 10, k = i & 1023; const float x = r == 0 ? P.in[I_CCTX][k] : P.in[I_C][(r - 1) * 1024 + k]; sc[i] = siluf_(x); }
    __syncthreads();
    float* MOD = (float*)(P.ws + WS_MOD);
    const int kg = C.tid >> 5, c = C.tid & 31;
    for (int tile = C.bid; tile < 768; tile += C.G) {
        const int l = tile / 192, col = (tile % 192) * 32 + c;
        const float* w = P.in[I_WMOD] + (size_t)l * 1024 * 6144 + col;
        float a0 = 0.f, a1 = 0.f, a2 = 0.f, a3 = 0.f, a4 = 0.f;
#pragma unroll 32
        for (int k = kg * 64; k < kg * 64 + 64; ++k) { const float wv = w[(size_t)k * 6144]; a0 += sc[k] * wv; a1 += sc[1024 + k] * wv; a2 += sc[2048 + k] * wv; a3 += sc[3072 + k] * wv; a4 += sc[4096 + k] * wv; }
        red[(kg * 5 + 0) * 32 + c] = a0; red[(kg * 5 + 1) * 32 + c] = a1; red[(kg * 5 + 2) * 32 + c] = a2; red[(kg * 5 + 3) * 32 + c] = a3; red[(kg * 5 + 4) * 32 + c] = a4;
        __syncthreads();
        if (C.tid < 160) { const int r = C.tid >> 5; float s = 0.f;
#pragma unroll
            for (int q = 0; q < 16; ++q) s += red[(q * 5 + r) * 32 + c];
            MOD[(size_t)(l * 5 + r) * 6144 + col] = s + P.in[I_BMOD][l * 6144 + col]; }
        __syncthreads();
    }
}

__device__ __forceinline__ void transpose_item(const float* W, int K, int N, bf16_t* WT, LAS float* scr, int item, int nblk, int lane) {
    const int kb = item / nblk, nb = item % nblk, k0 = 64 * kb, n0 = 32 * nb;
    const bool nok = (n0 + (lane & 31)) < N;
#pragma unroll
    for (int i = 0; i < 32; ++i) { const int kk = 2 * i + (lane >> 5); scr[kk * 33 + (lane & 31)] = nok ? W[(size_t)(k0 + kk) * N + n0 + (lane & 31)] : 0.f; }
    asm volatile("s_waitcnt lgkmcnt(0)" ::: "memory");
    const int c = lane & 7;
#pragma unroll
    for (int j = 0; j < 4; ++j) { const int n = (lane >> 3) + 8 * j; const LAS float* s = scr + (8 * c) * 33 + n;
        u32x4 o; o.x = pk2(s[0 * 33], s[1 * 33]); o.y = pk2(s[2 * 33], s[3 * 33]); o.z = pk2(s[4 * 33], s[5 * 33]); o.w = pk2(s[6 * 33], s[7 * 33]);
        *(u32x4*)(WT + (size_t)(n0 + n) * K + k0 + 8 * c) = o; }
    asm volatile("s_waitcnt lgkmcnt(0)" ::: "memory");
}
__device__ __forceinline__ void phase_convert(const Params& P, const Ctx& C, int l) {
    LAS float* scr = (LAS float*)(C.lds + 32768 + C.wave * 8704);
    const int gw = C.bid * 8 + C.wave, NGW = C.G * 8; const int j = l >> 1; const bool ev = (l & 1) == 0;
    const float* win = ev ? P.in[I_WINAB] + (size_t)j * 1024 * N_AB : P.in[I_WINCD] + (size_t)j * 1024 * N_CD;
    const float* wout = (ev ? P.in[I_WOUTAB] : P.in[I_WOUTCD]) + (size_t)j * 2048 * 1024;
    const float* wup = P.in[I_WUP] + (size_t)l * 1024 * 4096; const float* wdn = P.in[I_WDN] + (size_t)l * 4096 * 1024;
    const int N_in = ev ? N_AB : N_CD, Np = ev ? N_AB_P : N_CD_P;
    const int I0 = 16 * (Np / 32), I1 = 32 * 32, I2 = 16 * 128, I3 = 64 * 32;
    const int NI = I0 + I1 + I2 + I3; const int lane = C.lane;
    struct Desc { const float* W; bf16_t* WT; int K, N, k0, n0; };
    auto desc = [&](int it) { Desc d; int r = it, nblk;
        if (r < I0) { d.W = win; d.K = 1024; d.N = N_in; d.WT = (bf16_t*)(P.ws + WS_WIN); nblk = Np / 32; }
        else if ((r -= I0) < I1) { d.W = wout; d.K = 2048; d.N = 1024; d.WT = (bf16_t*)(P.ws + WS_WOUT); nblk = 32; }
        else if ((r -= I1) < I2) { d.W = wup; d.K = 1024; d.N = 4096; d.WT = (bf16_t*)(P.ws + WS_WUP); nblk = 128; }
        else { r -= I2; d.W = wdn; d.K = 4096; d.N = 1024; d.WT = (bf16_t*)(P.ws + WS_WDN); nblk = 32; }
        d.k0 = 64 * (r / nblk); d.n0 = 32 * (r % nblk); return d; };
    float v[32];
#define CV_LOAD(d) do { const bool nok_ = ((d).n0 + (lane & 31)) < (d).N; _Pragma("unroll") for (int i = 0; i < 32; ++i) { const int kk = 2 * i + (lane >> 5); \
        v[i] = nok_ ? (d).W[(size_t)((d).k0 + kk) * (d).N + (d).n0 + (lane & 31)] : 0.f; } } while (0)
    int it = gw; Desc d = desc(it < NI ? it : 0);
    if (it < NI) CV_LOAD(d);
    while (it < NI) {
#pragma unroll
        for (int i = 0; i < 32; ++i) { const int kk = 2 * i + (lane >> 5); scr[kk * 33 + (lane & 31)] = v[i]; }
        asm volatile("s_waitcnt lgkmcnt(0)" ::: "memory");
        const int nit = it + NGW; Desc dn = desc(nit < NI ? nit : 0);
        if (nit < NI) CV_LOAD(dn);
        const int c = lane & 7;
#pragma unroll
        for (int jq = 0; jq < 4; ++jq) { const int n = (lane >> 3) + 8 * jq; const LAS float* sp = scr + (8 * c) * 33 + n;
            u32x4 o; o.x = pk2(sp[0 * 33], sp[1 * 33]); o.y = pk2(sp[2 * 33], sp[3 * 33]); o.z = pk2(sp[4 * 33], sp[5 * 33]); o.w = pk2(sp[6 * 33], sp[7 * 33]);
            *(u32x4*)(d.WT + (size_t)(d.n0 + n) * d.K + d.k0 + 8 * c) = o; }
        asm volatile("s_waitcnt lgkmcnt(0)" ::: "memory");
        d = dn; it = nit;
    }
#undef CV_LOAD
    if (ev) {
        bf16_t* WL = (bf16_t*)(P.ws + WS_WLORA);
        for (int idx = C.bid * 512 + C.tid; idx < 5120 * 16; idx += C.G * 512) {
            const int n = idx % 5120, k8 = idx / 5120, g = n >> 10, cc = n & 1023; float o[8];
#pragma unroll
            for (int e = 0; e < 8; ++e) { const int k = k8 * 8 + e; float v = 0.f;
                if (g == 0) { if (k < 64) v = P.in[I_W2][((size_t)(j * 2 + 0) * 64 + k) * 1024 + cc]; }
                else if (g == 1) { if (k >= 64) v = P.in[I_W2][((size_t)(j * 2 + 1) * 64 + (k - 64)) * 1024 + cc]; }
                else if (g == 2) { if (k < 64) v = P.in[I_A2][((size_t)(j * 2 + 0) * 64 + k) * 1024 + cc]; }
                else if (g == 3) { if (k >= 64) v = P.in[I_A2][((size_t)(j * 2 + 1) * 64 + (k - 64)) * 1024 + cc]; }
                else v = P.in[I_G2][((size_t)j * 128 + k) * 1024 + cc];
                o[e] = v; }
            *(u32x4*)(WL + (size_t)n * 128 + k8 * 8) = pack8(o);
        }
    }
}

__device__ __forceinline__ void phase_rows(const Params& P, const Ctx& C, int mode, const float* gpost, const float* gate_mod  ,
                                           bool next, const float* gpre, const float* mod_next  , bool dummy = false) {
    float* X = P.out + O_X; const bf16_t* MP0 = (const bf16_t*)(P.ws + WS_MP); const bf16_t* MP1 = MP0 + (size_t)MTOK * DM; bf16_t* H = (bf16_t*)(P.ws + WS_H);
    const int gw = C.bid * 8 + C.wave, NGW = C.G * 8;
    for (int m = gw; m < MTOK; m += NGW) {
        const int mr = m < 4096 ? 0 : 1 + ((m - 4096) >> 10);
        f32x4 x[4];
        f32x4 gq[4], sh[4], sl[4];
        if (next) { const f32x4* gp_ = (const f32x4*)gpre + C.lane; const f32x4* sh_ = (const f32x4*)(mod_next + (size_t)mr * 6144) + C.lane; const f32x4* sl_ = (const f32x4*)(mod_next + (size_t)mr * 6144 + 1024) + C.lane;
#pragma unroll
            for (int j = 0; j < 4; ++j) { gq[j] = gp_[64 * j]; sh[j] = sh_[64 * j]; sl[j] = sl_[64 * j]; } }
        if (mode == 0) { const f32x4* src = (const f32x4*)(m < 4096 ? P.in[I_XP] + (size_t)m * DM : P.in[I_XS] + (size_t)(m - 4096) * DM) + C.lane;
#pragma unroll
            for (int j = 0; j < 4; ++j) x[j] = src[64 * j];
        } else {
            const f32x4* xs = (const f32x4*)(X + (size_t)m * DM) + C.lane; const u32x2* p0 = (const u32x2*)(MP0 + (size_t)m * DM) + C.lane; const u32x2* p1 = (const u32x2*)(MP1 + (size_t)m * DM) + C.lane;
            const f32x4* gp = (const f32x4*)gpost + C.lane; const f32x4* gt = (const f32x4*)(gate_mod + (size_t)mr * 6144) + C.lane;
            f32x4 gpv[4], gtv[4];
#pragma unroll
            for (int j = 0; j < 4; ++j) { gpv[j] = gp[64 * j]; gtv[j] = gt[64 * j]; }
            f32x4 f[4]; float ss = 0.f;
#pragma unroll
            for (int j = 0; j < 4; ++j) { x[j] = xs[64 * j]; f[j] = unpack4(p0[64 * j]) + unpack4(p1[64 * j]); ss += (f[j].x * f[j].x + f[j].y * f[j].y) + (f[j].z * f[j].z + f[j].w * f[j].w); }
            const float rs = rsqrtf(wave_sum(ss) * (1.f / DM) + 1e-6f);
#pragma unroll
            for (int j = 0; j < 4; ++j) x[j] = x[j] + gtv[j] * (f[j] * rs * gpv[j]);
        }
        f32x4* xo = (f32x4*)((dummy ? (float*)(P.ws + WS_PREP) : X) + (size_t)m * DM) + C.lane;
#pragma unroll
        for (int j = 0; j < 4; ++j) xo[64 * j] = x[j];
        if (next) {
            float ss = 0.f;
#pragma unroll
            for (int j = 0; j < 4; ++j) ss += (x[j].x * x[j].x + x[j].y * x[j].y) + (x[j].z * x[j].z + x[j].w * x[j].w);
            const float rs = rsqrtf(wave_sum(ss) * (1.f / DM) + 1e-6f);
            u32x2* ho = (u32x2*)((dummy ? (bf16_t*)(P.ws + WS_PREP + 40 * MiB) : H) + (size_t)m * DM) + C.lane;
#pragma unroll
            for (int j = 0; j < 4; ++j) { const f32x4 h = (x[j] * rs * gq[j]) * (sl[j] + 1.f) + sh[j]; u32x2 w; w.x = pk2(h.x, h.y); w.y = pk2(h.z, h.w); ho[64 * j] = w; }
        }
    }
}

__device__ __forceinline__ void conv8(const bf16_t* src, int ld, int col0, int base, int t, bool samp, const float* w, const float* b, int NC, int ch, float* acc) {
    { const f32x4 b0 = *(const f32x4*)(b + ch), b1 = *(const f32x4*)(b + ch + 4); acc[0] = b0.x; acc[1] = b0.y; acc[2] = b0.z; acc[3] = b0.w; acc[4] = b1.x; acc[5] = b1.y; acc[6] = b1.z; acc[7] = b1.w; }
    if (!samp) {
#pragma unroll
        for (int d = 0; d < 3; ++d) { const int tt = t + d - 1; if (tt < 0 || tt >= 256) continue;
            float xv[8]; unpack8(*(const u32x4*)(src + (size_t)(base + tt) * ld + col0 + ch), xv);
            const f32x4 w0 = *(const f32x4*)(w + (3 + d) * NC + ch), w1 = *(const f32x4*)(w + (3 + d) * NC + ch + 4);
            acc[0] += w0.x * xv[0]; acc[1] += w0.y * xv[1]; acc[2] += w0.z * xv[2]; acc[3] += w0.w * xv[3]; acc[4] += w1.x * xv[4]; acc[5] += w1.y * xv[5]; acc[6] += w1.z * xv[6]; acc[7] += w1.w * xv[7]; }
    } else {
        const int r = t >> 6, c = t & 63;
#pragma unroll
        for (int i = 0; i < 3; ++i)
#pragma unroll
            for (int d = 0; d < 3; ++d) { const int rr = r + i - 1, cc = c + d - 1; if (rr < 0 || rr >= 16 || cc < 0 || cc >= 64) continue;
                float xv[8]; unpack8(*(const u32x4*)(src + (size_t)(base + rr * 64 + cc) * ld + col0 + ch), xv);
                const f32x4 w0 = *(const f32x4*)(w + (i * 3 + d) * NC + ch), w1 = *(const f32x4*)(w + (i * 3 + d) * NC + ch + 4);
                acc[0] += w0.x * xv[0]; acc[1] += w0.y * xv[1]; acc[2] += w0.z * xv[2]; acc[3] += w0.w * xv[3]; acc[4] += w1.x * xv[4]; acc[5] += w1.y * xv[5]; acc[6] += w1.z * xv[6]; acc[7] += w1.w * xv[7]; }
    }
}

__device__ __forceinline__ void phase_prep_even(const Params& P, const Ctx& C, int j) {
    const bf16_t* PROJ = (const bf16_t*)(P.ws + WS_PROJ); bf16_t* PREP = (bf16_t*)(P.ws + WS_PREP); bf16_t* LA = (bf16_t*)(P.ws + WS_LORAA);
    float* DT = (float*)(P.ws + WS_DT); float* DA = (float*)(P.ws + WS_DA);
    const float* cw = P.in[I_SCONVW] + (size_t)j * 9 * 2048; const float* cb = P.in[I_SCONVB] + j * 2048;
    const float* mu = P.in[I_MU] + j * 3456; const float* kkw = P.in[I_KK] + j * 1024;
    const int gw = C.bid * 8 + C.wave, NGW = C.G * 8, lane = C.lane;
    for (int m = gw; m < MTOK; m += NGW) {
        const bool samp = m >= 4096; const int T = samp ? 1024 : 256; const int t = samp ? ((m - 4096) & 1023) : (m & 255); const int base = m - t;
        const bf16_t* prow = PROJ + (size_t)m * PROJ_LD_AB; bf16_t* orow = PREP + (size_t)m * PREP_LD;
        const bool hp = t > 0, hn = t < T - 1;
        u32x4 rx[7], rxp[7], rxn[7], rz[2];
#pragma unroll
        for (int it = 0; it < 7; ++it) { const int c = it * 512 + lane * 8; const bool ok = c < 3456; const u32x4 z4 = (u32x4){0u, 0u, 0u, 0u};
            rx[it] = ok ? *(const u32x4*)(prow + IN_SSD + c) : z4; rxp[it] = (ok && hp) ? *(const u32x4*)(prow - PROJ_LD_AB + IN_SSD + c) : z4; rxn[it] = (ok && hn) ? *(const u32x4*)(prow + PROJ_LD_AB + IN_SSD + c) : z4; }
#pragma unroll
        for (int it = 0; it < 2; ++it) rz[it] = *(const u32x4*)(prow + it * 512 + lane * 8);
#pragma unroll 1
        for (int it = 0; it < 4; it += 2) { const int ch = it * 512 + lane * 8; float acc[8], acc2[8];
            conv8(PROJ, PROJ_LD_AB, 1024, base, t, samp, cw, cb, 2048, ch, acc); conv8(PROJ, PROJ_LD_AB, 1024, base, t, samp, cw, cb, 2048, ch + 512, acc2);
#pragma unroll
            for (int e = 0; e < 8; ++e) { acc[e] = siluf_(acc[e]); acc2[e] = siluf_(acc2[e]); }
            *(u32x4*)(orow + ch) = pack8(acc); *(u32x4*)(orow + ch + 512) = pack8(acc2); }
#pragma unroll
        for (int it = 0; it < 2; ++it) { const int ch = it * 512 + lane * 8; float z[8]; unpack8(rz[it], z);
#pragma unroll
            for (int e = 0; e < 8; ++e) z[e] = siluf_(z[e]);
            *(u32x4*)(orow + 2048 + ch) = pack8(z); }
        if (lane < 32) { const float raw = bf2f(prow[3072 + lane]); const float dt = softplusf_(raw + P.in[I_DTB][j * 32 + lane]);
            DT[(size_t)m * 32 + lane] = dt; DA[(size_t)m * 32 + lane] = -dt * __expf(P.in[I_ALOG][j * 32 + lane]); }
#pragma unroll
        for (int it = 0; it < 7; ++it) { const int c = it * 512 + lane * 8; if (c >= 3456) break;
            float x[8], xp[8], xn[8];
            unpack8(rx[it], x); unpack8(rxp[it], xp); unpack8(rxn[it], xn);
            const f32x4 m0 = *(const f32x4*)(mu + c), m1 = *(const f32x4*)(mu + c + 4);
            const float mv[8] = {m0.x, m0.y, m0.z, m0.w, m1.x, m1.y, m1.z, m1.w};
#pragma unroll
            for (int e = 0; e < 8; ++e) x[e] = x[e] + mv[e] * (0.5f * (xp[e] + xn[e]) - x[e]);
            if (it < 2) { *(u32x4*)(orow + 3072 + c) = pack8(x); }
            else if (it < 4) { *(u32x4*)(orow + 4096 + (c - 1024)) = pack8(x);
                const f32x4 k0 = *(const f32x4*)(kkw + c - 1024), k1 = *(const f32x4*)(kkw + c - 1024 + 4);
                const float kv[8] = {k0.x, k0.y, k0.z, k0.w, k1.x, k1.y, k1.z, k1.w}; float ss = 0.f;
#pragma unroll
                for (int e = 0; e < 8; ++e) { x[e] *= kv[e]; ss += x[e] * x[e]; }
                ss += __shfl_xor(ss, 1); ss += __shfl_xor(ss, 2); ss += __shfl_xor(ss, 4);
                const float rn = rsqrtf(ss + 1e-12f);
#pragma unroll
                for (int e = 0; e < 8; ++e) x[e] *= rn;
                *(u32x4*)(orow + 6144 + (c - 1024)) = pack8(x); }
            else if (it < 6) { *(u32x4*)(orow + 5120 + (c - 2048)) = pack8(x); }
            else { const int cc = c - 3072;
#pragma unroll
                for (int e = 0; e < 8; ++e) x[e] = cc < 128 ? tanhf_(x[e]) : (cc < 256 ? x[e] : sigmoidf_(x[e]));
                *(u32x4*)(LA + (size_t)m * LORA_K + cc) = pack8(x); }
        }
    }
}
__device__ __forceinline__ void phase_prep_odd(const Params& P, const Ctx& C, int j) {
    const bf16_t* PROJ = (const bf16_t*)(P.ws + WS_PROJ); bf16_t* PREP = (bf16_t*)(P.ws + WS_PREP);
    const float* cw = P.in[I_MCONVW] + (size_t)j * 9 * 1024; const float* cb = P.in[I_MCONVB] + j * 1024;
    const int gw = C.bid * 8 + C.wave, NGW = C.G * 8, lane = C.lane;
    for (int m = gw; m < MTOK; m += NGW) {
        const bool samp = m >= 4096; const int t = samp ? ((m - 4096) & 1023) : (m & 255); const int base = m - t;
        { const int ch = lane * 8; float acc[8], acc2[8];
            conv8(PROJ, PROJ_LD_CD, IN_GLA, base, t, samp, cw, cb, 1024, ch, acc); conv8(PROJ, PROJ_LD_CD, IN_GLA, base, t, samp, cw, cb, 1024, ch + 512, acc2);
#pragma unroll
            for (int e = 0; e < 8; ++e) { acc[e] = siluf_(acc[e]); acc2[e] = siluf_(acc2[e]); }
            *(u32x4*)(PREP + (size_t)m * PREP_LD + ch) = pack8(acc); *(u32x4*)(PREP + (size_t)m * PREP_LD + ch + 512) = pack8(acc2); }
    }
}

constexpr int CS_QLD = 136, CS_SLD = 72;
constexpr int CS_QS = 0, CS_KS = 17408, CS_KT = 34816, CS_VT = 53248;
__device__ __forceinline__ bf16x8 lds_frag(const LAS bf16_t* p) { return *(const LAS bf16x8*)p; }
template <int MODE>
__device__ __forceinline__ void chunk_scan(const Params& P, const Ctx& C, int j, int s, int dir, int h, int vs) {
    const int tid = C.tid, lane = C.lane, w = C.wave, fr = lane & 15, fq = lane >> 4;
    const int T = s < 16 ? 256 : 1024, base = s < 16 ? s * 256 : 4096 + (s - 16) * 1024, nch = T >> 6;
    const bf16_t* PROJ = (const bf16_t*)(P.ws + WS_PROJ); const bf16_t* PREP = (const bf16_t*)(P.ws + WS_PREP);
    bf16_t* Y = (bf16_t*)(P.ws + WS_MP) + (size_t)dir * MTOK * YLD;
    LAS bf16_t* Qs = (LAS bf16_t*)(C.lds + CS_QS); LAS bf16_t* Ks = (LAS bf16_t*)(C.lds + CS_KS); LAS bf16_t* Kt = (LAS bf16_t*)(C.lds + CS_KT); LAS bf16_t* Vt = (LAS bf16_t*)(C.lds + CS_VT);
    constexpr int NV = MODE == 0 ? 64 : 128, NVC = NV / 16, VROWS = NV + (MODE == 2 ? 16 : 0);
    constexpr int CS_ST = CS_VT + VROWS * CS_SLD * 2, CS_LA = CS_ST + VROWS * CS_QLD * 2, CS_PS = CS_LA  , CS_TOT = CS_LA + (MODE == 1 ? 32768 : 9216),
                  CS_BV = CS_TOT + 2560, CS_IG = CS_BV + 256, CS_FV = CS_IG + 256, CS_DTV = CS_FV + 256, CS_MS = CS_DTV + 256;
    static_assert(CS_MS + 64 <= LDS_BYTES - 16, "chunk-scan LDS map");
    LAS bf16_t* Ps = (LAS bf16_t*)(C.lds + CS_PS); LAS bf16_t* St = (LAS bf16_t*)(C.lds + CS_ST);
    LAS float* LA = (LAS float*)(C.lds + CS_LA); LAS float* TOT = (LAS float*)(C.lds + CS_TOT); LAS float* BV = (LAS float*)(C.lds + CS_BV); LAS float* IG = (LAS float*)(C.lds + CS_IG);
    LAS float* MS = (LAS float*)(C.lds + CS_MS); LAS float* FV = (LAS float*)(C.lds + CS_FV); LAS float* DTV = (LAS float*)(C.lds + CS_DTV);
    constexpr int NVT = NVC + (MODE == 2 ? 1 : 0);
    const int si = tid >> 3, kq = tid & 7;
    __syncthreads();
    bf16x8 gwa_hi = {0, 0, 0, 0, 0, 0, 0, 0}, gwa_lo = {0, 0, 0, 0, 0, 0, 0, 0}; f32x4 gb4 = {0.f, 0.f, 0.f, 0.f};
    if (MODE == 1) {
        const float* gwp = P.in[I_GGW] + (size_t)(j * 2 + dir) * 16 * 512 + h * 128 + 16 * w + fr;
        if (fq < 2) {
#pragma unroll
            for (int e = 0; e < 8; ++e) { const float g = gwp[(8 * fq + e) * 512]; const unsigned hb = f2bf(g); const float rem = g - bf2f(hb); gwa_hi[e] = (short)hb; gwa_lo[e] = (short)f2bf(rem); } }
        gb4 = *(const f32x4*)(P.in[I_GGB] + (j * 2 + dir) * 512 + h * 128 + 16 * w + 4 * fq);
    }
    f32x4 Sacc[NVT];
    {
        const float* s0 = nullptr; int kstride = 64; float em0 = 1.f;
        if (s >= 16) { const int b = s - 16;
            if (MODE == 0) { s0 = P.in[I_SSSD] + ((size_t)((b * 2 + j) * 2 + dir) * 16 + h) * 8192; kstride = 64; }
            if (MODE == 1) { s0 = P.in[I_SGLA] + ((size_t)((b * 2 + j) * 2 + dir) * 4 + h) * 32768 + vs * NV; kstride = 256; }
            if (MODE == 2) { s0 = P.in[I_SMC] + ((size_t)((b * 2 + j) * 2 + dir) * 4 + h) * 32768 + vs * NV; kstride = 256; em0 = __expf(P.in[I_SMM][((b * 2 + j) * 2 + dir) * 4 + h]); } }
#pragma unroll
        for (int vt = 0; vt < NVC; ++vt)
#pragma unroll
            for (int e = 0; e < 4; ++e) Sacc[vt][e] = s0 ? s0[(size_t)(16 * w + 4 * fq + e) * kstride + 16 * vt + fr] * em0 : 0.f;
        if (MODE == 2) {
            const float* n0 = s >= 16 ? P.in[I_SMN] + ((size_t)(((s - 16) * 2 + j) * 2 + dir) * 4 + h) * 128 : nullptr;
#pragma unroll
            for (int e = 0; e < 4; ++e) Sacc[NVT - 1][e] = (n0 && fr == 0) ? n0[16 * w + 4 * fq + e] * em0 : 0.f;
            if (tid == 0) MS[0] = s >= 16 ? P.in[I_SMM][(((s - 16) * 2 + j) * 2 + dir) * 4 + h] : 0.f;
            for (int i = tid; i < 16 * CS_SLD; i += 512) Vt[NV * CS_SLD + i] = (bf16_t)((i < CS_SLD) ? 0x3F80 : 0);
        }
#pragma unroll
        for (int vt = 0; vt < NVT; ++vt) { u32x2 wv; wv.x = pk2(Sacc[vt][0], Sacc[vt][1]); wv.y = pk2(Sacc[vt][2], Sacc[vt][3]); *(LAS u32x2*)(St + (16 * vt + fr) * CS_QLD + 16 * w + 4 * fq) = wv; }
    }
    u32x4 rq0, rq1, rk0, rk1, rgd[4]; float rla = 0.f, rig = 0.f, rdt = 0.f;
    constexpr int NVTOK = MODE == 0 ? 8 : 16;
    unsigned short rkt[16], rvt[NVTOK];
    const int kx = tid & 127, tgk = tid >> 7, vx = tid & (NV - 1), tgv = MODE == 0 ? (tid >> 6) : (tid >> 7);
    auto tok = [&](int c, int i) { const int st0 = c * 64 + i; return base + (dir ? (T - 1 - st0) : st0); };
    auto load_raw = [&](int c) {
        const int m = tok(c, si); const int m1 = tok(c, tid & 63);
        const bf16_t* krow; const bf16_t* vrow; int kld, vld;
        if (MODE == 0) { const int g = h >> 2; const bf16_t* pr = PREP + (size_t)m * PREP_LD;
            rq0 = *(const u32x4*)(pr + 1536 + g * 128 + 16 * kq); rq1 = *(const u32x4*)(pr + 1536 + g * 128 + 16 * kq + 8);
            rk0 = *(const u32x4*)(pr + 1024 + g * 128 + 16 * kq); rk1 = *(const u32x4*)(pr + 1024 + g * 128 + 16 * kq + 8);
            if (tid < 64) { rla = ((const float*)(P.ws + WS_DA))[(size_t)m1 * 32 + dir * 16 + h]; rdt = ((const float*)(P.ws + WS_DT))[(size_t)m1 * 32 + dir * 16 + h]; }
            krow = PREP + 1024 + g * 128 + kx; kld = PREP_LD; vrow = PREP + h * 64 + vx; vld = PREP_LD; }
        if (MODE == 1) { const bf16_t* pr = PROJ + (size_t)m * PROJ_LD_CD;
            rq0 = *(const u32x4*)(pr + h * 128 + 16 * kq); rq1 = *(const u32x4*)(pr + h * 128 + 16 * kq + 8);
            rk0 = *(const u32x4*)(pr + 512 + h * 128 + 16 * kq); rk1 = *(const u32x4*)(pr + 512 + h * 128 + 16 * kq + 8);
#pragma unroll
            for (int t4 = 0; t4 < 4; ++t4) { rgd[t4] = (u32x4){0u, 0u, 0u, 0u}; if (fq < 2) rgd[t4] = *(const u32x4*)(PROJ + (size_t)tok(c, 16 * t4 + fr) * PROJ_LD_CD + 3072 + dir * 16 + 8 * fq); }
            krow = PROJ + 512 + h * 128 + kx; kld = PROJ_LD_CD; vrow = PROJ + 1024 + h * 256 + vs * NV + vx; vld = PROJ_LD_CD; }
        if (MODE == 2) { const bf16_t* pp = PREP + (size_t)m * PREP_LD;
            rq0 = *(const u32x4*)(pp + h * 128 + 16 * kq); rq1 = *(const u32x4*)(pp + h * 128 + 16 * kq + 8);
            rk0 = *(const u32x4*)(pp + 512 + h * 128 + 16 * kq); rk1 = *(const u32x4*)(pp + 512 + h * 128 + 16 * kq + 8);
            if (tid < 64) { const bf16_t* p1 = PROJ + (size_t)m1 * PROJ_LD_CD + IN_GLA + 3072; rig = bf2f(p1[dir * 4 + h]); rla = bf2f(p1[8 + dir * 4 + h]); }
            krow = PREP + 512 + h * 128 + kx; kld = PREP_LD; vrow = PROJ + IN_GLA + 1024 + h * 256 + vs * NV + vx; vld = PROJ_LD_CD; }
        { const bf16_t* kp = krow + (size_t)tok(c, 16 * tgk) * kld; const long ks_ = dir ? -(long)kld : (long)kld;
#pragma unroll
          for (int jj = 0; jj < 16; ++jj) { rkt[jj] = *kp; kp += ks_; }
          const bf16_t* vp = vrow + (size_t)tok(c, NVTOK * tgv) * vld; const long vs_ = dir ? -(long)vld : (long)vld;
#pragma unroll
          for (int jj = 0; jj < NVTOK; ++jj) { rvt[jj] = *vp; vp += vs_; } }
    };
    load_raw(0);
    __syncthreads();
    const int ycol0 = (MODE == 0 ? h * 64 : (MODE == 1 ? h * 256 + vs * NV : 1024 + h * 256 + vs * NV));
    for (int c = 0; c < nch; ++c) {
        if (MODE == 1) {
#pragma unroll
            for (int t4 = 0; t4 < 4; ++t4) { f32x4 acc = (f32x4){0.f, 0.f, 0.f, 0.f}; const bf16x8 gf = __builtin_bit_cast(bf16x8, rgd[t4]);
                acc = __builtin_amdgcn_mfma_f32_16x16x32_bf16(gwa_hi, gf, acc, 0, 0, 0); acc = __builtin_amdgcn_mfma_f32_16x16x32_bf16(gwa_lo, gf, acc, 0, 0, 0);
                f32x4 la;
#pragma unroll
                for (int e = 0; e < 4; ++e) la[e] = logsigmoidf_(acc[e] + gb4[e]) * 0.0625f;
                *(LAS f32x4*)(LA + (16 * t4 + fr) * 128 + 16 * w + 4 * fq) = la; }
        } else if (tid < 64) {
            float ig = 0.f, la = rla;
            if (MODE == 2) { ig = rig + P.in[I_MIB][(j * 2 + dir) * 4 + h]; la = logsigmoidf_(rla + P.in[I_MFB][(j * 2 + dir) * 4 + h]); }
            float x = la;
            x += __int_as_float(__builtin_amdgcn_update_dpp(0, __float_as_int(x), 0x111, 0xF, 0xF, true));
            x += __int_as_float(__builtin_amdgcn_update_dpp(0, __float_as_int(x), 0x112, 0xF, 0xF, true));
            x += __int_as_float(__builtin_amdgcn_update_dpp(0, __float_as_int(x), 0x114, 0xF, 0xF, true));
            x += __int_as_float(__builtin_amdgcn_update_dpp(0, __float_as_int(x), 0x118, 0xF, 0xF, true));
            { const float t0 = __int_as_float(__builtin_amdgcn_readlane(__float_as_int(x), 15)), t1 = __int_as_float(__builtin_amdgcn_readlane(__float_as_int(x), 31)), t2 = __int_as_float(__builtin_amdgcn_readlane(__float_as_int(x), 47));
              const int rw = lane >> 4; x += (rw > 0 ? t0 : 0.f) + (rw > 1 ? t1 : 0.f) + (rw > 2 ? t2 : 0.f); }
            const float bl = __int_as_float(__builtin_amdgcn_readlane(__float_as_int(x), 63));
            const float kgn = MODE == 2 ? 0.08838834764831845f * __expf(ig) : 1.f;
            BV[tid] = x; IG[tid] = kgn; FV[tid] = kgn * __expf(bl - x); DTV[tid] = MODE == 0 ? rdt : 1.f;
            if (MODE == 2) { float ml = bl - x + ig;
                ml = fmaxf(ml, __int_as_float(__builtin_amdgcn_update_dpp(__float_as_int(ml), __float_as_int(ml), 0xB1, 0xF, 0xF, false)));
                ml = fmaxf(ml, __int_as_float(__builtin_amdgcn_update_dpp(__float_as_int(ml), __float_as_int(ml), 0x4E, 0xF, 0xF, false)));
                ml = fmaxf(ml, __int_as_float(__builtin_amdgcn_update_dpp(__float_as_int(ml), __float_as_int(ml), 0x141, 0xF, 0xF, false)));
                ml = fmaxf(ml, __int_as_float(__builtin_amdgcn_update_dpp(__float_as_int(ml), __float_as_int(ml), 0x140, 0xF, 0xF, false)));
                const float m01 = fmaxf(__int_as_float(__builtin_amdgcn_readlane(__float_as_int(ml), 0)), __int_as_float(__builtin_amdgcn_readlane(__float_as_int(ml), 16)));
                const float m23 = fmaxf(__int_as_float(__builtin_amdgcn_readlane(__float_as_int(ml), 32)), __int_as_float(__builtin_amdgcn_readlane(__float_as_int(ml), 48)));
                if (tid == 0) MS[0] = fmaxf(bl + MS[0], fmaxf(m01, m23)); }
        }
        __syncthreads();
        if (MODE == 1) {
            const int k = tid & 127, qd = tid >> 7; float run = 0.f;
#pragma unroll
            for (int jj = 0; jj < 16; ++jj) { run += LA[(16 * qd + jj) * 128 + k]; LA[(16 * qd + jj) * 128 + k] = run; }
            TOT[qd * 128 + k] = run;
            __syncthreads();
            if (tid < 128) TOT[4 * 128 + tid] = __expf(TOT[tid] + TOT[128 + tid] + TOT[256 + tid] + TOT[384 + tid]);
        }
        {
            float q[16], k[16]; unpack8(rq0, q); unpack8(rq1, q + 8); unpack8(rk0, k); unpack8(rk1, k + 8);
            float qs[16], ks[16];
            if (MODE == 1) { const int qd = si >> 4;
#pragma unroll
                for (int e4 = 0; e4 < 4; ++e4) { const int kk = 16 * kq + 4 * e4; const f32x4 bb = *(LAS f32x4*)(LA + si * 128 + kk), t0 = *(LAS f32x4*)(TOT + kk), t1 = *(LAS f32x4*)(TOT + 128 + kk), t2 = *(LAS f32x4*)(TOT + 256 + kk);
#pragma unroll
                    for (int e = 0; e < 4; ++e) { const float b = bb[e] + (qd > 0 ? t0[e] : 0.f) + (qd > 1 ? t1[e] : 0.f) + (qd > 2 ? t2[e] : 0.f);
                        qs[4 * e4 + e] = q[4 * e4 + e] * 0.08838834764831845f * __expf(b); ks[4 * e4 + e] = k[4 * e4 + e] * __expf(fminf(-b, 80.f)); } }
            } else { const float kgn = IG[si];
#pragma unroll
                for (int e = 0; e < 16; ++e) { qs[e] = q[e]; ks[e] = k[e] * kgn; } }
            *(LAS u32x4*)(Qs + si * CS_QLD + 16 * kq) = pack8(qs); *(LAS u32x4*)(Qs + si * CS_QLD + 16 * kq + 8) = pack8(qs + 8);
            *(LAS u32x4*)(Ks + si * CS_QLD + 16 * kq) = pack8(ks); *(LAS u32x4*)(Ks + si * CS_QLD + 16 * kq + 8) = pack8(ks + 8);
        }
        if (MODE == 1)
        {
            float kt[16];
            if (MODE == 1) { float off = 0.f; const float t0 = TOT[kx], t1 = TOT[128 + kx], t2 = TOT[256 + kx], t3 = TOT[384 + kx];
                off = (tgk > 0 ? t0 : 0.f) + (tgk > 1 ? t1 : 0.f) + (tgk > 2 ? t2 : 0.f); const float bl = (t0 + t1) + (t2 + t3);
#pragma unroll
                for (int jj = 0; jj < 16; ++jj) kt[jj] = bf2f(rkt[jj]) * __expf(bl - (LA[(16 * tgk + jj) * 128 + kx] + off));
            } else {
#pragma unroll
                for (int jj = 0; jj < 16; ++jj) kt[jj] = bf2f(rkt[jj]) * FV[16 * tgk + jj]; }
            *(LAS u32x4*)(Kt + kx * CS_SLD + 16 * tgk) = pack8(kt); *(LAS u32x4*)(Kt + kx * CS_SLD + 16 * tgk + 8) = pack8(kt + 8);
            float vt8[NVTOK];
#pragma unroll
            for (int jj = 0; jj < NVTOK; ++jj) vt8[jj] = bf2f(rvt[jj]) * (MODE == 0 ? DTV[NVTOK * tgv + jj] : 1.f);
            *(LAS u32x4*)(Vt + vx * CS_SLD + NVTOK * tgv) = pack8(vt8);
            if (NVTOK == 16) *(LAS u32x4*)(Vt + vx * CS_SLD + NVTOK * tgv + 8) = pack8(vt8 + 8);
        }
        __syncthreads();
        if (MODE != 1)
        {
            float kt[16];
            if (MODE == 1) { float off = 0.f; const float t0 = TOT[kx], t1 = TOT[128 + kx], t2 = TOT[256 + kx], t3 = TOT[384 + kx];
                off = (tgk > 0 ? t0 : 0.f) + (tgk > 1 ? t1 : 0.f) + (tgk > 2 ? t2 : 0.f); const float bl = (t0 + t1) + (t2 + t3);
#pragma unroll
                for (int jj = 0; jj < 16; ++jj) kt[jj] = bf2f(rkt[jj]) * __expf(bl - (LA[(16 * tgk + jj) * 128 + kx] + off));
            } else {
#pragma unroll
                for (int jj = 0; jj < 16; ++jj) kt[jj] = bf2f(rkt[jj]) * FV[16 * tgk + jj]; }
            *(LAS u32x4*)(Kt + kx * CS_SLD + 16 * tgk) = pack8(kt); *(LAS u32x4*)(Kt + kx * CS_SLD + 16 * tgk + 8) = pack8(kt + 8);
            float vt8[NVTOK];
#pragma unroll
            for (int jj = 0; jj < NVTOK; ++jj) vt8[jj] = bf2f(rvt[jj]) * (MODE == 0 ? DTV[NVTOK * tgv + jj] : 1.f);
            *(LAS u32x4*)(Vt + vx * CS_SLD + NVTOK * tgv) = pack8(vt8);
            if (NVTOK == 16) *(LAS u32x4*)(Vt + vx * CS_SLD + NVTOK * tgv + 8) = pack8(vt8 + 8);
        }
        if (c + 1 < nch) load_raw(c + 1);
        const int tt = w >> 1;
#pragma unroll
        for (int sj = 0; sj < 2; ++sj) { const int st = 2 * (w & 1) + sj; u32x2 wv; wv.x = 0u; wv.y = 0u;
            if (st <= tt) { f32x4 acc = (f32x4){0.f, 0.f, 0.f, 0.f};
#pragma unroll
                for (int kk = 0; kk < 4; ++kk) acc = __builtin_amdgcn_mfma_f32_16x16x32_bf16(lds_frag(Ks + (16 * st + fr) * CS_QLD + 32 * kk + 8 * fq), lds_frag(Qs + (16 * tt + fr) * CS_QLD + 32 * kk + 8 * fq), acc, 0, 0, 0);
                const int tg = 16 * tt + fr, sg = 16 * st + 4 * fq;
                if (MODE != 1) { const float bt = BV[tg]; const f32x4 bs = *(LAS f32x4*)(BV + sg);
#pragma unroll
                    for (int e = 0; e < 4; ++e) acc[e] *= __expf(fminf(bt - bs[e], 0.f)); }
#pragma unroll
                for (int e = 0; e < 4; ++e) acc[e] = (sg + e <= tg) ? acc[e] : 0.f;
                wv.x = pk2(acc[0], acc[1]); wv.y = pk2(acc[2], acc[3]); }
            *(LAS u32x2*)(Ps + (16 * tt + fr) * CS_SLD + 16 * st + 4 * fq) = wv; }
        __syncthreads();
        {
            const int tg = 16 * tt + fr; const int stp = c * 64 + tg; const int m = base + (dir ? (T - 1 - stp) : stp);
            const float ebt = MODE == 1 ? 1.f : __expf(BV[tg]);
            bf16x8 pf[2], qf[4];
#pragma unroll
            for (int ks2 = 0; ks2 < 2; ++ks2) pf[ks2] = lds_frag(Ps + tg * CS_SLD + 32 * ks2 + 8 * fq);
#pragma unroll
            for (int kk = 0; kk < 4; ++kk) qf[kk] = lds_frag(Qs + tg * CS_QLD + 32 * kk + 8 * fq);
            float rden = 1.f;
            if (MODE == 2) { f32x4 ai = (f32x4){0.f, 0.f, 0.f, 0.f}, ao = (f32x4){0.f, 0.f, 0.f, 0.f};
#pragma unroll
                for (int ks2 = 0; ks2 < 2; ++ks2) ai = __builtin_amdgcn_mfma_f32_16x16x32_bf16(lds_frag(Vt + (NV + fr) * CS_SLD + 32 * ks2 + 8 * fq), pf[ks2], ai, 0, 0, 0);
#pragma unroll
                for (int kk = 0; kk < 4; ++kk) ao = __builtin_amdgcn_mfma_f32_16x16x32_bf16(lds_frag(St + (NV + fr) * CS_QLD + 32 * kk + 8 * fq), qf[kk], ao, 0, 0, 0);
                const float den = __shfl(ai[0] + ao[0] * ebt, fr); rden = 1.f / fmaxf(fabsf(den), 1.f); }
#pragma unroll
            for (int vj = 0; vj < NVC / 2; ++vj) { const int vt = (NVC / 2) * (w & 1) + vj; f32x4 ai = (f32x4){0.f, 0.f, 0.f, 0.f}, ao = (f32x4){0.f, 0.f, 0.f, 0.f};
#pragma unroll
                for (int ks2 = 0; ks2 < 2; ++ks2) ai = __builtin_amdgcn_mfma_f32_16x16x32_bf16(lds_frag(Vt + (16 * vt + fr) * CS_SLD + 32 * ks2 + 8 * fq), pf[ks2], ai, 0, 0, 0);
#pragma unroll
                for (int kk = 0; kk < 4; ++kk) ao = __builtin_amdgcn_mfma_f32_16x16x32_bf16(lds_frag(St + (16 * vt + fr) * CS_QLD + 32 * kk + 8 * fq), qf[kk], ao, 0, 0, 0);
                u32x2 wv; wv.x = pk2((ai[0] + ao[0] * ebt) * rden, (ai[1] + ao[1] * ebt) * rden); wv.y = pk2((ai[2] + ao[2] * ebt) * rden, (ai[3] + ao[3] * ebt) * rden);
                *(u32x2*)(Y + (size_t)m * YLD + ycol0 + 16 * vt + 4 * fq) = wv; }
        }
        {
            f32x4 dec; if (MODE == 1) dec = *(LAS f32x4*)(TOT + 4 * 128 + 16 * w + 4 * fq); else { const float d = __expf(BV[63]); dec = (f32x4){d, d, d, d}; }
            bf16x8 kf[2];
#pragma unroll
            for (int ks2 = 0; ks2 < 2; ++ks2) kf[ks2] = lds_frag(Kt + (16 * w + fr) * CS_SLD + 32 * ks2 + 8 * fq);
#pragma unroll
            for (int vt = 0; vt < NVT; ++vt) { Sacc[vt] = Sacc[vt] * dec;
#pragma unroll
                for (int ks2 = 0; ks2 < 2; ++ks2) Sacc[vt] = __builtin_amdgcn_mfma_f32_16x16x32_bf16(kf[ks2], lds_frag(Vt + (16 * vt + fr) * CS_SLD + 32 * ks2 + 8 * fq), Sacc[vt], 0, 0, 0); }
        }
        __syncthreads();
#pragma unroll
        for (int vt = 0; vt < NVT; ++vt) { u32x2 wv; wv.x = pk2(Sacc[vt][0], Sacc[vt][1]); wv.y = pk2(Sacc[vt][2], Sacc[vt][3]); *(LAS u32x2*)(St + (16 * vt + fr) * CS_QLD + 16 * w + 4 * fq) = wv; }
    }
    if (s < 16) {
        float* o; int kstride; float sc = 1.f;
        if (MODE == 0) { o = P.out + O_SSD + ((size_t)((s * 2 + j) * 2 + dir) * 16 + h) * 8192; kstride = 64; }
        else { o = P.out + (MODE == 1 ? O_GLA : O_MC) + ((size_t)((s * 2 + j) * 2 + dir) * 4 + h) * 32768 + vs * NV; kstride = 256; }
        if (MODE == 2) { __syncthreads(); sc = __expf(-MS[0]); }
#pragma unroll
        for (int vt = 0; vt < NVC; ++vt)
#pragma unroll
            for (int e = 0; e < 4; ++e) o[(size_t)(16 * w + 4 * fq + e) * kstride + 16 * vt + fr] = Sacc[vt][e] * sc;
        if (MODE == 2 && vs == 0) {
            if (fr == 0) {
#pragma unroll
                for (int e = 0; e < 4; ++e) P.out[O_MN + ((size_t)((s * 2 + j) * 2 + dir) * 4 + h) * 128 + 16 * w + 4 * fq + e] = Sacc[NVT - 1][e] * sc; }
            if (tid == 0) P.out[O_MM + ((s * 2 + j) * 2 + dir) * 4 + h] = MS[0]; }
    }
}

struct RwOps { f32x4 kk0, kk1, w0, w1, kd0, kd1, ka0, ka1, r0, r1; f32x2 vv; };
__device__ __forceinline__ RwOps rw_ops(const LAS float* B, int tt, int kg, int vg) {
    const LAS float* p = B + tt * 64 + 4 * kg; RwOps o;
    o.kk0 = *(const LAS f32x4*)(p + 4096); o.kk1 = *(const LAS f32x4*)(p + 4096 + 32); o.w0 = *(const LAS f32x4*)(p + 1024); o.w1 = *(const LAS f32x4*)(p + 1024 + 32);
    o.kd0 = *(const LAS f32x4*)(p + 2048); o.kd1 = *(const LAS f32x4*)(p + 2048 + 32); o.ka0 = *(const LAS f32x4*)(p + 5120); o.ka1 = *(const LAS f32x4*)(p + 5120 + 32);
    o.r0 = *(const LAS f32x4*)(p); o.r1 = *(const LAS f32x4*)(p + 32); o.vv = *(const LAS f32x2*)(B + 3072 + tt * 64 + 2 * vg); return o;
}
__device__ __forceinline__ void rwkv_pair(const Params& P, const Ctx& C, int j, int bq, bool lng) {
    const int niter = lng ? 64 : 32; const bool act = !lng || C.tid < 256;
    const int tid = C.tid, half = tid >> 8, tl = tid & 255, kg = tl & 7, vg = tl >> 3;
    const bf16_t* PREP = (const bf16_t*)(P.ws + WS_PREP); const bf16_t* LOUT = (const bf16_t*)(P.ws + WS_PROJ);
    constexpr int BUFSZ = 6 * 1024;
    LAS float* L0 = (LAS float*)C.lds + half * 2 * BUFSZ;
    const int stt = tl >> 4, sc4 = (tl & 15) * 4;
    auto unit_of = [&](int cc, int& s, int& dir, int& h, int& lc) {
        if (lng) { s = 16 + (bq >> 5); dir = (bq >> 4) & 1; h = bq & 15; lc = cc; }
        else { const int q = 4 * bq + 2 * half + (cc >> 4); s = q >> 5; dir = (q >> 4) & 1; h = q & 15; lc = cc & 15; } };
    f32x2 S2[8];
    auto init_state = [&](int s, int dir, int h) {
        const float* s0 = s >= 16 ? P.in[I_SRWKV] + (((size_t)(((s - 16) * 2 + j) * 2 + dir) * 16 + h) * 64 + 2 * vg) * 64 : nullptr;
#pragma unroll
        for (int hh = 0; hh < 2; ++hh) { const f32x4 u0 = s0 ? *(const f32x4*)(s0 + 32 * hh + 4 * kg) : (f32x4){0.f, 0.f, 0.f, 0.f}, u1 = s0 ? *(const f32x4*)(s0 + 64 + 32 * hh + 4 * kg) : (f32x4){0.f, 0.f, 0.f, 0.f};
#pragma unroll
            for (int e = 0; e < 4; ++e) S2[hh * 4 + e] = (f32x2){u0[e], u1[e]}; } };
    u32x2 rr, rk, rv, rkk, rwl, ral; f32x4 cw0, ca0, cka;
    auto load_raw = [&](int cc) {
        int s, dir, h, lc; unit_of(cc, s, dir, h, lc);
        const int T = s < 16 ? 256 : 1024, base = s < 16 ? s * 256 : 4096 + (s - 16) * 1024;
        const int step = lc * 16 + stt; const int m = base + (dir ? (T - 1 - step) : step);
        const bf16_t* pp = PREP + (size_t)m * PREP_LD + h * 64 + sc4; const bf16_t* lo = LOUT + (size_t)m * LOUT_LD + dir * 1024 + h * 64 + sc4;
        rr = *(const u32x2*)(pp + 3072); rk = *(const u32x2*)(pp + 4096); rv = *(const u32x2*)(pp + 5120); rkk = *(const u32x2*)(pp + 6144);
        rwl = *(const u32x2*)lo; ral = *(const u32x2*)(lo + 2048);
        cw0 = *(const f32x4*)(P.in[I_W0] + (j * 2 + dir) * 1024 + h * 64 + sc4); ca0 = *(const f32x4*)(P.in[I_A0] + (j * 2 + dir) * 1024 + h * 64 + sc4); cka = *(const f32x4*)(P.in[I_KA] + j * 1024 + h * 64 + sc4);
    };
    auto write_lds = [&](LAS float* B) {
        const f32x4 r = unpack4(rr), k = unpack4(rk), v = unpack4(rv), kk = unpack4(rkk), wl = unpack4(rwl), al = unpack4(ral);
        f32x4 w, kd, kka;
#pragma unroll
        for (int e = 0; e < 4; ++e) { const float wp = cw0[e] + wl[e]; const float lw = -__expf(-softplusf_(-wp) - 0.5f); w[e] = __expf(lw);
            const float a = sigmoidf_(ca0[e] + al[e]); kd[e] = k[e] * (1.f + (a - 1.f) * cka[e]); kka[e] = kk[e] * a; }
        LAS float* p = B + stt * 64 + sc4;
        *(LAS f32x4*)(p) = r; *(LAS f32x4*)(p + 1024) = w; *(LAS f32x4*)(p + 2048) = kd; *(LAS f32x4*)(p + 3072) = v; *(LAS f32x4*)(p + 4096) = kk; *(LAS f32x4*)(p + 5120) = kka;
    };
    __syncthreads();
    if (act) { load_raw(0); write_lds(L0);
    { int s, dir, h, lc; unit_of(0, s, dir, h, lc); init_state(s, dir, h); } }
    __syncthreads();
#pragma unroll 1
    for (int cc = 0; cc < niter; ++cc) {
        if (act) {
        LAS float* B = L0 + (cc & 1) * BUFSZ;
        int s, dir, h, lc; unit_of(cc, s, dir, h, lc);
        const int T = s < 16 ? 256 : 1024, base = s < 16 ? s * 256 : 4096 + (s - 16) * 1024;
        if (cc + 1 < niter) load_raw(cc + 1);
        bf16_t* Y = (bf16_t*)(P.ws + WS_MP) + (size_t)dir * MTOK * YLD + 1024 + h * 64 + 2 * vg;
        RwOps cur = rw_ops(B, 0, kg, vg);
#pragma unroll 2
        for (int tt = 0; tt < 16; ++tt) {
            const RwOps nx = rw_ops(B, (tt + 1) & 15, kg, vg);
            const int step = lc * 16 + tt; const int m = base + (dir ? (T - 1 - step) : step);
            f32x2 da = (f32x2){0.f, 0.f}, db = (f32x2){0.f, 0.f};
#pragma unroll
            for (int e = 0; e < 4; ++e) { da = da + S2[e] * (f32x2){cur.kk0[e], cur.kk0[e]}; db = db + S2[4 + e] * (f32x2){cur.kk1[e], cur.kk1[e]}; }
            const f32x2 d2 = da + db;
            f32x2 sk2; sk2.x = row_sum8(d2.x); sk2.y = row_sum8(d2.y);
            f32x2 ya = (f32x2){0.f, 0.f}, yb = (f32x2){0.f, 0.f};
#pragma unroll
            for (int e = 0; e < 4; ++e) {
                S2[e] = S2[e] * (f32x2){cur.w0[e], cur.w0[e]} - sk2 * (f32x2){cur.ka0[e], cur.ka0[e]} + cur.vv * (f32x2){cur.kd0[e], cur.kd0[e]};
                S2[4 + e] = S2[4 + e] * (f32x2){cur.w1[e], cur.w1[e]} - sk2 * (f32x2){cur.ka1[e], cur.ka1[e]} + cur.vv * (f32x2){cur.kd1[e], cur.kd1[e]};
                ya = ya + S2[e] * (f32x2){cur.r0[e], cur.r0[e]}; yb = yb + S2[4 + e] * (f32x2){cur.r1[e], cur.r1[e]}; }
            const f32x2 y2 = ya + yb;
            const float y0 = row_sum8(y2.x), y1 = row_sum8(y2.y);
            if (kg == 0) *(unsigned*)(Y + (size_t)m * YLD) = pg8::cvt_pk_bf16(y0, y1);
            cur = nx;
        }
        const int nchU = lng ? 64 : 16;
        if (lc == nchU - 1 && s < 16) { float* o = P.out + O_RWKV + (((size_t)((s * 2 + j) * 2 + dir) * 16 + h) * 64 + 2 * vg) * 64;
#pragma unroll
            for (int hh = 0; hh < 2; ++hh) { *(f32x4*)(o + 32 * hh + 4 * kg) = (f32x4){S2[hh * 4].x, S2[hh * 4 + 1].x, S2[hh * 4 + 2].x, S2[hh * 4 + 3].x};
                *(f32x4*)(o + 64 + 32 * hh + 4 * kg) = (f32x4){S2[hh * 4].y, S2[hh * 4 + 1].y, S2[hh * 4 + 2].y, S2[hh * 4 + 3].y}; } }
        if (cc + 1 < niter) { write_lds(L0 + ((cc + 1) & 1) * BUFSZ);
            if (lc == nchU - 1) { int s2, d2_, h2, lc2; unit_of(cc + 1, s2, d2_, h2, lc2); init_state(s2, d2_, h2); } }
        }
        __syncthreads();
    }
}

__device__ __forceinline__ void scan_unit(const Params& P, const Ctx& C, int l, int type, int q) {
    const int j = l >> 1; const bool ev = (l & 1) == 0;
    if (ev) { int s, idx; if (q < 128) { s = 16 + (q >> 5); idx = q & 31; } else { const int r = q - 128; s = r >> 5; idx = r & 31; }
        chunk_scan<0>(P, C, j, s, idx >> 4, idx & 15, 0); }
    else { int s, idx; if (q < 64) { s = 16 + (q >> 4); idx = q & 15; } else { const int r = q - 64; s = r >> 4; idx = r & 15; }
        const int dir = idx >> 3, h = (idx >> 1) & 3, vs = idx & 1; if (type == 0) chunk_scan<1>(P, C, j, s, dir, h, vs); else chunk_scan<2>(P, C, j, s, dir, h, vs); }
}
__device__ __forceinline__ int queue_next(const Params& P, const Ctx& C, int l) {
    volatile LAS unsigned* qw = (volatile LAS unsigned*)(C.lds + LDS_BYTES - 16);
    __syncthreads();
    if (C.tid == 0) qw[3] = __hip_atomic_fetch_add((unsigned*)(P.ws + WS_CTL) + 6144 + 64 * l, 1u, __ATOMIC_RELAXED, __HIP_MEMORY_SCOPE_AGENT);
    __syncthreads();
    return __builtin_amdgcn_readfirstlane((int)qw[3]);
}
__device__ __forceinline__ void phase_scan(const Params& P, const Ctx& C0, int l) {
    const int G = C0.G, bid = C0.bid; const bool ev = (l & 1) == 0;
    if (ev) {
        if (G == 256) rwkv_pair(P, fresh_ctx(C0.lds), l >> 1, bid < 128 ? bid : bid - 128, bid < 128);
        else {
#pragma unroll 1
            for (int x = bid; x < 256; x += G) rwkv_pair(P, fresh_ctx(C0.lds), l >> 1, x < 128 ? x : x - 128, x < 128);
        }
#pragma unroll 1
        for (;;) { const Ctx C = fresh_ctx(C0.lds); const int x = queue_next(P, C, l); if (x >= 640) break; scan_unit(P, C, l, 0, x); }
        return;
    }
#pragma unroll 1
    for (;;) { const Ctx C = fresh_ctx(C0.lds); const int x = queue_next(P, C, l); if (x >= 640) break;
        int type, q; if (x < 128) { type = x >> 6; q = x & 63; } else { const int r = x - 128; type = r & 1; q = 64 + (r >> 1); }
        scan_unit(P, C, l, type, q); }
}

__device__ __forceinline__ void ld16(const bf16_t* p, float* o) { unpack8(*(const u32x4*)p, o); unpack8(*(const u32x4*)(p + 8), o + 8); }
__device__ __forceinline__ void ld16f(const float* p, float* o) {
#pragma unroll
    for (int q = 0; q < 4; ++q) { const f32x4 v = *(const f32x4*)(p + 4 * q); o[4 * q] = v.x; o[4 * q + 1] = v.y; o[4 * q + 2] = v.z; o[4 * q + 3] = v.w; } }
__device__ __forceinline__ void st16(bf16_t* p, const float* o) { *(u32x4*)p = pack8(o); *(u32x4*)(p + 8) = pack8(o + 8); }
struct R16 { u32x4 a, b; };
__device__ __forceinline__ R16 ldraw(const bf16_t* p) { R16 r; r.a = *(const u32x4*)p; r.b = *(const u32x4*)(p + 8); return r; }
__device__ __forceinline__ void cvt16(const R16& r, float* o) { unpack8(r.a, o); unpack8(r.b, o + 8); }
__device__ __forceinline__ void phase_post(const Params& P, const Ctx& C, int l) {
    const int j = l >> 1; const bool ev = (l & 1) == 0;
    const bf16_t* PROJ = (const bf16_t*)(P.ws + WS_PROJ); const bf16_t* PREP = (const bf16_t*)(P.ws + WS_PREP);
    const bf16_t* Y0 = (const bf16_t*)(P.ws + WS_MP); const bf16_t* Y1 = Y0 + (size_t)MTOK * YLD; bf16_t* MIX = (bf16_t*)(P.ws + WS_MIX);
    const int gw = C.bid * 8 + C.wave, NGW = C.G * 8, lane = C.lane, c0 = lane * 16;
#pragma unroll 1
    for (int m = gw; m < MTOK; m += NGW) {
        float ya[16], yb[16], t0[16], t1[16], o[16];
        if (ev) {
            const bf16_t* pp = PREP + (size_t)m * PREP_LD;
            const R16 rY0a = ldraw(Y0 + (size_t)m * YLD + c0), rY1a = ldraw(Y1 + (size_t)m * YLD + c0), rXS = ldraw(pp + c0), rSZ = ldraw(pp + 2048 + c0);
            const R16 rY0b = ldraw(Y0 + (size_t)m * YLD + 1024 + c0), rY1b = ldraw(Y1 + (size_t)m * YLD + 1024 + c0);
            const R16 rR = ldraw(pp + 3072 + c0), rK = ldraw(pp + 4096 + c0), rV = ldraw(pp + 5120 + c0), rG = ldraw(PROJ + (size_t)m * LOUT_LD + 4096 + c0);
            float pn[16], pw[16], pb[16], pk[16];
            ld16f(P.in[I_SSDN] + j * 1024 + c0, pn); ld16f(P.in[I_LNW] + j * 1024 + c0, pw); ld16f(P.in[I_LNB] + j * 1024 + c0, pb); ld16f(P.in[I_RK] + j * 1024 + c0, pk);
            cvt16(rY0a, ya); cvt16(rY1a, yb); cvt16(rXS, t0); cvt16(rSZ, t1);
            const float dsk = P.in[I_SSDD][j * 16 + (lane >> 2)]; float ss = 0.f;
#pragma unroll
            for (int e = 0; e < 16; ++e) { o[e] = (ya[e] + yb[e] + t0[e] * dsk) * t1[e]; ss += o[e] * o[e]; }
            const float rs = rsqrtf(wave_sum(ss) * (1.f / 1024.f) + 1e-6f);
#pragma unroll
            for (int e = 0; e < 16; ++e) o[e] = o[e] * rs * pn[e];
            st16(MIX + (size_t)m * 2048 + c0, o);
            cvt16(rY0b, ya); cvt16(rY1b, yb);
            float mu = 0.f;
#pragma unroll
            for (int e = 0; e < 16; ++e) { ya[e] += yb[e]; mu += ya[e]; }
            mu += __shfl_xor(mu, 1); mu += __shfl_xor(mu, 2); mu *= (1.f / 64.f);
            float var = 0.f;
#pragma unroll
            for (int e = 0; e < 16; ++e) { ya[e] -= mu; var += ya[e] * ya[e]; }
            var += __shfl_xor(var, 1); var += __shfl_xor(var, 2); var *= (1.f / 64.f);
            const float rstd = rsqrtf(var + 64e-5f);
#pragma unroll
            for (int e = 0; e < 16; ++e) o[e] = ya[e] * rstd * pw[e] + pb[e];
            cvt16(rR, ya); cvt16(rK, yb);
            float bs = 0.f;
#pragma unroll
            for (int e = 0; e < 16; ++e) bs += ya[e] * yb[e] * pk[e];
            bs += __shfl_xor(bs, 1); bs += __shfl_xor(bs, 2);
            cvt16(rV, ya); cvt16(rG, yb);
#pragma unroll
            for (int e = 0; e < 16; ++e) o[e] = (o[e] + bs * ya[e]) * yb[e];
            st16(MIX + (size_t)m * 2048 + 1024 + c0, o);
        } else {
            const bf16_t* pr = PROJ + (size_t)m * PROJ_LD_CD;
            const R16 rA0 = ldraw(Y0 + (size_t)m * YLD + c0), rB0 = ldraw(Y1 + (size_t)m * YLD + c0), rA1 = ldraw(Y0 + (size_t)m * YLD + 1024 + c0), rB1 = ldraw(Y1 + (size_t)m * YLD + 1024 + c0);
            const R16 rG0 = ldraw(pr + 2048 + c0), rG1 = ldraw(pr + IN_GLA + 2048 + c0);
            float pg[16], pm[16]; ld16f(P.in[I_GLAN] + j * 1024 + c0, pg); ld16f(P.in[I_MLN] + j * 1024 + c0, pm);
#pragma unroll
            for (int g = 0; g < 2; ++g) {
                cvt16(g == 0 ? rA0 : rA1, ya); cvt16(g == 0 ? rB0 : rB1, yb);
                float ss = 0.f;
#pragma unroll
                for (int e = 0; e < 16; ++e) { ya[e] += yb[e]; ss += ya[e] * ya[e]; }
                ss += __shfl_xor(ss, 1); ss += __shfl_xor(ss, 2); ss += __shfl_xor(ss, 4); ss += __shfl_xor(ss, 8);
                const float rs = rsqrtf(ss * (1.f / 256.f) + 1e-6f);
                cvt16(g == 0 ? rG0 : rG1, t1);
#pragma unroll
                for (int e = 0; e < 16; ++e) o[e] = ya[e] * rs * (g == 0 ? pg[e] : pm[e]) * (g == 0 ? siluf_(t1[e]) : sigmoidf_(t1[e]));
                st16(MIX + (size_t)m * 2048 + g * 1024 + c0, o);
            }
        }
    }
}

__global__ void __launch_bounds__(512, 2) hybrid_fwd(Params P) {
    extern __shared__ __attribute__((aligned(16))) unsigned char lds_raw[];
    cg::grid_group grid = cg::this_grid();
    Ctx C; C.lds = (LAS unsigned char*)lds_raw; C.tid = threadIdx.x; C.lane = C.tid & 63; C.wave = __builtin_amdgcn_readfirstlane(C.tid >> 6); C.G = gridDim.x; C.bid = blockIdx.x;
    const float* MOD = (const float*)(P.ws + WS_MOD);
    const bf16_t* H = (const bf16_t*)(P.ws + WS_H);
    if (C.tid < 4) ((volatile LAS unsigned*)(C.lds + LDS_BYTES - 16))[C.tid] = 0u;
    __syncthreads();
    const XcdBarrier xb = xcd_barrier_post((unsigned*)(P.ws + WS_CTL), (volatile LAS unsigned*)(C.lds + LDS_BYTES - 16));
    REP(1) if (PH & 1) phase_mod(P, fresh_ctx(C.lds));
    REP(2) if (PH & 2) phase_convert(P, fresh_ctx(C.lds), 0);
    if (P.ws == nullptr) grid.sync(); else GSYNC();
    if (PH & 4) phase_rows(P, fresh_ctx(C.lds), 0, nullptr, nullptr, true, P.in[I_NORMG] + 0, MOD + 0);
    GSYNC();
#pragma unroll 1
    for (int l = 0; l < 4; ++l) {
        const bool ev = (l & 1) == 0; const float* modl = MOD + (size_t)l * 5 * 6144; const float* ng = P.in[I_NORMG] + l * 4 * 1024;
        REP(8) if (PH & 8) { pg8::Gemm g{H, (const bf16_t*)(P.ws + WS_WIN), 1024, 1024, 1024}; pg8::Sched<0> S; S.init(MTOK, ev ? N_AB_P : N_CD_P, 1, 1024, C.G, C.bid);
          pg8::EpiBf16<0> E{(bf16_t*)(P.ws + WS_PROJ), ev ? PROJ_LD_AB : PROJ_LD_CD, 0}; pg8::gemm_phase(C.lds, g, S, E); }
        GSYNC();
        REP(16) if (PH & 16) { if (ev) phase_prep_even(P, fresh_ctx(C.lds), l >> 1); else phase_prep_odd(P, fresh_ctx(C.lds), l >> 1); }
        GSYNC();
        if (ev && (PH & 32)) {
            REP(32) {
            pg8::Gemm g{(const bf16_t*)(P.ws + WS_LORAA), (const bf16_t*)(P.ws + WS_WLORA), LORA_K, 128, 128}; pg8::Sched<1> S; S.init(MTOK, LOUT_LD, 1, 128, C.G, C.bid);
            pg8::EpiBf16<0> E{(bf16_t*)(P.ws + WS_PROJ), LOUT_LD, 0}; pg8::gemm_phase(C.lds, g, S, E); }
            GSYNC();
        }
        for (int rep_ = 0; rep_ < (((DUP & 64) && ev) || ((DUP & 0x4000) && !ev) ? 2 : 1); ++rep_) if (PH & 64) phase_scan(P, fresh_ctx(C.lds), l);
        GSYNC();
        REP(128) if (PH & 128) phase_post(P, fresh_ctx(C.lds), l);
        GSYNC();
        REP(256) if (PH & 256) { pg8::Gemm g{(const bf16_t*)(P.ws + WS_MIX), (const bf16_t*)(P.ws + WS_WOUT), 2048, 2048, 1024}; pg8::Sched<0> S; S.init(MTOK, 1024, 2, 1024, C.G, C.bid);
          pg8::EpiBf16<0> E{(bf16_t*)(P.ws + WS_MP), 1024, (size_t)MTOK * 1024}; pg8::gemm_phase(C.lds, g, S, E); }
        GSYNC();
        if (DUP & 512) phase_rows(P, fresh_ctx(C.lds), 1, ng + 1024, modl + 2048, true, ng + 2048, modl + 3072, true);
        if (PH & 512) phase_rows(P, fresh_ctx(C.lds), 1, ng + 1024, modl + 2048, true, ng + 2048, modl + 3072);
        GSYNC();
        REP(1024) if (PH & 1024) { pg8::Gemm g{H, (const bf16_t*)(P.ws + WS_WUP), 1024, 1024, 1024}; pg8::Sched<0> S; S.init(MTOK, 4096, 1, 1024, C.G, C.bid);
          pg8::EpiBf16<2> E{(bf16_t*)(P.ws + WS_PROJ), 4096, 0}; pg8::gemm_phase(C.lds, g, S, E); }
        GSYNC();
        REP(2048) if (PH & 2048) { pg8::Gemm g{(const bf16_t*)(P.ws + WS_PROJ), (const bf16_t*)(P.ws + WS_WDN), 4096, 4096, 2048}; pg8::Sched<0> S; S.init(MTOK, 1024, 2, 2048, C.G, C.bid);
          pg8::EpiBf16<0> E{(bf16_t*)(P.ws + WS_MP), 1024, (size_t)MTOK * 1024}; pg8::gemm_phase(C.lds, g, S, E); }
        GSYNC();
        if (DUP & 4096) phase_rows(P, fresh_ctx(C.lds), 1, ng + 3072, modl + 5120, true, ng + 2048, modl + 3072, true);
        if (PH & 4096) { if (l < 3) { phase_rows(P, fresh_ctx(C.lds), 1, ng + 3072, modl + 5120, true, ng + 4096, modl + 5 * 6144); phase_convert(P, fresh_ctx(C.lds), l + 1); }
        else phase_rows(P, fresh_ctx(C.lds), 1, ng + 3072, modl + 5120, false, nullptr, nullptr); }
        if (l < 3) GSYNC();
    }
}

extern "C" void kernel_launch(void* const* d_in, const int* in_sizes, int n_in, void* d_out, int out_size, void* d_ws, size_t ws_size, hipStream_t stream) {
    static int grid = 0;
    if (grid == 0) {
        if (n_in != 44 || ws_size < WS_END) { fprintf(stderr, "kernel_launch: unexpected n_in %d / ws %zu\n", n_in, ws_size); grid = -1; return; }
        int dev = 0, cus = 0, per_cu = 0;
        hipGetDevice(&dev); hipDeviceGetAttribute(&cus, hipDeviceAttributeMultiprocessorCount, dev);
        if (hipFuncSetAttribute((const void*)hybrid_fwd, hipFuncAttributeMaxDynamicSharedMemorySize, LDS_BYTES) != hipSuccess) { fprintf(stderr, "hipFuncSetAttribute failed\n"); grid = -1; return; }
        hipOccupancyMaxActiveBlocksPerMultiprocessor(&per_cu, (const void*)hybrid_fwd, 512, LDS_BYTES);
        (void)hipGetLastError();
        if (per_cu < 1) per_cu = 1;
        grid = cus * 1;
    }
    if (grid < 0) return;
    if (hipMemsetAsync((char*)d_ws + WS_CTL, 0, CTL_BYTES, stream) != hipSuccess) { fprintf(stderr, "memset failed\n"); return; }
    Params p{};
    for (int i = 0; i < 44; ++i) p.in[i] = (const float*)d_in[i];
    p.out = (float*)d_out; p.ws = (unsigned char*)d_ws;
    void* args[] = {&p};
    hipError_t e = hipLaunchCooperativeKernel((const void*)hybrid_fwd, dim3(grid), dim3(512), args, LDS_BYTES, stream);
    if (e != hipSuccess) fprintf(stderr, "cooperative launch failed: %s (grid %d)\n", hipGetErrorString(e), grid);
}
```

```cpp
#include <hip/hip_runtime.h>
#include <hip/hip_cooperative_groups.h>
#include <cstdio>
#include <cstdint>
namespace cg = cooperative_groups;

#define LAS __attribute__((address_space(3)))
typedef unsigned short bf16_t;
typedef short bf16x8 __attribute__((ext_vector_type(8)));
typedef float f32x4 __attribute__((ext_vector_type(4)));
typedef float f32x2 __attribute__((ext_vector_type(2)));
typedef unsigned u32x4 __attribute__((ext_vector_type(4)));
typedef unsigned u32x2 __attribute__((ext_vector_type(2)));

constexpr int MTOK = 8192, DM = 1024, DFF = 4096;
constexpr int N_AB = 6560, N_AB_P = 6656, N_CD = 6192, N_CD_P = 6400;
constexpr int PROJ_LD_AB = N_AB_P, PROJ_LD_CD = N_CD_P;
constexpr int PREP_LD = 7168, LOUT_LD = 5120, LORA_K = 384, YLD = 2048;
constexpr int IN_SSD = 3104, IN_GLA = 3104;
constexpr size_t MiB = 1u << 20;
constexpr size_t WS_MOD = 0, WS_CTL = 512 * 1024, CTL_BYTES = 32768, WS_DT = 1 * MiB, WS_DA = 3 * MiB, WS_WIN = 5 * MiB, WS_WOUT = 19 * MiB, WS_WUP = 23 * MiB, WS_WDN = 31 * MiB,
                 WS_WLORA = 39 * MiB, WS_H = 41 * MiB, WS_PROJ = 57 * MiB, WS_PREP = 161 * MiB, WS_MIX = 273 * MiB, WS_MP = 305 * MiB,
                 WS_LORAA = 369 * MiB, WS_END = 375 * MiB;
constexpr size_t O_X = 0, O_SSD = 8388608, O_RWKV = 16777216, O_GLA = 20971520, O_MC = 29360128, O_MN = 37748736, O_MM = 37781504;

struct Params { const float* in[44]; float* out; unsigned char* ws; };
enum { I_XP = 0, I_XS, I_SSSD, I_SRWKV, I_SGLA, I_SMC, I_SMN, I_SMM, I_C, I_CCTX, I_WMOD, I_BMOD, I_NORMG, I_WUP, I_WDN, I_WINAB, I_SCONVW, I_SCONVB,
       I_DTB, I_ALOG, I_SSDD, I_SSDN, I_MU, I_W0, I_W2, I_A0, I_A2, I_G2, I_KK, I_KA, I_RK, I_LNW, I_LNB, I_WOUTAB, I_WINCD, I_GGW, I_GGB, I_GLAN,
       I_MCONVW, I_MCONVB, I_MIB, I_MFB, I_MLN, I_WOUTCD };

__device__ __forceinline__ float bf2f(unsigned b) { return __uint_as_float(b << 16); }
__device__ __forceinline__ unsigned f2bf(float f) { unsigned u = __float_as_uint(f); return (u + 0x7fffu + ((u >> 16) & 1u)) >> 16; }
typedef __bf16 bf16x2_hw __attribute__((ext_vector_type(2)));
__device__ __forceinline__ unsigned pk2(float lo, float hi) { const f32x2 v = {lo, hi}; const bf16x2_hw b = __builtin_convertvector(v, bf16x2_hw); return __builtin_bit_cast(unsigned, b); }
__device__ __forceinline__ float lo16(unsigned w) { return __uint_as_float(w << 16); }
__device__ __forceinline__ float hi16(unsigned w) { return __uint_as_float(w & 0xffff0000u); }
__device__ __forceinline__ void unpack8(u32x4 w, float* o) { o[0] = lo16(w.x); o[1] = hi16(w.x); o[2] = lo16(w.y); o[3] = hi16(w.y); o[4] = lo16(w.z); o[5] = hi16(w.z); o[6] = lo16(w.w); o[7] = hi16(w.w); }
__device__ __forceinline__ f32x4 unpack4(u32x2 w) { return (f32x4){lo16(w.x), hi16(w.x), lo16(w.y), hi16(w.y)}; }
__device__ __forceinline__ u32x4 pack8(const float* o) { u32x4 w; w.x = pk2(o[0], o[1]); w.y = pk2(o[2], o[3]); w.z = pk2(o[4], o[5]); w.w = pk2(o[6], o[7]); return w; }
__device__ __forceinline__ float sigmoidf_(float x) { return 1.f / (1.f + __expf(-x)); }
__device__ __forceinline__ float siluf_(float x) { return x / (1.f + __expf(-x)); }
__device__ __forceinline__ float softplusf_(float x) { return fmaxf(x, 0.f) + __logf(1.f + __expf(-fabsf(x))); }
__device__ __forceinline__ float logsigmoidf_(float x) { return fminf(x, 0.f) - __logf(1.f + __expf(-fabsf(x))); }
__device__ __forceinline__ float tanhf_(float x) { const float e = __expf(-2.f * fabsf(x)); const float r = (1.f - e) / (1.f + e); return x < 0.f ? -r : r; }
__device__ __forceinline__ float wave_sum(float v) {
#pragma unroll
    for (int o = 1; o < 64; o <<= 1) v += __shfl_xor(v, o);
    return v;
}
__device__ __forceinline__ float quad_sum(float x) {
    x += __int_as_float(__builtin_amdgcn_update_dpp(0, __float_as_int(x), 0xB1, 0xF, 0xF, true));
    x += __int_as_float(__builtin_amdgcn_update_dpp(0, __float_as_int(x), 0x4E, 0xF, 0xF, true));
    return x;
}

#define DPP_ADD(x, ctrl) ((x) + __int_as_float(__builtin_amdgcn_update_dpp(0, __float_as_int(x), (ctrl), 0xF, 0xF, true)))
__device__ __forceinline__ float row_sum8(float x) { x = DPP_ADD(x, 0xB1); x = DPP_ADD(x, 0x4E); x = DPP_ADD(x, 0x141); return x; }
__device__ __forceinline__ float row_sum16(float x) { x = row_sum8(x); x = DPP_ADD(x, 0x140); return x; }
namespace pg8 {
constexpr int BM = 256, BK = 64, HALF = 128, HTB = HALF * BK * 2, STAGE_BYTES = 8 * HTB, NXCD = 8, WGM = 8;
__host__ __device__ __forceinline__ int lds_byte(int r, int c) { const int st = (r >> 4) * 2 + (c >> 5), rr = r & 15, cc = c & 31, ob = rr * 64 + cc * 2; return st * 1024 + (ob ^ (((ob >> 9) & 1) << 5)); }
__host__ __device__ __forceinline__ void stage_rc(int b, int& R, int& C) { const int st = b / 1024, sb = b % 1024, swz = sb ^ (((sb >> 9) & 1) << 5); R = (st >> 1) * 16 + swz / 64; C = (st & 1) * 32 + (swz % 64) / 2; }
__host__ __device__ __forceinline__ int perm32(int rho) { const int n = rho >> 4, i = rho & 15; return 8 * (i >> 2) + 4 * n + (i & 3); }

struct Unit { int pm, pn, ks; };
struct Gemm { const bf16_t* A; const bf16_t* Bt; int lda, ldb, K; };
template <int mode> struct Sched {
    int nM, nN, nNv, nwg, G, c, K;
    __device__ void init(int M, int N, int nK, int K_, int G_, int c_) { nM = M / BM; nN = N / BM; nNv = nN * nK; nwg = nM * nNv; G = G_; c = c_; K = K_; }
    __device__ bool next(int i, Unit& u) const {
        const long L = (long)i * G + c; if (L >= nwg) return false;
        int wgid = (int)L; { const int q = nwg / NXCD, r = nwg % NXCD, xcd = wgid % NXCD, off = wgid / NXCD; wgid = (xcd < r ? xcd * (q + 1) : r * (q + 1) + (xcd - r) * q) + off; }
        const int nig = WGM * nNv, gid = wgid / nig, fm = gid * WGM, gsz = (nM - fm) < WGM ? (nM - fm) : WGM;
        u.pm = fm + ((wgid % nig) % gsz); const int pnv = (wgid % nig) / gsz; u.pn = pnv % nN; u.ks = pnv / nN; return true;
    }
    __device__ __forceinline__ size_t aoff(const Unit& u) const { if (mode == 1) { const int g = u.pn >> 2; return (size_t)(g < 2 ? 0 : (g < 4 ? 128 : 256)) * 2; } return (size_t)u.ks * K * 2; }
    __device__ __forceinline__ size_t boff(const Unit& u) const { return mode == 1 ? 0 : (size_t)u.ks * K * 2; }
};

__device__ __forceinline__ unsigned cvt_pk_bf16(float lo, float hi) { unsigned r; asm volatile("v_cvt_pk_bf16_f32 %0, %1, %2" : "=v"(r) : "v"(lo), "v"(hi)); return r; }

template <int ACT> struct EpiBf16 {
    static constexpr bool PERM = true;
    bf16_t* O; int ldc; size_t pstride;
    __device__ __forceinline__ void operator()(const f32x4 (&acc)[2][2][4][2], const Unit& u, int wr, int wc, int fr, int fq) const {
        const int row0 = u.pm * BM + wr * 64 + fr; const int col0 = u.pn * BM + wc * 32 + 8 * fq; bf16_t* Ob = O + (size_t)u.ks * pstride;
#pragma unroll
        for (int ai = 0; ai < 2; ++ai)
#pragma unroll
            for (int m = 0; m < 4; ++m) { bf16_t* rowp = Ob + (size_t)(row0 + ai * HALF + m * 16) * ldc + col0;
#pragma unroll
                for (int bj = 0; bj < 2; ++bj) { f32x4 v0 = acc[ai][bj][m][0], v1 = acc[ai][bj][m][1];
                    if (ACT == 2) {
#pragma unroll
                        for (int e = 0; e < 4; ++e) { const float a = fmaxf(v0[e], 0.f), b = fmaxf(v1[e], 0.f); v0[e] = a * a; v1[e] = b * b; } }
                    u32x4 w; w.x = cvt_pk_bf16(v0[0], v0[1]); w.y = cvt_pk_bf16(v0[2], v0[3]); w.z = cvt_pk_bf16(v1[0], v1[1]); w.w = cvt_pk_bf16(v1[2], v1[3]);
                    *(u32x4*)(rowp + bj * HALF) = w; } }
    }
};
struct EpiF32 {
    static constexpr bool PERM = false;
    float* O; int ldc; size_t pstride;
    __device__ __forceinline__ void operator()(const f32x4 (&acc)[2][2][4][2], const Unit& u, int wr, int wc, int fr, int fq) const {
        float* base = O + (size_t)u.ks * pstride; const int col0 = u.pn * BM + wc * 32 + 4 * fq;
#pragma unroll
        for (int ai = 0; ai < 2; ++ai)
#pragma unroll
            for (int m = 0; m < 4; ++m) { float* rowp = base + (size_t)(u.pm * BM + ai * HALF + wr * 64 + m * 16 + fr) * ldc + col0;
#pragma unroll
                for (int bj = 0; bj < 2; ++bj)
#pragma unroll
                    for (int n = 0; n < 2; ++n) *(f32x4*)(rowp + bj * HALF + n * 16) = acc[ai][bj][m][n]; }
    }
};

template <class Epi, class SchedT>
__device__ __forceinline__ void gemm_phase(LAS unsigned char* lds, const Gemm g, const SchedT& S, const Epi& E) {
    int tid_ = threadIdx.x; asm volatile("" : "+v"(tid_));
    const int tid = tid_, wid = __builtin_amdgcn_readfirstlane(tid >> 6), lane = tid & 63, wr = wid >> 2, wc = wid & 3, fr = lane & 15, fq = lane >> 4;
    int K_ = g.K; asm volatile("" : "+s"(K_));
    const int K = K_, nt = K / BK;
    unsigned voffA[2], voffB[2];
#pragma unroll
    for (int i = 0; i < 2; ++i) { int R, C; stage_rc(tid * 16 + i * 8192, R, C); const int Rb = Epi::PERM ? ((R & ~31) + perm32(R & 31)) : R;
        voffA[i] = (unsigned)(R * g.lda + C) * 2u; voffB[i] = (unsigned)(Rb * g.ldb + C) * 2u; }
    const size_t kstep = (size_t)(BK * 2);
    const size_t hstepA = (size_t)HALF * g.lda * 2, hstepB = (size_t)HALF * g.ldb * 2;
    const size_t tstepA = 2 * hstepA, tstepB = 2 * hstepB;
    const unsigned ldsw = (unsigned)wid * 1024u;
    const int aoff = lds_byte(wr * 64 + fr, fq * 8), boff = lds_byte(wc * 32 + fr, fq * 8);
#define PG8_SA(b, h) (((b) * 2 + (h)) * HTB)
#define PG8_SB(b, h) ((4 + (b) * 2 + (h)) * HTB)
#define PG8_STAGE(bufoff, gbase, voff) do { _Pragma("unroll") for (int _i = 0; _i < 2; ++_i) \
        __builtin_amdgcn_global_load_lds((const unsigned*)((const char*)(gbase) + (voff)[_i]), (LAS unsigned*)(lds + (bufoff) + ldsw + _i * 8192), 16, 0, 0); } while (0)
#define PG8_LDA(dst, b, h) do { _Pragma("unroll") for (int m = 0; m < 4; ++m) _Pragma("unroll") for (int k = 0; k < 2; ++k) dst[m][k] = *(const LAS bf16x8*)(lds + PG8_SA(b, h) + aoff + m * 2048 + k * 1024); } while (0)
#define PG8_LDB(dst, b, h) do { _Pragma("unroll") for (int n = 0; n < 2; ++n) _Pragma("unroll") for (int k = 0; k < 2; ++k) dst[n][k] = *(const LAS bf16x8*)(lds + PG8_SB(b, h) + boff + n * 2048 + k * 1024); } while (0)
#define PG8_MMA(ai, bj, At, Bt) do { __builtin_amdgcn_s_setprio(1); _Pragma("unroll") for (int m = 0; m < 4; ++m) _Pragma("unroll") for (int n = 0; n < 2; ++n) _Pragma("unroll") for (int k = 0; k < 2; ++k) \
        acc[ai][bj][m][n] = __builtin_amdgcn_mfma_f32_16x16x32_bf16(Bt[n][k], At[m][k], acc[ai][bj][m][n], 0, 0, 0); __builtin_amdgcn_s_setprio(0); } while (0)
#define PG8_WAIT_V(n) asm volatile("s_waitcnt vmcnt(" #n ")" ::: "memory")
#define PG8_WAIT_L(n) asm volatile("s_waitcnt lgkmcnt(" #n ")" ::: "memory")
#define PG8_BAR __builtin_amdgcn_s_barrier()
#define PG8_SCHED __builtin_amdgcn_sched_barrier(0)
    Unit cur, nxt; int ui = 0;
    if (!S.next(0, cur)) return;
    f32x4 acc[2][2][4][2];
#pragma unroll
    for (int a = 0; a < 2; ++a)
#pragma unroll
        for (int b = 0; b < 2; ++b)
#pragma unroll
            for (int m = 0; m < 4; ++m)
#pragma unroll
                for (int n = 0; n < 2; ++n) acc[a][b][m][n] = (f32x4){0.f, 0.f, 0.f, 0.f};
    bf16x8 At[4][2], B0[2][2], B1[2][2];
    const char* cA = (const char*)g.A + (size_t)cur.pm * tstepA + S.aoff(cur); const char* cB = (const char*)g.Bt + (size_t)cur.pn * tstepB + S.boff(cur);
    PG8_STAGE(PG8_SB(0, 0), cB, voffB); PG8_STAGE(PG8_SB(0, 1), cB + hstepB, voffB); PG8_STAGE(PG8_SA(0, 0), cA, voffA); PG8_STAGE(PG8_SA(0, 1), cA + hstepA, voffA);
    if (wr == 1) PG8_BAR;
    PG8_WAIT_V(2); PG8_BAR;
    PG8_STAGE(PG8_SB(1, 0), cB + kstep, voffB); PG8_STAGE(PG8_SA(1, 0), cA + kstep, voffA); PG8_STAGE(PG8_SB(1, 1), cB + hstepB + kstep, voffB);
    PG8_WAIT_V(6); PG8_BAR;
    for (;;) {
        const bool has_next = S.next(ui + 1, nxt);
        const char* nA = has_next ? (const char*)g.A + (size_t)nxt.pm * tstepA + S.aoff(nxt) : cA; const char* nB = has_next ? (const char*)g.Bt + (size_t)nxt.pn * tstepB + S.boff(nxt) : cB;
        for (int t = 0; t < nt; t += 2) {
            const bool last = (t == nt - 2);
            const char* a1 = cA + (size_t)(t + 1) * kstep;
            const char* a2 = last ? nA : cA + (size_t)(t + 2) * kstep; const char* b2 = last ? nB : cB + (size_t)(t + 2) * kstep;
            const char* a3 = a2 + kstep; const char* b3 = b2 + kstep;
            PG8_LDB(B0, 0, 0); PG8_LDB(B1, 0, 1); PG8_SCHED; PG8_LDA(At, 0, 0); PG8_STAGE(PG8_SA(1, 1), a1 + hstepA, voffA);
            PG8_WAIT_V(8); PG8_WAIT_L(0); PG8_BAR; PG8_MMA(0, 0, At, B0); PG8_MMA(0, 1, At, B1); PG8_BAR; PG8_SCHED;
            PG8_LDA(At, 0, 1); PG8_STAGE(PG8_SB(0, 0), b2, voffB); PG8_STAGE(PG8_SB(0, 1), b2 + hstepB, voffB); PG8_STAGE(PG8_SA(0, 0), a2, voffA);
            PG8_WAIT_V(8); PG8_WAIT_L(0); PG8_BAR; PG8_MMA(1, 0, At, B0); PG8_MMA(1, 1, At, B1); PG8_BAR; PG8_SCHED;
            PG8_LDB(B0, 1, 0); PG8_LDB(B1, 1, 1); PG8_SCHED; PG8_LDA(At, 1, 0); PG8_STAGE(PG8_SA(0, 1), a2 + hstepA, voffA);
            PG8_WAIT_V(8); PG8_WAIT_L(0); PG8_BAR; PG8_MMA(0, 0, At, B0); PG8_MMA(0, 1, At, B1); PG8_BAR; PG8_SCHED;
            PG8_LDA(At, 1, 1); PG8_STAGE(PG8_SB(1, 0), b3, voffB); PG8_STAGE(PG8_SB(1, 1), b3 + hstepB, voffB); PG8_STAGE(PG8_SA(1, 0), a3, voffA);
            PG8_WAIT_V(8); PG8_WAIT_L(0); PG8_BAR; PG8_MMA(1, 0, At, B0); PG8_MMA(1, 1, At, B1); PG8_BAR; PG8_SCHED;
        }
        if (wr == 0) PG8_BAR;
        E(acc, cur, wr, wc, fr, fq);
        if (!has_next) break;
#pragma unroll
        for (int a = 0; a < 2; ++a)
#pragma unroll
            for (int b = 0; b < 2; ++b)
#pragma unroll
                for (int m = 0; m < 4; ++m)
#pragma unroll
                    for (int n = 0; n < 2; ++n) acc[a][b][m][n] = (f32x4){0.f, 0.f, 0.f, 0.f};
        cur = nxt; cA = nA; cB = nB; ++ui;
        if (wr == 1) PG8_BAR;
    }
    PG8_WAIT_V(0);
    PG8_BAR;
#undef PG8_SA
#undef PG8_SB
#undef PG8_STAGE
#undef PG8_LDA
#undef PG8_LDB
#undef PG8_MMA
#undef PG8_WAIT_V
#undef PG8_WAIT_L
#undef PG8_BAR
#undef PG8_SCHED
}
}

#define XB_TMO      128
#define XB_XCNT(j)  (256  + 64 * (j))
#define XB_XSUB(j)  (1280 + 64 * (j))
#define XB_XGEN(j)  (2304 + 64 * (j))
#define XB_TOP      3328
#define XB_TOPGEN   3392
#define XCD_BAR_WORDS 3456
#define XB_SPIN_CAP (1u << 18)
__device__ __forceinline__ unsigned xb_ld(unsigned* p)              { return __hip_atomic_load(p, __ATOMIC_RELAXED, __HIP_MEMORY_SCOPE_AGENT); }
__device__ __forceinline__ unsigned xb_add(unsigned* p, unsigned v) { return __hip_atomic_fetch_add(p, v, __ATOMIC_RELAXED, __HIP_MEMORY_SCOPE_AGENT); }
__device__ __forceinline__ unsigned xb_xcc_id() { return (unsigned)__builtin_amdgcn_s_getreg((3 << 11) | 20) & 0xFu; }
#define XB_SPIN(cond, bar) do { unsigned _sp = 0; while (cond) { __builtin_amdgcn_s_sleep(1); \
    if ((++_sp & 255u) == 0u) { if (xb_ld(&(bar)[XB_TMO])) break; if (_sp > XB_SPIN_CAP) { atomicAdd(&(bar)[XB_TMO], 1u); break; } } } } while (0)
struct XcdBarrier { unsigned* bar; unsigned x; volatile LAS unsigned* st; };
__device__ __forceinline__ XcdBarrier xcd_barrier_post(unsigned* bar, volatile LAS unsigned* st) {
    XcdBarrier b; b.bar = bar; b.x = xb_xcc_id(); b.st = st;
    if (threadIdx.x == 0) (void)xb_add(&bar[XB_XCNT(b.x)], 1u);
    return b;
}
__device__ __forceinline__ void xcd_barrier_complete(unsigned* bar, unsigned x, unsigned& nloc, unsigned& nx) {
    const unsigned G = gridDim.x * gridDim.y * gridDim.z;
    unsigned sum, cnt, mine, sp = 0u;
    for (;;) {
        sum = 0u; cnt = 0u; mine = 0u;
#pragma unroll
        for (unsigned j = 0; j < 16; ++j) { const unsigned c = xb_ld(&bar[XB_XCNT(j)]); sum += c; cnt += (c > 0u) ? 1u : 0u; mine = (j == x) ? c : mine; }
        if (sum == G) break;
        __builtin_amdgcn_s_sleep(1);
        if ((++sp & 255u) == 0u) { if (xb_ld(&bar[XB_TMO])) break; if (sp > XB_SPIN_CAP) { atomicAdd(&bar[XB_TMO], 1u); break; } }
    }
    nloc = mine > 0u ? mine : 1u; nx = cnt > 0u ? cnt : 1u;
}
__device__ __forceinline__ void xcd_barrier(const XcdBarrier& b) {
    asm volatile("s_waitcnt vmcnt(0)" ::: "memory");
    __syncthreads();
    if (threadIdx.x == 0) {
        unsigned* bar = b.bar;
        __builtin_amdgcn_s_waitcnt(0);
        unsigned nloc = b.st[0], nx = b.st[1];
        if (nloc == 0u) { xcd_barrier_complete(bar, b.x, nloc, nx); b.st[0] = nloc; b.st[1] = nx; }
        const unsigned old = xb_add(&bar[XB_XSUB(b.x)], 1u);
        const unsigned gen = old / nloc;
        if (old + 1u == (gen + 1u) * nloc) {
            __builtin_amdgcn_fence(__ATOMIC_RELEASE, "agent");
            asm volatile("s_waitcnt vmcnt(0)" ::: "memory");
            const unsigned og = xb_add(&bar[XB_TOP], 1u);
            const unsigned tg = og / nx;
            if (og + 1u == (tg + 1u) * nx) xb_add(&bar[XB_TOPGEN], 1u);
            else XB_SPIN(xb_ld(&bar[XB_TOPGEN]) == tg, bar);
            __builtin_amdgcn_fence(__ATOMIC_ACQUIRE, "agent");
            xb_add(&bar[XB_XGEN(b.x)], 1u);
            asm volatile("s_waitcnt vmcnt(0)" ::: "memory");
        } else {
            XB_SPIN(xb_ld(&bar[XB_XGEN(b.x)]) == gen, bar);
            __builtin_amdgcn_fence(__ATOMIC_ACQUIRE, "agent");
            asm volatile("s_waitcnt vmcnt(0)" ::: "memory");
        }
    }
    __syncthreads();
}

constexpr int LDS_BYTES = 147456;
#ifndef PH
#define PH 0xFFFF
#endif
#ifndef DUP
#define DUP 0
#endif
#define GSYNC() do { xcd_barrier(xb); if (DUP & 0x8000) { xcd_barrier(xb); xcd_barrier(xb); } } while (0)
#define REP(bit) for (int rep_ = 0; rep_ < ((DUP & (bit)) ? 2 : 1); ++rep_)
struct Ctx { LAS unsigned char* lds; int tid, lane, wave, G, bid; };
__device__ __forceinline__ Ctx fresh_ctx(LAS unsigned char* lds) { Ctx C; int t = threadIdx.x; asm volatile("" : "+v"(t)); C.lds = lds; C.tid = t; C.lane = t & 63; C.wave = __builtin_amdgcn_readfirstlane(t >> 6); C.G = gridDim.x; C.bid = blockIdx.x; return C; }

__device__ __forceinline__ void phase_mod(const Params& P, const Ctx& C) {
    LAS float* sc = (LAS float*)C.lds; LAS float* red = sc + 5120;
    for (int i = C.tid; i < 5120; i += 512) { const int r = i >> 10, k = i & 1023; const float x = r == 0 ? P.in[I_CCTX][k] : P.in[I_C][(r - 1) * 1024 + k]; sc[i] = siluf_(x); }
    __syncthreads();
    float* MOD = (float*)(P.ws + WS_MOD);
    const int kg = C.tid >> 5, c = C.tid & 31;
    for (int tile = C.bid; tile < 768; tile += C.G) {
        const int l = tile / 192, col = (tile % 192) * 32 + c;
        const float* w = P.in[I_WMOD] + (size_t)l * 1024 * 6144 + col;
        float a0 = 0.f, a1 = 0.f, a2 = 0.f, a3 = 0.f, a4 = 0.f;
#pragma unroll 32
        for (int k = kg * 64; k < kg * 64 + 64; ++k) { const float wv = w[(size_t)k * 6144]; a0 += sc[k] * wv; a1 += sc[1024 + k] * wv; a2 += sc[2048 + k] * wv; a3 += sc[3072 + k] * wv; a4 += sc[4096 + k] * wv; }
        red[(kg * 5 + 0) * 32 + c] = a0; red[(kg * 5 + 1) * 32 + c] = a1; red[(kg * 5 + 2) * 32 + c] = a2; red[(kg * 5 + 3) * 32 + c] = a3; red[(kg * 5 + 4) * 32 + c] = a4;
        __syncthreads();
        if (C.tid < 160) { const int r = C.tid >> 5; float s = 0.f;
#pragma unroll
            for (int q = 0; q < 16; ++q) s += red[(q * 5 + r) * 32 + c];
            MOD[(size_t)(l * 5 + r) * 6144 + col] = s + P.in[I_BMOD][l * 6144 + col]; }
        __syncthreads();
    }
}

__device__ __forceinline__ void transpose_item(const float* W, int K, int N, bf16_t* WT, LAS float* scr, int item, int nblk, int lane) {
    const int kb = item / nblk, nb = item % nblk, k0 = 64 * kb, n0 = 32 * nb;
    const bool nok = (n0 + (lane & 31)) < N;
#pragma unroll
    for (int i = 0; i < 32; ++i) { const int kk = 2 * i + (lane >> 5); scr[kk * 33 + (lane & 31)] = nok ? W[(size_t)(k0 + kk) * N + n0 + (lane & 31)] : 0.f; }
    asm volatile("s_waitcnt lgkmcnt(0)" ::: "memory");
    const int c = lane & 7;
#pragma unroll
    for (int j = 0; j < 4; ++j) { const int n = (lane >> 3) + 8 * j; const LAS float* s = scr + (8 * c) * 33 + n;
        u32x4 o; o.x = pk2(s[0 * 33], s[1 * 33]); o.y = pk2(s[2 * 33], s[3 * 33]); o.z = pk2(s[4 * 33], s[5 * 33]); o.w = pk2(s[6 * 33], s[7 * 33]);
        *(u32x4*)(WT + (size_t)(n0 + n) * K + k0 + 8 * c) = o; }
    asm volatile("s_waitcnt lgkmcnt(0)" ::: "memory");
}
__device__ __forceinline__ void phase_convert(const Params& P, const Ctx& C, int l) {
    LAS float* scr = (LAS float*)(C.lds + 32768 + C.wave * 8704);
    const int gw = C.bid * 8 + C.wave, NGW = C.G * 8; const int j = l >> 1; const bool ev = (l & 1) == 0;
    const float* win = ev ? P.in[I_WINAB] + (size_t)j * 1024 * N_AB : P.in[I_WINCD] + (size_t)j * 1024 * N_CD;
    const float* wout = (ev ? P.in[I_WOUTAB] : P.in[I_WOUTCD]) + (size_t)j * 2048 * 1024;
    const float* wup = P.in[I_WUP] + (size_t)l * 1024 * 4096; const float* wdn = P.in[I_WDN] + (size_t)l * 4096 * 1024;
    const int N_in = ev ? N_AB : N_CD, Np = ev ? N_AB_P : N_CD_P;
    const int I0 = 16 * (Np / 32), I1 = 32 * 32, I2 = 16 * 128, I3 = 64 * 32;
    const int NI = I0 + I1 + I2 + I3; const int lane = C.lane;
    struct Desc { const float* W; bf16_t* WT; int K, N, k0, n0; };
    auto desc = [&](int it) { Desc d; int r = it, nblk;
        if (r < I0) { d.W = win; d.K = 1024; d.N = N_in; d.WT = (bf16_t*)(P.ws + WS_WIN); nblk = Np / 32; }
        else if ((r -= I0) < I1) { d.W = wout; d.K = 2048; d.N = 1024; d.WT = (bf16_t*)(P.ws + WS_WOUT); nblk = 32; }
        else if ((r -= I1) < I2) { d.W = wup; d.K = 1024; d.N = 4096; d.WT = (bf16_t*)(P.ws + WS_WUP); nblk = 128; }
        else { r -= I2; d.W = wdn; d.K = 4096; d.N = 1024; d.WT = (bf16_t*)(P.ws + WS_WDN); nblk = 32; }
        d.k0 = 64 * (r / nblk); d.n0 = 32 * (r % nblk); return d; };
    float v[32];
#define CV_LOAD(d) do { const bool nok_ = ((d).n0 + (lane & 31)) < (d).N; _Pragma("unroll") for (int i = 0; i < 32; ++i) { const int kk = 2 * i + (lane >> 5); \
        v[i] = nok_ ? (d).W[(size_t)((d).k0 + kk) * (d).N + (d).n0 + (lane & 31)] : 0.f; } } while (0)
    int it = gw; Desc d = desc(it < NI ? it : 0);
    if (it < NI) CV_LOAD(d);
    while (it < NI) {
#pragma unroll
        for (int i = 0; i < 32; ++i) { const int kk = 2 * i + (lane >> 5); scr[kk * 33 + (lane & 31)] = v[i]; }
        asm volatile("s_waitcnt lgkmcnt(0)" ::: "memory");
        const int nit = it + NGW; Desc dn = desc(nit < NI ? nit : 0);
        if (nit < NI) CV_LOAD(dn);
        const int c = lane & 7;
#pragma unroll
        for (int jq = 0; jq < 4; ++jq) { const int n = (lane >> 3) + 8 * jq; const LAS float* sp = scr + (8 * c) * 33 + n;
            u32x4 o; o.x = pk2(sp[0 * 33], sp[1 * 33]); o.y = pk2(sp[2 * 33], sp[3 * 33]); o.z = pk2(sp[4 * 33], sp[5 * 33]); o.w = pk2(sp[6 * 33], sp[7 * 33]);
            *(u32x4*)(d.WT + (size_t)(d.n0 + n) * d.K + d.k0 + 8 * c) = o; }
        asm volatile("s_waitcnt lgkmcnt(0)" ::: "memory");
        d = dn; it = nit;
    }
#undef CV_LOAD
    if (ev) {
        bf16_t* WL = (bf16_t*)(P.ws + WS_WLORA);
        for (int idx = C.bid * 512 + C.tid; idx < 5120 * 16; idx += C.G * 512) {
            const int n = idx % 5120, k8 = idx / 5120, g = n >> 10, cc = n & 1023; float o[8];
#pragma unroll
            for (int e = 0; e < 8; ++e) { const int k = k8 * 8 + e; float v = 0.f;
                if (g == 0) { if (k < 64) v = P.in[I_W2][((size_t)(j * 2 + 0) * 64 + k) * 1024 + cc]; }
                else if (g == 1) { if (k >= 64) v = P.in[I_W2][((size_t)(j * 2 + 1) * 64 + (k - 64)) * 1024 + cc]; }
                else if (g == 2) { if (k < 64) v = P.in[I_A2][((size_t)(j * 2 + 0) * 64 + k) * 1024 + cc]; }
                else if (g == 3) { if (k >= 64) v = P.in[I_A2][((size_t)(j * 2 + 1) * 64 + (k - 64)) * 1024 + cc]; }
                else v = P.in[I_G2][((size_t)j * 128 + k) * 1024 + cc];
                o[e] = v; }
            *(u32x4*)(WL + (size_t)n * 128 + k8 * 8) = pack8(o);
        }
    }
}

__device__ __forceinline__ void phase_rows(const Params& P, const Ctx& C, int mode, const float* gpost, const float* gate_mod  ,
                                           bool next, const float* gpre, const float* mod_next  , bool dummy = false) {
    float* X = P.out + O_X; const bf16_t* MP0 = (const bf16_t*)(P.ws + WS_MP); const bf16_t* MP1 = MP0 + (size_t)MTOK * DM; bf16_t* H = (bf16_t*)(P.ws + WS_H);
    const int gw = C.bid * 8 + C.wave, NGW = C.G * 8;
    for (int m = gw; m < MTOK; m += NGW) {
        const int mr = m < 4096 ? 0 : 1 + ((m - 4096) >> 10);
        f32x4 x[4];
        f32x4 gq[4], sh[4], sl[4];
        if (next) { const f32x4* gp_ = (const f32x4*)gpre + C.lane; const f32x4* sh_ = (const f32x4*)(mod_next + (size_t)mr * 6144) + C.lane; const f32x4* sl_ = (const f32x4*)(mod_next + (size_t)mr * 6144 + 1024) + C.lane;
#pragma unroll
            for (int j = 0; j < 4; ++j) { gq[j] = gp_[64 * j]; sh[j] = sh_[64 * j]; sl[j] = sl_[64 * j]; } }
        if (mode == 0) { const f32x4* src = (const f32x4*)(m < 4096 ? P.in[I_XP] + (size_t)m * DM : P.in[I_XS] + (size_t)(m - 4096) * DM) + C.lane;
#pragma unroll
            for (int j = 0; j < 4; ++j) x[j] = src[64 * j];
        } else {
            const f32x4* xs = (const f32x4*)(X + (size_t)m * DM) + C.lane; const u32x2* p0 = (const u32x2*)(MP0 + (size_t)m * DM) + C.lane; const u32x2* p1 = (const u32x2*)(MP1 + (size_t)m * DM) + C.lane;
            const f32x4* gp = (const f32x4*)gpost + C.lane; const f32x4* gt = (const f32x4*)(gate_mod + (size_t)mr * 6144) + C.lane;
            f32x4 gpv[4], gtv[4];
#pragma unroll
            for (int j = 0; j < 4; ++j) { gpv[j] = gp[64 * j]; gtv[j] = gt[64 * j]; }
            f32x4 f[4]; float ss = 0.f;
#pragma unroll
            for (int j = 0; j < 4; ++j) { x[j] = xs[64 * j]; f[j] = unpack4(p0[64 * j]) + unpack4(p1[64 * j]); ss += (f[j].x * f[j].x + f[j].y * f[j].y) + (f[j].z * f[j].z + f[j].w * f[j].w); }
            const float rs = rsqrtf(wave_sum(ss) * (1.f / DM) + 1e-6f);
#pragma unroll
            for (int j = 0; j < 4; ++j) x[j] = x[j] + gtv[j] * (f[j] * rs * gpv[j]);
        }
        f32x4* xo = (f32x4*)((dummy ? (float*)(P.ws + WS_PREP) : X) + (size_t)m * DM) + C.lane;
#pragma unroll
        for (int j = 0; j < 4; ++j) xo[64 * j] = x[j];
        if (next) {
            float ss = 0.f;
#pragma unroll
            for (int j = 0; j < 4; ++j) ss += (x[j].x * x[j].x + x[j].y * x[j].y) + (x[j].z * x[j].z + x[j].w * x[j].w);
            const float rs = rsqrtf(wave_sum(ss) * (1.f / DM) + 1e-6f);
            u32x2* ho = (u32x2*)((dummy ? (bf16_t*)(P.ws + WS_PREP + 40 * MiB) : H) + (size_t)m * DM) + C.lane;
#pragma unroll
            for (int j = 0; j < 4; ++j) { const f32x4 h = (x[j] * rs * gq[j]) * (sl[j] + 1.f) + sh[j]; u32x2 w; w.x = pk2(h.x, h.y); w.y = pk2(h.z, h.w); ho[64 * j] = w; }
        }
    }
}

__device__ __forceinline__ void conv8(const bf16_t* src, int ld, int col0, int base, int t, bool samp, const float* w, const float* b, int NC, int ch, float* acc) {
    { const f32x4 b0 = *(const f32x4*)(b + ch), b1 = *(const f32x4*)(b + ch + 4); acc[0] = b0.x; acc[1] = b0.y; acc[2] = b0.z; acc[3] = b0.w; acc[4] = b1.x; acc[5] = b1.y; acc[6] = b1.z; acc[7] = b1.w; }
    if (!samp) {
#pragma unroll
        for (int d = 0; d < 3; ++d) { const int tt = t + d - 1; if (tt < 0 || tt >= 256) continue;
            float xv[8]; unpack8(*(const u32x4*)(src + (size_t)(base + tt) * ld + col0 + ch), xv);
            const f32x4 w0 = *(const f32x4*)(w + (3 + d) * NC + ch), w1 = *(const f32x4*)(w + (3 + d) * NC + ch + 4);
            acc[0] += w0.x * xv[0]; acc[1] += w0.y * xv[1]; acc[2] += w0.z * xv[2]; acc[3] += w0.w * xv[3]; acc[4] += w1.x * xv[4]; acc[5] += w1.y * xv[5]; acc[6] += w1.z * xv[6]; acc[7] += w1.w * xv[7]; }
    } else {
        const int r = t >> 6, c = t & 63;
#pragma unroll
        for (int i = 0; i < 3; ++i)
#pragma unroll
            for (int d = 0; d < 3; ++d) { const int rr = r + i - 1, cc = c + d - 1; if (rr < 0 || rr >= 16 || cc < 0 || cc >= 64) continue;
                float xv[8]; unpack8(*(const u32x4*)(src + (size_t)(base + rr * 64 + cc) * ld + col0 + ch), xv);
                const f32x4 w0 = *(const f32x4*)(w + (i * 3 + d) * NC + ch), w1 = *(const f32x4*)(w + (i * 3 + d) * NC + ch + 4);
                acc[0] += w0.x * xv[0]; acc[1] += w0.y * xv[1]; acc[2] += w0.z * xv[2]; acc[3] += w0.w * xv[3]; acc[4] += w1.x * xv[4]; acc[5] += w1.y * xv[5]; acc[6] += w1.z * xv[6]; acc[7] += w1.w * xv[7]; }
    }
}

__device__ __forceinline__ void phase_prep_even(const Params& P, const Ctx& C, int j) {
    const bf16_t* PROJ = (const bf16_t*)(P.ws + WS_PROJ); bf16_t* PREP = (bf16_t*)(P.ws + WS_PREP); bf16_t* LA = (bf16_t*)(P.ws + WS_LORAA);
    float* DT = (float*)(P.ws + WS_DT); float* DA = (float*)(P.ws + WS_DA);
    const float* cw = P.in[I_SCONVW] + (size_t)j * 9 * 2048; const float* cb = P.in[I_SCONVB] + j * 2048;
    const float* mu = P.in[I_MU] + j * 3456; const float* kkw = P.in[I_KK] + j * 1024;
    const int gw = C.bid * 8 + C.wave, NGW = C.G * 8, lane = C.lane;
    for (int m = gw; m < MTOK; m += NGW) {
        const bool samp = m >= 4096; const int T = samp ? 1024 : 256; const int t = samp ? ((m - 4096) & 1023) : (m & 255); const int base = m - t;
        const bf16_t* prow = PROJ + (size_t)m * PROJ_LD_AB; bf16_t* orow = PREP + (size_t)m * PREP_LD;
        const bool hp = t > 0, hn = t < T - 1;
        u32x4 rx[7], rxp[7], rxn[7], rz[2];
#pragma unroll
        for (int it = 0; it < 7; ++it) { const int c = it * 512 + lane * 8; const bool ok = c < 3456; const u32x4 z4 = (u32x4){0u, 0u, 0u, 0u};
            rx[it] = ok ? *(const u32x4*)(prow + IN_SSD + c) : z4; rxp[it] = (ok && hp) ? *(const u32x4*)(prow - PROJ_LD_AB + IN_SSD + c) : z4; rxn[it] = (ok && hn) ? *(const u32x4*)(prow + PROJ_LD_AB + IN_SSD + c) : z4; }
#pragma unroll
        for (int it = 0; it < 2; ++it) rz[it] = *(const u32x4*)(prow + it * 512 + lane * 8);
#pragma unroll 1
        for (int it = 0; it < 4; it += 2) { const int ch = it * 512 + lane * 8; float acc[8], acc2[8];
            conv8(PROJ, PROJ_LD_AB, 1024, base, t, samp, cw, cb, 2048, ch, acc); conv8(PROJ, PROJ_LD_AB, 1024, base, t, samp, cw, cb, 2048, ch + 512, acc2);
#pragma unroll
            for (int e = 0; e < 8; ++e) { acc[e] = siluf_(acc[e]); acc2[e] = siluf_(acc2[e]); }
            *(u32x4*)(orow + ch) = pack8(acc); *(u32x4*)(orow + ch + 512) = pack8(acc2); }
#pragma unroll
        for (int it = 0; it < 2; ++it) { const int ch = it * 512 + lane * 8; float z[8]; unpack8(rz[it], z);
#pragma unroll
            for (int e = 0; e < 8; ++e) z[e] = siluf_(z[e]);
            *(u32x4*)(orow + 2048 + ch) = pack8(z); }
        if (lane < 32) { const float raw = bf2f(prow[3072 + lane]); const float dt = softplusf_(raw + P.in[I_DTB][j * 32 + lane]);
            DT[(size_t)m * 32 + lane] = dt; DA[(size_t)m * 32 + lane] = -dt * __expf(P.in[I_ALOG][j * 32 + lane]); }
#pragma unroll
        for (int it = 0; it < 7; ++it) { const int c = it * 512 + lane * 8; if (c >= 3456) break;
            float x[8], xp[8], xn[8];
            unpack8(rx[it], x); unpack8(rxp[it], xp); unpack8(rxn[it], xn);
            const f32x4 m0 = *(const f32x4*)(mu + c), m1 = *(const f32x4*)(mu + c + 4);
            const float mv[8] = {m0.x, m0.y, m0.z, m0.w, m1.x, m1.y, m1.z, m1.w};
#pragma unroll
            for (int e = 0; e < 8; ++e) x[e] = x[e] + mv[e] * (0.5f * (xp[e] + xn[e]) - x[e]);
            if (it < 2) { *(u32x4*)(orow + 3072 + c) = pack8(x); }
            else if (it < 4) { *(u32x4*)(orow + 4096 + (c - 1024)) = pack8(x);
                const f32x4 k0 = *(const f32x4*)(kkw + c - 1024), k1 = *(const f32x4*)(kkw + c - 1024 + 4);
                const float kv[8] = {k0.x, k0.y, k0.z, k0.w, k1.x, k1.y, k1.z, k1.w}; float ss = 0.f;
#pragma unroll
                for (int e = 0; e < 8; ++e) { x[e] *= kv[e]; ss += x[e] * x[e]; }
                ss += __shfl_xor(ss, 1); ss += __shfl_xor(ss, 2); ss += __shfl_xor(ss, 4);
                const float rn = rsqrtf(ss + 1e-12f);
#pragma unroll
                for (int e = 0; e < 8; ++e) x[e] *= rn;
                *(u32x4*)(orow + 6144 + (c - 1024)) = pack8(x); }
            else if (it < 6) { *(u32x4*)(orow + 5120 + (c - 2048)) = pack8(x); }
            else { const int cc = c - 3072;
#pragma unroll
                for (int e = 0; e < 8; ++e) x[e] = cc < 128 ? tanhf_(x[e]) : (cc < 256 ? x[e] : sigmoidf_(x[e]));
                *(u32x4*)(LA + (size_t)m * LORA_K + cc) = pack8(x); }
        }
    }
}
__device__ __forceinline__ void phase_prep_odd(const Params& P, const Ctx& C, int j) {
    const bf16_t* PROJ = (const bf16_t*)(P.ws + WS_PROJ); bf16_t* PREP = (bf16_t*)(P.ws + WS_PREP);
    const float* cw = P.in[I_MCONVW] + (size_t)j * 9 * 1024; const float* cb = P.in[I_MCONVB] + j * 1024;
    const int gw = C.bid * 8 + C.wave, NGW = C.G * 8, lane = C.lane;
    for (int m = gw; m < MTOK; m += NGW) {
        const bool samp = m >= 4096; const int t = samp ? ((m - 4096) & 1023) : (m & 255); const int base = m - t;
        { const int ch = lane * 8; float acc[8], acc2[8];
            conv8(PROJ, PROJ_LD_CD, IN_GLA, base, t, samp, cw, cb, 1024, ch, acc); conv8(PROJ, PROJ_LD_CD, IN_GLA, base, t, samp, cw, cb, 1024, ch + 512, acc2);
#pragma unroll
            for (int e = 0; e < 8; ++e) { acc[e] = siluf_(acc[e]); acc2[e] = siluf_(acc2[e]); }
            *(u32x4*)(PREP + (size_t)m * PREP_LD + ch) = pack8(acc); *(u32x4*)(PREP + (size_t)m * PREP_LD + ch + 512) = pack8(acc2); }
    }
}

constexpr int CS_QLD = 136, CS_SLD = 72;
constexpr int CS_QS = 0, CS_KS = 17408, CS_KT = 34816, CS_VT = 53248;
__device__ __forceinline__ bf16x8 lds_frag(const LAS bf16_t* p) { return *(const LAS bf16x8*)p; }
template <int MODE>
__device__ __forceinline__ void chunk_scan(const Params& P, const Ctx& C, int j, int s, int dir, int h, int vs) {
    const int tid = C.tid, lane = C.lane, w = C.wave, fr = lane & 15, fq = lane >> 4;
    const int T = s < 16 ? 256 : 1024, base = s < 16 ? s * 256 : 4096 + (s - 16) * 1024, nch = T >> 6;
    const bf16_t* PROJ = (const bf16_t*)(P.ws + WS_PROJ); const bf16_t* PREP = (const bf16_t*)(P.ws + WS_PREP);
    bf16_t* Y = (bf16_t*)(P.ws + WS_MP) + (size_t)dir * MTOK * YLD;
    LAS bf16_t* Qs = (LAS bf16_t*)(C.lds + CS_QS); LAS bf16_t* Ks = (LAS bf16_t*)(C.lds + CS_KS); LAS bf16_t* Kt = (LAS bf16_t*)(C.lds + CS_KT); LAS bf16_t* Vt = (LAS bf16_t*)(C.lds + CS_VT);
    constexpr int NV = MODE == 0 ? 64 : 128, NVC = NV / 16, VROWS = NV + (MODE == 2 ? 16 : 0);
    constexpr int CS_ST = CS_VT + VROWS * CS_SLD * 2, CS_LA = CS_ST + VROWS * CS_QLD * 2, CS_PS = CS_LA  , CS_TOT = CS_LA + (MODE == 1 ? 32768 : 9216),
                  CS_BV = CS_TOT + 2560, CS_IG = CS_BV + 256, CS_FV = CS_IG + 256, CS_DTV = CS_FV + 256, CS_MS = CS_DTV + 256;
    static_assert(CS_MS + 64 <= LDS_BYTES - 16, "chunk-scan LDS map");
    LAS bf16_t* Ps = (LAS bf16_t*)(C.lds + CS_PS); LAS bf16_t* St = (LAS bf16_t*)(C.lds + CS_ST);
    LAS float* LA = (LAS float*)(C.lds + CS_LA); LAS float* TOT = (LAS float*)(C.lds + CS_TOT); LAS float* BV = (LAS float*)(C.lds + CS_BV); LAS float* IG = (LAS float*)(C.lds + CS_IG);
    LAS float* MS = (LAS float*)(C.lds + CS_MS); LAS float* FV = (LAS float*)(C.lds + CS_FV); LAS float* DTV = (LAS float*)(C.lds + CS_DTV);
    constexpr int NVT = NVC + (MODE == 2 ? 1 : 0);
    const int si = tid >> 3, kq = tid & 7;
    __syncthreads();
    bf16x8 gwa_hi = {0, 0, 0, 0, 0, 0, 0, 0}, gwa_lo = {0, 0, 0, 0, 0, 0, 0, 0}; f32x4 gb4 = {0.f, 0.f, 0.f, 0.f};
    if (MODE == 1) {
        const float* gwp = P.in[I_GGW] + (size_t)(j * 2 + dir) * 16 * 512 + h * 128 + 16 * w + fr;
        if (fq < 2) {
#pragma unroll
            for (int e = 0; e < 8; ++e) { const float g = gwp[(8 * fq + e) * 512]; const unsigned hb = f2bf(g); const float rem = g - bf2f(hb); gwa_hi[e] = (short)hb; gwa_lo[e] = (short)f2bf(rem); } }
        gb4 = *(const f32x4*)(P.in[I_GGB] + (j * 2 + dir) * 512 + h * 128 + 16 * w + 4 * fq);
    }
    f32x4 Sacc[NVT];
    {
        const float* s0 = nullptr; int kstride = 64; float em0 = 1.f;
        if (s >= 16) { const int b = s - 16;
            if (MODE == 0) { s0 = P.in[I_SSSD] + ((size_t)((b * 2 + j) * 2 + dir) * 16 + h) * 8192; kstride = 64; }
            if (MODE == 1) { s0 = P.in[I_SGLA] + ((size_t)((b * 2 + j) * 2 + dir) * 4 + h) * 32768 + vs * NV; kstride = 256; }
            if (MODE == 2) { s0 = P.in[I_SMC] + ((size_t)((b * 2 + j) * 2 + dir) * 4 + h) * 32768 + vs * NV; kstride = 256; em0 = __expf(P.in[I_SMM][((b * 2 + j) * 2 + dir) * 4 + h]); } }
#pragma unroll
        for (int vt = 0; vt < NVC; ++vt)
#pragma unroll
            for (int e = 0; e < 4; ++e) Sacc[vt][e] = s0 ? s0[(size_t)(16 * w + 4 * fq + e) * kstride + 16 * vt + fr] * em0 : 0.f;
        if (MODE == 2) {
            const float* n0 = s >= 16 ? P.in[I_SMN] + ((size_t)(((s - 16) * 2 + j) * 2 + dir) * 4 + h) * 128 : nullptr;
#pragma unroll
            for (int e = 0; e < 4; ++e) Sacc[NVT - 1][e] = (n0 && fr == 0) ? n0[16 * w + 4 * fq + e] * em0 : 0.f;
            if (tid == 0) MS[0] = s >= 16 ? P.in[I_SMM][(((s - 16) * 2 + j) * 2 + dir) * 4 + h] : 0.f;
            for (int i = tid; i < 16 * CS_SLD; i += 512) Vt[NV * CS_SLD + i] = (bf16_t)((i < CS_SLD) ? 0x3F80 : 0);
        }
#pragma unroll
        for (int vt = 0; vt < NVT; ++vt) { u32x2 wv; wv.x = pk2(Sacc[vt][0], Sacc[vt][1]); wv.y = pk2(Sacc[vt][2], Sacc[vt][3]); *(LAS u32x2*)(St + (16 * vt + fr) * CS_QLD + 16 * w + 4 * fq) = wv; }
    }
    u32x4 rq0, rq1, rk0, rk1, rgd[4]; float rla = 0.f, rig = 0.f, rdt = 0.f;
    constexpr int NVTOK = MODE == 0 ? 8 : 16;
    unsigned short rkt[16], rvt[NVTOK];
    const int kx = tid & 127, tgk = tid >> 7, vx = tid & (NV - 1), tgv = MODE == 0 ? (tid >> 6) : (tid >> 7);
    auto tok = [&](int c, int i) { const int st0 = c * 64 + i; return base + (dir ? (T - 1 - st0) : st0); };
    auto load_raw = [&](int c) {
        const int m = tok(c, si); const int m1 = tok(c, tid & 63);
        const bf16_t* krow; const bf16_t* vrow; int kld, vld;
        if (MODE == 0) { const int g = h >> 2; const bf16_t* pr = PREP + (size_t)m * PREP_LD;
            rq0 = *(const u32x4*)(pr + 1536 + g * 128 + 16 * kq); rq1 = *(const u32x4*)(pr + 1536 + g * 128 + 16 * kq + 8);
            rk0 = *(const u32x4*)(pr + 1024 + g * 128 + 16 * kq); rk1 = *(const u32x4*)(pr + 1024 + g * 128 + 16 * kq + 8);
            if (tid < 64) { rla = ((const float*)(P.ws + WS_DA))[(size_t)m1 * 32 + dir * 16 + h]; rdt = ((const float*)(P.ws + WS_DT))[(size_t)m1 * 32 + dir * 16 + h]; }
            krow = PREP + 1024 + g * 128 + kx; kld = PREP_LD; vrow = PREP + h * 64 + vx; vld = PREP_LD; }
        if (MODE == 1) { const bf16_t* pr = PROJ + (size_t)m * PROJ_LD_CD;
            rq0 = *(const u32x4*)(pr + h * 128 + 16 * kq); rq1 = *(const u32x4*)(pr + h * 128 + 16 * kq + 8);
            rk0 = *(const u32x4*)(pr + 512 + h * 128 + 16 * kq); rk1 = *(const u32x4*)(pr + 512 + h * 128 + 16 * kq + 8);
#pragma unroll
            for (int t4 = 0; t4 < 4; ++t4) { rgd[t4] = (u32x4){0u, 0u, 0u, 0u}; if (fq < 2) rgd[t4] = *(const u32x4*)(PROJ + (size_t)tok(c, 16 * t4 + fr) * PROJ_LD_CD + 3072 + dir * 16 + 8 * fq); }
            krow = PROJ + 512 + h * 128 + kx; kld = PROJ_LD_CD; vrow = PROJ + 1024 + h * 256 + vs * NV + vx; vld = PROJ_LD_CD; }
        if (MODE == 2) { const bf16_t* pp = PREP + (size_t)m * PREP_LD;
            rq0 = *(const u32x4*)(pp + h * 128 + 16 * kq); rq1 = *(const u32x4*)(pp + h * 128 + 16 * kq + 8);
            rk0 = *(const u32x4*)(pp + 512 + h * 128 + 16 * kq); rk1 = *(const u32x4*)(pp + 512 + h * 128 + 16 * kq + 8);
            if (tid < 64) { const bf16_t* p1 = PROJ + (size_t)m1 * PROJ_LD_CD + IN_GLA + 3072; rig = bf2f(p1[dir * 4 + h]); rla = bf2f(p1[8 + dir * 4 + h]); }
            krow = PREP + 512 + h * 128 + kx; kld = PREP_LD; vrow = PROJ + IN_GLA + 1024 + h * 256 + vs * NV + vx; vld = PROJ_LD_CD; }
        { const bf16_t* kp = krow + (size_t)tok(c, 16 * tgk) * kld; const long ks_ = dir ? -(long)kld : (long)kld;
#pragma unroll
          for (int jj = 0; jj < 16; ++jj) { rkt[jj] = *kp; kp += ks_; }
          const bf16_t* vp = vrow + (size_t)tok(c, NVTOK * tgv) * vld; const long vs_ = dir ? -(long)vld : (long)vld;
#pragma unroll
          for (int jj = 0; jj < NVTOK; ++jj) { rvt[jj] = *vp; vp += vs_; } }
    };
    load_raw(0);
    __syncthreads();
    const int ycol0 = (MODE == 0 ? h * 64 : (MODE == 1 ? h * 256 + vs * NV : 1024 + h * 256 + vs * NV));
    for (int c = 0; c < nch; ++c) {
        if (MODE == 1) {
#pragma unroll
            for (int t4 = 0; t4 < 4; ++t4) { f32x4 acc = (f32x4){0.f, 0.f, 0.f, 0.f}; const bf16x8 gf = __builtin_bit_cast(bf16x8, rgd[t4]);
                acc = __builtin_amdgcn_mfma_f32_16x16x32_bf16(gwa_hi, gf, acc, 0, 0, 0); acc = __builtin_amdgcn_mfma_f32_16x16x32_bf16(gwa_lo, gf, acc, 0, 0, 0);
                f32x4 la;
#pragma unroll
                for (int e = 0; e < 4; ++e) la[e] = logsigmoidf_(acc[e] + gb4[e]) * 0.0625f;
                *(LAS f32x4*)(LA + (16 * t4 + fr) * 128 + 16 * w + 4 * fq) = la; }
        } else if (tid < 64) {
            float ig = 0.f, la = rla;
            if (MODE == 2) { ig = rig + P.in[I_MIB][(j * 2 + dir) * 4 + h]; la = logsigmoidf_(rla + P.in[I_MFB][(j * 2 + dir) * 4 + h]); }
            float x = la;
            x += __int_as_float(__builtin_amdgcn_update_dpp(0, __float_as_int(x), 0x111, 0xF, 0xF, true));
            x += __int_as_float(__builtin_amdgcn_update_dpp(0, __float_as_int(x), 0x112, 0xF, 0xF, true));
            x += __int_as_float(__builtin_amdgcn_update_dpp(0, __float_as_int(x), 0x114, 0xF, 0xF, true));
            x += __int_as_float(__builtin_amdgcn_update_dpp(0, __float_as_int(x), 0x118, 0xF, 0xF, true));
            { const float t0 = __int_as_float(__builtin_amdgcn_readlane(__float_as_int(x), 15)), t1 = __int_as_float(__builtin_amdgcn_readlane(__float_as_int(x), 31)), t2 = __int_as_float(__builtin_amdgcn_readlane(__float_as_int(x), 47));
              const int rw = lane >> 4; x += (rw > 0 ? t0 : 0.f) + (rw > 1 ? t1 : 0.f) + (rw > 2 ? t2 : 0.f); }
            const float bl = __int_as_float(__builtin_amdgcn_readlane(__float_as_int(x), 63));
            const float kgn = MODE == 2 ? 0.08838834764831845f * __expf(ig) : 1.f;
            BV[tid] = x; IG[tid] = kgn; FV[tid] = kgn * __expf(bl - x); DTV[tid] = MODE == 0 ? rdt : 1.f;
            if (MODE == 2) { float ml = bl - x + ig;
                ml = fmaxf(ml, __int_as_float(__builtin_amdgcn_update_dpp(__float_as_int(ml), __float_as_int(ml), 0xB1, 0xF, 0xF, false)));
                ml = fmaxf(ml, __int_as_float(__builtin_amdgcn_update_dpp(__float_as_int(ml), __float_as_int(ml), 0x4E, 0xF, 0xF, false)));
                ml = fmaxf(ml, __int_as_float(__builtin_amdgcn_update_dpp(__float_as_int(ml), __float_as_int(ml), 0x141, 0xF, 0xF, false)));
                ml = fmaxf(ml, __int_as_float(__builtin_amdgcn_update_dpp(__float_as_int(ml), __float_as_int(ml), 0x140, 0xF, 0xF, false)));
                const float m01 = fmaxf(__int_as_float(__builtin_amdgcn_readlane(__float_as_int(ml), 0)), __int_as_float(__builtin_amdgcn_readlane(__float_as_int(ml), 16)));
                const float m23 = fmaxf(__int_as_float(__builtin_amdgcn_readlane(__float_as_int(ml), 32)), __int_as_float(__builtin_amdgcn_readlane(__float_as_int(ml), 48)));
                if (tid == 0) MS[0] = fmaxf(bl + MS[0], fmaxf(m01, m23)); }
        }
        __syncthreads();
        if (MODE == 1) {
            const int k = tid & 127, qd = tid >> 7; float run = 0.f;
#pragma unroll
            for (int jj = 0; jj < 16; ++jj) { run += LA[(16 * qd + jj) * 128 + k]; LA[(16 * qd + jj) * 128 + k] = run; }
            TOT[qd * 128 + k] = run;
            __syncthreads();
            if (tid < 128) TOT[4 * 128 + tid] = __expf(TOT[tid] + TOT[128 + tid] + TOT[256 + tid] + TOT[384 + tid]);
        }
        {
            float q[16], k[16]; unpack8(rq0, q); unpack8(rq1, q + 8); unpack8(rk0, k); unpack8(rk1, k + 8);
            float qs[16], ks[16];
            if (MODE == 1) { const int qd = si >> 4;
#pragma unroll
                for (int e4 = 0; e4 < 4; ++e4) { const int kk = 16 * kq + 4 * e4; const f32x4 bb = *(LAS f32x4*)(LA + si * 128 + kk), t0 = *(LAS f32x4*)(TOT + kk), t1 = *(LAS f32x4*)(TOT + 128 + kk), t2 = *(LAS f32x4*)(TOT + 256 + kk);
#pragma unroll
                    for (int e = 0; e < 4; ++e) { const float b = bb[e] + (qd > 0 ? t0[e] : 0.f) + (qd > 1 ? t1[e] : 0.f) + (qd > 2 ? t2[e] : 0.f);
                        qs[4 * e4 + e] = q[4 * e4 + e] * 0.08838834764831845f * __expf(b); ks[4 * e4 + e] = k[4 * e4 + e] * __expf(fminf(-b, 80.f)); } }
            } else { const float kgn = IG[si];
#pragma unroll
                for (int e = 0; e < 16; ++e) { qs[e] = q[e]; ks[e] = k[e] * kgn; } }
            *(LAS u32x4*)(Qs + si * CS_QLD + 16 * kq) = pack8(qs); *(LAS u32x4*)(Qs + si * CS_QLD + 16 * kq + 8) = pack8(qs + 8);
            *(LAS u32x4*)(Ks + si * CS_QLD + 16 * kq) = pack8(ks); *(LAS u32x4*)(Ks + si * CS_QLD + 16 * kq + 8) = pack8(ks + 8);
        }
        if (MODE == 1)
        {
            float kt[16];
            if (MODE == 1) { float off = 0.f; const float t0 = TOT[kx], t1 = TOT[128 + kx], t2 = TOT[256 + kx], t3 = TOT[384 + kx];
                off = (tgk > 0 ? t0 : 0.f) + (tgk > 1 ? t1 : 0.f) + (tgk > 2 ? t2 : 0.f); const float bl = (t0 + t1) + (t2 + t3);
#pragma unroll
                for (int jj = 0; jj < 16; ++jj) kt[jj] = bf2f(rkt[jj]) * __expf(bl - (LA[(16 * tgk + jj) * 128 + kx] + off));
            } else {
#pragma unroll
                for (int jj = 0; jj < 16; ++jj) kt[jj] = bf2f(rkt[jj]) * FV[16 * tgk + jj]; }
            *(LAS u32x4*)(Kt + kx * CS_SLD + 16 * tgk) = pack8(kt); *(LAS u32x4*)(Kt + kx * CS_SLD + 16 * tgk + 8) = pack8(kt + 8);
            float vt8[NVTOK];
#pragma unroll
            for (int jj = 0; jj < NVTOK; ++jj) vt8[jj] = bf2f(rvt[jj]) * (MODE == 0 ? DTV[NVTOK * tgv + jj] : 1.f);
            *(LAS u32x4*)(Vt + vx * CS_SLD + NVTOK * tgv) = pack8(vt8);
            if (NVTOK == 16) *(LAS u32x4*)(Vt + vx * CS_SLD + NVTOK * tgv + 8) = pack8(vt8 + 8);
        }
        __syncthreads();
        if (MODE != 1)
        {
            float kt[16];
            if (MODE == 1) { float off = 0.f; const float t0 = TOT[kx], t1 = TOT[128 + kx], t2 = TOT[256 + kx], t3 = TOT[384 + kx];
                off = (tgk > 0 ? t0 : 0.f) + (tgk > 1 ? t1 : 0.f) + (tgk > 2 ? t2 : 0.f); const float bl = (t0 + t1) + (t2 + t3);
#pragma unroll
                for (int jj = 0; jj < 16; ++jj) kt[jj] = bf2f(rkt[jj]) * __expf(bl - (LA[(16 * tgk + jj) * 128 + kx] + off));
            } else {
#pragma unroll
                for (int jj = 0; jj < 16; ++jj) kt[jj] = bf2f(rkt[jj]) * FV[16 * tgk + jj]; }
            *(LAS u32x4*)(Kt + kx * CS_SLD + 16 * tgk) = pack8(kt); *(LAS u32x4*)(Kt + kx * CS_SLD + 16 * tgk + 8) = pack8(kt + 8);
            float vt8[NVTOK];
#pragma unroll
            for (int jj = 0; jj < NVTOK; ++jj) vt8[jj] = bf2f(rvt[jj]) * (MODE == 0 ? DTV[NVTOK * tgv + jj] : 1.f);
            *(LAS u32x4*)(Vt + vx * CS_SLD + NVTOK * tgv) = pack8(vt8);
            if (NVTOK == 16) *(LAS u32x4*)(Vt + vx * CS_SLD + NVTOK * tgv + 8) = pack8(vt8 + 8);
        }
        if (c + 1 < nch) load_raw(c + 1);
        const int tt = w >> 1;
#pragma unroll
        for (int sj = 0; sj < 2; ++sj) { const int st = 2 * (w & 1) + sj; u32x2 wv; wv.x = 0u; wv.y = 0u;
            if (st <= tt) { f32x4 acc = (f32x4){0.f, 0.f, 0.f, 0.f};
#pragma unroll
                for (int kk = 0; kk < 4; ++kk) acc = __builtin_amdgcn_mfma_f32_16x16x32_bf16(lds_frag(Ks + (16 * st + fr) * CS_QLD + 32 * kk + 8 * fq), lds_frag(Qs + (16 * tt + fr) * CS_QLD + 32 * kk + 8 * fq), acc, 0, 0, 0);
                const int tg = 16 * tt + fr, sg = 16 * st + 4 * fq;
                if (MODE != 1) { const float bt = BV[tg]; const f32x4 bs = *(LAS f32x4*)(BV + sg);
#pragma unroll
                    for (int e = 0; e < 4; ++e) acc[e] *= __expf(fminf(bt - bs[e], 0.f)); }
#pragma unroll
                for (int e = 0; e < 4; ++e) acc[e] = (sg + e <= tg) ? acc[e] : 0.f;
                wv.x = pk2(acc[0], acc[1]); wv.y = pk2(acc[2], acc[3]); }
            *(LAS u32x2*)(Ps + (16 * tt + fr) * CS_SLD + 16 * st + 4 * fq) = wv; }
        __syncthreads();
        {
            const int tg = 16 * tt + fr; const int stp = c * 64 + tg; const int m = base + (dir ? (T - 1 - stp) : stp);
            const float ebt = MODE == 1 ? 1.f : __expf(BV[tg]);
            bf16x8 pf[2], qf[4];
#pragma unroll
            for (int ks2 = 0; ks2 < 2; ++ks2) pf[ks2] = lds_frag(Ps + tg * CS_SLD + 32 * ks2 + 8 * fq);
#pragma unroll
            for (int kk = 0; kk < 4; ++kk) qf[kk] = lds_frag(Qs + tg * CS_QLD + 32 * kk + 8 * fq);
            float rden = 1.f;
            if (MODE == 2) { f32x4 ai = (f32x4){0.f, 0.f, 0.f, 0.f}, ao = (f32x4){0.f, 0.f, 0.f, 0.f};
#pragma unroll
                for (int ks2 = 0; ks2 < 2; ++ks2) ai = __builtin_amdgcn_mfma_f32_16x16x32_bf16(lds_frag(Vt + (NV + fr) * CS_SLD + 32 * ks2 + 8 * fq), pf[ks2], ai, 0, 0, 0);
#pragma unroll
                for (int kk = 0; kk < 4; ++kk) ao = __builtin_amdgcn_mfma_f32_16x16x32_bf16(lds_frag(St + (NV + fr) * CS_QLD + 32 * kk + 8 * fq), qf[kk], ao, 0, 0, 0);
                const float den = __shfl(ai[0] + ao[0] * ebt, fr); rden = 1.f / fmaxf(fabsf(den), 1.f); }
#pragma unroll
            for (int vj = 0; vj < NVC / 2; ++vj) { const int vt = (NVC / 2) * (w & 1) + vj; f32x4 ai = (f32x4){0.f, 0.f, 0.f, 0.f}, ao = (f32x4){0.f, 0.f, 0.f, 0.f};
#pragma unroll
                for (int ks2 = 0; ks2 < 2; ++ks2) ai = __builtin_amdgcn_mfma_f32_16x16x32_bf16(lds_frag(Vt + (16 * vt + fr) * CS_SLD + 32 * ks2 + 8 * fq), pf[ks2], ai, 0, 0, 0);
#pragma unroll
                for (int kk = 0; kk < 4; ++kk) ao = __builtin_amdgcn_mfma_f32_16x16x32_bf16(lds_frag(St + (16 * vt + fr) * CS_QLD + 32 * kk + 8 * fq), qf[kk], ao, 0, 0, 0);
                u32x2 wv; wv.x = pk2((ai[0] + ao[0] * ebt) * rden, (ai[1] + ao[1] * ebt) * rden); wv.y = pk2((ai[2] + ao[2] * ebt) * rden, (ai[3] + ao[3] * ebt) * rden);
                *(u32x2*)(Y + (size_t)m * YLD + ycol0 + 16 * vt + 4 * fq) = wv; }
        }
        {
            f32x4 dec; if (MODE == 1) dec = *(LAS f32x4*)(TOT + 4 * 128 + 16 * w + 4 * fq); else { const float d = __expf(BV[63]); dec = (f32x4){d, d, d, d}; }
            bf16x8 kf[2];
#pragma unroll
            for (int ks2 = 0; ks2 < 2; ++ks2) kf[ks2] = lds_frag(Kt + (16 * w + fr) * CS_SLD + 32 * ks2 + 8 * fq);
#pragma unroll
            for (int vt = 0; vt < NVT; ++vt) { Sacc[vt] = Sacc[vt] * dec;
#pragma unroll
                for (int ks2 = 0; ks2 < 2; ++ks2) Sacc[vt] = __builtin_amdgcn_mfma_f32_16x16x32_bf16(kf[ks2], lds_frag(Vt + (16 * vt + fr) * CS_SLD + 32 * ks2 + 8 * fq), Sacc[vt], 0, 0, 0); }
        }
        __syncthreads();
#pragma unroll
        for (int vt = 0; vt < NVT; ++vt) { u32x2 wv; wv.x = pk2(Sacc[vt][0], Sacc[vt][1]); wv.y = pk2(Sacc[vt][2], Sacc[vt][3]); *(LAS u32x2*)(St + (16 * vt + fr) * CS_QLD + 16 * w + 4 * fq) = wv; }
    }
    if (s < 16) {
        float* o; int kstride; float sc = 1.f;
        if (MODE == 0) { o = P.out + O_SSD + ((size_t)((s * 2 + j) * 2 + dir) * 16 + h) * 8192; kstride = 64; }
        else { o = P.out + (MODE == 1 ? O_GLA : O_MC) + ((size_t)((s * 2 + j) * 2 + dir) * 4 + h) * 32768 + vs * NV; kstride = 256; }
        if (MODE == 2) { __syncthreads(); sc = __expf(-MS[0]); }
#pragma unroll
        for (int vt = 0; vt < NVC; ++vt)
#pragma unroll
            for (int e = 0; e < 4; ++e) o[(size_t)(16 * w + 4 * fq + e) * kstride + 16 * vt + fr] = Sacc[vt][e] * sc;
        if (MODE == 2 && vs == 0) {
            if (fr == 0) {
#pragma unroll
                for (int e = 0; e < 4; ++e) P.out[O_MN + ((size_t)((s * 2 + j) * 2 + dir) * 4 + h) * 128 + 16 * w + 4 * fq + e] = Sacc[NVT - 1][e] * sc; }
            if (tid == 0) P.out[O_MM + ((s * 2 + j) * 2 + dir) * 4 + h] = MS[0]; }
    }
}

#define LO2(q_) ((f32x2){(q_)[0], (q_)[1]})
#define HI2(q_) ((f32x2){(q_)[2], (q_)[3]})
struct RwOps { f32x4 kk0, kk1, w0, w1, kd0, kd1, ka0, ka1, r0, r1; f32x2 vv; };
__device__ __forceinline__ RwOps rw_ops(const LAS float* B, int tt, int kg, int vg) {
    const LAS float* p = B + tt * 64 + 4 * kg; RwOps o;
    o.kk0 = *(const LAS f32x4*)(p + 4096); o.kk1 = *(const LAS f32x4*)(p + 4096 + 32); o.w0 = *(const LAS f32x4*)(p + 1024); o.w1 = *(const LAS f32x4*)(p + 1024 + 32);
    o.kd0 = *(const LAS f32x4*)(p + 2048); o.kd1 = *(const LAS f32x4*)(p + 2048 + 32); o.ka0 = *(const LAS f32x4*)(p + 5120); o.ka1 = *(const LAS f32x4*)(p + 5120 + 32);
    o.r0 = *(const LAS f32x4*)(p); o.r1 = *(const LAS f32x4*)(p + 32); o.vv = *(const LAS f32x2*)(B + 3072 + tt * 64 + 2 * vg); return o;
}
__device__ __forceinline__ void rwkv_pair(const Params& P, const Ctx& C, int j, int bq, bool lng) {
    const int niter = lng ? 64 : 32; const bool act = !lng || C.tid < 256;
    const int tid = C.tid, half = tid >> 8, tl = tid & 255, kg = tl & 7, vg = tl >> 3;
    const bf16_t* PREP = (const bf16_t*)(P.ws + WS_PREP); const bf16_t* LOUT = (const bf16_t*)(P.ws + WS_PROJ);
    constexpr int BUFSZ = 6 * 1024;
    LAS float* L0 = (LAS float*)C.lds + (lng ? 0 : half * 2 * BUFSZ);
    const int stt = tl >> 4, sc4 = (tl & 15) * 4;
    auto unit_of = [&](int cc, int& s, int& dir, int& h, int& lc) {
        if (lng) { s = 16 + (bq >> 5); dir = (bq >> 4) & 1; h = bq & 15; lc = cc; }
        else { const int q = 4 * bq + 2 * half + (cc >> 4); s = q >> 5; dir = (q >> 4) & 1; h = q & 15; lc = cc & 15; } };
    f32x2 Sa[4], Sb[4];
    auto init_state = [&](int s, int dir, int h) {
        const float* s0 = s >= 16 ? P.in[I_SRWKV] + (((size_t)(((s - 16) * 2 + j) * 2 + dir) * 16 + h) * 64 + 2 * vg) * 64 : nullptr;
#pragma unroll
        for (int hh = 0; hh < 2; ++hh) { const f32x4 u0 = s0 ? *(const f32x4*)(s0 + 32 * hh + 4 * kg) : (f32x4){0.f, 0.f, 0.f, 0.f}, u1 = s0 ? *(const f32x4*)(s0 + 64 + 32 * hh + 4 * kg) : (f32x4){0.f, 0.f, 0.f, 0.f};
            Sa[2 * hh] = LO2(u0); Sa[2 * hh + 1] = HI2(u0); Sb[2 * hh] = LO2(u1); Sb[2 * hh + 1] = HI2(u1); } };
    u32x2 rr, rk, rv, rkk, rwl, ral; f32x4 cw0, ca0, cka;
    auto load_raw = [&](int cc) {
        int s, dir, h, lc; unit_of(cc, s, dir, h, lc);
        const int T = s < 16 ? 256 : 1024, base = s < 16 ? s * 256 : 4096 + (s - 16) * 1024;
        const int step = lc * 16 + stt; const int m = base + (dir ? (T - 1 - step) : step);
        const bf16_t* pp = PREP + (size_t)m * PREP_LD + h * 64 + sc4; const bf16_t* lo = LOUT + (size_t)m * LOUT_LD + dir * 1024 + h * 64 + sc4;
        rr = *(const u32x2*)(pp + 3072); rk = *(const u32x2*)(pp + 4096); rv = *(const u32x2*)(pp + 5120); rkk = *(const u32x2*)(pp + 6144);
        rwl = *(const u32x2*)lo; ral = *(const u32x2*)(lo + 2048);
        cw0 = *(const f32x4*)(P.in[I_W0] + (j * 2 + dir) * 1024 + h * 64 + sc4); ca0 = *(const f32x4*)(P.in[I_A0] + (j * 2 + dir) * 1024 + h * 64 + sc4); cka = *(const f32x4*)(P.in[I_KA] + j * 1024 + h * 64 + sc4);
    };
    auto write_lds = [&](LAS float* B) {
        const f32x4 r = unpack4(rr), k = unpack4(rk), v = unpack4(rv), kk = unpack4(rkk), wl = unpack4(rwl), al = unpack4(ral);
        f32x4 w, kd, kka;
#pragma unroll
        for (int e = 0; e < 4; ++e) { const float wp = cw0[e] + wl[e]; const float lw = -__expf(-softplusf_(-wp) - 0.5f); w[e] = __expf(lw);
            const float a = sigmoidf_(ca0[e] + al[e]); kd[e] = k[e] * (1.f + (a - 1.f) * cka[e]); kka[e] = kk[e] * a; }
        LAS float* p = B + stt * 64 + sc4;
        *(LAS f32x4*)(p) = r; *(LAS f32x4*)(p + 1024) = w; *(LAS f32x4*)(p + 2048) = kd; *(LAS f32x4*)(p + 3072) = v; *(LAS f32x4*)(p + 4096) = kk; *(LAS f32x4*)(p + 5120) = kka;
    };
    __syncthreads();
    if (!lng || half == 1) { load_raw(0); write_lds(L0); }
    if (act) { int s, dir, h, lc; unit_of(0, s, dir, h, lc); init_state(s, dir, h); }
    __syncthreads();
#pragma unroll 1
    for (int cc = 0; cc < niter; ++cc) {
        if (lng && half == 1) { if (cc + 1 < niter) { load_raw(cc + 1); write_lds(L0 + ((cc + 1) & 1) * BUFSZ); } }
        if (act) {
        LAS float* B = L0 + (cc & 1) * BUFSZ;
        int s, dir, h, lc; unit_of(cc, s, dir, h, lc);
        const int T = s < 16 ? 256 : 1024, base = s < 16 ? s * 256 : 4096 + (s - 16) * 1024;
        if (!lng && cc + 1 < niter) load_raw(cc + 1);
        bf16_t* Y = (bf16_t*)(P.ws + WS_MP) + (size_t)dir * MTOK * YLD + 1024 + h * 64 + 2 * vg;
        RwOps cur = rw_ops(B, 0, kg, vg);
#pragma unroll 2
        for (int tt = 0; tt < 16; ++tt) {
            const RwOps nx = rw_ops(B, (tt + 1) & 15, kg, vg);
            const int step = lc * 16 + tt; const int m = base + (dir ? (T - 1 - step) : step);
            const f32x2 da = (Sa[0] * LO2(cur.kk0) + Sa[1] * HI2(cur.kk0)) + (Sa[2] * LO2(cur.kk1) + Sa[3] * HI2(cur.kk1));
            const f32x2 db = (Sb[0] * LO2(cur.kk0) + Sb[1] * HI2(cur.kk0)) + (Sb[2] * LO2(cur.kk1) + Sb[3] * HI2(cur.kk1));
            const float ska = row_sum8(da.x + da.y), skb = row_sum8(db.x + db.y);
            const f32x2 na = (f32x2){-ska, -ska}, nb = (f32x2){-skb, -skb}, va = (f32x2){cur.vv.x, cur.vv.x}, vb = (f32x2){cur.vv.y, cur.vv.y};
            Sa[0] = Sa[0] * LO2(cur.w0) + na * LO2(cur.ka0) + va * LO2(cur.kd0); Sa[1] = Sa[1] * HI2(cur.w0) + na * HI2(cur.ka0) + va * HI2(cur.kd0);
            Sa[2] = Sa[2] * LO2(cur.w1) + na * LO2(cur.ka1) + va * LO2(cur.kd1); Sa[3] = Sa[3] * HI2(cur.w1) + na * HI2(cur.ka1) + va * HI2(cur.kd1);
            Sb[0] = Sb[0] * LO2(cur.w0) + nb * LO2(cur.ka0) + vb * LO2(cur.kd0); Sb[1] = Sb[1] * HI2(cur.w0) + nb * HI2(cur.ka0) + vb * HI2(cur.kd0);
            Sb[2] = Sb[2] * LO2(cur.w1) + nb * LO2(cur.ka1) + vb * LO2(cur.kd1); Sb[3] = Sb[3] * HI2(cur.w1) + nb * HI2(cur.ka1) + vb * HI2(cur.kd1);
            const f32x2 ya = (Sa[0] * LO2(cur.r0) + Sa[1] * HI2(cur.r0)) + (Sa[2] * LO2(cur.r1) + Sa[3] * HI2(cur.r1));
            const f32x2 yb = (Sb[0] * LO2(cur.r0) + Sb[1] * HI2(cur.r0)) + (Sb[2] * LO2(cur.r1) + Sb[3] * HI2(cur.r1));
            const float y0 = row_sum8(ya.x + ya.y), y1 = row_sum8(yb.x + yb.y);
            if (kg == 0) *(unsigned*)(Y + (size_t)m * YLD) = pg8::cvt_pk_bf16(y0, y1);
            cur = nx;
        }
        const int nchU = lng ? 64 : 16;
        if (lc == nchU - 1 && s < 16) { float* o = P.out + O_RWKV + (((size_t)((s * 2 + j) * 2 + dir) * 16 + h) * 64 + 2 * vg) * 64;
#pragma unroll
            for (int hh = 0; hh < 2; ++hh) { *(f32x4*)(o + 32 * hh + 4 * kg) = (f32x4){Sa[2 * hh].x, Sa[2 * hh].y, Sa[2 * hh + 1].x, Sa[2 * hh + 1].y};
                *(f32x4*)(o + 64 + 32 * hh + 4 * kg) = (f32x4){Sb[2 * hh].x, Sb[2 * hh].y, Sb[2 * hh + 1].x, Sb[2 * hh + 1].y}; } }
        if (cc + 1 < niter) { if (!lng) write_lds(L0 + ((cc + 1) & 1) * BUFSZ);
            if (lc == nchU - 1) { int s2, d2_, h2, lc2; unit_of(cc + 1, s2, d2_, h2, lc2); init_state(s2, d2_, h2); } }
        }
        __syncthreads();
    }
}

__device__ __forceinline__ void scan_unit(const Params& P, const Ctx& C, int l, int type, int q) {
    const int j = l >> 1; const bool ev = (l & 1) == 0;
    if (ev) { int s, idx; if (q < 128) { s = 16 + (q >> 5); idx = q & 31; } else { const int r = q - 128; s = r >> 5; idx = r & 31; }
        chunk_scan<0>(P, C, j, s, idx >> 4, idx & 15, 0); }
    else { int s, idx; if (q < 64) { s = 16 + (q >> 4); idx = q & 15; } else { const int r = q - 64; s = r >> 4; idx = r & 15; }
        const int dir = idx >> 3, h = (idx >> 1) & 3, vs = idx & 1; if (type == 0) chunk_scan<1>(P, C, j, s, dir, h, vs); else chunk_scan<2>(P, C, j, s, dir, h, vs); }
}
__device__ __forceinline__ int queue_next(const Params& P, const Ctx& C, int l) {
    volatile LAS unsigned* qw = (volatile LAS unsigned*)(C.lds + LDS_BYTES - 16);
    __syncthreads();
    if (C.tid == 0) qw[3] = __hip_atomic_fetch_add((unsigned*)(P.ws + WS_CTL) + 6144 + 64 * l, 1u, __ATOMIC_RELAXED, __HIP_MEMORY_SCOPE_AGENT);
    __syncthreads();
    return __builtin_amdgcn_readfirstlane((int)qw[3]);
}
__device__ __forceinline__ void phase_scan(const Params& P, const Ctx& C0, int l) {
    const int G = C0.G, bid = C0.bid; const bool ev = (l & 1) == 0;
    if (ev) {
        if (G == 256) rwkv_pair(P, fresh_ctx(C0.lds), l >> 1, bid < 128 ? bid : bid - 128, bid < 128);
        else {
#pragma unroll 1
            for (int x = bid; x < 256; x += G) rwkv_pair(P, fresh_ctx(C0.lds), l >> 1, x < 128 ? x : x - 128, x < 128);
        }
#pragma unroll 1
        for (;;) { const Ctx C = fresh_ctx(C0.lds); const int x = queue_next(P, C, l); if (x >= 640) break; scan_unit(P, C, l, 0, x); }
        return;
    }
#pragma unroll 1
    for (;;) { const Ctx C = fresh_ctx(C0.lds); const int x = queue_next(P, C, l); if (x >= 640) break;
        int type, q; if (x < 128) { type = x >> 6; q = x & 63; } else { const int r = x - 128; type = r & 1; q = 64 + (r >> 1); }
        scan_unit(P, C, l, type, q); }
}

__device__ __forceinline__ void ld16(const bf16_t* p, float* o) { unpack8(*(const u32x4*)p, o); unpack8(*(const u32x4*)(p + 8), o + 8); }
__device__ __forceinline__ void ld16f(const float* p, float* o) {
#pragma unroll
    for (int q = 0; q < 4; ++q) { const f32x4 v = *(const f32x4*)(p + 4 * q); o[4 * q] = v.x; o[4 * q + 1] = v.y; o[4 * q + 2] = v.z; o[4 * q + 3] = v.w; } }
__device__ __forceinline__ void st16(bf16_t* p, const float* o) { *(u32x4*)p = pack8(o); *(u32x4*)(p + 8) = pack8(o + 8); }
struct R16 { u32x4 a, b; };
__device__ __forceinline__ R16 ldraw(const bf16_t* p) { R16 r; r.a = *(const u32x4*)p; r.b = *(const u32x4*)(p + 8); return r; }
__device__ __forceinline__ void cvt16(const R16& r, float* o) { unpack8(r.a, o); unpack8(r.b, o + 8); }
__device__ __forceinline__ void phase_post(const Params& P, const Ctx& C, int l) {
    const int j = l >> 1; const bool ev = (l & 1) == 0;
    const bf16_t* PROJ = (const bf16_t*)(P.ws + WS_PROJ); const bf16_t* PREP = (const bf16_t*)(P.ws + WS_PREP);
    const bf16_t* Y0 = (const bf16_t*)(P.ws + WS_MP); const bf16_t* Y1 = Y0 + (size_t)MTOK * YLD; bf16_t* MIX = (bf16_t*)(P.ws + WS_MIX);
    const int gw = C.bid * 8 + C.wave, NGW = C.G * 8, lane = C.lane, c0 = lane * 16;
#pragma unroll 1
    for (int m = gw; m < MTOK; m += NGW) {
        float ya[16], yb[16], t0[16], t1[16], o[16];
        if (ev) {
            const bf16_t* pp = PREP + (size_t)m * PREP_LD;
            const R16 rY0a = ldraw(Y0 + (size_t)m * YLD + c0), rY1a = ldraw(Y1 + (size_t)m * YLD + c0), rXS = ldraw(pp + c0), rSZ = ldraw(pp + 2048 + c0);
            const R16 rY0b = ldraw(Y0 + (size_t)m * YLD + 1024 + c0), rY1b = ldraw(Y1 + (size_t)m * YLD + 1024 + c0);
            const R16 rR = ldraw(pp + 3072 + c0), rK = ldraw(pp + 4096 + c0), rV = ldraw(pp + 5120 + c0), rG = ldraw(PROJ + (size_t)m * LOUT_LD + 4096 + c0);
            float pn[16], pw[16], pb[16], pk[16];
            ld16f(P.in[I_SSDN] + j * 1024 + c0, pn); ld16f(P.in[I_LNW] + j * 1024 + c0, pw); ld16f(P.in[I_LNB] + j * 1024 + c0, pb); ld16f(P.in[I_RK] + j * 1024 + c0, pk);
            cvt16(rY0a, ya); cvt16(rY1a, yb); cvt16(rXS, t0); cvt16(rSZ, t1);
            const float dsk = P.in[I_SSDD][j * 16 + (lane >> 2)]; float ss = 0.f;
#pragma unroll
            for (int e = 0; e < 16; ++e) { o[e] = (ya[e] + yb[e] + t0[e] * dsk) * t1[e]; ss += o[e] * o[e]; }
            const float rs = rsqrtf(wave_sum(ss) * (1.f / 1024.f) + 1e-6f);
#pragma unroll
            for (int e = 0; e < 16; ++e) o[e] = o[e] * rs * pn[e];
            st16(MIX + (size_t)m * 2048 + c0, o);
            cvt16(rY0b, ya); cvt16(rY1b, yb);
            float mu = 0.f;
#pragma unroll
            for (int e = 0; e < 16; ++e) { ya[e] += yb[e]; mu += ya[e]; }
            mu += __shfl_xor(mu, 1); mu += __shfl_xor(mu, 2); mu *= (1.f / 64.f);
            float var = 0.f;
#pragma unroll
            for (int e = 0; e < 16; ++e) { ya[e] -= mu; var += ya[e] * ya[e]; }
            var += __shfl_xor(var, 1); var += __shfl_xor(var, 2); var *= (1.f / 64.f);
            const float rstd = rsqrtf(var + 64e-5f);
#pragma unroll
            for (int e = 0; e < 16; ++e) o[e] = ya[e] * rstd * pw[e] + pb[e];
            cvt16(rR, ya); cvt16(rK, yb);
            float bs = 0.f;
#pragma unroll
            for (int e = 0; e < 16; ++e) bs += ya[e] * yb[e] * pk[e];
            bs += __shfl_xor(bs, 1); bs += __shfl_xor(bs, 2);
            cvt16(rV, ya); cvt16(rG, yb);
#pragma unroll
            for (int e = 0; e < 16; ++e) o[e] = (o[e] + bs * ya[e]) * yb[e];
            st16(MIX + (size_t)m * 2048 + 1024 + c0, o);
        } else {
            const bf16_t* pr = PROJ + (size_t)m * PROJ_LD_CD;
            const R16 rA0 = ldraw(Y0 + (size_t)m * YLD + c0), rB0 = ldraw(Y1 + (size_t)m * YLD + c0), rA1 = ldraw(Y0 + (size_t)m * YLD + 1024 + c0), rB1 = ldraw(Y1 + (size_t)m * YLD + 1024 + c0);
            const R16 rG0 = ldraw(pr + 2048 + c0), rG1 = ldraw(pr + IN_GLA + 2048 + c0);
            float pg[16], pm[16]; ld16f(P.in[I_GLAN] + j * 1024 + c0, pg); ld16f(P.in[I_MLN] + j * 1024 + c0, pm);
#pragma unroll
            for (int g = 0; g < 2; ++g) {
                cvt16(g == 0 ? rA0 : rA1, ya); cvt16(g == 0 ? rB0 : rB1, yb);
                float ss = 0.f;
#pragma unroll
                for (int e = 0; e < 16; ++e) { ya[e] += yb[e]; ss += ya[e] * ya[e]; }
                ss += __shfl_xor(ss, 1); ss += __shfl_xor(ss, 2); ss += __shfl_xor(ss, 4); ss += __shfl_xor(ss, 8);
                const float rs = rsqrtf(ss * (1.f / 256.f) + 1e-6f);
                cvt16(g == 0 ? rG0 : rG1, t1);
#pragma unroll
                for (int e = 0; e < 16; ++e) o[e] = ya[e] * rs * (g == 0 ? pg[e] : pm[e]) * (g == 0 ? siluf_(t1[e]) : sigmoidf_(t1[e]));
                st16(MIX + (size_t)m * 2048 + g * 1024 + c0, o);
            }
        }
    }
}

__global__ void __launch_bounds__(512, 2) hybrid_fwd(Params P) {
    extern __shared__ __attribute__((aligned(16))) unsigned char lds_raw[];
    cg::grid_group grid = cg::this_grid();
    Ctx C; C.lds = (LAS unsigned char*)lds_raw; C.tid = threadIdx.x; C.lane = C.tid & 63; C.wave = __builtin_amdgcn_readfirstlane(C.tid >> 6); C.G = gridDim.x; C.bid = blockIdx.x;
    const float* MOD = (const float*)(P.ws + WS_MOD);
    const bf16_t* H = (const bf16_t*)(P.ws + WS_H);
    if (C.tid < 4) ((volatile LAS unsigned*)(C.lds + LDS_BYTES - 16))[C.tid] = 0u;
    __syncthreads();
    const XcdBarrier xb = xcd_barrier_post((unsigned*)(P.ws + WS_CTL), (volatile LAS unsigned*)(C.lds + LDS_BYTES - 16));
    REP(1) if (PH & 1) phase_mod(P, fresh_ctx(C.lds));
    REP(2) if (PH & 2) phase_convert(P, fresh_ctx(C.lds), 0);
    if (P.ws == nullptr) grid.sync(); else GSYNC();
    if (PH & 4) phase_rows(P, fresh_ctx(C.lds), 0, nullptr, nullptr, true, P.in[I_NORMG] + 0, MOD + 0);
    GSYNC();
#pragma unroll 1
    for (int l = 0; l < 4; ++l) {
        const bool ev = (l & 1) == 0; const float* modl = MOD + (size_t)l * 5 * 6144; const float* ng = P.in[I_NORMG] + l * 4 * 1024;
        REP(8) if (PH & 8) { pg8::Gemm g{H, (const bf16_t*)(P.ws + WS_WIN), 1024, 1024, 1024}; pg8::Sched<0> S; S.init(MTOK, ev ? N_AB_P : N_CD_P, 1, 1024, C.G, C.bid);
          pg8::EpiBf16<0> E{(bf16_t*)(P.ws + WS_PROJ), ev ? PROJ_LD_AB : PROJ_LD_CD, 0}; pg8::gemm_phase(C.lds, g, S, E); }
        GSYNC();
        REP(16) if (PH & 16) { if (ev) phase_prep_even(P, fresh_ctx(C.lds), l >> 1); else phase_prep_odd(P, fresh_ctx(C.lds), l >> 1); }
        GSYNC();
        if (ev && (PH & 32)) {
            REP(32) {
            pg8::Gemm g{(const bf16_t*)(P.ws + WS_LORAA), (const bf16_t*)(P.ws + WS_WLORA), LORA_K, 128, 128}; pg8::Sched<1> S; S.init(MTOK, LOUT_LD, 1, 128, C.G, C.bid);
            pg8::EpiBf16<0> E{(bf16_t*)(P.ws + WS_PROJ), LOUT_LD, 0}; pg8::gemm_phase(C.lds, g, S, E); }
            GSYNC();
        }
        for (int rep_ = 0; rep_ < (((DUP & 64) && ev) || ((DUP & 0x4000) && !ev) ? 2 : 1); ++rep_) if (PH & 64) phase_scan(P, fresh_ctx(C.lds), l);
        GSYNC();
        REP(128) if (PH & 128) phase_post(P, fresh_ctx(C.lds), l);
        GSYNC();
        REP(256) if (PH & 256) { pg8::Gemm g{(const bf16_t*)(P.ws + WS_MIX), (const bf16_t*)(P.ws + WS_WOUT), 2048, 2048, 1024}; pg8::Sched<0> S; S.init(MTOK, 1024, 2, 1024, C.G, C.bid);
          pg8::EpiBf16<0> E{(bf16_t*)(P.ws + WS_MP), 1024, (size_t)MTOK * 1024}; pg8::gemm_phase(C.lds, g, S, E); }
        GSYNC();
        if (DUP & 512) phase_rows(P, fresh_ctx(C.lds), 1, ng + 1024, modl + 2048, true, ng + 2048, modl + 3072, true);
        if (PH & 512) phase_rows(P, fresh_ctx(C.lds), 1, ng + 1024, modl + 2048, true, ng + 2048, modl + 3072);
        GSYNC();
        REP(1024) if (PH & 1024) { pg8::Gemm g{H, (const bf16_t*)(P.ws + WS_WUP), 1024, 1024, 1024}; pg8::Sched<0> S; S.init(MTOK, 4096, 1, 1024, C.G, C.bid);
          pg8::EpiBf16<2> E{(bf16_t*)(P.ws + WS_PROJ), 4096, 0}; pg8::gemm_phase(C.lds, g, S, E); }
        GSYNC();
        REP(2048) if (PH & 2048) { pg8::Gemm g{(const bf16_t*)(P.ws + WS_PROJ), (const bf16_t*)(P.ws + WS_WDN), 4096, 4096, 2048}; pg8::Sched<0> S; S.init(MTOK, 1024, 2, 2048, C.G, C.bid);
          pg8::EpiBf16<0> E{(bf16_t*)(P.ws + WS_MP), 1024, (size_t)MTOK * 1024}; pg8::gemm_phase(C.lds, g, S, E); }
        GSYNC();
        if (DUP & 4096) phase_rows(P, fresh_ctx(C.lds), 1, ng + 3072, modl + 5120, true, ng + 2048, modl + 3072, true);
        if (PH & 4096) { if (l < 3) { phase_rows(P, fresh_ctx(C.lds), 1, ng + 3072, modl + 5120, true, ng + 4096, modl + 5 * 6144); phase_convert(P, fresh_ctx(C.lds), l + 1); }
        else phase_rows(P, fresh_ctx(C.lds), 1, ng + 3072, modl + 5120, false, nullptr, nullptr); }
        if (l < 3) GSYNC();
    }
}

extern "C" void kernel_launch(void* const* d_in, const int* in_sizes, int n_in, void* d_out, int out_size, void* d_ws, size_t ws_size, hipStream_t stream) {
    static int grid = 0;
    if (grid == 0) {
        if (n_in != 44 || ws_size < WS_END) { fprintf(stderr, "kernel_launch: unexpected n_in %d / ws %zu\n", n_in, ws_size); grid = -1; return; }
        int dev = 0, cus = 0, per_cu = 0;
        hipGetDevice(&dev); hipDeviceGetAttribute(&cus, hipDeviceAttributeMultiprocessorCount, dev);
        if (hipFuncSetAttribute((const void*)hybrid_fwd, hipFuncAttributeMaxDynamicSharedMemorySize, LDS_BYTES) != hipSuccess) { fprintf(stderr, "hipFuncSetAttribute failed\n"); grid = -1; return; }
        hipOccupancyMaxActiveBlocksPerMultiprocessor(&per_cu, (const void*)hybrid_fwd, 512, LDS_BYTES);
        (void)hipGetLastError();
        if (per_cu < 1) per_cu = 1;
        grid = cus * 1;
    }
    if (grid < 0) return;
    if (hipMemsetAsync((char*)d_ws + WS_CTL, 0, CTL_BYTES, stream) != hipSuccess) { fprintf(stderr, "memset failed\n"); return; }
    Params p{};
    for (int i = 0; i < 44; ++i) p.in[i] = (const float*)d_in[i];
    p.out = (float*)d_out; p.ws = (unsigned char*)d_ws;
    void* args[] = {&p};
    hipError_t e = hipLaunchCooperativeKernel((const void*)hybrid_fwd, dim3(grid), dim3(512), args, LDS_BYTES, stream);
    if (e != hipSuccess) fprintf(stderr, "cooperative launch failed: %s (grid %d)\n", hipGetErrorString(e), grid);
}
```

```cpp
#include <hip/hip_runtime.h>
#include <hip/hip_cooperative_groups.h>
#include <cstdio>
#include <cstdint>
namespace cg = cooperative_groups;

#define LAS __attribute__((address_space(3)))
typedef unsigned short bf16_t;
typedef short bf16x8 __attribute__((ext_vector_type(8)));
typedef float f32x4 __attribute__((ext_vector_type(4)));
typedef float f32x2 __attribute__((ext_vector_type(2)));
typedef unsigned u32x4 __attribute__((ext_vector_type(4)));
typedef unsigned u32x2 __attribute__((ext_vector_type(2)));

constexpr int MTOK = 8192, DM = 1024, DFF = 4096;
constexpr int N_AB = 6560, N_AB_P = 6656, N_CD = 6192, N_CD_P = 6400;
constexpr int PROJ_LD_AB = N_AB_P, PROJ_LD_CD = N_CD_P;
constexpr int PREP_LD = 7168, LOUT_LD = 5120, LORA_K = 384, YLD = 2048;
constexpr int IN_SSD = 3104, IN_GLA = 3104;
constexpr size_t MiB = 1u << 20;
constexpr size_t WS_MOD = 0, WS_CTL = 512 * 1024, CTL_BYTES = 32768, WS_DT = 1 * MiB, WS_DA = 3 * MiB, WS_WIN = 5 * MiB, WS_WOUT = 19 * MiB, WS_WUP = 23 * MiB, WS_WDN = 31 * MiB,
                 WS_WLORA = 39 * MiB, WS_H = 41 * MiB, WS_PROJ = 57 * MiB, WS_PREP = 161 * MiB, WS_MIX = 273 * MiB, WS_MP = 305 * MiB,
                 WS_LORAA = 369 * MiB, WS_END = 375 * MiB;
constexpr size_t O_X = 0, O_SSD = 8388608, O_RWKV = 16777216, O_GLA = 20971520, O_MC = 29360128, O_MN = 37748736, O_MM = 37781504;

struct Params { const float* in[44]; float* out; unsigned char* ws; };
enum { I_XP = 0, I_XS, I_SSSD, I_SRWKV, I_SGLA, I_SMC, I_SMN, I_SMM, I_C, I_CCTX, I_WMOD, I_BMOD, I_NORMG, I_WUP, I_WDN, I_WINAB, I_SCONVW, I_SCONVB,
       I_DTB, I_ALOG, I_SSDD, I_SSDN, I_MU, I_W0, I_W2, I_A0, I_A2, I_G2, I_KK, I_KA, I_RK, I_LNW, I_LNB, I_WOUTAB, I_WINCD, I_GGW, I_GGB, I_GLAN,
       I_MCONVW, I_MCONVB, I_MIB, I_MFB, I_MLN, I_WOUTCD };

__device__ __forceinline__ float bf2f(unsigned b) { return __uint_as_float(b << 16); }
__device__ __forceinline__ unsigned f2bf(float f) { unsigned u = __float_as_uint(f); return (u + 0x7fffu + ((u >> 16) & 1u)) >> 16; }
typedef __bf16 bf16x2_hw __attribute__((ext_vector_type(2)));
__device__ __forceinline__ unsigned pk2(float lo, float hi) { const f32x2 v = {lo, hi}; const bf16x2_hw b = __builtin_convertvector(v, bf16x2_hw); return __builtin_bit_cast(unsigned, b); }
__device__ __forceinline__ float lo16(unsigned w) { return __uint_as_float(w << 16); }
__device__ __forceinline__ float hi16(unsigned w) { return __uint_as_float(w & 0xffff0000u); }
__device__ __forceinline__ void unpack8(u32x4 w, float* o) { o[0] = lo16(w.x); o[1] = hi16(w.x); o[2] = lo16(w.y); o[3] = hi16(w.y); o[4] = lo16(w.z); o[5] = hi16(w.z); o[6] = lo16(w.w); o[7] = hi16(w.w); }
__device__ __forceinline__ f32x4 unpack4(u32x2 w) { return (f32x4){lo16(w.x), hi16(w.x), lo16(w.y), hi16(w.y)}; }
__device__ __forceinline__ u32x4 pack8(const float* o) { u32x4 w; w.x = pk2(o[0], o[1]); w.y = pk2(o[2], o[3]); w.z = pk2(o[4], o[5]); w.w = pk2(o[6], o[7]); return w; }
__device__ __forceinline__ float sigmoidf_(float x) { return 1.f / (1.f + __expf(-x)); }
__device__ __forceinline__ float siluf_(float x) { return x / (1.f + __expf(-x)); }
__device__ __forceinline__ float softplusf_(float x) { return fmaxf(x, 0.f) + __logf(1.f + __expf(-fabsf(x))); }
__device__ __forceinline__ float logsigmoidf_(float x) { return fminf(x, 0.f) - __logf(1.f + __expf(-fabsf(x))); }
__device__ __forceinline__ float tanhf_(float x) { const float e = __expf(-2.f * fabsf(x)); const float r = (1.f - e) / (1.f + e); return x < 0.f ? -r : r; }
__device__ __forceinline__ float wave_sum(float v) {
#pragma unroll
    for (int o = 1; o < 64; o <<= 1) v += __shfl_xor(v, o);
    return v;
}
__device__ __forceinline__ float quad_sum(float x) {
    x += __int_as_float(__builtin_amdgcn_update_dpp(0, __float_as_int(x), 0xB1, 0xF, 0xF, true));
    x += __int_as_float(__builtin_amdgcn_update_dpp(0, __float_as_int(x), 0x4E, 0xF, 0xF, true));
    return x;
}

#define DPP_ADD(x, ctrl) ((x) + __int_as_float(__builtin_amdgcn_update_dpp(0, __float_as_int(x), (ctrl), 0xF, 0xF, true)))
__device__ __forceinline__ float row_sum8(float x) { x = DPP_ADD(x, 0xB1); x = DPP_ADD(x, 0x4E); x = DPP_ADD(x, 0x141); return x; }
__device__ __forceinline__ float row_sum16(float x) { x = row_sum8(x); x = DPP_ADD(x, 0x140); return x; }
namespace pg8 {
constexpr int BM = 256, BK = 64, HALF = 128, HTB = HALF * BK * 2, STAGE_BYTES = 8 * HTB, NXCD = 8, WGM = 8;
__host__ __device__ __forceinline__ int lds_byte(int r, int c) { const int st = (r >> 4) * 2 + (c >> 5), rr = r & 15, cc = c & 31, ob = rr * 64 + cc * 2; return st * 1024 + (ob ^ (((ob >> 9) & 1) << 5)); }
__host__ __device__ __forceinline__ void stage_rc(int b, int& R, int& C) { const int st = b / 1024, sb = b % 1024, swz = sb ^ (((sb >> 9) & 1) << 5); R = (st >> 1) * 16 + swz / 64; C = (st & 1) * 32 + (swz % 64) / 2; }
__host__ __device__ __forceinline__ int perm32(int rho) { const int n = rho >> 4, i = rho & 15; return 8 * (i >> 2) + 4 * n + (i & 3); }

struct Unit { int pm, pn, ks; };
struct Gemm { const bf16_t* A; const bf16_t* Bt; int lda, ldb, K; };
template <int mode> struct Sched {
    int nM, nN, nNv, nwg, G, c, K;
    __device__ void init(int M, int N, int nK, int K_, int G_, int c_) { nM = M / BM; nN = N / BM; nNv = nN * nK; nwg = nM * nNv; G = G_; c = c_; K = K_; }
    __device__ bool next(int i, Unit& u) const {
        const long L = (long)i * G + c; if (L >= nwg) return false;
        int wgid = (int)L; { const int q = nwg / NXCD, r = nwg % NXCD, xcd = wgid % NXCD, off = wgid / NXCD; wgid = (xcd < r ? xcd * (q + 1) : r * (q + 1) + (xcd - r) * q) + off; }
        const int nig = WGM * nNv, gid = wgid / nig, fm = gid * WGM, gsz = (nM - fm) < WGM ? (nM - fm) : WGM;
        u.pm = fm + ((wgid % nig) % gsz); const int pnv = (wgid % nig) / gsz; u.pn = pnv % nN; u.ks = pnv / nN; return true;
    }
    __device__ __forceinline__ size_t aoff(const Unit& u) const { if (mode == 1) { const int g = u.pn >> 2; return (size_t)(g < 2 ? 0 : (g < 4 ? 128 : 256)) * 2; } return (size_t)u.ks * K * 2; }
    __device__ __forceinline__ size_t boff(const Unit& u) const { return mode == 1 ? 0 : (size_t)u.ks * K * 2; }
};

__device__ __forceinline__ unsigned cvt_pk_bf16(float lo, float hi) { unsigned r; asm volatile("v_cvt_pk_bf16_f32 %0, %1, %2" : "=v"(r) : "v"(lo), "v"(hi)); return r; }

template <int ACT> struct EpiBf16 {
    static constexpr bool PERM = true;
    bf16_t* O; int ldc; size_t pstride;
    __device__ __forceinline__ void operator()(const f32x4 (&acc)[2][2][4][2], const Unit& u, int wr, int wc, int fr, int fq) const {
        const int row0 = u.pm * BM + wr * 64 + fr; const int col0 = u.pn * BM + wc * 32 + 8 * fq; bf16_t* Ob = O + (size_t)u.ks * pstride;
#pragma unroll
        for (int ai = 0; ai < 2; ++ai)
#pragma unroll
            for (int m = 0; m < 4; ++m) { bf16_t* rowp = Ob + (size_t)(row0 + ai * HALF + m * 16) * ldc + col0;
#pragma unroll
                for (int bj = 0; bj < 2; ++bj) { f32x4 v0 = acc[ai][bj][m][0], v1 = acc[ai][bj][m][1];
                    if (ACT == 2) {
#pragma unroll
                        for (int e = 0; e < 4; ++e) { const float a = fmaxf(v0[e], 0.f), b = fmaxf(v1[e], 0.f); v0[e] = a * a; v1[e] = b * b; } }
                    u32x4 w; w.x = cvt_pk_bf16(v0[0], v0[1]); w.y = cvt_pk_bf16(v0[2], v0[3]); w.z = cvt_pk_bf16(v1[0], v1[1]); w.w = cvt_pk_bf16(v1[2], v1[3]);
                    *(u32x4*)(rowp + bj * HALF) = w; } }
    }
};
struct EpiF32 {
    static constexpr bool PERM = false;
    float* O; int ldc; size_t pstride;
    __device__ __forceinline__ void operator()(const f32x4 (&acc)[2][2][4][2], const Unit& u, int wr, int wc, int fr, int fq) const {
        float* base = O + (size_t)u.ks * pstride; const int col0 = u.pn * BM + wc * 32 + 4 * fq;
#pragma unroll
        for (int ai = 0; ai < 2; ++ai)
#pragma unroll
            for (int m = 0; m < 4; ++m) { float* rowp = base + (size_t)(u.pm * BM + ai * HALF + wr * 64 + m * 16 + fr) * ldc + col0;
#pragma unroll
                for (int bj = 0; bj < 2; ++bj)
#pragma unroll
                    for (int n = 0; n < 2; ++n) *(f32x4*)(rowp + bj * HALF + n * 16) = acc[ai][bj][m][n]; }
    }
};

template <class Epi, class SchedT>
__device__ __forceinline__ void gemm_phase(LAS unsigned char* lds, const Gemm g, const SchedT& S, const Epi& E) {
    int tid_ = threadIdx.x; asm volatile("" : "+v"(tid_));
    const int tid = tid_, wid = __builtin_amdgcn_readfirstlane(tid >> 6), lane = tid & 63, wr = wid >> 2, wc = wid & 3, fr = lane & 15, fq = lane >> 4;
    int K_ = g.K; asm volatile("" : "+s"(K_));
    const int K = K_, nt = K / BK;
    unsigned voffA[2], voffB[2];
#pragma unroll
    for (int i = 0; i < 2; ++i) { int R, C; stage_rc(tid * 16 + i * 8192, R, C); const int Rb = Epi::PERM ? ((R & ~31) + perm32(R & 31)) : R;
        voffA[i] = (unsigned)(R * g.lda + C) * 2u; voffB[i] = (unsigned)(Rb * g.ldb + C) * 2u; }
    const size_t kstep = (size_t)(BK * 2);
    const size_t hstepA = (size_t)HALF * g.lda * 2, hstepB = (size_t)HALF * g.ldb * 2;
    const size_t tstepA = 2 * hstepA, tstepB = 2 * hstepB;
    const unsigned ldsw = (unsigned)wid * 1024u;
    const int aoff = lds_byte(wr * 64 + fr, fq * 8), boff = lds_byte(wc * 32 + fr, fq * 8);
#define PG8_SA(b, h) (((b) * 2 + (h)) * HTB)
#define PG8_SB(b, h) ((4 + (b) * 2 + (h)) * HTB)
#define PG8_STAGE(bufoff, gbase, voff) do { _Pragma("unroll") for (int _i = 0; _i < 2; ++_i) \
        __builtin_amdgcn_global_load_lds((const unsigned*)((const char*)(gbase) + (voff)[_i]), (LAS unsigned*)(lds + (bufoff) + ldsw + _i * 8192), 16, 0, 0); } while (0)
#define PG8_LDA(dst, b, h) do { _Pragma("unroll") for (int m = 0; m < 4; ++m) _Pragma("unroll") for (int k = 0; k < 2; ++k) dst[m][k] = *(const LAS bf16x8*)(lds + PG8_SA(b, h) + aoff + m * 2048 + k * 1024); } while (0)
#define PG8_LDB(dst, b, h) do { _Pragma("unroll") for (int n = 0; n < 2; ++n) _Pragma("unroll") for (int k = 0; k < 2; ++k) dst[n][k] = *(const LAS bf16x8*)(lds + PG8_SB(b, h) + boff + n * 2048 + k * 1024); } while (0)
#define PG8_MMA(ai, bj, At, Bt) do { __builtin_amdgcn_s_setprio(1); _Pragma("unroll") for (int m = 0; m < 4; ++m) _Pragma("unroll") for (int n = 0; n < 2; ++n) _Pragma("unroll") for (int k = 0; k < 2; ++k) \
        acc[ai][bj][m][n] = __builtin_amdgcn_mfma_f32_16x16x32_bf16(Bt[n][k], At[m][k], acc[ai][bj][m][n], 0, 0, 0); __builtin_amdgcn_s_setprio(0); } while (0)
#define PG8_WAIT_V(n) asm volatile("s_waitcnt vmcnt(" #n ")" ::: "memory")
#define PG8_WAIT_L(n) asm volatile("s_waitcnt lgkmcnt(" #n ")" ::: "memory")
#define PG8_BAR __builtin_amdgcn_s_barrier()
#define PG8_SCHED __builtin_amdgcn_sched_barrier(0)
    Unit cur, nxt; int ui = 0;
    if (!S.next(0, cur)) return;
    f32x4 acc[2][2][4][2];
#pragma unroll
    for (int a = 0; a < 2; ++a)
#pragma unroll
        for (int b = 0; b < 2; ++b)
#pragma unroll
            for (int m = 0; m < 4; ++m)
#pragma unroll
                for (int n = 0; n < 2; ++n) acc[a][b][m][n] = (f32x4){0.f, 0.f, 0.f, 0.f};
    bf16x8 At[4][2], B0[2][2], B1[2][2];
    const char* cA = (const char*)g.A + (size_t)cur.pm * tstepA + S.aoff(cur); const char* cB = (const char*)g.Bt + (size_t)cur.pn * tstepB + S.boff(cur);
    PG8_STAGE(PG8_SB(0, 0), cB, voffB); PG8_STAGE(PG8_SB(0, 1), cB + hstepB, voffB); PG8_STAGE(PG8_SA(0, 0), cA, voffA); PG8_STAGE(PG8_SA(0, 1), cA + hstepA, voffA);
    if (wr == 1) PG8_BAR;
    PG8_WAIT_V(2); PG8_BAR;
    PG8_STAGE(PG8_SB(1, 0), cB + kstep, voffB); PG8_STAGE(PG8_SA(1, 0), cA + kstep, voffA); PG8_STAGE(PG8_SB(1, 1), cB + hstepB + kstep, voffB);
    PG8_WAIT_V(6); PG8_BAR;
    for (;;) {
        const bool has_next = S.next(ui + 1, nxt);
        const char* nA = has_next ? (const char*)g.A + (size_t)nxt.pm * tstepA + S.aoff(nxt) : cA; const char* nB = has_next ? (const char*)g.Bt + (size_t)nxt.pn * tstepB + S.boff(nxt) : cB;
        for (int t = 0; t < nt; t += 2) {
            const bool last = (t == nt - 2);
            const char* a1 = cA + (size_t)(t + 1) * kstep;
            const char* a2 = last ? nA : cA + (size_t)(t + 2) * kstep; const char* b2 = last ? nB : cB + (size_t)(t + 2) * kstep;
            const char* a3 = a2 + kstep; const char* b3 = b2 + kstep;
            PG8_LDB(B0, 0, 0); PG8_LDB(B1, 0, 1); PG8_SCHED; PG8_LDA(At, 0, 0); PG8_STAGE(PG8_SA(1, 1), a1 + hstepA, voffA);
            PG8_WAIT_V(8); PG8_WAIT_L(0); PG8_BAR; PG8_MMA(0, 0, At, B0); PG8_MMA(0, 1, At, B1); PG8_BAR; PG8_SCHED;
            PG8_LDA(At, 0, 1); PG8_STAGE(PG8_SB(0, 0), b2, voffB); PG8_STAGE(PG8_SB(0, 1), b2 + hstepB, voffB); PG8_STAGE(PG8_SA(0, 0), a2, voffA);
            PG8_WAIT_V(8); PG8_WAIT_L(0); PG8_BAR; PG8_MMA(1, 0, At, B0); PG8_MMA(1, 1, At, B1); PG8_BAR; PG8_SCHED;
            PG8_LDB(B0, 1, 0); PG8_LDB(B1, 1, 1); PG8_SCHED; PG8_LDA(At, 1, 0); PG8_STAGE(PG8_SA(0, 1), a2 + hstepA, voffA);
            PG8_WAIT_V(8); PG8_WAIT_L(0); PG8_BAR; PG8_MMA(0, 0, At, B0); PG8_MMA(0, 1, At, B1); PG8_BAR; PG8_SCHED;
            PG8_LDA(At, 1, 1); PG8_STAGE(PG8_SB(1, 0), b3, voffB); PG8_STAGE(PG8_SB(1, 1), b3 + hstepB, voffB); PG8_STAGE(PG8_SA(1, 0), a3, voffA);
            PG8_WAIT_V(8); PG8_WAIT_L(0); PG8_BAR; PG8_MMA(1, 0, At, B0); PG8_MMA(1, 1, At, B1); PG8_BAR; PG8_SCHED;
        }
        if (wr == 0) PG8_BAR;
        E(acc, cur, wr, wc, fr, fq);
        if (!has_next) break;
#pragma unroll
        for (int a = 0; a < 2; ++a)
#pragma unroll
            for (int b = 0; b < 2; ++b)
#pragma unroll
                for (int m = 0; m < 4; ++m)
#pragma unroll
                    for (int n = 0; n < 2; ++n) acc[a][b][m][n] = (f32x4){0.f, 0.f, 0.f, 0.f};
        cur = nxt; cA = nA; cB = nB; ++ui;
        if (wr == 1) PG8_BAR;
    }
    PG8_WAIT_V(0);
    PG8_BAR;
#undef PG8_SA
#undef PG8_SB
#undef PG8_STAGE
#undef PG8_LDA
#undef PG8_LDB
#undef PG8_MMA
#undef PG8_WAIT_V
#undef PG8_WAIT_L
#undef PG8_BAR
#undef PG8_SCHED
}
}

#define XB_TMO      128
#define XB_XCNT(j)  (256  + 64 * (j))
#define XB_XSUB(j)  (1280 + 64 * (j))
#define XB_XGEN(j)  (2304 + 64 * (j))
#define XB_TOP      3328
#define XB_TOPGEN   3392
#define XCD_BAR_WORDS 3456
#define XB_SPIN_CAP (1u << 18)
__device__ __forceinline__ unsigned xb_ld(unsigned* p)              { return __hip_atomic_load(p, __ATOMIC_RELAXED, __HIP_MEMORY_SCOPE_AGENT); }
__device__ __forceinline__ unsigned xb_add(unsigned* p, unsigned v) { return __hip_atomic_fetch_add(p, v, __ATOMIC_RELAXED, __HIP_MEMORY_SCOPE_AGENT); }
__device__ __forceinline__ unsigned xb_xcc_id() { return (unsigned)__builtin_amdgcn_s_getreg((3 << 11) | 20) & 0xFu; }
#define XB_SPIN(cond, bar) do { unsigned _sp = 0; while (cond) { __builtin_amdgcn_s_sleep(1); \
    if ((++_sp & 255u) == 0u) { if (xb_ld(&(bar)[XB_TMO])) break; if (_sp > XB_SPIN_CAP) { atomicAdd(&(bar)[XB_TMO], 1u); break; } } } } while (0)
struct XcdBarrier { unsigned* bar; unsigned x; volatile LAS unsigned* st; };
__device__ __forceinline__ XcdBarrier xcd_barrier_post(unsigned* bar, volatile LAS unsigned* st) {
    XcdBarrier b; b.bar = bar; b.x = xb_xcc_id(); b.st = st;
    if (threadIdx.x == 0) (void)xb_add(&bar[XB_XCNT(b.x)], 1u);
    return b;
}
__device__ __forceinline__ void xcd_barrier_complete(unsigned* bar, unsigned x, unsigned& nloc, unsigned& nx) {
    const unsigned G = gridDim.x * gridDim.y * gridDim.z;
    unsigned sum, cnt, mine, sp = 0u;
    for (;;) {
        sum = 0u; cnt = 0u; mine = 0u;
#pragma unroll
        for (unsigned j = 0; j < 16; ++j) { const unsigned c = xb_ld(&bar[XB_XCNT(j)]); sum += c; cnt += (c > 0u) ? 1u : 0u; mine = (j == x) ? c : mine; }
        if (sum == G) break;
        __builtin_amdgcn_s_sleep(1);
        if ((++sp & 255u) == 0u) { if (xb_ld(&bar[XB_TMO])) break; if (sp > XB_SPIN_CAP) { atomicAdd(&bar[XB_TMO], 1u); break; } }
    }
    nloc = mine > 0u ? mine : 1u; nx = cnt > 0u ? cnt : 1u;
}
__device__ __forceinline__ void xcd_barrier(const XcdBarrier& b) {
    asm volatile("s_waitcnt vmcnt(0)" ::: "memory");
    __syncthreads();
    if (threadIdx.x == 0) {
        unsigned* bar = b.bar;
        __builtin_amdgcn_s_waitcnt(0);
        unsigned nloc = b.st[0], nx = b.st[1];
        if (nloc == 0u) { xcd_barrier_complete(bar, b.x, nloc, nx); b.st[0] = nloc; b.st[1] = nx; }
        const unsigned old = xb_add(&bar[XB_XSUB(b.x)], 1u);
        const unsigned gen = old / nloc;
        if (old + 1u == (gen + 1u) * nloc) {
            __builtin_amdgcn_fence(__ATOMIC_RELEASE, "agent");
            asm volatile("s_waitcnt vmcnt(0)" ::: "memory");
            const unsigned og = xb_add(&bar[XB_TOP], 1u);
            const unsigned tg = og / nx;
            if (og + 1u == (tg + 1u) * nx) xb_add(&bar[XB_TOPGEN], 1u);
            else XB_SPIN(xb_ld(&bar[XB_TOPGEN]) == tg, bar);
            __builtin_amdgcn_fence(__ATOMIC_ACQUIRE, "agent");
            xb_add(&bar[XB_XGEN(b.x)], 1u);
            asm volatile("s_waitcnt vmcnt(0)" ::: "memory");
        } else {
            XB_SPIN(xb_ld(&bar[XB_XGEN(b.x)]) == gen, bar);
            __builtin_amdgcn_fence(__ATOMIC_ACQUIRE, "agent");
            asm volatile("s_waitcnt vmcnt(0)" ::: "memory");
        }
    }
    __syncthreads();
}

constexpr int LDS_BYTES = 147456;
#ifndef PH
#define PH 0xFFFF
#endif
#ifndef DUP
#define DUP 0
#endif
#define GSYNC() do { xcd_barrier(xb); if (DUP & 0x8000) { xcd_barrier(xb); xcd_barrier(xb); } } while (0)
#define REP(bit) for (int rep_ = 0; rep_ < ((DUP & (bit)) ? 2 : 1); ++rep_)
struct Ctx { LAS unsigned char* lds; int tid, lane, wave, G, bid; };
__device__ __forceinline__ Ctx fresh_ctx(LAS unsigned char* lds) { Ctx C; int t = threadIdx.x; asm volatile("" : "+v"(t)); C.lds = lds; C.tid = t; C.lane = t & 63; C.wave = __builtin_amdgcn_readfirstlane(t >> 6); C.G = gridDim.x; C.bid = blockIdx.x; return C; }

__device__ __forceinline__ void phase_mod(const Params& P, const Ctx& C) {
    LAS float* sc = (LAS float*)C.lds; LAS float* red = sc + 5120;
    for (int i = C.tid; i < 5120; i += 512) { const int r = i >> 10, k = i & 1023; const float x = r == 0 ? P.in[I_CCTX][k] : P.in[I_C][(r - 1) * 1024 + k]; sc[i] = siluf_(x); }
    __syncthreads();
    float* MOD = (float*)(P.ws + WS_MOD);
    const int kg = C.tid >> 5, c = C.tid & 31;
    for (int tile = C.bid; tile < 768; tile += C.G) {
        const int l = tile / 192, col = (tile % 192) * 32 + c;
        const float* w = P.in[I_WMOD] + (size_t)l * 1024 * 6144 + col;
        float a0 = 0.f, a1 = 0.f, a2 = 0.f, a3 = 0.f, a4 = 0.f;
#pragma unroll 32
        for (int k = kg * 64; k < kg * 64 + 64; ++k) { const float wv = w[(size_t)k * 6144]; a0 += sc[k] * wv; a1 += sc[1024 + k] * wv; a2 += sc[2048 + k] * wv; a3 += sc[3072 + k] * wv; a4 += sc[4096 + k] * wv; }
        red[(kg * 5 + 0) * 32 + c] = a0; red[(kg * 5 + 1) * 32 + c] = a1; red[(kg * 5 + 2) * 32 + c] = a2; red[(kg * 5 + 3) * 32 + c] = a3; red[(kg * 5 + 4) * 32 + c] = a4;
        __syncthreads();
        if (C.tid < 160) { const int r = C.tid >> 5; float s = 0.f;
#pragma unroll
            for (int q = 0; q < 16; ++q) s += red[(q * 5 + r) * 32 + c];
            MOD[(size_t)(l * 5 + r) * 6144 + col] = s + P.in[I_BMOD][l * 6144 + col]; }
        __syncthreads();
    }
}

__device__ __forceinline__ void transpose_item(const float* W, int K, int N, bf16_t* WT, LAS float* scr, int item, int nblk, int lane) {
    const int kb = item / nblk, nb = item % nblk, k0 = 64 * kb, n0 = 32 * nb;
    const bool nok = (n0 + (lane & 31)) < N;
#pragma unroll
    for (int i = 0; i < 32; ++i) { const int kk = 2 * i + (lane >> 5); scr[kk * 33 + (lane & 31)] = nok ? W[(size_t)(k0 + kk) * N + n0 + (lane & 31)] : 0.f; }
    asm volatile("s_waitcnt lgkmcnt(0)" ::: "memory");
    const int c = lane & 7;
#pragma unroll
    for (int j = 0; j < 4; ++j) { const int n = (lane >> 3) + 8 * j; const LAS float* s = scr + (8 * c) * 33 + n;
        u32x4 o; o.x = pk2(s[0 * 33], s[1 * 33]); o.y = pk2(s[2 * 33], s[3 * 33]); o.z = pk2(s[4 * 33], s[5 * 33]); o.w = pk2(s[6 * 33], s[7 * 33]);
        *(u32x4*)(WT + (size_t)(n0 + n) * K + k0 + 8 * c) = o; }
    asm volatile("s_waitcnt lgkmcnt(0)" ::: "memory");
}
__device__ __forceinline__ void phase_convert(const Params& P, const Ctx& C, int l) {
    LAS float* scr = (LAS float*)(C.lds + 32768 + C.wave * 8704);
    const int gw = C.bid * 8 + C.wave, NGW = C.G * 8; const int j = l >> 1; const bool ev = (l & 1) == 0;
    const float* win = ev ? P.in[I_WINAB] + (size_t)j * 1024 * N_AB : P.in[I_WINCD] + (size_t)j * 1024 * N_CD;
    const float* wout = (ev ? P.in[I_WOUTAB] : P.in[I_WOUTCD]) + (size_t)j * 2048 * 1024;
    const float* wup = P.in[I_WUP] + (size_t)l * 1024 * 4096; const float* wdn = P.in[I_WDN] + (size_t)l * 4096 * 1024;
    const int N_in = ev ? N_AB : N_CD, Np = ev ? N_AB_P : N_CD_P;
    const int I0 = 16 * (Np / 32), I1 = 32 * 32, I2 = 16 * 128, I3 = 64 * 32;
    const int NI = I0 + I1 + I2 + I3; const int lane = C.lane;
    struct Desc { const float* W; bf16_t* WT; int K, N, k0, n0; };
    auto desc = [&](int it) { Desc d; int r = it, nblk;
        if (r < I0) { d.W = win; d.K = 1024; d.N = N_in; d.WT = (bf16_t*)(P.ws + WS_WIN); nblk = Np / 32; }
        else if ((r -= I0) < I1) { d.W = wout; d.K = 2048; d.N = 1024; d.WT = (bf16_t*)(P.ws + WS_WOUT); nblk = 32; }
        else if ((r -= I1) < I2) { d.W = wup; d.K = 1024; d.N = 4096; d.WT = (bf16_t*)(P.ws + WS_WUP); nblk = 128; }
        else { r -= I2; d.W = wdn; d.K = 4096; d.N = 1024; d.WT = (bf16_t*)(P.ws + WS_WDN); nblk = 32; }
        d.k0 = 64 * (r / nblk); d.n0 = 32 * (r % nblk); return d; };
    float v[32];
#define CV_LOAD(d) do { const bool nok_ = ((d).n0 + (lane & 31)) < (d).N; _Pragma("unroll") for (int i = 0; i < 32; ++i) { const int kk = 2 * i + (lane >> 5); \
        v[i] = nok_ ? (d).W[(size_t)((d).k0 + kk) * (d).N + (d).n0 + (lane & 31)] : 0.f; } } while (0)
    int it = gw; Desc d = desc(it < NI ? it : 0);
    if (it < NI) CV_LOAD(d);
    while (it < NI) {
#pragma unroll
        for (int i = 0; i < 32; ++i) { const int kk = 2 * i + (lane >> 5); scr[kk * 33 + (lane & 31)] = v[i]; }
        asm volatile("s_waitcnt lgkmcnt(0)" ::: "memory");
        const int nit = it + NGW; Desc dn = desc(nit < NI ? nit : 0);
        if (nit < NI) CV_LOAD(dn);
        const int c = lane & 7;
#pragma unroll
        for (int jq = 0; jq < 4; ++jq) { const int n = (lane >> 3) + 8 * jq; const LAS float* sp = scr + (8 * c) * 33 + n;
            u32x4 o; o.x = pk2(sp[0 * 33], sp[1 * 33]); o.y = pk2(sp[2 * 33], sp[3 * 33]); o.z = pk2(sp[4 * 33], sp[5 * 33]); o.w = pk2(sp[6 * 33], sp[7 * 33]);
            *(u32x4*)(d.WT + (size_t)(d.n0 + n) * d.K + d.k0 + 8 * c) = o; }
        asm volatile("s_waitcnt lgkmcnt(0)" ::: "memory");
        d = dn; it = nit;
    }
#undef CV_LOAD
    if (ev) {
        bf16_t* WL = (bf16_t*)(P.ws + WS_WLORA);
        for (int idx = C.bid * 512 + C.tid; idx < 5120 * 16; idx += C.G * 512) {
            const int n = idx % 5120, k8 = idx / 5120, g = n >> 10, cc = n & 1023; float o[8];
#pragma unroll
            for (int e = 0; e < 8; ++e) { const int k = k8 * 8 + e; float v = 0.f;
                if (g == 0) { if (k < 64) v = P.in[I_W2][((size_t)(j * 2 + 0) * 64 + k) * 1024 + cc]; }
                else if (g == 1) { if (k >= 64) v = P.in[I_W2][((size_t)(j * 2 + 1) * 64 + (k - 64)) * 1024 + cc]; }
                else if (g == 2) { if (k < 64) v = P.in[I_A2][((size_t)(j * 2 + 0) * 64 + k) * 1024 + cc]; }
                else if (g == 3) { if (k >= 64) v = P.in[I_A2][((size_t)(j * 2 + 1) * 64 + (k - 64)) * 1024 + cc]; }
                else v = P.in[I_G2][((size_t)j * 128 + k) * 1024 + cc];
                o[e] = v; }
            *(u32x4*)(WL + (size_t)n * 128 + k8 * 8) = pack8(o);
        }
    }
}

__device__ __forceinline__ void phase_rows(const Params& P, const Ctx& C, int mode, const float* gpost, const float* gate_mod  ,
                                           bool next, const float* gpre, const float* mod_next  , bool dummy = false) {
    float* X = P.out + O_X; const bf16_t* MP0 = (const bf16_t*)(P.ws + WS_MP); const bf16_t* MP1 = MP0 + (size_t)MTOK * DM; bf16_t* H = (bf16_t*)(P.ws + WS_H);
    const int gw = C.bid * 8 + C.wave, NGW = C.G * 8;
    for (int m = gw; m < MTOK; m += NGW) {
        const int mr = m < 4096 ? 0 : 1 + ((m - 4096) >> 10);
        f32x4 x[4];
        f32x4 gq[4], sh[4], sl[4];
        if (next) { const f32x4* gp_ = (const f32x4*)gpre + C.lane; const f32x4* sh_ = (const f32x4*)(mod_next + (size_t)mr * 6144) + C.lane; const f32x4* sl_ = (const f32x4*)(mod_next + (size_t)mr * 6144 + 1024) + C.lane;
#pragma unroll
            for (int j = 0; j < 4; ++j) { gq[j] = gp_[64 * j]; sh[j] = sh_[64 * j]; sl[j] = sl_[64 * j]; } }
        if (mode == 0) { const f32x4* src = (const f32x4*)(m < 4096 ? P.in[I_XP] + (size_t)m * DM : P.in[I_XS] + (size_t)(m - 4096) * DM) + C.lane;
#pragma unroll
            for (int j = 0; j < 4; ++j) x[j] = src[64 * j];
        } else {
            const f32x4* xs = (const f32x4*)(X + (size_t)m * DM) + C.lane; const u32x2* p0 = (const u32x2*)(MP0 + (size_t)m * DM) + C.lane; const u32x2* p1 = (const u32x2*)(MP1 + (size_t)m * DM) + C.lane;
            const f32x4* gp = (const f32x4*)gpost + C.lane; const f32x4* gt = (const f32x4*)(gate_mod + (size_t)mr * 6144) + C.lane;
            f32x4 gpv[4], gtv[4];
#pragma unroll
            for (int j = 0; j < 4; ++j) { gpv[j] = gp[64 * j]; gtv[j] = gt[64 * j]; }
            f32x4 f[4]; float ss = 0.f;
#pragma unroll
            for (int j = 0; j < 4; ++j) { x[j] = xs[64 * j]; f[j] = unpack4(p0[64 * j]) + unpack4(p1[64 * j]); ss += (f[j].x * f[j].x + f[j].y * f[j].y) + (f[j].z * f[j].z + f[j].w * f[j].w); }
            const float rs = rsqrtf(wave_sum(ss) * (1.f / DM) + 1e-6f);
#pragma unroll
            for (int j = 0; j < 4; ++j) x[j] = x[j] + gtv[j] * (f[j] * rs * gpv[j]);
        }
        f32x4* xo = (f32x4*)((dummy ? (float*)(P.ws + WS_PREP) : X) + (size_t)m * DM) + C.lane;
#pragma unroll
        for (int j = 0; j < 4; ++j) xo[64 * j] = x[j];
        if (next) {
            float ss = 0.f;
#pragma unroll
            for (int j = 0; j < 4; ++j) ss += (x[j].x * x[j].x + x[j].y * x[j].y) + (x[j].z * x[j].z + x[j].w * x[j].w);
            const float rs = rsqrtf(wave_sum(ss) * (1.f / DM) + 1e-6f);
            u32x2* ho = (u32x2*)((dummy ? (bf16_t*)(P.ws + WS_PREP + 40 * MiB) : H) + (size_t)m * DM) + C.lane;
#pragma unroll
            for (int j = 0; j < 4; ++j) { const f32x4 h = (x[j] * rs * gq[j]) * (sl[j] + 1.f) + sh[j]; u32x2 w; w.x = pk2(h.x, h.y); w.y = pk2(h.z, h.w); ho[64 * j] = w; }
        }
    }
}

__device__ __forceinline__ void conv8(const bf16_t* src, int ld, int col0, int base, int t, bool samp, const float* w, const float* b, int NC, int ch, float* acc) {
    { const f32x4 b0 = *(const f32x4*)(b + ch), b1 = *(const f32x4*)(b + ch + 4); acc[0] = b0.x; acc[1] = b0.y; acc[2] = b0.z; acc[3] = b0.w; acc[4] = b1.x; acc[5] = b1.y; acc[6] = b1.z; acc[7] = b1.w; }
    if (!samp) {
#pragma unroll
        for (int d = 0; d < 3; ++d) { const int tt = t + d - 1; if (tt < 0 || tt >= 256) continue;
            float xv[8]; unpack8(*(const u32x4*)(src + (size_t)(base + tt) * ld + col0 + ch), xv);
            const f32x4 w0 = *(const f32x4*)(w + (3 + d) * NC + ch), w1 = *(const f32x4*)(w + (3 + d) * NC + ch + 4);
            acc[0] += w0.x * xv[0]; acc[1] += w0.y * xv[1]; acc[2] += w0.z * xv[2]; acc[3] += w0.w * xv[3]; acc[4] += w1.x * xv[4]; acc[5] += w1.y * xv[5]; acc[6] += w1.z * xv[6]; acc[7] += w1.w * xv[7]; }
    } else {
        const int r = t >> 6, c = t & 63;
#pragma unroll
        for (int i = 0; i < 3; ++i)
#pragma unroll
            for (int d = 0; d < 3; ++d) { const int rr = r + i - 1, cc = c + d - 1; if (rr < 0 || rr >= 16 || cc < 0 || cc >= 64) continue;
                float xv[8]; unpack8(*(const u32x4*)(src + (size_t)(base + rr * 64 + cc) * ld + col0 + ch), xv);
                const f32x4 w0 = *(const f32x4*)(w + (i * 3 + d) * NC + ch), w1 = *(const f32x4*)(w + (i * 3 + d) * NC + ch + 4);
                acc[0] += w0.x * xv[0]; acc[1] += w0.y * xv[1]; acc[2] += w0.z * xv[2]; acc[3] += w0.w * xv[3]; acc[4] += w1.x * xv[4]; acc[5] += w1.y * xv[5]; acc[6] += w1.z * xv[6]; acc[7] += w1.w * xv[7]; }
    }
}

__device__ __forceinline__ void phase_prep_even(const Params& P, const Ctx& C, int j) {
    const bf16_t* PROJ = (const bf16_t*)(P.ws + WS_PROJ); bf16_t* PREP = (bf16_t*)(P.ws + WS_PREP); bf16_t* LA = (bf16_t*)(P.ws + WS_LORAA);
    float* DT = (float*)(P.ws + WS_DT); float* DA = (float*)(P.ws + WS_DA);
    const float* cw = P.in[I_SCONVW] + (size_t)j * 9 * 2048; const float* cb = P.in[I_SCONVB] + j * 2048;
    const float* mu = P.in[I_MU] + j * 3456; const float* kkw = P.in[I_KK] + j * 1024;
    const int gw = C.bid * 8 + C.wave, NGW = C.G * 8, lane = C.lane;
    for (int m = gw; m < MTOK; m += NGW) {
        const bool samp = m >= 4096; const int T = samp ? 1024 : 256; const int t = samp ? ((m - 4096) & 1023) : (m & 255); const int base = m - t;
        const bf16_t* prow = PROJ + (size_t)m * PROJ_LD_AB; bf16_t* orow = PREP + (size_t)m * PREP_LD;
        const bool hp = t > 0, hn = t < T - 1;
        u32x4 rx[7], rxp[7], rxn[7], rz[2];
#pragma unroll
        for (int it = 0; it < 7; ++it) { const int c = it * 512 + lane * 8; const bool ok = c < 3456; const u32x4 z4 = (u32x4){0u, 0u, 0u, 0u};
            rx[it] = ok ? *(const u32x4*)(prow + IN_SSD + c) : z4; rxp[it] = (ok && hp) ? *(const u32x4*)(prow - PROJ_LD_AB + IN_SSD + c) : z4; rxn[it] = (ok && hn) ? *(const u32x4*)(prow + PROJ_LD_AB + IN_SSD + c) : z4; }
#pragma unroll
        for (int it = 0; it < 2; ++it) rz[it] = *(const u32x4*)(prow + it * 512 + lane * 8);
#pragma unroll 1
        for (int it = 0; it < 4; it += 2) { const int ch = it * 512 + lane * 8; float acc[8], acc2[8];
            conv8(PROJ, PROJ_LD_AB, 1024, base, t, samp, cw, cb, 2048, ch, acc); conv8(PROJ, PROJ_LD_AB, 1024, base, t, samp, cw, cb, 2048, ch + 512, acc2);
#pragma unroll
            for (int e = 0; e < 8; ++e) { acc[e] = siluf_(acc[e]); acc2[e] = siluf_(acc2[e]); }
            *(u32x4*)(orow + ch) = pack8(acc); *(u32x4*)(orow + ch + 512) = pack8(acc2); }
#pragma unroll
        for (int it = 0; it < 2; ++it) { const int ch = it * 512 + lane * 8; float z[8]; unpack8(rz[it], z);
#pragma unroll
            for (int e = 0; e < 8; ++e) z[e] = siluf_(z[e]);
            *(u32x4*)(orow + 2048 + ch) = pack8(z); }
        if (lane < 32) { const float raw = bf2f(prow[3072 + lane]); const float dt = softplusf_(raw + P.in[I_DTB][j * 32 + lane]);
            DT[(size_t)m * 32 + lane] = dt; DA[(size_t)m * 32 + lane] = -dt * __expf(P.in[I_ALOG][j * 32 + lane]); }
#pragma unroll
        for (int it = 0; it < 7; ++it) { const int c = it * 512 + lane * 8; if (c >= 3456) break;
            float x[8], xp[8], xn[8];
            unpack8(rx[it], x); unpack8(rxp[it], xp); unpack8(rxn[it], xn);
            const f32x4 m0 = *(const f32x4*)(mu + c), m1 = *(const f32x4*)(mu + c + 4);
            const float mv[8] = {m0.x, m0.y, m0.z, m0.w, m1.x, m1.y, m1.z, m1.w};
#pragma unroll
            for (int e = 0; e < 8; ++e) x[e] = x[e] + mv[e] * (0.5f * (xp[e] + xn[e]) - x[e]);
            if (it < 2) { *(u32x4*)(orow + 3072 + c) = pack8(x); }
            else if (it < 4) { *(u32x4*)(orow + 4096 + (c - 1024)) = pack8(x);
                const f32x4 k0 = *(const f32x4*)(kkw + c - 1024), k1 = *(const f32x4*)(kkw + c - 1024 + 4);
                const float kv[8] = {k0.x, k0.y, k0.z, k0.w, k1.x, k1.y, k1.z, k1.w}; float ss = 0.f;
#pragma unroll
                for (int e = 0; e < 8; ++e) { x[e] *= kv[e]; ss += x[e] * x[e]; }
                ss += __shfl_xor(ss, 1); ss += __shfl_xor(ss, 2); ss += __shfl_xor(ss, 4);
                const float rn = rsqrtf(ss + 1e-12f);
#pragma unroll
                for (int e = 0; e < 8; ++e) x[e] *= rn;
                *(u32x4*)(orow + 6144 + (c - 1024)) = pack8(x); }
            else if (it < 6) { *(u32x4*)(orow + 5120 + (c - 2048)) = pack8(x); }
            else { const int cc = c - 3072;
#pragma unroll
                for (int e = 0; e < 8; ++e) x[e] = cc < 128 ? tanhf_(x[e]) : (cc < 256 ? x[e] : sigmoidf_(x[e]));
                *(u32x4*)(LA + (size_t)m * LORA_K + cc) = pack8(x); }
        }
    }
}
__device__ __forceinline__ void phase_prep_odd(const Params& P, const Ctx& C, int j) {
    const bf16_t* PROJ = (const bf16_t*)(P.ws + WS_PROJ); bf16_t* PREP = (bf16_t*)(P.ws + WS_PREP);
    const float* cw = P.in[I_MCONVW] + (size_t)j * 9 * 1024; const float* cb = P.in[I_MCONVB] + j * 1024;
    const int gw = C.bid * 8 + C.wave, NGW = C.G * 8, lane = C.lane;
    for (int m = gw; m < MTOK; m += NGW) {
        const bool samp = m >= 4096; const int t = samp ? ((m - 4096) & 1023) : (m & 255); const int base = m - t;
        { const int ch = lane * 8; float acc[8], acc2[8];
            conv8(PROJ, PROJ_LD_CD, IN_GLA, base, t, samp, cw, cb, 1024, ch, acc); conv8(PROJ, PROJ_LD_CD, IN_GLA, base, t, samp, cw, cb, 1024, ch + 512, acc2);
#pragma unroll
            for (int e = 0; e < 8; ++e) { acc[e] = siluf_(acc[e]); acc2[e] = siluf_(acc2[e]); }
            *(u32x4*)(PREP + (size_t)m * PREP_LD + ch) = pack8(acc); *(u32x4*)(PREP + (size_t)m * PREP_LD + ch + 512) = pack8(acc2); }
    }
}

constexpr int CS_QLD = 136, CS_SLD = 72;
constexpr int CS_QS = 0, CS_KS = 17408, CS_KT = 34816, CS_VT = 53248;
__device__ __forceinline__ bf16x8 lds_frag(const LAS bf16_t* p) { return *(const LAS bf16x8*)p; }
template <int MODE>
__device__ __forceinline__ void chunk_scan(const Params& P, const Ctx& C, int j, int s, int dir, int h, int vs) {
    const int tid = C.tid, lane = C.lane, w = C.wave, fr = lane & 15, fq = lane >> 4;
    const int T = s < 16 ? 256 : 1024, base = s < 16 ? s * 256 : 4096 + (s - 16) * 1024, nch = T >> 6;
    const bf16_t* PROJ = (const bf16_t*)(P.ws + WS_PROJ); const bf16_t* PREP = (const bf16_t*)(P.ws + WS_PREP);
    bf16_t* Y = (bf16_t*)(P.ws + WS_MP) + (size_t)dir * MTOK * YLD;
    LAS bf16_t* Qs = (LAS bf16_t*)(C.lds + CS_QS); LAS bf16_t* Ks = (LAS bf16_t*)(C.lds + CS_KS); LAS bf16_t* Kt = (LAS bf16_t*)(C.lds + CS_KT); LAS bf16_t* Vt = (LAS bf16_t*)(C.lds + CS_VT);
    constexpr int NV = MODE == 0 ? 64 : 128, NVC = NV / 16, VROWS = NV + (MODE == 2 ? 16 : 0);
    constexpr int CS_ST = CS_VT + VROWS * CS_SLD * 2, CS_LA = CS_ST + VROWS * CS_QLD * 2, CS_PS = CS_LA  , CS_TOT = CS_LA + (MODE == 1 ? 32768 : 9216),
                  CS_BV = CS_TOT + 2560, CS_IG = CS_BV + 256, CS_FV = CS_IG + 256, CS_DTV = CS_FV + 256, CS_MS = CS_DTV + 256;
    static_assert(CS_MS + 64 <= LDS_BYTES - 16, "chunk-scan LDS map");
    LAS bf16_t* Ps = (LAS bf16_t*)(C.lds + CS_PS); LAS bf16_t* St = (LAS bf16_t*)(C.lds + CS_ST);
    LAS float* LA = (LAS float*)(C.lds + CS_LA); LAS float* TOT = (LAS float*)(C.lds + CS_TOT); LAS float* BV = (LAS float*)(C.lds + CS_BV); LAS float* IG = (LAS float*)(C.lds + CS_IG);
    LAS float* MS = (LAS float*)(C.lds + CS_MS); LAS float* FV = (LAS float*)(C.lds + CS_FV); LAS float* DTV = (LAS float*)(C.lds + CS_DTV);
    constexpr int NVT = NVC + (MODE == 2 ? 1 : 0);
    const int si = tid >> 3, kq = tid & 7;
    __syncthreads();
    bf16x8 gwa_hi = {0, 0, 0, 0, 0, 0, 0, 0}, gwa_lo = {0, 0, 0, 0, 0, 0, 0, 0}; f32x4 gb4 = {0.f, 0.f, 0.f, 0.f};
    if (MODE == 1) {
        const float* gwp = P.in[I_GGW] + (size_t)(j * 2 + dir) * 16 * 512 + h * 128 + 16 * w + fr;
        if (fq < 2) {
#pragma unroll
            for (int e = 0; e < 8; ++e) { const float g = gwp[(8 * fq + e) * 512]; const unsigned hb = f2bf(g); const float rem = g - bf2f(hb); gwa_hi[e] = (short)hb; gwa_lo[e] = (short)f2bf(rem); } }
        gb4 = *(const f32x4*)(P.in[I_GGB] + (j * 2 + dir) * 512 + h * 128 + 16 * w + 4 * fq);
    }
    f32x4 Sacc[NVT];
    {
        const float* s0 = nullptr; int kstride = 64; float em0 = 1.f;
        if (s >= 16) { const int b = s - 16;
            if (MODE == 0) { s0 = P.in[I_SSSD] + ((size_t)((b * 2 + j) * 2 + dir) * 16 + h) * 8192; kstride = 64; }
            if (MODE == 1) { s0 = P.in[I_SGLA] + ((size_t)((b * 2 + j) * 2 + dir) * 4 + h) * 32768 + vs * NV; kstride = 256; }
            if (MODE == 2) { s0 = P.in[I_SMC] + ((size_t)((b * 2 + j) * 2 + dir) * 4 + h) * 32768 + vs * NV; kstride = 256; em0 = __expf(P.in[I_SMM][((b * 2 + j) * 2 + dir) * 4 + h]); } }
#pragma unroll
        for (int vt = 0; vt < NVC; ++vt)
#pragma unroll
            for (int e = 0; e < 4; ++e) Sacc[vt][e] = s0 ? s0[(size_t)(16 * w + 4 * fq + e) * kstride + 16 * vt + fr] * em0 : 0.f;
        if (MODE == 2) {
            const float* n0 = s >= 16 ? P.in[I_SMN] + ((size_t)(((s - 16) * 2 + j) * 2 + dir) * 4 + h) * 128 : nullptr;
#pragma unroll
            for (int e = 0; e < 4; ++e) Sacc[NVT - 1][e] = (n0 && fr == 0) ? n0[16 * w + 4 * fq + e] * em0 : 0.f;
            if (tid == 0) MS[0] = s >= 16 ? P.in[I_SMM][(((s - 16) * 2 + j) * 2 + dir) * 4 + h] : 0.f;
            for (int i = tid; i < 16 * CS_SLD; i += 512) Vt[NV * CS_SLD + i] = (bf16_t)((i < CS_SLD) ? 0x3F80 : 0);
        }
#pragma unroll
        for (int vt = 0; vt < NVT; ++vt) { u32x2 wv; wv.x = pk2(Sacc[vt][0], Sacc[vt][1]); wv.y = pk2(Sacc[vt][2], Sacc[vt][3]); *(LAS u32x2*)(St + (16 * vt + fr) * CS_QLD + 16 * w + 4 * fq) = wv; }
    }
    u32x4 rq0, rq1, rk0, rk1, rgd[4]; float rla = 0.f, rig = 0.f, rdt = 0.f;
    constexpr int NVTOK = MODE == 0 ? 8 : 16;
    unsigned short rkt[16], rvt[NVTOK];
    const int kx = tid & 127, tgk = tid >> 7, vx = tid & (NV - 1), tgv = MODE == 0 ? (tid >> 6) : (tid >> 7);
    auto tok = [&](int c, int i) { const int st0 = c * 64 + i; return base + (dir ? (T - 1 - st0) : st0); };
    auto load_raw = [&](int c) {
        const int m = tok(c, si); const int m1 = tok(c, tid & 63);
        const bf16_t* krow; const bf16_t* vrow; int kld, vld;
        if (MODE == 0) { const int g = h >> 2; const bf16_t* pr = PREP + (size_t)m * PREP_LD;
            rq0 = *(const u32x4*)(pr + 1536 + g * 128 + 16 * kq); rq1 = *(const u32x4*)(pr + 1536 + g * 128 + 16 * kq + 8);
            rk0 = *(const u32x4*)(pr + 1024 + g * 128 + 16 * kq); rk1 = *(const u32x4*)(pr + 1024 + g * 128 + 16 * kq + 8);
            if (tid < 64) { rla = ((const float*)(P.ws + WS_DA))[(size_t)m1 * 32 + dir * 16 + h]; rdt = ((const float*)(P.ws + WS_DT))[(size_t)m1 * 32 + dir * 16 + h]; }
            krow = PREP + 1024 + g * 128 + kx; kld = PREP_LD; vrow = PREP + h * 64 + vx; vld = PREP_LD; }
        if (MODE == 1) { const bf16_t* pr = PROJ + (size_t)m * PROJ_LD_CD;
            rq0 = *(const u32x4*)(pr + h * 128 + 16 * kq); rq1 = *(const u32x4*)(pr + h * 128 + 16 * kq + 8);
            rk0 = *(const u32x4*)(pr + 512 + h * 128 + 16 * kq); rk1 = *(const u32x4*)(pr + 512 + h * 128 + 16 * kq + 8);
#pragma unroll
            for (int t4 = 0; t4 < 4; ++t4) { rgd[t4] = (u32x4){0u, 0u, 0u, 0u}; if (fq < 2) rgd[t4] = *(const u32x4*)(PROJ + (size_t)tok(c, 16 * t4 + fr) * PROJ_LD_CD + 3072 + dir * 16 + 8 * fq); }
            krow = PROJ + 512 + h * 128 + kx; kld = PROJ_LD_CD; vrow = PROJ + 1024 + h * 256 + vs * NV + vx; vld = PROJ_LD_CD; }
        if (MODE == 2) { const bf16_t* pp = PREP + (size_t)m * PREP_LD;
            rq0 = *(const u32x4*)(pp + h * 128 + 16 * kq); rq1 = *(const u32x4*)(pp + h * 128 + 16 * kq + 8);
            rk0 = *(const u32x4*)(pp + 512 + h * 128 + 16 * kq); rk1 = *(const u32x4*)(pp + 512 + h * 128 + 16 * kq + 8);
            if (tid < 64) { const bf16_t* p1 = PROJ + (size_t)m1 * PROJ_LD_CD + IN_GLA + 3072; rig = bf2f(p1[dir * 4 + h]); rla = bf2f(p1[8 + dir * 4 + h]); }
            krow = PREP + 512 + h * 128 + kx; kld = PREP_LD; vrow = PROJ + IN_GLA + 1024 + h * 256 + vs * NV + vx; vld = PROJ_LD_CD; }
        { const bf16_t* kp = krow + (size_t)tok(c, 16 * tgk) * kld; const long ks_ = dir ? -(long)kld : (long)kld;
#pragma unroll
          for (int jj = 0; jj < 16; ++jj) { rkt[jj] = *kp; kp += ks_; }
          const bf16_t* vp = vrow + (size_t)tok(c, NVTOK * tgv) * vld; const long vs_ = dir ? -(long)vld : (long)vld;
#pragma unroll
          for (int jj = 0; jj < NVTOK; ++jj) { rvt[jj] = *vp; vp += vs_; } }
    };
    load_raw(0);
    __syncthreads();
    const int ycol0 = (MODE == 0 ? h * 64 : (MODE == 1 ? h * 256 + vs * NV : 1024 + h * 256 + vs * NV));
    for (int c = 0; c < nch; ++c) {
        if (MODE == 1) {
#pragma unroll
            for (int t4 = 0; t4 < 4; ++t4) { f32x4 acc = (f32x4){0.f, 0.f, 0.f, 0.f}; const bf16x8 gf = __builtin_bit_cast(bf16x8, rgd[t4]);
                acc = __builtin_amdgcn_mfma_f32_16x16x32_bf16(gwa_hi, gf, acc, 0, 0, 0); acc = __builtin_amdgcn_mfma_f32_16x16x32_bf16(gwa_lo, gf, acc, 0, 0, 0);
                f32x4 la;
#pragma unroll
                for (int e = 0; e < 4; ++e) la[e] = logsigmoidf_(acc[e] + gb4[e]) * 0.0625f;
                *(LAS f32x4*)(LA + (16 * t4 + fr) * 128 + 16 * w + 4 * fq) = la; }
        } else if (tid < 64) {
            float ig = 0.f, la = rla;
            if (MODE == 2) { ig = rig + P.in[I_MIB][(j * 2 + dir) * 4 + h]; la = logsigmoidf_(rla + P.in[I_MFB][(j * 2 + dir) * 4 + h]); }
            float x = la;
            x += __int_as_float(__builtin_amdgcn_update_dpp(0, __float_as_int(x), 0x111, 0xF, 0xF, true));
            x += __int_as_float(__builtin_amdgcn_update_dpp(0, __float_as_int(x), 0x112, 0xF, 0xF, true));
            x += __int_as_float(__builtin_amdgcn_update_dpp(0, __float_as_int(x), 0x114, 0xF, 0xF, true));
            x += __int_as_float(__builtin_amdgcn_update_dpp(0, __float_as_int(x), 0x118, 0xF, 0xF, true));
            { const float t0 = __int_as_float(__builtin_amdgcn_readlane(__float_as_int(x), 15)), t1 = __int_as_float(__builtin_amdgcn_readlane(__float_as_int(x), 31)), t2 = __int_as_float(__builtin_amdgcn_readlane(__float_as_int(x), 47));
              const int rw = lane >> 4; x += (rw > 0 ? t0 : 0.f) + (rw > 1 ? t1 : 0.f) + (rw > 2 ? t2 : 0.f); }
            const float bl = __int_as_float(__builtin_amdgcn_readlane(__float_as_int(x), 63));
            const float kgn = MODE == 2 ? 0.08838834764831845f * __expf(ig) : 1.f;
            BV[tid] = x; IG[tid] = kgn; FV[tid] = kgn * __expf(bl - x); DTV[tid] = MODE == 0 ? rdt : 1.f;
            if (MODE == 2) { float ml = bl - x + ig;
                ml = fmaxf(ml, __int_as_float(__builtin_amdgcn_update_dpp(__float_as_int(ml), __float_as_int(ml), 0xB1, 0xF, 0xF, false)));
                ml = fmaxf(ml, __int_as_float(__builtin_amdgcn_update_dpp(__float_as_int(ml), __float_as_int(ml), 0x4E, 0xF, 0xF, false)));
                ml = fmaxf(ml, __int_as_float(__builtin_amdgcn_update_dpp(__float_as_int(ml), __float_as_int(ml), 0x141, 0xF, 0xF, false)));
                ml = fmaxf(ml, __int_as_float(__builtin_amdgcn_update_dpp(__float_as_int(ml), __float_as_int(ml), 0x140, 0xF, 0xF, false)));
                const float m01 = fmaxf(__int_as_float(__builtin_amdgcn_readlane(__float_as_int(ml), 0)), __int_as_float(__builtin_amdgcn_readlane(__float_as_int(ml), 16)));
                const float m23 = fmaxf(__int_as_float(__builtin_amdgcn_readlane(__float_as_int(ml), 32)), __int_as_float(__builtin_amdgcn_readlane(__float_as_int(ml), 48)));
                if (tid == 0) MS[0] = fmaxf(bl + MS[0], fmaxf(m01, m23)); }
        }
        __syncthreads();
        if (MODE == 1) {
            const int k = tid & 127, qd = tid >> 7; float run = 0.f;
#pragma unroll
            for (int jj = 0; jj < 16; ++jj) { run += LA[(16 * qd + jj) * 128 + k]; LA[(16 * qd + jj) * 128 + k] = run; }
            TOT[qd * 128 + k] = run;
            __syncthreads();
            if (tid < 128) TOT[4 * 128 + tid] = __expf(TOT[tid] + TOT[128 + tid] + TOT[256 + tid] + TOT[384 + tid]);
        }
        {
            float q[16], k[16]; unpack8(rq0, q); unpack8(rq1, q + 8); unpack8(rk0, k); unpack8(rk1, k + 8);
            float qs[16], ks[16];
            if (MODE == 1) { const int qd = si >> 4;
#pragma unroll
                for (int e4 = 0; e4 < 4; ++e4) { const int kk = 16 * kq + 4 * e4; const f32x4 bb = *(LAS f32x4*)(LA + si * 128 + kk), t0 = *(LAS f32x4*)(TOT + kk), t1 = *(LAS f32x4*)(TOT + 128 + kk), t2 = *(LAS f32x4*)(TOT + 256 + kk);
#pragma unroll
                    for (int e = 0; e < 4; ++e) { const float b = bb[e] + (qd > 0 ? t0[e] : 0.f) + (qd > 1 ? t1[e] : 0.f) + (qd > 2 ? t2[e] : 0.f);
                        qs[4 * e4 + e] = q[4 * e4 + e] * 0.08838834764831845f * __expf(b); ks[4 * e4 + e] = k[4 * e4 + e] * __expf(fminf(-b, 80.f)); } }
            } else { const float kgn = IG[si];
#pragma unroll
                for (int e = 0; e < 16; ++e) { qs[e] = q[e]; ks[e] = k[e] * kgn; } }
            *(LAS u32x4*)(Qs + si * CS_QLD + 16 * kq) = pack8(qs); *(LAS u32x4*)(Qs + si * CS_QLD + 16 * kq + 8) = pack8(qs + 8);
            *(LAS u32x4*)(Ks + si * CS_QLD + 16 * kq) = pack8(ks); *(LAS u32x4*)(Ks + si * CS_QLD + 16 * kq + 8) = pack8(ks + 8);
        }
        if (MODE == 1)
        {
            float kt[16];
            if (MODE == 1) { float off = 0.f; const float t0 = TOT[kx], t1 = TOT[128 + kx], t2 = TOT[256 + kx], t3 = TOT[384 + kx];
                off = (tgk > 0 ? t0 : 0.f) + (tgk > 1 ? t1 : 0.f) + (tgk > 2 ? t2 : 0.f); const float bl = (t0 + t1) + (t2 + t3);
#pragma unroll
                for (int jj = 0; jj < 16; ++jj) kt[jj] = bf2f(rkt[jj]) * __expf(bl - (LA[(16 * tgk + jj) * 128 + kx] + off));
            } else {
#pragma unroll
                for (int jj = 0; jj < 16; ++jj) kt[jj] = bf2f(rkt[jj]) * FV[16 * tgk + jj]; }
            *(LAS u32x4*)(Kt + kx * CS_SLD + 16 * tgk) = pack8(kt); *(LAS u32x4*)(Kt + kx * CS_SLD + 16 * tgk + 8) = pack8(kt + 8);
            float vt8[NVTOK];
#pragma unroll
            for (int jj = 0; jj < NVTOK; ++jj) vt8[jj] = bf2f(rvt[jj]) * (MODE == 0 ? DTV[NVTOK * tgv + jj] : 1.f);
            *(LAS u32x4*)(Vt + vx * CS_SLD + NVTOK * tgv) = pack8(vt8);
            if (NVTOK == 16) *(LAS u32x4*)(Vt + vx * CS_SLD + NVTOK * tgv + 8) = pack8(vt8 + 8);
        }
        __syncthreads();
        if (MODE != 1)
        {
            float kt[16];
            if (MODE == 1) { float off = 0.f; const float t0 = TOT[kx], t1 = TOT[128 + kx], t2 = TOT[256 + kx], t3 = TOT[384 + kx];
                off = (tgk > 0 ? t0 : 0.f) + (tgk > 1 ? t1 : 0.f) + (tgk > 2 ? t2 : 0.f); const float bl = (t0 + t1) + (t2 + t3);
#pragma unroll
                for (int jj = 0; jj < 16; ++jj) kt[jj] = bf2f(rkt[jj]) * __expf(bl - (LA[(16 * tgk + jj) * 128 + kx] + off));
            } else {
#pragma unroll
                for (int jj = 0; jj < 16; ++jj) kt[jj] = bf2f(rkt[jj]) * FV[16 * tgk + jj]; }
            *(LAS u32x4*)(Kt + kx * CS_SLD + 16 * tgk) = pack8(kt); *(LAS u32x4*)(Kt + kx * CS_SLD + 16 * tgk + 8) = pack8(kt + 8);
            float vt8[NVTOK];
#pragma unroll
            for (int jj = 0; jj < NVTOK; ++jj) vt8[jj] = bf2f(rvt[jj]) * (MODE == 0 ? DTV[NVTOK * tgv + jj] : 1.f);
            *(LAS u32x4*)(Vt + vx * CS_SLD + NVTOK * tgv) = pack8(vt8);
            if (NVTOK == 16) *(LAS u32x4*)(Vt + vx * CS_SLD + NVTOK * tgv + 8) = pack8(vt8 + 8);
        }
        if (c + 1 < nch) load_raw(c + 1);
        const int tt = w >> 1;
#pragma unroll
        for (int sj = 0; sj < 2; ++sj) { const int st = 2 * (w & 1) + sj; u32x2 wv; wv.x = 0u; wv.y = 0u;
            if (st <= tt) { f32x4 acc = (f32x4){0.f, 0.f, 0.f, 0.f};
#pragma unroll
                for (int kk = 0; kk < 4; ++kk) acc = __builtin_amdgcn_mfma_f32_16x16x32_bf16(lds_frag(Ks + (16 * st + fr) * CS_QLD + 32 * kk + 8 * fq), lds_frag(Qs + (16 * tt + fr) * CS_QLD + 32 * kk + 8 * fq), acc, 0, 0, 0);
                const int tg = 16 * tt + fr, sg = 16 * st + 4 * fq;
                if (MODE != 1) { const float bt = BV[tg]; const f32x4 bs = *(LAS f32x4*)(BV + sg);
#pragma unroll
                    for (int e = 0; e < 4; ++e) acc[e] *= __expf(fminf(bt - bs[e], 0.f)); }
#pragma unroll
                for (int e = 0; e < 4; ++e) acc[e] = (sg + e <= tg) ? acc[e] : 0.f;
                wv.x = pk2(acc[0], acc[1]); wv.y = pk2(acc[2], acc[3]); }
            *(LAS u32x2*)(Ps + (16 * tt + fr) * CS_SLD + 16 * st + 4 * fq) = wv; }
        __syncthreads();
        {
            const int tg = 16 * tt + fr; const int stp = c * 64 + tg; const int m = base + (dir ? (T - 1 - stp) : stp);
            const float ebt = MODE == 1 ? 1.f : __expf(BV[tg]);
            bf16x8 pf[2], qf[4];
#pragma unroll
            for (int ks2 = 0; ks2 < 2; ++ks2) pf[ks2] = lds_frag(Ps + tg * CS_SLD + 32 * ks2 + 8 * fq);
#pragma unroll
            for (int kk = 0; kk < 4; ++kk) qf[kk] = lds_frag(Qs + tg * CS_QLD + 32 * kk + 8 * fq);
            float rden = 1.f;
            if (MODE == 2) { f32x4 ai = (f32x4){0.f, 0.f, 0.f, 0.f}, ao = (f32x4){0.f, 0.f, 0.f, 0.f};
#pragma unroll
                for (int ks2 = 0; ks2 < 2; ++ks2) ai = __builtin_amdgcn_mfma_f32_16x16x32_bf16(lds_frag(Vt + (NV + fr) * CS_SLD + 32 * ks2 + 8 * fq), pf[ks2], ai, 0, 0, 0);
#pragma unroll
                for (int kk = 0; kk < 4; ++kk) ao = __builtin_amdgcn_mfma_f32_16x16x32_bf16(lds_frag(St + (NV + fr) * CS_QLD + 32 * kk + 8 * fq), qf[kk], ao, 0, 0, 0);
                const float den = __shfl(ai[0] + ao[0] * ebt, fr); rden = 1.f / fmaxf(fabsf(den), 1.f); }
#pragma unroll
            for (int vj = 0; vj < NVC / 2; ++vj) { const int vt = (NVC / 2) * (w & 1) + vj; f32x4 ai = (f32x4){0.f, 0.f, 0.f, 0.f}, ao = (f32x4){0.f, 0.f, 0.f, 0.f};
#pragma unroll
                for (int ks2 = 0; ks2 < 2; ++ks2) ai = __builtin_amdgcn_mfma_f32_16x16x32_bf16(lds_frag(Vt + (16 * vt + fr) * CS_SLD + 32 * ks2 + 8 * fq), pf[ks2], ai, 0, 0, 0);
#pragma unroll
                for (int kk = 0; kk < 4; ++kk) ao = __builtin_amdgcn_mfma_f32_16x16x32_bf16(lds_frag(St + (16 * vt + fr) * CS_QLD + 32 * kk + 8 * fq), qf[kk], ao, 0, 0, 0);
                u32x2 wv; wv.x = pk2((ai[0] + ao[0] * ebt) * rden, (ai[1] + ao[1] * ebt) * rden); wv.y = pk2((ai[2] + ao[2] * ebt) * rden, (ai[3] + ao[3] * ebt) * rden);
                *(u32x2*)(Y + (size_t)m * YLD + ycol0 + 16 * vt + 4 * fq) = wv; }
        }
        {
            f32x4 dec; if (MODE == 1) dec = *(LAS f32x4*)(TOT + 4 * 128 + 16 * w + 4 * fq); else { const float d = __expf(BV[63]); dec = (f32x4){d, d, d, d}; }
            bf16x8 kf[2];
#pragma unroll
            for (int ks2 = 0; ks2 < 2; ++ks2) kf[ks2] = lds_frag(Kt + (16 * w + fr) * CS_SLD + 32 * ks2 + 8 * fq);
#pragma unroll
            for (int vt = 0; vt < NVT; ++vt) { Sacc[vt] = Sacc[vt] * dec;
#pragma unroll
                for (int ks2 = 0; ks2 < 2; ++ks2) Sacc[vt] = __builtin_amdgcn_mfma_f32_16x16x32_bf16(kf[ks2], lds_frag(Vt + (16 * vt + fr) * CS_SLD + 32 * ks2 + 8 * fq), Sacc[vt], 0, 0, 0); }
        }
        __syncthreads();
#pragma unroll
        for (int vt = 0; vt < NVT; ++vt) { u32x2 wv; wv.x = pk2(Sacc[vt][0], Sacc[vt][1]); wv.y = pk2(Sacc[vt][2], Sacc[vt][3]); *(LAS u32x2*)(St + (16 * vt + fr) * CS_QLD + 16 * w + 4 * fq) = wv; }
    }
    if (s < 16) {
        float* o; int kstride; float sc = 1.f;
        if (MODE == 0) { o = P.out + O_SSD + ((size_t)((s * 2 + j) * 2 + dir) * 16 + h) * 8192; kstride = 64; }
        else { o = P.out + (MODE == 1 ? O_GLA : O_MC) + ((size_t)((s * 2 + j) * 2 + dir) * 4 + h) * 32768 + vs * NV; kstride = 256; }
        if (MODE == 2) { __syncthreads(); sc = __expf(-MS[0]); }
#pragma unroll
        for (int vt = 0; vt < NVC; ++vt)
#pragma unroll
            for (int e = 0; e < 4; ++e) o[(size_t)(16 * w + 4 * fq + e) * kstride + 16 * vt + fr] = Sacc[vt][e] * sc;
        if (MODE == 2 && vs == 0) {
            if (fr == 0) {
#pragma unroll
                for (int e = 0; e < 4; ++e) P.out[O_MN + ((size_t)((s * 2 + j) * 2 + dir) * 4 + h) * 128 + 16 * w + 4 * fq + e] = Sacc[NVT - 1][e] * sc; }
            if (tid == 0) P.out[O_MM + ((s * 2 + j) * 2 + dir) * 4 + h] = MS[0]; }
    }
}

#define LO2(q_) ((f32x2){(q_)[0], (q_)[1]})
#define HI2(q_) ((f32x2){(q_)[2], (q_)[3]})
struct RwOps { f32x4 kk0, kk1, w0, w1, kd0, kd1, ka0, ka1, r0, r1; f32x2 vv; };
__device__ __forceinline__ RwOps rw_ops(const LAS float* B, int tt, int kg, int vg) {
    const LAS float* p = B + tt * 64 + 4 * kg; RwOps o;
    o.kk0 = *(const LAS f32x4*)(p + 4096); o.kk1 = *(const LAS f32x4*)(p + 4096 + 32); o.w0 = *(const LAS f32x4*)(p + 1024); o.w1 = *(const LAS f32x4*)(p + 1024 + 32);
    o.kd0 = *(const LAS f32x4*)(p + 2048); o.kd1 = *(const LAS f32x4*)(p + 2048 + 32); o.ka0 = *(const LAS f32x4*)(p + 5120); o.ka1 = *(const LAS f32x4*)(p + 5120 + 32);
    o.r0 = *(const LAS f32x4*)(p); o.r1 = *(const LAS f32x4*)(p + 32); o.vv = *(const LAS f32x2*)(B + 3072 + tt * 64 + 2 * vg); return o;
}
__device__ __forceinline__ void rwkv_pair(const Params& P, const Ctx& C, int j, int bq, bool lng) {
    const int niter = lng ? 64 : 32; const bool act = !lng || C.tid < 256;
    const int tid = C.tid, half = tid >> 8, tl = tid & 255, kg = tl & 7, vg = tl >> 3;
    const bf16_t* PREP = (const bf16_t*)(P.ws + WS_PREP); const bf16_t* LOUT = (const bf16_t*)(P.ws + WS_PROJ);
    constexpr int BUFSZ = 6 * 1024;
    LAS float* L0 = (LAS float*)C.lds + (lng ? 0 : half * 2 * BUFSZ);
    const int stt = tl >> 4, sc4 = (tl & 15) * 4;
    auto unit_of = [&](int cc, int& s, int& dir, int& h, int& lc) {
        if (lng) { s = 16 + (bq >> 5); dir = (bq >> 4) & 1; h = bq & 15; lc = cc; }
        else { const int q = 4 * bq + 2 * half + (cc >> 4); s = q >> 5; dir = (q >> 4) & 1; h = q & 15; lc = cc & 15; } };
    f32x2 Sa[4], Sb[4];
    auto init_state = [&](int s, int dir, int h) {
        const float* s0 = s >= 16 ? P.in[I_SRWKV] + (((size_t)(((s - 16) * 2 + j) * 2 + dir) * 16 + h) * 64 + 2 * vg) * 64 : nullptr;
#pragma unroll
        for (int hh = 0; hh < 2; ++hh) { const f32x4 u0 = s0 ? *(const f32x4*)(s0 + 32 * hh + 4 * kg) : (f32x4){0.f, 0.f, 0.f, 0.f}, u1 = s0 ? *(const f32x4*)(s0 + 64 + 32 * hh + 4 * kg) : (f32x4){0.f, 0.f, 0.f, 0.f};
            Sa[2 * hh] = LO2(u0); Sa[2 * hh + 1] = HI2(u0); Sb[2 * hh] = LO2(u1); Sb[2 * hh + 1] = HI2(u1); } };
    u32x2 rr, rk, rv, rkk, rwl, ral; f32x4 cw0, ca0, cka;
    auto load_raw = [&](int cc) {
        int s, dir, h, lc; unit_of(cc, s, dir, h, lc);
        const int T = s < 16 ? 256 : 1024, base = s < 16 ? s * 256 : 4096 + (s - 16) * 1024;
        const int step = lc * 16 + stt; const int m = base + (dir ? (T - 1 - step) : step);
        const bf16_t* pp = PREP + (size_t)m * PREP_LD + h * 64 + sc4; const bf16_t* lo = LOUT + (size_t)m * LOUT_LD + dir * 1024 + h * 64 + sc4;
        rr = *(const u32x2*)(pp + 3072); rk = *(const u32x2*)(pp + 4096); rv = *(const u32x2*)(pp + 5120); rkk = *(const u32x2*)(pp + 6144);
        rwl = *(const u32x2*)lo; ral = *(const u32x2*)(lo + 2048);
        cw0 = *(const f32x4*)(P.in[I_W0] + (j * 2 + dir) * 1024 + h * 64 + sc4); ca0 = *(const f32x4*)(P.in[I_A0] + (j * 2 + dir) * 1024 + h * 64 + sc4); cka = *(const f32x4*)(P.in[I_KA] + j * 1024 + h * 64 + sc4);
    };
    auto write_lds = [&](LAS float* B) {
        const f32x4 r = unpack4(rr), k = unpack4(rk), v = unpack4(rv), kk = unpack4(rkk), wl = unpack4(rwl), al = unpack4(ral);
        f32x4 w, kd, kka;
#pragma unroll
        for (int e = 0; e < 4; ++e) { const float wp = cw0[e] + wl[e]; const float lw = -__expf(-softplusf_(-wp) - 0.5f); w[e] = __expf(lw);
            const float a = sigmoidf_(ca0[e] + al[e]); kd[e] = k[e] * (1.f + (a - 1.f) * cka[e]); kka[e] = kk[e] * a; }
        LAS float* p = B + stt * 64 + sc4;
        *(LAS f32x4*)(p) = r; *(LAS f32x4*)(p + 1024) = w; *(LAS f32x4*)(p + 2048) = kd; *(LAS f32x4*)(p + 3072) = v; *(LAS f32x4*)(p + 4096) = kk; *(LAS f32x4*)(p + 5120) = kka;
    };
    __syncthreads();
    if (!lng || half == 1) { load_raw(0); write_lds(L0); }
    if (act) { int s, dir, h, lc; unit_of(0, s, dir, h, lc); init_state(s, dir, h); }
    __syncthreads();
#pragma unroll 1
    for (int cc = 0; cc < niter; ++cc) {
        if (lng && half == 1) { if (cc + 1 < niter) { load_raw(cc + 1); write_lds(L0 + ((cc + 1) & 1) * BUFSZ); } }
        if (act) {
        LAS float* B = L0 + (cc & 1) * BUFSZ;
        int s, dir, h, lc; unit_of(cc, s, dir, h, lc);
        const int T = s < 16 ? 256 : 1024, base = s < 16 ? s * 256 : 4096 + (s - 16) * 1024;
        if (!lng && cc + 1 < niter) load_raw(cc + 1);
        bf16_t* Yp = (bf16_t*)(P.ws + WS_MP) + (size_t)dir * MTOK * YLD + 1024 + h * 64 + 2 * vg + (size_t)(base + (dir ? (T - 1 - lc * 16) : lc * 16)) * YLD;
        const long ystep = dir ? -(long)YLD : (long)YLD;
        RwOps cur = rw_ops(B, 0, kg, vg);
#pragma unroll
        for (int tt = 0; tt < 16; ++tt) {
            const RwOps nx = rw_ops(B, (tt + 1) & 15, kg, vg);
            const f32x2 da = (Sa[0] * LO2(cur.kk0) + Sa[1] * HI2(cur.kk0)) + (Sa[2] * LO2(cur.kk1) + Sa[3] * HI2(cur.kk1));
            const f32x2 db = (Sb[0] * LO2(cur.kk0) + Sb[1] * HI2(cur.kk0)) + (Sb[2] * LO2(cur.kk1) + Sb[3] * HI2(cur.kk1));
            const float ska = row_sum8(da.x + da.y), skb = row_sum8(db.x + db.y);
            const f32x2 na = (f32x2){-ska, -ska}, nb = (f32x2){-skb, -skb}, va = (f32x2){cur.vv.x, cur.vv.x}, vb = (f32x2){cur.vv.y, cur.vv.y};
            Sa[0] = Sa[0] * LO2(cur.w0) + na * LO2(cur.ka0) + va * LO2(cur.kd0); Sa[1] = Sa[1] * HI2(cur.w0) + na * HI2(cur.ka0) + va * HI2(cur.kd0);
            Sa[2] = Sa[2] * LO2(cur.w1) + na * LO2(cur.ka1) + va * LO2(cur.kd1); Sa[3] = Sa[3] * HI2(cur.w1) + na * HI2(cur.ka1) + va * HI2(cur.kd1);
            Sb[0] = Sb[0] * LO2(cur.w0) + nb * LO2(cur.ka0) + vb * LO2(cur.kd0); Sb[1] = Sb[1] * HI2(cur.w0) + nb * HI2(cur.ka0) + vb * HI2(cur.kd0);
            Sb[2] = Sb[2] * LO2(cur.w1) + nb * LO2(cur.ka1) + vb * LO2(cur.kd1); Sb[3] = Sb[3] * HI2(cur.w1) + nb * HI2(cur.ka1) + vb * HI2(cur.kd1);
            const f32x2 ya = (Sa[0] * LO2(cur.r0) + Sa[1] * HI2(cur.r0)) + (Sa[2] * LO2(cur.r1) + Sa[3] * HI2(cur.r1));
            const f32x2 yb = (Sb[0] * LO2(cur.r0) + Sb[1] * HI2(cur.r0)) + (Sb[2] * LO2(cur.r1) + Sb[3] * HI2(cur.r1));
            const float y0 = row_sum8(ya.x + ya.y), y1 = row_sum8(yb.x + yb.y);
            *(unsigned*)Yp = pg8::cvt_pk_bf16(y0, y1);
            Yp += ystep;
            cur = nx;
        }
        const int nchU = lng ? 64 : 16;
        if (lc == nchU - 1 && s < 16) { float* o = P.out + O_RWKV + (((size_t)((s * 2 + j) * 2 + dir) * 16 + h) * 64 + 2 * vg) * 64;
#pragma unroll
            for (int hh = 0; hh < 2; ++hh) { *(f32x4*)(o + 32 * hh + 4 * kg) = (f32x4){Sa[2 * hh].x, Sa[2 * hh].y, Sa[2 * hh + 1].x, Sa[2 * hh + 1].y};
                *(f32x4*)(o + 64 + 32 * hh + 4 * kg) = (f32x4){Sb[2 * hh].x, Sb[2 * hh].y, Sb[2 * hh + 1].x, Sb[2 * hh + 1].y}; } }
        if (cc + 1 < niter) { if (!lng) write_lds(L0 + ((cc + 1) & 1) * BUFSZ);
            if (lc == nchU - 1) { int s2, d2_, h2, lc2; unit_of(cc + 1, s2, d2_, h2, lc2); init_state(s2, d2_, h2); } }
        }
        __syncthreads();
    }
}

__device__ __forceinline__ void scan_unit(const Params& P, const Ctx& C, int l, int type, int q) {
    const int j = l >> 1; const bool ev = (l & 1) == 0;
    if (ev) { int s, idx; if (q < 128) { s = 16 + (q >> 5); idx = q & 31; } else { const int r = q - 128; s = r >> 5; idx = r & 31; }
        chunk_scan<0>(P, C, j, s, idx >> 4, idx & 15, 0); }
    else { int s, idx; if (q < 64) { s = 16 + (q >> 4); idx = q & 15; } else { const int r = q - 64; s = r >> 4; idx = r & 15; }
        const int dir = idx >> 3, h = (idx >> 1) & 3, vs = idx & 1; if (type == 0) chunk_scan<1>(P, C, j, s, dir, h, vs); else chunk_scan<2>(P, C, j, s, dir, h, vs); }
}
__device__ __forceinline__ int queue_next(const Params& P, const Ctx& C, int l) {
    volatile LAS unsigned* qw = (volatile LAS unsigned*)(C.lds + LDS_BYTES - 16);
    __syncthreads();
    if (C.tid == 0) qw[3] = __hip_atomic_fetch_add((unsigned*)(P.ws + WS_CTL) + 6144 + 64 * l, 1u, __ATOMIC_RELAXED, __HIP_MEMORY_SCOPE_AGENT);
    __syncthreads();
    return __builtin_amdgcn_readfirstlane((int)qw[3]);
}
__device__ __forceinline__ void phase_scan(const Params& P, const Ctx& C0, int l) {
    const int G = C0.G, bid = C0.bid; const bool ev = (l & 1) == 0;
    if (ev) {
        if (G == 256) rwkv_pair(P, fresh_ctx(C0.lds), l >> 1, bid < 128 ? bid : bid - 128, bid < 128);
        else {
#pragma unroll 1
            for (int x = bid; x < 256; x += G) rwkv_pair(P, fresh_ctx(C0.lds), l >> 1, x < 128 ? x : x - 128, x < 128);
        }
#pragma unroll 1
        for (;;) { const Ctx C = fresh_ctx(C0.lds); const int x = queue_next(P, C, l); if (x >= 640) break; scan_unit(P, C, l, 0, x); }
        return;
    }
#pragma unroll 1
    for (;;) { const Ctx C = fresh_ctx(C0.lds); const int x = queue_next(P, C, l); if (x >= 640) break;
        int type, q; if (x < 128) { type = x >> 6; q = x & 63; } else { const int r = x - 128; type = r & 1; q = 64 + (r >> 1); }
        scan_unit(P, C, l, type, q); }
}

__device__ __forceinline__ void ld16(const bf16_t* p, float* o) { unpack8(*(const u32x4*)p, o); unpack8(*(const u32x4*)(p + 8), o + 8); }
__device__ __forceinline__ void ld16f(const float* p, float* o) {
#pragma unroll
    for (int q = 0; q < 4; ++q) { const f32x4 v = *(const f32x4*)(p + 4 * q); o[4 * q] = v.x; o[4 * q + 1] = v.y; o[4 * q + 2] = v.z; o[4 * q + 3] = v.w; } }
__device__ __forceinline__ void st16(bf16_t* p, const float* o) { *(u32x4*)p = pack8(o); *(u32x4*)(p + 8) = pack8(o + 8); }
struct R16 { u32x4 a, b; };
__device__ __forceinline__ R16 ldraw(const bf16_t* p) { R16 r; r.a = *(const u32x4*)p; r.b = *(const u32x4*)(p + 8); return r; }
__device__ __forceinline__ void cvt16(const R16& r, float* o) { unpack8(r.a, o); unpack8(r.b, o + 8); }
__device__ __forceinline__ void phase_post(const Params& P, const Ctx& C, int l) {
    const int j = l >> 1; const bool ev = (l & 1) == 0;
    const bf16_t* PROJ = (const bf16_t*)(P.ws + WS_PROJ); const bf16_t* PREP = (const bf16_t*)(P.ws + WS_PREP);
    const bf16_t* Y0 = (const bf16_t*)(P.ws + WS_MP); const bf16_t* Y1 = Y0 + (size_t)MTOK * YLD; bf16_t* MIX = (bf16_t*)(P.ws + WS_MIX);
    const int gw = C.bid * 8 + C.wave, NGW = C.G * 8, lane = C.lane, c0 = lane * 16;
#pragma unroll 1
    for (int m = gw; m < MTOK; m += NGW) {
        float ya[16], yb[16], t0[16], t1[16], o[16];
        if (ev) {
            const bf16_t* pp = PREP + (size_t)m * PREP_LD;
            const R16 rY0a = ldraw(Y0 + (size_t)m * YLD + c0), rY1a = ldraw(Y1 + (size_t)m * YLD + c0), rXS = ldraw(pp + c0), rSZ = ldraw(pp + 2048 + c0);
            const R16 rY0b = ldraw(Y0 + (size_t)m * YLD + 1024 + c0), rY1b = ldraw(Y1 + (size_t)m * YLD + 1024 + c0);
            const R16 rR = ldraw(pp + 3072 + c0), rK = ldraw(pp + 4096 + c0), rV = ldraw(pp + 5120 + c0), rG = ldraw(PROJ + (size_t)m * LOUT_LD + 4096 + c0);
            float pn[16], pw[16], pb[16], pk[16];
            ld16f(P.in[I_SSDN] + j * 1024 + c0, pn); ld16f(P.in[I_LNW] + j * 1024 + c0, pw); ld16f(P.in[I_LNB] + j * 1024 + c0, pb); ld16f(P.in[I_RK] + j * 1024 + c0, pk);
            cvt16(rY0a, ya); cvt16(rY1a, yb); cvt16(rXS, t0); cvt16(rSZ, t1);
            const float dsk = P.in[I_SSDD][j * 16 + (lane >> 2)]; float ss = 0.f;
#pragma unroll
            for (int e = 0; e < 16; ++e) { o[e] = (ya[e] + yb[e] + t0[e] * dsk) * t1[e]; ss += o[e] * o[e]; }
            const float rs = rsqrtf(wave_sum(ss) * (1.f / 1024.f) + 1e-6f);
#pragma unroll
            for (int e = 0; e < 16; ++e) o[e] = o[e] * rs * pn[e];
            st16(MIX + (size_t)m * 2048 + c0, o);
            cvt16(rY0b, ya); cvt16(rY1b, yb);
            float mu = 0.f;
#pragma unroll
            for (int e = 0; e < 16; ++e) { ya[e] += yb[e]; mu += ya[e]; }
            mu += __shfl_xor(mu, 1); mu += __shfl_xor(mu, 2); mu *= (1.f / 64.f);
            float var = 0.f;
#pragma unroll
            for (int e = 0; e < 16; ++e) { ya[e] -= mu; var += ya[e] * ya[e]; }
            var += __shfl_xor(var, 1); var += __shfl_xor(var, 2); var *= (1.f / 64.f);
            const float rstd = rsqrtf(var + 64e-5f);
#pragma unroll
            for (int e = 0; e < 16; ++e) o[e] = ya[e] * rstd * pw[e] + pb[e];
            cvt16(rR, ya); cvt16(rK, yb);
            float bs = 0.f;
#pragma unroll
            for (int e = 0; e < 16; ++e) bs += ya[e] * yb[e] * pk[e];
            bs += __shfl_xor(bs, 1); bs += __shfl_xor(bs, 2);
            cvt16(rV, ya); cvt16(rG, yb);
#pragma unroll
            for (int e = 0; e < 16; ++e) o[e] = (o[e] + bs * ya[e]) * yb[e];
            st16(MIX + (size_t)m * 2048 + 1024 + c0, o);
        } else {
            const bf16_t* pr = PROJ + (size_t)m * PROJ_LD_CD;
            const R16 rA0 = ldraw(Y0 + (size_t)m * YLD + c0), rB0 = ldraw(Y1 + (size_t)m * YLD + c0), rA1 = ldraw(Y0 + (size_t)m * YLD + 1024 + c0), rB1 = ldraw(Y1 + (size_t)m * YLD + 1024 + c0);
            const R16 rG0 = ldraw(pr + 2048 + c0), rG1 = ldraw(pr + IN_GLA + 2048 + c0);
            float pg[16], pm[16]; ld16f(P.in[I_GLAN] + j * 1024 + c0, pg); ld16f(P.in[I_MLN] + j * 1024 + c0, pm);
#pragma unroll
            for (int g = 0; g < 2; ++g) {
                cvt16(g == 0 ? rA0 : rA1, ya); cvt16(g == 0 ? rB0 : rB1, yb);
                float ss = 0.f;
#pragma unroll
                for (int e = 0; e < 16; ++e) { ya[e] += yb[e]; ss += ya[e] * ya[e]; }
                ss += __shfl_xor(ss, 1); ss += __shfl_xor(ss, 2); ss += __shfl_xor(ss, 4); ss += __shfl_xor(ss, 8);
                const float rs = rsqrtf(ss * (1.f / 256.f) + 1e-6f);
                cvt16(g == 0 ? rG0 : rG1, t1);
#pragma unroll
                for (int e = 0; e < 16; ++e) o[e] = ya[e] * rs * (g == 0 ? pg[e] : pm[e]) * (g == 0 ? siluf_(t1[e]) : sigmoidf_(t1[e]));
                st16(MIX + (size_t)m * 2048 + g * 1024 + c0, o);
            }
        }
    }
}

__global__ void __launch_bounds__(512, 2) hybrid_fwd(Params P) {
    extern __shared__ __attribute__((aligned(16))) unsigned char lds_raw[];
    cg::grid_group grid = cg::this_grid();
    Ctx C; C.lds = (LAS unsigned char*)lds_raw; C.tid = threadIdx.x; C.lane = C.tid & 63; C.wave = __builtin_amdgcn_readfirstlane(C.tid >> 6); C.G = gridDim.x; C.bid = blockIdx.x;
    const float* MOD = (const float*)(P.ws + WS_MOD);
    const bf16_t* H = (const bf16_t*)(P.ws + WS_H);
    if (C.tid < 4) ((volatile LAS unsigned*)(C.lds + LDS_BYTES - 16))[C.tid] = 0u;
    __syncthreads();
    const XcdBarrier xb = xcd_barrier_post((unsigned*)(P.ws + WS_CTL), (volatile LAS unsigned*)(C.lds + LDS_BYTES - 16));
    REP(1) if (PH & 1) phase_mod(P, fresh_ctx(C.lds));
    REP(2) if (PH & 2) phase_convert(P, fresh_ctx(C.lds), 0);
    if (P.ws == nullptr) grid.sync(); else GSYNC();
    if (PH & 4) phase_rows(P, fresh_ctx(C.lds), 0, nullptr, nullptr, true, P.in[I_NORMG] + 0, MOD + 0);
    GSYNC();
#pragma unroll 1
    for (int l = 0; l < 4; ++l) {
        const bool ev = (l & 1) == 0; const float* modl = MOD + (size_t)l * 5 * 6144; const float* ng = P.in[I_NORMG] + l * 4 * 1024;
        REP(8) if (PH & 8) { pg8::Gemm g{H, (const bf16_t*)(P.ws + WS_WIN), 1024, 1024, 1024}; pg8::Sched<0> S; S.init(MTOK, ev ? N_AB_P : N_CD_P, 1, 1024, C.G, C.bid);
          pg8::EpiBf16<0> E{(bf16_t*)(P.ws + WS_PROJ), ev ? PROJ_LD_AB : PROJ_LD_CD, 0}; pg8::gemm_phase(C.lds, g, S, E); }
        GSYNC();
        REP(16) if (PH & 16) { if (ev) phase_prep_even(P, fresh_ctx(C.lds), l >> 1); else phase_prep_odd(P, fresh_ctx(C.lds), l >> 1); }
        GSYNC();
        if (ev && (PH & 32)) {
            REP(32) {
            pg8::Gemm g{(const bf16_t*)(P.ws + WS_LORAA), (const bf16_t*)(P.ws + WS_WLORA), LORA_K, 128, 128}; pg8::Sched<1> S; S.init(MTOK, LOUT_LD, 1, 128, C.G, C.bid);
            pg8::EpiBf16<0> E{(bf16_t*)(P.ws + WS_PROJ), LOUT_LD, 0}; pg8::gemm_phase(C.lds, g, S, E); }
            GSYNC();
        }
        for (int rep_ = 0; rep_ < (((DUP & 64) && ev) || ((DUP & 0x4000) && !ev) ? 2 : 1); ++rep_) if (PH & 64) phase_scan(P, fresh_ctx(C.lds), l);
        GSYNC();
        REP(128) if (PH & 128) phase_post(P, fresh_ctx(C.lds), l);
        GSYNC();
        REP(256) if (PH & 256) { pg8::Gemm g{(const bf16_t*)(P.ws + WS_MIX), (const bf16_t*)(P.ws + WS_WOUT), 2048, 2048, 1024}; pg8::Sched<0> S; S.init(MTOK, 1024, 2, 1024, C.G, C.bid);
          pg8::EpiBf16<0> E{(bf16_t*)(P.ws + WS_MP), 1024, (size_t)MTOK * 1024}; pg8::gemm_phase(C.lds, g, S, E); }
        GSYNC();
        if (DUP & 512) phase_rows(P, fresh_ctx(C.lds), 1, ng + 1024, modl + 2048, true, ng + 2048, modl + 3072, true);
        if (PH & 512) phase_rows(P, fresh_ctx(C.lds), 1, ng + 1024, modl + 2048, true, ng + 2048, modl + 3072);
        GSYNC();
        REP(1024) if (PH & 1024) { pg8::Gemm g{H, (const bf16_t*)(P.ws + WS_WUP), 1024, 1024, 1024}; pg8::Sched<0> S; S.init(MTOK, 4096, 1, 1024, C.G, C.bid);
          pg8::EpiBf16<2> E{(bf16_t*)(P.ws + WS_PROJ), 4096, 0}; pg8::gemm_phase(C.lds, g, S, E); }
        GSYNC();
        REP(2048) if (PH & 2048) { pg8::Gemm g{(const bf16_t*)(P.ws + WS_PROJ), (const bf16_t*)(P.ws + WS_WDN), 4096, 4096, 2048}; pg8::Sched<0> S; S.init(MTOK, 1024, 2, 2048, C.G, C.bid);
          pg8::EpiBf16<0> E{(bf16_t*)(P.ws + WS_MP), 1024, (size_t)MTOK * 1024}; pg8::gemm_phase(C.lds, g, S, E); }
        GSYNC();
        if (DUP & 4096) phase_rows(P, fresh_ctx(C.lds), 1, ng + 3072, modl + 5120, true, ng + 2048, modl + 3072, true);
        if (PH & 4096) { if (l < 3) { phase_rows(P, fresh_ctx(C.lds), 1, ng + 3072, modl + 5120, true, ng + 4096, modl + 5 * 6144); phase_convert(P, fresh_ctx(C.lds), l + 1); }
        else phase_rows(P, fresh_ctx(C.lds), 1, ng + 3072, modl + 5120, false, nullptr, nullptr); }
        if (l < 3) GSYNC();
    }
}

extern "C" void kernel_launch(void* const* d_in, const int* in_sizes, int n_in, void* d_out, int out_size, void* d_ws, size_t ws_size, hipStream_t stream) {
    static int grid = 0;
    if (grid == 0) {
        if (n_in != 44 || ws_size < WS_END) { fprintf(stderr, "kernel_launch: unexpected n_in %d / ws %zu\n", n_in, ws_size); grid = -1; return; }
        int dev = 0, cus = 0, per_cu = 0;
        hipGetDevice(&dev); hipDeviceGetAttribute(&cus, hipDeviceAttributeMultiprocessorCount, dev);
        if (hipFuncSetAttribute((const void*)hybrid_fwd, hipFuncAttributeMaxDynamicSharedMemorySize, LDS_BYTES) != hipSuccess) { fprintf(stderr, "hipFuncSetAttribute failed\n"); grid = -1; return; }
        hipOccupancyMaxActiveBlocksPerMultiprocessor(&per_cu, (const void*)hybrid_fwd, 512, LDS_BYTES);
        (void)hipGetLastError();
        if (per_cu < 1) per_cu = 1;
        grid = cus * 1;
    }
    if (grid < 0) return;
    if (hipMemsetAsync((char*)d_ws + WS_CTL, 0, CTL_BYTES, stream) != hipSuccess) { fprintf(stderr, "memset failed\n"); return; }
    Params p{};
    for (int i = 0; i < 44; ++i) p.in[i] = (const float*)d_in[i];
    p.out = (float*)d_out; p.ws = (unsigned char*)d_ws;
    void* args[] = {&p};
    hipError_t e = hipLaunchCooperativeKernel((const void*)hybrid_fwd, dim3(grid), dim3(512), args, LDS_BYTES, stream);
    if (e != hipSuccess) fprintf(stderr, "cooperative launch failed: %s (grid %d)\n", hipGetErrorString(e), grid);
}
```
